# Optimizing an MI355X kernel written in HIP

```python
import jax, jax.numpy as jnp
from jax import lax
import numpy as np

D_MODEL = 1024
BATCH = 8
SEQ = 2048
DEPTH = 1

D_MIX = D_MODEL
D_LRU = D_MIX // 2
LRU_BLOCKS = 8
LRU_BLOCK_DIM = D_LRU // LRU_BLOCKS
CONV_WIDTH = 4
LRU_C = 8.0
D_ATTN = D_MIX - D_LRU
ATTN_HEADS = 8
HEAD_DIM = D_ATTN // ATTN_HEADS
Q_BLOCK = 128
D_IN_PROJ = 2 * D_LRU + 3 * D_ATTN + ATTN_HEADS
IN_SPLITS = (D_LRU, 2 * D_LRU, 2 * D_LRU + D_ATTN, 2 * D_LRU + 2 * D_ATTN, 2 * D_LRU + 3 * D_ATTN)
N_EXPERTS = 32
TOP_K = 4
D_EXPERT = D_MODEL
SWIGLU_ALPHA = 1.702
SWIGLU_LIMIT = 7.0
EXPERT_BLOCK = 256
N_MOD = 6
RMS_EPS = 1e-6

kernel_name = "hybrid_rglru_fox_moe_block"


def rmsnorm(x, g):
    xf = x.astype(jnp.float32)
    y = xf * lax.rsqrt(jnp.mean(xf * xf, axis=-1, keepdims=True) + RMS_EPS)
    return (y * g.astype(jnp.float32)).astype(x.dtype)


def causal_depthwise_conv(x, w, b):
    y = lax.conv_general_dilated(
        x, w[:, None, :].astype(x.dtype), window_strides=(1,),
        padding=[(CONV_WIDTH - 1, 0)], dimension_numbers=("NWC", "WIO", "NWC"),
        feature_group_count=x.shape[-1])
    return y + b


def _lin_rec_combine(left, right):
    a_l, b_l = left
    a_r, b_r = right
    return a_l * a_r, a_r * b_l + b_r


def rg_lru(x, wa, ba, wx, bx, lam):
    b, s, _ = x.shape
    xg = x.reshape(b, s, LRU_BLOCKS, LRU_BLOCK_DIM)
    r = jax.nn.sigmoid(jnp.einsum("bsgi,gij->bsgj", xg, wa) + ba).reshape(b, s, D_LRU)
    i = jax.nn.sigmoid(jnp.einsum("bsgi,gij->bsgj", xg, wx) + bx).reshape(b, s, D_LRU)
    log_a = -LRU_C * r.astype(jnp.float32) * jax.nn.softplus(-lam.astype(jnp.float32))
    a = jnp.exp(log_a)
    gated_x = jnp.sqrt(1.0 - jnp.exp(2.0 * log_a)) * (i * x).astype(jnp.float32)
    _, h = lax.associative_scan(_lin_rec_combine, (a, gated_x), axis=1)
    return h.astype(x.dtype)


def forgetting_attention(q, k, v, f_logit):
    b, s, h, dh = q.shape
    nb = s // Q_BLOCK
    cum = jnp.cumsum(jax.nn.log_sigmoid(f_logit.astype(jnp.float32)), axis=1).transpose(0, 2, 1)
    qb = q.reshape(b, nb, Q_BLOCK, h, dh).transpose(1, 0, 2, 3, 4)
    cq = cum.reshape(b, h, nb, Q_BLOCK).transpose(2, 0, 1, 3)
    kpos = jnp.arange(s, dtype=jnp.int32)
    qpos = kpos.reshape(nb, Q_BLOCK)
    scale = dh ** -0.5

    def block(args):
        q_blk, c_blk, p_blk = args
        logits = jnp.einsum("bqhd,bkhd->bhqk", q_blk, k).astype(jnp.float32) * scale
        logits = logits + c_blk[..., :, None] - cum[..., None, :]
        logits = jnp.where(p_blk[:, None] >= kpos[None, :], logits, -jnp.inf)
        p = jax.nn.softmax(logits, axis=-1).astype(v.dtype)
        return jnp.einsum("bhqk,bkhd->bqhd", p, v)

    out = lax.map(block, (qb, cq, qpos))
    return out.transpose(1, 0, 2, 3, 4).reshape(b, s, h * dh)


def hybrid_mixer(h, w_in, conv_w, conv_b, lru_wa, lru_ba, lru_wx, lru_bx, lru_lambda,
                 attn_fb, gn_lru, gn_attn, w_out):
    b, s, _ = h.shape
    proj = h @ w_in
    x_lru, y_lru, q, k, v, f_logit = jnp.split(proj, IN_SPLITS, axis=-1)
    x_conv = causal_depthwise_conv(x_lru, conv_w, conv_b)
    lru_out = rg_lru(x_conv, lru_wa, lru_ba, lru_wx, lru_bx, lru_lambda) * jax.nn.gelu(y_lru)
    shp = (b, s, ATTN_HEADS, HEAD_DIM)
    attn_out = forgetting_attention(q.reshape(shp), k.reshape(shp), v.reshape(shp), f_logit + attn_fb)
    merged = jnp.concatenate([rmsnorm(lru_out, gn_lru), rmsnorm(attn_out, gn_attn)], axis=-1)
    return merged @ w_out


def moe_ffn(h, w_router, b_router, w_up, b_up, w_down, b_down):
    n = h.shape[0]
    logits = (h @ w_router + b_router).astype(jnp.float32)
    top_logit, top_idx = lax.top_k(logits, TOP_K)
    top_w = jax.nn.softmax(top_logit, axis=-1).astype(h.dtype)
    e_flat = top_idx.reshape(-1).astype(jnp.int32)
    w_flat = top_w.reshape(-1)
    tok_flat = jnp.arange(n * TOP_K, dtype=jnp.int32) // TOP_K
    order = jnp.argsort(e_flat)
    e_sorted = e_flat[order]
    counts = jnp.bincount(e_flat, length=N_EXPERTS).astype(jnp.int32)
    starts = jnp.cumsum(counts) - counts
    padded = (counts + EXPERT_BLOCK - 1) // EXPERT_BLOCK * EXPERT_BLOCK
    pends = jnp.cumsum(padded)
    pstarts = pends - padded
    rank = jnp.arange(n * TOP_K, dtype=jnp.int32) - starts[e_sorted]
    dest = pstarts[e_sorted] + rank
    n_blocks = (n * TOP_K + EXPERT_BLOCK - 1) // EXPERT_BLOCK + N_EXPERTS
    n_rows = n_blocks * EXPERT_BLOCK
    row_tok = jnp.zeros((n_rows,), jnp.int32).at[dest].set(tok_flat[order])
    row_w = jnp.zeros((n_rows,), h.dtype).at[dest].set(w_flat[order])
    blk_start = jnp.arange(n_blocks, dtype=jnp.int32) * EXPERT_BLOCK
    blk_exp = jnp.minimum(jnp.searchsorted(pends, blk_start, side="right"), N_EXPERTS - 1).astype(jnp.int32)

    def expert_block(args):
        tok, e = args
        xb = h[tok]
        gu = xb @ w_up[e] + b_up[e]
        glu = jnp.minimum(gu[:, :D_EXPERT], SWIGLU_LIMIT)
        lin = jnp.clip(gu[:, D_EXPERT:], -SWIGLU_LIMIT, SWIGLU_LIMIT)
        act = glu * jax.nn.sigmoid(SWIGLU_ALPHA * glu) * (lin + 1.0)
        return act @ w_down[e] + b_down[e]

    rows = lax.map(expert_block, (row_tok.reshape(n_blocks, EXPERT_BLOCK), blk_exp))
    return jax.ops.segment_sum(rows.reshape(n_rows, -1) * row_w[:, None], row_tok, num_segments=n)


def setup_inputs(seed: int = 0) -> dict:
    key = jax.random.key(seed)
    ks = jax.random.split(key, 26)

    def nrm(k, shape, scale):
        return jax.random.normal(k, shape, jnp.float32) * scale

    u = jax.random.uniform(ks[13], (DEPTH, D_LRU), jnp.float32, 0.9, 0.999)
    p = u ** (1.0 / LRU_C)
    return {
        "x": nrm(ks[0], (BATCH, SEQ, D_MODEL), 1.0),
        "c": nrm(ks[1], (BATCH, D_MODEL), 1.0),
        "w_ada": nrm(ks[2], (DEPTH, D_MODEL, N_MOD * D_MODEL), 0.5 * D_MODEL ** -0.5),
        "b_ada": nrm(ks[3], (DEPTH, N_MOD * D_MODEL), 0.02),
        "norm_mix_pre": 1.0 + nrm(ks[4], (DEPTH, D_MODEL), 0.05),
        "norm_mix_post": 1.0 + nrm(ks[5], (DEPTH, D_MODEL), 0.05),
        "w_in": nrm(ks[6], (DEPTH, D_MODEL, D_IN_PROJ), D_MODEL ** -0.5),
        "conv_w": nrm(ks[7], (DEPTH, CONV_WIDTH, D_LRU), CONV_WIDTH ** -0.5),
        "conv_b": nrm(ks[8], (DEPTH, D_LRU), 0.02),
        "lru_wa": nrm(ks[9], (DEPTH, LRU_BLOCKS, LRU_BLOCK_DIM, LRU_BLOCK_DIM), LRU_BLOCK_DIM ** -0.5),
        "lru_ba": nrm(ks[10], (DEPTH, LRU_BLOCKS, LRU_BLOCK_DIM), 0.02),
        "lru_wx": nrm(ks[11], (DEPTH, LRU_BLOCKS, LRU_BLOCK_DIM, LRU_BLOCK_DIM), LRU_BLOCK_DIM ** -0.5),
        "lru_bx": nrm(ks[12], (DEPTH, LRU_BLOCKS, LRU_BLOCK_DIM), 0.02),
        "lru_lambda": jnp.log(p) - jnp.log1p(-p),
        "attn_fb": jnp.linspace(1.0, 5.0, ATTN_HEADS, dtype=jnp.float32)[None, :] + nrm(ks[14], (DEPTH, ATTN_HEADS), 0.1),
        "gn_lru": 1.0 + nrm(ks[15], (DEPTH, D_LRU), 0.05),
        "gn_attn": 1.0 + nrm(ks[16], (DEPTH, D_ATTN), 0.05),
        "w_out": nrm(ks[17], (DEPTH, D_MIX, D_MODEL), D_MIX ** -0.5),
        "norm_ffn_pre": 1.0 + nrm(ks[18], (DEPTH, D_MODEL), 0.05),
        "norm_ffn_post": 1.0 + nrm(ks[19], (DEPTH, D_MODEL), 0.05),
        "w_router": nrm(ks[20], (DEPTH, D_MODEL, N_EXPERTS), D_MODEL ** -0.5),
        "b_router": nrm(ks[21], (DEPTH, N_EXPERTS), 0.01),
        "w_up": nrm(ks[22], (DEPTH, N_EXPERTS, D_MODEL, 2 * D_EXPERT), D_MODEL ** -0.5),
        "b_up": nrm(ks[23], (DEPTH, N_EXPERTS, 2 * D_EXPERT), 0.01),
        "w_down": nrm(ks[24], (DEPTH, N_EXPERTS, D_EXPERT, D_MODEL), D_EXPERT ** -0.5),
        "b_down": nrm(ks[25], (DEPTH, N_EXPERTS, D_MODEL), 0.01),
    }


def reference(x, c, w_ada, b_ada, norm_mix_pre, norm_mix_post, w_in, conv_w, conv_b,
              lru_wa, lru_ba, lru_wx, lru_bx, lru_lambda, attn_fb, gn_lru, gn_attn, w_out,
              norm_ffn_pre, norm_ffn_post, w_router, b_router, w_up, b_up, w_down, b_down):
    b, s, d = x.shape
    cond = jax.nn.silu(c)
    for l in range(DEPTH):
        mod = cond @ w_ada[l] + b_ada[l]
        sh_m, sc_m, g_m, sh_f, sc_f, g_f = [m[:, None, :] for m in jnp.split(mod, N_MOD, axis=-1)]
        h = rmsnorm(x, norm_mix_pre[l]) * (1.0 + sc_m) + sh_m
        y = hybrid_mixer(h, w_in[l], conv_w[l], conv_b[l], lru_wa[l], lru_ba[l], lru_wx[l],
                         lru_bx[l], lru_lambda[l], attn_fb[l], gn_lru[l], gn_attn[l], w_out[l])
        x = x + g_m * rmsnorm(y, norm_mix_post[l])
        h = rmsnorm(x, norm_ffn_pre[l]) * (1.0 + sc_f) + sh_f
        y = moe_ffn(h.reshape(b * s, d), w_router[l], b_router[l], w_up[l], b_up[l],
                    w_down[l], b_down[l]).reshape(b, s, d)
        x = x + g_f * rmsnorm(y, norm_ffn_post[l])
    return x
```

```cpp
#include <hip/hip_runtime.h>
#include <cstdio>
#include <cstdint>

constexpr int DM = 1024, BATCH = 8, SEQ = 2048, NTOK = BATCH * SEQ;
constexpr int DLRU = 512, DATT = 512, NH = 8, HD = 64, NPROJ = 2 * DLRU + 3 * DATT + NH;
constexpr int NE = 32, TOPK = 4, DEXP = 1024, NMOD = 6;
constexpr float RMS_EPS = 1e-6f;

__device__ __forceinline__ float sigmoidf_(float x) { return 1.f / (1.f + __expf(-x)); }
__device__ __forceinline__ float gelu_tanh(float x) { const float u = 0.7978845608028654f * (x + 0.044715f * x * x * x); return 0.5f * x * (1.f + tanhf(u)); }
__device__ __forceinline__ float log_sigmoid(float z) { return z >= 0.f ? -log1pf(expf(-z)) : z - log1pf(expf(z)); }
__device__ __forceinline__ float softplusf_(float z) { return z > 0.f ? z + log1pf(expf(-z)) : log1pf(expf(z)); }

__device__ __forceinline__ float block_sum_256(float v, float* red) {
    for (int o = 32; o > 0; o >>= 1) v += __shfl_xor(v, o);
    const int w = threadIdx.x >> 6, l = threadIdx.x & 63;
    __syncthreads();
    if (l == 0) red[w] = v;
    __syncthreads();
    return red[0] + red[1] + red[2] + red[3];
}

__global__ void k_ada(const float* c, const float* w_ada, const float* b_ada, float* mod) {
    const int j = blockIdx.x * 256 + threadIdx.x, b = blockIdx.y;
    float acc = b_ada[j];
    for (int k = 0; k < DM; ++k) { const float cv = c[b * DM + k]; acc += cv * sigmoidf_(cv) * w_ada[(size_t)k * (NMOD * DM) + j]; }
    mod[b * NMOD * DM + j] = acc;
}

__global__ void k_prep(const float* x, const float* g, const float* mod, int sh_off, int sc_off, float* h) {
    __shared__ float red[4];
    const int row = blockIdx.x, b = row / SEQ;
    const float* xr = x + (size_t)row * DM;
    float v[4], s = 0.f;
#pragma unroll
    for (int i = 0; i < 4; ++i) { v[i] = xr[threadIdx.x + 256 * i]; s += v[i] * v[i]; }
    const float tot = block_sum_256(s, red);
    const float rinv = rsqrtf(tot / DM + RMS_EPS);
#pragma unroll
    for (int i = 0; i < 4; ++i) { const int k = threadIdx.x + 256 * i;
        h[(size_t)row * DM + k] = v[i] * rinv * g[k] * (1.f + mod[b * NMOD * DM + sc_off + k]) + mod[b * NMOD * DM + sh_off + k]; }
}

struct GemmArgs { const float* A; const float* B; float* C; const float* bias; const int* rowidx; const int* Mptr; int M, N, K, lda, ldb, ldc;
                  size_t gB, gC, gbias; int gidx; };
__global__ void __launch_bounds__(256) k_sgemm(GemmArgs a) {
    __shared__ float As[8][128 + 4], Bs[8][128 + 4];
    const int z = blockIdx.z;
    const float* B = a.B + z * a.gB; float* C = a.C + z * a.gC; const float* bias = a.bias ? a.bias + z * a.gbias : nullptr;
    const int* rowidx = a.rowidx ? a.rowidx + (size_t)z * a.gidx : nullptr;
    const int M = a.Mptr ? a.Mptr[z] : a.M;
    const int m0 = blockIdx.y * 128, n0 = blockIdx.x * 128;
    if (m0 >= M) return;
    const int tid = threadIdx.x, tx = tid & 15, ty = tid >> 4;
    float acc[8][8];
#pragma unroll
    for (int i = 0; i < 8; ++i)
#pragma unroll
        for (int j = 0; j < 8; ++j) acc[i][j] = 0.f;
    const int ar = tid >> 1, ak = (tid & 1) * 4;
    const int am = m0 + ar; const bool aok = am < M;
    const int arow = aok ? (rowidx ? rowidx[am] : am) : 0;
    const float* Ap = a.A + (size_t)arow * a.lda + ak;
    const int bk = tid >> 5, bn = (tid & 31) * 4;
    for (int k0 = 0; k0 < a.K; k0 += 8) {
        float4 av = aok ? *(const float4*)(Ap + k0) : make_float4(0.f, 0.f, 0.f, 0.f);
        float bv[4];
#pragma unroll
        for (int j = 0; j < 4; ++j) { const int n = n0 + bn + j; bv[j] = n < a.N ? B[(size_t)(k0 + bk) * a.ldb + n] : 0.f; }
        __syncthreads();
        As[ak + 0][ar] = av.x; As[ak + 1][ar] = av.y; As[ak + 2][ar] = av.z; As[ak + 3][ar] = av.w;
#pragma unroll
        for (int j = 0; j < 4; ++j) Bs[bk][bn + j] = bv[j];
        __syncthreads();
#pragma unroll
        for (int k = 0; k < 8; ++k) {
            float af[8], bf[8];
#pragma unroll
            for (int i = 0; i < 8; ++i) af[i] = As[k][ty * 8 + i];
#pragma unroll
            for (int j = 0; j < 8; ++j) bf[j] = Bs[k][tx * 8 + j];
#pragma unroll
            for (int i = 0; i < 8; ++i)
#pragma unroll
                for (int j = 0; j < 8; ++j) acc[i][j] += af[i] * bf[j];
        }
    }
#pragma unroll
    for (int i = 0; i < 8; ++i) { const int m = m0 + ty * 8 + i; if (m >= M) continue;
#pragma unroll
        for (int j = 0; j < 8; ++j) { const int n = n0 + tx * 8 + j; if (n < a.N) C[(size_t)m * a.ldc + n] = acc[i][j] + (bias ? bias[n] : 0.f); } }
}

__global__ void __launch_bounds__(64) k_lru(const float* proj, const float* conv_w, const float* conv_b, const float* wa, const float* ba, const float* wx, const float* bx,
                                            const float* lam, float* lru_out) {
    __shared__ float xc[64];
    const int b = blockIdx.x >> 3, g = blockIdx.x & 7, j = threadIdx.x, ch = g * 64 + j;
    float wac[64], wxc[64];
#pragma unroll
    for (int i = 0; i < 64; ++i) { wac[i] = wa[(g * 64 + i) * 64 + j]; wxc[i] = wx[(g * 64 + i) * 64 + j]; }
    const float cw0 = conv_w[0 * DLRU + ch], cw1 = conv_w[1 * DLRU + ch], cw2 = conv_w[2 * DLRU + ch], cw3 = conv_w[3 * DLRU + ch], cb = conv_b[ch];
    const float baj = ba[ch], bxj = bx[ch], sp = softplusf_(-lam[ch]);
    float x1 = 0.f, x2 = 0.f, x3 = 0.f, h = 0.f;
    for (int t = 0; t < SEQ; ++t) {
        const size_t row = (size_t)b * SEQ + t;
        const float x0 = proj[row * NPROJ + ch];
        const float y = proj[row * NPROJ + DLRU + ch];
        const float xcv = cw0 * x3 + cw1 * x2 + cw2 * x1 + cw3 * x0 + cb;
        x3 = x2; x2 = x1; x1 = x0;
        __syncthreads();
        xc[j] = xcv;
        __syncthreads();
        float ra = baj, ri = bxj;
#pragma unroll
        for (int i = 0; i < 64; ++i) { const float xi = xc[i]; ra += xi * wac[i]; ri += xi * wxc[i]; }
        const float r = sigmoidf_(ra), ig = sigmoidf_(ri);
        const float log_a = -8.0f * r * sp;
        const float av = expf(log_a);
        const float gx = sqrtf(1.f - expf(2.f * log_a)) * (ig * xcv);
        h = av * h + gx;
        lru_out[row * DLRU + ch] = h * gelu_tanh(y);
    }
}

__global__ void k_cum(const float* proj, const float* fb, float* cum) {
    const int b = blockIdx.x, h = threadIdx.x;
    float c = 0.f;
    for (int t = 0; t < SEQ; ++t) { c += log_sigmoid(proj[((size_t)b * SEQ + t) * NPROJ + 2 * DLRU + 3 * DATT + h] + fb[h]); cum[((size_t)b * NH + h) * SEQ + t] = c; }
}
__global__ void __launch_bounds__(256) k_attn(const float* proj, const float* cum, float* attn_out) {
    __shared__ float Ks[64][64], Vs[64][64], Cs[64];
    const int qb = blockIdx.x, h = blockIdx.y, b = blockIdx.z, t = qb * 256 + threadIdx.x;
    const size_t rowq = (size_t)b * SEQ + t;
    float q[64], acc[64];
#pragma unroll
    for (int d = 0; d < 64; ++d) { q[d] = proj[rowq * NPROJ + 2 * DLRU + h * 64 + d] * 0.125f; acc[d] = 0.f; }
    const float ct = cum[((size_t)b * NH + h) * SEQ + t];
    float m = -INFINITY, l = 0.f;
    const int send = qb * 256 + 256;
    for (int s0 = 0; s0 < send; s0 += 64) {
        __syncthreads();
        for (int i = threadIdx.x; i < 64 * 64; i += 256) { const int r = i >> 6, d = i & 63; const size_t rk = (size_t)b * SEQ + s0 + r;
            Ks[r][d] = proj[rk * NPROJ + 2 * DLRU + DATT + h * 64 + d]; Vs[r][d] = proj[rk * NPROJ + 2 * DLRU + 2 * DATT + h * 64 + d]; }
        if (threadIdx.x < 64) Cs[threadIdx.x] = cum[((size_t)b * NH + h) * SEQ + s0 + threadIdx.x];
        __syncthreads();
        for (int r = 0; r < 64; ++r) {
            const int s = s0 + r; if (s > t) break;
            float dot = 0.f;
#pragma unroll
            for (int d = 0; d < 64; ++d) dot += q[d] * Ks[r][d];
            const float lg = dot + ct - Cs[r];
            const float mn = fmaxf(m, lg), sc = expf(m - mn), p = expf(lg - mn);
            l = l * sc + p;
#pragma unroll
            for (int d = 0; d < 64; ++d) acc[d] = acc[d] * sc + p * Vs[r][d];
            m = mn;
        }
    }
    const float li = 1.f / l;
#pragma unroll
    for (int d = 0; d < 64; ++d) attn_out[rowq * DATT + h * 64 + d] = acc[d] * li;
}

__global__ void k_merge(const float* lru_out, const float* attn_out, const float* gn_lru, const float* gn_attn, float* merged) {
    __shared__ float red[4];
    const int row = blockIdx.x, tid = threadIdx.x;
    const float a0 = lru_out[(size_t)row * DLRU + tid], a1 = lru_out[(size_t)row * DLRU + 256 + tid];
    const float b0 = attn_out[(size_t)row * DATT + tid], b1 = attn_out[(size_t)row * DATT + 256 + tid];
    const float sa = block_sum_256(a0 * a0 + a1 * a1, red);
    const float sb = block_sum_256(b0 * b0 + b1 * b1, red);
    const float ra = rsqrtf(sa / DLRU + RMS_EPS), rb = rsqrtf(sb / DATT + RMS_EPS);
    float* o = merged + (size_t)row * DM;
    o[tid] = a0 * ra * gn_lru[tid]; o[256 + tid] = a1 * ra * gn_lru[256 + tid];
    o[512 + tid] = b0 * rb * gn_attn[tid]; o[768 + tid] = b1 * rb * gn_attn[256 + tid];
}

__global__ void k_resid(const float* xin, const float* y, const float* gpost, const float* mod, int gate_off, float* xo) {
    __shared__ float red[4];
    const int row = blockIdx.x, b = row / SEQ;
    float v[4], s = 0.f;
#pragma unroll
    for (int i = 0; i < 4; ++i) { v[i] = y[(size_t)row * DM + threadIdx.x + 256 * i]; s += v[i] * v[i]; }
    const float rinv = rsqrtf(block_sum_256(s, red) / DM + RMS_EPS);
#pragma unroll
    for (int i = 0; i < 4; ++i) { const int k = threadIdx.x + 256 * i;
        xo[(size_t)row * DM + k] = xin[(size_t)row * DM + k] + mod[b * NMOD * DM + gate_off + k] * (v[i] * rinv * gpost[k]); }
}

__global__ void k_route(const float* logits, int* cnt, int* list_tok, int* list_pair, float* pair_w) {
    const int tok = blockIdx.x * 256 + threadIdx.x;
    float lg[NE];
#pragma unroll
    for (int e = 0; e < NE; ++e) lg[e] = logits[(size_t)tok * NE + e];
    int idx[TOPK]; float val[TOPK];
#pragma unroll
    for (int k = 0; k < TOPK; ++k) { int bi = 0; float bv = -INFINITY;
#pragma unroll
        for (int e = 0; e < NE; ++e) { if (lg[e] > bv) { bv = lg[e]; bi = e; } }
        idx[k] = bi; val[k] = bv;
#pragma unroll
        for (int e = 0; e < NE; ++e) if (e == bi) lg[e] = -INFINITY; }
    float den = 0.f; float p[TOPK];
#pragma unroll
    for (int k = 0; k < TOPK; ++k) { p[k] = expf(val[k] - val[0]); den += p[k]; }
#pragma unroll
    for (int k = 0; k < TOPK; ++k) { const int e = idx[k]; const int pos = atomicAdd(&cnt[e], 1);
        list_tok[(size_t)e * NTOK + pos] = tok; list_pair[(size_t)e * NTOK + pos] = tok * TOPK + k; pair_w[tok * TOPK + k] = p[k] / den; }
}
__global__ void k_act(const float* gu, const int* cnt, float* act) {
    const int e = blockIdx.z, pos = blockIdx.y; if (pos >= cnt[e]) return;
    const size_t r = (size_t)e * NTOK + pos;
    for (int j = threadIdx.x; j < DEXP; j += 256) { const float gl = fminf(gu[r * 2 * DEXP + j], 7.f); const float li = fminf(fmaxf(gu[r * 2 * DEXP + DEXP + j], -7.f), 7.f);
        act[r * DEXP + j] = gl * sigmoidf_(1.702f * gl) * (li + 1.f); }
}
__global__ void k_scatter(const float* dn, const int* cnt, const int* list_pair, float* ypair) {
    const int e = blockIdx.z, pos = blockIdx.y; if (pos >= cnt[e]) return;
    const size_t r = (size_t)e * NTOK + pos; const int pair = list_pair[r];
    for (int j = threadIdx.x; j < DM; j += 256) ypair[(size_t)pair * DM + j] = dn[r * DM + j];
}
__global__ void k_combine(const float* ypair, const float* pair_w, float* y) {
    const int tok = blockIdx.x;
    for (int j = threadIdx.x; j < DM; j += 256) { float s = 0.f; for (int k = 0; k < TOPK; ++k) s += pair_w[tok * TOPK + k] * ypair[((size_t)tok * TOPK + k) * DM + j]; y[(size_t)tok * DM + j] = s; }
}

static void sgemm(hipStream_t st, const float* A, const float* B, float* C, const float* bias, int M, int N, int K, int lda, int ldb, int ldc) {
    GemmArgs a{}; a.A = A; a.B = B; a.C = C; a.bias = bias; a.M = M; a.N = N; a.K = K; a.lda = lda; a.ldb = ldb; a.ldc = ldc;
    hipLaunchKernelGGL(k_sgemm, dim3((N + 127) / 128, (M + 127) / 128, 1), dim3(256), 0, st, a);
}

extern "C" void kernel_launch(void* const* d_in, const int* in_sizes, int n_in, void* d_out, int out_size, void* d_ws, size_t ws_size, hipStream_t stream) {
    const float* x = (const float*)d_in[0]; const float* c = (const float*)d_in[1]; const float* w_ada = (const float*)d_in[2]; const float* b_ada = (const float*)d_in[3];
    const float* g_mix_pre = (const float*)d_in[4]; const float* g_mix_post = (const float*)d_in[5]; const float* w_in = (const float*)d_in[6];
    const float* conv_w = (const float*)d_in[7]; const float* conv_b = (const float*)d_in[8]; const float* wa = (const float*)d_in[9]; const float* ba = (const float*)d_in[10];
    const float* wx = (const float*)d_in[11]; const float* bx = (const float*)d_in[12]; const float* lam = (const float*)d_in[13]; const float* fb = (const float*)d_in[14];
    const float* gn_lru = (const float*)d_in[15]; const float* gn_attn = (const float*)d_in[16]; const float* w_out = (const float*)d_in[17];
    const float* g_ffn_pre = (const float*)d_in[18]; const float* g_ffn_post = (const float*)d_in[19]; const float* w_router = (const float*)d_in[20]; const float* b_router = (const float*)d_in[21];
    const float* w_up = (const float*)d_in[22]; const float* b_up = (const float*)d_in[23]; const float* w_down = (const float*)d_in[24]; const float* b_down = (const float*)d_in[25];
    float* out = (float*)d_out;
    char* ws = (char*)d_ws; size_t off = 0;
    auto take = [&](size_t bytes) { char* p = ws + off; off += (bytes + 255) & ~(size_t)255; return p; };
    float* mod = (float*)take((size_t)BATCH * NMOD * DM * 4);
    float* h1 = (float*)take((size_t)NTOK * DM * 4);
    float* proj = (float*)take((size_t)NTOK * NPROJ * 4);
    float* lru_out = (float*)take((size_t)NTOK * DLRU * 4);
    float* attn_out = (float*)take((size_t)NTOK * DATT * 4);
    float* cum = (float*)take((size_t)BATCH * NH * SEQ * 4);
    float* ymix = (float*)take((size_t)NTOK * DM * 4);
    float* xmid = (float*)take((size_t)NTOK * DM * 4);
    float* h2 = (float*)take((size_t)NTOK * DM * 4);
    float* logits = (float*)take((size_t)NTOK * NE * 4);
    int* cnt = (int*)take(256);
    int* list_tok = (int*)take((size_t)NE * NTOK * 4);
    int* list_pair = (int*)take((size_t)NE * NTOK * 4);
    float* pair_w = (float*)take((size_t)NTOK * TOPK * 4);
    float* ypair = (float*)take((size_t)NTOK * TOPK * DM * 4);
    float* merged = h1;
    float* yffn = ymix;
    float* gu = proj;
    float* act = lru_out;
    float* dn = h1;
    if (off > ws_size) { fprintf(stderr, "workspace too small: need %zu have %zu\n", off, ws_size); return; }

    hipLaunchKernelGGL(k_ada, dim3(NMOD * DM / 256, BATCH), dim3(256), 0, stream, c, w_ada, b_ada, mod);
    hipLaunchKernelGGL(k_prep, dim3(NTOK), dim3(256), 0, stream, x, g_mix_pre, mod, 0 * DM, 1 * DM, h1);
    sgemm(stream, h1, w_in, proj, nullptr, NTOK, NPROJ, DM, DM, NPROJ, NPROJ);
    hipLaunchKernelGGL(k_lru, dim3(BATCH * 8), dim3(64), 0, stream, proj, conv_w, conv_b, wa, ba, wx, bx, lam, lru_out);
    hipLaunchKernelGGL(k_cum, dim3(BATCH), dim3(NH), 0, stream, proj, fb, cum);
    hipLaunchKernelGGL(k_attn, dim3(SEQ / 256, NH, BATCH), dim3(256), 0, stream, proj, cum, attn_out);
    hipLaunchKernelGGL(k_merge, dim3(NTOK), dim3(256), 0, stream, lru_out, attn_out, gn_lru, gn_attn, merged);
    sgemm(stream, merged, w_out, ymix, nullptr, NTOK, DM, DM, DM, DM, DM);
    hipLaunchKernelGGL(k_resid, dim3(NTOK), dim3(256), 0, stream, x, ymix, g_mix_post, mod, 2 * DM, xmid);
    hipLaunchKernelGGL(k_prep, dim3(NTOK), dim3(256), 0, stream, xmid, g_ffn_pre, mod, 3 * DM, 4 * DM, h2);
    sgemm(stream, h2, w_router, logits, b_router, NTOK, NE, DM, DM, NE, NE);
    (void)hipMemsetAsync(cnt, 0, 256, stream);
    hipLaunchKernelGGL(k_route, dim3(NTOK / 256), dim3(256), 0, stream, logits, cnt, list_tok, list_pair, pair_w);
    for (int e = 0; e < NE; ++e) {
        GemmArgs a{}; a.A = h2; a.B = w_up + (size_t)e * DM * 2 * DEXP; a.C = gu; a.bias = b_up + (size_t)e * 2 * DEXP; a.rowidx = list_tok + (size_t)e * NTOK; a.Mptr = cnt + e;
        a.M = NTOK; a.N = 2 * DEXP; a.K = DM; a.lda = DM; a.ldb = 2 * DEXP; a.ldc = 2 * DEXP;
        hipLaunchKernelGGL(k_sgemm, dim3(2 * DEXP / 128, NTOK / 128, 1), dim3(256), 0, stream, a);
        hipLaunchKernelGGL(k_act, dim3(1, NTOK, 1), dim3(256), 0, stream, gu, cnt + e, act);
        GemmArgs d{}; d.A = act; d.B = w_down + (size_t)e * DEXP * DM; d.C = dn; d.bias = b_down + (size_t)e * DM; d.rowidx = nullptr; d.Mptr = cnt + e;
        d.M = NTOK; d.N = DM; d.K = DEXP; d.lda = DEXP; d.ldb = DM; d.ldc = DM;
        hipLaunchKernelGGL(k_sgemm, dim3(DM / 128, NTOK / 128, 1), dim3(256), 0, stream, d);
        hipLaunchKernelGGL(k_scatter, dim3(1, NTOK, 1), dim3(256), 0, stream, dn, cnt + e, list_pair + (size_t)e * NTOK, ypair);
    }
    hipLaunchKernelGGL(k_combine, dim3(NTOK), dim3(256), 0, stream, ypair, pair_w, yffn);
    hipLaunchKernelGGL(k_resid, dim3(NTOK), dim3(256), 0, stream, xmid, yffn, g_ffn_post, mod, 5 * DM, out);
}
```

```cpp
#include <hip/hip_runtime.h>
#include <hip/hip_bf16.h>
#include <cstdio>
#include <cstdint>
#include <cmath>

#define MIX 4

constexpr int DM = 1024, BATCH = 8, SEQ = 2048, NTOK = BATCH * SEQ;
constexpr int DLRU = 512, DATT = 512, NH = 8, HD = 64, NPROJ = 2 * DLRU + 3 * DATT + NH, NPJ = 2560;
constexpr int NE = 32, TOPK = 4, DEXP = 1024, NMOD = 6;
constexpr float RMS_EPS = 1e-6f;
constexpr int MAXROWS = NTOK * TOPK + NE * 256;
constexpr int MAXMT = MAXROWS / 256;

namespace pg8 {
#define PG8_LAS __attribute__((address_space(3)))
typedef unsigned short bf16_t;
typedef short bf16x8 __attribute__((ext_vector_type(8)));
typedef float f32x4 __attribute__((ext_vector_type(4)));
typedef float f32x2 __attribute__((ext_vector_type(2)));
typedef unsigned u32x4 __attribute__((ext_vector_type(4)));
constexpr int BM = 256, BK = 64, HALF = 128, HTB = HALF * BK * 2  , STAGE_BYTES = 8 * HTB, NXCD = 8, WGM = 8;
constexpr int GK = 1024, GNT = GK / BK;

__host__ __device__ __forceinline__ int lds_byte(int r, int c) { const int st = (r >> 4) * 2 + (c >> 5), rr = r & 15, cc = c & 31, ob = rr * 64 + cc * 2; return st * 1024 + (ob ^ (((ob >> 9) & 1) << 5)); }
__host__ __device__ __forceinline__ void stage_rc(int b, int& R, int& C) { const int st = b / 1024, sb = b % 1024, swz = sb ^ (((sb >> 9) & 1) << 5); R = (st >> 1) * 16 + swz / 64; C = (st & 1) * 32 + (swz % 64) / 2; }
__host__ __device__ __forceinline__ int perm32(int rho) { const int n = rho >> 4, i = rho & 15; return 8 * (i >> 2) + 4 * n + (i & 3); }

struct Unit { const char* A0; const char* A1; const char* B0; const char* B1; int pm, pn, e; };

__device__ __forceinline__ unsigned cvt_pk_bf16(float lo, float hi) { unsigned r; asm volatile("v_cvt_pk_bf16_f32 %0, %1, %2" : "=v"(r) : "v"(lo), "v"(hi)); return r; }

template <class Epi, class Sched>
__device__ __forceinline__ void gemm_phase(PG8_LAS unsigned char* lds, const Sched& S, const Epi& E) {
    const int tid = threadIdx.x, wid = __builtin_amdgcn_readfirstlane(tid >> 6), lane = tid & 63, wr = wid >> 2, wc = wid & 3, fr = lane & 15, fq = lane >> 4;
    constexpr int K = GK, nt = GNT;
    int Rr[2], Cc[2];
    unsigned voffB[2], cvA[2][2], nvA[2][2];
#pragma unroll
    for (int i = 0; i < 2; ++i) { stage_rc(tid * 16 + i * 8192, Rr[i], Cc[i]); const int Rb = Epi::PERM ? ((Rr[i] & ~31) + perm32(Rr[i] & 31)) : Rr[i]; voffB[i] = (unsigned)(Rb * K + Cc[i]) * 2u; }
    constexpr size_t kstep = (size_t)(BK * 2);
    const unsigned ldsw = (unsigned)wid * 1024u;
    const int aoff = lds_byte(wr * 64 + fr, fq * 8), boff = lds_byte(wc * 32 + fr, fq * 8);
#define PG8_SA(b, h) (((b) * 2 + (h)) * HTB)
#define PG8_SB(b, h) ((4 + (b) * 2 + (h)) * HTB)
#define PG8_STAGE(bufoff, gbase, voff) do { _Pragma("unroll") for (int _i = 0; _i < 2; ++_i) \
        __builtin_amdgcn_global_load_lds((const unsigned*)((const char*)(gbase) + (voff)[_i]), (PG8_LAS unsigned*)(lds + (bufoff) + ldsw + _i * 8192), 16, 0, 0); } while (0)
#define PG8_LDA(dst, b, h) do { _Pragma("unroll") for (int m = 0; m < 4; ++m) _Pragma("unroll") for (int k = 0; k < 2; ++k) dst[m][k] = *(const PG8_LAS bf16x8*)(lds + PG8_SA(b, h) + aoff + m * 2048 + k * 1024); } while (0)
#define PG8_LDB(dst, b, h) do { _Pragma("unroll") for (int n = 0; n < 2; ++n) _Pragma("unroll") for (int k = 0; k < 2; ++k) dst[n][k] = *(const PG8_LAS bf16x8*)(lds + PG8_SB(b, h) + boff + n * 2048 + k * 1024); } while (0)
#define PG8_MMA(ai, bj, At, Bt) do { __builtin_amdgcn_s_setprio(1); _Pragma("unroll") for (int m = 0; m < 4; ++m) _Pragma("unroll") for (int n = 0; n < 2; ++n) _Pragma("unroll") for (int k = 0; k < 2; ++k) \
        acc[ai][bj][m][n] = __builtin_amdgcn_mfma_f32_16x16x32_bf16(Bt[n][k], At[m][k], acc[ai][bj][m][n], 0, 0, 0); __builtin_amdgcn_s_setprio(0); } while (0)
#define PG8_WAIT_V(n) asm volatile("s_waitcnt vmcnt(" #n ")" ::: "memory")
#define PG8_WAIT_L(n) asm volatile("s_waitcnt lgkmcnt(" #n ")" ::: "memory")
#define PG8_BAR __builtin_amdgcn_s_barrier()
#define PG8_SCHED __builtin_amdgcn_sched_barrier(0)
#define PG8_VOFF(dst, u) do { _Pragma("unroll") for (int _h = 0; _h < 2; ++_h) _Pragma("unroll") for (int _i = 0; _i < 2; ++_i) { \
        const int _row = Sched::GATHER ? S.row_of(u, _h * HALF + Rr[_i]) : Rr[_i]; dst[_h][_i] = (unsigned)(_row * K + Cc[_i]) * 2u; } } while (0)
    Unit cur, nxt; int ui = 0;
    if (!S.next(0, cur)) return;
    f32x4 acc[2][2][4][2];
#pragma unroll
    for (int a = 0; a < 2; ++a)
#pragma unroll
        for (int b = 0; b < 2; ++b)
#pragma unroll
            for (int m = 0; m < 4; ++m)
#pragma unroll
                for (int n = 0; n < 2; ++n) acc[a][b][m][n] = (f32x4){0.f, 0.f, 0.f, 0.f};
    bf16x8 At[4][2], B0[2][2], B1[2][2];
    PG8_VOFF(cvA, cur);
    if (Sched::GATHER) { asm volatile("s_waitcnt vmcnt(0)" ::: "memory"); }
    PG8_STAGE(PG8_SB(0, 0), cur.B0, voffB); PG8_STAGE(PG8_SB(0, 1), cur.B1, voffB); PG8_STAGE(PG8_SA(0, 0), cur.A0, cvA[0]); PG8_STAGE(PG8_SA(0, 1), cur.A1, cvA[1]);
    if (wr == 1) PG8_BAR;
    PG8_WAIT_V(2); PG8_BAR;
    PG8_STAGE(PG8_SB(1, 0), cur.B0 + kstep, voffB); PG8_STAGE(PG8_SA(1, 0), cur.A0 + kstep, cvA[0]); PG8_STAGE(PG8_SB(1, 1), cur.B1 + kstep, voffB);
    PG8_WAIT_V(6); PG8_BAR;
    for (;;) {
        const bool has_next = S.next(ui + 1, nxt);
        if (!has_next) nxt = cur;
        if (has_next) { PG8_VOFF(nvA, nxt); }
        else {
#pragma unroll
            for (int _h = 0; _h < 2; ++_h)
#pragma unroll
                for (int _i = 0; _i < 2; ++_i) nvA[_h][_i] = cvA[_h][_i]; }
        for (int t = 0; t < nt; t += 2) {
            const bool last = (t == nt - 2);
            if (Epi::MID && t == nt / 2) E.mid(acc, cur, wr, wc, fr, fq);
            const char* a1_1 = cur.A1 + (size_t)(t + 1) * kstep;
            const char* a2_0 = last ? nxt.A0 : cur.A0 + (size_t)(t + 2) * kstep; const char* a2_1 = last ? nxt.A1 : cur.A1 + (size_t)(t + 2) * kstep;
            const char* b2_0 = last ? nxt.B0 : cur.B0 + (size_t)(t + 2) * kstep; const char* b2_1 = last ? nxt.B1 : cur.B1 + (size_t)(t + 2) * kstep;
            const char* a3_0 = a2_0 + kstep; const char* a3_1 = a2_1 + kstep; const char* b3_0 = b2_0 + kstep; const char* b3_1 = b2_1 + kstep;
            unsigned sv0[2], sv1[2];
#pragma unroll
            for (int _i = 0; _i < 2; ++_i) { sv0[_i] = last ? nvA[0][_i] : cvA[0][_i]; sv1[_i] = last ? nvA[1][_i] : cvA[1][_i]; }
            PG8_LDB(B0, 0, 0); PG8_LDB(B1, 0, 1); PG8_SCHED; PG8_LDA(At, 0, 0); PG8_STAGE(PG8_SA(1, 1), a1_1, cvA[1]);
            PG8_WAIT_V(8); PG8_WAIT_L(0); PG8_BAR; PG8_MMA(0, 0, At, B0); PG8_MMA(0, 1, At, B1); PG8_BAR; PG8_SCHED;
            PG8_LDA(At, 0, 1); PG8_STAGE(PG8_SB(0, 0), b2_0, voffB); PG8_STAGE(PG8_SB(0, 1), b2_1, voffB); PG8_STAGE(PG8_SA(0, 0), a2_0, sv0);
            PG8_WAIT_V(8); PG8_WAIT_L(0); PG8_BAR; PG8_MMA(1, 0, At, B0); PG8_MMA(1, 1, At, B1); PG8_BAR; PG8_SCHED;
            PG8_LDB(B0, 1, 0); PG8_LDB(B1, 1, 1); PG8_SCHED; PG8_LDA(At, 1, 0); PG8_STAGE(PG8_SA(0, 1), a2_1, sv1);
            PG8_WAIT_V(8); PG8_WAIT_L(0); PG8_BAR; PG8_MMA(0, 0, At, B0); PG8_MMA(0, 1, At, B1); PG8_BAR; PG8_SCHED;
            PG8_LDA(At, 1, 1); PG8_STAGE(PG8_SB(1, 0), b3_0, voffB); PG8_STAGE(PG8_SB(1, 1), b3_1, voffB); PG8_STAGE(PG8_SA(1, 0), a3_0, sv0);
            PG8_WAIT_V(8); PG8_WAIT_L(0); PG8_BAR; PG8_MMA(1, 0, At, B0); PG8_MMA(1, 1, At, B1); PG8_BAR; PG8_SCHED;
            (void)a3_1; (void)b3_1;
        }
        if (wr == 0) PG8_BAR;
        E(acc, cur, wr, wc, fr, fq);
        if (!has_next) break;
#pragma unroll
        for (int a = 0; a < 2; ++a)
#pragma unroll
            for (int b = 0; b < 2; ++b)
#pragma unroll
                for (int m = 0; m < 4; ++m)
#pragma unroll
                    for (int n = 0; n < 2; ++n) acc[a][b][m][n] = (f32x4){0.f, 0.f, 0.f, 0.f};
        cur = nxt; ++ui;
#pragma unroll
        for (int _h = 0; _h < 2; ++_h)
#pragma unroll
            for (int _i = 0; _i < 2; ++_i) cvA[_h][_i] = nvA[_h][_i];
        if (wr == 1) PG8_BAR;
    }
    PG8_WAIT_V(0);
    PG8_BAR;
#undef PG8_SA
#undef PG8_SB
#undef PG8_STAGE
#undef PG8_LDA
#undef PG8_LDB
#undef PG8_MMA
#undef PG8_WAIT_V
#undef PG8_WAIT_L
#undef PG8_BAR
#undef PG8_SCHED
#undef PG8_VOFF
}
}

namespace pg8 {

struct DenseOrder {
    static constexpr bool GATHER = false;
    const bf16_t* A; const bf16_t* Bt; int nM, nN, nwg, G, c;
    __device__ __forceinline__ void init(const bf16_t* A_, const bf16_t* Bt_, int M, int N, int G_, int c_) { A = A_; Bt = Bt_; nM = M / BM; nN = N / BM; nwg = nM * nN; G = G_; c = c_; }
    __device__ __forceinline__ bool next(int i, Unit& u) const {
        const long L = (long)i * G + c; if (L >= nwg) return false;
        int wgid = (int)L; { const int q = nwg / NXCD, r = nwg % NXCD, xcd = wgid % NXCD, off = wgid / NXCD; wgid = (xcd < r ? xcd * (q + 1) : r * (q + 1) + (xcd - r) * q) + off; }
        const int nig = WGM * nN, gid = wgid / nig, fm = gid * WGM, gsz = (nM - fm) < WGM ? (nM - fm) : WGM;
        u.pm = fm + ((wgid % nig) % gsz); u.pn = (wgid % nig) / gsz; u.e = 0;
        u.A0 = (const char*)A + (size_t)u.pm * BM * GK * 2; u.A1 = u.A0 + (size_t)HALF * GK * 2;
        u.B0 = (const char*)Bt + (size_t)u.pn * BM * GK * 2; u.B1 = u.B0 + (size_t)HALF * GK * 2;
        return true;
    }
    __device__ __forceinline__ int row_of(const Unit&, int r) const { return r; }
};
struct UpOrder {
    static constexpr bool GATHER = true;
    const bf16_t* H2; const bf16_t* WupT; const int* row_tok; const int* mt_exp; int nunits, G, c;
    __device__ __forceinline__ bool next(int i, Unit& u) const {
        const int L = i * G + c; if (L >= nunits) return false;
        u.pm = L >> 3; u.pn = L & 7; u.e = mt_exp[u.pm];
        u.A0 = (const char*)H2; u.A1 = (const char*)H2;
        u.B0 = (const char*)WupT + ((size_t)u.e * 2 * DEXP + (size_t)u.pn * HALF) * GK * 2; u.B1 = u.B0 + (size_t)DEXP * GK * 2;
        return true;
    }
    __device__ __forceinline__ int row_of(const Unit& u, int r) const { return row_tok[u.pm * BM + r]; }
};
struct DownOrder {
    static constexpr bool GATHER = false;
    const bf16_t* ACT; const bf16_t* WdnT; const int* mt_exp; int nunits, G, c;
    __device__ __forceinline__ bool next(int i, Unit& u) const {
        const int L = i * G + c; if (L >= nunits) return false;
        u.pm = L >> 2; u.pn = L & 3; u.e = mt_exp[u.pm];
        u.A0 = (const char*)ACT + (size_t)u.pm * BM * GK * 2; u.A1 = u.A0 + (size_t)HALF * GK * 2;
        u.B0 = (const char*)WdnT + ((size_t)u.e * DM + (size_t)u.pn * BM) * GK * 2; u.B1 = u.B0 + (size_t)HALF * GK * 2;
        return true;
    }
    __device__ __forceinline__ int row_of(const Unit&, int r) const { return r; }
};

struct EpiProj {
    static constexpr bool PERM = true, MID = false;
    bf16_t* O; size_t tstride; float qscale;
    __device__ __forceinline__ void mid(f32x4 (&)[2][2][4][2], const Unit&, int, int, int, int) const {}
    __device__ __forceinline__ void operator()(const f32x4 (&acc)[2][2][4][2], const Unit& u, int wr, int wc, int fr, int fq) const {
        const int t = u.pn >> 1; bf16_t* base = O + (size_t)t * tstride; const float sc = (t == 2) ? qscale : 1.f;
        const int row0 = u.pm * BM + wr * 64 + fr, col0 = (u.pn & 1) * BM + wc * 32 + 8 * fq;
#pragma unroll
        for (int ai = 0; ai < 2; ++ai)
#pragma unroll
            for (int m = 0; m < 4; ++m) { bf16_t* rowp = base + (size_t)(row0 + ai * HALF + m * 16) * 512 + col0;
#pragma unroll
                for (int bj = 0; bj < 2; ++bj) { const f32x4 v0 = acc[ai][bj][m][0] * sc, v1 = acc[ai][bj][m][1] * sc;
                    u32x4 w; w.x = cvt_pk_bf16(v0[0], v0[1]); w.y = cvt_pk_bf16(v0[2], v0[3]); w.z = cvt_pk_bf16(v1[0], v1[1]); w.w = cvt_pk_bf16(v1[2], v1[3]);
                    *(u32x4*)(rowp + bj * HALF) = w; } }
    }
};
struct EpiOut {
    static constexpr bool PERM = false, MID = true;
    float* Y; const float* ssq;
    __device__ __forceinline__ void mid(f32x4 (&acc)[2][2][4][2], const Unit& u, int wr, int wc, int fr, int fq) const {
#pragma unroll
        for (int ai = 0; ai < 2; ++ai)
#pragma unroll
            for (int m = 0; m < 4; ++m) { const int row = u.pm * BM + ai * HALF + wr * 64 + m * 16 + fr;
                const f32x4 s0 = *(const f32x4*)(ssq + (size_t)row * 8), s1 = *(const f32x4*)(ssq + (size_t)row * 8 + 4);
                const float tot = ((s0[0] + s0[1]) + (s0[2] + s0[3])) + ((s1[0] + s1[1]) + (s1[2] + s1[3]));
                const float ri = 1.0f / sqrtf(tot * (1.0f / DATT) + RMS_EPS);
#pragma unroll
                for (int bj = 0; bj < 2; ++bj)
#pragma unroll
                    for (int n = 0; n < 2; ++n) acc[ai][bj][m][n] = acc[ai][bj][m][n] * ri; }
    }
    __device__ __forceinline__ void operator()(const f32x4 (&acc)[2][2][4][2], const Unit& u, int wr, int wc, int fr, int fq) const {
        const int row0 = u.pm * BM + wr * 64 + fr, col0 = u.pn * BM + wc * 32 + 4 * fq;
#pragma unroll
        for (int ai = 0; ai < 2; ++ai)
#pragma unroll
            for (int m = 0; m < 4; ++m) { float* rowp = Y + (size_t)(row0 + ai * HALF + m * 16) * DM + col0;
#pragma unroll
                for (int bj = 0; bj < 2; ++bj)
#pragma unroll
                    for (int n = 0; n < 2; ++n) *(f32x4*)(rowp + bj * HALF + n * 16) = acc[ai][bj][m][n]; }
    }
};
struct EpiUp {
    static constexpr bool PERM = true, MID = false;
    bf16_t* ACT; const float* b_up;
    __device__ __forceinline__ void mid(f32x4 (&)[2][2][4][2], const Unit&, int, int, int, int) const {}
    __device__ __forceinline__ void operator()(const f32x4 (&acc)[2][2][4][2], const Unit& u, int wr, int wc, int fr, int fq) const {
        const int row0 = u.pm * BM + wr * 64 + fr, col0 = u.pn * HALF + wc * 32 + 8 * fq;
        const float* bg = b_up + (size_t)u.e * 2 * DEXP + col0;
        f32x4 bgl[2], bli[2];
#pragma unroll
        for (int n = 0; n < 2; ++n) { bgl[n] = *(const f32x4*)(bg + 4 * n); bli[n] = *(const f32x4*)(bg + DEXP + 4 * n); }
#pragma unroll
        for (int ai = 0; ai < 2; ++ai)
#pragma unroll
            for (int m = 0; m < 4; ++m) { bf16_t* rowp = ACT + (size_t)(row0 + ai * HALF + m * 16) * DEXP + col0;
                float o[8];
#pragma unroll
                for (int n = 0; n < 2; ++n)
#pragma unroll
                    for (int j = 0; j < 4; ++j) { const float gl = fminf(acc[ai][0][m][n][j] + bgl[n][j], 7.0f); const float li = fminf(fmaxf(acc[ai][1][m][n][j] + bli[n][j], -7.0f), 7.0f);
                        const float sg = __builtin_amdgcn_rcpf(1.0f + __builtin_amdgcn_exp2f(-1.702f * 1.4426950408889634f * gl)); o[4 * n + j] = gl * sg * (li + 1.0f); }
                u32x4 w; w.x = cvt_pk_bf16(o[0], o[1]); w.y = cvt_pk_bf16(o[2], o[3]); w.z = cvt_pk_bf16(o[4], o[5]); w.w = cvt_pk_bf16(o[6], o[7]);
                *(u32x4*)rowp = w; }
    }
};
struct EpiDown {
    static constexpr bool PERM = true, MID = false;
    bf16_t* YP; const float* b_down; const int* row_pair; const float* row_w;
    __device__ __forceinline__ void mid(f32x4 (&)[2][2][4][2], const Unit&, int, int, int, int) const {}
    __device__ __forceinline__ void operator()(const f32x4 (&acc)[2][2][4][2], const Unit& u, int wr, int wc, int fr, int fq) const {
        const int row0 = u.pm * BM + wr * 64 + fr, col0 = u.pn * BM + wc * 32 + 8 * fq;
        const float* bd = b_down + (size_t)u.e * DM + col0;
        f32x4 bv[2][2];
#pragma unroll
        for (int bj = 0; bj < 2; ++bj)
#pragma unroll
            for (int n = 0; n < 2; ++n) bv[bj][n] = *(const f32x4*)(bd + bj * HALF + 4 * n);
#pragma unroll
        for (int ai = 0; ai < 2; ++ai)
#pragma unroll
            for (int m = 0; m < 4; ++m) { const int pos = row0 + ai * HALF + m * 16; const int pair = row_pair[pos]; const float w = row_w[pos];
                if (pair >= 0) { bf16_t* rowp = YP + (size_t)pair * DM + col0;
#pragma unroll
                    for (int bj = 0; bj < 2; ++bj) { const f32x4 v0 = (acc[ai][bj][m][0] + bv[bj][0]) * w, v1 = (acc[ai][bj][m][1] + bv[bj][1]) * w;
                        u32x4 q; q.x = cvt_pk_bf16(v0[0], v0[1]); q.y = cvt_pk_bf16(v0[2], v0[3]); q.z = cvt_pk_bf16(v1[0], v1[1]); q.w = cvt_pk_bf16(v1[2], v1[3]);
                        *(u32x4*)(rowp + bj * HALF) = q; } } }
    }
};
}

namespace attn_body {
using bf16=__hip_bfloat16;
using bf16x8=__attribute__((ext_vector_type(8)))short;
using s16x4=__attribute__((ext_vector_type(4)))short;
using f32x16=__attribute__((ext_vector_type(16)))float;
using u32x4=__attribute__((ext_vector_type(4)))unsigned;
constexpr int BATCH=8,NHEAD=8,SEQ=2048,D=64,DM=NHEAD*D,OPITCH=1024;
constexpr int NW=8,QBLK=32,QB=QBLK*NW,KVBLK=64,NQB=SEQ/QB;
constexpr int ATTN_PITCH=DM, ATTN_UNIT_ROWS=QB;
__device__ __forceinline__ int crow(int r,int hi){return (r&3)+8*(r>>2)+4*hi;}
#define SBAR() __builtin_amdgcn_sched_barrier(0)
__device__ __forceinline__ void cmask(f32x16&p0,f32x16&p1,int jb,int qrel,int hi){
  const float NEG=-INFINITY; int kb=64*jb+4*hi;
  #pragma unroll
  for(int r=0;r<16;++r){int kv=kb+(r&3)+8*(r>>2); if(kv>qrel)p0[r]=NEG; if(kv+32>qrel)p1[r]=NEG;}
}

constexpr int NSLOT=3, SLOTB=8192;
constexpr int LDS_K=0, LDS_V=NSLOT*SLOTB, LDS_WS=2*NSLOT*SLOTB, LDS_OST=LDS_WS+NW*64*4, LDS_BIAS=LDS_OST+NW*4096, LDS_SCAN=LDS_BIAS+(SEQ+64)*4, LDS_BYTES=LDS_SCAN+256;
constexpr float C2=0.125f*1.4426950408889634f;
__device__ __forceinline__ void glds16(const void*gsrc,unsigned lds_dst){unsigned keep;
  asm volatile("s_mov_b32 %0, m0\n\ts_mov_b32 m0, %2\n\ts_nop 0\n\tglobal_load_lds_dwordx4 %1, off\n\ts_mov_b32 m0, %0":"=&s"(keep):"v"(gsrc),"s"(lds_dst):"memory");}
__device__ __forceinline__ float max3f(float a,float b,float c){float r;asm("v_max3_f32 %0, %1, %2, %3":"=v"(r):"v"(a),"v"(b),"v"(c));return r;}
__device__ __forceinline__ float max2f(float a,float b){float r;asm("v_max_f32_e32 %0, %1, %2":"=v"(r):"v"(a),"v"(b));return r;}
__device__ __forceinline__ float fadd_s(float a,float b){float r;asm("v_add_f32_e32 %0, %1, %2":"=v"(r):"v"(a),"v"(b));return r;}
__device__ __forceinline__ float fsub_s(float a,float b){float r;asm("v_sub_f32_e32 %0, %1, %2":"=v"(r):"v"(a),"v"(b));return r;}
typedef float f32x2_t __attribute__((ext_vector_type(2))); typedef float f32x4_t __attribute__((ext_vector_type(4))); typedef __bf16 bf16x2_t __attribute__((ext_vector_type(2)));
__device__ __forceinline__ unsigned cvtpk_s(float lo,float hi){f32x2_t v={lo,hi};bf16x2_t b=__builtin_convertvector(v,bf16x2_t);return __builtin_bit_cast(unsigned,b);}
#define WAIT_BAR(N) asm volatile("s_waitcnt vmcnt(" #N ") lgkmcnt(0)\n\ts_barrier":::"memory")

__device__ __forceinline__ void qkt(f32x16&p0,f32x16&p1,const char*Kslot,const bf16x8*qr,int r32,int hi){
  const char*kb=Kslot+hi*1024+r32*16;
  #pragma unroll
  for(int d0=0;d0<4;++d0){
    const bf16x8 b0=*reinterpret_cast<const bf16x8*>(kb+d0*2048);
    const bf16x8 b1=*reinterpret_cast<const bf16x8*>(kb+d0*2048+512);
    p0=__builtin_amdgcn_mfma_f32_32x32x16_bf16(b0,qr[d0],p0,0,0,0);p1=__builtin_amdgcn_mfma_f32_32x32x16_bf16(b1,qr[d0],p1,0,0,0);}
}
typedef __attribute__((address_space(3))) const char* lds_cptr;
typedef short v4i16_t __attribute__((ext_vector_type(4)));
__device__ __forceinline__ void kload8(bf16x8*kf,lds_cptr kp){
  kf[0]=*(const __attribute__((address_space(3))) bf16x8*)(kp);      kf[1]=*(const __attribute__((address_space(3))) bf16x8*)(kp+512);
  kf[2]=*(const __attribute__((address_space(3))) bf16x8*)(kp+2048); kf[3]=*(const __attribute__((address_space(3))) bf16x8*)(kp+2560);
  kf[4]=*(const __attribute__((address_space(3))) bf16x8*)(kp+4096); kf[5]=*(const __attribute__((address_space(3))) bf16x8*)(kp+4608);
  kf[6]=*(const __attribute__((address_space(3))) bf16x8*)(kp+6144); kf[7]=*(const __attribute__((address_space(3))) bf16x8*)(kp+6656);
}
__device__ __forceinline__ void kload2(bf16x8*kf,lds_cptr kp,int j){ kf[2*j]=*(const __attribute__((address_space(3))) bf16x8*)(kp+j*2048); kf[2*j+1]=*(const __attribute__((address_space(3))) bf16x8*)(kp+j*2048+512); }
__device__ __forceinline__ s16x4 vtr(lds_cptr p){ return __builtin_bit_cast(s16x4,__builtin_amdgcn_ds_read_tr16_b64_v4i16((__attribute__((address_space(3))) v4i16_t*)p)); }
__device__ __forceinline__ float rowmax(const f32x16&p0,const f32x16&p1){
  float a=max3f(p0[0],p0[1],p1[0]),b=max3f(p0[2],p0[3],p1[1]);a=max3f(a,p1[2],p1[3]);
  #pragma unroll
  for(int r=4;r<16;r+=4){a=max3f(a,p0[r],p0[r+1]);b=max3f(b,p0[r+2],p0[r+3]);a=max3f(a,p1[r],p1[r+1]);b=max3f(b,p1[r+2],p1[r+3]);}
  const float m=max2f(a,b);
  auto rr=__builtin_amdgcn_permlane32_swap(__float_as_uint(m),__float_as_uint(m),false,false);
  return max2f(__uint_as_float(rr[0]),__uint_as_float(rr[1]));
}
__device__ __forceinline__ void pv(f32x16*o,int vb,bf16x8 pa0,bf16x8 pa1,bf16x8 pa2,bf16x8 pa3){
  #pragma unroll
  for(int d0=0;d0<2;++d0){s16x4 lo[4],hi[4];
    #pragma unroll
    for(int ks=0;ks<4;++ks){
      asm volatile("ds_read_b64_tr_b16 %0,%1 offset:%c2":"=&v"(lo[ks]):"v"(vb),"i"(d0*4096+ks*1024):"memory");
      asm volatile("ds_read_b64_tr_b16 %0,%1 offset:%c2":"=&v"(hi[ks]):"v"(vb),"i"(d0*4096+ks*1024+512):"memory");}
    asm volatile("s_waitcnt lgkmcnt(0)":::"memory");SBAR();
    #define PK(k) (bf16x8){lo[k][0],lo[k][1],lo[k][2],lo[k][3],hi[k][0],hi[k][1],hi[k][2],hi[k][3]}
    o[d0]=__builtin_amdgcn_mfma_f32_32x32x16_bf16(pa0,PK(0),o[d0],0,0,0);
    o[d0]=__builtin_amdgcn_mfma_f32_32x32x16_bf16(pa1,PK(1),o[d0],0,0,0);
    o[d0]=__builtin_amdgcn_mfma_f32_32x32x16_bf16(pa2,PK(2),o[d0],0,0,0);
    o[d0]=__builtin_amdgcn_mfma_f32_32x32x16_bf16(pa3,PK(3),o[d0],0,0,0);
    #undef PK
  }
}

#ifndef ATTN_STORE16
#define ATTN_STORE16(p,v) (*(u32x4*)(p)=(v))
#endif
template<int THRL> __device__ __forceinline__ void attn_unit(int b,int h,int qb,const bf16*Q,const bf16*__restrict__ K,const bf16*__restrict__ V,bf16*O,const float*__restrict__ LOGF2,float*SSQ,char*shm){
  const int tid=threadIdx.x,lane=tid&63,r32=lane&31,hi=lane>>5; const int wid=__builtin_amdgcn_readfirstlane(tid>>6);
  const long rowbase=(long)b*SEQ; const int q0=qb*QB;
  const bf16*Qw=Q+(rowbase+q0+wid*QBLK)*DM+h*D;
  const bf16*Kh=K+rowbase*DM+h*D,*Vh=V+rowbase*DM+h*D;
  const unsigned lds0=(unsigned)(uintptr_t)shm;
  float*wsf=(float*)(shm+LDS_WS)+wid*64;
  const bf16*ksrc=Kh+(long)lane*DM+wid*8;
  const bf16*vsrc=Vh+(long)(16*(wid&3)+(lane>>2))*DM+(wid>>2)*32+(lane&3)*8;
  const unsigned kdst=lds0+LDS_K+wid*1024, vdst=lds0+LDS_V+wid*1024;
  #define DMA_K(t,slot) glds16(ksrc+(long)(t)*KVBLK*DM,(unsigned)__builtin_amdgcn_readfirstlane(kdst+(slot)))
  #define DMA_V(t,slot) glds16(vsrc+(long)(t)*KVBLK*DM,(unsigned)__builtin_amdgcn_readfirstlane(vdst+(slot)))
  const int vb0=(int)(lds0+LDS_V)+((lane>>4)&1)*32+(lane&3)*8+(4*hi+((lane&15)>>2))*64;
  const char*Kbase=shm+LDS_K; bf16x8 kf[8];
  const lds_cptr shm3=(lds_cptr)shm; const lds_cptr kp0=shm3+LDS_K+hi*1024+r32*16; const lds_cptr vp0=shm3+LDS_V+((lane>>4)&1)*32+(lane&3)*8+(4*hi+((lane&15)>>2))*64;
  const int NT=(q0+QB)/KVBLK;
  { float*biasl=(float*)(shm+LDS_BIAS); float*scn=(float*)(shm+LDS_SCAN);
    const float*lf=LOGF2+rowbase*NHEAD+h;
    float v0=0.f,v1=0.f,v2=0.f,v3=0.f; const int i0=4*tid;
    if(i0<q0){ v0=lf[(long)(q0-1-i0)*NHEAD]; v1=lf[(long)(q0-2-i0)*NHEAD]; v2=lf[(long)(q0-3-i0)*NHEAD]; v3=lf[(long)(q0-4-i0)*NHEAD]; }
    const float tsum=(v0+v1)+(v2+v3); float inc=tsum;
    #pragma unroll
    for(int o=1;o<64;o<<=1){ const float n_=__shfl_up(inc,o); if(lane>=o)inc+=n_; }
    if(lane==63)scn[wid]=inc;
    const float f0=lf[(long)(q0+4*lane)*NHEAD],f1=lf[(long)(q0+4*lane+1)*NHEAD],f2=lf[(long)(q0+4*lane+2)*NHEAD],f3=lf[(long)(q0+4*lane+3)*NHEAD];
    float finc=(f0+f1)+(f2+f3);
    #pragma unroll
    for(int o=1;o<64;o<<=1){ const float n_=__shfl_up(finc,o); if(lane>=o)finc+=n_; }
    const float fex=finc-((f0+f1)+(f2+f3));
    if(wid==0){ biasl[q0+4*lane]=-(fex+f0); biasl[q0+4*lane+1]=-(fex+f0+f1); biasl[q0+4*lane+2]=-(fex+f0+f1+f2); biasl[q0+4*lane+3]=-(fex+f0+f1+f2+f3); }
    __syncthreads();
    float woff=0.f;
    #pragma unroll
    for(int w_=0;w_<NW;++w_) woff+=(w_<wid)?scn[w_]:0.f;
    const float ex=woff+inc-tsum;
    if(i0<q0){ biasl[q0-1-i0]=ex; biasl[q0-2-i0]=ex+v0; biasl[q0-3-i0]=ex+v0+v1; biasl[q0-4-i0]=ex+v0+v1+v2; }
    __syncthreads(); }
  const lds_cptr biasr=(lds_cptr)shm+LDS_BIAS+16*hi;
  #define BIAS4(t,o) (*(const __attribute__((address_space(3))) f32x4_t*)(biasr+(t)*(KVBLK*4)+(o)*4))
  #define INIT4(Y,g,t,o) do{ const f32x4_t x_=BIAS4(t,(o)+8*(g)); Y[4*(g)]=x_[0]-mhat; Y[4*(g)+1]=x_[1]-mhat; Y[4*(g)+2]=x_[2]-mhat; Y[4*(g)+3]=x_[3]-mhat; }while(0)
  #define INITT(Y0,Y1,t) do{ INIT4(Y0,0,t,0);INIT4(Y0,1,t,0);INIT4(Y0,2,t,0);INIT4(Y0,3,t,0); INIT4(Y1,0,t,32);INIT4(Y1,1,t,32);INIT4(Y1,2,t,32);INIT4(Y1,3,t,32); }while(0)
  DMA_K(0,0);DMA_V(0,0);DMA_K(1,SLOTB);
  bf16x8 qr[4];
  #pragma unroll
  for(int d0=0;d0<4;++d0)qr[d0]=*reinterpret_cast<const bf16x8*>(&Qw[(long)r32*DM+d0*16+hi*8]);
  float mhat=0.f,l_reg=0.f;f32x16 o[2];o[0]=f32x16{};o[1]=f32x16{};
  const int qrel=wid*QBLK+r32;
  #define CMASK(P0,P1,t) do{int jb_=(t)-(NT-4); if(jb_>=0)cmask(P0,P1,jb_,qrel,hi);}while(0)
  bool resc=false;
  #define START(P0,P1) do{ const float rm=rowmax(P0,P1); resc=false; \
    { const float dl=rm; mhat=fadd_s(mhat,dl); \
      _Pragma("unroll") for(int r=0;r<16;++r){P0[r]=fsub_s(P0[r],dl);P1[r]=fsub_s(P1[r],dl);} } \
    _Pragma("unroll") for(int r=0;r<16;++r)P0[r]=__builtin_amdgcn_exp2f(P0[r]); }while(0)
  #define RESC() do{ if(resc){ asm volatile("s_waitcnt lgkmcnt(0)":::"memory"); \
      _Pragma("unroll") for(int d_=0;d_<2;++d_) _Pragma("unroll") for(int r=0;r<16;++r)o[d_][r]*=wsf[crow(r,hi)]; } }while(0)
  f32x16 pA0,pA1,pB0,pB1;
  int sl_prev=0,sl_cur=0,sl_next=SLOTB;
  #define ROT() do{sl_prev=sl_cur;sl_cur=sl_next;sl_next=(sl_next==(NSLOT-1)*SLOTB)?0:sl_next+SLOTB;}while(0)
  DMA_K(2,2*SLOTB);
  WAIT_BAR(3);
  INITT(pA0,pA1,0); qkt(pA0,pA1,Kbase,qr,r32,hi);asm volatile("s_nop 15\n\ts_nop 7":"+v"(pA0),"+v"(pA1));CMASK(pA0,pA1,0);
  START(pA0,pA1);
  _Pragma("unroll") for(int r=0;r<16;++r)pA1[r]=__builtin_amdgcn_exp2f(pA1[r]);
  INITT(pB0,pB1,1);
  WAIT_BAR(0);
  DMA_K(3,0);DMA_V(1,SLOTB);
  ROT();
  kload8(kf,kp0+sl_cur);
  WAIT_BAR(2);
  s16x4 vlo[8],vhi[8]; u32x4 pw0,pw1,pw2,pw3;
  #define PKW(P,B) cvtpk_s(P[B],P[B+1])
  #define PAF(k) __builtin_bit_cast(bf16x8,pw##k)
  #define VFR(i) (bf16x8){vlo[i][0],vlo[i][1],vlo[i][2],vlo[i][3],vhi[i][0],vhi[i][1],vhi[i][2],vhi[i][3]}
  #define PIN(x) asm volatile("":"+v"(x))
  #define MX3(a,b,c) __builtin_fmaxf(__builtin_fmaxf((a),(b)),(c))
  #define GAPA(MF,A0,A1,A2,A3,W0,W1,PW) do{ MF; sacc+=A0; sacc+=A1; sacc+=A2; sacc+=A3; PIN(sacc); W0; W1; PIN(PW); SBAR(); }while(0)
  #define EX(v) __builtin_amdgcn_exp2f(v)
  #define GAPB(MF,X,B,GN,Y,tn,o) do{ MF; X[B]=EX(X[B]); X[B+1]=EX(X[B+1]); X[B+2]=EX(X[B+2]); X[B+3]=EX(X[B+3]); PIN(X); if(GN){ INIT4(Y,(B)/4,tn,o); PIN(Y); } SBAR(); }while(0)
  #define VRD(i) do{ vlo[i]=vtr(vp_+(((i)>>2)*4096+((i)&3)*1024)); vhi[i]=vtr(vp_+(((i)>>2)*4096+((i)&3)*1024+512)); }while(0)
  #define KRD(G,j) do{ if(G){ kload2(kf,kp0+sl_next,j); SBAR(); } }while(0)
  #define STEP(C0,C1,P0,P1,t,GK,GV,GL) do{ SBAR(); \
    const lds_cptr vp_=vp0+sl_prev; \
    VRD(0); SBAR(); float sacc=(P0[0]+P0[1]); \
    GAPA(C0=__builtin_amdgcn_mfma_f32_32x32x16_bf16(kf[0],qr[0],C0,0,0,0), P0[2],P0[3],P0[4],P0[5],     pw0[0]=PKW(P0,0), pw0[1]=PKW(P0,2), pw0); \
    VRD(4); SBAR(); GAPA(C1=__builtin_amdgcn_mfma_f32_32x32x16_bf16(kf[1],qr[0],C1,0,0,0), P0[6],P0[7],P0[8],P0[9],     pw0[2]=PKW(P0,4), pw0[3]=PKW(P0,6), pw0); \
    VRD(1); SBAR(); GAPA(C0=__builtin_amdgcn_mfma_f32_32x32x16_bf16(kf[2],qr[1],C0,0,0,0),   P0[10],P0[11],P0[12],P0[13], pw1[0]=PKW(P0,8), pw1[1]=PKW(P0,10), pw1); \
    VRD(5); SBAR(); GAPA(C1=__builtin_amdgcn_mfma_f32_32x32x16_bf16(kf[3],qr[1],C1,0,0,0),   P0[14],P0[15],P1[0],P1[1],   pw1[2]=PKW(P0,12),pw1[3]=PKW(P0,14), pw1); \
    VRD(2); SBAR(); GAPA(C0=__builtin_amdgcn_mfma_f32_32x32x16_bf16(kf[4],qr[2],C0,0,0,0),   P1[2],P1[3],P1[4],P1[5],     pw2[0]=PKW(P1,0), pw2[1]=PKW(P1,2), pw2); \
    VRD(6); SBAR(); GAPA(C1=__builtin_amdgcn_mfma_f32_32x32x16_bf16(kf[5],qr[2],C1,0,0,0),   P1[6],P1[7],P1[8],P1[9],     pw2[2]=PKW(P1,4), pw2[3]=PKW(P1,6), pw2); \
    VRD(3); SBAR(); GAPA(C0=__builtin_amdgcn_mfma_f32_32x32x16_bf16(kf[6],qr[3],C0,0,0,0),   P1[10],P1[11],P1[12],P1[13], pw3[0]=PKW(P1,8), pw3[1]=PKW(P1,10), pw3); \
    VRD(7); SBAR(); GAPA(C1=__builtin_amdgcn_mfma_f32_32x32x16_bf16(kf[7],qr[3],C1,0,0,0),   P1[14],P1[15],0.f,0.f,       pw3[2]=PKW(P1,12),pw3[3]=PKW(P1,14), pw3); \
    l_reg+=sacc; \
    if(GK){DMA_K((t)+3,sl_cur);} if(GV){DMA_V((t)+1,sl_next);} \
    CMASK(C0,C1,t); \
    { float a=MX3(C0[0],C0[1],C1[0]),b=MX3(C0[2],C0[3],C1[1]); a=MX3(a,C1[2],C1[3]); \
      _Pragma("unroll") for(int r=4;r<16;r+=4){a=MX3(a,C0[r],C0[r+1]);b=MX3(b,C0[r+2],C0[r+3]);a=MX3(a,C1[r],C1[r+1]);b=MX3(b,C1[r+2],C1[r+3]);} \
      float rm=__builtin_fmaxf(a,b); { auto rr=__builtin_amdgcn_permlane32_swap(__float_as_uint(rm),__float_as_uint(rm),false,false); rm=__builtin_fmaxf(__uint_as_float(rr[0]),__uint_as_float(rr[1])); } \
      resc=false; \
      if(__builtin_expect(__any(rm>(float)THRL),0)){ const float dl=__builtin_fmaxf(rm,0.f); mhat+=dl; \
        _Pragma("unroll") for(int r=0;r<16;++r){C0[r]-=dl;C1[r]-=dl;} \
        const float f=__builtin_amdgcn_exp2f(-dl); l_reg*=f; if(hi==0)wsf[r32]=f; resc=true; } } \
    SBAR(); \
    GAPB(o[0]=__builtin_amdgcn_mfma_f32_32x32x16_bf16(PAF(0),VFR(0),o[0],0,0,0), C0,0,  GL,P0,(t)+1,0); \
    GAPB(o[1]=__builtin_amdgcn_mfma_f32_32x32x16_bf16(PAF(0),VFR(4),o[1],0,0,0), C0,4,  GL,P0,(t)+1,0); \
    KRD(GL,0); GAPB(o[0]=__builtin_amdgcn_mfma_f32_32x32x16_bf16(PAF(1),VFR(1),o[0],0,0,0), C0,8,  GL,P0,(t)+1,0); \
    KRD(GL,1); GAPB(o[1]=__builtin_amdgcn_mfma_f32_32x32x16_bf16(PAF(1),VFR(5),o[1],0,0,0), C0,12, GL,P0,(t)+1,0); \
    KRD(GL,2); GAPB(o[0]=__builtin_amdgcn_mfma_f32_32x32x16_bf16(PAF(2),VFR(2),o[0],0,0,0), C1,0,  GL,P1,(t)+1,32); \
    KRD(GL,3); GAPB(o[1]=__builtin_amdgcn_mfma_f32_32x32x16_bf16(PAF(2),VFR(6),o[1],0,0,0), C1,4,  GL,P1,(t)+1,32); \
    GAPB(o[0]=__builtin_amdgcn_mfma_f32_32x32x16_bf16(PAF(3),VFR(3),o[0],0,0,0), C1,8,  GL,P1,(t)+1,32); \
    GAPB(o[1]=__builtin_amdgcn_mfma_f32_32x32x16_bf16(PAF(3),VFR(7),o[1],0,0,0), C1,12, GL,P1,(t)+1,32); \
    }while(0)
  int t=1;
  #undef CMASK
  #define CMASK(P0,P1,t) do{}while(0)
  for(;t+5<NT;t+=2){
    STEP(pB0,pB1,pA0,pA1,t,true,true,true);     WAIT_BAR(2); RESC(); ROT();
    STEP(pA0,pA1,pB0,pB1,t+1,true,true,true);   WAIT_BAR(2); RESC(); ROT();
  }
  #undef CMASK
  #define CMASK(P0,P1,t) do{int jb_=(t)-(NT-4); if(jb_>=0)cmask(P0,P1,jb_,qrel,hi);}while(0)
  #define ENDW(tt) do{ if((tt)+3<NT){WAIT_BAR(2);} else if((tt)+2<NT){WAIT_BAR(1);} else {WAIT_BAR(0);} }while(0)
  for(;t+1<NT;t+=2){
    STEP(pB0,pB1,pA0,pA1,t,(t+3<NT),(t+1<NT),(t+1<NT));       ENDW(t);   RESC(); ROT();
    STEP(pA0,pA1,pB0,pB1,t+1,(t+4<NT),(t+2<NT),(t+2<NT));     ENDW(t+1); RESC(); ROT();
  }
  STEP(pB0,pB1,pA0,pA1,NT-1,false,false,false); RESC();
  { float sacc=pB0[0]+pB0[1]; _Pragma("unroll") for(int r=2;r<16;++r)sacc+=pB0[r]; _Pragma("unroll") for(int r=0;r<16;++r)sacc+=pB1[r]; l_reg+=sacc;
    pw0=(u32x4){PKW(pB0,0),PKW(pB0,2),PKW(pB0,4),PKW(pB0,6)};pw1=(u32x4){PKW(pB0,8),PKW(pB0,10),PKW(pB0,12),PKW(pB0,14)};pw2=(u32x4){PKW(pB1,0),PKW(pB1,2),PKW(pB1,4),PKW(pB1,6)};pw3=(u32x4){PKW(pB1,8),PKW(pB1,10),PKW(pB1,12),PKW(pB1,14)};
    SBAR(); pv(o,vb0+sl_cur,PAF(0),PAF(1),PAF(2),PAF(3)); }
  #undef PKW
  #undef PAF
  #undef VFR
  #undef PIN
  #undef MX3
  #undef GAPA
  #undef GAPB
  #undef EX
  #undef VRD
  #undef KRD
  #undef STEP
  #undef ENDW
  {auto rr=__builtin_amdgcn_permlane32_swap(__float_as_uint(l_reg),__float_as_uint(l_reg),false,false);l_reg=__uint_as_float(rr[0])+__uint_as_float(rr[1]);}
  if(hi==0)wsf[32+r32]=l_reg;asm volatile("s_waitcnt lgkmcnt(0)":::"memory");
  float rli[16];
  #pragma unroll
  for(int r=0;r<16;++r)rli[r]=__builtin_amdgcn_rcpf(wsf[32+crow(r,hi)]);
  bf16*Ow=O+(rowbase+q0+wid*QBLK)*OPITCH+h*D; float*Sw=SSQ+(rowbase+q0+wid*QBLK)*NHEAD+h;
  { bf16*stg=(bf16*)(shm+LDS_OST)+wid*2048;
    #pragma unroll
    for(int r=0;r<16;++r){const int orow=crow(r,hi);
      #pragma unroll
      for(int d0=0;d0<2;++d0)stg[orow*64+d0*32+r32]=__float2bfloat16(o[d0][r]*rli[r]);}
    asm volatile("s_waitcnt lgkmcnt(0)":::"memory");
    #pragma unroll
    for(int i=0;i<4;++i){const int row=i*8+(lane>>3),ch=lane&7; const u32x4 v=*(const u32x4*)(stg+row*64+ch*8); ATTN_STORE16(Ow+(long)row*OPITCH+ch*8,v);
      float sq=0.f;
      #pragma unroll
      for(int j=0;j<4;++j){ const float lo_=__uint_as_float(v[j]<<16), hi_=__uint_as_float(v[j]&0xffff0000u); sq+=lo_*lo_+hi_*hi_; }
      sq+=__shfl_xor(sq,1); sq+=__shfl_xor(sq,2); sq+=__shfl_xor(sq,4);
      if(ch==0)Sw[(long)row*NHEAD]=sq; } }
  asm volatile("s_waitcnt lgkmcnt(0)\n\ts_barrier":::"memory");
  #undef DMA_K
  #undef BIAS4
  #undef INIT4
  #undef INITT
  #undef DMA_V
  #undef CMASK
  #undef START
  #undef RESC
  #undef ROT
}
constexpr int ATTN_LDS_BYTES=LDS_BYTES;
struct AttnTensors { const bf16* Q; const bf16* K; const bf16* V; bf16* O; const float* LOGF2; float* SSQ; };
struct AttnUnit { int bh; int qb; };
struct StaticOrder {
  int vcu,G;
  __device__ __forceinline__ explicit StaticOrder(int grid,int vcu_):vcu(vcu_),G(grid){}
  __device__ __forceinline__ bool next(int i,AttnUnit&u)const{ const int L=(i>>1)*G+vcu; if(L>=BATCH*NHEAD*4)return false; const int s=L&3; u.bh=L>>2; u.qb=(i&1)?7-s:s; return true; }
  __device__ __forceinline__ void a_ready(const AttnUnit&)const{}
  __device__ __forceinline__ void done(const AttnUnit&)const{}
};
template<class Sched,int THRL=8> __device__ __forceinline__ void attn_phase(char*lds,const AttnTensors&T,const Sched&S){
  AttnUnit u;
  for(int i=0;S.next(i,u);++i){ S.a_ready(u); attn_unit<THRL>(u.bh/NHEAD,u.bh%NHEAD,u.qb,T.Q,T.K,T.V,T.O,T.LOGF2,T.SSQ,lds); S.done(u); }
}
#undef SBAR
#undef WAIT_BAR
}

constexpr int NWAVES = 8;
constexpr int NPHASES = 11;

constexpr size_t MiB = 1u << 20, KiB = 1u << 10;
constexpr size_t WS_CTL = 0, CTL_ZERO_BYTES = 1 * MiB;
constexpr size_t WS_MOD = 1 * MiB;
constexpr size_t WS_LOGF2 = 1 * MiB + 256 * KiB;
constexpr size_t WS_SSQ = 1 * MiB + 768 * KiB;
constexpr size_t WS_TOPI = 2 * MiB + 256 * KiB;
constexpr size_t WS_TOPW = 2 * MiB + 512 * KiB;
constexpr size_t WS_WGCNT = 2 * MiB + 768 * KiB;
constexpr size_t WS_LSUM = 3 * MiB;
constexpr size_t WS_ROWTOK = 4 * MiB, WS_ROWPAIR = 4 * MiB + 512 * KiB, WS_ROWW = 5 * MiB, WS_MTEXP = 5 * MiB + 512 * KiB;
constexpr size_t WS_LWT = 6 * MiB;
constexpr size_t WS_WIN = 8 * MiB;
constexpr size_t WS_WOUT = 13 * MiB;
constexpr size_t WS_WUP = 16 * MiB;
constexpr size_t WS_WDN = 144 * MiB;
constexpr size_t WS_H1 = 208 * MiB;
constexpr size_t WS_PJ = 240 * MiB;
constexpr size_t PJ_STRIDE = (size_t)NTOK * 512;
constexpr size_t WS_MRG = 320 * MiB;
constexpr size_t WS_Y = 352 * MiB;
constexpr size_t WS_H2 = 416 * MiB;
constexpr size_t WS_ACT = 448 * MiB;
constexpr size_t WS_YP = 592 * MiB;
constexpr size_t WS_END = 720 * MiB;
static_assert(WS_ACT + (size_t)MAXROWS * 1024 * 2 <= WS_YP && WS_YP + (size_t)NTOK * 4 * 1024 * 2 <= WS_END, "d_ws map");
constexpr int CW_BAR = 4096;

constexpr int LDS_BYTES = 147456;
constexpr int LDSCTL_OFF = LDS_BYTES - 512, MISC_OFF = LDSCTL_OFF + 320;
constexpr int SCRATCH_BYTES = LDSCTL_OFF;

#define GAS __attribute__((address_space(1)))
#define LAS __attribute__((address_space(3)))
typedef unsigned short bf16;
typedef unsigned v4u __attribute__((ext_vector_type(4)));
typedef unsigned v2u __attribute__((ext_vector_type(2)));
typedef float f32x4 __attribute__((ext_vector_type(4)));
typedef float f32x16 __attribute__((ext_vector_type(16)));
typedef short bf16x8 __attribute__((ext_vector_type(8)));
typedef GAS unsigned gu32;
#define RLX_AGENT __ATOMIC_RELAXED, __HIP_MEMORY_SCOPE_AGENT
#define LDS_WAIT() asm volatile("s_waitcnt lgkmcnt(0)" ::: "memory")
#define VM_WAIT() asm volatile("s_waitcnt vmcnt(0)" ::: "memory")
__device__ __forceinline__ unsigned f2bf(float f) { unsigned u = __builtin_bit_cast(unsigned, f); return (u + 0x7fffu + ((u >> 16) & 1u)) >> 16; }
__device__ __forceinline__ unsigned pk2(float lo, float hi) { return f2bf(lo) | (f2bf(hi) << 16); }
__device__ __forceinline__ float bflo(unsigned w) { return __uint_as_float(w << 16); }
__device__ __forceinline__ float bfhi(unsigned w) { return __uint_as_float(w & 0xffff0000u); }
__device__ __forceinline__ float bf1(bf16 h) { return __uint_as_float((unsigned)h << 16); }

#define XB_TMO      128
#define XB_XCNT(j)  (256  + 64 * (j))
#define XB_XSUB(j)  (1280 + 64 * (j))
#define XB_XGEN(j)  (2304 + 64 * (j))
#define XB_TOP      3328
#define XB_TOPGEN   3392
#define XCD_BAR_WORDS 3456
#define XB_SPIN_CAP (1u << 18)
__device__ __forceinline__ unsigned xb_ld(unsigned* p)              { return __hip_atomic_load(p, __ATOMIC_RELAXED, __HIP_MEMORY_SCOPE_AGENT); }
__device__ __forceinline__ unsigned xb_add(unsigned* p, unsigned v) { return __hip_atomic_fetch_add(p, v, __ATOMIC_RELAXED, __HIP_MEMORY_SCOPE_AGENT); }
__device__ __forceinline__ unsigned xb_xcc_id() { return (unsigned)__builtin_amdgcn_s_getreg((3 << 11) | 20) & 0xFu; }
#define XB_SPIN(cond, bar) do { unsigned _sp = 0; while (cond) { __builtin_amdgcn_s_sleep(1); \
    if ((++_sp & 255u) == 0u) { if (xb_ld(&(bar)[XB_TMO])) break; if (_sp > XB_SPIN_CAP) { atomicAdd(&(bar)[XB_TMO], 1u); break; } } } } while (0)
struct XcdBarrier { unsigned* bar; unsigned x; volatile LAS unsigned* st; };
__device__ __forceinline__ XcdBarrier xcd_barrier_post(unsigned* bar, volatile LAS unsigned* st) {
    XcdBarrier b; b.bar = bar; b.x = xb_xcc_id(); b.st = st;
    if (threadIdx.x == 0) (void)xb_add(&bar[XB_XCNT(b.x)], 1u);
    return b;
}
__device__ __forceinline__ void xcd_barrier_complete(unsigned* bar, unsigned x, unsigned& nloc, unsigned& nx) {
    const unsigned G = gridDim.x * gridDim.y * gridDim.z;
    unsigned sum, cnt, mine, sp = 0u;
    for (;;) {
        sum = 0u; cnt = 0u; mine = 0u;
#pragma unroll
        for (unsigned j = 0; j < 16; ++j) { const unsigned c = xb_ld(&bar[XB_XCNT(j)]); sum += c; cnt += (c > 0u) ? 1u : 0u; mine = (j == x) ? c : mine; }
        if (sum == G) break;
        __builtin_amdgcn_s_sleep(1);
        if ((++sp & 255u) == 0u) { if (xb_ld(&bar[XB_TMO])) break; if (sp > XB_SPIN_CAP) { atomicAdd(&bar[XB_TMO], 1u); break; } }
    }
    nloc = mine > 0u ? mine : 1u; nx = cnt > 0u ? cnt : 1u;
}
__device__ __forceinline__ void xcd_barrier(const XcdBarrier& b) {
    asm volatile("s_waitcnt vmcnt(0)" ::: "memory");
    __syncthreads();
    if (threadIdx.x == 0) {
        unsigned* bar = b.bar;
        __builtin_amdgcn_s_waitcnt(0);
        unsigned nloc = b.st[0], nx = b.st[1];
        if (nloc == 0u) { xcd_barrier_complete(bar, b.x, nloc, nx); b.st[0] = nloc; b.st[1] = nx; }
        const unsigned old = xb_add(&bar[XB_XSUB(b.x)], 1u);
        const unsigned gen = old / nloc;
        if (old + 1u == (gen + 1u) * nloc) {
            __builtin_amdgcn_fence(__ATOMIC_RELEASE, "agent");
            asm volatile("s_waitcnt vmcnt(0)" ::: "memory");
            const unsigned og = xb_add(&bar[XB_TOP], 1u);
            const unsigned tg = og / nx;
            if (og + 1u == (tg + 1u) * nx) xb_add(&bar[XB_TOPGEN], 1u);
            else XB_SPIN(xb_ld(&bar[XB_TOPGEN]) == tg, bar);
            __builtin_amdgcn_fence(__ATOMIC_ACQUIRE, "agent");
            xb_add(&bar[XB_XGEN(b.x)], 1u);
            asm volatile("s_waitcnt vmcnt(0)" ::: "memory");
        } else {
            XB_SPIN(xb_ld(&bar[XB_XGEN(b.x)]) == gen, bar);
            __builtin_amdgcn_fence(__ATOMIC_ACQUIRE, "agent");
            asm volatile("s_waitcnt vmcnt(0)" ::: "memory");
        }
    }
    __syncthreads();
}

struct Args { const float* in[26]; float* out; unsigned char* ws; int ph_lo, ph_hi, li, pad; };
struct Frame {
    LAS unsigned char* lds;
    int tid, lane, wave, vcu, G;
    float* out; unsigned char* ws;
    __device__ __forceinline__ const float* in(int k) const { const LAS unsigned* t = (const LAS unsigned*)(lds + LDSCTL_OFF) + 2 * k;
        const unsigned lo = (unsigned)__builtin_amdgcn_readfirstlane((int)t[0]), hi = (unsigned)__builtin_amdgcn_readfirstlane((int)t[1]);
        return (const float*)(const GAS float*)(((unsigned long long)hi << 32) | lo); }
};
__device__ __forceinline__ float wave_sum(float v) {
#pragma unroll
    for (int o = 1; o < 64; o <<= 1) v += __shfl_xor(v, o);
    return v;
}
__device__ __forceinline__ float wave_max(float v) {
#pragma unroll
    for (int o = 1; o < 64; o <<= 1) v = fmaxf(v, __shfl_xor(v, o));
    return v;
}
__device__ __forceinline__ float sigmoid_f(float x) { return 1.0f / (1.0f + __expf(-x)); }
__device__ __forceinline__ float gelu_tanh_f(float x) { const float u = 0.7978845608028654f * (x + 0.044715f * x * x * x); const float e = __expf(2.0f * u); return x * (1.0f - 1.0f / (e + 1.0f)); }
__device__ __forceinline__ float log_sigmoid_f(float z) { return z >= 0.f ? -log1pf(expf(-z)) : z - log1pf(expf(z)); }
__device__ __forceinline__ float softplus_f(float z) { return z > 0.f ? z + log1pf(expf(-z)) : log1pf(expf(z)); }

__device__ __forceinline__ void p0_transpose_item(const float* W, int ldw, bf16* WT, int k0, int n0, int kdst0, const float* gain, LAS float* scr, int lane) {
#pragma unroll 8
    for (int i = 0; i < 32; ++i) { const int kk = 2 * i + (lane >> 5); float v = W[(size_t)(k0 + kk) * ldw + n0 + (lane & 31)]; if (gain) v *= gain[k0 + kk]; scr[kk * 33 + (lane & 31)] = v; }
    LDS_WAIT(); asm volatile("" ::: "memory");
    const int c = lane & 7;
#pragma unroll
    for (int j = 0; j < 4; ++j) { const int n = (lane >> 3) + 8 * j; const LAS float* s = scr + (8 * c) * 33 + n;
        v4u o; o.x = pk2(s[0 * 33], s[1 * 33]); o.y = pk2(s[2 * 33], s[3 * 33]); o.z = pk2(s[4 * 33], s[5 * 33]); o.w = pk2(s[6 * 33], s[7 * 33]);
        *(GAS v4u*)(WT + (size_t)(n0 + n) * 1024 + kdst0 + 8 * c) = o; }
    LDS_WAIT(); asm volatile("" ::: "memory");
}
__device__ __forceinline__ void p0_phase(Frame& F) {
    const float* c_in = F.in(1); const float* w_ada = F.in(2); const float* b_ada = F.in(3);
    float* MOD = (float*)(F.ws + WS_MOD);
    if (F.vcu < 96) {
        LAS float* sc = (LAS float*)F.lds;
        LAS float* red = (LAS float*)(F.lds + 32768);
        for (int i = F.tid; i < BATCH * DM; i += NWAVES * 64) { const int b = i >> 10, k = i & 1023; const float v = c_in[i]; sc[k * 8 + b] = v * sigmoid_f(v); }
        __syncthreads();
        for (int ci = F.vcu; ci < 96; ci += F.G) {
            float acc[8];
#pragma unroll
            for (int b = 0; b < 8; ++b) acc[b] = 0.f;
            const float* wp = w_ada + (size_t)(128 * F.wave) * (NMOD * DM) + ci * 64 + F.lane;
#pragma unroll 8
            for (int kk = 0; kk < 128; ++kk) { const float wv = wp[(size_t)kk * (NMOD * DM)]; const LAS f32x4* sp = (const LAS f32x4*)(sc + (128 * F.wave + kk) * 8); const f32x4 s0 = sp[0], s1 = sp[1];
                acc[0] += s0[0] * wv; acc[1] += s0[1] * wv; acc[2] += s0[2] * wv; acc[3] += s0[3] * wv; acc[4] += s1[0] * wv; acc[5] += s1[1] * wv; acc[6] += s1[2] * wv; acc[7] += s1[3] * wv; }
#pragma unroll
            for (int b = 0; b < 8; ++b) red[(F.wave * 8 + b) * 64 + F.lane] = acc[b];
            __syncthreads();
            { const int b = F.tid >> 6, col = F.tid & 63; float s = 0.f;
#pragma unroll
              for (int w = 0; w < 8; ++w) s += red[(w * 8 + b) * 64 + col];
              MOD[b * NMOD * DM + ci * 64 + col] = s + b_ada[ci * 64 + col]; }
            __syncthreads();
        }
    }
    __syncthreads();
    const float* w_in = F.in(6); const float* w_out = F.in(17); const float* w_up = F.in(22); const float* w_down = F.in(24); const float* gn_attn = F.in(16);
    bf16* WIN = (bf16*)(F.ws + WS_WIN); bf16* WOUT = (bf16*)(F.ws + WS_WOUT); bf16* WUP = (bf16*)(F.ws + WS_WUP); bf16* WDN = (bf16*)(F.ws + WS_WDN);
    LAS float* scr = (LAS float*)(F.lds + F.wave * 16384);
    const int gw = F.vcu * NWAVES + F.wave, NGW = F.G * NWAVES;
    constexpr int I_IN = 16 * (NPJ / 32), I_OUT = 16 * (DM / 32), I_UP1 = 16 * (2 * DEXP / 32), I_UP = NE * I_UP1, I_DN1 = 16 * (DM / 32), I_DN = NE * I_DN1;
    constexpr int NITEMS = I_IN + I_OUT + I_UP + I_DN;
    for (int it = gw; it < NITEMS; it += NGW) {
        int r = it;
        if (r < I_IN) { const int kb = r / (NPJ / 32), nb = r % (NPJ / 32); p0_transpose_item(w_in, NPROJ, WIN, 64 * kb, 32 * nb, 64 * kb, nullptr, scr, F.lane); continue; } r -= I_IN;
        if (r < I_OUT) { const int kb = r / (DM / 32), nb = r % (DM / 32); const int k0 = 64 * kb;
            p0_transpose_item(w_out, DM, WOUT, k0, 32 * nb, (k0 + 512) & 1023, k0 >= 512 ? gn_attn - 512 : nullptr, scr, F.lane); continue; } r -= I_OUT;
        if (r < I_UP) { const int e = r / I_UP1, q = r % I_UP1, kb = q / (2 * DEXP / 32), nb = q % (2 * DEXP / 32);
            p0_transpose_item(w_up + (size_t)e * DM * 2 * DEXP, 2 * DEXP, WUP + (size_t)e * 2 * DEXP * 1024, 64 * kb, 32 * nb, 64 * kb, nullptr, scr, F.lane); continue; } r -= I_UP;
        { const int e = r / I_DN1, q = r % I_DN1, kb = q / (DM / 32), nb = q % (DM / 32);
            p0_transpose_item(w_down + (size_t)e * DEXP * DM, DM, WDN + (size_t)e * DM * 1024, 64 * kb, 32 * nb, 64 * kb, nullptr, scr, F.lane); }
    }
    { const float* wa = F.in(9); const float* wx = F.in(11); bf16* LWT = (bf16*)(F.ws + WS_LWT);
      for (int idx = F.vcu * (NWAVES * 64) + F.tid; idx < 2 * 8 * 64 * 64; idx += F.G * NWAVES * 64) { const int gate = idx >> 15, g = (idx >> 12) & 7, j = (idx >> 6) & 63, i = idx & 63;
          LWT[idx] = (bf16)f2bf((gate ? wx : wa)[(g * 64 + i) * 64 + j]); } }
}

__device__ __forceinline__ void p1_phase(Frame& F) {
    const float* x = F.in(0); const float* gpre = F.in(4); const float* w_in = F.in(6); const float* fb = F.in(14);
    const float* MOD = (const float*)(F.ws + WS_MOD); bf16* H1 = (bf16*)(F.ws + WS_H1); float* LOGF2 = (float*)(F.ws + WS_LOGF2);
    LAS float* wf = (LAS float*)F.lds;
    for (int i = F.tid; i < 8 * DM; i += NWAVES * 64) { const int k = i >> 3, h = i & 7; wf[h * DM + k] = w_in[(size_t)k * NPROJ + NPJ + h]; }
    __syncthreads();
    const int gw = F.vcu * NWAVES + F.wave;
    if (F.G * NWAVES * 8 != NTOK) return;
    const int row0 = gw * 8, b = row0 / SEQ;
    f32x4 gm[4], sh[4];
#pragma unroll
    for (int j = 0; j < 4; ++j) { const int k = 4 * F.lane + 256 * j; const f32x4 g = *(const f32x4*)(gpre + k), s = *(const f32x4*)(MOD + b * NMOD * DM + DM + k); gm[j] = g * (s + 1.0f); sh[j] = *(const f32x4*)(MOD + b * NMOD * DM + k); }
    for (int r = 0; r < 8; ++r) { const int row = row0 + r;
        f32x4 v[4]; float ss = 0.f;
#pragma unroll
        for (int j = 0; j < 4; ++j) { v[j] = *(const f32x4*)(x + (size_t)row * DM + 4 * F.lane + 256 * j); ss += (v[j][0] * v[j][0] + v[j][1] * v[j][1]) + (v[j][2] * v[j][2] + v[j][3] * v[j][3]); }
        const float rinv = 1.0f / sqrtf(wave_sum(ss) * (1.0f / DM) + RMS_EPS);
        float fl[8];
#pragma unroll
        for (int h = 0; h < 8; ++h) fl[h] = 0.f;
#pragma unroll
        for (int j = 0; j < 4; ++j) { const f32x4 hv = v[j] * rinv * gm[j] + sh[j];
            v2u o; o.x = pk2(hv[0], hv[1]); o.y = pk2(hv[2], hv[3]); *(GAS v2u*)(H1 + (size_t)row * DM + 4 * F.lane + 256 * j) = o;
#pragma unroll
            for (int h = 0; h < 8; ++h) { const f32x4 w = *(const LAS f32x4*)(wf + h * DM + 4 * F.lane + 256 * j); fl[h] += (hv[0] * w[0] + hv[1] * w[1]) + (hv[2] * w[2] + hv[3] * w[3]); } }
#pragma unroll
        for (int h = 0; h < 8; ++h) fl[h] = wave_sum(fl[h]);
        if (F.lane < 8) { float f = fl[0];
#pragma unroll
            for (int h = 1; h < 8; ++h) f = (F.lane == h) ? fl[h] : f;
            LOGF2[(size_t)row * 8 + F.lane] = log_sigmoid_f(f + fb[F.lane]) * 1.4426950408889634f; }
    }
}

constexpr int LRU_XP = 1040;
constexpr int LRU_XT = 0, LRU_XC = 69696, LRU_PAR = 136256, LRU_CAR = 142400, LRU_SSQ = 144448;
static_assert(LRU_SSQ + 2048 <= SCRATCH_BYTES && 67 * LRU_XP <= LRU_XC && LRU_XC + 64 * LRU_XP <= LRU_PAR, "LRU LDS map");
__device__ __forceinline__ int crow16(int r, int hi) { return (r & 3) + 8 * (r >> 2) + 4 * hi; }
template <bool FINAL> __device__ __forceinline__ void lru_item(Frame& F, int b, int c) {
    LAS unsigned char* XT = F.lds + LRU_XT; LAS unsigned char* XC = F.lds + LRU_XC;
    LAS float* PAR = (LAS float*)(F.lds + LRU_PAR); LAS float* CAR = (LAS float*)(F.lds + LRU_CAR); LAS float* SSQL = (LAS float*)(F.lds + LRU_SSQ);
    const bf16* XL = (const bf16*)(F.ws + WS_PJ); const bf16* YL = XL + PJ_STRIDE; const bf16* LWT = (const bf16*)(F.ws + WS_LWT);
    float* LSUM = (float*)(F.ws + WS_LSUM); bf16* MRG = (bf16*)(F.ws + WS_MRG);
    const float* conv_w = F.in(7); const float* conv_b = F.in(8); const float* ba = F.in(10); const float* bx = F.in(12); const float* lam = F.in(13); const float* gn_lru = F.in(15);
    const int t0 = c * 64; const size_t rowb = (size_t)b * SEQ;
#pragma unroll 1
    for (int p = F.tid; p < 67 * 64; p += NWAVES * 64) { const int i = p >> 6, c8 = p & 63, t = t0 - 3 + i; v4u v = (v4u){0u, 0u, 0u, 0u};
        if (t >= 0) v = *(const GAS v4u*)(XL + (rowb + t) * 512 + c8 * 8); *(LAS v4u*)(XT + i * LRU_XP + c8 * 16) = v; }
    { const int ch = F.tid; PAR[ch] = ba[ch]; PAR[512 + ch] = bx[ch]; PAR[1024 + ch] = 8.0f * softplus_f(-lam[ch]);
      if (FINAL) { float cr = 0.f; for (int cc = 0; cc < c; ++cc) { const float A = LSUM[(((size_t)b * 32 + cc) * 2 + 0) * 512 + ch], B = LSUM[(((size_t)b * 32 + cc) * 2 + 1) * 512 + ch]; cr = A * cr + B; } CAR[ch] = cr; } }
    __syncthreads();
    { const int ch = F.tid; const float w0 = conv_w[ch], w1 = conv_w[512 + ch], w2 = conv_w[1024 + ch], w3 = conv_w[1536 + ch], cb = conv_b[ch];
      float xa = bf1(*(const LAS bf16*)(XT + 0 * LRU_XP + ch * 2)), xb = bf1(*(const LAS bf16*)(XT + 1 * LRU_XP + ch * 2)), xc = bf1(*(const LAS bf16*)(XT + 2 * LRU_XP + ch * 2));
#pragma unroll 8
      for (int t = 0; t < 64; ++t) { const float xd = bf1(*(const LAS bf16*)(XT + (t + 3) * LRU_XP + ch * 2)); const float v = ((w0 * xa + w1 * xb) + (w2 * xc + w3 * xd)) + cb;
          *(LAS bf16*)(XC + t * LRU_XP + ch * 2) = (bf16)f2bf(v); xa = xb; xb = xc; xc = xd; } }
    __syncthreads();
    if (FINAL) {
#pragma unroll 1
        for (int p = F.tid; p < 64 * 64; p += NWAVES * 64) { const int i = p >> 6, c8 = p & 63; *(LAS v4u*)(XT + i * LRU_XP + c8 * 16) = *(const GAS v4u*)(YL + (rowb + t0 + i) * 512 + c8 * 8); } }
    const int g = F.wave, l31 = F.lane & 31, hi = F.lane >> 5;
    __syncthreads();
    float ssq0 = 0.f, ssq1 = 0.f;
#pragma unroll 1
    for (int cg = 0; cg < 2; ++cg) {
        f32x16 aA[2], aX[2];
#pragma unroll
        for (int tg = 0; tg < 2; ++tg) { aA[tg] = f32x16{}; aX[tg] = f32x16{}; }
#pragma unroll
        for (int s = 0; s < 4; ++s) {
            const bf16x8 wa = *(const GAS bf16x8*)(LWT + ((size_t)((0 * 8 + g) * 64 + 32 * cg + l31)) * 64 + 16 * s + 8 * hi);
            const bf16x8 wx = *(const GAS bf16x8*)(LWT + ((size_t)((1 * 8 + g) * 64 + 32 * cg + l31)) * 64 + 16 * s + 8 * hi);
#pragma unroll
            for (int tg = 0; tg < 2; ++tg) { const bf16x8 bfr = *(const LAS bf16x8*)(XC + (32 * tg + l31) * LRU_XP + (g * 64 + 16 * s + 8 * hi) * 2);
                aA[tg] = __builtin_amdgcn_mfma_f32_32x32x16_bf16(wa, bfr, aA[tg], 0, 0, 0); aX[tg] = __builtin_amdgcn_mfma_f32_32x32x16_bf16(wx, bfr, aX[tg], 0, 0, 0); }
        }
#pragma unroll
        for (int tg = 0; tg < 2; ++tg) {
            f32x16& A = aA[tg]; f32x16& X = aX[tg]; const int tok = 32 * tg + l31;
#pragma unroll
            for (int q = 0; q < 4; ++q) { const int chb = g * 64 + 32 * cg + 8 * q + 4 * hi;
                const f32x4 pba = *(const LAS f32x4*)(PAR + chb), pbx = *(const LAS f32x4*)(PAR + 512 + chb), psp = *(const LAS f32x4*)(PAR + 1024 + chb);
                const v2u xw = *(const LAS v2u*)(XC + tok * LRU_XP + chb * 2);
                const float xv[4] = {bflo(xw.x), bfhi(xw.x), bflo(xw.y), bfhi(xw.y)};
#pragma unroll
                for (int i = 0; i < 4; ++i) { const int r = 4 * q + i; const float rg = sigmoid_f(A[r] + pba[i]), ig = sigmoid_f(X[r] + pbx[i]); const float la = -rg * psp[i];
                    A[r] = __expf(la); X[r] = sqrtf(-expm1f(2.0f * la)) * (ig * xv[i]); } }
#pragma unroll
            for (int d = 1; d < 32; d <<= 1) {
#pragma unroll
                for (int r = 0; r < 16; ++r) { const float ap = __shfl_up(A[r], d, 32), bp = __shfl_up(X[r], d, 32); if (l31 >= d) { X[r] = A[r] * bp + X[r]; A[r] = A[r] * ap; } } }
        }
#pragma unroll
        for (int r = 0; r < 16; ++r) { const float ca = __shfl(aA[0][r], 31, 32), cb2 = __shfl(aX[0][r], 31, 32); aX[1][r] = aA[1][r] * cb2 + aX[1][r]; aA[1][r] = aA[1][r] * ca; }
        if (!FINAL) {
            if (l31 == 31) {
#pragma unroll
                for (int q = 0; q < 4; ++q) { const int chb = g * 64 + 32 * cg + 8 * q + 4 * hi; float* d0 = LSUM + (((size_t)b * 32 + c) * 2 + 0) * 512 + chb;
                    *(f32x4*)d0 = (f32x4){aA[1][4 * q], aA[1][4 * q + 1], aA[1][4 * q + 2], aA[1][4 * q + 3]};
                    *(f32x4*)(d0 + 512) = (f32x4){aX[1][4 * q], aX[1][4 * q + 1], aX[1][4 * q + 2], aX[1][4 * q + 3]}; }
            }
        } else {
#pragma unroll
            for (int tg = 0; tg < 2; ++tg) { const int tok = 32 * tg + l31; float sq = 0.f;
#pragma unroll
                for (int q = 0; q < 4; ++q) { const int chb = g * 64 + 32 * cg + 8 * q + 4 * hi; const f32x4 car = *(const LAS f32x4*)(CAR + chb);
                    LAS v2u* yp = (LAS v2u*)(XT + tok * LRU_XP + chb * 2); const v2u yw = *yp; const float yv[4] = {bflo(yw.x), bfhi(yw.x), bflo(yw.y), bfhi(yw.y)}; float o[4];
#pragma unroll
                    for (int i = 0; i < 4; ++i) { const int r = 4 * q + i; const float h = aX[tg][r] + aA[tg][r] * car[i]; o[i] = h * gelu_tanh_f(yv[i]); sq += o[i] * o[i]; }
                    v2u ow; ow.x = pk2(o[0], o[1]); ow.y = pk2(o[2], o[3]); *yp = ow; }
                if (tg == 0) ssq0 += sq; else ssq1 += sq; }
        }
    }
    if (FINAL) {
        ssq0 += __shfl_xor(ssq0, 32); ssq1 += __shfl_xor(ssq1, 32);
        if (hi == 0) { SSQL[g * 64 + l31] = ssq0; SSQL[g * 64 + 32 + l31] = ssq1; }
        __syncthreads();
        if (F.tid < 64) { float tot = 0.f;
#pragma unroll
            for (int w = 0; w < 8; ++w) tot += SSQL[w * 64 + F.tid];
            CAR[F.tid] = 1.0f / sqrtf(tot * (1.0f / DLRU) + RMS_EPS); }
        __syncthreads();
#pragma unroll 1
        for (int p = F.tid; p < 64 * 64; p += NWAVES * 64) { const int i = p >> 6, c8 = p & 63; const float rinv = CAR[i];
            const v4u w = *(const LAS v4u*)(XT + i * LRU_XP + c8 * 16); const f32x4 g0 = *(const f32x4*)(gn_lru + c8 * 8), g1 = *(const f32x4*)(gn_lru + c8 * 8 + 4);
            v4u o; o.x = pk2(bflo(w.x) * rinv * g0[0], bfhi(w.x) * rinv * g0[1]); o.y = pk2(bflo(w.y) * rinv * g0[2], bfhi(w.y) * rinv * g0[3]);
            o.z = pk2(bflo(w.z) * rinv * g1[0], bfhi(w.z) * rinv * g1[1]); o.w = pk2(bflo(w.w) * rinv * g1[2], bfhi(w.w) * rinv * g1[3]);
            *(GAS v4u*)(MRG + (rowb + t0 + i) * 1024 + 512 + c8 * 8) = o; }
    }
    __syncthreads();
}
template <bool FINAL> __device__ __forceinline__ void lru_phase(Frame& F) { for (int it = F.vcu; it < BATCH * 32; it += F.G) lru_item<FINAL>(F, it >> 5, it & 31); }

__device__ __forceinline__ void p6_phase(Frame& F) {
    const float* x = F.in(0); const float* gpost = F.in(5); const float* gffn = F.in(18); const float* w_router = F.in(20); const float* b_router = F.in(21);
    const float* MOD = (const float*)(F.ws + WS_MOD); const float* Y = (const float*)(F.ws + WS_Y); bf16* H2 = (bf16*)(F.ws + WS_H2);
    int* TOPI = (int*)(F.ws + WS_TOPI); float* TOPW = (float*)(F.ws + WS_TOPW); int* WGCNT = (int*)(F.ws + WS_WGCNT);
    LAS float* wrl = (LAS float*)F.lds;
    LAS int* hist = (LAS int*)(F.lds + 131072);
    for (int i = F.tid; i < NE * DM; i += NWAVES * 64) { const int e = i >> 10, k = i & 1023; wrl[i] = w_router[k * NE + e]; }
    if (F.tid < NE) hist[F.tid] = 0;
    __syncthreads();
    if (F.G * 64 == NTOK) {
    const int bx = blockIdx.x, row0 = bx * 64 + F.wave * 8, b = row0 / SEQ;
    f32x4 gpm[4], gf[4], shf[4];
#pragma unroll
    for (int j = 0; j < 4; ++j) { const int k = 4 * F.lane + 256 * j; const float* mb = MOD + b * NMOD * DM + k;
        gpm[j] = *(const f32x4*)(mb + 2 * DM) * *(const f32x4*)(gpost + k); gf[j] = *(const f32x4*)(gffn + k) * (*(const f32x4*)(mb + 4 * DM) + 1.0f); shf[j] = *(const f32x4*)(mb + 3 * DM); }
    for (int rp = 0; rp < 4; ++rp) {
        f32x4 hv[2][4];
#pragma unroll
        for (int u = 0; u < 2; ++u) { const int row = row0 + 2 * rp + u;
            f32x4 yv[4]; float ss = 0.f;
#pragma unroll
            for (int j = 0; j < 4; ++j) { yv[j] = *(const f32x4*)(Y + (size_t)row * DM + 4 * F.lane + 256 * j); ss += (yv[j][0] * yv[j][0] + yv[j][1] * yv[j][1]) + (yv[j][2] * yv[j][2] + yv[j][3] * yv[j][3]); }
            const float rinv = 1.0f / sqrtf(wave_sum(ss) * (1.0f / DM) + RMS_EPS);
            float s2 = 0.f;
#pragma unroll
            for (int j = 0; j < 4; ++j) { const f32x4 xm = *(const f32x4*)(x + (size_t)row * DM + 4 * F.lane + 256 * j) + gpm[j] * (yv[j] * rinv);
                *(f32x4*)(F.out + (size_t)row * DM + 4 * F.lane + 256 * j) = xm; yv[j] = xm; s2 += (xm[0] * xm[0] + xm[1] * xm[1]) + (xm[2] * xm[2] + xm[3] * xm[3]); }
            const float rinv2 = 1.0f / sqrtf(wave_sum(s2) * (1.0f / DM) + RMS_EPS);
#pragma unroll
            for (int j = 0; j < 4; ++j) { const f32x4 h = yv[j] * rinv2 * gf[j] + shf[j]; hv[u][j] = h;
                v2u o; o.x = pk2(h[0], h[1]); o.y = pk2(h[2], h[3]); *(GAS v2u*)(H2 + (size_t)row * DM + 4 * F.lane + 256 * j) = o; }
        }
        float pa[32], pb[32];
#pragma unroll
        for (int e = 0; e < 32; ++e) { float sa = 0.f, sb = 0.f;
#pragma unroll
            for (int j = 0; j < 4; ++j) { const f32x4 w = *(const LAS f32x4*)(wrl + e * DM + 4 * F.lane + 256 * j);
                sa += (hv[0][j][0] * w[0] + hv[0][j][1] * w[1]) + (hv[0][j][2] * w[2] + hv[0][j][3] * w[3]); sb += (hv[1][j][0] * w[0] + hv[1][j][1] * w[1]) + (hv[1][j][2] * w[2] + hv[1][j][3] * w[3]); }
            pa[e] = sa; pb[e] = sb; }
#define TR_STEP(N, OFF, BIT) _Pragma("unroll") for (int i = 0; i < N; ++i) { const bool up = (F.lane & BIT) != 0; \
            const float ka = up ? pa[N + i] : pa[i], sa_ = up ? pa[i] : pa[N + i], kb = up ? pb[N + i] : pb[i], sb_ = up ? pb[i] : pb[N + i]; \
            pa[i] = ka + __shfl_xor(sa_, OFF); pb[i] = kb + __shfl_xor(sb_, OFF); }
        TR_STEP(16, 32, 32) TR_STEP(8, 16, 16) TR_STEP(4, 8, 8) TR_STEP(2, 4, 4) TR_STEP(1, 2, 2)
#undef TR_STEP
        const int e = (F.lane >> 1) & 31; const float br = b_router[e];
#pragma unroll
        for (int u = 0; u < 2; ++u) { const int row = row0 + 2 * rp + u; float v = (u ? pb[0] : pa[0]); v += __shfl_xor(v, 1); v += br;
            int rank = 0;
#pragma unroll
            for (int j = 0; j < 32; ++j) { const float vj = __uint_as_float((unsigned)__builtin_amdgcn_readlane((int)__float_as_uint(v), 2 * j)); rank += (vj > v || (vj == v && j < e)) ? 1 : 0; }
            const bool sel = rank < TOPK; const float vmax = wave_max(v); const float ex = sel ? __expf(v - vmax) : 0.f; const float den = wave_sum(ex) * 0.5f;
            if (sel && !(F.lane & 1)) { TOPI[(size_t)row * TOPK + rank] = e; TOPW[(size_t)row * TOPK + rank] = ex / den; __hip_atomic_fetch_add((LAS int*)&hist[e], 1, __ATOMIC_RELAXED, __HIP_MEMORY_SCOPE_WORKGROUP); } }
    }
    __syncthreads();
    if (F.tid < NE) WGCNT[bx * NE + F.tid] = hist[F.tid];
    }
}

__device__ __forceinline__ void p7_phase(Frame& F) {
    const int* TOPI = (const int*)(F.ws + WS_TOPI); const float* TOPW = (const float*)(F.ws + WS_TOPW); const int* WGCNT = (const int*)(F.ws + WS_WGCNT);
    int* ROWTOK = (int*)(F.ws + WS_ROWTOK); int* ROWPAIR = (int*)(F.ws + WS_ROWPAIR); float* ROWW = (float*)(F.ws + WS_ROWW); int* MTEXP = (int*)(F.ws + WS_MTEXP);
    LAS int* ptot = (LAS int*)F.lds; LAS int* pbef = ptot + 512; LAS int* cnt = pbef + 512; LAS int* wgb = cnt + 32; LAS int* pst = wgb + 32; LAS int* pad = pst + 64; LAS int* ep = pad + 32;
    if (F.G != 256) return;
    const int bx = blockIdx.x;
    { const int e = F.tid & 31, part = F.tid >> 5; int tt = 0, tb = 0;
      for (int w = part * 16; w < part * 16 + 16; ++w) { const int v = WGCNT[w * NE + e]; tt += v; tb += (w < bx) ? v : 0; }
      ptot[part * 32 + e] = tt; pbef[part * 32 + e] = tb; }
    __syncthreads();
    if (F.tid < NE) { int tt = 0, tb = 0; for (int p = 0; p < 16; ++p) { tt += ptot[p * 32 + F.tid]; tb += pbef[p * 32 + F.tid]; } cnt[F.tid] = tt; wgb[F.tid] = tb; pad[F.tid] = (tt + 255) & ~255; }
    __syncthreads();
    if (F.tid == 0) { int s = 0; for (int e = 0; e < NE; ++e) { pst[e] = s; s += pad[e]; } pst[NE] = s; }
    if (F.tid < 256) ep[F.tid] = TOPI[(size_t)bx * 256 + F.tid];
    __syncthreads();
    if (F.tid < 256) { const int p = F.tid, e = ep[p]; int rk = 0; for (int q = 0; q < p; ++q) rk += (ep[q] == e) ? 1 : 0;
        const int dest = pst[e] + wgb[e] + rk; const int pair = bx * 256 + p; ROWTOK[dest] = pair >> 2; ROWPAIR[dest] = pair; ROWW[dest] = TOPW[pair]; }
    if (bx < NE) { const int e = bx; for (int i = pst[e] + cnt[e] + F.tid; i < pst[e] + pad[e]; i += NWAVES * 64) { ROWTOK[i] = 0; ROWPAIR[i] = -1; ROWW[i] = 0.f; } }
    if (bx == 0) { if (F.tid < NE) { for (int mt = pst[F.tid] >> 8; mt < (pst[F.tid] + pad[F.tid]) >> 8; ++mt) MTEXP[mt] = F.tid; } if (F.tid == 0) MTEXP[512] = pst[NE] >> 8; }
}

__device__ __forceinline__ void p10_phase(Frame& F) {
    const float* gpost = F.in(19); const float* MOD = (const float*)(F.ws + WS_MOD); const bf16* YP = (const bf16*)(F.ws + WS_YP);
    const int gw = F.vcu * NWAVES + F.wave;
    if (F.G * NWAVES * 8 != NTOK) return;
    const int row0 = gw * 8, b = row0 / SEQ;
    f32x4 gg[4];
#pragma unroll
    for (int j = 0; j < 4; ++j) { const int k = 4 * F.lane + 256 * j; gg[j] = *(const f32x4*)(MOD + b * NMOD * DM + 5 * DM + k) * *(const f32x4*)(gpost + k); }
    for (int r = 0; r < 8; ++r) { const int row = row0 + r;
        f32x4 y[4]; float ss = 0.f;
#pragma unroll
        for (int j = 0; j < 4; ++j) { f32x4 s = (f32x4){0.f, 0.f, 0.f, 0.f};
#pragma unroll
            for (int k = 0; k < TOPK; ++k) { const v2u w = *(const GAS v2u*)(YP + ((size_t)row * TOPK + k) * DM + 4 * F.lane + 256 * j); s += (f32x4){bflo(w.x), bfhi(w.x), bflo(w.y), bfhi(w.y)}; }
            y[j] = s; ss += (s[0] * s[0] + s[1] * s[1]) + (s[2] * s[2] + s[3] * s[3]); }
        const float rinv = 1.0f / sqrtf(wave_sum(ss) * (1.0f / DM) + RMS_EPS);
#pragma unroll
        for (int j = 0; j < 4; ++j) { float* op = F.out + (size_t)row * DM + 4 * F.lane + 256 * j; *(f32x4*)op = *(const f32x4*)op + gg[j] * (y[j] * rinv); }
    }
}

__global__ void __launch_bounds__(NWAVES * 64, 2) mega_fwd(Args args) {
    extern __shared__ __attribute__((aligned(16))) unsigned char lds[];
    Frame F;
    F.lds = (LAS unsigned char*)lds;
    F.tid = threadIdx.x; F.lane = F.tid & 63; F.wave = __builtin_amdgcn_readfirstlane(F.tid >> 6);
    F.G = gridDim.x; { const int bx = blockIdx.x; F.vcu = (F.G % 8 == 0) ? (bx % 8) * (F.G / 8) + bx / 8 : bx; }
    F.out = args.out; F.ws = args.ws;
    volatile LAS unsigned* MISC = (volatile LAS unsigned*)(F.lds + MISC_OFF);
    for (int u = F.tid; u < (LDS_BYTES - LDSCTL_OFF) / 4; u += NWAVES * 64) ((LAS unsigned*)(F.lds + LDSCTL_OFF))[u] = 0u;
    __syncthreads();
    if (F.tid < 26) ((LAS unsigned long long*)(F.lds + LDSCTL_OFF))[F.tid] = (unsigned long long)args.in[F.tid];
    __syncthreads();
    gu32* ctl = (gu32*)(F.ws + WS_CTL);
    XcdBarrier bar = xcd_barrier_post((unsigned*)(ctl + CW_BAR) + args.li * XCD_BAR_WORDS, MISC + 8);
    const int lo = args.ph_lo, hi = args.ph_hi;
#ifndef PHMASK
#define PHMASK 0x7ff
#endif
#define IN(k) (((PHMASK >> (k)) & 1) && lo <= (k) && (k) < hi)
#define SEAM(k) do { if (IN(k) && IN((k) + 1)) xcd_barrier(bar); } while (0)
#define REFRESH() do { int t_; asm volatile("v_mov_b32 %0, %1" : "=v"(t_) : "v"(threadIdx.x)); F.tid = t_; F.lane = t_ & 63; } while (0)
    if (IN(0)) { REFRESH(); p0_phase(F); } SEAM(0);
    if (IN(1)) { REFRESH(); p1_phase(F); } SEAM(1);
    if (IN(2)) { REFRESH();
        pg8::DenseOrder S; S.init((const pg8::bf16_t*)(F.ws + WS_H1), (const pg8::bf16_t*)(F.ws + WS_WIN), NTOK, NPJ, F.G, (int)blockIdx.x);
        pg8::EpiProj E{(pg8::bf16_t*)(F.ws + WS_PJ), PJ_STRIDE, attn_body::C2};
        pg8::gemm_phase<pg8::EpiProj, pg8::DenseOrder>(F.lds, S, E);
    } SEAM(2);
    if (IN(3)) { REFRESH();
        lru_phase<false>(F);
        const attn_body::AttnTensors AT{(const attn_body::bf16*)(F.ws + WS_PJ) + 2 * PJ_STRIDE, (const attn_body::bf16*)(F.ws + WS_PJ) + 3 * PJ_STRIDE, (const attn_body::bf16*)(F.ws + WS_PJ) + 4 * PJ_STRIDE,
                                        (attn_body::bf16*)(F.ws + WS_MRG), (const float*)(F.ws + WS_LOGF2), (float*)(F.ws + WS_SSQ)};
        const attn_body::StaticOrder S((int)F.G, F.vcu);
        attn_body::attn_phase<attn_body::StaticOrder>((char*)lds, AT, S);
    } SEAM(3);
    if (IN(4)) { REFRESH(); lru_phase<true>(F); } SEAM(4);
    if (IN(5)) { REFRESH();
        pg8::DenseOrder S; S.init((const pg8::bf16_t*)(F.ws + WS_MRG), (const pg8::bf16_t*)(F.ws + WS_WOUT), NTOK, DM, F.G, (int)blockIdx.x);
        pg8::EpiOut E{(float*)(F.ws + WS_Y), (const float*)(F.ws + WS_SSQ)};
        pg8::gemm_phase<pg8::EpiOut, pg8::DenseOrder>(F.lds, S, E);
    } SEAM(5);
    if (IN(6)) { REFRESH(); p6_phase(F); } SEAM(6);
    if (IN(7)) { REFRESH(); p7_phase(F); } SEAM(7);
    if (IN(8)) { REFRESH();
        const int nmt = ((const int*)(F.ws + WS_MTEXP))[512];
        pg8::UpOrder S{(const pg8::bf16_t*)(F.ws + WS_H2), (const pg8::bf16_t*)(F.ws + WS_WUP), (const int*)(F.ws + WS_ROWTOK), (const int*)(F.ws + WS_MTEXP), nmt * 8, F.G, F.vcu};
        pg8::EpiUp E{(pg8::bf16_t*)(F.ws + WS_ACT), F.in(23)};
        pg8::gemm_phase<pg8::EpiUp, pg8::UpOrder>(F.lds, S, E);
    } SEAM(8);
    if (IN(9)) { REFRESH();
        const int nmt = ((const int*)(F.ws + WS_MTEXP))[512];
        pg8::DownOrder S{(const pg8::bf16_t*)(F.ws + WS_ACT), (const pg8::bf16_t*)(F.ws + WS_WDN), (const int*)(F.ws + WS_MTEXP), nmt * 4, F.G, F.vcu};
        pg8::EpiDown E{(pg8::bf16_t*)(F.ws + WS_YP), F.in(25), (const int*)(F.ws + WS_ROWPAIR), (const float*)(F.ws + WS_ROWW)};
        pg8::gemm_phase<pg8::EpiDown, pg8::DownOrder>(F.lds, S, E);
    } SEAM(9);
    if (IN(10)) { REFRESH(); p10_phase(F); }
#undef IN
#undef SEAM
#undef REFRESH
}

static void launch_mega(hipStream_t stream, void* const* d_in, void* d_out, void* d_ws, int lo, int hi, int li, int grid) {
    Args a{};
    for (int i = 0; i < 26; ++i) a.in[i] = (const float*)d_in[i];
    a.out = (float*)d_out; a.ws = (unsigned char*)d_ws; a.ph_lo = lo; a.ph_hi = hi; a.li = li; a.pad = 0;
    hipLaunchKernelGGL(mega_fwd, dim3(grid), dim3(NWAVES * 64), LDS_BYTES, stream, a);
}

#if MIX < 4
namespace simple {
__device__ __forceinline__ float sigmoidf_(float x) { return 1.f / (1.f + __expf(-x)); }
__device__ __forceinline__ float gelu_tanh(float x) { const float u = 0.7978845608028654f * (x + 0.044715f * x * x * x); return 0.5f * x * (1.f + tanhf(u)); }
__device__ __forceinline__ float log_sigmoid(float z) { return z >= 0.f ? -log1pf(expf(-z)) : z - log1pf(expf(z)); }
__device__ __forceinline__ float softplusf_(float z) { return z > 0.f ? z + log1pf(expf(-z)) : log1pf(expf(z)); }

__device__ __forceinline__ float block_sum_256(float v, float* red) {
    for (int o = 32; o > 0; o >>= 1) v += __shfl_xor(v, o);
    const int w = threadIdx.x >> 6, l = threadIdx.x & 63;
    __syncthreads();
    if (l == 0) red[w] = v;
    __syncthreads();
    return red[0] + red[1] + red[2] + red[3];
}

__global__ void k_ada(const float* c, const float* w_ada, const float* b_ada, float* mod) {
    const int j = blockIdx.x * 256 + threadIdx.x, b = blockIdx.y;
    float acc = b_ada[j];
    for (int k = 0; k < DM; ++k) { const float cv = c[b * DM + k]; acc += cv * sigmoidf_(cv) * w_ada[(size_t)k * (NMOD * DM) + j]; }
    mod[b * NMOD * DM + j] = acc;
}

__global__ void k_prep(const float* x, const float* g, const float* mod, int sh_off, int sc_off, float* h) {
    __shared__ float red[4];
    const int row = blockIdx.x, b = row / SEQ;
    const float* xr = x + (size_t)row * DM;
    float v[4], s = 0.f;
#pragma unroll
    for (int i = 0; i < 4; ++i) { v[i] = xr[threadIdx.x + 256 * i]; s += v[i] * v[i]; }
    const float tot = block_sum_256(s, red);
    const float rinv = rsqrtf(tot / DM + RMS_EPS);
#pragma unroll
    for (int i = 0; i < 4; ++i) { const int k = threadIdx.x + 256 * i;
        h[(size_t)row * DM + k] = v[i] * rinv * g[k] * (1.f + mod[b * NMOD * DM + sc_off + k]) + mod[b * NMOD * DM + sh_off + k]; }
}

struct GemmArgs { const float* A; const float* B; float* C; const float* bias; const int* rowidx; const int* Mptr; int M, N, K, lda, ldb, ldc;
                  size_t gB, gC, gbias; int gidx; };
__global__ void __launch_bounds__(256) k_sgemm(GemmArgs a) {
    __shared__ float As[8][128 + 4], Bs[8][128 + 4];
    const int z = blockIdx.z;
    const float* B = a.B + z * a.gB; float* C = a.C + z * a.gC; const float* bias = a.bias ? a.bias + z * a.gbias : nullptr;
    const int* rowidx = a.rowidx ? a.rowidx + (size_t)z * a.gidx : nullptr;
    const int M = a.Mptr ? a.Mptr[z] : a.M;
    const int m0 = blockIdx.y * 128, n0 = blockIdx.x * 128;
    if (m0 >= M) return;
    const int tid = threadIdx.x, tx = tid & 15, ty = tid >> 4;
    float acc[8][8];
#pragma unroll
    for (int i = 0; i < 8; ++i)
#pragma unroll
        for (int j = 0; j < 8; ++j) acc[i][j] = 0.f;
    const int ar = tid >> 1, ak = (tid & 1) * 4;
    const int am = m0 + ar; const bool aok = am < M;
    const int arow = aok ? (rowidx ? rowidx[am] : am) : 0;
    const float* Ap = a.A + (size_t)arow * a.lda + ak;
    const int bk = tid >> 5, bn = (tid & 31) * 4;
    for (int k0 = 0; k0 < a.K; k0 += 8) {
        float4 av = aok ? *(const float4*)(Ap + k0) : make_float4(0.f, 0.f, 0.f, 0.f);
        float bv[4];
#pragma unroll
        for (int j = 0; j < 4; ++j) { const int n = n0 + bn + j; bv[j] = n < a.N ? B[(size_t)(k0 + bk) * a.ldb + n] : 0.f; }
        __syncthreads();
        As[ak + 0][ar] = av.x; As[ak + 1][ar] = av.y; As[ak + 2][ar] = av.z; As[ak + 3][ar] = av.w;
#pragma unroll
        for (int j = 0; j < 4; ++j) Bs[bk][bn + j] = bv[j];
        __syncthreads();
#pragma unroll
        for (int k = 0; k < 8; ++k) {
            float af[8], bf[8];
#pragma unroll
            for (int i = 0; i < 8; ++i) af[i] = As[k][ty * 8 + i];
#pragma unroll
            for (int j = 0; j < 8; ++j) bf[j] = Bs[k][tx * 8 + j];
#pragma unroll
            for (int i = 0; i < 8; ++i)
#pragma unroll
                for (int j = 0; j < 8; ++j) acc[i][j] += af[i] * bf[j];
        }
    }
#pragma unroll
    for (int i = 0; i < 8; ++i) { const int m = m0 + ty * 8 + i; if (m >= M) continue;
#pragma unroll
        for (int j = 0; j < 8; ++j) { const int n = n0 + tx * 8 + j; if (n < a.N) C[(size_t)m * a.ldc + n] = acc[i][j] + (bias ? bias[n] : 0.f); } }
}

__global__ void __launch_bounds__(64) k_lru(const float* proj, const float* conv_w, const float* conv_b, const float* wa, const float* ba, const float* wx, const float* bx,
                                            const float* lam, float* lru_out) {
    __shared__ float xc[64];
    const int b = blockIdx.x >> 3, g = blockIdx.x & 7, j = threadIdx.x, ch = g * 64 + j;
    float wac[64], wxc[64];
#pragma unroll
    for (int i = 0; i < 64; ++i) { wac[i] = wa[(g * 64 + i) * 64 + j]; wxc[i] = wx[(g * 64 + i) * 64 + j]; }
    const float cw0 = conv_w[0 * DLRU + ch], cw1 = conv_w[1 * DLRU + ch], cw2 = conv_w[2 * DLRU + ch], cw3 = conv_w[3 * DLRU + ch], cb = conv_b[ch];
    const float baj = ba[ch], bxj = bx[ch], sp = softplusf_(-lam[ch]);
    float x1 = 0.f, x2 = 0.f, x3 = 0.f, h = 0.f;
    for (int t = 0; t < SEQ; ++t) {
        const size_t row = (size_t)b * SEQ + t;
        const float x0 = proj[row * NPROJ + ch];
        const float y = proj[row * NPROJ + DLRU + ch];
        const float xcv = cw0 * x3 + cw1 * x2 + cw2 * x1 + cw3 * x0 + cb;
        x3 = x2; x2 = x1; x1 = x0;
        __syncthreads();
        xc[j] = xcv;
        __syncthreads();
        float ra = baj, ri = bxj;
#pragma unroll
        for (int i = 0; i < 64; ++i) { const float xi = xc[i]; ra += xi * wac[i]; ri += xi * wxc[i]; }
        const float r = sigmoidf_(ra), ig = sigmoidf_(ri);
        const float log_a = -8.0f * r * sp;
        const float av = expf(log_a);
        const float gx = sqrtf(1.f - expf(2.f * log_a)) * (ig * xcv);
        h = av * h + gx;
        lru_out[row * DLRU + ch] = h * gelu_tanh(y);
    }
}

__global__ void k_cum(const float* proj, const float* fb, float* cum) {
    const int b = blockIdx.x, h = threadIdx.x;
    float c = 0.f;
    for (int t = 0; t < SEQ; ++t) { c += log_sigmoid(proj[((size_t)b * SEQ + t) * NPROJ + 2 * DLRU + 3 * DATT + h] + fb[h]); cum[((size_t)b * NH + h) * SEQ + t] = c; }
}
__global__ void __launch_bounds__(256) k_attn(const float* proj, const float* cum, float* attn_out) {
    __shared__ float Ks[64][64], Vs[64][64], Cs[64];
    const int qb = blockIdx.x, h = blockIdx.y, b = blockIdx.z, t = qb * 256 + threadIdx.x;
    const size_t rowq = (size_t)b * SEQ + t;
    float q[64], acc[64];
#pragma unroll
    for (int d = 0; d < 64; ++d) { q[d] = proj[rowq * NPROJ + 2 * DLRU + h * 64 + d] * 0.125f; acc[d] = 0.f; }
    const float ct = cum[((size_t)b * NH + h) * SEQ + t];
    float m = -INFINITY, l = 0.f;
    const int send = qb * 256 + 256;
    for (int s0 = 0; s0 < send; s0 += 64) {
        __syncthreads();
        for (int i = threadIdx.x; i < 64 * 64; i += 256) { const int r = i >> 6, d = i & 63; const size_t rk = (size_t)b * SEQ + s0 + r;
            Ks[r][d] = proj[rk * NPROJ + 2 * DLRU + DATT + h * 64 + d]; Vs[r][d] = proj[rk * NPROJ + 2 * DLRU + 2 * DATT + h * 64 + d]; }
        if (threadIdx.x < 64) Cs[threadIdx.x] = cum[((size_t)b * NH + h) * SEQ + s0 + threadIdx.x];
        __syncthreads();
        for (int r = 0; r < 64; ++r) {
            const int s = s0 + r; if (s > t) break;
            float dot = 0.f;
#pragma unroll
            for (int d = 0; d < 64; ++d) dot += q[d] * Ks[r][d];
            const float lg = dot + ct - Cs[r];
            const float mn = fmaxf(m, lg), sc = expf(m - mn), p = expf(lg - mn);
            l = l * sc + p;
#pragma unroll
            for (int d = 0; d < 64; ++d) acc[d] = acc[d] * sc + p * Vs[r][d];
            m = mn;
        }
    }
    const float li = 1.f / l;
#pragma unroll
    for (int d = 0; d < 64; ++d) attn_out[rowq * DATT + h * 64 + d] = acc[d] * li;
}

__global__ void k_merge(const float* lru_out, const float* attn_out, const float* gn_lru, const float* gn_attn, float* merged) {
    __shared__ float red[4];
    const int row = blockIdx.x, tid = threadIdx.x;
    const float a0 = lru_out[(size_t)row * DLRU + tid], a1 = lru_out[(size_t)row * DLRU + 256 + tid];
    const float b0 = attn_out[(size_t)row * DATT + tid], b1 = attn_out[(size_t)row * DATT + 256 + tid];
    const float sa = block_sum_256(a0 * a0 + a1 * a1, red);
    const float sb = block_sum_256(b0 * b0 + b1 * b1, red);
    const float ra = rsqrtf(sa / DLRU + RMS_EPS), rb = rsqrtf(sb / DATT + RMS_EPS);
    float* o = merged + (size_t)row * DM;
    o[tid] = a0 * ra * gn_lru[tid]; o[256 + tid] = a1 * ra * gn_lru[256 + tid];
    o[512 + tid] = b0 * rb * gn_attn[tid]; o[768 + tid] = b1 * rb * gn_attn[256 + tid];
}

__global__ void k_resid(const float* xin, const float* y, const float* gpost, const float* mod, int gate_off, float* xo) {
    __shared__ float red[4];
    const int row = blockIdx.x, b = row / SEQ;
    float v[4], s = 0.f;
#pragma unroll
    for (int i = 0; i < 4; ++i) { v[i] = y[(size_t)row * DM + threadIdx.x + 256 * i]; s += v[i] * v[i]; }
    const float rinv = rsqrtf(block_sum_256(s, red) / DM + RMS_EPS);
#pragma unroll
    for (int i = 0; i < 4; ++i) { const int k = threadIdx.x + 256 * i;
        xo[(size_t)row * DM + k] = xin[(size_t)row * DM + k] + mod[b * NMOD * DM + gate_off + k] * (v[i] * rinv * gpost[k]); }
}

__global__ void k_route(const float* logits, int* cnt, int* list_tok, int* list_pair, float* pair_w) {
    const int tok = blockIdx.x * 256 + threadIdx.x;
    float lg[NE];
#pragma unroll
    for (int e = 0; e < NE; ++e) lg[e] = logits[(size_t)tok * NE + e];
    int idx[TOPK]; float val[TOPK];
#pragma unroll
    for (int k = 0; k < TOPK; ++k) { int bi = 0; float bv = -INFINITY;
#pragma unroll
        for (int e = 0; e < NE; ++e) { if (lg[e] > bv) { bv = lg[e]; bi = e; } }
        idx[k] = bi; val[k] = bv;
#pragma unroll
        for (int e = 0; e < NE; ++e) if (e == bi) lg[e] = -INFINITY; }
    float den = 0.f; float p[TOPK];
#pragma unroll
    for (int k = 0; k < TOPK; ++k) { p[k] = expf(val[k] - val[0]); den += p[k]; }
#pragma unroll
    for (int k = 0; k < TOPK; ++k) { const int e = idx[k]; const int pos = atomicAdd(&cnt[e], 1);
        list_tok[(size_t)e * NTOK + pos] = tok; list_pair[(size_t)e * NTOK + pos] = tok * TOPK + k; pair_w[tok * TOPK + k] = p[k] / den; }
}
__global__ void k_act(const float* gu, const int* cnt, float* act) {
    const int e = blockIdx.z, pos = blockIdx.y; if (pos >= cnt[e]) return;
    const size_t r = (size_t)e * NTOK + pos;
    for (int j = threadIdx.x; j < DEXP; j += 256) { const float gl = fminf(gu[r * 2 * DEXP + j], 7.f); const float li = fminf(fmaxf(gu[r * 2 * DEXP + DEXP + j], -7.f), 7.f);
        act[r * DEXP + j] = gl * sigmoidf_(1.702f * gl) * (li + 1.f); }
}
__global__ void k_scatter(const float* dn, const int* cnt, const int* list_pair, float* ypair) {
    const int e = blockIdx.z, pos = blockIdx.y; if (pos >= cnt[e]) return;
    const size_t r = (size_t)e * NTOK + pos; const int pair = list_pair[r];
    for (int j = threadIdx.x; j < DM; j += 256) ypair[(size_t)pair * DM + j] = dn[r * DM + j];
}
__global__ void k_combine(const float* ypair, const float* pair_w, float* y) {
    const int tok = blockIdx.x;
    for (int j = threadIdx.x; j < DM; j += 256) { float s = 0.f; for (int k = 0; k < TOPK; ++k) s += pair_w[tok * TOPK + k] * ypair[((size_t)tok * TOPK + k) * DM + j]; y[(size_t)tok * DM + j] = s; }
}


__global__ void k_conv_proj(const float* proj, const float* fb, unsigned short* PJ, float* LOGF2) {
    const int row = blockIdx.x;
    for (int c = threadIdx.x; c < 2560; c += 256) { const int t = c >> 9, cc = c & 511; float v = proj[(size_t)row * NPROJ + c]; if (t == 2) v *= attn_body::C2; PJ[(size_t)t * PJ_STRIDE + (size_t)row * 512 + cc] = (unsigned short)f2bf(v); }
    if (threadIdx.x < 8) LOGF2[(size_t)row * 8 + threadIdx.x] = log_sigmoid(proj[(size_t)row * NPROJ + 2560 + threadIdx.x] + fb[threadIdx.x]) * 1.4426950408889634f;
}
__global__ void k_conv_mix(const float* lru_out, const float* attn_out, const float* gn_lru, unsigned short* MRG, float* SSQ) {
    __shared__ float red[4];
    const int row = blockIdx.x, tid = threadIdx.x;
    const float a0 = lru_out[(size_t)row * DLRU + tid], a1 = lru_out[(size_t)row * DLRU + 256 + tid];
    const float ra = rsqrtf(block_sum_256(a0 * a0 + a1 * a1, red) / DLRU + RMS_EPS);
    MRG[(size_t)row * 1024 + 512 + tid] = (unsigned short)f2bf(a0 * ra * gn_lru[tid]); MRG[(size_t)row * 1024 + 768 + tid] = (unsigned short)f2bf(a1 * ra * gn_lru[256 + tid]);
    for (int i = 0; i < 2; ++i) { const int c = tid + 256 * i; const unsigned short hb = (unsigned short)f2bf(attn_out[(size_t)row * DATT + c]); MRG[(size_t)row * 1024 + c] = hb;
        float q = bf1(hb); q = q * q; for (int o = 1; o < 64; o <<= 1) q += __shfl_xor(q, o); if ((tid & 63) == 0) SSQ[(size_t)row * 8 + (c >> 6)] = q; }
}
static void sgemm(hipStream_t st, const float* A, const float* B, float* C, const float* bias, int M, int N, int K, int lda, int ldb, int ldc) {
    GemmArgs a{}; a.A = A; a.B = B; a.C = C; a.bias = bias; a.M = M; a.N = N; a.K = K; a.lda = lda; a.ldb = ldb; a.ldc = ldc;
    hipLaunchKernelGGL(k_sgemm, dim3((N + 127) / 128, (M + 127) / 128, 1), dim3(256), 0, st, a);
}
}
#endif

extern "C" void kernel_launch(void* const* d_in, const int* in_sizes, int n_in, void* d_out, int out_size, void* d_ws, size_t ws_size, hipStream_t stream) {
    static int grid = 0;
    if (grid == 0) {
        int dev = 0, cus = 0;
        if (n_in != 26 || out_size != NTOK * DM || ws_size < WS_END) { fprintf(stderr, "kernel_launch: unexpected problem shape / workspace (%d inputs, out %d, ws %zu)\n", n_in, out_size, ws_size); grid = -1; return; }
        if (hipGetDevice(&dev) != hipSuccess || hipDeviceGetAttribute(&cus, hipDeviceAttributeMultiprocessorCount, dev) != hipSuccess) { grid = -1; return; }
        if (hipFuncSetAttribute((const void*)mega_fwd, hipFuncAttributeMaxDynamicSharedMemorySize, LDS_BYTES) != hipSuccess) { fprintf(stderr, "kernel_launch: hipFuncSetAttribute failed\n"); grid = -1; return; }
        grid = cus;
        if (grid != 256) fprintf(stderr, "kernel_launch: %d CUs; this kernel is laid out for 256\n", grid);
    }
    if (grid < 0) return;
    (void)hipMemsetAsync((char*)d_ws + WS_CTL, 0, CTL_ZERO_BYTES, stream);
#if MIX >= 4
    launch_mega(stream, d_in, d_out, d_ws, 0, NPHASES, 0, grid);
#else
    using namespace simple;
    const float* x = (const float*)d_in[0]; const float* c = (const float*)d_in[1]; const float* w_ada = (const float*)d_in[2]; const float* b_ada = (const float*)d_in[3];
    const float* g_mix_pre = (const float*)d_in[4]; const float* w_in = (const float*)d_in[6];
    const float* conv_w = (const float*)d_in[7]; const float* conv_b = (const float*)d_in[8]; const float* wa = (const float*)d_in[9]; const float* ba = (const float*)d_in[10];
    const float* wx = (const float*)d_in[11]; const float* bx = (const float*)d_in[12]; const float* lam = (const float*)d_in[13]; const float* fb = (const float*)d_in[14];
    const float* gn_lru = (const float*)d_in[15]; const float* gn_attn = (const float*)d_in[16]; const float* w_out = (const float*)d_in[17];
    char* ws = (char*)d_ws;
    float* mod_s = (float*)(ws + 7 * MiB);
    float* h1 = (float*)(ws + 416 * MiB); float* proj = (float*)(ws + 480 * MiB); float* lru_out = (float*)(ws + 641 * MiB); float* attn_out = (float*)(ws + 673 * MiB); float* cum = (float*)(ws + 705 * MiB);
    float* merged = h1; float* Yb = (float*)(ws + WS_Y);
    launch_mega(stream, d_in, d_out, d_ws, 0, 1, 0, grid);
    hipLaunchKernelGGL(k_ada, dim3(NMOD * DM / 256, BATCH), dim3(256), 0, stream, c, w_ada, b_ada, mod_s);
    hipLaunchKernelGGL(k_prep, dim3(NTOK), dim3(256), 0, stream, x, g_mix_pre, mod_s, 0 * DM, 1 * DM, h1);
    sgemm(stream, h1, w_in, proj, nullptr, NTOK, NPROJ, DM, DM, NPROJ, NPROJ);
#if MIX <= 2
    hipLaunchKernelGGL(k_lru, dim3(BATCH * 8), dim3(64), 0, stream, proj, conv_w, conv_b, wa, ba, wx, bx, lam, lru_out);
    hipLaunchKernelGGL(k_cum, dim3(BATCH), dim3(NH), 0, stream, proj, fb, cum);
    hipLaunchKernelGGL(k_attn, dim3(SEQ / 256, NH, BATCH), dim3(256), 0, stream, proj, cum, attn_out);
#endif
#if MIX == 1
    hipLaunchKernelGGL(k_merge, dim3(NTOK), dim3(256), 0, stream, lru_out, attn_out, gn_lru, gn_attn, merged);
    sgemm(stream, merged, w_out, Yb, nullptr, NTOK, DM, DM, DM, DM, DM);
    launch_mega(stream, d_in, d_out, d_ws, 6, NPHASES, 1, grid);
#elif MIX == 2
    hipLaunchKernelGGL(k_conv_mix, dim3(NTOK), dim3(256), 0, stream, lru_out, attn_out, gn_lru, (unsigned short*)(ws + WS_MRG), (float*)(ws + WS_SSQ));
    launch_mega(stream, d_in, d_out, d_ws, 5, NPHASES, 1, grid);
#elif MIX == 3
    hipLaunchKernelGGL(k_conv_proj, dim3(NTOK), dim3(256), 0, stream, proj, fb, (unsigned short*)(ws + WS_PJ), (float*)(ws + WS_LOGF2));
    launch_mega(stream, d_in, d_out, d_ws, 3, NPHASES, 1, grid);
#endif
    (void)gn_attn; (void)w_out; (void)cum; (void)lru_out; (void)attn_out; (void)merged; (void)Yb;
#endif
}
```

```cpp
#include <hip/hip_runtime.h>
#include <hip/hip_bf16.h>
#include <cstdio>
#include <cstdint>
#include <cmath>

#define MIX 4

constexpr int DM = 1024, BATCH = 8, SEQ = 2048, NTOK = BATCH * SEQ;
constexpr int DLRU = 512, DATT = 512, NH = 8, HD = 64, NPROJ = 2 * DLRU + 3 * DATT + NH, NPJ = 2560;
constexpr int NE = 32, TOPK = 4, DEXP = 1024, NMOD = 6;
constexpr float RMS_EPS = 1e-6f;
constexpr int MAXROWS = NTOK * TOPK + NE * 256;
constexpr int MAXMT = MAXROWS / 256;

namespace pg8 {
#define PG8_LAS __attribute__((address_space(3)))
typedef unsigned short bf16_t;
typedef short bf16x8 __attribute__((ext_vector_type(8)));
typedef float f32x4 __attribute__((ext_vector_type(4)));
typedef float f32x2 __attribute__((ext_vector_type(2)));
typedef unsigned u32x4 __attribute__((ext_vector_type(4)));
constexpr int BM = 256, BK = 64, HALF = 128, HTB = HALF * BK * 2  , STAGE_BYTES = 8 * HTB, NXCD = 8, WGM = 8;
constexpr int GK = 1024, GNT = GK / BK;
typedef int i32x8 __attribute__((ext_vector_type(8)));
typedef int i32x4 __attribute__((ext_vector_type(4)));
constexpr int F8_SCALE_W = 0x79797979, F8_SCALE_A = 0x7f7f7f7f;

__host__ __device__ __forceinline__ int lds_byte(int r, int c) { const int st = (r >> 4) * 2 + (c >> 5), rr = r & 15, cc = c & 31, ob = rr * 64 + cc * 2; return st * 1024 + (ob ^ (((ob >> 9) & 1) << 5)); }
__host__ __device__ __forceinline__ void stage_rc(int b, int& R, int& C) { const int st = b / 1024, sb = b % 1024, swz = sb ^ (((sb >> 9) & 1) << 5); R = (st >> 1) * 16 + swz / 64; C = (st & 1) * 32 + (swz % 64) / 2; }
__host__ __device__ __forceinline__ int perm32(int rho) { const int n = rho >> 4, i = rho & 15; return 8 * (i >> 2) + 4 * n + (i & 3); }

struct Unit { const char* A0; const char* A1; const char* B0; const char* B1; int pm, pn, e; };

__device__ __forceinline__ void mfma_f8_acc(f32x4& acc, const i32x8& b, const i32x8& a, int sw, int sa) {
    asm volatile("v_mfma_scale_f32_16x16x128_f8f6f4 %0, %1, %2, %0, %3, %4 op_sel_hi:[0,0,0]" : "+v"(acc) : "v"(b), "v"(a), "v"(sw), "v"(sa)); }
__device__ __forceinline__ unsigned cvt_pk_bf16(float lo, float hi) { unsigned r; asm volatile("v_cvt_pk_bf16_f32 %0, %1, %2" : "=v"(r) : "v"(lo), "v"(hi)); return r; }

template <class Epi, class Sched, bool F8 = false>
__device__ __forceinline__ void gemm_phase(PG8_LAS unsigned char* lds, const Sched& S, const Epi& E) {
    const int tid = threadIdx.x, wid = __builtin_amdgcn_readfirstlane(tid >> 6), lane = tid & 63, wr = wid >> 2, wc = wid & 3, fr = lane & 15, fq = lane >> 4;
    constexpr int KB = F8 ? GK : GK * 2, nt = F8 ? GK / 128 : GNT;
    int Rr[2], Cc[2];
    unsigned voffB[2], cvA[2][2], nvA[2][2];
#pragma unroll
    for (int i = 0; i < 2; ++i) { stage_rc(tid * 16 + i * 8192, Rr[i], Cc[i]); const int Rb = Epi::PERM ? ((Rr[i] & ~31) + perm32(Rr[i] & 31)) : Rr[i]; voffB[i] = (unsigned)(Rb * KB + Cc[i] * 2); }
    constexpr size_t kstep = (size_t)(BK * 2);
    const unsigned ldsw = (unsigned)wid * 1024u;
    const int aoff = lds_byte(wr * 64 + fr, fq * 8), boff = lds_byte(wc * 32 + fr, fq * 8);
#define PG8_SA(b, h) (((b) * 2 + (h)) * HTB)
#define PG8_SB(b, h) ((4 + (b) * 2 + (h)) * HTB)
#define PG8_STAGE(bufoff, gbase, voff) do { _Pragma("unroll") for (int _i = 0; _i < 2; ++_i) \
        __builtin_amdgcn_global_load_lds((const unsigned*)((const char*)(gbase) + (voff)[_i]), (PG8_LAS unsigned*)(lds + (bufoff) + ldsw + _i * 8192), 16, 0, 0); } while (0)
#define PG8_LD8(p) __builtin_shufflevector(*(const PG8_LAS i32x4*)(p), *(const PG8_LAS i32x4*)((p) + 1024), 0, 1, 2, 3, 4, 5, 6, 7)
#define PG8_LDA(dst, b, h) do { _Pragma("unroll") for (int m = 0; m < 4; ++m) { if constexpr (F8) { dst##8[m] = PG8_LD8(lds + PG8_SA(b, h) + aoff + m * 2048); } \
        else { _Pragma("unroll") for (int k = 0; k < 2; ++k) dst[m][k] = *(const PG8_LAS bf16x8*)(lds + PG8_SA(b, h) + aoff + m * 2048 + k * 1024); } } } while (0)
#define PG8_LDB(dst, b, h) do { _Pragma("unroll") for (int n = 0; n < 2; ++n) { if constexpr (F8) { dst##8[n] = PG8_LD8(lds + PG8_SB(b, h) + boff + n * 2048); } \
        else { _Pragma("unroll") for (int k = 0; k < 2; ++k) dst[n][k] = *(const PG8_LAS bf16x8*)(lds + PG8_SB(b, h) + boff + n * 2048 + k * 1024); } } } while (0)
#define PG8_MMA(ai, bj, At, Bt) do { __builtin_amdgcn_s_setprio(1); _Pragma("unroll") for (int m = 0; m < 4; ++m) _Pragma("unroll") for (int n = 0; n < 2; ++n) { \
        if constexpr (F8) { mfma_f8_acc(acc[ai][bj][m][n], Bt##8[n], At##8[m], scw, sca); } \
        else { _Pragma("unroll") for (int k = 0; k < 2; ++k) acc[ai][bj][m][n] = __builtin_amdgcn_mfma_f32_16x16x32_bf16(Bt[n][k], At[m][k], acc[ai][bj][m][n], 0, 0, 0); } } \
        __builtin_amdgcn_s_setprio(0); } while (0)
#define PG8_WAIT_V(n) asm volatile("s_waitcnt vmcnt(" #n ")" ::: "memory")
#define PG8_WAIT_L(n) asm volatile("s_waitcnt lgkmcnt(" #n ")" ::: "memory")
#define PG8_BAR __builtin_amdgcn_s_barrier()
#define PG8_SCHED __builtin_amdgcn_sched_barrier(0)
#define PG8_VOFF(dst, u) do { _Pragma("unroll") for (int _h = 0; _h < 2; ++_h) _Pragma("unroll") for (int _i = 0; _i < 2; ++_i) { \
        const int _row = Sched::GATHER ? S.row_of(u, _h * HALF + Rr[_i]) : Rr[_i]; dst[_h][_i] = (unsigned)(_row * KB + Cc[_i] * 2); } } while (0)
    Unit cur, nxt; int ui = 0;
    if (!S.next(0, cur)) return;
    f32x4 acc[2][2][4][2];
#pragma unroll
    for (int a = 0; a < 2; ++a)
#pragma unroll
        for (int b = 0; b < 2; ++b)
#pragma unroll
            for (int m = 0; m < 4; ++m)
#pragma unroll
                for (int n = 0; n < 2; ++n) acc[a][b][m][n] = (f32x4){0.f, 0.f, 0.f, 0.f};
    const int scw = F8_SCALE_W, sca = F8_SCALE_A;
    bf16x8 At[4][2], B0[2][2], B1[2][2]; i32x8 At8[4], B08[2], B18[2];
    PG8_VOFF(cvA, cur);
    if (Sched::GATHER) { asm volatile("s_waitcnt vmcnt(0)" ::: "memory"); }
    PG8_STAGE(PG8_SB(0, 0), cur.B0, voffB); PG8_STAGE(PG8_SB(0, 1), cur.B1, voffB); PG8_STAGE(PG8_SA(0, 0), cur.A0, cvA[0]); PG8_STAGE(PG8_SA(0, 1), cur.A1, cvA[1]);
    if (wr == 1) PG8_BAR;
    PG8_WAIT_V(2); PG8_BAR;
    PG8_STAGE(PG8_SB(1, 0), cur.B0 + kstep, voffB); PG8_STAGE(PG8_SA(1, 0), cur.A0 + kstep, cvA[0]); PG8_STAGE(PG8_SB(1, 1), cur.B1 + kstep, voffB);
    PG8_WAIT_V(6); PG8_BAR;
    for (;;) {
        const bool has_next = S.next(ui + 1, nxt);
        if (!has_next) nxt = cur;
        if (has_next) { PG8_VOFF(nvA, nxt); }
        else {
#pragma unroll
            for (int _h = 0; _h < 2; ++_h)
#pragma unroll
                for (int _i = 0; _i < 2; ++_i) nvA[_h][_i] = cvA[_h][_i]; }
#pragma unroll 1
        for (int t = 0; t < nt; t += 2) {
            const bool last = (t == nt - 2);
            if (Epi::MID && t == nt / 2) E.mid(acc, cur, wr, wc, fr, fq);
            const char* a1_1 = cur.A1 + (size_t)(t + 1) * kstep;
            const char* a2_0 = last ? nxt.A0 : cur.A0 + (size_t)(t + 2) * kstep; const char* a2_1 = last ? nxt.A1 : cur.A1 + (size_t)(t + 2) * kstep;
            const char* b2_0 = last ? nxt.B0 : cur.B0 + (size_t)(t + 2) * kstep; const char* b2_1 = last ? nxt.B1 : cur.B1 + (size_t)(t + 2) * kstep;
            const char* a3_0 = a2_0 + kstep; const char* a3_1 = a2_1 + kstep; const char* b3_0 = b2_0 + kstep; const char* b3_1 = b2_1 + kstep;
            unsigned sv0[2], sv1[2];
#pragma unroll
            for (int _i = 0; _i < 2; ++_i) { sv0[_i] = last ? nvA[0][_i] : cvA[0][_i]; sv1[_i] = last ? nvA[1][_i] : cvA[1][_i]; }
            PG8_LDB(B0, 0, 0); PG8_LDB(B1, 0, 1); PG8_SCHED; PG8_LDA(At, 0, 0); PG8_STAGE(PG8_SA(1, 1), a1_1, cvA[1]);
            PG8_WAIT_V(8); PG8_WAIT_L(0); PG8_BAR; PG8_MMA(0, 0, At, B0); PG8_MMA(0, 1, At, B1); PG8_BAR; PG8_SCHED;
            PG8_LDA(At, 0, 1); PG8_STAGE(PG8_SB(0, 0), b2_0, voffB); PG8_STAGE(PG8_SB(0, 1), b2_1, voffB); PG8_STAGE(PG8_SA(0, 0), a2_0, sv0);
            PG8_WAIT_V(8); PG8_WAIT_L(0); PG8_BAR; PG8_MMA(1, 0, At, B0); PG8_MMA(1, 1, At, B1); PG8_BAR; PG8_SCHED;
            PG8_LDB(B0, 1, 0); PG8_LDB(B1, 1, 1); PG8_SCHED; PG8_LDA(At, 1, 0); PG8_STAGE(PG8_SA(0, 1), a2_1, sv1);
            PG8_WAIT_V(8); PG8_WAIT_L(0); PG8_BAR; PG8_MMA(0, 0, At, B0); PG8_MMA(0, 1, At, B1); PG8_BAR; PG8_SCHED;
            PG8_LDA(At, 1, 1); PG8_STAGE(PG8_SB(1, 0), b3_0, voffB); PG8_STAGE(PG8_SB(1, 1), b3_1, voffB); PG8_STAGE(PG8_SA(1, 0), a3_0, sv0);
            PG8_WAIT_V(8); PG8_WAIT_L(0); PG8_BAR; PG8_MMA(1, 0, At, B0); PG8_MMA(1, 1, At, B1); PG8_BAR; PG8_SCHED;
            (void)a3_1; (void)b3_1;
        }
        if (wr == 0) PG8_BAR;
        if constexpr (F8) { asm volatile("s_nop 15\n\ts_nop 15\n\ts_nop 7" ::: "memory"); }
        E(acc, cur, wr, wc, fr, fq);
        if (!has_next) break;
#pragma unroll
        for (int a = 0; a < 2; ++a)
#pragma unroll
            for (int b = 0; b < 2; ++b)
#pragma unroll
                for (int m = 0; m < 4; ++m)
#pragma unroll
                    for (int n = 0; n < 2; ++n) acc[a][b][m][n] = (f32x4){0.f, 0.f, 0.f, 0.f};
        cur = nxt; ++ui;
#pragma unroll
        for (int _h = 0; _h < 2; ++_h)
#pragma unroll
            for (int _i = 0; _i < 2; ++_i) cvA[_h][_i] = nvA[_h][_i];
        if (wr == 1) PG8_BAR;
    }
    PG8_WAIT_V(0);
    PG8_BAR;
#undef PG8_SA
#undef PG8_SB
#undef PG8_STAGE
#undef PG8_LDA
#undef PG8_LDB
#undef PG8_MMA
#undef PG8_LD8
#undef PG8_WAIT_V
#undef PG8_WAIT_L
#undef PG8_BAR
#undef PG8_SCHED
#undef PG8_VOFF
}
}

namespace pg8 {

struct DenseOrder {
    static constexpr bool GATHER = false;
    const bf16_t* A; const bf16_t* Bt; int nM, nN, nwg, G, c;
    __device__ __forceinline__ void init(const bf16_t* A_, const bf16_t* Bt_, int M, int N, int G_, int c_) { A = A_; Bt = Bt_; nM = M / BM; nN = N / BM; nwg = nM * nN; G = G_; c = c_; }
    __device__ __forceinline__ bool next(int i, Unit& u) const {
        const long L = (long)i * G + c; if (L >= nwg) return false;
        int wgid = (int)L; { const int q = nwg / NXCD, r = nwg % NXCD, xcd = wgid % NXCD, off = wgid / NXCD; wgid = (xcd < r ? xcd * (q + 1) : r * (q + 1) + (xcd - r) * q) + off; }
        const int nig = WGM * nN, gid = wgid / nig, fm = gid * WGM, gsz = (nM - fm) < WGM ? (nM - fm) : WGM;
        u.pm = fm + ((wgid % nig) % gsz); u.pn = (wgid % nig) / gsz; u.e = 0;
        u.A0 = (const char*)A + (size_t)u.pm * BM * GK * 2; u.A1 = u.A0 + (size_t)HALF * GK * 2;
        u.B0 = (const char*)Bt + (size_t)u.pn * BM * GK * 2; u.B1 = u.B0 + (size_t)HALF * GK * 2;
        return true;
    }
    __device__ __forceinline__ int row_of(const Unit&, int r) const { return r; }
};
struct UpOrder {
    static constexpr bool GATHER = true;
    const unsigned char* H2; const unsigned char* WupT; const int* row_tok; const int* mt_exp; int nunits, G, c;
    __device__ __forceinline__ bool next(int i, Unit& u) const {
        const int L = i * G + c; if (L >= nunits) return false;
        u.pm = L >> 3; u.pn = L & 7; u.e = mt_exp[u.pm];
        u.A0 = (const char*)H2; u.A1 = (const char*)H2;
        u.B0 = (const char*)WupT + ((size_t)u.e * 2 * DEXP + (size_t)u.pn * HALF) * GK; u.B1 = u.B0 + (size_t)DEXP * GK;
        return true;
    }
    __device__ __forceinline__ int row_of(const Unit& u, int r) const { return row_tok[u.pm * BM + r]; }
};
struct DownOrder {
    static constexpr bool GATHER = false;
    const unsigned char* ACT; const unsigned char* WdnT; const int* mt_exp; int nunits, G, c;
    __device__ __forceinline__ bool next(int i, Unit& u) const {
        const int L = i * G + c; if (L >= nunits) return false;
        u.pm = L >> 2; u.pn = L & 3; u.e = mt_exp[u.pm];
        u.A0 = (const char*)ACT + (size_t)u.pm * BM * GK; u.A1 = u.A0 + (size_t)HALF * GK;
        u.B0 = (const char*)WdnT + ((size_t)u.e * DM + (size_t)u.pn * BM) * GK; u.B1 = u.B0 + (size_t)HALF * GK;
        return true;
    }
    __device__ __forceinline__ int row_of(const Unit&, int r) const { return r; }
};

struct EpiProj {
    static constexpr bool PERM = true, MID = false;
    bf16_t* O; size_t tstride; float qscale;
    __device__ __forceinline__ void mid(f32x4 (&)[2][2][4][2], const Unit&, int, int, int, int) const {}
    __device__ __forceinline__ void operator()(const f32x4 (&acc)[2][2][4][2], const Unit& u, int wr, int wc, int fr, int fq) const {
        const int t = u.pn >> 1; bf16_t* base = O + (size_t)t * tstride; const float sc = (t == 2) ? qscale : 1.f;
        const int row0 = u.pm * BM + wr * 64 + fr, col0 = (u.pn & 1) * BM + wc * 32 + 8 * fq;
#pragma unroll
        for (int ai = 0; ai < 2; ++ai)
#pragma unroll
            for (int m = 0; m < 4; ++m) { bf16_t* rowp = base + (size_t)(row0 + ai * HALF + m * 16) * 512 + col0;
#pragma unroll
                for (int bj = 0; bj < 2; ++bj) { const f32x4 v0 = acc[ai][bj][m][0] * sc, v1 = acc[ai][bj][m][1] * sc;
                    u32x4 w; w.x = cvt_pk_bf16(v0[0], v0[1]); w.y = cvt_pk_bf16(v0[2], v0[3]); w.z = cvt_pk_bf16(v1[0], v1[1]); w.w = cvt_pk_bf16(v1[2], v1[3]);
                    *(u32x4*)(rowp + bj * HALF) = w; } }
    }
};
struct EpiOut {
    static constexpr bool PERM = false, MID = true;
    float* Y; const float* ssq;
    __device__ __forceinline__ void mid(f32x4 (&acc)[2][2][4][2], const Unit& u, int wr, int wc, int fr, int fq) const {
#pragma unroll
        for (int ai = 0; ai < 2; ++ai)
#pragma unroll
            for (int m = 0; m < 4; ++m) { const int row = u.pm * BM + ai * HALF + wr * 64 + m * 16 + fr;
                const f32x4 s0 = *(const f32x4*)(ssq + (size_t)row * 8), s1 = *(const f32x4*)(ssq + (size_t)row * 8 + 4);
                const float tot = ((s0[0] + s0[1]) + (s0[2] + s0[3])) + ((s1[0] + s1[1]) + (s1[2] + s1[3]));
                const float ri = 1.0f / sqrtf(tot * (1.0f / DATT) + RMS_EPS);
#pragma unroll
                for (int bj = 0; bj < 2; ++bj)
#pragma unroll
                    for (int n = 0; n < 2; ++n) acc[ai][bj][m][n] = acc[ai][bj][m][n] * ri; }
    }
    __device__ __forceinline__ void operator()(const f32x4 (&acc)[2][2][4][2], const Unit& u, int wr, int wc, int fr, int fq) const {
        const int row0 = u.pm * BM + wr * 64 + fr, col0 = u.pn * BM + wc * 32 + 4 * fq;
#pragma unroll
        for (int ai = 0; ai < 2; ++ai)
#pragma unroll
            for (int m = 0; m < 4; ++m) { float* rowp = Y + (size_t)(row0 + ai * HALF + m * 16) * DM + col0;
#pragma unroll
                for (int bj = 0; bj < 2; ++bj)
#pragma unroll
                    for (int n = 0; n < 2; ++n) *(f32x4*)(rowp + bj * HALF + n * 16) = acc[ai][bj][m][n]; }
    }
};
struct EpiUp {
    static constexpr bool PERM = true, MID = false;
    unsigned char* ACT; const float* b_up;
    __device__ __forceinline__ void mid(f32x4 (&)[2][2][4][2], const Unit&, int, int, int, int) const {}
    __device__ __forceinline__ void operator()(const f32x4 (&acc)[2][2][4][2], const Unit& u, int wr, int wc, int fr, int fq) const {
        const int row0 = u.pm * BM + wr * 64 + fr, col0 = u.pn * HALF + wc * 32 + 8 * fq;
        const float* bg = b_up + (size_t)u.e * 2 * DEXP + col0;
        f32x4 bgl[2], bli[2];
#pragma unroll
        for (int n = 0; n < 2; ++n) { bgl[n] = *(const f32x4*)(bg + 4 * n); bli[n] = *(const f32x4*)(bg + DEXP + 4 * n); }
#pragma unroll
        for (int ai = 0; ai < 2; ++ai)
#pragma unroll
            for (int m = 0; m < 4; ++m) { unsigned char* rowp = ACT + (size_t)(row0 + ai * HALF + m * 16) * DEXP + col0;
                float o[8];
#pragma unroll
                for (int n = 0; n < 2; ++n)
#pragma unroll
                    for (int j = 0; j < 4; ++j) { const float gl = fminf(acc[ai][0][m][n][j] + bgl[n][j], 7.0f); const float li = fminf(fmaxf(acc[ai][1][m][n][j] + bli[n][j], -7.0f), 7.0f);
                        const float sg = __builtin_amdgcn_rcpf(1.0f + __builtin_amdgcn_exp2f(-1.702f * 1.4426950408889634f * gl)); o[4 * n + j] = gl * sg * (li + 1.0f); }
                int w0 = 0, w1 = 0; w0 = __builtin_amdgcn_cvt_pk_fp8_f32(o[0], o[1], w0, false); w0 = __builtin_amdgcn_cvt_pk_fp8_f32(o[2], o[3], w0, true);
                w1 = __builtin_amdgcn_cvt_pk_fp8_f32(o[4], o[5], w1, false); w1 = __builtin_amdgcn_cvt_pk_fp8_f32(o[6], o[7], w1, true);
                typedef int i32x2_ __attribute__((ext_vector_type(2))); *(i32x2_*)rowp = (i32x2_){w0, w1}; }
    }
};
struct EpiDown {
    static constexpr bool PERM = true, MID = false;
    bf16_t* YP; const float* b_down; const int* row_pair; const float* row_w;
    __device__ __forceinline__ void mid(f32x4 (&)[2][2][4][2], const Unit&, int, int, int, int) const {}
    __device__ __forceinline__ void operator()(const f32x4 (&acc)[2][2][4][2], const Unit& u, int wr, int wc, int fr, int fq) const {
        const int row0 = u.pm * BM + wr * 64 + fr, col0 = u.pn * BM + wc * 32 + 8 * fq;
        const float* bd = b_down + (size_t)u.e * DM + col0;
        f32x4 bv[2][2];
#pragma unroll
        for (int bj = 0; bj < 2; ++bj)
#pragma unroll
            for (int n = 0; n < 2; ++n) bv[bj][n] = *(const f32x4*)(bd + bj * HALF + 4 * n);
#pragma unroll
        for (int ai = 0; ai < 2; ++ai)
#pragma unroll
            for (int m = 0; m < 4; ++m) { const int pos = row0 + ai * HALF + m * 16; const int pair = row_pair[pos]; const float w = row_w[pos];
                if (pair >= 0) { bf16_t* rowp = YP + (size_t)pair * DM + col0;
#pragma unroll
                    for (int bj = 0; bj < 2; ++bj) { const f32x4 v0 = (acc[ai][bj][m][0] + bv[bj][0]) * w, v1 = (acc[ai][bj][m][1] + bv[bj][1]) * w;
                        u32x4 q; q.x = cvt_pk_bf16(v0[0], v0[1]); q.y = cvt_pk_bf16(v0[2], v0[3]); q.z = cvt_pk_bf16(v1[0], v1[1]); q.w = cvt_pk_bf16(v1[2], v1[3]);
                        *(u32x4*)(rowp + bj * HALF) = q; } } }
    }
};
}

namespace attn_body {
using bf16=__hip_bfloat16;
using bf16x8=__attribute__((ext_vector_type(8)))short;
using s16x4=__attribute__((ext_vector_type(4)))short;
using f32x16=__attribute__((ext_vector_type(16)))float;
using u32x4=__attribute__((ext_vector_type(4)))unsigned;
constexpr int BATCH=8,NHEAD=8,SEQ=2048,D=64,DM=NHEAD*D,OPITCH=1024;
constexpr int NW=8,QBLK=32,QB=QBLK*NW,KVBLK=64,NQB=SEQ/QB;
constexpr int ATTN_PITCH=DM, ATTN_UNIT_ROWS=QB;
__device__ __forceinline__ int crow(int r,int hi){return (r&3)+8*(r>>2)+4*hi;}
#define SBAR() __builtin_amdgcn_sched_barrier(0)
__device__ __forceinline__ void cmask(f32x16&p0,f32x16&p1,int jb,int qrel,int hi){
  const float NEG=-INFINITY; int kb=64*jb+4*hi;
  #pragma unroll
  for(int r=0;r<16;++r){int kv=kb+(r&3)+8*(r>>2); if(kv>qrel)p0[r]=NEG; if(kv+32>qrel)p1[r]=NEG;}
}

constexpr int NSLOT=3, SLOTB=8192;
constexpr int LDS_K=0, LDS_V=NSLOT*SLOTB, LDS_WS=2*NSLOT*SLOTB, LDS_OST=LDS_WS+NW*64*4, LDS_BIAS=LDS_OST+NW*4096, LDS_SCAN=LDS_BIAS+(SEQ+64)*4, LDS_BYTES=LDS_SCAN+256;
constexpr float C2=0.125f*1.4426950408889634f;
__device__ __forceinline__ void glds16(const void*gsrc,unsigned lds_dst){unsigned keep;
  asm volatile("s_mov_b32 %0, m0\n\ts_mov_b32 m0, %2\n\ts_nop 0\n\tglobal_load_lds_dwordx4 %1, off\n\ts_mov_b32 m0, %0":"=&s"(keep):"v"(gsrc),"s"(lds_dst):"memory");}
__device__ __forceinline__ float max3f(float a,float b,float c){float r;asm("v_max3_f32 %0, %1, %2, %3":"=v"(r):"v"(a),"v"(b),"v"(c));return r;}
__device__ __forceinline__ float max2f(float a,float b){float r;asm("v_max_f32_e32 %0, %1, %2":"=v"(r):"v"(a),"v"(b));return r;}
__device__ __forceinline__ float fadd_s(float a,float b){float r;asm("v_add_f32_e32 %0, %1, %2":"=v"(r):"v"(a),"v"(b));return r;}
__device__ __forceinline__ float fsub_s(float a,float b){float r;asm("v_sub_f32_e32 %0, %1, %2":"=v"(r):"v"(a),"v"(b));return r;}
typedef float f32x2_t __attribute__((ext_vector_type(2))); typedef float f32x4_t __attribute__((ext_vector_type(4))); typedef __bf16 bf16x2_t __attribute__((ext_vector_type(2)));
__device__ __forceinline__ unsigned cvtpk_s(float lo,float hi){f32x2_t v={lo,hi};bf16x2_t b=__builtin_convertvector(v,bf16x2_t);return __builtin_bit_cast(unsigned,b);}
#define WAIT_BAR(N) asm volatile("s_waitcnt vmcnt(" #N ") lgkmcnt(0)\n\ts_barrier":::"memory")

__device__ __forceinline__ void qkt(f32x16&p0,f32x16&p1,const char*Kslot,const bf16x8*qr,int r32,int hi){
  const char*kb=Kslot+hi*1024+r32*16;
  #pragma unroll
  for(int d0=0;d0<4;++d0){
    const bf16x8 b0=*reinterpret_cast<const bf16x8*>(kb+d0*2048);
    const bf16x8 b1=*reinterpret_cast<const bf16x8*>(kb+d0*2048+512);
    p0=__builtin_amdgcn_mfma_f32_32x32x16_bf16(b0,qr[d0],p0,0,0,0);p1=__builtin_amdgcn_mfma_f32_32x32x16_bf16(b1,qr[d0],p1,0,0,0);}
}
typedef __attribute__((address_space(3))) const char* lds_cptr;
typedef short v4i16_t __attribute__((ext_vector_type(4)));
__device__ __forceinline__ void kload8(bf16x8*kf,lds_cptr kp){
  kf[0]=*(const __attribute__((address_space(3))) bf16x8*)(kp);      kf[1]=*(const __attribute__((address_space(3))) bf16x8*)(kp+512);
  kf[2]=*(const __attribute__((address_space(3))) bf16x8*)(kp+2048); kf[3]=*(const __attribute__((address_space(3))) bf16x8*)(kp+2560);
  kf[4]=*(const __attribute__((address_space(3))) bf16x8*)(kp+4096); kf[5]=*(const __attribute__((address_space(3))) bf16x8*)(kp+4608);
  kf[6]=*(const __attribute__((address_space(3))) bf16x8*)(kp+6144); kf[7]=*(const __attribute__((address_space(3))) bf16x8*)(kp+6656);
}
__device__ __forceinline__ void kload2(bf16x8*kf,lds_cptr kp,int j){ kf[2*j]=*(const __attribute__((address_space(3))) bf16x8*)(kp+j*2048); kf[2*j+1]=*(const __attribute__((address_space(3))) bf16x8*)(kp+j*2048+512); }
__device__ __forceinline__ s16x4 vtr(lds_cptr p){ return __builtin_bit_cast(s16x4,__builtin_amdgcn_ds_read_tr16_b64_v4i16((__attribute__((address_space(3))) v4i16_t*)p)); }
__device__ __forceinline__ float rowmax(const f32x16&p0,const f32x16&p1){
  float a=max3f(p0[0],p0[1],p1[0]),b=max3f(p0[2],p0[3],p1[1]);a=max3f(a,p1[2],p1[3]);
  #pragma unroll
  for(int r=4;r<16;r+=4){a=max3f(a,p0[r],p0[r+1]);b=max3f(b,p0[r+2],p0[r+3]);a=max3f(a,p1[r],p1[r+1]);b=max3f(b,p1[r+2],p1[r+3]);}
  const float m=max2f(a,b);
  auto rr=__builtin_amdgcn_permlane32_swap(__float_as_uint(m),__float_as_uint(m),false,false);
  return max2f(__uint_as_float(rr[0]),__uint_as_float(rr[1]));
}
__device__ __forceinline__ void pv(f32x16*o,int vb,bf16x8 pa0,bf16x8 pa1,bf16x8 pa2,bf16x8 pa3){
  #pragma unroll
  for(int d0=0;d0<2;++d0){s16x4 lo[4],hi[4];
    #pragma unroll
    for(int ks=0;ks<4;++ks){
      asm volatile("ds_read_b64_tr_b16 %0,%1 offset:%c2":"=&v"(lo[ks]):"v"(vb),"i"(d0*4096+ks*1024):"memory");
      asm volatile("ds_read_b64_tr_b16 %0,%1 offset:%c2":"=&v"(hi[ks]):"v"(vb),"i"(d0*4096+ks*1024+512):"memory");}
    asm volatile("s_waitcnt lgkmcnt(0)":::"memory");SBAR();
    #define PK(k) (bf16x8){lo[k][0],lo[k][1],lo[k][2],lo[k][3],hi[k][0],hi[k][1],hi[k][2],hi[k][3]}
    o[d0]=__builtin_amdgcn_mfma_f32_32x32x16_bf16(pa0,PK(0),o[d0],0,0,0);
    o[d0]=__builtin_amdgcn_mfma_f32_32x32x16_bf16(pa1,PK(1),o[d0],0,0,0);
    o[d0]=__builtin_amdgcn_mfma_f32_32x32x16_bf16(pa2,PK(2),o[d0],0,0,0);
    o[d0]=__builtin_amdgcn_mfma_f32_32x32x16_bf16(pa3,PK(3),o[d0],0,0,0);
    #undef PK
  }
}

#ifndef ATTN_STORE16
#define ATTN_STORE16(p,v) (*(u32x4*)(p)=(v))
#endif
template<int THRL> __device__ __forceinline__ void attn_unit(int b,int h,int qb,const bf16*Q,const bf16*__restrict__ K,const bf16*__restrict__ V,bf16*O,const float*__restrict__ LOGF2,float*SSQ,char*shm){
  const int tid=threadIdx.x,lane=tid&63,r32=lane&31,hi=lane>>5; const int wid=__builtin_amdgcn_readfirstlane(tid>>6);
  const long rowbase=(long)b*SEQ; const int q0=qb*QB;
  const bf16*Qw=Q+(rowbase+q0+wid*QBLK)*DM+h*D;
  const bf16*Kh=K+rowbase*DM+h*D,*Vh=V+rowbase*DM+h*D;
  const unsigned lds0=(unsigned)(uintptr_t)shm;
  float*wsf=(float*)(shm+LDS_WS)+wid*64;
  const bf16*ksrc=Kh+(long)lane*DM+wid*8;
  const bf16*vsrc=Vh+(long)(16*(wid&3)+(lane>>2))*DM+(wid>>2)*32+(lane&3)*8;
  const unsigned kdst=lds0+LDS_K+wid*1024, vdst=lds0+LDS_V+wid*1024;
  #define DMA_K(t,slot) glds16(ksrc+(long)(t)*KVBLK*DM,(unsigned)__builtin_amdgcn_readfirstlane(kdst+(slot)))
  #define DMA_V(t,slot) glds16(vsrc+(long)(t)*KVBLK*DM,(unsigned)__builtin_amdgcn_readfirstlane(vdst+(slot)))
  const int vb0=(int)(lds0+LDS_V)+((lane>>4)&1)*32+(lane&3)*8+(4*hi+((lane&15)>>2))*64;
  const char*Kbase=shm+LDS_K; bf16x8 kf[8];
  const lds_cptr shm3=(lds_cptr)shm; const lds_cptr kp0=shm3+LDS_K+hi*1024+r32*16; const lds_cptr vp0=shm3+LDS_V+((lane>>4)&1)*32+(lane&3)*8+(4*hi+((lane&15)>>2))*64;
  const int NT=(q0+QB)/KVBLK;
  { float*biasl=(float*)(shm+LDS_BIAS); float*scn=(float*)(shm+LDS_SCAN);
    const float*lf=LOGF2+rowbase*NHEAD+h;
    float v0=0.f,v1=0.f,v2=0.f,v3=0.f; const int i0=4*tid;
    if(i0<q0){ v0=lf[(long)(q0-1-i0)*NHEAD]; v1=lf[(long)(q0-2-i0)*NHEAD]; v2=lf[(long)(q0-3-i0)*NHEAD]; v3=lf[(long)(q0-4-i0)*NHEAD]; }
    const float tsum=(v0+v1)+(v2+v3); float inc=tsum;
    #pragma unroll
    for(int o=1;o<64;o<<=1){ const float n_=__shfl_up(inc,o); if(lane>=o)inc+=n_; }
    if(lane==63)scn[wid]=inc;
    const float f0=lf[(long)(q0+4*lane)*NHEAD],f1=lf[(long)(q0+4*lane+1)*NHEAD],f2=lf[(long)(q0+4*lane+2)*NHEAD],f3=lf[(long)(q0+4*lane+3)*NHEAD];
    float finc=(f0+f1)+(f2+f3);
    #pragma unroll
    for(int o=1;o<64;o<<=1){ const float n_=__shfl_up(finc,o); if(lane>=o)finc+=n_; }
    const float fex=finc-((f0+f1)+(f2+f3));
    if(wid==0){ biasl[q0+4*lane]=-(fex+f0); biasl[q0+4*lane+1]=-(fex+f0+f1); biasl[q0+4*lane+2]=-(fex+f0+f1+f2); biasl[q0+4*lane+3]=-(fex+f0+f1+f2+f3); }
    __syncthreads();
    float woff=0.f;
    #pragma unroll
    for(int w_=0;w_<NW;++w_) woff+=(w_<wid)?scn[w_]:0.f;
    const float ex=woff+inc-tsum;
    if(i0<q0){ biasl[q0-1-i0]=ex; biasl[q0-2-i0]=ex+v0; biasl[q0-3-i0]=ex+v0+v1; biasl[q0-4-i0]=ex+v0+v1+v2; }
    __syncthreads(); }
  const lds_cptr biasr=(lds_cptr)shm+LDS_BIAS+16*hi;
  #define BIAS4(t,o) (*(const __attribute__((address_space(3))) f32x4_t*)(biasr+(t)*(KVBLK*4)+(o)*4))
  #define INIT4(Y,g,t,o) do{ const f32x4_t x_=BIAS4(t,(o)+8*(g)); Y[4*(g)]=x_[0]-mhat; Y[4*(g)+1]=x_[1]-mhat; Y[4*(g)+2]=x_[2]-mhat; Y[4*(g)+3]=x_[3]-mhat; }while(0)
  #define INITT(Y0,Y1,t) do{ INIT4(Y0,0,t,0);INIT4(Y0,1,t,0);INIT4(Y0,2,t,0);INIT4(Y0,3,t,0); INIT4(Y1,0,t,32);INIT4(Y1,1,t,32);INIT4(Y1,2,t,32);INIT4(Y1,3,t,32); }while(0)
  DMA_K(0,0);DMA_V(0,0);DMA_K(1,SLOTB);
  bf16x8 qr[4];
  #pragma unroll
  for(int d0=0;d0<4;++d0)qr[d0]=*reinterpret_cast<const bf16x8*>(&Qw[(long)r32*DM+d0*16+hi*8]);
  float mhat=0.f,l_reg=0.f;f32x16 o[2];o[0]=f32x16{};o[1]=f32x16{};
  const int qrel=wid*QBLK+r32;
  #define CMASK(P0,P1,t) do{int jb_=(t)-(NT-4); if(jb_>=0)cmask(P0,P1,jb_,qrel,hi);}while(0)
  bool resc=false;
  #define START(P0,P1) do{ const float rm=rowmax(P0,P1); resc=false; \
    { const float dl=rm; mhat=fadd_s(mhat,dl); \
      _Pragma("unroll") for(int r=0;r<16;++r){P0[r]=fsub_s(P0[r],dl);P1[r]=fsub_s(P1[r],dl);} } \
    _Pragma("unroll") for(int r=0;r<16;++r)P0[r]=__builtin_amdgcn_exp2f(P0[r]); }while(0)
  #define RESC() do{ if(resc){ asm volatile("s_waitcnt lgkmcnt(0)":::"memory"); \
      _Pragma("unroll") for(int d_=0;d_<2;++d_) _Pragma("unroll") for(int r=0;r<16;++r)o[d_][r]*=wsf[crow(r,hi)]; } }while(0)
  f32x16 pA0,pA1,pB0,pB1;
  int sl_prev=0,sl_cur=0,sl_next=SLOTB;
  #define ROT() do{sl_prev=sl_cur;sl_cur=sl_next;sl_next=(sl_next==(NSLOT-1)*SLOTB)?0:sl_next+SLOTB;}while(0)
  DMA_K(2,2*SLOTB);
  WAIT_BAR(3);
  INITT(pA0,pA1,0); qkt(pA0,pA1,Kbase,qr,r32,hi);asm volatile("s_nop 15\n\ts_nop 7":"+v"(pA0),"+v"(pA1));CMASK(pA0,pA1,0);
  START(pA0,pA1);
  _Pragma("unroll") for(int r=0;r<16;++r)pA1[r]=__builtin_amdgcn_exp2f(pA1[r]);
  INITT(pB0,pB1,1);
  WAIT_BAR(0);
  DMA_K(3,0);DMA_V(1,SLOTB);
  ROT();
  kload8(kf,kp0+sl_cur);
  WAIT_BAR(2);
  s16x4 vlo[8],vhi[8]; u32x4 pw0,pw1,pw2,pw3;
  #define PKW(P,B) cvtpk_s(P[B],P[B+1])
  #define PAF(k) __builtin_bit_cast(bf16x8,pw##k)
  #define VFR(i) (bf16x8){vlo[i][0],vlo[i][1],vlo[i][2],vlo[i][3],vhi[i][0],vhi[i][1],vhi[i][2],vhi[i][3]}
  #define PIN(x) asm volatile("":"+v"(x))
  #define MX3(a,b,c) __builtin_fmaxf(__builtin_fmaxf((a),(b)),(c))
  #define GAPA(MF,A0,A1,A2,A3,W0,W1,PW) do{ MF; sacc+=A0; sacc+=A1; sacc+=A2; sacc+=A3; PIN(sacc); W0; W1; PIN(PW); SBAR(); }while(0)
  #define EX(v) __builtin_amdgcn_exp2f(v)
  #define GAPB(MF,X,B,GN,Y,tn,o) do{ MF; X[B]=EX(X[B]); X[B+1]=EX(X[B+1]); X[B+2]=EX(X[B+2]); X[B+3]=EX(X[B+3]); PIN(X); if(GN){ INIT4(Y,(B)/4,tn,o); PIN(Y); } SBAR(); }while(0)
  #define VRD(i) do{ vlo[i]=vtr(vp_+(((i)>>2)*4096+((i)&3)*1024)); vhi[i]=vtr(vp_+(((i)>>2)*4096+((i)&3)*1024+512)); }while(0)
  #define KRD(G,j) do{ if(G){ kload2(kf,kp0+sl_next,j); SBAR(); } }while(0)
  #define STEP(C0,C1,P0,P1,t,GK,GV,GL) do{ SBAR(); \
    const lds_cptr vp_=vp0+sl_prev; \
    VRD(0); SBAR(); float sacc=(P0[0]+P0[1]); \
    GAPA(C0=__builtin_amdgcn_mfma_f32_32x32x16_bf16(kf[0],qr[0],C0,0,0,0), P0[2],P0[3],P0[4],P0[5],     pw0[0]=PKW(P0,0), pw0[1]=PKW(P0,2), pw0); \
    VRD(4); SBAR(); GAPA(C1=__builtin_amdgcn_mfma_f32_32x32x16_bf16(kf[1],qr[0],C1,0,0,0), P0[6],P0[7],P0[8],P0[9],     pw0[2]=PKW(P0,4), pw0[3]=PKW(P0,6), pw0); \
    VRD(1); SBAR(); GAPA(C0=__builtin_amdgcn_mfma_f32_32x32x16_bf16(kf[2],qr[1],C0,0,0,0),   P0[10],P0[11],P0[12],P0[13], pw1[0]=PKW(P0,8), pw1[1]=PKW(P0,10), pw1); \
    VRD(5); SBAR(); GAPA(C1=__builtin_amdgcn_mfma_f32_32x32x16_bf16(kf[3],qr[1],C1,0,0,0),   P0[14],P0[15],P1[0],P1[1],   pw1[2]=PKW(P0,12),pw1[3]=PKW(P0,14), pw1); \
    VRD(2); SBAR(); GAPA(C0=__builtin_amdgcn_mfma_f32_32x32x16_bf16(kf[4],qr[2],C0,0,0,0),   P1[2],P1[3],P1[4],P1[5],     pw2[0]=PKW(P1,0), pw2[1]=PKW(P1,2), pw2); \
    VRD(6); SBAR(); GAPA(C1=__builtin_amdgcn_mfma_f32_32x32x16_bf16(kf[5],qr[2],C1,0,0,0),   P1[6],P1[7],P1[8],P1[9],     pw2[2]=PKW(P1,4), pw2[3]=PKW(P1,6), pw2); \
    VRD(3); SBAR(); GAPA(C0=__builtin_amdgcn_mfma_f32_32x32x16_bf16(kf[6],qr[3],C0,0,0,0),   P1[10],P1[11],P1[12],P1[13], pw3[0]=PKW(P1,8), pw3[1]=PKW(P1,10), pw3); \
    VRD(7); SBAR(); GAPA(C1=__builtin_amdgcn_mfma_f32_32x32x16_bf16(kf[7],qr[3],C1,0,0,0),   P1[14],P1[15],0.f,0.f,       pw3[2]=PKW(P1,12),pw3[3]=PKW(P1,14), pw3); \
    l_reg+=sacc; \
    if(GK){DMA_K((t)+3,sl_cur);} if(GV){DMA_V((t)+1,sl_next);} \
    CMASK(C0,C1,t); \
    { float a=MX3(C0[0],C0[1],C1[0]),b=MX3(C0[2],C0[3],C1[1]); a=MX3(a,C1[2],C1[3]); \
      _Pragma("unroll") for(int r=4;r<16;r+=4){a=MX3(a,C0[r],C0[r+1]);b=MX3(b,C0[r+2],C0[r+3]);a=MX3(a,C1[r],C1[r+1]);b=MX3(b,C1[r+2],C1[r+3]);} \
      float rm=__builtin_fmaxf(a,b); { auto rr=__builtin_amdgcn_permlane32_swap(__float_as_uint(rm),__float_as_uint(rm),false,false); rm=__builtin_fmaxf(__uint_as_float(rr[0]),__uint_as_float(rr[1])); } \
      resc=false; \
      if(__builtin_expect(__any(rm>(float)THRL),0)){ const float dl=__builtin_fmaxf(rm,0.f); mhat+=dl; \
        _Pragma("unroll") for(int r=0;r<16;++r){C0[r]-=dl;C1[r]-=dl;} \
        const float f=__builtin_amdgcn_exp2f(-dl); l_reg*=f; if(hi==0)wsf[r32]=f; resc=true; } } \
    SBAR(); \
    GAPB(o[0]=__builtin_amdgcn_mfma_f32_32x32x16_bf16(PAF(0),VFR(0),o[0],0,0,0), C0,0,  GL,P0,(t)+1,0); \
    GAPB(o[1]=__builtin_amdgcn_mfma_f32_32x32x16_bf16(PAF(0),VFR(4),o[1],0,0,0), C0,4,  GL,P0,(t)+1,0); \
    KRD(GL,0); GAPB(o[0]=__builtin_amdgcn_mfma_f32_32x32x16_bf16(PAF(1),VFR(1),o[0],0,0,0), C0,8,  GL,P0,(t)+1,0); \
    KRD(GL,1); GAPB(o[1]=__builtin_amdgcn_mfma_f32_32x32x16_bf16(PAF(1),VFR(5),o[1],0,0,0), C0,12, GL,P0,(t)+1,0); \
    KRD(GL,2); GAPB(o[0]=__builtin_amdgcn_mfma_f32_32x32x16_bf16(PAF(2),VFR(2),o[0],0,0,0), C1,0,  GL,P1,(t)+1,32); \
    KRD(GL,3); GAPB(o[1]=__builtin_amdgcn_mfma_f32_32x32x16_bf16(PAF(2),VFR(6),o[1],0,0,0), C1,4,  GL,P1,(t)+1,32); \
    GAPB(o[0]=__builtin_amdgcn_mfma_f32_32x32x16_bf16(PAF(3),VFR(3),o[0],0,0,0), C1,8,  GL,P1,(t)+1,32); \
    GAPB(o[1]=__builtin_amdgcn_mfma_f32_32x32x16_bf16(PAF(3),VFR(7),o[1],0,0,0), C1,12, GL,P1,(t)+1,32); \
    }while(0)
  int t=1;
  #undef CMASK
  #define CMASK(P0,P1,t) do{}while(0)
  for(;t+5<NT;t+=2){
    STEP(pB0,pB1,pA0,pA1,t,true,true,true);     WAIT_BAR(2); RESC(); ROT();
    STEP(pA0,pA1,pB0,pB1,t+1,true,true,true);   WAIT_BAR(2); RESC(); ROT();
  }
  #undef CMASK
  #define CMASK(P0,P1,t) do{int jb_=(t)-(NT-4); if(jb_>=0)cmask(P0,P1,jb_,qrel,hi);}while(0)
  #define ENDW(tt) do{ if((tt)+3<NT){WAIT_BAR(2);} else if((tt)+2<NT){WAIT_BAR(1);} else {WAIT_BAR(0);} }while(0)
  for(;t+1<NT;t+=2){
    STEP(pB0,pB1,pA0,pA1,t,(t+3<NT),(t+1<NT),(t+1<NT));       ENDW(t);   RESC(); ROT();
    STEP(pA0,pA1,pB0,pB1,t+1,(t+4<NT),(t+2<NT),(t+2<NT));     ENDW(t+1); RESC(); ROT();
  }
  STEP(pB0,pB1,pA0,pA1,NT-1,false,false,false); RESC();
  { float sacc=pB0[0]+pB0[1]; _Pragma("unroll") for(int r=2;r<16;++r)sacc+=pB0[r]; _Pragma("unroll") for(int r=0;r<16;++r)sacc+=pB1[r]; l_reg+=sacc;
    pw0=(u32x4){PKW(pB0,0),PKW(pB0,2),PKW(pB0,4),PKW(pB0,6)};pw1=(u32x4){PKW(pB0,8),PKW(pB0,10),PKW(pB0,12),PKW(pB0,14)};pw2=(u32x4){PKW(pB1,0),PKW(pB1,2),PKW(pB1,4),PKW(pB1,6)};pw3=(u32x4){PKW(pB1,8),PKW(pB1,10),PKW(pB1,12),PKW(pB1,14)};
    SBAR(); pv(o,vb0+sl_cur,PAF(0),PAF(1),PAF(2),PAF(3)); }
  #undef PKW
  #undef PAF
  #undef VFR
  #undef PIN
  #undef MX3
  #undef GAPA
  #undef GAPB
  #undef EX
  #undef VRD
  #undef KRD
  #undef STEP
  #undef ENDW
  {auto rr=__builtin_amdgcn_permlane32_swap(__float_as_uint(l_reg),__float_as_uint(l_reg),false,false);l_reg=__uint_as_float(rr[0])+__uint_as_float(rr[1]);}
  if(hi==0)wsf[32+r32]=l_reg;asm volatile("s_waitcnt lgkmcnt(0)":::"memory");
  float rli[16];
  #pragma unroll
  for(int r=0;r<16;++r)rli[r]=__builtin_amdgcn_rcpf(wsf[32+crow(r,hi)]);
  bf16*Ow=O+(rowbase+q0+wid*QBLK)*OPITCH+h*D; float*Sw=SSQ+(rowbase+q0+wid*QBLK)*NHEAD+h;
  { bf16*stg=(bf16*)(shm+LDS_OST)+wid*2048;
    #pragma unroll
    for(int r=0;r<16;++r){const int orow=crow(r,hi);
      #pragma unroll
      for(int d0=0;d0<2;++d0)stg[orow*64+d0*32+r32]=__float2bfloat16(o[d0][r]*rli[r]);}
    asm volatile("s_waitcnt lgkmcnt(0)":::"memory");
    #pragma unroll
    for(int i=0;i<4;++i){const int row=i*8+(lane>>3),ch=lane&7; const u32x4 v=*(const u32x4*)(stg+row*64+ch*8); ATTN_STORE16(Ow+(long)row*OPITCH+ch*8,v);
      float sq=0.f;
      #pragma unroll
      for(int j=0;j<4;++j){ const float lo_=__uint_as_float(v[j]<<16), hi_=__uint_as_float(v[j]&0xffff0000u); sq+=lo_*lo_+hi_*hi_; }
      sq+=__shfl_xor(sq,1); sq+=__shfl_xor(sq,2); sq+=__shfl_xor(sq,4);
      if(ch==0)Sw[(long)row*NHEAD]=sq; } }
  asm volatile("s_waitcnt lgkmcnt(0)\n\ts_barrier":::"memory");
  #undef DMA_K
  #undef BIAS4
  #undef INIT4
  #undef INITT
  #undef DMA_V
  #undef CMASK
  #undef START
  #undef RESC
  #undef ROT
}
constexpr int ATTN_LDS_BYTES=LDS_BYTES;
struct AttnTensors { const bf16* Q; const bf16* K; const bf16* V; bf16* O; const float* LOGF2; float* SSQ; };
struct AttnUnit { int bh; int qb; };
struct StaticOrder {
  int vcu,G;
  __device__ __forceinline__ explicit StaticOrder(int grid,int vcu_):vcu(vcu_),G(grid){}
  __device__ __forceinline__ bool next(int i,AttnUnit&u)const{ const int L=(i>>1)*G+vcu; if(L>=BATCH*NHEAD*4)return false; const int s=L&3; u.bh=L>>2; u.qb=(i&1)?7-s:s; return true; }
  __device__ __forceinline__ void a_ready(const AttnUnit&)const{}
  __device__ __forceinline__ void done(const AttnUnit&)const{}
};
template<class Sched,int THRL=8> __device__ __forceinline__ void attn_phase(char*lds,const AttnTensors&T,const Sched&S){
  AttnUnit u;
  for(int i=0;S.next(i,u);++i){ S.a_ready(u); attn_unit<THRL>(u.bh/NHEAD,u.bh%NHEAD,u.qb,T.Q,T.K,T.V,T.O,T.LOGF2,T.SSQ,lds); S.done(u); }
}
#undef SBAR
#undef WAIT_BAR
}

constexpr int NWAVES = 8;
constexpr int NPHASES = 11;

constexpr size_t MiB = 1u << 20, KiB = 1u << 10;
constexpr size_t WS_CTL = 0, CTL_ZERO_BYTES = 1 * MiB;
constexpr size_t WS_MOD = 1 * MiB;
constexpr size_t WS_LOGF2 = 1 * MiB + 256 * KiB;
constexpr size_t WS_SSQ = 1 * MiB + 768 * KiB;
constexpr size_t WS_TOPI = 2 * MiB + 256 * KiB;
constexpr size_t WS_TOPW = 2 * MiB + 512 * KiB;
constexpr size_t WS_WGCNT = 2 * MiB + 768 * KiB;
constexpr size_t WS_LSUM = 3 * MiB;
constexpr size_t WS_ROWTOK = 4 * MiB, WS_ROWPAIR = 4 * MiB + 512 * KiB, WS_ROWW = 5 * MiB, WS_MTEXP = 5 * MiB + 512 * KiB;
constexpr size_t WS_LWT = 6 * MiB;
constexpr size_t WS_WRT = 7 * MiB;
constexpr size_t WS_WIN = 8 * MiB;
constexpr size_t WS_WOUT = 13 * MiB;
constexpr size_t WS_WUP = 16 * MiB;
constexpr size_t WS_WDN = 144 * MiB;
constexpr size_t WS_H1 = 208 * MiB;
constexpr size_t WS_PJ = 240 * MiB;
constexpr size_t PJ_STRIDE = (size_t)NTOK * 512;
constexpr size_t WS_MRG = 320 * MiB;
constexpr size_t WS_Y = 352 * MiB;
constexpr size_t WS_H2 = 416 * MiB;
constexpr size_t WS_ACT = 448 * MiB;
constexpr size_t WS_YP = 592 * MiB;
constexpr size_t WS_END = 720 * MiB;
static_assert(WS_ACT + (size_t)MAXROWS * 1024 * 2 <= WS_YP && WS_YP + (size_t)NTOK * 4 * 1024 * 2 <= WS_END, "d_ws map");
constexpr int CW_BAR = 4096;

constexpr int LDS_BYTES = 147456;
constexpr int LDSCTL_OFF = LDS_BYTES - 512, MISC_OFF = LDSCTL_OFF + 320;
constexpr int SCRATCH_BYTES = LDSCTL_OFF;

#define GAS __attribute__((address_space(1)))
#define LAS __attribute__((address_space(3)))
typedef unsigned short bf16;
typedef unsigned v4u __attribute__((ext_vector_type(4)));
typedef unsigned v2u __attribute__((ext_vector_type(2)));
typedef float f32x4 __attribute__((ext_vector_type(4)));
typedef float f32x16 __attribute__((ext_vector_type(16)));
typedef short bf16x8 __attribute__((ext_vector_type(8)));
typedef GAS unsigned gu32;
#define RLX_AGENT __ATOMIC_RELAXED, __HIP_MEMORY_SCOPE_AGENT
#define LDS_WAIT() asm volatile("s_waitcnt lgkmcnt(0)" ::: "memory")
#define VM_WAIT() asm volatile("s_waitcnt vmcnt(0)" ::: "memory")
__device__ __forceinline__ unsigned f2bf(float f) { unsigned u = __builtin_bit_cast(unsigned, f); return (u + 0x7fffu + ((u >> 16) & 1u)) >> 16; }
__device__ __forceinline__ unsigned pk2(float lo, float hi) { return f2bf(lo) | (f2bf(hi) << 16); }
__device__ __forceinline__ float bflo(unsigned w) { return __uint_as_float(w << 16); }
__device__ __forceinline__ float bfhi(unsigned w) { return __uint_as_float(w & 0xffff0000u); }
__device__ __forceinline__ float bf1(bf16 h) { return __uint_as_float((unsigned)h << 16); }

#define XB_TMO      128
#define XB_XCNT(j)  (256  + 64 * (j))
#define XB_XSUB(j)  (1280 + 64 * (j))
#define XB_XGEN(j)  (2304 + 64 * (j))
#define XB_TOP      3328
#define XB_TOPGEN   3392
#define XCD_BAR_WORDS 3456
#define XB_SPIN_CAP (1u << 18)
__device__ __forceinline__ unsigned xb_ld(unsigned* p)              { return __hip_atomic_load(p, __ATOMIC_RELAXED, __HIP_MEMORY_SCOPE_AGENT); }
__device__ __forceinline__ unsigned xb_add(unsigned* p, unsigned v) { return __hip_atomic_fetch_add(p, v, __ATOMIC_RELAXED, __HIP_MEMORY_SCOPE_AGENT); }
__device__ __forceinline__ unsigned xb_xcc_id() { return (unsigned)__builtin_amdgcn_s_getreg((3 << 11) | 20) & 0xFu; }
#define XB_SPIN(cond, bar) do { unsigned _sp = 0; while (cond) { __builtin_amdgcn_s_sleep(1); \
    if ((++_sp & 255u) == 0u) { if (xb_ld(&(bar)[XB_TMO])) break; if (_sp > XB_SPIN_CAP) { atomicAdd(&(bar)[XB_TMO], 1u); break; } } } } while (0)
struct XcdBarrier { unsigned* bar; unsigned x; volatile LAS unsigned* st; };
__device__ __forceinline__ XcdBarrier xcd_barrier_post(unsigned* bar, volatile LAS unsigned* st) {
    XcdBarrier b; b.bar = bar; b.x = xb_xcc_id(); b.st = st;
    if (threadIdx.x == 0) (void)xb_add(&bar[XB_XCNT(b.x)], 1u);
    return b;
}
__device__ __forceinline__ void xcd_barrier_complete(unsigned* bar, unsigned x, unsigned& nloc, unsigned& nx) {
    const unsigned G = gridDim.x * gridDim.y * gridDim.z;
    unsigned sum, cnt, mine, sp = 0u;
    for (;;) {
        sum = 0u; cnt = 0u; mine = 0u;
#pragma unroll
        for (unsigned j = 0; j < 16; ++j) { const unsigned c = xb_ld(&bar[XB_XCNT(j)]); sum += c; cnt += (c > 0u) ? 1u : 0u; mine = (j == x) ? c : mine; }
        if (sum == G) break;
        __builtin_amdgcn_s_sleep(1);
        if ((++sp & 255u) == 0u) { if (xb_ld(&bar[XB_TMO])) break; if (sp > XB_SPIN_CAP) { atomicAdd(&bar[XB_TMO], 1u); break; } }
    }
    nloc = mine > 0u ? mine : 1u; nx = cnt > 0u ? cnt : 1u;
}
__device__ __forceinline__ void xcd_barrier(const XcdBarrier& b) {
    asm volatile("s_waitcnt vmcnt(0)" ::: "memory");
    __syncthreads();
    if (threadIdx.x == 0) {
        unsigned* bar = b.bar;
        __builtin_amdgcn_s_waitcnt(0);
        unsigned nloc = b.st[0], nx = b.st[1];
        if (nloc == 0u) { xcd_barrier_complete(bar, b.x, nloc, nx); b.st[0] = nloc; b.st[1] = nx; }
        const unsigned old = xb_add(&bar[XB_XSUB(b.x)], 1u);
        const unsigned gen = old / nloc;
        if (old + 1u == (gen + 1u) * nloc) {
            __builtin_amdgcn_fence(__ATOMIC_RELEASE, "agent");
            asm volatile("s_waitcnt vmcnt(0)" ::: "memory");
            const unsigned og = xb_add(&bar[XB_TOP], 1u);
            const unsigned tg = og / nx;
            if (og + 1u == (tg + 1u) * nx) xb_add(&bar[XB_TOPGEN], 1u);
            else XB_SPIN(xb_ld(&bar[XB_TOPGEN]) == tg, bar);
            __builtin_amdgcn_fence(__ATOMIC_ACQUIRE, "agent");
            xb_add(&bar[XB_XGEN(b.x)], 1u);
            asm volatile("s_waitcnt vmcnt(0)" ::: "memory");
        } else {
            XB_SPIN(xb_ld(&bar[XB_XGEN(b.x)]) == gen, bar);
            __builtin_amdgcn_fence(__ATOMIC_ACQUIRE, "agent");
            asm volatile("s_waitcnt vmcnt(0)" ::: "memory");
        }
    }
    __syncthreads();
}

struct Args { const float* in[26]; float* out; unsigned char* ws; int ph_lo, ph_hi, li, pad; };
struct Frame {
    LAS unsigned char* lds;
    int tid, lane, wave, vcu, G;
    float* out; unsigned char* ws;
    __device__ __forceinline__ const float* in(int k) const { const LAS unsigned* t = (const LAS unsigned*)(lds + LDSCTL_OFF) + 2 * k;
        const unsigned lo = (unsigned)__builtin_amdgcn_readfirstlane((int)t[0]), hi = (unsigned)__builtin_amdgcn_readfirstlane((int)t[1]);
        return (const float*)(const GAS float*)(((unsigned long long)hi << 32) | lo); }
};
__device__ __forceinline__ float wave_sum(float v) {
#pragma unroll
    for (int o = 1; o < 64; o <<= 1) v += __shfl_xor(v, o);
    return v;
}
__device__ __forceinline__ float wave_max(float v) {
#pragma unroll
    for (int o = 1; o < 64; o <<= 1) v = fmaxf(v, __shfl_xor(v, o));
    return v;
}
__device__ __forceinline__ float sigmoid_f(float x) { return 1.0f / (1.0f + __expf(-x)); }
__device__ __forceinline__ float gelu_tanh_f(float x) { const float u = 0.7978845608028654f * (x + 0.044715f * x * x * x); const float e = __expf(2.0f * u); return x * (1.0f - 1.0f / (e + 1.0f)); }
__device__ __forceinline__ float log_sigmoid_f(float z) { return z >= 0.f ? -log1pf(expf(-z)) : z - log1pf(expf(z)); }
__device__ __forceinline__ float softplus_f(float z) { return z > 0.f ? z + log1pf(expf(-z)) : log1pf(expf(z)); }

__device__ __forceinline__ void p0_transpose_item(const float* W, int ldw, bf16* WT, int k0, int n0, int kdst0, const float* gain, LAS float* scr, int lane) {
#pragma unroll 8
    for (int i = 0; i < 32; ++i) { const int kk = 2 * i + (lane >> 5); float v = W[(size_t)(k0 + kk) * ldw + n0 + (lane & 31)]; if (gain) v *= gain[k0 + kk]; scr[kk * 33 + (lane & 31)] = v; }
    LDS_WAIT(); asm volatile("" ::: "memory");
    const int c = lane & 7;
#pragma unroll
    for (int j = 0; j < 4; ++j) { const int n = (lane >> 3) + 8 * j; const LAS float* s = scr + (8 * c) * 33 + n;
        v4u o; o.x = pk2(s[0 * 33], s[1 * 33]); o.y = pk2(s[2 * 33], s[3 * 33]); o.z = pk2(s[4 * 33], s[5 * 33]); o.w = pk2(s[6 * 33], s[7 * 33]);
        *(GAS v4u*)(WT + (size_t)(n0 + n) * 1024 + kdst0 + 8 * c) = o; }
    LDS_WAIT(); asm volatile("" ::: "memory");
}
__device__ __forceinline__ void p0_transpose_item_f8(const float* W, int ldw, unsigned char* WT, int k0, int n0, float scale, LAS float* scr, int lane) {
#pragma unroll 8
    for (int i = 0; i < 32; ++i) { const int kk = 2 * i + (lane >> 5); scr[kk * 33 + (lane & 31)] = W[(size_t)(k0 + kk) * ldw + n0 + (lane & 31)] * scale; }
    LDS_WAIT(); asm volatile("" ::: "memory");
    const int c = lane & 7;
#pragma unroll
    for (int j = 0; j < 4; ++j) { const int n = (lane >> 3) + 8 * j; const LAS float* s = scr + (8 * c) * 33 + n;
        int w0 = 0, w1 = 0; w0 = __builtin_amdgcn_cvt_pk_fp8_f32(s[0 * 33], s[1 * 33], w0, false); w0 = __builtin_amdgcn_cvt_pk_fp8_f32(s[2 * 33], s[3 * 33], w0, true);
        w1 = __builtin_amdgcn_cvt_pk_fp8_f32(s[4 * 33], s[5 * 33], w1, false); w1 = __builtin_amdgcn_cvt_pk_fp8_f32(s[6 * 33], s[7 * 33], w1, true);
        typedef int i32x2_ __attribute__((ext_vector_type(2))); *(GAS i32x2_*)(WT + (size_t)(n0 + n) * 1024 + k0 + 8 * c) = (i32x2_){w0, w1}; }
    LDS_WAIT(); asm volatile("" ::: "memory");
}
__device__ __forceinline__ void p0_phase(Frame& F) {
    const float* c_in = F.in(1); const float* w_ada = F.in(2); const float* b_ada = F.in(3);
    float* MOD = (float*)(F.ws + WS_MOD);
    if (F.vcu < 96) {
        LAS float* sc = (LAS float*)F.lds;
        LAS float* red = (LAS float*)(F.lds + 32768);
        for (int i = F.tid; i < BATCH * DM; i += NWAVES * 64) { const int b = i >> 10, k = i & 1023; const float v = c_in[i]; sc[k * 8 + b] = v * sigmoid_f(v); }
        __syncthreads();
        for (int ci = F.vcu; ci < 96; ci += F.G) {
            float acc[8];
#pragma unroll
            for (int b = 0; b < 8; ++b) acc[b] = 0.f;
            const float* wp = w_ada + (size_t)(128 * F.wave) * (NMOD * DM) + ci * 64 + F.lane;
#pragma unroll 8
            for (int kk = 0; kk < 128; ++kk) { const float wv = wp[(size_t)kk * (NMOD * DM)]; const LAS f32x4* sp = (const LAS f32x4*)(sc + (128 * F.wave + kk) * 8); const f32x4 s0 = sp[0], s1 = sp[1];
                acc[0] += s0[0] * wv; acc[1] += s0[1] * wv; acc[2] += s0[2] * wv; acc[3] += s0[3] * wv; acc[4] += s1[0] * wv; acc[5] += s1[1] * wv; acc[6] += s1[2] * wv; acc[7] += s1[3] * wv; }
#pragma unroll
            for (int b = 0; b < 8; ++b) red[(F.wave * 8 + b) * 64 + F.lane] = acc[b];
            __syncthreads();
            { const int b = F.tid >> 6, col = F.tid & 63; float s = 0.f;
#pragma unroll
              for (int w = 0; w < 8; ++w) s += red[(w * 8 + b) * 64 + col];
              MOD[b * NMOD * DM + ci * 64 + col] = s + b_ada[ci * 64 + col]; }
            __syncthreads();
        }
    }
    __syncthreads();
    const float* w_in = F.in(6); const float* w_out = F.in(17); const float* w_up = F.in(22); const float* w_down = F.in(24); const float* gn_attn = F.in(16);
    bf16* WIN = (bf16*)(F.ws + WS_WIN); bf16* WOUT = (bf16*)(F.ws + WS_WOUT); unsigned char* WUP = (unsigned char*)(F.ws + WS_WUP); unsigned char* WDN = (unsigned char*)(F.ws + WS_WDN);
    LAS float* scr = (LAS float*)(F.lds + F.wave * 16384);
    const int gw = F.vcu * NWAVES + F.wave, NGW = F.G * NWAVES;
    constexpr int I_IN = 16 * (NPJ / 32), I_OUT = 16 * (DM / 32), I_UP1 = 16 * (2 * DEXP / 32), I_UP = NE * I_UP1, I_DN1 = 16 * (DM / 32), I_DN = NE * I_DN1;
    constexpr int NITEMS = I_IN + I_OUT + I_UP + I_DN;
    for (int it = gw; it < NITEMS; it += NGW) {
        int r = it;
        if (r < I_IN) { const int kb = r / (NPJ / 32), nb = r % (NPJ / 32); p0_transpose_item(w_in, NPROJ, WIN, 64 * kb, 32 * nb, 64 * kb, nullptr, scr, F.lane); continue; } r -= I_IN;
        if (r < I_OUT) { const int kb = r / (DM / 32), nb = r % (DM / 32); const int k0 = 64 * kb;
            p0_transpose_item(w_out, DM, WOUT, k0, 32 * nb, (k0 + 512) & 1023, k0 >= 512 ? gn_attn - 512 : nullptr, scr, F.lane); continue; } r -= I_OUT;
        if (r < I_UP) { const int e = r / I_UP1, q = r % I_UP1, kb = q / (2 * DEXP / 32), nb = q % (2 * DEXP / 32);
            p0_transpose_item_f8(w_up + (size_t)e * DM * 2 * DEXP, 2 * DEXP, WUP + (size_t)e * 2 * DEXP * 1024, 64 * kb, 32 * nb, 64.0f, scr, F.lane); continue; } r -= I_UP;
        { const int e = r / I_DN1, q = r % I_DN1, kb = q / (DM / 32), nb = q % (DM / 32);
            p0_transpose_item_f8(w_down + (size_t)e * DEXP * DM, DM, WDN + (size_t)e * DM * 1024, 64 * kb, 32 * nb, 64.0f, scr, F.lane); }
    }
    { const float* w_router = F.in(20); float* WRT = (float*)(F.ws + WS_WRT);
      for (int idx = F.vcu * (NWAVES * 64) + F.tid; idx < NE * DM; idx += F.G * NWAVES * 64) { const int e = idx >> 10, k = idx & 1023; WRT[idx] = w_router[k * NE + e]; } }
    { const float* wa = F.in(9); const float* wx = F.in(11); bf16* LWT = (bf16*)(F.ws + WS_LWT);
      for (int idx = F.vcu * (NWAVES * 64) + F.tid; idx < 2 * 8 * 64 * 64; idx += F.G * NWAVES * 64) { const int gate = idx >> 15, g = (idx >> 12) & 7, j = (idx >> 6) & 63, i = idx & 63;
          LWT[idx] = (bf16)f2bf((gate ? wx : wa)[(g * 64 + i) * 64 + j]); } }
}

__device__ __forceinline__ void p1_phase(Frame& F) {
    const float* x = F.in(0); const float* gpre = F.in(4); const float* w_in = F.in(6); const float* fb = F.in(14);
    const float* MOD = (const float*)(F.ws + WS_MOD); bf16* H1 = (bf16*)(F.ws + WS_H1); float* LOGF2 = (float*)(F.ws + WS_LOGF2);
    LAS float* wf = (LAS float*)F.lds;
    for (int i = F.tid; i < 8 * DM; i += NWAVES * 64) { const int k = i >> 3, h = i & 7; wf[h * DM + k] = w_in[(size_t)k * NPROJ + NPJ + h]; }
    __syncthreads();
    const int gw = F.vcu * NWAVES + F.wave;
    if (F.G * NWAVES * 8 != NTOK) return;
    const int row0 = gw * 8, b = row0 / SEQ;
    f32x4 gm[4], sh[4];
#pragma unroll
    for (int j = 0; j < 4; ++j) { const int k = 4 * F.lane + 256 * j; const f32x4 g = *(const f32x4*)(gpre + k), s = *(const f32x4*)(MOD + b * NMOD * DM + DM + k); gm[j] = g * (s + 1.0f); sh[j] = *(const f32x4*)(MOD + b * NMOD * DM + k); }
    for (int r = 0; r < 8; ++r) { const int row = row0 + r;
        f32x4 v[4]; float ss = 0.f;
#pragma unroll
        for (int j = 0; j < 4; ++j) { v[j] = *(const f32x4*)(x + (size_t)row * DM + 4 * F.lane + 256 * j); ss += (v[j][0] * v[j][0] + v[j][1] * v[j][1]) + (v[j][2] * v[j][2] + v[j][3] * v[j][3]); }
        const float rinv = 1.0f / sqrtf(wave_sum(ss) * (1.0f / DM) + RMS_EPS);
        float fl[8];
#pragma unroll
        for (int h = 0; h < 8; ++h) fl[h] = 0.f;
#pragma unroll
        for (int j = 0; j < 4; ++j) { const f32x4 hv = v[j] * rinv * gm[j] + sh[j];
            v2u o; o.x = pk2(hv[0], hv[1]); o.y = pk2(hv[2], hv[3]); *(GAS v2u*)(H1 + (size_t)row * DM + 4 * F.lane + 256 * j) = o;
#pragma unroll
            for (int h = 0; h < 8; ++h) { const f32x4 w = *(const LAS f32x4*)(wf + h * DM + 4 * F.lane + 256 * j); fl[h] += (hv[0] * w[0] + hv[1] * w[1]) + (hv[2] * w[2] + hv[3] * w[3]); } }
#pragma unroll
        for (int h = 0; h < 8; ++h) fl[h] = wave_sum(fl[h]);
        if (F.lane < 8) { float f = fl[0];
#pragma unroll
            for (int h = 1; h < 8; ++h) f = (F.lane == h) ? fl[h] : f;
            LOGF2[(size_t)row * 8 + F.lane] = log_sigmoid_f(f + fb[F.lane]) * 1.4426950408889634f; }
    }
}

constexpr int LRU_XP = 1040;
constexpr int LRU_XT = 0, LRU_XC = 69696, LRU_CAR = 136256;
constexpr int CW_LRU = 131072;
static_assert(LRU_CAR + 2048 <= SCRATCH_BYTES && 67 * LRU_XP <= LRU_XC && LRU_XC + 64 * LRU_XP <= LRU_CAR, "LRU LDS map");
__device__ __forceinline__ float one_minus_exp(float x) { const float p = -x * (1.0f + x * (0.5f + x * (0.16666667f + x * (0.041666668f + x * (0.0083333338f + x * (0.0013888889f + x * 0.00019841270f)))))); const float d = 1.0f - __expf(x); return x > -0.25f ? p : d; }
__device__ __forceinline__ void lru_item(Frame& F, int b, int c) {
    LAS unsigned char* XT = F.lds + LRU_XT; LAS unsigned char* XC = F.lds + LRU_XC; LAS float* CAR = (LAS float*)(F.lds + LRU_CAR);
    const bf16* XL = (const bf16*)(F.ws + WS_PJ); const bf16* YL = XL + PJ_STRIDE; const bf16* LWT = (const bf16*)(F.ws + WS_LWT);
    float* LSUM = (float*)(F.ws + WS_LSUM); bf16* MRG = (bf16*)(F.ws + WS_MRG); unsigned* flags = (unsigned*)(F.ws + WS_CTL) + CW_LRU;
    const float* conv_w = F.in(7); const float* conv_b = F.in(8); const float* ba = F.in(10); const float* bx = F.in(12); const float* lam = F.in(13); const float* gn_lru = F.in(15);
    const int t0 = c * 64; const size_t rowb = (size_t)b * SEQ;
    { v4u xv[9];
#pragma unroll
      for (int q = 0; q < 9; ++q) { const int p = F.tid + q * (NWAVES * 64), i = p >> 6, c8 = p & 63, t = t0 - 3 + i; xv[q] = (v4u){0u, 0u, 0u, 0u};
          if (p < 67 * 64 && t >= 0) xv[q] = *(const GAS v4u*)(XL + (rowb + t) * 512 + c8 * 8); }
#pragma unroll
      for (int q = 0; q < 9; ++q) { const int p = F.tid + q * (NWAVES * 64), i = p >> 6, c8 = p & 63; if (p < 67 * 64) *(LAS v4u*)(XT + i * LRU_XP + c8 * 16) = xv[q]; } }
    v4u yv8[8];
#pragma unroll
    for (int q = 0; q < 8; ++q) { const int p = F.tid + q * (NWAVES * 64), i = p >> 6, c8 = p & 63; yv8[q] = *(const GAS v4u*)(YL + (rowb + t0 + i) * 512 + c8 * 8); }
    __syncthreads();
    { const int ch = F.tid; const float w0 = conv_w[ch], w1 = conv_w[512 + ch], w2 = conv_w[1024 + ch], w3 = conv_w[1536 + ch], cb = conv_b[ch];
      float xa = bf1(*(const LAS bf16*)(XT + 0 * LRU_XP + ch * 2)), xb = bf1(*(const LAS bf16*)(XT + 1 * LRU_XP + ch * 2)), xc = bf1(*(const LAS bf16*)(XT + 2 * LRU_XP + ch * 2));
#pragma unroll 8
      for (int t = 0; t < 64; ++t) { const float xd = bf1(*(const LAS bf16*)(XT + (t + 3) * LRU_XP + ch * 2)); const float v = ((w0 * xa + w1 * xb) + (w2 * xc + w3 * xd)) + cb;
          *(LAS bf16*)(XC + t * LRU_XP + ch * 2) = (bf16)f2bf(v); xa = xb; xb = xc; xc = xd; } }
    __syncthreads();
#pragma unroll
    for (int q = 0; q < 8; ++q) { const int p = F.tid + q * (NWAVES * 64), i = p >> 6, c8 = p & 63; *(LAS v4u*)(XT + i * LRU_XP + c8 * 16) = yv8[q]; }
    const int g = F.wave, l31 = F.lane & 31, hi = F.lane >> 5;
    __syncthreads();
#pragma unroll 1
    for (int hp = 0; hp < 2; ++hp) {
        const int chl = g * 64 + 32 * hp + l31;
        f32x16 cumA[2], hloc[2];
#pragma unroll
        for (int tg = 0; tg < 2; ++tg) { cumA[tg] = f32x16{}; hloc[tg] = f32x16{}; }
#pragma unroll
        for (int s = 0; s < 4; ++s) {
            const bf16x8 wa = *(const GAS bf16x8*)(LWT + ((size_t)((0 * 8 + g) * 64 + 32 * hp + l31)) * 64 + 16 * s + 8 * hi);
            const bf16x8 wx = *(const GAS bf16x8*)(LWT + ((size_t)((1 * 8 + g) * 64 + 32 * hp + l31)) * 64 + 16 * s + 8 * hi);
#pragma unroll
            for (int tg = 0; tg < 2; ++tg) { const bf16x8 bfr = *(const LAS bf16x8*)(XC + (32 * tg + l31) * LRU_XP + (g * 64 + 16 * s + 8 * hi) * 2);
                cumA[tg] = __builtin_amdgcn_mfma_f32_32x32x16_bf16(bfr, wa, cumA[tg], 0, 0, 0); hloc[tg] = __builtin_amdgcn_mfma_f32_32x32x16_bf16(bfr, wx, hloc[tg], 0, 0, 0); }
        }
        const float pba = ba[chl], pbx = bx[chl], psp = 8.0f * softplus_f(-lam[chl]);
        float cA = 1.0f, cB = 0.0f;
#pragma unroll
        for (int tg = 0; tg < 2; ++tg) {
            f32x16& A = cumA[tg]; f32x16& X = hloc[tg];
#pragma unroll
            for (int r = 0; r < 16; ++r) { const int tok = 32 * tg + (r & 3) + 8 * (r >> 2) + 4 * hi; const float xv = bf1(*(const LAS bf16*)(XC + tok * LRU_XP + chl * 2));
                const float rg = sigmoid_f(A[r] + pba), ig = sigmoid_f(X[r] + pbx); const float la = -rg * psp;
                A[r] = __expf(la); X[r] = sqrtf(one_minus_exp(2.0f * la)) * (ig * xv); }
#pragma unroll
            for (int q = 0; q < 4; ++q)
#pragma unroll
                for (int i = 1; i < 4; ++i) { X[4 * q + i] = A[4 * q + i] * X[4 * q + i - 1] + X[4 * q + i]; A[4 * q + i] = A[4 * q + i] * A[4 * q + i - 1]; }
#pragma unroll
            for (int q2 = 0; q2 < 8; ++q2) { const int q = q2 >> 1; const bool own = (hi == (q2 & 1));
#pragma unroll
                for (int i = 0; i < 4; ++i) { const float nb = A[4 * q + i] * cB + X[4 * q + i], na = A[4 * q + i] * cA; X[4 * q + i] = own ? nb : X[4 * q + i]; A[4 * q + i] = own ? na : A[4 * q + i]; }
                const float ra = __shfl_xor(A[4 * q + 3], 32), rb = __shfl_xor(X[4 * q + 3], 32);
                cA = own ? A[4 * q + 3] : ra; cB = own ? X[4 * q + 3] : rb; }
        }
        if (hi == 0) { float* d0 = LSUM + (((size_t)b * 32 + c) * 2 + 0) * 512 + chl; __hip_atomic_store(d0, cA, __ATOMIC_RELAXED, __HIP_MEMORY_SCOPE_AGENT); __hip_atomic_store(d0 + 512, cB, __ATOMIC_RELAXED, __HIP_MEMORY_SCOPE_AGENT); }
        asm volatile("s_waitcnt vmcnt(0)" ::: "memory");
        __syncthreads();
        if (F.tid == 0) {
            __hip_atomic_store(flags + 64 * ((32 * b + c) * 2 + hp), 1u, __ATOMIC_RELAXED, __HIP_MEMORY_SCOPE_AGENT);
            for (int j = 0; j < c; ++j) { unsigned sp = 0; while (__hip_atomic_load(flags + 64 * ((32 * b + j) * 2 + hp), __ATOMIC_RELAXED, __HIP_MEMORY_SCOPE_AGENT) == 0u) { __builtin_amdgcn_s_sleep(1); if (++sp > (1u << 22)) break; } }
        }
        __syncthreads();
        if (F.tid < 256) { const int ch = (F.tid >> 5) * 64 + 32 * hp + (F.tid & 31); float cr = 0.f; float* LS = LSUM + (size_t)b * 32 * 2 * 512 + ch;
          for (int c0 = 0; c0 < c; c0 += 8) { float A8[8], B8[8];
#pragma unroll
              for (int u = 0; u < 8; ++u) { const bool ok = (c0 + u) < c; A8[u] = 1.0f; B8[u] = 0.0f; if (ok) { A8[u] = __hip_atomic_load(LS + (size_t)(c0 + u) * 1024, __ATOMIC_RELAXED, __HIP_MEMORY_SCOPE_AGENT); B8[u] = __hip_atomic_load(LS + (size_t)(c0 + u) * 1024 + 512, __ATOMIC_RELAXED, __HIP_MEMORY_SCOPE_AGENT); } }
#pragma unroll
              for (int u = 0; u < 8; ++u) cr = A8[u] * cr + B8[u]; }
          CAR[ch] = cr; }
        __syncthreads();
        { const float cin = CAR[chl];
#pragma unroll
          for (int tg = 0; tg < 2; ++tg)
#pragma unroll
              for (int r = 0; r < 16; ++r) { const int tok = 32 * tg + (r & 3) + 8 * (r >> 2) + 4 * hi; LAS bf16* yp = (LAS bf16*)(XT + tok * LRU_XP + chl * 2);
                  const float h = hloc[tg][r] + cumA[tg][r] * cin; *yp = (bf16)f2bf(h * gelu_tanh_f(bf1(*yp))); } }
    }
    __syncthreads();
#pragma unroll 2
    for (int q = 0; q < 8; ++q) { const int i = F.wave + 8 * q, c8 = F.lane;
        const v4u w = *(const LAS v4u*)(XT + i * LRU_XP + c8 * 16);
        const float v0 = bflo(w.x), v1 = bfhi(w.x), v2 = bflo(w.y), v3 = bfhi(w.y), v4 = bflo(w.z), v5 = bfhi(w.z), v6 = bflo(w.w), v7 = bfhi(w.w);
        const float ss = wave_sum(((v0 * v0 + v1 * v1) + (v2 * v2 + v3 * v3)) + ((v4 * v4 + v5 * v5) + (v6 * v6 + v7 * v7)));
        const float rinv = 1.0f / sqrtf(ss * (1.0f / DLRU) + RMS_EPS);
        const f32x4 g0 = *(const f32x4*)(gn_lru + c8 * 8), g1 = *(const f32x4*)(gn_lru + c8 * 8 + 4);
        v4u o; o.x = pk2(v0 * rinv * g0[0], v1 * rinv * g0[1]); o.y = pk2(v2 * rinv * g0[2], v3 * rinv * g0[3]); o.z = pk2(v4 * rinv * g1[0], v5 * rinv * g1[1]); o.w = pk2(v6 * rinv * g1[2], v7 * rinv * g1[3]);
        *(GAS v4u*)(MRG + (rowb + t0 + i) * 1024 + 512 + c8 * 8) = o; }
    __syncthreads();
}
__device__ __forceinline__ void lru_phase(Frame& F) { for (int it = F.vcu; it < BATCH * 32; it += F.G) lru_item(F, it >> 5, it & 31); }

__device__ __forceinline__ void p6_phase(Frame& F) {
    const float* x = F.in(0); const float* gpost = F.in(5); const float* gffn = F.in(18); const float* b_router = F.in(21);
    const float* MOD = (const float*)(F.ws + WS_MOD); const float* Y = (const float*)(F.ws + WS_Y); unsigned char* H2 = (unsigned char*)(F.ws + WS_H2);
    int* TOPI = (int*)(F.ws + WS_TOPI); float* TOPW = (float*)(F.ws + WS_TOPW); int* WGCNT = (int*)(F.ws + WS_WGCNT);
    LAS float* wrl = (LAS float*)F.lds;
    LAS int* hist = (LAS int*)(F.lds + 131072);
    { const float* WRT = (const float*)(F.ws + WS_WRT);
#pragma unroll 4
      for (int i = F.tid; i < NE * DM / 4; i += NWAVES * 64) *(LAS f32x4*)(wrl + 4 * i) = *(const f32x4*)(WRT + 4 * i); }
    if (F.tid < NE) hist[F.tid] = 0;
    __syncthreads();
    if (F.G * 64 == NTOK) {
    const int bx = blockIdx.x, row0 = bx * 64 + F.wave * 8, b = row0 / SEQ;
    f32x4 gpm[4], gf[4], shf[4];
#pragma unroll
    for (int j = 0; j < 4; ++j) { const int k = 4 * F.lane + 256 * j; const float* mb = MOD + b * NMOD * DM + k;
        gpm[j] = *(const f32x4*)(mb + 2 * DM) * *(const f32x4*)(gpost + k); gf[j] = *(const f32x4*)(gffn + k) * (*(const f32x4*)(mb + 4 * DM) + 1.0f); shf[j] = *(const f32x4*)(mb + 3 * DM); }
    for (int rp = 0; rp < 4; ++rp) {
        f32x4 hv[2][4];
#pragma unroll
        for (int u = 0; u < 2; ++u) { const int row = row0 + 2 * rp + u;
            f32x4 yv[4]; float ss = 0.f;
#pragma unroll
            for (int j = 0; j < 4; ++j) { yv[j] = *(const f32x4*)(Y + (size_t)row * DM + 4 * F.lane + 256 * j); ss += (yv[j][0] * yv[j][0] + yv[j][1] * yv[j][1]) + (yv[j][2] * yv[j][2] + yv[j][3] * yv[j][3]); }
            const float rinv = 1.0f / sqrtf(wave_sum(ss) * (1.0f / DM) + RMS_EPS);
            float s2 = 0.f;
#pragma unroll
            for (int j = 0; j < 4; ++j) { const f32x4 xm = *(const f32x4*)(x + (size_t)row * DM + 4 * F.lane + 256 * j) + gpm[j] * (yv[j] * rinv);
                *(f32x4*)(F.out + (size_t)row * DM + 4 * F.lane + 256 * j) = xm; yv[j] = xm; s2 += (xm[0] * xm[0] + xm[1] * xm[1]) + (xm[2] * xm[2] + xm[3] * xm[3]); }
            const float rinv2 = 1.0f / sqrtf(wave_sum(s2) * (1.0f / DM) + RMS_EPS);
#pragma unroll
            for (int j = 0; j < 4; ++j) { const f32x4 h = yv[j] * rinv2 * gf[j] + shf[j]; hv[u][j] = h;
                int w8 = 0; w8 = __builtin_amdgcn_cvt_pk_fp8_f32(h[0], h[1], w8, false); w8 = __builtin_amdgcn_cvt_pk_fp8_f32(h[2], h[3], w8, true); *(GAS int*)(H2 + (size_t)row * DM + 4 * F.lane + 256 * j) = w8; }
        }
        float pa[32], pb[32];
#pragma unroll
        for (int e = 0; e < 32; ++e) { float sa = 0.f, sb = 0.f;
#pragma unroll
            for (int j = 0; j < 4; ++j) { const f32x4 w = *(const LAS f32x4*)(wrl + e * DM + 4 * F.lane + 256 * j);
                sa += (hv[0][j][0] * w[0] + hv[0][j][1] * w[1]) + (hv[0][j][2] * w[2] + hv[0][j][3] * w[3]); sb += (hv[1][j][0] * w[0] + hv[1][j][1] * w[1]) + (hv[1][j][2] * w[2] + hv[1][j][3] * w[3]); }
            pa[e] = sa; pb[e] = sb; }
#define TR_STEP(N, OFF, BIT) _Pragma("unroll") for (int i = 0; i < N; ++i) { const bool up = (F.lane & BIT) != 0; \
            const float ka = up ? pa[N + i] : pa[i], sa_ = up ? pa[i] : pa[N + i], kb = up ? pb[N + i] : pb[i], sb_ = up ? pb[i] : pb[N + i]; \
            pa[i] = ka + __shfl_xor(sa_, OFF); pb[i] = kb + __shfl_xor(sb_, OFF); }
        TR_STEP(16, 32, 32) TR_STEP(8, 16, 16) TR_STEP(4, 8, 8) TR_STEP(2, 4, 4) TR_STEP(1, 2, 2)
#undef TR_STEP
        const int e = (F.lane >> 1) & 31; const float br = b_router[e];
#pragma unroll
        for (int u = 0; u < 2; ++u) { const int row = row0 + 2 * rp + u; float v = (u ? pb[0] : pa[0]); v += __shfl_xor(v, 1); v += br;
            int rank = 0;
#pragma unroll
            for (int j = 0; j < 32; ++j) { const float vj = __uint_as_float((unsigned)__builtin_amdgcn_readlane((int)__float_as_uint(v), 2 * j)); rank += (vj > v || (vj == v && j < e)) ? 1 : 0; }
            const bool sel = rank < TOPK; const float vmax = wave_max(v); const float ex = sel ? __expf(v - vmax) : 0.f; const float den = wave_sum(ex) * 0.5f;
            if (sel && !(F.lane & 1)) { TOPI[(size_t)row * TOPK + rank] = e; TOPW[(size_t)row * TOPK + rank] = ex / den; __hip_atomic_fetch_add((LAS int*)&hist[e], 1, __ATOMIC_RELAXED, __HIP_MEMORY_SCOPE_WORKGROUP); } }
    }
    __syncthreads();
    if (F.tid < NE) WGCNT[bx * NE + F.tid] = hist[F.tid];
    }
}

__device__ __forceinline__ void p7_phase(Frame& F) {
    const int* TOPI = (const int*)(F.ws + WS_TOPI); const float* TOPW = (const float*)(F.ws + WS_TOPW); const int* WGCNT = (const int*)(F.ws + WS_WGCNT);
    int* ROWTOK = (int*)(F.ws + WS_ROWTOK); int* ROWPAIR = (int*)(F.ws + WS_ROWPAIR); float* ROWW = (float*)(F.ws + WS_ROWW); int* MTEXP = (int*)(F.ws + WS_MTEXP);
    LAS int* ptot = (LAS int*)F.lds; LAS int* pbef = ptot + 512; LAS int* cnt = pbef + 512; LAS int* wgb = cnt + 32; LAS int* pst = wgb + 32; LAS int* pad = pst + 64; LAS int* ep = pad + 32;
    if (F.G != 256) return;
    const int bx = blockIdx.x;
    { const int e = F.tid & 31, part = F.tid >> 5; int tt = 0, tb = 0;
      for (int w = part * 16; w < part * 16 + 16; ++w) { const int v = WGCNT[w * NE + e]; tt += v; tb += (w < bx) ? v : 0; }
      ptot[part * 32 + e] = tt; pbef[part * 32 + e] = tb; }
    __syncthreads();
    if (F.tid < NE) { int tt = 0, tb = 0; for (int p = 0; p < 16; ++p) { tt += ptot[p * 32 + F.tid]; tb += pbef[p * 32 + F.tid]; } cnt[F.tid] = tt; wgb[F.tid] = tb; pad[F.tid] = (tt + 255) & ~255; }
    __syncthreads();
    if (F.tid == 0) { int s = 0; for (int e = 0; e < NE; ++e) { pst[e] = s; s += pad[e]; } pst[NE] = s; }
    if (F.tid < 256) ep[F.tid] = TOPI[(size_t)bx * 256 + F.tid];
    __syncthreads();
    if (F.tid < 256) { const int p = F.tid, e = ep[p]; int rk = 0; for (int q = 0; q < p; ++q) rk += (ep[q] == e) ? 1 : 0;
        const int dest = pst[e] + wgb[e] + rk; const int pair = bx * 256 + p; ROWTOK[dest] = pair >> 2; ROWPAIR[dest] = pair; ROWW[dest] = TOPW[pair]; }
    if (bx < NE) { const int e = bx; for (int i = pst[e] + cnt[e] + F.tid; i < pst[e] + pad[e]; i += NWAVES * 64) { ROWTOK[i] = 0; ROWPAIR[i] = -1; ROWW[i] = 0.f; } }
    if (bx == 0) { if (F.tid < NE) { for (int mt = pst[F.tid] >> 8; mt < (pst[F.tid] + pad[F.tid]) >> 8; ++mt) MTEXP[mt] = F.tid; } if (F.tid == 0) MTEXP[512] = pst[NE] >> 8; }
}

__device__ __forceinline__ void p10_phase(Frame& F) {
    const float* gpost = F.in(19); const float* MOD = (const float*)(F.ws + WS_MOD); const bf16* YP = (const bf16*)(F.ws + WS_YP);
    const int gw = F.vcu * NWAVES + F.wave;
    if (F.G * NWAVES * 8 != NTOK) return;
    const int row0 = gw * 8, b = row0 / SEQ;
    f32x4 gg[4];
#pragma unroll
    for (int j = 0; j < 4; ++j) { const int k = 4 * F.lane + 256 * j; gg[j] = *(const f32x4*)(MOD + b * NMOD * DM + 5 * DM + k) * *(const f32x4*)(gpost + k); }
    for (int r = 0; r < 8; ++r) { const int row = row0 + r;
        f32x4 y[4]; float ss = 0.f;
#pragma unroll
        for (int j = 0; j < 4; ++j) { f32x4 s = (f32x4){0.f, 0.f, 0.f, 0.f};
#pragma unroll
            for (int k = 0; k < TOPK; ++k) { const v2u w = *(const GAS v2u*)(YP + ((size_t)row * TOPK + k) * DM + 4 * F.lane + 256 * j); s += (f32x4){bflo(w.x), bfhi(w.x), bflo(w.y), bfhi(w.y)}; }
            y[j] = s; ss += (s[0] * s[0] + s[1] * s[1]) + (s[2] * s[2] + s[3] * s[3]); }
        const float rinv = 1.0f / sqrtf(wave_sum(ss) * (1.0f / DM) + RMS_EPS);
#pragma unroll
        for (int j = 0; j < 4; ++j) { float* op = F.out + (size_t)row * DM + 4 * F.lane + 256 * j; *(f32x4*)op = *(const f32x4*)op + gg[j] * (y[j] * rinv); }
    }
}

__global__ void __launch_bounds__(NWAVES * 64, 2) mega_fwd(Args args) {
    extern __shared__ __attribute__((aligned(16))) unsigned char lds[];
    Frame F;
    F.lds = (LAS unsigned char*)lds;
    F.tid = threadIdx.x; F.lane = F.tid & 63; F.wave = __builtin_amdgcn_readfirstlane(F.tid >> 6);
    F.G = gridDim.x; { const int bx = blockIdx.x; F.vcu = (F.G % 8 == 0) ? (bx % 8) * (F.G / 8) + bx / 8 : bx; }
    F.out = args.out; F.ws = args.ws;
    volatile LAS unsigned* MISC = (volatile LAS unsigned*)(F.lds + MISC_OFF);
    for (int u = F.tid; u < (LDS_BYTES - LDSCTL_OFF) / 4; u += NWAVES * 64) ((LAS unsigned*)(F.lds + LDSCTL_OFF))[u] = 0u;
    __syncthreads();
    if (F.tid < 26) ((LAS unsigned long long*)(F.lds + LDSCTL_OFF))[F.tid] = (unsigned long long)args.in[F.tid];
    __syncthreads();
    gu32* ctl = (gu32*)(F.ws + WS_CTL);
    XcdBarrier bar = xcd_barrier_post((unsigned*)(ctl + CW_BAR) + args.li * XCD_BAR_WORDS, MISC + 8);
    const int lo = args.ph_lo, hi = args.ph_hi;
#ifndef PHMASK
#define PHMASK 0x7ff
#endif
#define IN(k) (((PHMASK >> (k)) & 1) && lo <= (k) && (k) < hi)
#ifndef REPMASK
#define REPMASK 0
#endif
#define NREP(k) (((REPMASK >> (k)) & 1) ? 2 : 1)
#define SEAM(k) do { if ((k) != 3 && IN(k) && IN((k) + 1)) xcd_barrier(bar); if ((k) == 3 && IN(3) && IN(5)) xcd_barrier(bar); } while (0)
#define REFRESH() do { int t_; asm volatile("v_mov_b32 %0, %1" : "=v"(t_) : "v"(threadIdx.x)); F.tid = t_; F.lane = t_ & 63; } while (0)
    if (IN(0)) { { REFRESH(); p0_phase(F);  }
      if (NREP(0) > 1) { xcd_barrier(bar); REFRESH(); p0_phase(F);  } } SEAM(0);

    if (IN(1)) { { REFRESH(); p1_phase(F);  }
      if (NREP(1) > 1) { xcd_barrier(bar); REFRESH(); p1_phase(F);  } } SEAM(1);

    if (IN(2)) { { REFRESH();
        pg8::DenseOrder S; S.init((const pg8::bf16_t*)(F.ws + WS_H1), (const pg8::bf16_t*)(F.ws + WS_WIN), NTOK, NPJ, F.G, (int)blockIdx.x);
        pg8::EpiProj E{(pg8::bf16_t*)(F.ws + WS_PJ), PJ_STRIDE, attn_body::C2};
        pg8::gemm_phase<pg8::EpiProj, pg8::DenseOrder>(F.lds, S, E); }
      if (NREP(2) > 1) { xcd_barrier(bar); REFRESH();
        pg8::DenseOrder S; S.init((const pg8::bf16_t*)(F.ws + WS_H1), (const pg8::bf16_t*)(F.ws + WS_WIN), NTOK, NPJ, F.G, (int)blockIdx.x);
        pg8::EpiProj E{(pg8::bf16_t*)(F.ws + WS_PJ), PJ_STRIDE, attn_body::C2};
        pg8::gemm_phase<pg8::EpiProj, pg8::DenseOrder>(F.lds, S, E); } } SEAM(2);

    if (IN(3)) { { REFRESH();
        lru_phase(F);
        const attn_body::AttnTensors AT{(const attn_body::bf16*)(F.ws + WS_PJ) + 2 * PJ_STRIDE, (const attn_body::bf16*)(F.ws + WS_PJ) + 3 * PJ_STRIDE, (const attn_body::bf16*)(F.ws + WS_PJ) + 4 * PJ_STRIDE,
                                        (attn_body::bf16*)(F.ws + WS_MRG), (const float*)(F.ws + WS_LOGF2), (float*)(F.ws + WS_SSQ)};
        const attn_body::StaticOrder S((int)F.G, F.vcu);
        attn_body::attn_phase<attn_body::StaticOrder>((char*)lds, AT, S); }
      if (NREP(3) > 1) { xcd_barrier(bar); REFRESH();
        lru_phase(F);
        const attn_body::AttnTensors AT{(const attn_body::bf16*)(F.ws + WS_PJ) + 2 * PJ_STRIDE, (const attn_body::bf16*)(F.ws + WS_PJ) + 3 * PJ_STRIDE, (const attn_body::bf16*)(F.ws + WS_PJ) + 4 * PJ_STRIDE,
                                        (attn_body::bf16*)(F.ws + WS_MRG), (const float*)(F.ws + WS_LOGF2), (float*)(F.ws + WS_SSQ)};
        const attn_body::StaticOrder S((int)F.G, F.vcu);
        attn_body::attn_phase<attn_body::StaticOrder>((char*)lds, AT, S); } } SEAM(3);


    if (IN(5)) { { REFRESH();
        pg8::DenseOrder S; S.init((const pg8::bf16_t*)(F.ws + WS_MRG), (const pg8::bf16_t*)(F.ws + WS_WOUT), NTOK, DM, F.G, (int)blockIdx.x);
        pg8::EpiOut E{(float*)(F.ws + WS_Y), (const float*)(F.ws + WS_SSQ)};
        pg8::gemm_phase<pg8::EpiOut, pg8::DenseOrder>(F.lds, S, E); }
      if (NREP(5) > 1) { xcd_barrier(bar); REFRESH();
        pg8::DenseOrder S; S.init((const pg8::bf16_t*)(F.ws + WS_MRG), (const pg8::bf16_t*)(F.ws + WS_WOUT), NTOK, DM, F.G, (int)blockIdx.x);
        pg8::EpiOut E{(float*)(F.ws + WS_Y), (const float*)(F.ws + WS_SSQ)};
        pg8::gemm_phase<pg8::EpiOut, pg8::DenseOrder>(F.lds, S, E); } } SEAM(5);

    if (IN(6)) { { REFRESH(); p6_phase(F);  }
      if (NREP(6) > 1) { xcd_barrier(bar); REFRESH(); p6_phase(F);  } } SEAM(6);

    if (IN(7)) { { REFRESH(); p7_phase(F);  }
      if (NREP(7) > 1) { xcd_barrier(bar); REFRESH(); p7_phase(F);  } } SEAM(7);

    if (IN(8)) { { REFRESH();
        const int nmt = ((const int*)(F.ws + WS_MTEXP))[512];
        pg8::UpOrder S{(const unsigned char*)(F.ws + WS_H2), (const unsigned char*)(F.ws + WS_WUP), (const int*)(F.ws + WS_ROWTOK), (const int*)(F.ws + WS_MTEXP), nmt * 8, F.G, F.vcu};
        pg8::EpiUp E{(unsigned char*)(F.ws + WS_ACT), F.in(23)};
        pg8::gemm_phase<pg8::EpiUp, pg8::UpOrder, true>(F.lds, S, E); }
      if (NREP(8) > 1) { xcd_barrier(bar); REFRESH();
        const int nmt = ((const int*)(F.ws + WS_MTEXP))[512];
        pg8::UpOrder S{(const unsigned char*)(F.ws + WS_H2), (const unsigned char*)(F.ws + WS_WUP), (const int*)(F.ws + WS_ROWTOK), (const int*)(F.ws + WS_MTEXP), nmt * 8, F.G, F.vcu};
        pg8::EpiUp E{(unsigned char*)(F.ws + WS_ACT), F.in(23)};
        pg8::gemm_phase<pg8::EpiUp, pg8::UpOrder, true>(F.lds, S, E); } } SEAM(8);

    if (IN(9)) { { REFRESH();
        const int nmt = ((const int*)(F.ws + WS_MTEXP))[512];
        pg8::DownOrder S{(const unsigned char*)(F.ws + WS_ACT), (const unsigned char*)(F.ws + WS_WDN), (const int*)(F.ws + WS_MTEXP), nmt * 4, F.G, F.vcu};
        pg8::EpiDown E{(pg8::bf16_t*)(F.ws + WS_YP), F.in(25), (const int*)(F.ws + WS_ROWPAIR), (const float*)(F.ws + WS_ROWW)};
        pg8::gemm_phase<pg8::EpiDown, pg8::DownOrder, true>(F.lds, S, E); }
      if (NREP(9) > 1) { xcd_barrier(bar); REFRESH();
        const int nmt = ((const int*)(F.ws + WS_MTEXP))[512];
        pg8::DownOrder S{(const unsigned char*)(F.ws + WS_ACT), (const unsigned char*)(F.ws + WS_WDN), (const int*)(F.ws + WS_MTEXP), nmt * 4, F.G, F.vcu};
        pg8::EpiDown E{(pg8::bf16_t*)(F.ws + WS_YP), F.in(25), (const int*)(F.ws + WS_ROWPAIR), (const float*)(F.ws + WS_ROWW)};
        pg8::gemm_phase<pg8::EpiDown, pg8::DownOrder, true>(F.lds, S, E); } } SEAM(9);

    if (IN(10)) { { REFRESH(); p10_phase(F);  }
      if (NREP(10) > 1) { xcd_barrier(bar); REFRESH(); p10_phase(F);  } }
    if (lo == 11) { REFRESH(); lru_phase(F); }
    if (lo == 12) { REFRESH();
        const attn_body::AttnTensors AT{(const attn_body::bf16*)(F.ws + WS_PJ) + 2 * PJ_STRIDE, (const attn_body::bf16*)(F.ws + WS_PJ) + 3 * PJ_STRIDE, (const attn_body::bf16*)(F.ws + WS_PJ) + 4 * PJ_STRIDE,
                                        (attn_body::bf16*)(F.ws + WS_MRG), (const float*)(F.ws + WS_LOGF2), (float*)(F.ws + WS_SSQ)};
        const attn_body::StaticOrder S((int)F.G, F.vcu);
        attn_body::attn_phase<attn_body::StaticOrder>((char*)lds, AT, S); }
#undef IN
#undef SEAM
#undef REFRESH
}

static void launch_mega(hipStream_t stream, void* const* d_in, void* d_out, void* d_ws, int lo, int hi, int li, int grid) {
    Args a{};
    for (int i = 0; i < 26; ++i) a.in[i] = (const float*)d_in[i];
    a.out = (float*)d_out; a.ws = (unsigned char*)d_ws; a.ph_lo = lo; a.ph_hi = hi; a.li = li; a.pad = 0;
    hipLaunchKernelGGL(mega_fwd, dim3(grid), dim3(NWAVES * 64), LDS_BYTES, stream, a);
}

#if MIX < 4
namespace simple {
__device__ __forceinline__ float sigmoidf_(float x) { return 1.f / (1.f + __expf(-x)); }
__device__ __forceinline__ float gelu_tanh(float x) { const float u = 0.7978845608028654f * (x + 0.044715f * x * x * x); return 0.5f * x * (1.f + tanhf(u)); }
__device__ __forceinline__ float log_sigmoid(float z) { return z >= 0.f ? -log1pf(expf(-z)) : z - log1pf(expf(z)); }
__device__ __forceinline__ float softplusf_(float z) { return z > 0.f ? z + log1pf(expf(-z)) : log1pf(expf(z)); }

__device__ __forceinline__ float block_sum_256(float v, float* red) {
    for (int o = 32; o > 0; o >>= 1) v += __shfl_xor(v, o);
    const int w = threadIdx.x >> 6, l = threadIdx.x & 63;
    __syncthreads();
    if (l == 0) red[w] = v;
    __syncthreads();
    return red[0] + red[1] + red[2] + red[3];
}

__global__ void k_ada(const float* c, const float* w_ada, const float* b_ada, float* mod) {
    const int j = blockIdx.x * 256 + threadIdx.x, b = blockIdx.y;
    float acc = b_ada[j];
    for (int k = 0; k < DM; ++k) { const float cv = c[b * DM + k]; acc += cv * sigmoidf_(cv) * w_ada[(size_t)k * (NMOD * DM) + j]; }
    mod[b * NMOD * DM + j] = acc;
}

__global__ void k_prep(const float* x, const float* g, const float* mod, int sh_off, int sc_off, float* h) {
    __shared__ float red[4];
    const int row = blockIdx.x, b = row / SEQ;
    const float* xr = x + (size_t)row * DM;
    float v[4], s = 0.f;
#pragma unroll
    for (int i = 0; i < 4; ++i) { v[i] = xr[threadIdx.x + 256 * i]; s += v[i] * v[i]; }
    const float tot = block_sum_256(s, red);
    const float rinv = rsqrtf(tot / DM + RMS_EPS);
#pragma unroll
    for (int i = 0; i < 4; ++i) { const int k = threadIdx.x + 256 * i;
        h[(size_t)row * DM + k] = v[i] * rinv * g[k] * (1.f + mod[b * NMOD * DM + sc_off + k]) + mod[b * NMOD * DM + sh_off + k]; }
}

struct GemmArgs { const float* A; const float* B; float* C; const float* bias; const int* rowidx; const int* Mptr; int M, N, K, lda, ldb, ldc;
                  size_t gB, gC, gbias; int gidx; };
__global__ void __launch_bounds__(256) k_sgemm(GemmArgs a) {
    __shared__ float As[8][128 + 4], Bs[8][128 + 4];
    const int z = blockIdx.z;
    const float* B = a.B + z * a.gB; float* C = a.C + z * a.gC; const float* bias = a.bias ? a.bias + z * a.gbias : nullptr;
    const int* rowidx = a.rowidx ? a.rowidx + (size_t)z * a.gidx : nullptr;
    const int M = a.Mptr ? a.Mptr[z] : a.M;
    const int m0 = blockIdx.y * 128, n0 = blockIdx.x * 128;
    if (m0 >= M) return;
    const int tid = threadIdx.x, tx = tid & 15, ty = tid >> 4;
    float acc[8][8];
#pragma unroll
    for (int i = 0; i < 8; ++i)
#pragma unroll
        for (int j = 0; j < 8; ++j) acc[i][j] = 0.f;
    const int ar = tid >> 1, ak = (tid & 1) * 4;
    const int am = m0 + ar; const bool aok = am < M;
    const int arow = aok ? (rowidx ? rowidx[am] : am) : 0;
    const float* Ap = a.A + (size_t)arow * a.lda + ak;
    const int bk = tid >> 5, bn = (tid & 31) * 4;
    for (int k0 = 0; k0 < a.K; k0 += 8) {
        float4 av = aok ? *(const float4*)(Ap + k0) : make_float4(0.f, 0.f, 0.f, 0.f);
        float bv[4];
#pragma unroll
        for (int j = 0; j < 4; ++j) { const int n = n0 + bn + j; bv[j] = n < a.N ? B[(size_t)(k0 + bk) * a.ldb + n] : 0.f; }
        __syncthreads();
        As[ak + 0][ar] = av.x; As[ak + 1][ar] = av.y; As[ak + 2][ar] = av.z; As[ak + 3][ar] = av.w;
#pragma unroll
        for (int j = 0; j < 4; ++j) Bs[bk][bn + j] = bv[j];
        __syncthreads();
#pragma unroll
        for (int k = 0; k < 8; ++k) {
            float af[8], bf[8];
#pragma unroll
            for (int i = 0; i < 8; ++i) af[i] = As[k][ty * 8 + i];
#pragma unroll
            for (int j = 0; j < 8; ++j) bf[j] = Bs[k][tx * 8 + j];
#pragma unroll
            for (int i = 0; i < 8; ++i)
#pragma unroll
                for (int j = 0; j < 8; ++j) acc[i][j] += af[i] * bf[j];
        }
    }
#pragma unroll
    for (int i = 0; i < 8; ++i) { const int m = m0 + ty * 8 + i; if (m >= M) continue;
#pragma unroll
        for (int j = 0; j < 8; ++j) { const int n = n0 + tx * 8 + j; if (n < a.N) C[(size_t)m * a.ldc + n] = acc[i][j] + (bias ? bias[n] : 0.f); } }
}

__global__ void __launch_bounds__(64) k_lru(const float* proj, const float* conv_w, const float* conv_b, const float* wa, const float* ba, const float* wx, const float* bx,
                                            const float* lam, float* lru_out) {
    __shared__ float xc[64];
    const int b = blockIdx.x >> 3, g = blockIdx.x & 7, j = threadIdx.x, ch = g * 64 + j;
    float wac[64], wxc[64];
#pragma unroll
    for (int i = 0; i < 64; ++i) { wac[i] = wa[(g * 64 + i) * 64 + j]; wxc[i] = wx[(g * 64 + i) * 64 + j]; }
    const float cw0 = conv_w[0 * DLRU + ch], cw1 = conv_w[1 * DLRU + ch], cw2 = conv_w[2 * DLRU + ch], cw3 = conv_w[3 * DLRU + ch], cb = conv_b[ch];
    const float baj = ba[ch], bxj = bx[ch], sp = softplusf_(-lam[ch]);
    float x1 = 0.f, x2 = 0.f, x3 = 0.f, h = 0.f;
    for (int t = 0; t < SEQ; ++t) {
        const size_t row = (size_t)b * SEQ + t;
        const float x0 = proj[row * NPROJ + ch];
        const float y = proj[row * NPROJ + DLRU + ch];
        const float xcv = cw0 * x3 + cw1 * x2 + cw2 * x1 + cw3 * x0 + cb;
        x3 = x2; x2 = x1; x1 = x0;
        __syncthreads();
        xc[j] = xcv;
        __syncthreads();
        float ra = baj, ri = bxj;
#pragma unroll
        for (int i = 0; i < 64; ++i) { const float xi = xc[i]; ra += xi * wac[i]; ri += xi * wxc[i]; }
        const float r = sigmoidf_(ra), ig = sigmoidf_(ri);
        const float log_a = -8.0f * r * sp;
        const float av = expf(log_a);
        const float gx = sqrtf(1.f - expf(2.f * log_a)) * (ig * xcv);
        h = av * h + gx;
        lru_out[row * DLRU + ch] = h * gelu_tanh(y);
    }
}

__global__ void k_cum(const float* proj, const float* fb, float* cum) {
    const int b = blockIdx.x, h = threadIdx.x;
    float c = 0.f;
    for (int t = 0; t < SEQ; ++t) { c += log_sigmoid(proj[((size_t)b * SEQ + t) * NPROJ + 2 * DLRU + 3 * DATT + h] + fb[h]); cum[((size_t)b * NH + h) * SEQ + t] = c; }
}
__global__ void __launch_bounds__(256) k_attn(const float* proj, const float* cum, float* attn_out) {
    __shared__ float Ks[64][64], Vs[64][64], Cs[64];
    const int qb = blockIdx.x, h = blockIdx.y, b = blockIdx.z, t = qb * 256 + threadIdx.x;
    const size_t rowq = (size_t)b * SEQ + t;
    float q[64], acc[64];
#pragma unroll
    for (int d = 0; d < 64; ++d) { q[d] = proj[rowq * NPROJ + 2 * DLRU + h * 64 + d] * 0.125f; acc[d] = 0.f; }
    const float ct = cum[((size_t)b * NH + h) * SEQ + t];
    float m = -INFINITY, l = 0.f;
    const int send = qb * 256 + 256;
    for (int s0 = 0; s0 < send; s0 += 64) {
        __syncthreads();
        for (int i = threadIdx.x; i < 64 * 64; i += 256) { const int r = i >> 6, d = i & 63; const size_t rk = (size_t)b * SEQ + s0 + r;
            Ks[r][d] = proj[rk * NPROJ + 2 * DLRU + DATT + h * 64 + d]; Vs[r][d] = proj[rk * NPROJ + 2 * DLRU + 2 * DATT + h * 64 + d]; }
        if (threadIdx.x < 64) Cs[threadIdx.x] = cum[((size_t)b * NH + h) * SEQ + s0 + threadIdx.x];
        __syncthreads();
        for (int r = 0; r < 64; ++r) {
            const int s = s0 + r; if (s > t) break;
            float dot = 0.f;
#pragma unroll
            for (int d = 0; d < 64; ++d) dot += q[d] * Ks[r][d];
            const float lg = dot + ct - Cs[r];
            const float mn = fmaxf(m, lg), sc = expf(m - mn), p = expf(lg - mn);
            l = l * sc + p;
#pragma unroll
            for (int d = 0; d < 64; ++d) acc[d] = acc[d] * sc + p * Vs[r][d];
            m = mn;
        }
    }
    const float li = 1.f / l;
#pragma unroll
    for (int d = 0; d < 64; ++d) attn_out[rowq * DATT + h * 64 + d] = acc[d] * li;
}

__global__ void k_merge(const float* lru_out, const float* attn_out, const float* gn_lru, const float* gn_attn, float* merged) {
    __shared__ float red[4];
    const int row = blockIdx.x, tid = threadIdx.x;
    const float a0 = lru_out[(size_t)row * DLRU + tid], a1 = lru_out[(size_t)row * DLRU + 256 + tid];
    const float b0 = attn_out[(size_t)row * DATT + tid], b1 = attn_out[(size_t)row * DATT + 256 + tid];
    const float sa = block_sum_256(a0 * a0 + a1 * a1, red);
    const float sb = block_sum_256(b0 * b0 + b1 * b1, red);
    const float ra = rsqrtf(sa / DLRU + RMS_EPS), rb = rsqrtf(sb / DATT + RMS_EPS);
    float* o = merged + (size_t)row * DM;
    o[tid] = a0 * ra * gn_lru[tid]; o[256 + tid] = a1 * ra * gn_lru[256 + tid];
    o[512 + tid] = b0 * rb * gn_attn[tid]; o[768 + tid] = b1 * rb * gn_attn[256 + tid];
}

__global__ void k_resid(const float* xin, const float* y, const float* gpost, const float* mod, int gate_off, float* xo) {
    __shared__ float red[4];
    const int row = blockIdx.x, b = row / SEQ;
    float v[4], s = 0.f;
#pragma unroll
    for (int i = 0; i < 4; ++i) { v[i] = y[(size_t)row * DM + threadIdx.x + 256 * i]; s += v[i] * v[i]; }
    const float rinv = rsqrtf(block_sum_256(s, red) / DM + RMS_EPS);
#pragma unroll
    for (int i = 0; i < 4; ++i) { const int k = threadIdx.x + 256 * i;
        xo[(size_t)row * DM + k] = xin[(size_t)row * DM + k] + mod[b * NMOD * DM + gate_off + k] * (v[i] * rinv * gpost[k]); }
}

__global__ void k_route(const float* logits, int* cnt, int* list_tok, int* list_pair, float* pair_w) {
    const int tok = blockIdx.x * 256 + threadIdx.x;
    float lg[NE];
#pragma unroll
    for (int e = 0; e < NE; ++e) lg[e] = logits[(size_t)tok * NE + e];
    int idx[TOPK]; float val[TOPK];
#pragma unroll
    for (int k = 0; k < TOPK; ++k) { int bi = 0; float bv = -INFINITY;
#pragma unroll
        for (int e = 0; e < NE; ++e) { if (lg[e] > bv) { bv = lg[e]; bi = e; } }
        idx[k] = bi; val[k] = bv;
#pragma unroll
        for (int e = 0; e < NE; ++e) if (e == bi) lg[e] = -INFINITY; }
    float den = 0.f; float p[TOPK];
#pragma unroll
    for (int k = 0; k < TOPK; ++k) { p[k] = expf(val[k] - val[0]); den += p[k]; }
#pragma unroll
    for (int k = 0; k < TOPK; ++k) { const int e = idx[k]; const int pos = atomicAdd(&cnt[e], 1);
        list_tok[(size_t)e * NTOK + pos] = tok; list_pair[(size_t)e * NTOK + pos] = tok * TOPK + k; pair_w[tok * TOPK + k] = p[k] / den; }
}
__global__ void k_act(const float* gu, const int* cnt, float* act) {
    const int e = blockIdx.z, pos = blockIdx.y; if (pos >= cnt[e]) return;
    const size_t r = (size_t)e * NTOK + pos;
    for (int j = threadIdx.x; j < DEXP; j += 256) { const float gl = fminf(gu[r * 2 * DEXP + j], 7.f); const float li = fminf(fmaxf(gu[r * 2 * DEXP + DEXP + j], -7.f), 7.f);
        act[r * DEXP + j] = gl * sigmoidf_(1.702f * gl) * (li + 1.f); }
}
__global__ void k_scatter(const float* dn, const int* cnt, const int* list_pair, float* ypair) {
    const int e = blockIdx.z, pos = blockIdx.y; if (pos >= cnt[e]) return;
    const size_t r = (size_t)e * NTOK + pos; const int pair = list_pair[r];
    for (int j = threadIdx.x; j < DM; j += 256) ypair[(size_t)pair * DM + j] = dn[r * DM + j];
}
__global__ void k_combine(const float* ypair, const float* pair_w, float* y) {
    const int tok = blockIdx.x;
    for (int j = threadIdx.x; j < DM; j += 256) { float s = 0.f; for (int k = 0; k < TOPK; ++k) s += pair_w[tok * TOPK + k] * ypair[((size_t)tok * TOPK + k) * DM + j]; y[(size_t)tok * DM + j] = s; }
}


__global__ void k_conv_proj(const float* proj, const float* fb, unsigned short* PJ, float* LOGF2) {
    const int row = blockIdx.x;
    for (int c = threadIdx.x; c < 2560; c += 256) { const int t = c >> 9, cc = c & 511; float v = proj[(size_t)row * NPROJ + c]; if (t == 2) v *= attn_body::C2; PJ[(size_t)t * PJ_STRIDE + (size_t)row * 512 + cc] = (unsigned short)f2bf(v); }
    if (threadIdx.x < 8) LOGF2[(size_t)row * 8 + threadIdx.x] = log_sigmoid(proj[(size_t)row * NPROJ + 2560 + threadIdx.x] + fb[threadIdx.x]) * 1.4426950408889634f;
}
__global__ void k_conv_mix(const float* lru_out, const float* attn_out, const float* gn_lru, unsigned short* MRG, float* SSQ) {
    __shared__ float red[4];
    const int row = blockIdx.x, tid = threadIdx.x;
    const float a0 = lru_out[(size_t)row * DLRU + tid], a1 = lru_out[(size_t)row * DLRU + 256 + tid];
    const float ra = rsqrtf(block_sum_256(a0 * a0 + a1 * a1, red) / DLRU + RMS_EPS);
    MRG[(size_t)row * 1024 + 512 + tid] = (unsigned short)f2bf(a0 * ra * gn_lru[tid]); MRG[(size_t)row * 1024 + 768 + tid] = (unsigned short)f2bf(a1 * ra * gn_lru[256 + tid]);
    for (int i = 0; i < 2; ++i) { const int c = tid + 256 * i; const unsigned short hb = (unsigned short)f2bf(attn_out[(size_t)row * DATT + c]); MRG[(size_t)row * 1024 + c] = hb;
        float q = bf1(hb); q = q * q; for (int o = 1; o < 64; o <<= 1) q += __shfl_xor(q, o); if ((tid & 63) == 0) SSQ[(size_t)row * 8 + (c >> 6)] = q; }
}
static void sgemm(hipStream_t st, const float* A, const float* B, float* C, const float* bias, int M, int N, int K, int lda, int ldb, int ldc) {
    GemmArgs a{}; a.A = A; a.B = B; a.C = C; a.bias = bias; a.M = M; a.N = N; a.K = K; a.lda = lda; a.ldb = ldb; a.ldc = ldc;
    hipLaunchKernelGGL(k_sgemm, dim3((N + 127) / 128, (M + 127) / 128, 1), dim3(256), 0, st, a);
}
}
#endif

extern "C" void kernel_launch(void* const* d_in, const int* in_sizes, int n_in, void* d_out, int out_size, void* d_ws, size_t ws_size, hipStream_t stream) {
    static int grid = 0;
    if (grid == 0) {
        int dev = 0, cus = 0;
        if (n_in != 26 || out_size != NTOK * DM || ws_size < WS_END) { fprintf(stderr, "kernel_launch: unexpected problem shape / workspace (%d inputs, out %d, ws %zu)\n", n_in, out_size, ws_size); grid = -1; return; }
        if (hipGetDevice(&dev) != hipSuccess || hipDeviceGetAttribute(&cus, hipDeviceAttributeMultiprocessorCount, dev) != hipSuccess) { grid = -1; return; }
        if (hipFuncSetAttribute((const void*)mega_fwd, hipFuncAttributeMaxDynamicSharedMemorySize, LDS_BYTES) != hipSuccess) { fprintf(stderr, "kernel_launch: hipFuncSetAttribute failed\n"); grid = -1; return; }
        grid = cus;
        if (grid != 256) fprintf(stderr, "kernel_launch: %d CUs; this kernel is laid out for 256\n", grid);
    }
    if (grid < 0) return;
    (void)hipMemsetAsync((char*)d_ws + WS_CTL, 0, CTL_ZERO_BYTES, stream);
#if MIX >= 4
    launch_mega(stream, d_in, d_out, d_ws, 0, NPHASES, 0, grid);
#ifdef EXTRA_LO
    launch_mega(stream, d_in, d_out, d_ws, EXTRA_LO, EXTRA_HI, 1, grid);
#endif
#else
    using namespace simple;
    const float* x = (const float*)d_in[0]; const float* c = (const float*)d_in[1]; const float* w_ada = (const float*)d_in[2]; const float* b_ada = (const float*)d_in[3];
    const float* g_mix_pre = (const float*)d_in[4]; const float* w_in = (const float*)d_in[6];
    const float* conv_w = (const float*)d_in[7]; const float* conv_b = (const float*)d_in[8]; const float* wa = (const float*)d_in[9]; const float* ba = (const float*)d_in[10];
    const float* wx = (const float*)d_in[11]; const float* bx = (const float*)d_in[12]; const float* lam = (const float*)d_in[13]; const float* fb = (const float*)d_in[14];
    const float* gn_lru = (const float*)d_in[15]; const float* gn_attn = (const float*)d_in[16]; const float* w_out = (const float*)d_in[17];
    char* ws = (char*)d_ws;
    float* mod_s = (float*)(ws + 7 * MiB + 512 * KiB);
    float* h1 = (float*)(ws + 416 * MiB); float* proj = (float*)(ws + 480 * MiB); float* lru_out = (float*)(ws + 641 * MiB); float* attn_out = (float*)(ws + 673 * MiB); float* cum = (float*)(ws + 705 * MiB);
    float* merged = h1; float* Yb = (float*)(ws + WS_Y);
    launch_mega(stream, d_in, d_out, d_ws, 0, 1, 0, grid);
    hipLaunchKernelGGL(k_ada, dim3(NMOD * DM / 256, BATCH), dim3(256), 0, stream, c, w_ada, b_ada, mod_s);
    hipLaunchKernelGGL(k_prep, dim3(NTOK), dim3(256), 0, stream, x, g_mix_pre, mod_s, 0 * DM, 1 * DM, h1);
    sgemm(stream, h1, w_in, proj, nullptr, NTOK, NPROJ, DM, DM, NPROJ, NPROJ);
#if MIX <= 2
    hipLaunchKernelGGL(k_lru, dim3(BATCH * 8), dim3(64), 0, stream, proj, conv_w, conv_b, wa, ba, wx, bx, lam, lru_out);
    hipLaunchKernelGGL(k_cum, dim3(BATCH), dim3(NH), 0, stream, proj, fb, cum);
    hipLaunchKernelGGL(k_attn, dim3(SEQ / 256, NH, BATCH), dim3(256), 0, stream, proj, cum, attn_out);
#endif
#if MIX == 1
    hipLaunchKernelGGL(k_merge, dim3(NTOK), dim3(256), 0, stream, lru_out, attn_out, gn_lru, gn_attn, merged);
    sgemm(stream, merged, w_out, Yb, nullptr, NTOK, DM, DM, DM, DM, DM);
    launch_mega(stream, d_in, d_out, d_ws, 6, NPHASES, 1, grid);
#elif MIX == 2
    hipLaunchKernelGGL(k_conv_mix, dim3(NTOK), dim3(256), 0, stream, lru_out, attn_out, gn_lru, (unsigned short*)(ws + WS_MRG), (float*)(ws + WS_SSQ));
    launch_mega(stream, d_in, d_out, d_ws, 5, NPHASES, 1, grid);
#elif MIX == 3
    hipLaunchKernelGGL(k_conv_proj, dim3(NTOK), dim3(256), 0, stream, proj, fb, (unsigned short*)(ws + WS_PJ), (float*)(ws + WS_LOGF2));
    launch_mega(stream, d_in, d_out, d_ws, 3, NPHASES, 1, grid);
#endif
    (void)gn_attn; (void)w_out; (void)cum; (void)lru_out; (void)attn_out; (void)merged; (void)Yb;
#endif
}
```

```cpp
#include <hip/hip_runtime.h>
#include <hip/hip_bf16.h>
#include <cstdio>
#include <cstdint>
#include <cmath>

#define MIX 4

constexpr int DM = 1024, BATCH = 8, SEQ = 2048, NTOK = BATCH * SEQ;
constexpr int DLRU = 512, DATT = 512, NH = 8, HD = 64, NPROJ = 2 * DLRU + 3 * DATT + NH, NPJ = 2560;
constexpr int NE = 32, TOPK = 4, DEXP = 1024, NMOD = 6;
constexpr float RMS_EPS = 1e-6f;
constexpr int MAXROWS = NTOK * TOPK + NE * 256;
constexpr int MAXMT = MAXROWS / 256;

namespace pg8 {
#define PG8_LAS __attribute__((address_space(3)))
typedef unsigned short bf16_t;
typedef short bf16x8 __attribute__((ext_vector_type(8)));
typedef float f32x4 __attribute__((ext_vector_type(4)));
typedef float f32x2 __attribute__((ext_vector_type(2)));
typedef unsigned u32x4 __attribute__((ext_vector_type(4)));
constexpr int BM = 256, BK = 64, HALF = 128, HTB = HALF * BK * 2  , STAGE_BYTES = 8 * HTB, NXCD = 8, WGM = 8;
constexpr int GK = 1024, GNT = GK / BK;
typedef int i32x8 __attribute__((ext_vector_type(8)));
typedef int i32x4 __attribute__((ext_vector_type(4)));
constexpr int F8_SCALE_W = 0x79797979, F8_SCALE_A = 0x7f7f7f7f;

__host__ __device__ __forceinline__ int lds_byte(int r, int c) { const int st = (r >> 4) * 2 + (c >> 5), rr = r & 15, cc = c & 31, ob = rr * 64 + cc * 2; return st * 1024 + (ob ^ (((ob >> 9) & 1) << 5)); }
__host__ __device__ __forceinline__ void stage_rc(int b, int& R, int& C) { const int st = b / 1024, sb = b % 1024, swz = sb ^ (((sb >> 9) & 1) << 5); R = (st >> 1) * 16 + swz / 64; C = (st & 1) * 32 + (swz % 64) / 2; }
__host__ __device__ __forceinline__ int perm32(int rho) { const int n = rho >> 4, i = rho & 15; return 8 * (i >> 2) + 4 * n + (i & 3); }

struct Unit { const char* A0; const char* A1; const char* B0; const char* B1; int pm, pn, e; };

__device__ __forceinline__ void mfma_f8_acc(f32x4& acc, const i32x8& b, const i32x8& a, int sw, int sa) {
    asm volatile("v_mfma_scale_f32_16x16x128_f8f6f4 %0, %1, %2, %0, %3, %4 op_sel_hi:[0,0,0]" : "+v"(acc) : "v"(b), "v"(a), "v"(sw), "v"(sa)); }
__device__ __forceinline__ unsigned cvt_pk_bf16(float lo, float hi) { unsigned r; asm volatile("v_cvt_pk_bf16_f32 %0, %1, %2" : "=v"(r) : "v"(lo), "v"(hi)); return r; }

template <class Epi, class Sched, bool F8 = false>
__device__ __forceinline__ void gemm_phase(PG8_LAS unsigned char* lds, const Sched& S, const Epi& E) {
    const int tid = threadIdx.x, wid = __builtin_amdgcn_readfirstlane(tid >> 6), lane = tid & 63, wr = wid >> 2, wc = wid & 3, fr = lane & 15, fq = lane >> 4;
    constexpr int KB = F8 ? GK : GK * 2, nt = F8 ? GK / 128 : GNT;
    int Rr[2], Cc[2];
    unsigned voffB[2], cvA[2][2], nvA[2][2];
#pragma unroll
    for (int i = 0; i < 2; ++i) { stage_rc(tid * 16 + i * 8192, Rr[i], Cc[i]); const int Rb = Epi::PERM ? ((Rr[i] & ~31) + perm32(Rr[i] & 31)) : Rr[i]; voffB[i] = (unsigned)(Rb * KB + Cc[i] * 2); }
    constexpr size_t kstep = (size_t)(BK * 2);
    const unsigned ldsw = (unsigned)wid * 1024u;
    const int aoff = lds_byte(wr * 64 + fr, fq * 8), boff = lds_byte(wc * 32 + fr, fq * 8);
#define PG8_SA(b, h) (((b) * 2 + (h)) * HTB)
#define PG8_SB(b, h) ((4 + (b) * 2 + (h)) * HTB)
#define PG8_STAGE(bufoff, gbase, voff) do { _Pragma("unroll") for (int _i = 0; _i < 2; ++_i) \
        __builtin_amdgcn_global_load_lds((const unsigned*)((const char*)(gbase) + (voff)[_i]), (PG8_LAS unsigned*)(lds + (bufoff) + ldsw + _i * 8192), 16, 0, 0); } while (0)
#define PG8_LD8(p) __builtin_shufflevector(*(const PG8_LAS i32x4*)(p), *(const PG8_LAS i32x4*)((p) + 1024), 0, 1, 2, 3, 4, 5, 6, 7)
#define PG8_LDA(dst, b, h) do { _Pragma("unroll") for (int m = 0; m < 4; ++m) { if constexpr (F8) { dst##8[m] = PG8_LD8(lds + PG8_SA(b, h) + aoff + m * 2048); } \
        else { _Pragma("unroll") for (int k = 0; k < 2; ++k) dst[m][k] = *(const PG8_LAS bf16x8*)(lds + PG8_SA(b, h) + aoff + m * 2048 + k * 1024); } } } while (0)
#define PG8_LDB(dst, b, h) do { _Pragma("unroll") for (int n = 0; n < 2; ++n) { if constexpr (F8) { dst##8[n] = PG8_LD8(lds + PG8_SB(b, h) + boff + n * 2048); } \
        else { _Pragma("unroll") for (int k = 0; k < 2; ++k) dst[n][k] = *(const PG8_LAS bf16x8*)(lds + PG8_SB(b, h) + boff + n * 2048 + k * 1024); } } } while (0)
#define PG8_MMA(ai, bj, At, Bt) do { __builtin_amdgcn_s_setprio(1); _Pragma("unroll") for (int m = 0; m < 4; ++m) _Pragma("unroll") for (int n = 0; n < 2; ++n) { \
        if constexpr (F8) { mfma_f8_acc(acc[ai][bj][m][n], Bt##8[n], At##8[m], scw, sca); } \
        else { _Pragma("unroll") for (int k = 0; k < 2; ++k) acc[ai][bj][m][n] = __builtin_amdgcn_mfma_f32_16x16x32_bf16(Bt[n][k], At[m][k], acc[ai][bj][m][n], 0, 0, 0); } } \
        __builtin_amdgcn_s_setprio(0); } while (0)
#define PG8_WAIT_V(n) asm volatile("s_waitcnt vmcnt(" #n ")" ::: "memory")
#define PG8_WAIT_L(n) asm volatile("s_waitcnt lgkmcnt(" #n ")" ::: "memory")
#define PG8_BAR __builtin_amdgcn_s_barrier()
#define PG8_SCHED __builtin_amdgcn_sched_barrier(0)
#define PG8_VOFF(dst, u) do { _Pragma("unroll") for (int _h = 0; _h < 2; ++_h) _Pragma("unroll") for (int _i = 0; _i < 2; ++_i) { \
        const int _row = Sched::GATHER ? S.row_of(u, _h * HALF + Rr[_i]) : Rr[_i]; dst[_h][_i] = (unsigned)(_row * KB + Cc[_i] * 2); } } while (0)
    Unit cur, nxt; int ui = 0;
    if (!S.next(0, cur)) return;
    f32x4 acc[2][2][4][2];
#pragma unroll
    for (int a = 0; a < 2; ++a)
#pragma unroll
        for (int b = 0; b < 2; ++b)
#pragma unroll
            for (int m = 0; m < 4; ++m)
#pragma unroll
                for (int n = 0; n < 2; ++n) acc[a][b][m][n] = (f32x4){0.f, 0.f, 0.f, 0.f};
    const int scw = F8_SCALE_W, sca = F8_SCALE_A;
    bf16x8 At[4][2], B0[2][2], B1[2][2]; i32x8 At8[4], B08[2], B18[2];
    PG8_VOFF(cvA, cur);
    if (Sched::GATHER) { asm volatile("s_waitcnt vmcnt(0)" ::: "memory"); }
    PG8_STAGE(PG8_SB(0, 0), cur.B0, voffB); PG8_STAGE(PG8_SB(0, 1), cur.B1, voffB); PG8_STAGE(PG8_SA(0, 0), cur.A0, cvA[0]); PG8_STAGE(PG8_SA(0, 1), cur.A1, cvA[1]);
    if (wr == 1) PG8_BAR;
    PG8_WAIT_V(2); PG8_BAR;
    PG8_STAGE(PG8_SB(1, 0), cur.B0 + kstep, voffB); PG8_STAGE(PG8_SA(1, 0), cur.A0 + kstep, cvA[0]); PG8_STAGE(PG8_SB(1, 1), cur.B1 + kstep, voffB);
    PG8_WAIT_V(6); PG8_BAR;
    for (;;) {
        const bool has_next = S.next(ui + 1, nxt);
        if (!has_next) nxt = cur;
        if (has_next) { PG8_VOFF(nvA, nxt); }
        else {
#pragma unroll
            for (int _h = 0; _h < 2; ++_h)
#pragma unroll
                for (int _i = 0; _i < 2; ++_i) nvA[_h][_i] = cvA[_h][_i]; }
#pragma unroll 1
        for (int t = 0; t < nt; t += 2) {
            const bool last = (t == nt - 2);
            if (Epi::MID && t == nt / 2) E.mid(acc, cur, wr, wc, fr, fq);
            const char* a1_1 = cur.A1 + (size_t)(t + 1) * kstep;
            const char* a2_0 = last ? nxt.A0 : cur.A0 + (size_t)(t + 2) * kstep; const char* a2_1 = last ? nxt.A1 : cur.A1 + (size_t)(t + 2) * kstep;
            const char* b2_0 = last ? nxt.B0 : cur.B0 + (size_t)(t + 2) * kstep; const char* b2_1 = last ? nxt.B1 : cur.B1 + (size_t)(t + 2) * kstep;
            const char* a3_0 = a2_0 + kstep; const char* a3_1 = a2_1 + kstep; const char* b3_0 = b2_0 + kstep; const char* b3_1 = b2_1 + kstep;
            unsigned sv0[2], sv1[2];
#pragma unroll
            for (int _i = 0; _i < 2; ++_i) { sv0[_i] = last ? nvA[0][_i] : cvA[0][_i]; sv1[_i] = last ? nvA[1][_i] : cvA[1][_i]; }
            PG8_LDB(B0, 0, 0); PG8_LDB(B1, 0, 1); PG8_SCHED; PG8_LDA(At, 0, 0); PG8_STAGE(PG8_SA(1, 1), a1_1, cvA[1]);
            PG8_WAIT_V(8); PG8_WAIT_L(0); PG8_BAR; PG8_MMA(0, 0, At, B0); PG8_MMA(0, 1, At, B1); PG8_BAR; PG8_SCHED;
            PG8_LDA(At, 0, 1); PG8_STAGE(PG8_SB(0, 0), b2_0, voffB); PG8_STAGE(PG8_SB(0, 1), b2_1, voffB); PG8_STAGE(PG8_SA(0, 0), a2_0, sv0);
            PG8_WAIT_V(8); PG8_WAIT_L(0); PG8_BAR; PG8_MMA(1, 0, At, B0); PG8_MMA(1, 1, At, B1); PG8_BAR; PG8_SCHED;
            PG8_LDB(B0, 1, 0); PG8_LDB(B1, 1, 1); PG8_SCHED; PG8_LDA(At, 1, 0); PG8_STAGE(PG8_SA(0, 1), a2_1, sv1);
            PG8_WAIT_V(8); PG8_WAIT_L(0); PG8_BAR; PG8_MMA(0, 0, At, B0); PG8_MMA(0, 1, At, B1); PG8_BAR; PG8_SCHED;
            PG8_LDA(At, 1, 1); PG8_STAGE(PG8_SB(1, 0), b3_0, voffB); PG8_STAGE(PG8_SB(1, 1), b3_1, voffB); PG8_STAGE(PG8_SA(1, 0), a3_0, sv0);
            PG8_WAIT_V(8); PG8_WAIT_L(0); PG8_BAR; PG8_MMA(1, 0, At, B0); PG8_MMA(1, 1, At, B1); PG8_BAR; PG8_SCHED;
            (void)a3_1; (void)b3_1;
        }
        if (wr == 0) PG8_BAR;
        if constexpr (F8) { asm volatile("s_nop 15\n\ts_nop 15\n\ts_nop 7" ::: "memory"); }
        E(acc, cur, wr, wc, fr, fq);
        if (!has_next) break;
#pragma unroll
        for (int a = 0; a < 2; ++a)
#pragma unroll
            for (int b = 0; b < 2; ++b)
#pragma unroll
                for (int m = 0; m < 4; ++m)
#pragma unroll
                    for (int n = 0; n < 2; ++n) acc[a][b][m][n] = (f32x4){0.f, 0.f, 0.f, 0.f};
        cur = nxt; ++ui;
#pragma unroll
        for (int _h = 0; _h < 2; ++_h)
#pragma unroll
            for (int _i = 0; _i < 2; ++_i) cvA[_h][_i] = nvA[_h][_i];
        if (wr == 1) PG8_BAR;
    }
    PG8_WAIT_V(0);
    PG8_BAR;
#undef PG8_SA
#undef PG8_SB
#undef PG8_STAGE
#undef PG8_LDA
#undef PG8_LDB
#undef PG8_MMA
#undef PG8_LD8
#undef PG8_WAIT_V
#undef PG8_WAIT_L
#undef PG8_BAR
#undef PG8_SCHED
#undef PG8_VOFF
}
}

namespace pg8 {

struct DenseOrder {
    static constexpr bool GATHER = false;
    const bf16_t* A; const bf16_t* Bt; int nM, nN, nwg, G, c;
    __device__ __forceinline__ void init(const bf16_t* A_, const bf16_t* Bt_, int M, int N, int G_, int c_) { A = A_; Bt = Bt_; nM = M / BM; nN = N / BM; nwg = nM * nN; G = G_; c = c_; }
    __device__ __forceinline__ bool next(int i, Unit& u) const {
        const long L = (long)i * G + c; if (L >= nwg) return false;
        int wgid = (int)L; { const int q = nwg / NXCD, r = nwg % NXCD, xcd = wgid % NXCD, off = wgid / NXCD; wgid = (xcd < r ? xcd * (q + 1) : r * (q + 1) + (xcd - r) * q) + off; }
        const int nig = WGM * nN, gid = wgid / nig, fm = gid * WGM, gsz = (nM - fm) < WGM ? (nM - fm) : WGM;
        u.pm = fm + ((wgid % nig) % gsz); u.pn = (wgid % nig) / gsz; u.e = 0;
        u.A0 = (const char*)A + (size_t)u.pm * BM * GK * 2; u.A1 = u.A0 + (size_t)HALF * GK * 2;
        u.B0 = (const char*)Bt + (size_t)u.pn * BM * GK * 2; u.B1 = u.B0 + (size_t)HALF * GK * 2;
        return true;
    }
    __device__ __forceinline__ int row_of(const Unit&, int r) const { return r; }
};
struct UpOrder {
    static constexpr bool GATHER = true;
    const unsigned char* H2; const unsigned char* WupT; const int* row_tok; const int* mt_exp; int nunits, G, c;
    __device__ __forceinline__ bool next(int i, Unit& u) const {
        const int L = i * G + c; if (L >= nunits) return false;
        u.pm = L >> 3; u.pn = L & 7; u.e = mt_exp[u.pm];
        u.A0 = (const char*)H2; u.A1 = (const char*)H2;
        u.B0 = (const char*)WupT + ((size_t)u.e * 2 * DEXP + (size_t)u.pn * HALF) * GK; u.B1 = u.B0 + (size_t)DEXP * GK;
        return true;
    }
    __device__ __forceinline__ int row_of(const Unit& u, int r) const { return row_tok[u.pm * BM + r]; }
};
struct DownOrder {
    static constexpr bool GATHER = false;
    const unsigned char* ACT; const unsigned char* WdnT; const int* mt_exp; int nunits, G, c;
    __device__ __forceinline__ bool next(int i, Unit& u) const {
        const int L = i * G + c; if (L >= nunits) return false;
        u.pm = L >> 2; u.pn = L & 3; u.e = mt_exp[u.pm];
        u.A0 = (const char*)ACT + (size_t)u.pm * BM * GK; u.A1 = u.A0 + (size_t)HALF * GK;
        u.B0 = (const char*)WdnT + ((size_t)u.e * DM + (size_t)u.pn * BM) * GK; u.B1 = u.B0 + (size_t)HALF * GK;
        return true;
    }
    __device__ __forceinline__ int row_of(const Unit&, int r) const { return r; }
};

struct EpiProj {
    static constexpr bool PERM = true, MID = false;
    bf16_t* O; size_t tstride; float qscale;
    __device__ __forceinline__ void mid(f32x4 (&)[2][2][4][2], const Unit&, int, int, int, int) const {}
    __device__ __forceinline__ void operator()(const f32x4 (&acc)[2][2][4][2], const Unit& u, int wr, int wc, int fr, int fq) const {
        const int t = u.pn >> 1; bf16_t* base = O + (size_t)t * tstride; const float sc = (t == 2) ? qscale : 1.f;
        const int row0 = u.pm * BM + wr * 64 + fr, col0 = (u.pn & 1) * BM + wc * 32 + 8 * fq;
#pragma unroll
        for (int ai = 0; ai < 2; ++ai)
#pragma unroll
            for (int m = 0; m < 4; ++m) { bf16_t* rowp = base + (size_t)(row0 + ai * HALF + m * 16) * 512 + col0;
#pragma unroll
                for (int bj = 0; bj < 2; ++bj) { const f32x4 v0 = acc[ai][bj][m][0] * sc, v1 = acc[ai][bj][m][1] * sc;
                    u32x4 w; w.x = cvt_pk_bf16(v0[0], v0[1]); w.y = cvt_pk_bf16(v0[2], v0[3]); w.z = cvt_pk_bf16(v1[0], v1[1]); w.w = cvt_pk_bf16(v1[2], v1[3]);
                    *(u32x4*)(rowp + bj * HALF) = w; } }
    }
};
struct EpiOut {
    static constexpr bool PERM = true, MID = true;
    bf16_t* Y; const float* ssq;
    __device__ __forceinline__ void mid(f32x4 (&acc)[2][2][4][2], const Unit& u, int wr, int wc, int fr, int fq) const {
#pragma unroll
        for (int ai = 0; ai < 2; ++ai)
#pragma unroll
            for (int m = 0; m < 4; ++m) { const int row = u.pm * BM + ai * HALF + wr * 64 + m * 16 + fr;
                const f32x4 s0 = *(const f32x4*)(ssq + (size_t)row * 8), s1 = *(const f32x4*)(ssq + (size_t)row * 8 + 4);
                const float tot = ((s0[0] + s0[1]) + (s0[2] + s0[3])) + ((s1[0] + s1[1]) + (s1[2] + s1[3]));
                const float ri = 1.0f / sqrtf(tot * (1.0f / DATT) + RMS_EPS);
#pragma unroll
                for (int bj = 0; bj < 2; ++bj)
#pragma unroll
                    for (int n = 0; n < 2; ++n) acc[ai][bj][m][n] = acc[ai][bj][m][n] * ri; }
    }
    __device__ __forceinline__ void operator()(const f32x4 (&acc)[2][2][4][2], const Unit& u, int wr, int wc, int fr, int fq) const {
        const int row0 = u.pm * BM + wr * 64 + fr, col0 = u.pn * BM + wc * 32 + 8 * fq;
#pragma unroll
        for (int ai = 0; ai < 2; ++ai)
#pragma unroll
            for (int m = 0; m < 4; ++m) { bf16_t* rowp = Y + (size_t)(row0 + ai * HALF + m * 16) * DM + col0;
#pragma unroll
                for (int bj = 0; bj < 2; ++bj) { const f32x4 v0 = acc[ai][bj][m][0], v1 = acc[ai][bj][m][1];
                    u32x4 w; w.x = cvt_pk_bf16(v0[0], v0[1]); w.y = cvt_pk_bf16(v0[2], v0[3]); w.z = cvt_pk_bf16(v1[0], v1[1]); w.w = cvt_pk_bf16(v1[2], v1[3]);
                    *(u32x4*)(rowp + bj * HALF) = w; } }
    }
};
struct EpiUp {
    static constexpr bool PERM = true, MID = false;
    unsigned char* ACT; const float* b_up;
    __device__ __forceinline__ void mid(f32x4 (&)[2][2][4][2], const Unit&, int, int, int, int) const {}
    __device__ __forceinline__ void operator()(const f32x4 (&acc)[2][2][4][2], const Unit& u, int wr, int wc, int fr, int fq) const {
        const int row0 = u.pm * BM + wr * 64 + fr, col0 = u.pn * HALF + wc * 32 + 8 * fq;
        const float* bg = b_up + (size_t)u.e * 2 * DEXP + col0;
        f32x4 bgl[2], bli[2];
#pragma unroll
        for (int n = 0; n < 2; ++n) { bgl[n] = *(const f32x4*)(bg + 4 * n); bli[n] = *(const f32x4*)(bg + DEXP + 4 * n); }
#pragma unroll
        for (int ai = 0; ai < 2; ++ai)
#pragma unroll
            for (int m = 0; m < 4; ++m) { unsigned char* rowp = ACT + (size_t)(row0 + ai * HALF + m * 16) * DEXP + col0;
                float o[8];
#pragma unroll
                for (int n = 0; n < 2; ++n)
#pragma unroll
                    for (int j = 0; j < 4; ++j) { const float gl = fminf(acc[ai][0][m][n][j] + bgl[n][j], 7.0f); const float li = fminf(fmaxf(acc[ai][1][m][n][j] + bli[n][j], -7.0f), 7.0f);
                        const float sg = __builtin_amdgcn_rcpf(1.0f + __builtin_amdgcn_exp2f(-1.702f * 1.4426950408889634f * gl)); o[4 * n + j] = gl * sg * (li + 1.0f); }
                int w0 = 0, w1 = 0; w0 = __builtin_amdgcn_cvt_pk_fp8_f32(o[0], o[1], w0, false); w0 = __builtin_amdgcn_cvt_pk_fp8_f32(o[2], o[3], w0, true);
                w1 = __builtin_amdgcn_cvt_pk_fp8_f32(o[4], o[5], w1, false); w1 = __builtin_amdgcn_cvt_pk_fp8_f32(o[6], o[7], w1, true);
                typedef int i32x2_ __attribute__((ext_vector_type(2))); *(i32x2_*)rowp = (i32x2_){w0, w1}; }
    }
};
struct EpiDown {
    static constexpr bool PERM = true, MID = false;
    bf16_t* YP; const float* b_down; const int* row_pair; const float* row_w;
    __device__ __forceinline__ void mid(f32x4 (&)[2][2][4][2], const Unit&, int, int, int, int) const {}
    __device__ __forceinline__ void operator()(const f32x4 (&acc)[2][2][4][2], const Unit& u, int wr, int wc, int fr, int fq) const {
        const int row0 = u.pm * BM + wr * 64 + fr, col0 = u.pn * BM + wc * 32 + 8 * fq;
        const float* bd = b_down + (size_t)u.e * DM + col0;
        f32x4 bv[2][2];
#pragma unroll
        for (int bj = 0; bj < 2; ++bj)
#pragma unroll
            for (int n = 0; n < 2; ++n) bv[bj][n] = *(const f32x4*)(bd + bj * HALF + 4 * n);
        int pr[2][4]; float wt[2][4];
#pragma unroll
        for (int ai = 0; ai < 2; ++ai)
#pragma unroll
            for (int m = 0; m < 4; ++m) { const int pos = row0 + ai * HALF + m * 16; pr[ai][m] = row_pair[pos]; wt[ai][m] = row_w[pos]; }
#pragma unroll
        for (int ai = 0; ai < 2; ++ai)
#pragma unroll
            for (int m = 0; m < 4; ++m) { const int pair = pr[ai][m]; const float w = wt[ai][m];
                if (pair >= 0) { bf16_t* rowp = YP + (size_t)pair * DM + col0;
#pragma unroll
                    for (int bj = 0; bj < 2; ++bj) { const f32x4 v0 = (acc[ai][bj][m][0] + bv[bj][0]) * w, v1 = (acc[ai][bj][m][1] + bv[bj][1]) * w;
                        u32x4 q; q.x = cvt_pk_bf16(v0[0], v0[1]); q.y = cvt_pk_bf16(v0[2], v0[3]); q.z = cvt_pk_bf16(v1[0], v1[1]); q.w = cvt_pk_bf16(v1[2], v1[3]);
                        *(u32x4*)(rowp + bj * HALF) = q; } } }
    }
};
}

namespace attn_body {
using bf16=__hip_bfloat16;
using bf16x8=__attribute__((ext_vector_type(8)))short;
using s16x4=__attribute__((ext_vector_type(4)))short;
using f32x16=__attribute__((ext_vector_type(16)))float;
using u32x4=__attribute__((ext_vector_type(4)))unsigned;
constexpr int BATCH=8,NHEAD=8,SEQ=2048,D=64,DM=NHEAD*D,OPITCH=1024;
constexpr int NW=8,QBLK=32,QB=QBLK*NW,KVBLK=64,NQB=SEQ/QB;
constexpr int ATTN_PITCH=DM, ATTN_UNIT_ROWS=QB;
__device__ __forceinline__ int crow(int r,int hi){return (r&3)+8*(r>>2)+4*hi;}
#define SBAR() __builtin_amdgcn_sched_barrier(0)
__device__ __forceinline__ void cmask(f32x16&p0,f32x16&p1,int jb,int qrel,int hi){
  const float NEG=-INFINITY; int kb=64*jb+4*hi;
  #pragma unroll
  for(int r=0;r<16;++r){int kv=kb+(r&3)+8*(r>>2); if(kv>qrel)p0[r]=NEG; if(kv+32>qrel)p1[r]=NEG;}
}

constexpr int NSLOT=3, SLOTB=8192;
constexpr int LDS_K=0, LDS_V=NSLOT*SLOTB, LDS_WS=2*NSLOT*SLOTB, LDS_OST=LDS_WS+NW*64*4, LDS_BIAS=LDS_OST+NW*4096, LDS_SCAN=LDS_BIAS+(SEQ+64)*4, LDS_BYTES=LDS_SCAN+256;
constexpr float C2=0.125f*1.4426950408889634f;
__device__ __forceinline__ void glds16(const void*gsrc,unsigned lds_dst){unsigned keep;
  asm volatile("s_mov_b32 %0, m0\n\ts_mov_b32 m0, %2\n\ts_nop 0\n\tglobal_load_lds_dwordx4 %1, off\n\ts_mov_b32 m0, %0":"=&s"(keep):"v"(gsrc),"s"(lds_dst):"memory");}
__device__ __forceinline__ float max3f(float a,float b,float c){float r;asm("v_max3_f32 %0, %1, %2, %3":"=v"(r):"v"(a),"v"(b),"v"(c));return r;}
__device__ __forceinline__ float max2f(float a,float b){float r;asm("v_max_f32_e32 %0, %1, %2":"=v"(r):"v"(a),"v"(b));return r;}
__device__ __forceinline__ float fadd_s(float a,float b){float r;asm("v_add_f32_e32 %0, %1, %2":"=v"(r):"v"(a),"v"(b));return r;}
__device__ __forceinline__ float fsub_s(float a,float b){float r;asm("v_sub_f32_e32 %0, %1, %2":"=v"(r):"v"(a),"v"(b));return r;}
typedef float f32x2_t __attribute__((ext_vector_type(2))); typedef float f32x4_t __attribute__((ext_vector_type(4))); typedef __bf16 bf16x2_t __attribute__((ext_vector_type(2)));
__device__ __forceinline__ unsigned cvtpk_s(float lo,float hi){f32x2_t v={lo,hi};bf16x2_t b=__builtin_convertvector(v,bf16x2_t);return __builtin_bit_cast(unsigned,b);}
#define WAIT_BAR(N) asm volatile("s_waitcnt vmcnt(" #N ") lgkmcnt(0)\n\ts_barrier":::"memory")

__device__ __forceinline__ void qkt(f32x16&p0,f32x16&p1,const char*Kslot,const bf16x8*qr,int r32,int hi){
  const char*kb=Kslot+hi*1024+r32*16;
  #pragma unroll
  for(int d0=0;d0<4;++d0){
    const bf16x8 b0=*reinterpret_cast<const bf16x8*>(kb+d0*2048);
    const bf16x8 b1=*reinterpret_cast<const bf16x8*>(kb+d0*2048+512);
    p0=__builtin_amdgcn_mfma_f32_32x32x16_bf16(b0,qr[d0],p0,0,0,0);p1=__builtin_amdgcn_mfma_f32_32x32x16_bf16(b1,qr[d0],p1,0,0,0);}
}
typedef __attribute__((address_space(3))) const char* lds_cptr;
typedef short v4i16_t __attribute__((ext_vector_type(4)));
__device__ __forceinline__ void kload8(bf16x8*kf,lds_cptr kp){
  kf[0]=*(const __attribute__((address_space(3))) bf16x8*)(kp);      kf[1]=*(const __attribute__((address_space(3))) bf16x8*)(kp+512);
  kf[2]=*(const __attribute__((address_space(3))) bf16x8*)(kp+2048); kf[3]=*(const __attribute__((address_space(3))) bf16x8*)(kp+2560);
  kf[4]=*(const __attribute__((address_space(3))) bf16x8*)(kp+4096); kf[5]=*(const __attribute__((address_space(3))) bf16x8*)(kp+4608);
  kf[6]=*(const __attribute__((address_space(3))) bf16x8*)(kp+6144); kf[7]=*(const __attribute__((address_space(3))) bf16x8*)(kp+6656);
}
__device__ __forceinline__ void kload2(bf16x8*kf,lds_cptr kp,int j){ kf[2*j]=*(const __attribute__((address_space(3))) bf16x8*)(kp+j*2048); kf[2*j+1]=*(const __attribute__((address_space(3))) bf16x8*)(kp+j*2048+512); }
__device__ __forceinline__ s16x4 vtr(lds_cptr p){ return __builtin_bit_cast(s16x4,__builtin_amdgcn_ds_read_tr16_b64_v4i16((__attribute__((address_space(3))) v4i16_t*)p)); }
__device__ __forceinline__ float rowmax(const f32x16&p0,const f32x16&p1){
  float a=max3f(p0[0],p0[1],p1[0]),b=max3f(p0[2],p0[3],p1[1]);a=max3f(a,p1[2],p1[3]);
  #pragma unroll
  for(int r=4;r<16;r+=4){a=max3f(a,p0[r],p0[r+1]);b=max3f(b,p0[r+2],p0[r+3]);a=max3f(a,p1[r],p1[r+1]);b=max3f(b,p1[r+2],p1[r+3]);}
  const float m=max2f(a,b);
  auto rr=__builtin_amdgcn_permlane32_swap(__float_as_uint(m),__float_as_uint(m),false,false);
  return max2f(__uint_as_float(rr[0]),__uint_as_float(rr[1]));
}
__device__ __forceinline__ void pv(f32x16*o,int vb,bf16x8 pa0,bf16x8 pa1,bf16x8 pa2,bf16x8 pa3){
  #pragma unroll
  for(int d0=0;d0<2;++d0){s16x4 lo[4],hi[4];
    #pragma unroll
    for(int ks=0;ks<4;++ks){
      asm volatile("ds_read_b64_tr_b16 %0,%1 offset:%c2":"=&v"(lo[ks]):"v"(vb),"i"(d0*4096+ks*1024):"memory");
      asm volatile("ds_read_b64_tr_b16 %0,%1 offset:%c2":"=&v"(hi[ks]):"v"(vb),"i"(d0*4096+ks*1024+512):"memory");}
    asm volatile("s_waitcnt lgkmcnt(0)":::"memory");SBAR();
    #define PK(k) (bf16x8){lo[k][0],lo[k][1],lo[k][2],lo[k][3],hi[k][0],hi[k][1],hi[k][2],hi[k][3]}
    o[d0]=__builtin_amdgcn_mfma_f32_32x32x16_bf16(pa0,PK(0),o[d0],0,0,0);
    o[d0]=__builtin_amdgcn_mfma_f32_32x32x16_bf16(pa1,PK(1),o[d0],0,0,0);
    o[d0]=__builtin_amdgcn_mfma_f32_32x32x16_bf16(pa2,PK(2),o[d0],0,0,0);
    o[d0]=__builtin_amdgcn_mfma_f32_32x32x16_bf16(pa3,PK(3),o[d0],0,0,0);
    #undef PK
  }
}

#ifndef ATTN_STORE16
#define ATTN_STORE16(p,v) (*(u32x4*)(p)=(v))
#endif
template<int THRL> __device__ __forceinline__ void attn_unit(int b,int h,int qb,const bf16*Q,const bf16*__restrict__ K,const bf16*__restrict__ V,bf16*O,const float*__restrict__ LOGF2,float*SSQ,char*shm){
  const int tid=threadIdx.x,lane=tid&63,r32=lane&31,hi=lane>>5; const int wid=__builtin_amdgcn_readfirstlane(tid>>6);
  const long rowbase=(long)b*SEQ; const int q0=qb*QB;
  const bf16*Qw=Q+(rowbase+q0+wid*QBLK)*DM+h*D;
  const bf16*Kh=K+rowbase*DM+h*D,*Vh=V+rowbase*DM+h*D;
  const unsigned lds0=(unsigned)(uintptr_t)shm;
  float*wsf=(float*)(shm+LDS_WS)+wid*64;
  const bf16*ksrc=Kh+(long)lane*DM+wid*8;
  const bf16*vsrc=Vh+(long)(16*(wid&3)+(lane>>2))*DM+(wid>>2)*32+(lane&3)*8;
  const unsigned kdst=lds0+LDS_K+wid*1024, vdst=lds0+LDS_V+wid*1024;
  #define DMA_K(t,slot) glds16(ksrc+(long)(t)*KVBLK*DM,(unsigned)__builtin_amdgcn_readfirstlane(kdst+(slot)))
  #define DMA_V(t,slot) glds16(vsrc+(long)(t)*KVBLK*DM,(unsigned)__builtin_amdgcn_readfirstlane(vdst+(slot)))
  const int vb0=(int)(lds0+LDS_V)+((lane>>4)&1)*32+(lane&3)*8+(4*hi+((lane&15)>>2))*64;
  const char*Kbase=shm+LDS_K; bf16x8 kf[8];
  const lds_cptr shm3=(lds_cptr)shm; const lds_cptr kp0=shm3+LDS_K+hi*1024+r32*16; const lds_cptr vp0=shm3+LDS_V+((lane>>4)&1)*32+(lane&3)*8+(4*hi+((lane&15)>>2))*64;
  const int NT=(q0+QB)/KVBLK;
  { float*biasl=(float*)(shm+LDS_BIAS); float*scn=(float*)(shm+LDS_SCAN);
    const float*lf=LOGF2+rowbase*NHEAD+h;
    float v0=0.f,v1=0.f,v2=0.f,v3=0.f; const int i0=4*tid;
    if(i0<q0){ v0=lf[(long)(q0-1-i0)*NHEAD]; v1=lf[(long)(q0-2-i0)*NHEAD]; v2=lf[(long)(q0-3-i0)*NHEAD]; v3=lf[(long)(q0-4-i0)*NHEAD]; }
    const float tsum=(v0+v1)+(v2+v3); float inc=tsum;
    #pragma unroll
    for(int o=1;o<64;o<<=1){ const float n_=__shfl_up(inc,o); if(lane>=o)inc+=n_; }
    if(lane==63)scn[wid]=inc;
    const float f0=lf[(long)(q0+4*lane)*NHEAD],f1=lf[(long)(q0+4*lane+1)*NHEAD],f2=lf[(long)(q0+4*lane+2)*NHEAD],f3=lf[(long)(q0+4*lane+3)*NHEAD];
    float finc=(f0+f1)+(f2+f3);
    #pragma unroll
    for(int o=1;o<64;o<<=1){ const float n_=__shfl_up(finc,o); if(lane>=o)finc+=n_; }
    const float fex=finc-((f0+f1)+(f2+f3));
    if(wid==0){ biasl[q0+4*lane]=-(fex+f0); biasl[q0+4*lane+1]=-(fex+f0+f1); biasl[q0+4*lane+2]=-(fex+f0+f1+f2); biasl[q0+4*lane+3]=-(fex+f0+f1+f2+f3); }
    __syncthreads();
    float woff=0.f;
    #pragma unroll
    for(int w_=0;w_<NW;++w_) woff+=(w_<wid)?scn[w_]:0.f;
    const float ex=woff+inc-tsum;
    if(i0<q0){ biasl[q0-1-i0]=ex; biasl[q0-2-i0]=ex+v0; biasl[q0-3-i0]=ex+v0+v1; biasl[q0-4-i0]=ex+v0+v1+v2; }
    __syncthreads(); }
  const lds_cptr biasr=(lds_cptr)shm+LDS_BIAS+16*hi;
  #define BIAS4(t,o) (*(const __attribute__((address_space(3))) f32x4_t*)(biasr+(t)*(KVBLK*4)+(o)*4))
  #define INIT4(Y,g,t,o) do{ const f32x4_t x_=BIAS4(t,(o)+8*(g)); Y[4*(g)]=x_[0]-mhat; Y[4*(g)+1]=x_[1]-mhat; Y[4*(g)+2]=x_[2]-mhat; Y[4*(g)+3]=x_[3]-mhat; }while(0)
  #define INITT(Y0,Y1,t) do{ INIT4(Y0,0,t,0);INIT4(Y0,1,t,0);INIT4(Y0,2,t,0);INIT4(Y0,3,t,0); INIT4(Y1,0,t,32);INIT4(Y1,1,t,32);INIT4(Y1,2,t,32);INIT4(Y1,3,t,32); }while(0)
  DMA_K(0,0);DMA_V(0,0);DMA_K(1,SLOTB);
  bf16x8 qr[4];
  #pragma unroll
  for(int d0=0;d0<4;++d0)qr[d0]=*reinterpret_cast<const bf16x8*>(&Qw[(long)r32*DM+d0*16+hi*8]);
  float mhat=0.f,l_reg=0.f;f32x16 o[2];o[0]=f32x16{};o[1]=f32x16{};
  const int qrel=wid*QBLK+r32;
  #define CMASK(P0,P1,t) do{int jb_=(t)-(NT-4); if(jb_>=0)cmask(P0,P1,jb_,qrel,hi);}while(0)
  bool resc=false;
  #define START(P0,P1) do{ const float rm=rowmax(P0,P1); resc=false; \
    { const float dl=rm; mhat=fadd_s(mhat,dl); \
      _Pragma("unroll") for(int r=0;r<16;++r){P0[r]=fsub_s(P0[r],dl);P1[r]=fsub_s(P1[r],dl);} } \
    _Pragma("unroll") for(int r=0;r<16;++r)P0[r]=__builtin_amdgcn_exp2f(P0[r]); }while(0)
  #define RESC() do{ if(resc){ asm volatile("s_waitcnt lgkmcnt(0)":::"memory"); \
      _Pragma("unroll") for(int d_=0;d_<2;++d_) _Pragma("unroll") for(int r=0;r<16;++r)o[d_][r]*=wsf[crow(r,hi)]; } }while(0)
  f32x16 pA0,pA1,pB0,pB1;
  int sl_prev=0,sl_cur=0,sl_next=SLOTB;
  #define ROT() do{sl_prev=sl_cur;sl_cur=sl_next;sl_next=(sl_next==(NSLOT-1)*SLOTB)?0:sl_next+SLOTB;}while(0)
  DMA_K(2,2*SLOTB);
  WAIT_BAR(3);
  INITT(pA0,pA1,0); qkt(pA0,pA1,Kbase,qr,r32,hi);asm volatile("s_nop 15\n\ts_nop 7":"+v"(pA0),"+v"(pA1));CMASK(pA0,pA1,0);
  START(pA0,pA1);
  _Pragma("unroll") for(int r=0;r<16;++r)pA1[r]=__builtin_amdgcn_exp2f(pA1[r]);
  INITT(pB0,pB1,1);
  WAIT_BAR(0);
  DMA_K(3,0);DMA_V(1,SLOTB);
  ROT();
  kload8(kf,kp0+sl_cur);
  WAIT_BAR(2);
  s16x4 vlo[8],vhi[8]; u32x4 pw0,pw1,pw2,pw3;
  #define PKW(P,B) cvtpk_s(P[B],P[B+1])
  #define PAF(k) __builtin_bit_cast(bf16x8,pw##k)
  #define VFR(i) (bf16x8){vlo[i][0],vlo[i][1],vlo[i][2],vlo[i][3],vhi[i][0],vhi[i][1],vhi[i][2],vhi[i][3]}
  #define PIN(x) asm volatile("":"+v"(x))
  #define MX3(a,b,c) __builtin_fmaxf(__builtin_fmaxf((a),(b)),(c))
  #define GAPA(MF,A0,A1,A2,A3,W0,W1,PW) do{ MF; sacc+=A0; sacc+=A1; sacc+=A2; sacc+=A3; PIN(sacc); W0; W1; PIN(PW); SBAR(); }while(0)
  #define EX(v) __builtin_amdgcn_exp2f(v)
  #define GAPB(MF,X,B,GN,Y,tn,o) do{ MF; X[B]=EX(X[B]); X[B+1]=EX(X[B+1]); X[B+2]=EX(X[B+2]); X[B+3]=EX(X[B+3]); PIN(X); if(GN){ INIT4(Y,(B)/4,tn,o); PIN(Y); } SBAR(); }while(0)
  #define VRD(i) do{ vlo[i]=vtr(vp_+(((i)>>2)*4096+((i)&3)*1024)); vhi[i]=vtr(vp_+(((i)>>2)*4096+((i)&3)*1024+512)); }while(0)
  #define KRD(G,j) do{ if(G){ kload2(kf,kp0+sl_next,j); SBAR(); } }while(0)
  #define STEP(C0,C1,P0,P1,t,GK,GV,GL) do{ SBAR(); \
    const lds_cptr vp_=vp0+sl_prev; \
    VRD(0); SBAR(); float sacc=(P0[0]+P0[1]); \
    GAPA(C0=__builtin_amdgcn_mfma_f32_32x32x16_bf16(kf[0],qr[0],C0,0,0,0), P0[2],P0[3],P0[4],P0[5],     pw0[0]=PKW(P0,0), pw0[1]=PKW(P0,2), pw0); \
    VRD(4); SBAR(); GAPA(C1=__builtin_amdgcn_mfma_f32_32x32x16_bf16(kf[1],qr[0],C1,0,0,0), P0[6],P0[7],P0[8],P0[9],     pw0[2]=PKW(P0,4), pw0[3]=PKW(P0,6), pw0); \
    VRD(1); SBAR(); GAPA(C0=__builtin_amdgcn_mfma_f32_32x32x16_bf16(kf[2],qr[1],C0,0,0,0),   P0[10],P0[11],P0[12],P0[13], pw1[0]=PKW(P0,8), pw1[1]=PKW(P0,10), pw1); \
    VRD(5); SBAR(); GAPA(C1=__builtin_amdgcn_mfma_f32_32x32x16_bf16(kf[3],qr[1],C1,0,0,0),   P0[14],P0[15],P1[0],P1[1],   pw1[2]=PKW(P0,12),pw1[3]=PKW(P0,14), pw1); \
    VRD(2); SBAR(); GAPA(C0=__builtin_amdgcn_mfma_f32_32x32x16_bf16(kf[4],qr[2],C0,0,0,0),   P1[2],P1[3],P1[4],P1[5],     pw2[0]=PKW(P1,0), pw2[1]=PKW(P1,2), pw2); \
    VRD(6); SBAR(); GAPA(C1=__builtin_amdgcn_mfma_f32_32x32x16_bf16(kf[5],qr[2],C1,0,0,0),   P1[6],P1[7],P1[8],P1[9],     pw2[2]=PKW(P1,4), pw2[3]=PKW(P1,6), pw2); \
    VRD(3); SBAR(); GAPA(C0=__builtin_amdgcn_mfma_f32_32x32x16_bf16(kf[6],qr[3],C0,0,0,0),   P1[10],P1[11],P1[12],P1[13], pw3[0]=PKW(P1,8), pw3[1]=PKW(P1,10), pw3); \
    VRD(7); SBAR(); GAPA(C1=__builtin_amdgcn_mfma_f32_32x32x16_bf16(kf[7],qr[3],C1,0,0,0),   P1[14],P1[15],0.f,0.f,       pw3[2]=PKW(P1,12),pw3[3]=PKW(P1,14), pw3); \
    l_reg+=sacc; \
    if(GK){DMA_K((t)+3,sl_cur);} if(GV){DMA_V((t)+1,sl_next);} \
    CMASK(C0,C1,t); \
    { float a=MX3(C0[0],C0[1],C1[0]),b=MX3(C0[2],C0[3],C1[1]); a=MX3(a,C1[2],C1[3]); \
      _Pragma("unroll") for(int r=4;r<16;r+=4){a=MX3(a,C0[r],C0[r+1]);b=MX3(b,C0[r+2],C0[r+3]);a=MX3(a,C1[r],C1[r+1]);b=MX3(b,C1[r+2],C1[r+3]);} \
      float rm=__builtin_fmaxf(a,b); { auto rr=__builtin_amdgcn_permlane32_swap(__float_as_uint(rm),__float_as_uint(rm),false,false); rm=__builtin_fmaxf(__uint_as_float(rr[0]),__uint_as_float(rr[1])); } \
      resc=false; \
      if(__builtin_expect(__any(rm>(float)THRL),0)){ const float dl=__builtin_fmaxf(rm,0.f); mhat+=dl; \
        _Pragma("unroll") for(int r=0;r<16;++r){C0[r]-=dl;C1[r]-=dl;} \
        const float f=__builtin_amdgcn_exp2f(-dl); l_reg*=f; if(hi==0)wsf[r32]=f; resc=true; } } \
    SBAR(); \
    GAPB(o[0]=__builtin_amdgcn_mfma_f32_32x32x16_bf16(PAF(0),VFR(0),o[0],0,0,0), C0,0,  GL,P0,(t)+1,0); \
    GAPB(o[1]=__builtin_amdgcn_mfma_f32_32x32x16_bf16(PAF(0),VFR(4),o[1],0,0,0), C0,4,  GL,P0,(t)+1,0); \
    KRD(GL,0); GAPB(o[0]=__builtin_amdgcn_mfma_f32_32x32x16_bf16(PAF(1),VFR(1),o[0],0,0,0), C0,8,  GL,P0,(t)+1,0); \
    KRD(GL,1); GAPB(o[1]=__builtin_amdgcn_mfma_f32_32x32x16_bf16(PAF(1),VFR(5),o[1],0,0,0), C0,12, GL,P0,(t)+1,0); \
    KRD(GL,2); GAPB(o[0]=__builtin_amdgcn_mfma_f32_32x32x16_bf16(PAF(2),VFR(2),o[0],0,0,0), C1,0,  GL,P1,(t)+1,32); \
    KRD(GL,3); GAPB(o[1]=__builtin_amdgcn_mfma_f32_32x32x16_bf16(PAF(2),VFR(6),o[1],0,0,0), C1,4,  GL,P1,(t)+1,32); \
    GAPB(o[0]=__builtin_amdgcn_mfma_f32_32x32x16_bf16(PAF(3),VFR(3),o[0],0,0,0), C1,8,  GL,P1,(t)+1,32); \
    GAPB(o[1]=__builtin_amdgcn_mfma_f32_32x32x16_bf16(PAF(3),VFR(7),o[1],0,0,0), C1,12, GL,P1,(t)+1,32); \
    }while(0)
  int t=1;
  #undef CMASK
  #define CMASK(P0,P1,t) do{}while(0)
  for(;t+5<NT;t+=2){
    STEP(pB0,pB1,pA0,pA1,t,true,true,true);     WAIT_BAR(2); RESC(); ROT();
    STEP(pA0,pA1,pB0,pB1,t+1,true,true,true);   WAIT_BAR(2); RESC(); ROT();
  }
  #undef CMASK
  #define CMASK(P0,P1,t) do{int jb_=(t)-(NT-4); if(jb_>=0)cmask(P0,P1,jb_,qrel,hi);}while(0)
  #define ENDW(tt) do{ if((tt)+3<NT){WAIT_BAR(2);} else if((tt)+2<NT){WAIT_BAR(1);} else {WAIT_BAR(0);} }while(0)
  for(;t+1<NT;t+=2){
    STEP(pB0,pB1,pA0,pA1,t,(t+3<NT),(t+1<NT),(t+1<NT));       ENDW(t);   RESC(); ROT();
    STEP(pA0,pA1,pB0,pB1,t+1,(t+4<NT),(t+2<NT),(t+2<NT));     ENDW(t+1); RESC(); ROT();
  }
  STEP(pB0,pB1,pA0,pA1,NT-1,false,false,false); RESC();
  { float sacc=pB0[0]+pB0[1]; _Pragma("unroll") for(int r=2;r<16;++r)sacc+=pB0[r]; _Pragma("unroll") for(int r=0;r<16;++r)sacc+=pB1[r]; l_reg+=sacc;
    pw0=(u32x4){PKW(pB0,0),PKW(pB0,2),PKW(pB0,4),PKW(pB0,6)};pw1=(u32x4){PKW(pB0,8),PKW(pB0,10),PKW(pB0,12),PKW(pB0,14)};pw2=(u32x4){PKW(pB1,0),PKW(pB1,2),PKW(pB1,4),PKW(pB1,6)};pw3=(u32x4){PKW(pB1,8),PKW(pB1,10),PKW(pB1,12),PKW(pB1,14)};
    SBAR(); pv(o,vb0+sl_cur,PAF(0),PAF(1),PAF(2),PAF(3)); }
  #undef PKW
  #undef PAF
  #undef VFR
  #undef PIN
  #undef MX3
  #undef GAPA
  #undef GAPB
  #undef EX
  #undef VRD
  #undef KRD
  #undef STEP
  #undef ENDW
  {auto rr=__builtin_amdgcn_permlane32_swap(__float_as_uint(l_reg),__float_as_uint(l_reg),false,false);l_reg=__uint_as_float(rr[0])+__uint_as_float(rr[1]);}
  if(hi==0)wsf[32+r32]=l_reg;asm volatile("s_waitcnt lgkmcnt(0)":::"memory");
  float rli[16];
  #pragma unroll
  for(int r=0;r<16;++r)rli[r]=__builtin_amdgcn_rcpf(wsf[32+crow(r,hi)]);
  bf16*Ow=O+(rowbase+q0+wid*QBLK)*OPITCH+h*D; float*Sw=SSQ+(rowbase+q0+wid*QBLK)*NHEAD+h;
  { bf16*stg=(bf16*)(shm+LDS_OST)+wid*2048;
    #pragma unroll
    for(int r=0;r<16;++r){const int orow=crow(r,hi);
      #pragma unroll
      for(int d0=0;d0<2;++d0)stg[orow*64+d0*32+r32]=__float2bfloat16(o[d0][r]*rli[r]);}
    asm volatile("s_waitcnt lgkmcnt(0)":::"memory");
    #pragma unroll
    for(int i=0;i<4;++i){const int row=i*8+(lane>>3),ch=lane&7; const u32x4 v=*(const u32x4*)(stg+row*64+ch*8); ATTN_STORE16(Ow+(long)row*OPITCH+ch*8,v);
      float sq=0.f;
      #pragma unroll
      for(int j=0;j<4;++j){ const float lo_=__uint_as_float(v[j]<<16), hi_=__uint_as_float(v[j]&0xffff0000u); sq+=lo_*lo_+hi_*hi_; }
      sq+=__shfl_xor(sq,1); sq+=__shfl_xor(sq,2); sq+=__shfl_xor(sq,4);
      if(ch==0)Sw[(long)row*NHEAD]=sq; } }
  asm volatile("s_waitcnt lgkmcnt(0)\n\ts_barrier":::"memory");
  #undef DMA_K
  #undef BIAS4
  #undef INIT4
  #undef INITT
  #undef DMA_V
  #undef CMASK
  #undef START
  #undef RESC
  #undef ROT
}
constexpr int ATTN_LDS_BYTES=LDS_BYTES;
struct AttnTensors { const bf16* Q; const bf16* K; const bf16* V; bf16* O; const float* LOGF2; float* SSQ; };
struct AttnUnit { int bh; int qb; };
struct StaticOrder {
  int vcu,G;
  __device__ __forceinline__ explicit StaticOrder(int grid,int vcu_):vcu(vcu_),G(grid){}
  __device__ __forceinline__ bool next(int i,AttnUnit&u)const{ const int L=(i>>1)*G+vcu; if(L>=BATCH*NHEAD*4)return false; const int s=L&3; u.bh=L>>2; u.qb=(i&1)?7-s:s; return true; }
  __device__ __forceinline__ void a_ready(const AttnUnit&)const{}
  __device__ __forceinline__ void done(const AttnUnit&)const{}
};
template<class Sched,int THRL=8> __device__ __forceinline__ void attn_phase(char*lds,const AttnTensors&T,const Sched&S){
  AttnUnit u;
  for(int i=0;S.next(i,u);++i){ S.a_ready(u); attn_unit<THRL>(u.bh/NHEAD,u.bh%NHEAD,u.qb,T.Q,T.K,T.V,T.O,T.LOGF2,T.SSQ,lds); S.done(u); }
}
#undef SBAR
#undef WAIT_BAR
}

constexpr int NWAVES = 8;
constexpr int NPHASES = 11;

constexpr size_t MiB = 1u << 20, KiB = 1u << 10;
constexpr size_t WS_CTL = 0, CTL_ZERO_BYTES = 1 * MiB;
constexpr size_t WS_MOD = 1 * MiB;
constexpr size_t WS_LOGF2 = 1 * MiB + 256 * KiB;
constexpr size_t WS_SSQ = 1 * MiB + 768 * KiB;
constexpr size_t WS_TOPI = 2 * MiB + 256 * KiB;
constexpr size_t WS_TOPW = 2 * MiB + 512 * KiB;
constexpr size_t WS_WGCNT = 2 * MiB + 768 * KiB;
constexpr size_t WS_LSUM = 3 * MiB;
constexpr size_t WS_ROWTOK = 4 * MiB, WS_ROWPAIR = 4 * MiB + 512 * KiB, WS_ROWW = 5 * MiB, WS_MTEXP = 5 * MiB + 512 * KiB;
constexpr size_t WS_LWT = 6 * MiB;
constexpr size_t WS_WFT = 6 * MiB + 512 * KiB;
constexpr size_t WS_WRT = 7 * MiB;
constexpr size_t WS_WIN = 8 * MiB;
constexpr size_t WS_WOUT = 13 * MiB;
constexpr size_t WS_WUP = 16 * MiB;
constexpr size_t WS_WDN = 144 * MiB;
constexpr size_t WS_H1 = 208 * MiB;
constexpr size_t WS_PJ = 240 * MiB;
constexpr size_t PJ_STRIDE = (size_t)NTOK * 512;
constexpr size_t WS_MRG = 320 * MiB;
constexpr size_t WS_Y = 352 * MiB;
constexpr size_t WS_H2 = 416 * MiB;
constexpr size_t WS_ACT = 448 * MiB;
constexpr size_t WS_YP = 592 * MiB;
constexpr size_t WS_END = 720 * MiB;
static_assert(WS_ACT + (size_t)MAXROWS * 1024 * 2 <= WS_YP && WS_YP + (size_t)NTOK * 4 * 1024 * 2 <= WS_END, "d_ws map");
constexpr int CW_BAR = 4096;

constexpr int LDS_BYTES = 147456;
constexpr int LDSCTL_OFF = LDS_BYTES - 512, MISC_OFF = LDSCTL_OFF + 320;
constexpr int SCRATCH_BYTES = LDSCTL_OFF;

#define GAS __attribute__((address_space(1)))
#define LAS __attribute__((address_space(3)))
typedef unsigned short bf16;
typedef unsigned v4u __attribute__((ext_vector_type(4)));
typedef unsigned v2u __attribute__((ext_vector_type(2)));
typedef float f32x4 __attribute__((ext_vector_type(4)));
typedef float f32x16 __attribute__((ext_vector_type(16)));
typedef short bf16x8 __attribute__((ext_vector_type(8)));
typedef GAS unsigned gu32;
#define RLX_AGENT __ATOMIC_RELAXED, __HIP_MEMORY_SCOPE_AGENT
#define LDS_WAIT() asm volatile("s_waitcnt lgkmcnt(0)" ::: "memory")
#define VM_WAIT() asm volatile("s_waitcnt vmcnt(0)" ::: "memory")
__device__ __forceinline__ unsigned f2bf(float f) { unsigned u = __builtin_bit_cast(unsigned, f); return (u + 0x7fffu + ((u >> 16) & 1u)) >> 16; }
__device__ __forceinline__ unsigned pk2(float lo, float hi) { return f2bf(lo) | (f2bf(hi) << 16); }
__device__ __forceinline__ float bflo(unsigned w) { return __uint_as_float(w << 16); }
__device__ __forceinline__ float bfhi(unsigned w) { return __uint_as_float(w & 0xffff0000u); }
__device__ __forceinline__ float bf1(bf16 h) { return __uint_as_float((unsigned)h << 16); }

#define XB_TMO      128
#define XB_XCNT(j)  (256  + 64 * (j))
#define XB_XSUB(j)  (1280 + 64 * (j))
#define XB_XGEN(j)  (2304 + 64 * (j))
#define XB_TOP      3328
#define XB_TOPGEN   3392
#define XCD_BAR_WORDS 3456
#define XB_SPIN_CAP (1u << 18)
__device__ __forceinline__ unsigned xb_ld(unsigned* p)              { return __hip_atomic_load(p, __ATOMIC_RELAXED, __HIP_MEMORY_SCOPE_AGENT); }
__device__ __forceinline__ unsigned xb_add(unsigned* p, unsigned v) { return __hip_atomic_fetch_add(p, v, __ATOMIC_RELAXED, __HIP_MEMORY_SCOPE_AGENT); }
__device__ __forceinline__ unsigned xb_xcc_id() { return (unsigned)__builtin_amdgcn_s_getreg((3 << 11) | 20) & 0xFu; }
#define XB_SPIN(cond, bar) do { unsigned _sp = 0; while (cond) { __builtin_amdgcn_s_sleep(1); \
    if ((++_sp & 255u) == 0u) { if (xb_ld(&(bar)[XB_TMO])) break; if (_sp > XB_SPIN_CAP) { atomicAdd(&(bar)[XB_TMO], 1u); break; } } } } while (0)
struct XcdBarrier { unsigned* bar; unsigned x; volatile LAS unsigned* st; };
__device__ __forceinline__ XcdBarrier xcd_barrier_post(unsigned* bar, volatile LAS unsigned* st) {
    XcdBarrier b; b.bar = bar; b.x = xb_xcc_id(); b.st = st;
    if (threadIdx.x == 0) (void)xb_add(&bar[XB_XCNT(b.x)], 1u);
    return b;
}
__device__ __forceinline__ void xcd_barrier_complete(unsigned* bar, unsigned x, unsigned& nloc, unsigned& nx) {
    const unsigned G = gridDim.x * gridDim.y * gridDim.z;
    unsigned sum, cnt, mine, sp = 0u;
    for (;;) {
        sum = 0u; cnt = 0u; mine = 0u;
#pragma unroll
        for (unsigned j = 0; j < 16; ++j) { const unsigned c = xb_ld(&bar[XB_XCNT(j)]); sum += c; cnt += (c > 0u) ? 1u : 0u; mine = (j == x) ? c : mine; }
        if (sum == G) break;
        __builtin_amdgcn_s_sleep(1);
        if ((++sp & 255u) == 0u) { if (xb_ld(&bar[XB_TMO])) break; if (sp > XB_SPIN_CAP) { atomicAdd(&bar[XB_TMO], 1u); break; } }
    }
    nloc = mine > 0u ? mine : 1u; nx = cnt > 0u ? cnt : 1u;
}
__device__ __forceinline__ void xcd_barrier(const XcdBarrier& b) {
    asm volatile("s_waitcnt vmcnt(0)" ::: "memory");
    __syncthreads();
    if (threadIdx.x == 0) {
        unsigned* bar = b.bar;
        __builtin_amdgcn_s_waitcnt(0);
        unsigned nloc = b.st[0], nx = b.st[1];
        if (nloc == 0u) { xcd_barrier_complete(bar, b.x, nloc, nx); b.st[0] = nloc; b.st[1] = nx; }
        const unsigned old = xb_add(&bar[XB_XSUB(b.x)], 1u);
        const unsigned gen = old / nloc;
        if (old + 1u == (gen + 1u) * nloc) {
            __builtin_amdgcn_fence(__ATOMIC_RELEASE, "agent");
            asm volatile("s_waitcnt vmcnt(0)" ::: "memory");
            const unsigned og = xb_add(&bar[XB_TOP], 1u);
            const unsigned tg = og / nx;
            if (og + 1u == (tg + 1u) * nx) xb_add(&bar[XB_TOPGEN], 1u);
            else XB_SPIN(xb_ld(&bar[XB_TOPGEN]) == tg, bar);
            __builtin_amdgcn_fence(__ATOMIC_ACQUIRE, "agent");
            xb_add(&bar[XB_XGEN(b.x)], 1u);
            asm volatile("s_waitcnt vmcnt(0)" ::: "memory");
        } else {
            XB_SPIN(xb_ld(&bar[XB_XGEN(b.x)]) == gen, bar);
            __builtin_amdgcn_fence(__ATOMIC_ACQUIRE, "agent");
            asm volatile("s_waitcnt vmcnt(0)" ::: "memory");
        }
    }
    __syncthreads();
}

struct Args { const float* in[26]; float* out; unsigned char* ws; int ph_lo, ph_hi, li, pad; };
struct Frame {
    LAS unsigned char* lds;
    int tid, lane, wave, vcu, G;
    float* out; unsigned char* ws;
    __device__ __forceinline__ const float* in(int k) const { const LAS unsigned* t = (const LAS unsigned*)(lds + LDSCTL_OFF) + 2 * k;
        const unsigned lo = (unsigned)__builtin_amdgcn_readfirstlane((int)t[0]), hi = (unsigned)__builtin_amdgcn_readfirstlane((int)t[1]);
        return (const float*)(const GAS float*)(((unsigned long long)hi << 32) | lo); }
};
__device__ __forceinline__ float wave_sum(float v) {
#pragma unroll
    for (int o = 1; o < 64; o <<= 1) v += __shfl_xor(v, o);
    return v;
}
__device__ __forceinline__ float wave_max(float v) {
#pragma unroll
    for (int o = 1; o < 64; o <<= 1) v = fmaxf(v, __shfl_xor(v, o));
    return v;
}
__device__ __forceinline__ float sigmoid_f(float x) { return __builtin_amdgcn_rcpf(1.0f + __builtin_amdgcn_exp2f(-1.4426950408889634f * x)); }
__device__ __forceinline__ float gelu_tanh_f(float x) { const float u = 0.7978845608028654f * (x + 0.044715f * x * x * x); const float e = __builtin_amdgcn_exp2f(2.8853900817779268f * u); return x * (1.0f - __builtin_amdgcn_rcpf(e + 1.0f)); }
__device__ __forceinline__ float log_sigmoid_f(float z) { return z >= 0.f ? -log1pf(expf(-z)) : z - log1pf(expf(z)); }
__device__ __forceinline__ float softplus_f(float z) { return z > 0.f ? z + log1pf(expf(-z)) : log1pf(expf(z)); }

__device__ __forceinline__ void p0_transpose_item(const float* W, int ldw, bf16* WT, int k0, int n0, int kdst0, const float* gain, LAS float* scr, int lane) {
#pragma unroll 8
    for (int i = 0; i < 32; ++i) { const int kk = 2 * i + (lane >> 5); float v = W[(size_t)(k0 + kk) * ldw + n0 + (lane & 31)]; if (gain) v *= gain[k0 + kk]; scr[kk * 33 + (lane & 31)] = v; }
    LDS_WAIT(); asm volatile("" ::: "memory");
    const int c = lane & 7;
#pragma unroll
    for (int j = 0; j < 4; ++j) { const int n = (lane >> 3) + 8 * j; const LAS float* s = scr + (8 * c) * 33 + n;
        v4u o; o.x = pk2(s[0 * 33], s[1 * 33]); o.y = pk2(s[2 * 33], s[3 * 33]); o.z = pk2(s[4 * 33], s[5 * 33]); o.w = pk2(s[6 * 33], s[7 * 33]);
        *(GAS v4u*)(WT + (size_t)(n0 + n) * 1024 + kdst0 + 8 * c) = o; }
    LDS_WAIT(); asm volatile("" ::: "memory");
}
constexpr int CV_UP_ITEMS = NE * 16 * 32, CV_DN_ITEMS = NE * 16 * 16;
constexpr int CV_UP_TAIL = 8192, CV_DN_TAIL = 4096;
__device__ __forceinline__ void cvt_block_f8(const float* W, int ldw, unsigned char* WT, LAS unsigned char* scr, int lane) {
    float v[64];
#pragma unroll
    for (int i = 0; i < 64; ++i) v[i] = W[(size_t)i * ldw + lane];
#pragma unroll
    for (int q = 0; q < 4; ++q) { int w[4];
#pragma unroll
        for (int j = 0; j < 4; ++j) { int t = 0; t = __builtin_amdgcn_cvt_pk_fp8_f32(v[16 * q + 4 * j] * 64.0f, v[16 * q + 4 * j + 1] * 64.0f, t, false); t = __builtin_amdgcn_cvt_pk_fp8_f32(v[16 * q + 4 * j + 2] * 64.0f, v[16 * q + 4 * j + 3] * 64.0f, t, true); w[j] = t; }
        *(LAS v4u*)(scr + lane * 80 + 16 * q) = (v4u){(unsigned)w[0], (unsigned)w[1], (unsigned)w[2], (unsigned)w[3]}; }
    LDS_WAIT(); asm volatile("" ::: "memory");
#pragma unroll
    for (int j = 0; j < 4; ++j) { const int row = 16 * j + (lane >> 2), c = lane & 3;
        *(GAS v4u*)(WT + (size_t)row * 1024 + 16 * c) = *(const LAS v4u*)(scr + row * 80 + 16 * c); }
    LDS_WAIT(); asm volatile("" ::: "memory");
}
__device__ __forceinline__ void cvt_up_item(Frame& F, int u) { const int e = u >> 9, q = u & 511, kb = q >> 5, nb = q & 31;
    cvt_block_f8(F.in(22) + (size_t)e * DM * 2 * DEXP + (size_t)(64 * kb) * (2 * DEXP) + 64 * nb, 2 * DEXP, (unsigned char*)(F.ws + WS_WUP) + ((size_t)e * 2 * DEXP + 64 * nb) * 1024 + 64 * kb, F.lds + F.wave * 16384, F.lane); }
__device__ __forceinline__ void cvt_dn_item(Frame& F, int d) { const int e = d >> 8, q = d & 255, kb = q >> 4, nb = q & 15;
    cvt_block_f8(F.in(24) + (size_t)e * DEXP * DM + (size_t)(64 * kb) * DM + 64 * nb, DM, (unsigned char*)(F.ws + WS_WDN) + ((size_t)e * DM + 64 * nb) * 1024 + 64 * kb, F.lds + F.wave * 16384, F.lane); }
template <bool UP> __device__ __forceinline__ void cvt_range(Frame& F, int lo, int hi, int wr_, int nw) {
    for (int it = lo + wr_; it < hi; it += nw) { if (UP) cvt_up_item(F, it); else cvt_dn_item(F, it); }
}
__device__ __forceinline__ void p0_transpose_item_f8(const float* W, int ldw, unsigned char* WT, int k0, int n0, float scale, LAS float* scr, int lane) {
#pragma unroll 8
    for (int i = 0; i < 32; ++i) { const int kk = 2 * i + (lane >> 5); scr[kk * 33 + (lane & 31)] = W[(size_t)(k0 + kk) * ldw + n0 + (lane & 31)] * scale; }
    LDS_WAIT(); asm volatile("" ::: "memory");
    const int c = lane & 7;
#pragma unroll
    for (int j = 0; j < 4; ++j) { const int n = (lane >> 3) + 8 * j; const LAS float* s = scr + (8 * c) * 33 + n;
        int w0 = 0, w1 = 0; w0 = __builtin_amdgcn_cvt_pk_fp8_f32(s[0 * 33], s[1 * 33], w0, false); w0 = __builtin_amdgcn_cvt_pk_fp8_f32(s[2 * 33], s[3 * 33], w0, true);
        w1 = __builtin_amdgcn_cvt_pk_fp8_f32(s[4 * 33], s[5 * 33], w1, false); w1 = __builtin_amdgcn_cvt_pk_fp8_f32(s[6 * 33], s[7 * 33], w1, true);
        typedef int i32x2_ __attribute__((ext_vector_type(2))); *(GAS i32x2_*)(WT + (size_t)(n0 + n) * 1024 + k0 + 8 * c) = (i32x2_){w0, w1}; }
    LDS_WAIT(); asm volatile("" ::: "memory");
}
template <int PARTS = 7> __device__ __forceinline__ void p0_phase(Frame& F) {
    const float* c_in = F.in(1); const float* w_ada = F.in(2); const float* b_ada = F.in(3);
    float* MOD = (float*)(F.ws + WS_MOD);
    if ((PARTS & 1) && F.vcu < 192) {
        LAS float* sc = (LAS float*)F.lds;
        LAS float* red = (LAS float*)(F.lds + 32768);
        for (int i = F.tid; i < BATCH * DM; i += NWAVES * 64) { const int b = i >> 10, k = i & 1023; const float v = c_in[i]; sc[k * 8 + b] = v * sigmoid_f(v); }
        __syncthreads();
        for (int ci = F.vcu; ci < 192; ci += F.G) {
            const int col = F.lane & 31, ks = F.lane >> 5;
            float acc[8];
#pragma unroll
            for (int b = 0; b < 8; ++b) acc[b] = 0.f;
            const float* wp = w_ada + (size_t)(128 * F.wave + ks) * (NMOD * DM) + ci * 32 + col;
#pragma unroll 1
            for (int i0 = 0; i0 < 64; i0 += 32) {
                float wv[32];
#pragma unroll
                for (int i = 0; i < 32; ++i) wv[i] = wp[(size_t)(2 * (i0 + i)) * (NMOD * DM)];
#pragma unroll
                for (int i = 0; i < 32; ++i) { const LAS f32x4* sp = (const LAS f32x4*)(sc + (128 * F.wave + 2 * (i0 + i) + ks) * 8); const f32x4 s0 = sp[0], s1 = sp[1];
                    acc[0] += s0[0] * wv[i]; acc[1] += s0[1] * wv[i]; acc[2] += s0[2] * wv[i]; acc[3] += s0[3] * wv[i]; acc[4] += s1[0] * wv[i]; acc[5] += s1[1] * wv[i]; acc[6] += s1[2] * wv[i]; acc[7] += s1[3] * wv[i]; }
            }
#pragma unroll
            for (int b = 0; b < 8; ++b) { acc[b] += __shfl_xor(acc[b], 32); if (ks == 0) red[(F.wave * 8 + b) * 32 + col] = acc[b]; }
            __syncthreads();
            if (F.tid < 256) { const int b = F.tid >> 5, cl = F.tid & 31; float s = 0.f;
#pragma unroll
              for (int w = 0; w < 8; ++w) s += red[(w * 8 + b) * 32 + cl];
              MOD[b * NMOD * DM + ci * 32 + cl] = s + b_ada[ci * 32 + cl]; }
            __syncthreads();
        }
    }
    __syncthreads();
    const float* w_in = F.in(6); const float* w_out = F.in(17); const float* gn_attn = F.in(16);
    bf16* WIN = (bf16*)(F.ws + WS_WIN); bf16* WOUT = (bf16*)(F.ws + WS_WOUT);
    LAS float* scr = (LAS float*)(F.lds + F.wave * 16384);
    const int gw = F.vcu * NWAVES + F.wave, NGW = F.G * NWAVES;
    constexpr int I_IN = 16 * (NPJ / 32), I_OUT = 16 * (DM / 32);
    constexpr int NITEMS = I_IN + I_OUT;
    if (PARTS & 2) for (int it = gw; it < NITEMS; it += NGW) {
        int r = it;
        if (r < I_IN) { const int kb = r / (NPJ / 32), nb = r % (NPJ / 32); p0_transpose_item(w_in, NPROJ, WIN, 64 * kb, 32 * nb, 64 * kb, nullptr, scr, F.lane); continue; } r -= I_IN;
        { const int kb = r / (DM / 32), nb = r % (DM / 32); const int k0 = 64 * kb;
            p0_transpose_item(w_out, DM, WOUT, k0, 32 * nb, (k0 + 512) & 1023, k0 >= 512 ? gn_attn - 512 : nullptr, scr, F.lane); }
    }
    if (PARTS & 4) { const bool tails = (F.G == 256);
      cvt_range<true>(F, tails ? CV_UP_TAIL : 0, CV_UP_ITEMS, gw, NGW);
      cvt_range<false>(F, tails ? CV_DN_TAIL : 0, CV_DN_ITEMS, gw, NGW); }
    if (PARTS & 2) { const float* w_in2 = F.in(6); float* WFT = (float*)(F.ws + WS_WFT);
      for (int idx = F.vcu * (NWAVES * 64) + F.tid; idx < 8 * DM; idx += F.G * NWAVES * 64) { const int h = idx >> 10, k = idx & 1023; WFT[idx] = w_in2[(size_t)k * NPROJ + NPJ + h]; } }
    { const float* w_router = F.in(20); float* WRT = (float*)(F.ws + WS_WRT);
      for (int idx = F.vcu * (NWAVES * 64) + F.tid; idx < NE * DM; idx += F.G * NWAVES * 64) { const int e = idx >> 10, k = idx & 1023; WRT[idx] = w_router[k * NE + e]; } }
    { const float* wa = F.in(9); const float* wx = F.in(11); bf16* LWT = (bf16*)(F.ws + WS_LWT);
      for (int idx = F.vcu * (NWAVES * 64) + F.tid; idx < 2 * 8 * 64 * 64; idx += F.G * NWAVES * 64) { const int gate = idx >> 15, g = (idx >> 12) & 7, j = (idx >> 6) & 63, i = idx & 63;
          LWT[idx] = (bf16)f2bf((gate ? wx : wa)[(g * 64 + i) * 64 + j]); } }
}

__device__ __forceinline__ void p1_phase(Frame& F) {
    const float* x = F.in(0); const float* gpre = F.in(4); const float* fb = F.in(14);
    const float* MOD = (const float*)(F.ws + WS_MOD); bf16* H1 = (bf16*)(F.ws + WS_H1); float* LOGF2 = (float*)(F.ws + WS_LOGF2);
    LAS float* wf = (LAS float*)F.lds;
    { const float* WFT = (const float*)(F.ws + WS_WFT);
#pragma unroll
      for (int i = F.tid; i < 8 * DM / 4; i += NWAVES * 64) *(LAS f32x4*)(wf + 4 * i) = *(const f32x4*)(WFT + 4 * i); }
    __syncthreads();
    const int gw = F.vcu * NWAVES + F.wave;
    if (F.G * NWAVES * 8 != NTOK) return;
    const int row0 = gw * 8, b = row0 / SEQ;
    f32x4 gm[4], sh[4];
#pragma unroll
    for (int j = 0; j < 4; ++j) { const int k = 4 * F.lane + 256 * j; const f32x4 g = *(const f32x4*)(gpre + k), s = *(const f32x4*)(MOD + b * NMOD * DM + DM + k); gm[j] = g * (s + 1.0f); sh[j] = *(const f32x4*)(MOD + b * NMOD * DM + k); }
    f32x4 nx[4];
#pragma unroll
    for (int j = 0; j < 4; ++j) nx[j] = *(const f32x4*)(x + (size_t)row0 * DM + 4 * F.lane + 256 * j);
    for (int r = 0; r < 8; ++r) { const int row = row0 + r;
        f32x4 v[4]; float ss = 0.f;
#pragma unroll
        for (int j = 0; j < 4; ++j) { v[j] = nx[j]; ss += (v[j][0] * v[j][0] + v[j][1] * v[j][1]) + (v[j][2] * v[j][2] + v[j][3] * v[j][3]); }
        if (r < 7) {
#pragma unroll
            for (int j = 0; j < 4; ++j) nx[j] = *(const f32x4*)(x + (size_t)(row + 1) * DM + 4 * F.lane + 256 * j); }
        const float rinv = 1.0f / sqrtf(wave_sum(ss) * (1.0f / DM) + RMS_EPS);
        float fl[8];
#pragma unroll
        for (int h = 0; h < 8; ++h) fl[h] = 0.f;
#pragma unroll
        for (int j = 0; j < 4; ++j) { const f32x4 hv = v[j] * rinv * gm[j] + sh[j];
            v2u o; o.x = pk2(hv[0], hv[1]); o.y = pk2(hv[2], hv[3]); *(GAS v2u*)(H1 + (size_t)row * DM + 4 * F.lane + 256 * j) = o;
#pragma unroll
            for (int h = 0; h < 8; ++h) { const f32x4 w = *(const LAS f32x4*)(wf + h * DM + 4 * F.lane + 256 * j); fl[h] += (hv[0] * w[0] + hv[1] * w[1]) + (hv[2] * w[2] + hv[3] * w[3]); } }
#pragma unroll
        for (int h = 0; h < 8; ++h) fl[h] = wave_sum(fl[h]);
        if (F.lane < 8) { float f = fl[0];
#pragma unroll
            for (int h = 1; h < 8; ++h) f = (F.lane == h) ? fl[h] : f;
            LOGF2[(size_t)row * 8 + F.lane] = log_sigmoid_f(f + fb[F.lane]) * 1.4426950408889634f; }
    }
}

constexpr int LRU_XP = 1040;
constexpr int LRU_XT = 0, LRU_XC = 69696, LRU_CAR = 136256;
constexpr int CW_LRU = 131072;
static_assert(LRU_CAR + 2048 <= SCRATCH_BYTES && 67 * LRU_XP <= LRU_XC && LRU_XC + 64 * LRU_XP <= LRU_CAR, "LRU LDS map");
__device__ __forceinline__ float one_minus_exp(float x) { const float p = -x * (1.0f + x * (0.5f + x * (0.16666667f + x * (0.041666668f + x * (0.0083333338f + x * (0.0013888889f + x * 0.00019841270f)))))); const float d = 1.0f - __builtin_amdgcn_exp2f(1.4426950408889634f * x); return x > -0.25f ? p : d; }
__device__ __forceinline__ void lru_item(Frame& F, int b, int c) {
    LAS unsigned char* XT = F.lds + LRU_XT; LAS unsigned char* XC = F.lds + LRU_XC; LAS float* CAR = (LAS float*)(F.lds + LRU_CAR);
    const bf16* XL = (const bf16*)(F.ws + WS_PJ); const bf16* YL = XL + PJ_STRIDE; const bf16* LWT = (const bf16*)(F.ws + WS_LWT);
    float* LSUM = (float*)(F.ws + WS_LSUM); bf16* MRG = (bf16*)(F.ws + WS_MRG); unsigned* flags = (unsigned*)(F.ws + WS_CTL) + CW_LRU;
    const float* conv_w = F.in(7); const float* conv_b = F.in(8); const float* ba = F.in(10); const float* bx = F.in(12); const float* lam = F.in(13); const float* gn_lru = F.in(15);
    const int t0 = c * 64; const size_t rowb = (size_t)b * SEQ;
    { v4u xv[9];
#pragma unroll
      for (int q = 0; q < 9; ++q) { const int p = F.tid + q * (NWAVES * 64), i = p >> 6, c8 = p & 63, t = t0 - 3 + i; xv[q] = (v4u){0u, 0u, 0u, 0u};
          if (p < 67 * 64 && t >= 0) xv[q] = *(const GAS v4u*)(XL + (rowb + t) * 512 + c8 * 8); }
#pragma unroll
      for (int q = 0; q < 9; ++q) { const int p = F.tid + q * (NWAVES * 64), i = p >> 6, c8 = p & 63; if (p < 67 * 64) *(LAS v4u*)(XT + i * LRU_XP + c8 * 16) = xv[q]; } }
    v4u yv8[8];
#pragma unroll
    for (int q = 0; q < 8; ++q) { const int p = F.tid + q * (NWAVES * 64), i = p >> 6, c8 = p & 63; yv8[q] = *(const GAS v4u*)(YL + (rowb + t0 + i) * 512 + c8 * 8); }
    __syncthreads();
    { const int ch = F.tid; const float w0 = conv_w[ch], w1 = conv_w[512 + ch], w2 = conv_w[1024 + ch], w3 = conv_w[1536 + ch], cb = conv_b[ch];
      float xa = bf1(*(const LAS bf16*)(XT + 0 * LRU_XP + ch * 2)), xb = bf1(*(const LAS bf16*)(XT + 1 * LRU_XP + ch * 2)), xc = bf1(*(const LAS bf16*)(XT + 2 * LRU_XP + ch * 2));
#pragma unroll 8
      for (int t = 0; t < 64; ++t) { const float xd = bf1(*(const LAS bf16*)(XT + (t + 3) * LRU_XP + ch * 2)); const float v = ((w0 * xa + w1 * xb) + (w2 * xc + w3 * xd)) + cb;
          *(LAS bf16*)(XC + t * LRU_XP + ch * 2) = (bf16)f2bf(v); xa = xb; xb = xc; xc = xd; } }
    __syncthreads();
#pragma unroll
    for (int q = 0; q < 8; ++q) { const int p = F.tid + q * (NWAVES * 64), i = p >> 6, c8 = p & 63; *(LAS v4u*)(XT + i * LRU_XP + c8 * 16) = yv8[q]; }
    const int g = F.wave, l31 = F.lane & 31, hi = F.lane >> 5;
    __syncthreads();
#pragma unroll 1
    for (int hp = 0; hp < 2; ++hp) {
        const int chl = g * 64 + 32 * hp + l31;
        f32x16 cumA[2], hloc[2];
#pragma unroll
        for (int tg = 0; tg < 2; ++tg) { cumA[tg] = f32x16{}; hloc[tg] = f32x16{}; }
#pragma unroll
        for (int s = 0; s < 4; ++s) {
            const bf16x8 wa = *(const GAS bf16x8*)(LWT + ((size_t)((0 * 8 + g) * 64 + 32 * hp + l31)) * 64 + 16 * s + 8 * hi);
            const bf16x8 wx = *(const GAS bf16x8*)(LWT + ((size_t)((1 * 8 + g) * 64 + 32 * hp + l31)) * 64 + 16 * s + 8 * hi);
#pragma unroll
            for (int tg = 0; tg < 2; ++tg) { const bf16x8 bfr = *(const LAS bf16x8*)(XC + (32 * tg + l31) * LRU_XP + (g * 64 + 16 * s + 8 * hi) * 2);
                cumA[tg] = __builtin_amdgcn_mfma_f32_32x32x16_bf16(bfr, wa, cumA[tg], 0, 0, 0); hloc[tg] = __builtin_amdgcn_mfma_f32_32x32x16_bf16(bfr, wx, hloc[tg], 0, 0, 0); }
        }
        const float pba = ba[chl], pbx = bx[chl], psp = 8.0f * softplus_f(-lam[chl]);
        float cA = 1.0f, cB = 0.0f;
#pragma unroll
        for (int tg = 0; tg < 2; ++tg) {
            f32x16& A = cumA[tg]; f32x16& X = hloc[tg];
#pragma unroll
            for (int r = 0; r < 16; ++r) { const int tok = 32 * tg + (r & 3) + 8 * (r >> 2) + 4 * hi; const float xv = bf1(*(const LAS bf16*)(XC + tok * LRU_XP + chl * 2));
                const float rg = sigmoid_f(A[r] + pba), ig = sigmoid_f(X[r] + pbx); const float la = -rg * psp;
                A[r] = __builtin_amdgcn_exp2f(1.4426950408889634f * la); X[r] = __builtin_amdgcn_sqrtf(one_minus_exp(2.0f * la)) * (ig * xv); }
#pragma unroll
            for (int q = 0; q < 4; ++q)
#pragma unroll
                for (int i = 1; i < 4; ++i) { X[4 * q + i] = A[4 * q + i] * X[4 * q + i - 1] + X[4 * q + i]; A[4 * q + i] = A[4 * q + i] * A[4 * q + i - 1]; }
#pragma unroll
            for (int q2 = 0; q2 < 8; ++q2) { const int q = q2 >> 1; const bool own = (hi == (q2 & 1));
#pragma unroll
                for (int i = 0; i < 4; ++i) { const float nb = A[4 * q + i] * cB + X[4 * q + i], na = A[4 * q + i] * cA; X[4 * q + i] = own ? nb : X[4 * q + i]; A[4 * q + i] = own ? na : A[4 * q + i]; }
                const float ra = __shfl_xor(A[4 * q + 3], 32), rb = __shfl_xor(X[4 * q + 3], 32);
                cA = own ? A[4 * q + 3] : ra; cB = own ? X[4 * q + 3] : rb; }
        }
        if (hi == 0) { float* d0 = LSUM + (((size_t)b * 32 + c) * 2 + 0) * 512 + chl; __hip_atomic_store(d0, cA, __ATOMIC_RELAXED, __HIP_MEMORY_SCOPE_AGENT); __hip_atomic_store(d0 + 512, cB, __ATOMIC_RELAXED, __HIP_MEMORY_SCOPE_AGENT); }
        asm volatile("s_waitcnt vmcnt(0)" ::: "memory");
        __syncthreads();
        if (F.tid == 0) {
            __hip_atomic_store(flags + 64 * ((32 * b + c) * 2 + hp), 1u, __ATOMIC_RELAXED, __HIP_MEMORY_SCOPE_AGENT);
            for (int j = 0; j < c; ++j) { unsigned sp = 0; while (__hip_atomic_load(flags + 64 * ((32 * b + j) * 2 + hp), __ATOMIC_RELAXED, __HIP_MEMORY_SCOPE_AGENT) == 0u) { __builtin_amdgcn_s_sleep(1); if (++sp > (1u << 22)) break; } }
        }
        __syncthreads();
        if (F.tid < 256) { const int ch = (F.tid >> 5) * 64 + 32 * hp + (F.tid & 31); float cr = 0.f; float* LS = LSUM + (size_t)b * 32 * 2 * 512 + ch;
          for (int c0 = 0; c0 < c; c0 += 16) { float A8[16], B8[16];
#pragma unroll
              for (int u = 0; u < 16; ++u) { const bool ok = (c0 + u) < c; A8[u] = 1.0f; B8[u] = 0.0f; if (ok) { A8[u] = __hip_atomic_load(LS + (size_t)(c0 + u) * 1024, __ATOMIC_RELAXED, __HIP_MEMORY_SCOPE_AGENT); B8[u] = __hip_atomic_load(LS + (size_t)(c0 + u) * 1024 + 512, __ATOMIC_RELAXED, __HIP_MEMORY_SCOPE_AGENT); } }
#pragma unroll
              for (int u = 0; u < 16; ++u) cr = A8[u] * cr + B8[u]; }
          CAR[ch] = cr; }
        __syncthreads();
        { const float cin = CAR[chl];
#pragma unroll
          for (int tg = 0; tg < 2; ++tg)
#pragma unroll
              for (int r = 0; r < 16; ++r) { const int tok = 32 * tg + (r & 3) + 8 * (r >> 2) + 4 * hi; LAS bf16* yp = (LAS bf16*)(XT + tok * LRU_XP + chl * 2);
                  const float h = hloc[tg][r] + cumA[tg][r] * cin; *yp = (bf16)f2bf(h * gelu_tanh_f(bf1(*yp))); } }
    }
    __syncthreads();
#pragma unroll 2
    for (int q = 0; q < 8; ++q) { const int i = F.wave + 8 * q, c8 = F.lane;
        const v4u w = *(const LAS v4u*)(XT + i * LRU_XP + c8 * 16);
        const float v0 = bflo(w.x), v1 = bfhi(w.x), v2 = bflo(w.y), v3 = bfhi(w.y), v4 = bflo(w.z), v5 = bfhi(w.z), v6 = bflo(w.w), v7 = bfhi(w.w);
        const float ss = wave_sum(((v0 * v0 + v1 * v1) + (v2 * v2 + v3 * v3)) + ((v4 * v4 + v5 * v5) + (v6 * v6 + v7 * v7)));
        const float rinv = 1.0f / sqrtf(ss * (1.0f / DLRU) + RMS_EPS);
        const f32x4 g0 = *(const f32x4*)(gn_lru + c8 * 8), g1 = *(const f32x4*)(gn_lru + c8 * 8 + 4);
        v4u o; o.x = pk2(v0 * rinv * g0[0], v1 * rinv * g0[1]); o.y = pk2(v2 * rinv * g0[2], v3 * rinv * g0[3]); o.z = pk2(v4 * rinv * g1[0], v5 * rinv * g1[1]); o.w = pk2(v6 * rinv * g1[2], v7 * rinv * g1[3]);
        *(GAS v4u*)(MRG + (rowb + t0 + i) * 1024 + 512 + c8 * 8) = o; }
    __syncthreads();
}
__device__ __forceinline__ void lru_phase(Frame& F) { for (int it = F.vcu; it < BATCH * 32; it += F.G) lru_item(F, it >> 5, it & 31); }

__device__ __forceinline__ void p6_phase(Frame& F) {
    const float* x = F.in(0); const float* gpost = F.in(5); const float* gffn = F.in(18); const float* b_router = F.in(21);
    const float* MOD = (const float*)(F.ws + WS_MOD); const bf16* Y = (const bf16*)(F.ws + WS_Y); unsigned char* H2 = (unsigned char*)(F.ws + WS_H2);
    int* TOPI = (int*)(F.ws + WS_TOPI); float* TOPW = (float*)(F.ws + WS_TOPW); int* WGCNT = (int*)(F.ws + WS_WGCNT);
    LAS float* wrl = (LAS float*)F.lds;
    LAS int* hist = (LAS int*)(F.lds + 131072);
    { const float* WRT = (const float*)(F.ws + WS_WRT);
#pragma unroll 4
      for (int i = F.tid; i < NE * DM / 4; i += NWAVES * 64) *(LAS f32x4*)(wrl + 4 * i) = *(const f32x4*)(WRT + 4 * i); }
    if (F.tid < NE) hist[F.tid] = 0;
    __syncthreads();
    if (F.G * 64 == NTOK) {
    const int bx = blockIdx.x, row0 = bx * 64 + F.wave * 8, b = row0 / SEQ;
    f32x4 gpm[4], gf[4], shf[4];
#pragma unroll
    for (int j = 0; j < 4; ++j) { const int k = 4 * F.lane + 256 * j; const float* mb = MOD + b * NMOD * DM + k;
        gpm[j] = *(const f32x4*)(mb + 2 * DM) * *(const f32x4*)(gpost + k); gf[j] = *(const f32x4*)(gffn + k) * (*(const f32x4*)(mb + 4 * DM) + 1.0f); shf[j] = *(const f32x4*)(mb + 3 * DM); }
    for (int rp = 0; rp < 4; ++rp) {
        f32x4 hv[2][4];
#pragma unroll
        for (int u = 0; u < 2; ++u) { const int row = row0 + 2 * rp + u;
            f32x4 yv[4]; float ss = 0.f;
#pragma unroll
            for (int j = 0; j < 4; ++j) { const v2u yw = *(const GAS v2u*)(Y + (size_t)row * DM + 4 * F.lane + 256 * j); yv[j] = (f32x4){bflo(yw.x), bfhi(yw.x), bflo(yw.y), bfhi(yw.y)}; ss += (yv[j][0] * yv[j][0] + yv[j][1] * yv[j][1]) + (yv[j][2] * yv[j][2] + yv[j][3] * yv[j][3]); }
            const float rinv = 1.0f / sqrtf(wave_sum(ss) * (1.0f / DM) + RMS_EPS);
            float s2 = 0.f;
#pragma unroll
            for (int j = 0; j < 4; ++j) { const f32x4 xm = *(const f32x4*)(x + (size_t)row * DM + 4 * F.lane + 256 * j) + gpm[j] * (yv[j] * rinv);
                *(f32x4*)(F.out + (size_t)row * DM + 4 * F.lane + 256 * j) = xm; yv[j] = xm; s2 += (xm[0] * xm[0] + xm[1] * xm[1]) + (xm[2] * xm[2] + xm[3] * xm[3]); }
            const float rinv2 = 1.0f / sqrtf(wave_sum(s2) * (1.0f / DM) + RMS_EPS);
#pragma unroll
            for (int j = 0; j < 4; ++j) { const f32x4 h = yv[j] * rinv2 * gf[j] + shf[j]; hv[u][j] = h;
                int w8 = 0; w8 = __builtin_amdgcn_cvt_pk_fp8_f32(h[0], h[1], w8, false); w8 = __builtin_amdgcn_cvt_pk_fp8_f32(h[2], h[3], w8, true); *(GAS int*)(H2 + (size_t)row * DM + 4 * F.lane + 256 * j) = w8; }
        }
        float pa[32], pb[32];
#pragma unroll
        for (int e = 0; e < 32; ++e) { float sa = 0.f, sb = 0.f;
#pragma unroll
            for (int j = 0; j < 4; ++j) { const f32x4 w = *(const LAS f32x4*)(wrl + e * DM + 4 * F.lane + 256 * j);
                sa += (hv[0][j][0] * w[0] + hv[0][j][1] * w[1]) + (hv[0][j][2] * w[2] + hv[0][j][3] * w[3]); sb += (hv[1][j][0] * w[0] + hv[1][j][1] * w[1]) + (hv[1][j][2] * w[2] + hv[1][j][3] * w[3]); }
            pa[e] = sa; pb[e] = sb; }
#define TR_STEP(N, OFF, BIT) _Pragma("unroll") for (int i = 0; i < N; ++i) { const bool up = (F.lane & BIT) != 0; \
            const float ka = up ? pa[N + i] : pa[i], sa_ = up ? pa[i] : pa[N + i], kb = up ? pb[N + i] : pb[i], sb_ = up ? pb[i] : pb[N + i]; \
            pa[i] = ka + __shfl_xor(sa_, OFF); pb[i] = kb + __shfl_xor(sb_, OFF); }
        TR_STEP(16, 32, 32) TR_STEP(8, 16, 16) TR_STEP(4, 8, 8) TR_STEP(2, 4, 4) TR_STEP(1, 2, 2)
#undef TR_STEP
        const int e = (F.lane >> 1) & 31; const float br = b_router[e];
#pragma unroll
        for (int u = 0; u < 2; ++u) { const int row = row0 + 2 * rp + u; float v = (u ? pb[0] : pa[0]); v += __shfl_xor(v, 1); v += br;
            int rank = 0;
#pragma unroll
            for (int j = 0; j < 32; ++j) { const float vj = __uint_as_float((unsigned)__builtin_amdgcn_readlane((int)__float_as_uint(v), 2 * j)); rank += (vj > v || (vj == v && j < e)) ? 1 : 0; }
            const bool sel = rank < TOPK; const float vmax = wave_max(v); const float ex = sel ? __expf(v - vmax) : 0.f; const float den = wave_sum(ex) * 0.5f;
            if (sel && !(F.lane & 1)) { TOPI[(size_t)row * TOPK + rank] = e; TOPW[(size_t)row * TOPK + rank] = ex / den; __hip_atomic_fetch_add((LAS int*)&hist[e], 1, __ATOMIC_RELAXED, __HIP_MEMORY_SCOPE_WORKGROUP); } }
    }
    __syncthreads();
    if (F.tid < NE) WGCNT[bx * NE + F.tid] = hist[F.tid];
    }
}

__device__ __forceinline__ void p7_phase(Frame& F) {
    const int* TOPI = (const int*)(F.ws + WS_TOPI); const float* TOPW = (const float*)(F.ws + WS_TOPW); const int* WGCNT = (const int*)(F.ws + WS_WGCNT);
    int* ROWTOK = (int*)(F.ws + WS_ROWTOK); int* ROWPAIR = (int*)(F.ws + WS_ROWPAIR); float* ROWW = (float*)(F.ws + WS_ROWW); int* MTEXP = (int*)(F.ws + WS_MTEXP);
    LAS int* ptot = (LAS int*)F.lds; LAS int* pbef = ptot + 512; LAS int* cnt = pbef + 512; LAS int* wgb = cnt + 32; LAS int* pst = wgb + 32; LAS int* pad = pst + 64; LAS int* ep = pad + 32;
    if (F.G != 256) return;
    const int bx = blockIdx.x;
    { const int e = F.tid & 31, part = F.tid >> 5; int tt = 0, tb = 0;
      for (int w = part * 16; w < part * 16 + 16; ++w) { const int v = WGCNT[w * NE + e]; tt += v; tb += (w < bx) ? v : 0; }
      ptot[part * 32 + e] = tt; pbef[part * 32 + e] = tb; }
    __syncthreads();
    if (F.tid < NE) { int tt = 0, tb = 0; for (int p = 0; p < 16; ++p) { tt += ptot[p * 32 + F.tid]; tb += pbef[p * 32 + F.tid]; } cnt[F.tid] = tt; wgb[F.tid] = tb; pad[F.tid] = (tt + 255) & ~255; }
    __syncthreads();
    if (F.tid == 0) { int s = 0; for (int e = 0; e < NE; ++e) { pst[e] = s; s += pad[e]; } pst[NE] = s; }
    if (F.tid < 256) ep[F.tid] = TOPI[(size_t)bx * 256 + F.tid];
    __syncthreads();
    if (F.tid < 256) { const int p = F.tid, e = ep[p]; int rk = 0; for (int q = 0; q < p; ++q) rk += (ep[q] == e) ? 1 : 0;
        const int dest = pst[e] + wgb[e] + rk; const int pair = bx * 256 + p; ROWTOK[dest] = pair >> 2; ROWPAIR[dest] = pair; ROWW[dest] = TOPW[pair]; }
    if (bx < NE) { const int e = bx; for (int i = pst[e] + cnt[e] + F.tid; i < pst[e] + pad[e]; i += NWAVES * 64) { ROWTOK[i] = 0; ROWPAIR[i] = -1; ROWW[i] = 0.f; } }
    if (bx == 0) { if (F.tid < NE) { for (int mt = pst[F.tid] >> 8; mt < (pst[F.tid] + pad[F.tid]) >> 8; ++mt) MTEXP[mt] = F.tid; } if (F.tid == 0) MTEXP[512] = pst[NE] >> 8; }
}

__device__ __forceinline__ void p10_phase(Frame& F) {
    const float* gpost = F.in(19); const float* MOD = (const float*)(F.ws + WS_MOD); const bf16* YP = (const bf16*)(F.ws + WS_YP);
    const int gw = F.vcu * NWAVES + F.wave;
    if (F.G * NWAVES * 8 != NTOK) return;
    const int row0 = gw * 8, b = row0 / SEQ;
    f32x4 gg[4];
#pragma unroll
    for (int j = 0; j < 4; ++j) { const int k = 4 * F.lane + 256 * j; gg[j] = *(const f32x4*)(MOD + b * NMOD * DM + 5 * DM + k) * *(const f32x4*)(gpost + k); }
    v2u nw[4][TOPK];
#pragma unroll
    for (int j = 0; j < 4; ++j)
#pragma unroll
        for (int k = 0; k < TOPK; ++k) nw[j][k] = *(const GAS v2u*)(YP + ((size_t)row0 * TOPK + k) * DM + 4 * F.lane + 256 * j);
    for (int r = 0; r < 8; ++r) { const int row = row0 + r;
        f32x4 y[4]; float ss = 0.f;
#pragma unroll
        for (int j = 0; j < 4; ++j) { f32x4 s = (f32x4){0.f, 0.f, 0.f, 0.f};
#pragma unroll
            for (int k = 0; k < TOPK; ++k) { const v2u w = nw[j][k]; s += (f32x4){bflo(w.x), bfhi(w.x), bflo(w.y), bfhi(w.y)}; }
            y[j] = s; ss += (s[0] * s[0] + s[1] * s[1]) + (s[2] * s[2] + s[3] * s[3]); }
        if (r < 7) {
#pragma unroll
            for (int j = 0; j < 4; ++j)
#pragma unroll
                for (int k = 0; k < TOPK; ++k) nw[j][k] = *(const GAS v2u*)(YP + ((size_t)(row + 1) * TOPK + k) * DM + 4 * F.lane + 256 * j); }
        const float rinv = 1.0f / sqrtf(wave_sum(ss) * (1.0f / DM) + RMS_EPS);
#pragma unroll
        for (int j = 0; j < 4; ++j) { float* op = F.out + (size_t)row * DM + 4 * F.lane + 256 * j; *(f32x4*)op = *(const f32x4*)op + gg[j] * (y[j] * rinv); }
    }
}

__global__ void __launch_bounds__(NWAVES * 64, 2) mega_fwd(Args args) {
    extern __shared__ __attribute__((aligned(16))) unsigned char lds[];
    Frame F;
    F.lds = (LAS unsigned char*)lds;
    F.tid = threadIdx.x; F.lane = F.tid & 63; F.wave = __builtin_amdgcn_readfirstlane(F.tid >> 6);
    F.G = gridDim.x; { const int bx = blockIdx.x; F.vcu = (F.G % 8 == 0) ? (bx % 8) * (F.G / 8) + bx / 8 : bx; }
    F.out = args.out; F.ws = args.ws;
    volatile LAS unsigned* MISC = (volatile LAS unsigned*)(F.lds + MISC_OFF);
    for (int u = F.tid; u < (LDS_BYTES - LDSCTL_OFF) / 4; u += NWAVES * 64) ((LAS unsigned*)(F.lds + LDSCTL_OFF))[u] = 0u;
    __syncthreads();
    if (F.tid < 26) ((LAS unsigned long long*)(F.lds + LDSCTL_OFF))[F.tid] = (unsigned long long)args.in[F.tid];
    __syncthreads();
    gu32* ctl = (gu32*)(F.ws + WS_CTL);
    XcdBarrier bar = xcd_barrier_post((unsigned*)(ctl + CW_BAR) + args.li * XCD_BAR_WORDS, MISC + 8);
    const int lo = args.ph_lo, hi = args.ph_hi;
#ifndef PHMASK
#define PHMASK 0x7ff
#endif
#define IN(k) (((PHMASK >> (k)) & 1) && lo <= (k) && (k) < hi)
#ifndef REPMASK
#define REPMASK 0
#endif
#define NREP(k) (((REPMASK >> (k)) & 1) ? 2 : 1)
#define SEAM(k) do { if ((k) != 3 && IN(k) && IN((k) + 1)) xcd_barrier(bar); if ((k) == 3 && IN(3) && IN(5)) xcd_barrier(bar); } while (0)
#define REFRESH() do { int t_; asm volatile("v_mov_b32 %0, %1" : "=v"(t_) : "v"(threadIdx.x)); F.tid = t_; F.lane = t_ & 63; } while (0)
    if (IN(0)) { { REFRESH(); p0_phase(F);  }
      if (NREP(0) > 1) { xcd_barrier(bar); REFRESH(); p0_phase(F);  } } SEAM(0);

    if (IN(1)) { { REFRESH(); p1_phase(F);  }
      if (NREP(1) > 1) { xcd_barrier(bar); REFRESH(); p1_phase(F);  } } SEAM(1);

    if (IN(2)) { { REFRESH();
        pg8::DenseOrder S; S.init((const pg8::bf16_t*)(F.ws + WS_H1), (const pg8::bf16_t*)(F.ws + WS_WIN), NTOK, NPJ, F.G, (int)blockIdx.x);
        pg8::EpiProj E{(pg8::bf16_t*)(F.ws + WS_PJ), PJ_STRIDE, attn_body::C2};
        pg8::gemm_phase<pg8::EpiProj, pg8::DenseOrder>(F.lds, S, E);
        if (F.G == 256 && blockIdx.x >= 128) { REFRESH(); cvt_range<true>(F, 0, CV_UP_TAIL, ((int)blockIdx.x - 128) * NWAVES + F.wave, 128 * NWAVES); } }
      if (NREP(2) > 1) { xcd_barrier(bar); REFRESH();
        pg8::DenseOrder S; S.init((const pg8::bf16_t*)(F.ws + WS_H1), (const pg8::bf16_t*)(F.ws + WS_WIN), NTOK, NPJ, F.G, (int)blockIdx.x);
        pg8::EpiProj E{(pg8::bf16_t*)(F.ws + WS_PJ), PJ_STRIDE, attn_body::C2};
        pg8::gemm_phase<pg8::EpiProj, pg8::DenseOrder>(F.lds, S, E);
        if (F.G == 256 && blockIdx.x >= 128) { REFRESH(); cvt_range<true>(F, 0, CV_UP_TAIL, ((int)blockIdx.x - 128) * NWAVES + F.wave, 128 * NWAVES); } }     } SEAM(2);

    if (IN(3)) { { REFRESH();
        lru_phase(F);
        const attn_body::AttnTensors AT{(const attn_body::bf16*)(F.ws + WS_PJ) + 2 * PJ_STRIDE, (const attn_body::bf16*)(F.ws + WS_PJ) + 3 * PJ_STRIDE, (const attn_body::bf16*)(F.ws + WS_PJ) + 4 * PJ_STRIDE,
                                        (attn_body::bf16*)(F.ws + WS_MRG), (const float*)(F.ws + WS_LOGF2), (float*)(F.ws + WS_SSQ)};
        const attn_body::StaticOrder S((int)F.G, F.vcu);
        attn_body::attn_phase<attn_body::StaticOrder>((char*)lds, AT, S); }
      if (NREP(3) > 1) { xcd_barrier(bar); REFRESH();
        lru_phase(F);
        const attn_body::AttnTensors AT{(const attn_body::bf16*)(F.ws + WS_PJ) + 2 * PJ_STRIDE, (const attn_body::bf16*)(F.ws + WS_PJ) + 3 * PJ_STRIDE, (const attn_body::bf16*)(F.ws + WS_PJ) + 4 * PJ_STRIDE,
                                        (attn_body::bf16*)(F.ws + WS_MRG), (const float*)(F.ws + WS_LOGF2), (float*)(F.ws + WS_SSQ)};
        const attn_body::StaticOrder S((int)F.G, F.vcu);
        attn_body::attn_phase<attn_body::StaticOrder>((char*)lds, AT, S); } } SEAM(3);


    if (IN(5)) { { REFRESH();
        pg8::DenseOrder S; S.init((const pg8::bf16_t*)(F.ws + WS_MRG), (const pg8::bf16_t*)(F.ws + WS_WOUT), NTOK, DM, F.G, (int)blockIdx.x);
        pg8::EpiOut E{(pg8::bf16_t*)(F.ws + WS_Y), (const float*)(F.ws + WS_SSQ)};
        pg8::gemm_phase<pg8::EpiOut, pg8::DenseOrder>(F.lds, S, E); }
      if (NREP(5) > 1) { xcd_barrier(bar); REFRESH();
        pg8::DenseOrder S; S.init((const pg8::bf16_t*)(F.ws + WS_MRG), (const pg8::bf16_t*)(F.ws + WS_WOUT), NTOK, DM, F.G, (int)blockIdx.x);
        pg8::EpiOut E{(pg8::bf16_t*)(F.ws + WS_Y), (const float*)(F.ws + WS_SSQ)};
        pg8::gemm_phase<pg8::EpiOut, pg8::DenseOrder>(F.lds, S, E); } } SEAM(5);

    if (IN(6)) { { REFRESH(); p6_phase(F);  }
      if (NREP(6) > 1) { xcd_barrier(bar); REFRESH(); p6_phase(F);  } } SEAM(6);

    if (IN(7)) { { REFRESH(); p7_phase(F);  }
      if (NREP(7) > 1) { xcd_barrier(bar); REFRESH(); p7_phase(F);  } } SEAM(7);

    if (IN(8)) { { REFRESH();
        const int nmt = ((const int*)(F.ws + WS_MTEXP))[512];
        pg8::UpOrder S{(const unsigned char*)(F.ws + WS_H2), (const unsigned char*)(F.ws + WS_WUP), (const int*)(F.ws + WS_ROWTOK), (const int*)(F.ws + WS_MTEXP), nmt * 8, F.G, F.vcu};
        pg8::EpiUp E{(unsigned char*)(F.ws + WS_ACT), F.in(23)};
        pg8::gemm_phase<pg8::EpiUp, pg8::UpOrder, true>(F.lds, S, E);
        if (F.G == 256) {
            const int units = nmt * 8, maxu = (units + 255) >> 8, nfull = units - (maxu - 1) * 256, nidle = 256 - nfull;
            REFRESH();
            if (nidle >= 32) { if (F.vcu >= nfull) cvt_range<false>(F, 0, CV_DN_TAIL, (F.vcu - nfull) * NWAVES + F.wave, nidle * NWAVES); }
            else cvt_range<false>(F, 0, CV_DN_TAIL, F.vcu * NWAVES + F.wave, 256 * NWAVES); } }
      if (NREP(8) > 1) { xcd_barrier(bar); REFRESH();
        const int nmt = ((const int*)(F.ws + WS_MTEXP))[512];
        pg8::UpOrder S{(const unsigned char*)(F.ws + WS_H2), (const unsigned char*)(F.ws + WS_WUP), (const int*)(F.ws + WS_ROWTOK), (const int*)(F.ws + WS_MTEXP), nmt * 8, F.G, F.vcu};
        pg8::EpiUp E{(unsigned char*)(F.ws + WS_ACT), F.in(23)};
        pg8::gemm_phase<pg8::EpiUp, pg8::UpOrder, true>(F.lds, S, E);
        if (F.G == 256) {
            const int units = nmt * 8, maxu = (units + 255) >> 8, nfull = units - (maxu - 1) * 256, nidle = 256 - nfull;
            REFRESH();
            if (nidle >= 32) { if (F.vcu >= nfull) cvt_range<false>(F, 0, CV_DN_TAIL, (F.vcu - nfull) * NWAVES + F.wave, nidle * NWAVES); }
            else cvt_range<false>(F, 0, CV_DN_TAIL, F.vcu * NWAVES + F.wave, 256 * NWAVES); } } } SEAM(8);

    if (IN(9)) { { REFRESH();
        const int nmt = ((const int*)(F.ws + WS_MTEXP))[512];
        pg8::DownOrder S{(const unsigned char*)(F.ws + WS_ACT), (const unsigned char*)(F.ws + WS_WDN), (const int*)(F.ws + WS_MTEXP), nmt * 4, F.G, F.vcu};
        pg8::EpiDown E{(pg8::bf16_t*)(F.ws + WS_YP), F.in(25), (const int*)(F.ws + WS_ROWPAIR), (const float*)(F.ws + WS_ROWW)};
        pg8::gemm_phase<pg8::EpiDown, pg8::DownOrder, true>(F.lds, S, E); }
      if (NREP(9) > 1) { xcd_barrier(bar); REFRESH();
        const int nmt = ((const int*)(F.ws + WS_MTEXP))[512];
        pg8::DownOrder S{(const unsigned char*)(F.ws + WS_ACT), (const unsigned char*)(F.ws + WS_WDN), (const int*)(F.ws + WS_MTEXP), nmt * 4, F.G, F.vcu};
        pg8::EpiDown E{(pg8::bf16_t*)(F.ws + WS_YP), F.in(25), (const int*)(F.ws + WS_ROWPAIR), (const float*)(F.ws + WS_ROWW)};
        pg8::gemm_phase<pg8::EpiDown, pg8::DownOrder, true>(F.lds, S, E); } } SEAM(9);

    if (IN(10)) { { REFRESH(); p10_phase(F);  }
      if (NREP(10) > 1) { xcd_barrier(bar); REFRESH(); p10_phase(F);  } }
    if (lo == 11) { REFRESH(); lru_phase(F); }
    if (lo == 14) { REFRESH(); p0_phase<1>(F); }
    if (lo == 15) { REFRESH(); p0_phase<2>(F); }
    if (lo == 16) { REFRESH(); p0_phase<4>(F); }
    if (lo == 12) { REFRESH();
        const attn_body::AttnTensors AT{(const attn_body::bf16*)(F.ws + WS_PJ) + 2 * PJ_STRIDE, (const attn_body::bf16*)(F.ws + WS_PJ) + 3 * PJ_STRIDE, (const attn_body::bf16*)(F.ws + WS_PJ) + 4 * PJ_STRIDE,
                                        (attn_body::bf16*)(F.ws + WS_MRG), (const float*)(F.ws + WS_LOGF2), (float*)(F.ws + WS_SSQ)};
        const attn_body::StaticOrder S((int)F.G, F.vcu);
        attn_body::attn_phase<attn_body::StaticOrder>((char*)lds, AT, S); }
#undef IN
#undef SEAM
#undef REFRESH
}

static void launch_mega(hipStream_t stream, void* const* d_in, void* d_out, void* d_ws, int lo, int hi, int li, int grid) {
    Args a{};
    for (int i = 0; i < 26; ++i) a.in[i] = (const float*)d_in[i];
    a.out = (float*)d_out; a.ws = (unsigned char*)d_ws; a.ph_lo = lo; a.ph_hi = hi; a.li = li; a.pad = 0;
    hipLaunchKernelGGL(mega_fwd, dim3(grid), dim3(NWAVES * 64), LDS_BYTES, stream, a);
}

#if MIX < 4
namespace simple {
__device__ __forceinline__ float sigmoidf_(float x) { return 1.f / (1.f + __expf(-x)); }
__device__ __forceinline__ float gelu_tanh(float x) { const float u = 0.7978845608028654f * (x + 0.044715f * x * x * x); return 0.5f * x * (1.f + tanhf(u)); }
__device__ __forceinline__ float log_sigmoid(float z) { return z >= 0.f ? -log1pf(expf(-z)) : z - log1pf(expf(z)); }
__device__ __forceinline__ float softplusf_(float z) { return z > 0.f ? z + log1pf(expf(-z)) : log1pf(expf(z)); }

__device__ __forceinline__ float block_sum_256(float v, float* red) {
    for (int o = 32; o > 0; o >>= 1) v += __shfl_xor(v, o);
    const int w = threadIdx.x >> 6, l = threadIdx.x & 63;
    __syncthreads();
    if (l == 0) red[w] = v;
    __syncthreads();
    return red[0] + red[1] + red[2] + red[3];
}

__global__ void k_ada(const float* c, const float* w_ada, const float* b_ada, float* mod) {
    const int j = blockIdx.x * 256 + threadIdx.x, b = blockIdx.y;
    float acc = b_ada[j];
    for (int k = 0; k < DM; ++k) { const float cv = c[b * DM + k]; acc += cv * sigmoidf_(cv) * w_ada[(size_t)k * (NMOD * DM) + j]; }
    mod[b * NMOD * DM + j] = acc;
}

__global__ void k_prep(const float* x, const float* g, const float* mod, int sh_off, int sc_off, float* h) {
    __shared__ float red[4];
    const int row = blockIdx.x, b = row / SEQ;
    const float* xr = x + (size_t)row * DM;
    float v[4], s = 0.f;
#pragma unroll
    for (int i = 0; i < 4; ++i) { v[i] = xr[threadIdx.x + 256 * i]; s += v[i] * v[i]; }
    const float tot = block_sum_256(s, red);
    const float rinv = rsqrtf(tot / DM + RMS_EPS);
#pragma unroll
    for (int i = 0; i < 4; ++i) { const int k = threadIdx.x + 256 * i;
        h[(size_t)row * DM + k] = v[i] * rinv * g[k] * (1.f + mod[b * NMOD * DM + sc_off + k]) + mod[b * NMOD * DM + sh_off + k]; }
}

struct GemmArgs { const float* A; const float* B; float* C; const float* bias; const int* rowidx; const int* Mptr; int M, N, K, lda, ldb, ldc;
                  size_t gB, gC, gbias; int gidx; };
__global__ void __launch_bounds__(256) k_sgemm(GemmArgs a) {
    __shared__ float As[8][128 + 4], Bs[8][128 + 4];
    const int z = blockIdx.z;
    const float* B = a.B + z * a.gB; float* C = a.C + z * a.gC; const float* bias = a.bias ? a.bias + z * a.gbias : nullptr;
    const int* rowidx = a.rowidx ? a.rowidx + (size_t)z * a.gidx : nullptr;
    const int M = a.Mptr ? a.Mptr[z] : a.M;
    const int m0 = blockIdx.y * 128, n0 = blockIdx.x * 128;
    if (m0 >= M) return;
    const int tid = threadIdx.x, tx = tid & 15, ty = tid >> 4;
    float acc[8][8];
#pragma unroll
    for (int i = 0; i < 8; ++i)
#pragma unroll
        for (int j = 0; j < 8; ++j) acc[i][j] = 0.f;
    const int ar = tid >> 1, ak = (tid & 1) * 4;
    const int am = m0 + ar; const bool aok = am < M;
    const int arow = aok ? (rowidx ? rowidx[am] : am) : 0;
    const float* Ap = a.A + (size_t)arow * a.lda + ak;
    const int bk = tid >> 5, bn = (tid & 31) * 4;
    for (int k0 = 0; k0 < a.K; k0 += 8) {
        float4 av = aok ? *(const float4*)(Ap + k0) : make_float4(0.f, 0.f, 0.f, 0.f);
        float bv[4];
#pragma unroll
        for (int j = 0; j < 4; ++j) { const int n = n0 + bn + j; bv[j] = n < a.N ? B[(size_t)(k0 + bk) * a.ldb + n] : 0.f; }
        __syncthreads();
        As[ak + 0][ar] = av.x; As[ak + 1][ar] = av.y; As[ak + 2][ar] = av.z; As[ak + 3][ar] = av.w;
#pragma unroll
        for (int j = 0; j < 4; ++j) Bs[bk][bn + j] = bv[j];
        __syncthreads();
#pragma unroll
        for (int k = 0; k < 8; ++k) {
            float af[8], bf[8];
#pragma unroll
            for (int i = 0; i < 8; ++i) af[i] = As[k][ty * 8 + i];
#pragma unroll
            for (int j = 0; j < 8; ++j) bf[j] = Bs[k][tx * 8 + j];
#pragma unroll
            for (int i = 0; i < 8; ++i)
#pragma unroll
                for (int j = 0; j < 8; ++j) acc[i][j] += af[i] * bf[j];
        }
    }
#pragma unroll
    for (int i = 0; i < 8; ++i) { const int m = m0 + ty * 8 + i; if (m >= M) continue;
#pragma unroll
        for (int j = 0; j < 8; ++j) { const int n = n0 + tx * 8 + j; if (n < a.N) C[(size_t)m * a.ldc + n] = acc[i][j] + (bias ? bias[n] : 0.f); } }
}

__global__ void __launch_bounds__(64) k_lru(const float* proj, const float* conv_w, const float* conv_b, const float* wa, const float* ba, const float* wx, const float* bx,
                                            const float* lam, float* lru_out) {
    __shared__ float xc[64];
    const int b = blockIdx.x >> 3, g = blockIdx.x & 7, j = threadIdx.x, ch = g * 64 + j;
    float wac[64], wxc[64];
#pragma unroll
    for (int i = 0; i < 64; ++i) { wac[i] = wa[(g * 64 + i) * 64 + j]; wxc[i] = wx[(g * 64 + i) * 64 + j]; }
    const float cw0 = conv_w[0 * DLRU + ch], cw1 = conv_w[1 * DLRU + ch], cw2 = conv_w[2 * DLRU + ch], cw3 = conv_w[3 * DLRU + ch], cb = conv_b[ch];
    const float baj = ba[ch], bxj = bx[ch], sp = softplusf_(-lam[ch]);
    float x1 = 0.f, x2 = 0.f, x3 = 0.f, h = 0.f;
    for (int t = 0; t < SEQ; ++t) {
        const size_t row = (size_t)b * SEQ + t;
        const float x0 = proj[row * NPROJ + ch];
        const float y = proj[row * NPROJ + DLRU + ch];
        const float xcv = cw0 * x3 + cw1 * x2 + cw2 * x1 + cw3 * x0 + cb;
        x3 = x2; x2 = x1; x1 = x0;
        __syncthreads();
        xc[j] = xcv;
        __syncthreads();
        float ra = baj, ri = bxj;
#pragma unroll
        for (int i = 0; i < 64; ++i) { const float xi = xc[i]; ra += xi * wac[i]; ri += xi * wxc[i]; }
        const float r = sigmoidf_(ra), ig = sigmoidf_(ri);
        const float log_a = -8.0f * r * sp;
        const float av = expf(log_a);
        const float gx = sqrtf(1.f - expf(2.f * log_a)) * (ig * xcv);
        h = av * h + gx;
        lru_out[row * DLRU + ch] = h * gelu_tanh(y);
    }
}

__global__ void k_cum(const float* proj, const float* fb, float* cum) {
    const int b = blockIdx.x, h = threadIdx.x;
    float c = 0.f;
    for (int t = 0; t < SEQ; ++t) { c += log_sigmoid(proj[((size_t)b * SEQ + t) * NPROJ + 2 * DLRU + 3 * DATT + h] + fb[h]); cum[((size_t)b * NH + h) * SEQ + t] = c; }
}
__global__ void __launch_bounds__(256) k_attn(const float* proj, const float* cum, float* attn_out) {
    __shared__ float Ks[64][64], Vs[64][64], Cs[64];
    const int qb = blockIdx.x, h = blockIdx.y, b = blockIdx.z, t = qb * 256 + threadIdx.x;
    const size_t rowq = (size_t)b * SEQ + t;
    float q[64], acc[64];
#pragma unroll
    for (int d = 0; d < 64; ++d) { q[d] = proj[rowq * NPROJ + 2 * DLRU + h * 64 + d] * 0.125f; acc[d] = 0.f; }
    const float ct = cum[((size_t)b * NH + h) * SEQ + t];
    float m = -INFINITY, l = 0.f;
    const int send = qb * 256 + 256;
    for (int s0 = 0; s0 < send; s0 += 64) {
        __syncthreads();
        for (int i = threadIdx.x; i < 64 * 64; i += 256) { const int r = i >> 6, d = i & 63; const size_t rk = (size_t)b * SEQ + s0 + r;
            Ks[r][d] = proj[rk * NPROJ + 2 * DLRU + DATT + h * 64 + d]; Vs[r][d] = proj[rk * NPROJ + 2 * DLRU + 2 * DATT + h * 64 + d]; }
        if (threadIdx.x < 64) Cs[threadIdx.x] = cum[((size_t)b * NH + h) * SEQ + s0 + threadIdx.x];
        __syncthreads();
        for (int r = 0; r < 64; ++r) {
            const int s = s0 + r; if (s > t) break;
            float dot = 0.f;
#pragma unroll
            for (int d = 0; d < 64; ++d) dot += q[d] * Ks[r][d];
            const float lg = dot + ct - Cs[r];
            const float mn = fmaxf(m, lg), sc = expf(m - mn), p = expf(lg - mn);
            l = l * sc + p;
#pragma unroll
            for (int d = 0; d < 64; ++d) acc[d] = acc[d] * sc + p * Vs[r][d];
            m = mn;
        }
    }
    const float li = 1.f / l;
#pragma unroll
    for (int d = 0; d < 64; ++d) attn_out[rowq * DATT + h * 64 + d] = acc[d] * li;
}

__global__ void k_merge(const float* lru_out, const float* attn_out, const float* gn_lru, const float* gn_attn, float* merged) {
    __shared__ float red[4];
    const int row = blockIdx.x, tid = threadIdx.x;
    const float a0 = lru_out[(size_t)row * DLRU + tid], a1 = lru_out[(size_t)row * DLRU + 256 + tid];
    const float b0 = attn_out[(size_t)row * DATT + tid], b1 = attn_out[(size_t)row * DATT + 256 + tid];
    const float sa = block_sum_256(a0 * a0 + a1 * a1, red);
    const float sb = block_sum_256(b0 * b0 + b1 * b1, red);
    const float ra = rsqrtf(sa / DLRU + RMS_EPS), rb = rsqrtf(sb / DATT + RMS_EPS);
    float* o = merged + (size_t)row * DM;
    o[tid] = a0 * ra * gn_lru[tid]; o[256 + tid] = a1 * ra * gn_lru[256 + tid];
    o[512 + tid] = b0 * rb * gn_attn[tid]; o[768 + tid] = b1 * rb * gn_attn[256 + tid];
}

__global__ void k_resid(const float* xin, const float* y, const float* gpost, const float* mod, int gate_off, float* xo) {
    __shared__ float red[4];
    const int row = blockIdx.x, b = row / SEQ;
    float v[4], s = 0.f;
#pragma unroll
    for (int i = 0; i < 4; ++i) { v[i] = y[(size_t)row * DM + threadIdx.x + 256 * i]; s += v[i] * v[i]; }
    const float rinv = rsqrtf(block_sum_256(s, red) / DM + RMS_EPS);
#pragma unroll
    for (int i = 0; i < 4; ++i) { const int k = threadIdx.x + 256 * i;
        xo[(size_t)row * DM + k] = xin[(size_t)row * DM + k] + mod[b * NMOD * DM + gate_off + k] * (v[i] * rinv * gpost[k]); }
}

__global__ void k_route(const float* logits, int* cnt, int* list_tok, int* list_pair, float* pair_w) {
    const int tok = blockIdx.x * 256 + threadIdx.x;
    float lg[NE];
#pragma unroll
    for (int e = 0; e < NE; ++e) lg[e] = logits[(size_t)tok * NE + e];
    int idx[TOPK]; float val[TOPK];
#pragma unroll
    for (int k = 0; k < TOPK; ++k) { int bi = 0; float bv = -INFINITY;
#pragma unroll
        for (int e = 0; e < NE; ++e) { if (lg[e] > bv) { bv = lg[e]; bi = e; } }
        idx[k] = bi; val[k] = bv;
#pragma unroll
        for (int e = 0; e < NE; ++e) if (e == bi) lg[e] = -INFINITY; }
    float den = 0.f; float p[TOPK];
#pragma unroll
    for (int k = 0; k < TOPK; ++k) { p[k] = expf(val[k] - val[0]); den += p[k]; }
#pragma unroll
    for (int k = 0; k < TOPK; ++k) { const int e = idx[k]; const int pos = atomicAdd(&cnt[e], 1);
        list_tok[(size_t)e * NTOK + pos] = tok; list_pair[(size_t)e * NTOK + pos] = tok * TOPK + k; pair_w[tok * TOPK + k] = p[k] / den; }
}
__global__ void k_act(const float* gu, const int* cnt, float* act) {
    const int e = blockIdx.z, pos = blockIdx.y; if (pos >= cnt[e]) return;
    const size_t r = (size_t)e * NTOK + pos;
    for (int j = threadIdx.x; j < DEXP; j += 256) { const float gl = fminf(gu[r * 2 * DEXP + j], 7.f); const float li = fminf(fmaxf(gu[r * 2 * DEXP + DEXP + j], -7.f), 7.f);
        act[r * DEXP + j] = gl * sigmoidf_(1.702f * gl) * (li + 1.f); }
}
__global__ void k_scatter(const float* dn, const int* cnt, const int* list_pair, float* ypair) {
    const int e = blockIdx.z, pos = blockIdx.y; if (pos >= cnt[e]) return;
    const size_t r = (size_t)e * NTOK + pos; const int pair = list_pair[r];
    for (int j = threadIdx.x; j < DM; j += 256) ypair[(size_t)pair * DM + j] = dn[r * DM + j];
}
__global__ void k_combine(const float* ypair, const float* pair_w, float* y) {
    const int tok = blockIdx.x;
    for (int j = threadIdx.x; j < DM; j += 256) { float s = 0.f; for (int k = 0; k < TOPK; ++k) s += pair_w[tok * TOPK + k] * ypair[((size_t)tok * TOPK + k) * DM + j]; y[(size_t)tok * DM + j] = s; }
}


__global__ void k_conv_proj(const float* proj, const float* fb, unsigned short* PJ, float* LOGF2) {
    const int row = blockIdx.x;
    for (int c = threadIdx.x; c < 2560; c += 256) { const int t = c >> 9, cc = c & 511; float v = proj[(size_t)row * NPROJ + c]; if (t == 2) v *= attn_body::C2; PJ[(size_t)t * PJ_STRIDE + (size_t)row * 512 + cc] = (unsigned short)f2bf(v); }
    if (threadIdx.x < 8) LOGF2[(size_t)row * 8 + threadIdx.x] = log_sigmoid(proj[(size_t)row * NPROJ + 2560 + threadIdx.x] + fb[threadIdx.x]) * 1.4426950408889634f;
}
__global__ void k_conv_mix(const float* lru_out, const float* attn_out, const float* gn_lru, unsigned short* MRG, float* SSQ) {
    __shared__ float red[4];
    const int row = blockIdx.x, tid = threadIdx.x;
    const float a0 = lru_out[(size_t)row * DLRU + tid], a1 = lru_out[(size_t)row * DLRU + 256 + tid];
    const float ra = rsqrtf(block_sum_256(a0 * a0 + a1 * a1, red) / DLRU + RMS_EPS);
    MRG[(size_t)row * 1024 + 512 + tid] = (unsigned short)f2bf(a0 * ra * gn_lru[tid]); MRG[(size_t)row * 1024 + 768 + tid] = (unsigned short)f2bf(a1 * ra * gn_lru[256 + tid]);
    for (int i = 0; i < 2; ++i) { const int c = tid + 256 * i; const unsigned short hb = (unsigned short)f2bf(attn_out[(size_t)row * DATT + c]); MRG[(size_t)row * 1024 + c] = hb;
        float q = bf1(hb); q = q * q; for (int o = 1; o < 64; o <<= 1) q += __shfl_xor(q, o); if ((tid & 63) == 0) SSQ[(size_t)row * 8 + (c >> 6)] = q; }
}
static void sgemm(hipStream_t st, const float* A, const float* B, float* C, const float* bias, int M, int N, int K, int lda, int ldb, int ldc) {
    GemmArgs a{}; a.A = A; a.B = B; a.C = C; a.bias = bias; a.M = M; a.N = N; a.K = K; a.lda = lda; a.ldb = ldb; a.ldc = ldc;
    hipLaunchKernelGGL(k_sgemm, dim3((N + 127) / 128, (M + 127) / 128, 1), dim3(256), 0, st, a);
}
}
#endif

extern "C" void kernel_launch(void* const* d_in, const int* in_sizes, int n_in, void* d_out, int out_size, void* d_ws, size_t ws_size, hipStream_t stream) {
    static int grid = 0;
    if (grid == 0) {
        int dev = 0, cus = 0;
        if (n_in != 26 || out_size != NTOK * DM || ws_size < WS_END) { fprintf(stderr, "kernel_launch: unexpected problem shape / workspace (%d inputs, out %d, ws %zu)\n", n_in, out_size, ws_size); grid = -1; return; }
        if (hipGetDevice(&dev) != hipSuccess || hipDeviceGetAttribute(&cus, hipDeviceAttributeMultiprocessorCount, dev) != hipSuccess) { grid = -1; return; }
        if (hipFuncSetAttribute((const void*)mega_fwd, hipFuncAttributeMaxDynamicSharedMemorySize, LDS_BYTES) != hipSuccess) { fprintf(stderr, "kernel_launch: hipFuncSetAttribute failed\n"); grid = -1; return; }
        grid = cus;
        if (grid != 256) fprintf(stderr, "kernel_launch: %d CUs; this kernel is laid out for 256\n", grid);
    }
    if (grid < 0) return;
    (void)hipMemsetAsync((char*)d_ws + WS_CTL, 0, CTL_ZERO_BYTES, stream);
#if MIX >= 4
    launch_mega(stream, d_in, d_out, d_ws, 0, NPHASES, 0, grid);
#ifdef EXTRA_LO
    launch_mega(stream, d_in, d_out, d_ws, EXTRA_LO, EXTRA_HI, 1, grid);
#endif
#else
    using namespace simple;
    const float* x = (const float*)d_in[0]; const float* c = (const float*)d_in[1]; const float* w_ada = (const float*)d_in[2]; const float* b_ada = (const float*)d_in[3];
    const float* g_mix_pre = (const float*)d_in[4]; const float* w_in = (const float*)d_in[6];
    const float* conv_w = (const float*)d_in[7]; const float* conv_b = (const float*)d_in[8]; const float* wa = (const float*)d_in[9]; const float* ba = (const float*)d_in[10];
    const float* wx = (const float*)d_in[11]; const float* bx = (const float*)d_in[12]; const float* lam = (const float*)d_in[13]; const float* fb = (const float*)d_in[14];
    const float* gn_lru = (const float*)d_in[15]; const float* gn_attn = (const float*)d_in[16]; const float* w_out = (const float*)d_in[17];
    char* ws = (char*)d_ws;
    float* mod_s = (float*)(ws + 7 * MiB + 512 * KiB);
    float* h1 = (float*)(ws + 416 * MiB); float* proj = (float*)(ws + 480 * MiB); float* lru_out = (float*)(ws + 641 * MiB); float* attn_out = (float*)(ws + 673 * MiB); float* cum = (float*)(ws + 705 * MiB);
    float* merged = h1; float* Yb = (float*)(ws + WS_Y);
    launch_mega(stream, d_in, d_out, d_ws, 0, 1, 0, grid);
    hipLaunchKernelGGL(k_ada, dim3(NMOD * DM / 256, BATCH), dim3(256), 0, stream, c, w_ada, b_ada, mod_s);
    hipLaunchKernelGGL(k_prep, dim3(NTOK), dim3(256), 0, stream, x, g_mix_pre, mod_s, 0 * DM, 1 * DM, h1);
    sgemm(stream, h1, w_in, proj, nullptr, NTOK, NPROJ, DM, DM, NPROJ, NPROJ);
#if MIX <= 2
    hipLaunchKernelGGL(k_lru, dim3(BATCH * 8), dim3(64), 0, stream, proj, conv_w, conv_b, wa, ba, wx, bx, lam, lru_out);
    hipLaunchKernelGGL(k_cum, dim3(BATCH), dim3(NH), 0, stream, proj, fb, cum);
    hipLaunchKernelGGL(k_attn, dim3(SEQ / 256, NH, BATCH), dim3(256), 0, stream, proj, cum, attn_out);
#endif
#if MIX == 1
    hipLaunchKernelGGL(k_merge, dim3(NTOK), dim3(256), 0, stream, lru_out, attn_out, gn_lru, gn_attn, merged);
    sgemm(stream, merged, w_out, Yb, nullptr, NTOK, DM, DM, DM, DM, DM);
    launch_mega(stream, d_in, d_out, d_ws, 6, NPHASES, 1, grid);
#elif MIX == 2
    hipLaunchKernelGGL(k_conv_mix, dim3(NTOK), dim3(256), 0, stream, lru_out, attn_out, gn_lru, (unsigned short*)(ws + WS_MRG), (float*)(ws + WS_SSQ));
    launch_mega(stream, d_in, d_out, d_ws, 5, NPHASES, 1, grid);
#elif MIX == 3
    hipLaunchKernelGGL(k_conv_proj, dim3(NTOK), dim3(256), 0, stream, proj, fb, (unsigned short*)(ws + WS_PJ), (float*)(ws + WS_LOGF2));
    launch_mega(stream, d_in, d_out, d_ws, 3, NPHASES, 1, grid);
#endif
    (void)gn_attn; (void)w_out; (void)cum; (void)lru_out; (void)attn_out; (void)merged; (void)Yb;
#endif
}
```

```cpp
#include <hip/hip_runtime.h>
#include <hip/hip_bf16.h>
#include <cstdio>
#include <cstdint>
#include <cmath>

#define MIX 4

constexpr int DM = 1024, BATCH = 8, SEQ = 2048, NTOK = BATCH * SEQ;
constexpr int DLRU = 512, DATT = 512, NH = 8, HD = 64, NPROJ = 2 * DLRU + 3 * DATT + NH, NPJ = 2560;
constexpr int NE = 32, TOPK = 4, DEXP = 1024, NMOD = 6;
constexpr float RMS_EPS = 1e-6f;
constexpr int MAXROWS = NTOK * TOPK + NE * 256;
constexpr int MAXMT = MAXROWS / 256;

namespace pg8 {
#define PG8_LAS __attribute__((address_space(3)))
typedef unsigned short bf16_t;
typedef short bf16x8 __attribute__((ext_vector_type(8)));
typedef float f32x4 __attribute__((ext_vector_type(4)));
typedef float f32x2 __attribute__((ext_vector_type(2)));
typedef unsigned u32x4 __attribute__((ext_vector_type(4)));
constexpr int BM = 256, BK = 64, HALF = 128, HTB = HALF * BK * 2  , STAGE_BYTES = 8 * HTB, NXCD = 8, WGM = 8;
constexpr int GK = 1024, GNT = GK / BK;
typedef int i32x8 __attribute__((ext_vector_type(8)));
typedef int i32x4 __attribute__((ext_vector_type(4)));
constexpr int F8_SCALE_W = 0x79797979, F8_SCALE_A = 0x7f7f7f7f;

__host__ __device__ __forceinline__ int lds_byte(int r, int c) { const int st = (r >> 4) * 2 + (c >> 5), rr = r & 15, cc = c & 31, ob = rr * 64 + cc * 2; return st * 1024 + (ob ^ (((ob >> 9) & 1) << 5)); }
__host__ __device__ __forceinline__ void stage_rc(int b, int& R, int& C) { const int st = b / 1024, sb = b % 1024, swz = sb ^ (((sb >> 9) & 1) << 5); R = (st >> 1) * 16 + swz / 64; C = (st & 1) * 32 + (swz % 64) / 2; }
__host__ __device__ __forceinline__ int perm32(int rho) { const int n = rho >> 4, i = rho & 15; return 8 * (i >> 2) + 4 * n + (i & 3); }

struct Unit { const char* A0; const char* A1; const char* B0; const char* B1; int pm, pn, e; };

__device__ __forceinline__ void mfma_f8_acc(f32x4& acc, const i32x8& b, const i32x8& a, int sw, int sa) {
    asm volatile("v_mfma_scale_f32_16x16x128_f8f6f4 %0, %1, %2, %0, %3, %4 op_sel_hi:[0,0,0]" : "+v"(acc) : "v"(b), "v"(a), "v"(sw), "v"(sa)); }
__device__ __forceinline__ unsigned cvt_pk_bf16(float lo, float hi) { unsigned r; asm volatile("v_cvt_pk_bf16_f32 %0, %1, %2" : "=v"(r) : "v"(lo), "v"(hi)); return r; }

template <class Epi, class Sched, bool F8 = false, int KREP = 1>
__device__ __forceinline__ void gemm_phase(PG8_LAS unsigned char* lds, const Sched& S, const Epi& E) {
    const int tid = threadIdx.x, wid = __builtin_amdgcn_readfirstlane(tid >> 6), lane = tid & 63, wr = wid >> 2, wc = wid & 3, fr = lane & 15, fq = lane >> 4;
    constexpr int KB = F8 ? GK : GK * 2, nt1 = F8 ? GK / 128 : GNT, nt = nt1 * KREP;
    int Rr[2], Cc[2];
    unsigned voffB[2], cvA[2][2], nvA[2][2];
#pragma unroll
    for (int i = 0; i < 2; ++i) { stage_rc(tid * 16 + i * 8192, Rr[i], Cc[i]); const int Rb = Epi::PERM ? ((Rr[i] & ~31) + perm32(Rr[i] & 31)) : Rr[i]; voffB[i] = (unsigned)(Rb * KB + Cc[i] * 2); }
    constexpr size_t kstep = (size_t)(BK * 2);
    const unsigned ldsw = (unsigned)wid * 1024u;
    const int aoff = lds_byte(wr * 64 + fr, fq * 8), boff = lds_byte(wc * 32 + fr, fq * 8);
#define PG8_SA(b, h) (((b) * 2 + (h)) * HTB)
#define PG8_SB(b, h) ((4 + (b) * 2 + (h)) * HTB)
#define PG8_STAGE(bufoff, gbase, voff) do { _Pragma("unroll") for (int _i = 0; _i < 2; ++_i) \
        __builtin_amdgcn_global_load_lds((const unsigned*)((const char*)(gbase) + (voff)[_i]), (PG8_LAS unsigned*)(lds + (bufoff) + ldsw + _i * 8192), 16, 0, 0); } while (0)
#define PG8_LD8(p) __builtin_shufflevector(*(const PG8_LAS i32x4*)(p), *(const PG8_LAS i32x4*)((p) + 1024), 0, 1, 2, 3, 4, 5, 6, 7)
#define PG8_LDA(dst, b, h) do { _Pragma("unroll") for (int m = 0; m < 4; ++m) { if constexpr (F8) { dst##8[m] = PG8_LD8(lds + PG8_SA(b, h) + aoff + m * 2048); } \
        else { _Pragma("unroll") for (int k = 0; k < 2; ++k) dst[m][k] = *(const PG8_LAS bf16x8*)(lds + PG8_SA(b, h) + aoff + m * 2048 + k * 1024); } } } while (0)
#define PG8_LDB(dst, b, h) do { _Pragma("unroll") for (int n = 0; n < 2; ++n) { if constexpr (F8) { dst##8[n] = PG8_LD8(lds + PG8_SB(b, h) + boff + n * 2048); } \
        else { _Pragma("unroll") for (int k = 0; k < 2; ++k) dst[n][k] = *(const PG8_LAS bf16x8*)(lds + PG8_SB(b, h) + boff + n * 2048 + k * 1024); } } } while (0)
#define PG8_MMA(ai, bj, At, Bt) do { __builtin_amdgcn_s_setprio(1); _Pragma("unroll") for (int m = 0; m < 4; ++m) _Pragma("unroll") for (int n = 0; n < 2; ++n) { \
        if constexpr (F8) { mfma_f8_acc(acc[ai][bj][m][n], Bt##8[n], At##8[m], scw, sca); } \
        else { _Pragma("unroll") for (int k = 0; k < 2; ++k) acc[ai][bj][m][n] = __builtin_amdgcn_mfma_f32_16x16x32_bf16(Bt[n][k], At[m][k], acc[ai][bj][m][n], 0, 0, 0); } } \
        __builtin_amdgcn_s_setprio(0); } while (0)
#define PG8_WAIT_V(n) asm volatile("s_waitcnt vmcnt(" #n ")" ::: "memory")
#define PG8_WAIT_L(n) asm volatile("s_waitcnt lgkmcnt(" #n ")" ::: "memory")
#define PG8_BAR __builtin_amdgcn_s_barrier()
#define PG8_SCHED __builtin_amdgcn_sched_barrier(0)
#define PG8_VOFF(dst, u) do { _Pragma("unroll") for (int _h = 0; _h < 2; ++_h) _Pragma("unroll") for (int _i = 0; _i < 2; ++_i) { \
        const int _row = Sched::GATHER ? S.row_of(u, _h * HALF + Rr[_i]) : Rr[_i]; dst[_h][_i] = (unsigned)(_row * KB + Cc[_i] * 2); } } while (0)
    Unit cur, nxt; int ui = 0;
    if (!S.next(0, cur)) return;
    f32x4 acc[2][2][4][2];
#pragma unroll
    for (int a = 0; a < 2; ++a)
#pragma unroll
        for (int b = 0; b < 2; ++b)
#pragma unroll
            for (int m = 0; m < 4; ++m)
#pragma unroll
                for (int n = 0; n < 2; ++n) acc[a][b][m][n] = (f32x4){0.f, 0.f, 0.f, 0.f};
    const int scw = F8_SCALE_W, sca = F8_SCALE_A;
    bf16x8 At[4][2], B0[2][2], B1[2][2]; i32x8 At8[4], B08[2], B18[2];
    PG8_VOFF(cvA, cur);
    if (Sched::GATHER) { asm volatile("s_waitcnt vmcnt(0)" ::: "memory"); }
    PG8_STAGE(PG8_SB(0, 0), cur.B0, voffB); PG8_STAGE(PG8_SB(0, 1), cur.B1, voffB); PG8_STAGE(PG8_SA(0, 0), cur.A0, cvA[0]); PG8_STAGE(PG8_SA(0, 1), cur.A1, cvA[1]);
    if (wr == 1) PG8_BAR;
    PG8_WAIT_V(2); PG8_BAR;
    PG8_STAGE(PG8_SB(1, 0), cur.B0 + kstep, voffB); PG8_STAGE(PG8_SA(1, 0), cur.A0 + kstep, cvA[0]); PG8_STAGE(PG8_SB(1, 1), cur.B1 + kstep, voffB);
    PG8_WAIT_V(6); PG8_BAR;
    for (;;) {
        const bool has_next = S.next(ui + 1, nxt);
        if (!has_next) nxt = cur;
        int nraw[2][2];
        if (Sched::GATHER && has_next) {
#pragma unroll
            for (int _h = 0; _h < 2; ++_h)
#pragma unroll
                for (int _i = 0; _i < 2; ++_i) { const int* p_ = S.row_ptr(nxt, _h * HALF + Rr[_i]); asm volatile("global_load_dword %0, %1, off" : "=v"(nraw[_h][_i]) : "v"(p_) : "memory"); }
        }
        if (has_next) { if (!Sched::GATHER) { PG8_VOFF(nvA, nxt); } }
        else {
#pragma unroll
            for (int _h = 0; _h < 2; ++_h)
#pragma unroll
                for (int _i = 0; _i < 2; ++_i) nvA[_h][_i] = cvA[_h][_i]; }
#pragma unroll 1
        for (int t = 0; t < nt; t += 2) {
            const bool last = (t == nt - 2);
            if (Epi::MID && t == nt / 2) E.mid(acc, cur, wr, wc, fr, fq);
            const char* a1_1 = cur.A1 + (size_t)((t + 1) % nt1) * kstep;
            const char* a2_0 = last ? nxt.A0 : cur.A0 + (size_t)((t + 2) % nt1) * kstep; const char* a2_1 = last ? nxt.A1 : cur.A1 + (size_t)((t + 2) % nt1) * kstep;
            const char* b2_0 = last ? nxt.B0 : cur.B0 + (size_t)((t + 2) % nt1) * kstep; const char* b2_1 = last ? nxt.B1 : cur.B1 + (size_t)((t + 2) % nt1) * kstep;
            const char* a3_0 = a2_0 + kstep; const char* a3_1 = a2_1 + kstep; const char* b3_0 = b2_0 + kstep; const char* b3_1 = b2_1 + kstep;
            if (Sched::GATHER && last && has_next) {
#pragma unroll
                for (int _h = 0; _h < 2; ++_h)
#pragma unroll
                    for (int _i = 0; _i < 2; ++_i) { int r_ = nraw[_h][_i]; asm volatile("" : "+v"(r_));
                        nvA[_h][_i] = (unsigned)(r_ * KB + Cc[_i] * 2); } }
            unsigned sv0[2], sv1[2];
#pragma unroll
            for (int _i = 0; _i < 2; ++_i) { sv0[_i] = last ? nvA[0][_i] : cvA[0][_i]; sv1[_i] = last ? nvA[1][_i] : cvA[1][_i]; }
            PG8_LDB(B0, 0, 0); PG8_LDB(B1, 0, 1); PG8_SCHED; PG8_LDA(At, 0, 0); PG8_STAGE(PG8_SA(1, 1), a1_1, cvA[1]);
            PG8_WAIT_V(8); PG8_WAIT_L(0); PG8_BAR; PG8_MMA(0, 0, At, B0); PG8_MMA(0, 1, At, B1); PG8_BAR; PG8_SCHED;
            PG8_LDA(At, 0, 1); PG8_STAGE(PG8_SB(0, 0), b2_0, voffB); PG8_STAGE(PG8_SB(0, 1), b2_1, voffB); PG8_STAGE(PG8_SA(0, 0), a2_0, sv0);
            PG8_WAIT_V(8); PG8_WAIT_L(0); PG8_BAR; PG8_MMA(1, 0, At, B0); PG8_MMA(1, 1, At, B1); PG8_BAR; PG8_SCHED;
            PG8_LDB(B0, 1, 0); PG8_LDB(B1, 1, 1); PG8_SCHED; PG8_LDA(At, 1, 0); PG8_STAGE(PG8_SA(0, 1), a2_1, sv1);
            PG8_WAIT_V(8); PG8_WAIT_L(0); PG8_BAR; PG8_MMA(0, 0, At, B0); PG8_MMA(0, 1, At, B1); PG8_BAR; PG8_SCHED;
            PG8_LDA(At, 1, 1); PG8_STAGE(PG8_SB(1, 0), b3_0, voffB); PG8_STAGE(PG8_SB(1, 1), b3_1, voffB); PG8_STAGE(PG8_SA(1, 0), a3_0, sv0);
            PG8_WAIT_V(8); PG8_WAIT_L(0); PG8_BAR; PG8_MMA(1, 0, At, B0); PG8_MMA(1, 1, At, B1); PG8_BAR; PG8_SCHED;
            (void)a3_1; (void)b3_1;
        }
        if (wr == 0) PG8_BAR;
        if constexpr (F8) { asm volatile("s_nop 15\n\ts_nop 15\n\ts_nop 7" ::: "memory"); }
        E(acc, cur, wr, wc, fr, fq);
        if (!has_next) break;
#pragma unroll
        for (int a = 0; a < 2; ++a)
#pragma unroll
            for (int b = 0; b < 2; ++b)
#pragma unroll
                for (int m = 0; m < 4; ++m)
#pragma unroll
                    for (int n = 0; n < 2; ++n) acc[a][b][m][n] = (f32x4){0.f, 0.f, 0.f, 0.f};
        cur = nxt; ++ui;
#pragma unroll
        for (int _h = 0; _h < 2; ++_h)
#pragma unroll
            for (int _i = 0; _i < 2; ++_i) cvA[_h][_i] = nvA[_h][_i];
        if (wr == 1) PG8_BAR;
    }
    PG8_WAIT_V(0);
    PG8_BAR;
#undef PG8_SA
#undef PG8_SB
#undef PG8_STAGE
#undef PG8_LDA
#undef PG8_LDB
#undef PG8_MMA
#undef PG8_LD8
#undef PG8_WAIT_V
#undef PG8_WAIT_L
#undef PG8_BAR
#undef PG8_SCHED
#undef PG8_VOFF
}
}

namespace pg8 {

struct DenseOrder {
    static constexpr bool GATHER = false;
    const bf16_t* A; const bf16_t* Bt; int nM, nN, nwg, G, c;
    __device__ __forceinline__ void init(const bf16_t* A_, const bf16_t* Bt_, int M, int N, int G_, int c_) { A = A_; Bt = Bt_; nM = M / BM; nN = N / BM; nwg = nM * nN; G = G_; c = c_; }
    __device__ __forceinline__ bool next(int i, Unit& u) const {
        const long L = (long)i * G + c; if (L >= nwg) return false;
        int wgid = (int)L; { const int q = nwg / NXCD, r = nwg % NXCD, xcd = wgid % NXCD, off = wgid / NXCD; wgid = (xcd < r ? xcd * (q + 1) : r * (q + 1) + (xcd - r) * q) + off; }
        const int nig = WGM * nN, gid = wgid / nig, fm = gid * WGM, gsz = (nM - fm) < WGM ? (nM - fm) : WGM;
        u.pm = fm + ((wgid % nig) % gsz); u.pn = (wgid % nig) / gsz; u.e = 0;
        u.A0 = (const char*)A + (size_t)u.pm * BM * GK * 2; u.A1 = u.A0 + (size_t)HALF * GK * 2;
        u.B0 = (const char*)Bt + (size_t)u.pn * BM * GK * 2; u.B1 = u.B0 + (size_t)HALF * GK * 2;
        return true;
    }
    __device__ __forceinline__ int row_of(const Unit&, int r) const { return r; }
    __device__ __forceinline__ const int* row_ptr(const Unit&, int) const { return nullptr; }
};
struct UpOrder {
    static constexpr bool GATHER = true;
    const unsigned char* H2; const unsigned char* WupT; const int* row_tok; const int* mt_exp; int nunits, G, c;
    __device__ __forceinline__ bool next(int i, Unit& u) const {
        const int L = i * G + c; if (L >= nunits) return false;
        u.pm = L >> 3; u.pn = L & 7; u.e = mt_exp[u.pm];
        u.A0 = (const char*)H2; u.A1 = (const char*)H2;
        u.B0 = (const char*)WupT + ((size_t)u.e * 2 * DEXP + (size_t)u.pn * HALF) * GK; u.B1 = u.B0 + (size_t)DEXP * GK;
        return true;
    }
    __device__ __forceinline__ int row_of(const Unit& u, int r) const { return row_tok[u.pm * BM + r]; }
    __device__ __forceinline__ const int* row_ptr(const Unit& u, int r) const { return row_tok + u.pm * BM + r; }
};
struct DownOrder {
    static constexpr bool GATHER = false;
    const unsigned char* ACT; const unsigned char* WdnT; const int* mt_exp; int nunits, G, c;
    __device__ __forceinline__ bool next(int i, Unit& u) const {
        const int L = i * G + c; if (L >= nunits) return false;
        u.pm = L >> 2; u.pn = L & 3; u.e = mt_exp[u.pm];
        u.A0 = (const char*)ACT + (size_t)u.pm * BM * GK; u.A1 = u.A0 + (size_t)HALF * GK;
        u.B0 = (const char*)WdnT + ((size_t)u.e * DM + (size_t)u.pn * BM) * GK; u.B1 = u.B0 + (size_t)HALF * GK;
        return true;
    }
    __device__ __forceinline__ int row_of(const Unit&, int r) const { return r; }
    __device__ __forceinline__ const int* row_ptr(const Unit&, int) const { return nullptr; }
};

struct EpiProj {
    static constexpr bool PERM = true, MID = false;
    bf16_t* O; size_t tstride; float qscale;
    __device__ __forceinline__ void mid(f32x4 (&)[2][2][4][2], const Unit&, int, int, int, int) const {}
    __device__ __forceinline__ void operator()(const f32x4 (&acc)[2][2][4][2], const Unit& u, int wr, int wc, int fr, int fq) const {
        const int t = u.pn >> 1; bf16_t* base = O + (size_t)t * tstride; const float sc = (t == 2) ? qscale : 1.f;
        const int row0 = u.pm * BM + wr * 64 + fr, col0 = (u.pn & 1) * BM + wc * 32 + 8 * fq;
#pragma unroll
        for (int ai = 0; ai < 2; ++ai)
#pragma unroll
            for (int m = 0; m < 4; ++m) { bf16_t* rowp = base + (size_t)(row0 + ai * HALF + m * 16) * 512 + col0;
#pragma unroll
                for (int bj = 0; bj < 2; ++bj) { const f32x4 v0 = acc[ai][bj][m][0] * sc, v1 = acc[ai][bj][m][1] * sc;
                    u32x4 w; w.x = cvt_pk_bf16(v0[0], v0[1]); w.y = cvt_pk_bf16(v0[2], v0[3]); w.z = cvt_pk_bf16(v1[0], v1[1]); w.w = cvt_pk_bf16(v1[2], v1[3]);
                    *(u32x4*)(rowp + bj * HALF) = w; } }
    }
};
struct EpiOut {
    static constexpr bool PERM = true, MID = true;
    bf16_t* Y; const float* ssq;
    __device__ __forceinline__ void mid(f32x4 (&acc)[2][2][4][2], const Unit& u, int wr, int wc, int fr, int fq) const {
#pragma unroll
        for (int ai = 0; ai < 2; ++ai)
#pragma unroll
            for (int m = 0; m < 4; ++m) { const int row = u.pm * BM + ai * HALF + wr * 64 + m * 16 + fr;
                const f32x4 s0 = *(const f32x4*)(ssq + (size_t)row * 8), s1 = *(const f32x4*)(ssq + (size_t)row * 8 + 4);
                const float tot = ((s0[0] + s0[1]) + (s0[2] + s0[3])) + ((s1[0] + s1[1]) + (s1[2] + s1[3]));
                const float ri = 1.0f / sqrtf(tot * (1.0f / DATT) + RMS_EPS);
#pragma unroll
                for (int bj = 0; bj < 2; ++bj)
#pragma unroll
                    for (int n = 0; n < 2; ++n) acc[ai][bj][m][n] = acc[ai][bj][m][n] * ri; }
    }
    __device__ __forceinline__ void operator()(const f32x4 (&acc)[2][2][4][2], const Unit& u, int wr, int wc, int fr, int fq) const {
        const int row0 = u.pm * BM + wr * 64 + fr, col0 = u.pn * BM + wc * 32 + 8 * fq;
#pragma unroll
        for (int ai = 0; ai < 2; ++ai)
#pragma unroll
            for (int m = 0; m < 4; ++m) { bf16_t* rowp = Y + (size_t)(row0 + ai * HALF + m * 16) * DM + col0;
#pragma unroll
                for (int bj = 0; bj < 2; ++bj) { const f32x4 v0 = acc[ai][bj][m][0], v1 = acc[ai][bj][m][1];
                    u32x4 w; w.x = cvt_pk_bf16(v0[0], v0[1]); w.y = cvt_pk_bf16(v0[2], v0[3]); w.z = cvt_pk_bf16(v1[0], v1[1]); w.w = cvt_pk_bf16(v1[2], v1[3]);
                    *(u32x4*)(rowp + bj * HALF) = w; } }
    }
};
struct EpiUp {
    static constexpr bool PERM = true, MID = false;
    unsigned char* ACT; const float* b_up;
    __device__ __forceinline__ void mid(f32x4 (&)[2][2][4][2], const Unit&, int, int, int, int) const {}
    __device__ __forceinline__ void operator()(const f32x4 (&acc)[2][2][4][2], const Unit& u, int wr, int wc, int fr, int fq) const {
        const int row0 = u.pm * BM + wr * 64 + fr, col0 = u.pn * HALF + wc * 32 + 8 * fq;
        const float* bg = b_up + (size_t)u.e * 2 * DEXP + col0;
        f32x4 bgl[2], bli[2];
#pragma unroll
        for (int n = 0; n < 2; ++n) { bgl[n] = *(const f32x4*)(bg + 4 * n); bli[n] = *(const f32x4*)(bg + DEXP + 4 * n); }
#pragma unroll
        for (int ai = 0; ai < 2; ++ai)
#pragma unroll
            for (int m = 0; m < 4; ++m) { unsigned char* rowp = ACT + (size_t)(row0 + ai * HALF + m * 16) * DEXP + col0;
                float o[8];
#pragma unroll
                for (int n = 0; n < 2; ++n)
#pragma unroll
                    for (int j = 0; j < 4; ++j) { const float gl = fminf(acc[ai][0][m][n][j] + bgl[n][j], 7.0f); const float li = fminf(fmaxf(acc[ai][1][m][n][j] + bli[n][j], -7.0f), 7.0f);
                        const float sg = __builtin_amdgcn_rcpf(1.0f + __builtin_amdgcn_exp2f(-1.702f * 1.4426950408889634f * gl)); o[4 * n + j] = gl * sg * (li + 1.0f); }
                int w0 = 0, w1 = 0; w0 = __builtin_amdgcn_cvt_pk_fp8_f32(o[0], o[1], w0, false); w0 = __builtin_amdgcn_cvt_pk_fp8_f32(o[2], o[3], w0, true);
                w1 = __builtin_amdgcn_cvt_pk_fp8_f32(o[4], o[5], w1, false); w1 = __builtin_amdgcn_cvt_pk_fp8_f32(o[6], o[7], w1, true);
                typedef int i32x2_ __attribute__((ext_vector_type(2))); *(i32x2_*)rowp = (i32x2_){w0, w1}; }
    }
};
struct EpiDown {
    static constexpr bool PERM = true, MID = false;
    unsigned char* YP; const float* b_down; const int* row_pair; const float* row_w;
    __device__ __forceinline__ void mid(f32x4 (&)[2][2][4][2], const Unit&, int, int, int, int) const {}
    __device__ __forceinline__ void operator()(const f32x4 (&acc)[2][2][4][2], const Unit& u, int wr, int wc, int fr, int fq) const {
        const int row0 = u.pm * BM + wr * 64 + fr, col0 = u.pn * BM + wc * 32 + 8 * fq;
        const float* bd = b_down + (size_t)u.e * DM + col0;
        f32x4 bv[2][2];
#pragma unroll
        for (int bj = 0; bj < 2; ++bj)
#pragma unroll
            for (int n = 0; n < 2; ++n) bv[bj][n] = *(const f32x4*)(bd + bj * HALF + 4 * n);
        int pr[2][4]; float wt[2][4];
#pragma unroll
        for (int ai = 0; ai < 2; ++ai)
#pragma unroll
            for (int m = 0; m < 4; ++m) { const int pos = row0 + ai * HALF + m * 16; pr[ai][m] = row_pair[pos]; wt[ai][m] = row_w[pos] * 4.0f; }
#pragma unroll
        for (int ai = 0; ai < 2; ++ai)
#pragma unroll
            for (int m = 0; m < 4; ++m) { const int pair = pr[ai][m]; const float w = wt[ai][m];
                if (pair >= 0) { unsigned char* rowp = YP + (size_t)pair * DM + col0;
#pragma unroll
                    for (int bj = 0; bj < 2; ++bj) { const f32x4 v0 = (acc[ai][bj][m][0] + bv[bj][0]) * w, v1 = (acc[ai][bj][m][1] + bv[bj][1]) * w;
                        int q0 = 0, q1 = 0; q0 = __builtin_amdgcn_cvt_pk_fp8_f32(v0[0], v0[1], q0, false); q0 = __builtin_amdgcn_cvt_pk_fp8_f32(v0[2], v0[3], q0, true);
                        q1 = __builtin_amdgcn_cvt_pk_fp8_f32(v1[0], v1[1], q1, false); q1 = __builtin_amdgcn_cvt_pk_fp8_f32(v1[2], v1[3], q1, true);
                        typedef int i32x2_ __attribute__((ext_vector_type(2))); *(i32x2_*)(rowp + bj * HALF) = (i32x2_){q0, q1}; } } }
    }
};
struct EpiProjNoStore {
    static constexpr bool PERM = true, MID = false;
    __device__ __forceinline__ void mid(f32x4 (&)[2][2][4][2], const Unit&, int, int, int, int) const {}
    __device__ __forceinline__ void operator()(const f32x4 (&acc)[2][2][4][2], const Unit& u, int wr, int wc, int fr, int fq) const {
#pragma unroll
        for (int ai = 0; ai < 2; ++ai)
#pragma unroll
            for (int m = 0; m < 4; ++m)
#pragma unroll
                for (int bj = 0; bj < 2; ++bj) { const f32x4 v0 = acc[ai][bj][m][0], v1 = acc[ai][bj][m][1];
                    u32x4 w; w.x = cvt_pk_bf16(v0[0], v0[1]); w.y = cvt_pk_bf16(v0[2], v0[3]); w.z = cvt_pk_bf16(v1[0], v1[1]); w.w = cvt_pk_bf16(v1[2], v1[3]);
                    asm volatile("" :: "v"(w)); }
    }
};
struct EpiDownDense {
    static constexpr bool PERM = true, MID = false;
    bf16_t* YP; const float* b_down;
    __device__ __forceinline__ void mid(f32x4 (&)[2][2][4][2], const Unit&, int, int, int, int) const {}
    __device__ __forceinline__ void operator()(const f32x4 (&acc)[2][2][4][2], const Unit& u, int wr, int wc, int fr, int fq) const {
        const int row0 = u.pm * BM + wr * 64 + fr, col0 = u.pn * BM + wc * 32 + 8 * fq;
        const float* bd = b_down + (size_t)u.e * DM + col0;
        f32x4 bv[2][2];
#pragma unroll
        for (int bj = 0; bj < 2; ++bj)
#pragma unroll
            for (int n = 0; n < 2; ++n) bv[bj][n] = *(const f32x4*)(bd + bj * HALF + 4 * n);
#pragma unroll
        for (int ai = 0; ai < 2; ++ai)
#pragma unroll
            for (int m = 0; m < 4; ++m) { bf16_t* rowp = YP + (size_t)(row0 + ai * HALF + m * 16) * DM + col0;
#pragma unroll
                for (int bj = 0; bj < 2; ++bj) { const f32x4 v0 = acc[ai][bj][m][0] + bv[bj][0], v1 = acc[ai][bj][m][1] + bv[bj][1];
                    u32x4 q; q.x = cvt_pk_bf16(v0[0], v0[1]); q.y = cvt_pk_bf16(v0[2], v0[3]); q.z = cvt_pk_bf16(v1[0], v1[1]); q.w = cvt_pk_bf16(v1[2], v1[3]);
                    *(u32x4*)(rowp + bj * HALF) = q; } }
    }
};
}

namespace attn_body {
using bf16=__hip_bfloat16;
using bf16x8=__attribute__((ext_vector_type(8)))short;
using s16x4=__attribute__((ext_vector_type(4)))short;
using f32x16=__attribute__((ext_vector_type(16)))float;
using u32x4=__attribute__((ext_vector_type(4)))unsigned;
constexpr int BATCH=8,NHEAD=8,SEQ=2048,D=64,DM=NHEAD*D,OPITCH=1024;
constexpr int NW=8,QBLK=32,QB=QBLK*NW,KVBLK=64,NQB=SEQ/QB;
constexpr int ATTN_PITCH=DM, ATTN_UNIT_ROWS=QB;
__device__ __forceinline__ int crow(int r,int hi){return (r&3)+8*(r>>2)+4*hi;}
#define SBAR() __builtin_amdgcn_sched_barrier(0)
__device__ __forceinline__ void cmask(f32x16&p0,f32x16&p1,int jb,int qrel,int hi){
  const float NEG=-INFINITY; int kb=64*jb+4*hi;
  #pragma unroll
  for(int r=0;r<16;++r){int kv=kb+(r&3)+8*(r>>2); if(kv>qrel)p0[r]=NEG; if(kv+32>qrel)p1[r]=NEG;}
}

constexpr int NSLOT=3, SLOTB=8192;
constexpr int LDS_K=0, LDS_V=NSLOT*SLOTB, LDS_WS=2*NSLOT*SLOTB, LDS_OST=LDS_WS+NW*64*4, LDS_BIAS=LDS_OST+NW*4096, LDS_SCAN=LDS_BIAS+(SEQ+64)*4, LDS_BYTES=LDS_SCAN+256;
constexpr float C2=0.125f*1.4426950408889634f;
__device__ __forceinline__ void glds16(const void*gsrc,unsigned lds_dst){unsigned keep;
  asm volatile("s_mov_b32 %0, m0\n\ts_mov_b32 m0, %2\n\ts_nop 0\n\tglobal_load_lds_dwordx4 %1, off\n\ts_mov_b32 m0, %0":"=&s"(keep):"v"(gsrc),"s"(lds_dst):"memory");}
__device__ __forceinline__ float max3f(float a,float b,float c){float r;asm("v_max3_f32 %0, %1, %2, %3":"=v"(r):"v"(a),"v"(b),"v"(c));return r;}
__device__ __forceinline__ float max2f(float a,float b){float r;asm("v_max_f32_e32 %0, %1, %2":"=v"(r):"v"(a),"v"(b));return r;}
__device__ __forceinline__ float fadd_s(float a,float b){float r;asm("v_add_f32_e32 %0, %1, %2":"=v"(r):"v"(a),"v"(b));return r;}
__device__ __forceinline__ float fsub_s(float a,float b){float r;asm("v_sub_f32_e32 %0, %1, %2":"=v"(r):"v"(a),"v"(b));return r;}
typedef float f32x2_t __attribute__((ext_vector_type(2))); typedef float f32x4_t __attribute__((ext_vector_type(4))); typedef __bf16 bf16x2_t __attribute__((ext_vector_type(2)));
__device__ __forceinline__ unsigned cvtpk_s(float lo,float hi){f32x2_t v={lo,hi};bf16x2_t b=__builtin_convertvector(v,bf16x2_t);return __builtin_bit_cast(unsigned,b);}
#define WAIT_BAR(N) asm volatile("s_waitcnt vmcnt(" #N ") lgkmcnt(0)\n\ts_barrier":::"memory")

__device__ __forceinline__ void qkt(f32x16&p0,f32x16&p1,const char*Kslot,const bf16x8*qr,int r32,int hi){
  const char*kb=Kslot+hi*1024+r32*16;
  #pragma unroll
  for(int d0=0;d0<4;++d0){
    const bf16x8 b0=*reinterpret_cast<const bf16x8*>(kb+d0*2048);
    const bf16x8 b1=*reinterpret_cast<const bf16x8*>(kb+d0*2048+512);
    p0=__builtin_amdgcn_mfma_f32_32x32x16_bf16(b0,qr[d0],p0,0,0,0);p1=__builtin_amdgcn_mfma_f32_32x32x16_bf16(b1,qr[d0],p1,0,0,0);}
}
typedef __attribute__((address_space(3))) const char* lds_cptr;
typedef short v4i16_t __attribute__((ext_vector_type(4)));
__device__ __forceinline__ void kload8(bf16x8*kf,lds_cptr kp){
  kf[0]=*(const __attribute__((address_space(3))) bf16x8*)(kp);      kf[1]=*(const __attribute__((address_space(3))) bf16x8*)(kp+512);
  kf[2]=*(const __attribute__((address_space(3))) bf16x8*)(kp+2048); kf[3]=*(const __attribute__((address_space(3))) bf16x8*)(kp+2560);
  kf[4]=*(const __attribute__((address_space(3))) bf16x8*)(kp+4096); kf[5]=*(const __attribute__((address_space(3))) bf16x8*)(kp+4608);
  kf[6]=*(const __attribute__((address_space(3))) bf16x8*)(kp+6144); kf[7]=*(const __attribute__((address_space(3))) bf16x8*)(kp+6656);
}
__device__ __forceinline__ void kload2(bf16x8*kf,lds_cptr kp,int j){ kf[2*j]=*(const __attribute__((address_space(3))) bf16x8*)(kp+j*2048); kf[2*j+1]=*(const __attribute__((address_space(3))) bf16x8*)(kp+j*2048+512); }
__device__ __forceinline__ s16x4 vtr(lds_cptr p){ return __builtin_bit_cast(s16x4,__builtin_amdgcn_ds_read_tr16_b64_v4i16((__attribute__((address_space(3))) v4i16_t*)p)); }
__device__ __forceinline__ float rowmax(const f32x16&p0,const f32x16&p1){
  float a=max3f(p0[0],p0[1],p1[0]),b=max3f(p0[2],p0[3],p1[1]);a=max3f(a,p1[2],p1[3]);
  #pragma unroll
  for(int r=4;r<16;r+=4){a=max3f(a,p0[r],p0[r+1]);b=max3f(b,p0[r+2],p0[r+3]);a=max3f(a,p1[r],p1[r+1]);b=max3f(b,p1[r+2],p1[r+3]);}
  const float m=max2f(a,b);
  auto rr=__builtin_amdgcn_permlane32_swap(__float_as_uint(m),__float_as_uint(m),false,false);
  return max2f(__uint_as_float(rr[0]),__uint_as_float(rr[1]));
}
__device__ __forceinline__ void pv(f32x16*o,int vb,bf16x8 pa0,bf16x8 pa1,bf16x8 pa2,bf16x8 pa3){
  #pragma unroll
  for(int d0=0;d0<2;++d0){s16x4 lo[4],hi[4];
    #pragma unroll
    for(int ks=0;ks<4;++ks){
      asm volatile("ds_read_b64_tr_b16 %0,%1 offset:%c2":"=&v"(lo[ks]):"v"(vb),"i"(d0*4096+ks*1024):"memory");
      asm volatile("ds_read_b64_tr_b16 %0,%1 offset:%c2":"=&v"(hi[ks]):"v"(vb),"i"(d0*4096+ks*1024+512):"memory");}
    asm volatile("s_waitcnt lgkmcnt(0)":::"memory");SBAR();
    #define PK(k) (bf16x8){lo[k][0],lo[k][1],lo[k][2],lo[k][3],hi[k][0],hi[k][1],hi[k][2],hi[k][3]}
    o[d0]=__builtin_amdgcn_mfma_f32_32x32x16_bf16(pa0,PK(0),o[d0],0,0,0);
    o[d0]=__builtin_amdgcn_mfma_f32_32x32x16_bf16(pa1,PK(1),o[d0],0,0,0);
    o[d0]=__builtin_amdgcn_mfma_f32_32x32x16_bf16(pa2,PK(2),o[d0],0,0,0);
    o[d0]=__builtin_amdgcn_mfma_f32_32x32x16_bf16(pa3,PK(3),o[d0],0,0,0);
    #undef PK
  }
}

#ifndef ATTN_STORE16
#define ATTN_STORE16(p,v) (*(u32x4*)(p)=(v))
#endif
template<int THRL> __device__ __forceinline__ void attn_unit(int b,int h,int qb,const bf16*Q,const bf16*__restrict__ K,const bf16*__restrict__ V,bf16*O,const float*__restrict__ LOGF2,float*SSQ,char*shm){
  const int tid=threadIdx.x,lane=tid&63,r32=lane&31,hi=lane>>5; const int wid=__builtin_amdgcn_readfirstlane(tid>>6);
  const long rowbase=(long)b*SEQ; const int q0=qb*QB;
  const bf16*Qw=Q+(rowbase+q0+wid*QBLK)*DM+h*D;
  const bf16*Kh=K+rowbase*DM+h*D,*Vh=V+rowbase*DM+h*D;
  const unsigned lds0=(unsigned)(uintptr_t)shm;
  float*wsf=(float*)(shm+LDS_WS)+wid*64;
  const bf16*ksrc=Kh+(long)lane*DM+wid*8;
  const bf16*vsrc=Vh+(long)(16*(wid&3)+(lane>>2))*DM+(wid>>2)*32+(lane&3)*8;
  const unsigned kdst=lds0+LDS_K+wid*1024, vdst=lds0+LDS_V+wid*1024;
  #define DMA_K(t,slot) glds16(ksrc+(long)(t)*KVBLK*DM,(unsigned)__builtin_amdgcn_readfirstlane(kdst+(slot)))
  #define DMA_V(t,slot) glds16(vsrc+(long)(t)*KVBLK*DM,(unsigned)__builtin_amdgcn_readfirstlane(vdst+(slot)))
  const int vb0=(int)(lds0+LDS_V)+((lane>>4)&1)*32+(lane&3)*8+(4*hi+((lane&15)>>2))*64;
  const char*Kbase=shm+LDS_K; bf16x8 kf[8];
  const lds_cptr shm3=(lds_cptr)shm; const lds_cptr kp0=shm3+LDS_K+hi*1024+r32*16; const lds_cptr vp0=shm3+LDS_V+((lane>>4)&1)*32+(lane&3)*8+(4*hi+((lane&15)>>2))*64;
  const int NT=(q0+QB)/KVBLK;
  { float*biasl=(float*)(shm+LDS_BIAS); float*scn=(float*)(shm+LDS_SCAN);
    const float*lf=LOGF2+rowbase*NHEAD+h;
    float v0=0.f,v1=0.f,v2=0.f,v3=0.f; const int i0=4*tid;
    if(i0<q0){ v0=lf[(long)(q0-1-i0)*NHEAD]; v1=lf[(long)(q0-2-i0)*NHEAD]; v2=lf[(long)(q0-3-i0)*NHEAD]; v3=lf[(long)(q0-4-i0)*NHEAD]; }
    const float tsum=(v0+v1)+(v2+v3); float inc=tsum;
    #pragma unroll
    for(int o=1;o<64;o<<=1){ const float n_=__shfl_up(inc,o); if(lane>=o)inc+=n_; }
    if(lane==63)scn[wid]=inc;
    const float f0=lf[(long)(q0+4*lane)*NHEAD],f1=lf[(long)(q0+4*lane+1)*NHEAD],f2=lf[(long)(q0+4*lane+2)*NHEAD],f3=lf[(long)(q0+4*lane+3)*NHEAD];
    float finc=(f0+f1)+(f2+f3);
    #pragma unroll
    for(int o=1;o<64;o<<=1){ const float n_=__shfl_up(finc,o); if(lane>=o)finc+=n_; }
    const float fex=finc-((f0+f1)+(f2+f3));
    if(wid==0){ biasl[q0+4*lane]=-(fex+f0); biasl[q0+4*lane+1]=-(fex+f0+f1); biasl[q0+4*lane+2]=-(fex+f0+f1+f2); biasl[q0+4*lane+3]=-(fex+f0+f1+f2+f3); }
    __syncthreads();
    float woff=0.f;
    #pragma unroll
    for(int w_=0;w_<NW;++w_) woff+=(w_<wid)?scn[w_]:0.f;
    const float ex=woff+inc-tsum;
    if(i0<q0){ biasl[q0-1-i0]=ex; biasl[q0-2-i0]=ex+v0; biasl[q0-3-i0]=ex+v0+v1; biasl[q0-4-i0]=ex+v0+v1+v2; }
    __syncthreads(); }
  const lds_cptr biasr=(lds_cptr)shm+LDS_BIAS+16*hi;
  #define BIAS4(t,o) (*(const __attribute__((address_space(3))) f32x4_t*)(biasr+(t)*(KVBLK*4)+(o)*4))
  #define INIT4(Y,g,t,o) do{ const f32x4_t x_=BIAS4(t,(o)+8*(g)); Y[4*(g)]=x_[0]-mhat; Y[4*(g)+1]=x_[1]-mhat; Y[4*(g)+2]=x_[2]-mhat; Y[4*(g)+3]=x_[3]-mhat; }while(0)
  #define INITT(Y0,Y1,t) do{ INIT4(Y0,0,t,0);INIT4(Y0,1,t,0);INIT4(Y0,2,t,0);INIT4(Y0,3,t,0); INIT4(Y1,0,t,32);INIT4(Y1,1,t,32);INIT4(Y1,2,t,32);INIT4(Y1,3,t,32); }while(0)
  DMA_K(0,0);DMA_V(0,0);DMA_K(1,SLOTB);
  bf16x8 qr[4];
  #pragma unroll
  for(int d0=0;d0<4;++d0)qr[d0]=*reinterpret_cast<const bf16x8*>(&Qw[(long)r32*DM+d0*16+hi*8]);
  float mhat=0.f,l_reg=0.f;f32x16 o[2];o[0]=f32x16{};o[1]=f32x16{};
  const int qrel=wid*QBLK+r32;
  #define CMASK(P0,P1,t) do{int jb_=(t)-(NT-4); if(jb_>=0)cmask(P0,P1,jb_,qrel,hi);}while(0)
  bool resc=false;
  #define START(P0,P1) do{ const float rm=rowmax(P0,P1); resc=false; \
    { const float dl=rm; mhat=fadd_s(mhat,dl); \
      _Pragma("unroll") for(int r=0;r<16;++r){P0[r]=fsub_s(P0[r],dl);P1[r]=fsub_s(P1[r],dl);} } \
    _Pragma("unroll") for(int r=0;r<16;++r)P0[r]=__builtin_amdgcn_exp2f(P0[r]); }while(0)
  #define RESC() do{ if(resc){ asm volatile("s_waitcnt lgkmcnt(0)":::"memory"); \
      _Pragma("unroll") for(int d_=0;d_<2;++d_) _Pragma("unroll") for(int r=0;r<16;++r)o[d_][r]*=wsf[crow(r,hi)]; } }while(0)
  f32x16 pA0,pA1,pB0,pB1;
  int sl_prev=0,sl_cur=0,sl_next=SLOTB;
  #define ROT() do{sl_prev=sl_cur;sl_cur=sl_next;sl_next=(sl_next==(NSLOT-1)*SLOTB)?0:sl_next+SLOTB;}while(0)
  DMA_K(2,2*SLOTB);
  WAIT_BAR(3);
  INITT(pA0,pA1,0); qkt(pA0,pA1,Kbase,qr,r32,hi);asm volatile("s_nop 15\n\ts_nop 7":"+v"(pA0),"+v"(pA1));CMASK(pA0,pA1,0);
  START(pA0,pA1);
  _Pragma("unroll") for(int r=0;r<16;++r)pA1[r]=__builtin_amdgcn_exp2f(pA1[r]);
  INITT(pB0,pB1,1);
  WAIT_BAR(0);
  DMA_K(3,0);DMA_V(1,SLOTB);
  ROT();
  kload8(kf,kp0+sl_cur);
  WAIT_BAR(2);
  s16x4 vlo[8],vhi[8]; u32x4 pw0,pw1,pw2,pw3;
  #define PKW(P,B) cvtpk_s(P[B],P[B+1])
  #define PAF(k) __builtin_bit_cast(bf16x8,pw##k)
  #define VFR(i) (bf16x8){vlo[i][0],vlo[i][1],vlo[i][2],vlo[i][3],vhi[i][0],vhi[i][1],vhi[i][2],vhi[i][3]}
  #define PIN(x) asm volatile("":"+v"(x))
  #define MX3(a,b,c) __builtin_fmaxf(__builtin_fmaxf((a),(b)),(c))
  #define GAPA(MF,A0,A1,A2,A3,W0,W1,PW) do{ MF; sacc+=A0; sacc+=A1; sacc+=A2; sacc+=A3; PIN(sacc); W0; W1; PIN(PW); SBAR(); }while(0)
  #define EX(v) __builtin_amdgcn_exp2f(v)
  #define GAPB(MF,X,B,GN,Y,tn,o) do{ MF; X[B]=EX(X[B]); X[B+1]=EX(X[B+1]); X[B+2]=EX(X[B+2]); X[B+3]=EX(X[B+3]); PIN(X); if(GN){ INIT4(Y,(B)/4,tn,o); PIN(Y); } SBAR(); }while(0)
  #define VRD(i) do{ vlo[i]=vtr(vp_+(((i)>>2)*4096+((i)&3)*1024)); vhi[i]=vtr(vp_+(((i)>>2)*4096+((i)&3)*1024+512)); }while(0)
  #define KRD(G,j) do{ if(G){ kload2(kf,kp0+sl_next,j); SBAR(); } }while(0)
  #define STEP(C0,C1,P0,P1,t,GK,GV,GL) do{ SBAR(); \
    const lds_cptr vp_=vp0+sl_prev; \
    VRD(0); SBAR(); float sacc=(P0[0]+P0[1]); \
    GAPA(C0=__builtin_amdgcn_mfma_f32_32x32x16_bf16(kf[0],qr[0],C0,0,0,0), P0[2],P0[3],P0[4],P0[5],     pw0[0]=PKW(P0,0), pw0[1]=PKW(P0,2), pw0); \
    VRD(4); SBAR(); GAPA(C1=__builtin_amdgcn_mfma_f32_32x32x16_bf16(kf[1],qr[0],C1,0,0,0), P0[6],P0[7],P0[8],P0[9],     pw0[2]=PKW(P0,4), pw0[3]=PKW(P0,6), pw0); \
    VRD(1); SBAR(); GAPA(C0=__builtin_amdgcn_mfma_f32_32x32x16_bf16(kf[2],qr[1],C0,0,0,0),   P0[10],P0[11],P0[12],P0[13], pw1[0]=PKW(P0,8), pw1[1]=PKW(P0,10), pw1); \
    VRD(5); SBAR(); GAPA(C1=__builtin_amdgcn_mfma_f32_32x32x16_bf16(kf[3],qr[1],C1,0,0,0),   P0[14],P0[15],P1[0],P1[1],   pw1[2]=PKW(P0,12),pw1[3]=PKW(P0,14), pw1); \
    VRD(2); SBAR(); GAPA(C0=__builtin_amdgcn_mfma_f32_32x32x16_bf16(kf[4],qr[2],C0,0,0,0),   P1[2],P1[3],P1[4],P1[5],     pw2[0]=PKW(P1,0), pw2[1]=PKW(P1,2), pw2); \
    VRD(6); SBAR(); GAPA(C1=__builtin_amdgcn_mfma_f32_32x32x16_bf16(kf[5],qr[2],C1,0,0,0),   P1[6],P1[7],P1[8],P1[9],     pw2[2]=PKW(P1,4), pw2[3]=PKW(P1,6), pw2); \
    VRD(3); SBAR(); GAPA(C0=__builtin_amdgcn_mfma_f32_32x32x16_bf16(kf[6],qr[3],C0,0,0,0),   P1[10],P1[11],P1[12],P1[13], pw3[0]=PKW(P1,8), pw3[1]=PKW(P1,10), pw3); \
    VRD(7); SBAR(); GAPA(C1=__builtin_amdgcn_mfma_f32_32x32x16_bf16(kf[7],qr[3],C1,0,0,0),   P1[14],P1[15],0.f,0.f,       pw3[2]=PKW(P1,12),pw3[3]=PKW(P1,14), pw3); \
    l_reg+=sacc; \
    if(GK){DMA_K((t)+3,sl_cur);} if(GV){DMA_V((t)+1,sl_next);} \
    CMASK(C0,C1,t); \
    { float a=MX3(C0[0],C0[1],C1[0]),b=MX3(C0[2],C0[3],C1[1]); a=MX3(a,C1[2],C1[3]); \
      _Pragma("unroll") for(int r=4;r<16;r+=4){a=MX3(a,C0[r],C0[r+1]);b=MX3(b,C0[r+2],C0[r+3]);a=MX3(a,C1[r],C1[r+1]);b=MX3(b,C1[r+2],C1[r+3]);} \
      float rm=__builtin_fmaxf(a,b); { auto rr=__builtin_amdgcn_permlane32_swap(__float_as_uint(rm),__float_as_uint(rm),false,false); rm=__builtin_fmaxf(__uint_as_float(rr[0]),__uint_as_float(rr[1])); } \
      resc=false; \
      if(__builtin_expect(__any(rm>(float)THRL),0)){ const float dl=__builtin_fmaxf(rm,0.f); mhat+=dl; \
        _Pragma("unroll") for(int r=0;r<16;++r){C0[r]-=dl;C1[r]-=dl;} \
        const float f=__builtin_amdgcn_exp2f(-dl); l_reg*=f; if(hi==0)wsf[r32]=f; resc=true; } } \
    SBAR(); \
    GAPB(o[0]=__builtin_amdgcn_mfma_f32_32x32x16_bf16(PAF(0),VFR(0),o[0],0,0,0), C0,0,  GL,P0,(t)+1,0); \
    GAPB(o[1]=__builtin_amdgcn_mfma_f32_32x32x16_bf16(PAF(0),VFR(4),o[1],0,0,0), C0,4,  GL,P0,(t)+1,0); \
    KRD(GL,0); GAPB(o[0]=__builtin_amdgcn_mfma_f32_32x32x16_bf16(PAF(1),VFR(1),o[0],0,0,0), C0,8,  GL,P0,(t)+1,0); \
    KRD(GL,1); GAPB(o[1]=__builtin_amdgcn_mfma_f32_32x32x16_bf16(PAF(1),VFR(5),o[1],0,0,0), C0,12, GL,P0,(t)+1,0); \
    KRD(GL,2); GAPB(o[0]=__builtin_amdgcn_mfma_f32_32x32x16_bf16(PAF(2),VFR(2),o[0],0,0,0), C1,0,  GL,P1,(t)+1,32); \
    KRD(GL,3); GAPB(o[1]=__builtin_amdgcn_mfma_f32_32x32x16_bf16(PAF(2),VFR(6),o[1],0,0,0), C1,4,  GL,P1,(t)+1,32); \
    GAPB(o[0]=__builtin_amdgcn_mfma_f32_32x32x16_bf16(PAF(3),VFR(3),o[0],0,0,0), C1,8,  GL,P1,(t)+1,32); \
    GAPB(o[1]=__builtin_amdgcn_mfma_f32_32x32x16_bf16(PAF(3),VFR(7),o[1],0,0,0), C1,12, GL,P1,(t)+1,32); \
    }while(0)
  int t=1;
  #undef CMASK
  #define CMASK(P0,P1,t) do{}while(0)
  for(;t+5<NT;t+=2){
    STEP(pB0,pB1,pA0,pA1,t,true,true,true);     WAIT_BAR(2); RESC(); ROT();
    STEP(pA0,pA1,pB0,pB1,t+1,true,true,true);   WAIT_BAR(2); RESC(); ROT();
  }
  #undef CMASK
  #define CMASK(P0,P1,t) do{int jb_=(t)-(NT-4); if(jb_>=0)cmask(P0,P1,jb_,qrel,hi);}while(0)
  #define ENDW(tt) do{ if((tt)+3<NT){WAIT_BAR(2);} else if((tt)+2<NT){WAIT_BAR(1);} else {WAIT_BAR(0);} }while(0)
  for(;t+1<NT;t+=2){
    STEP(pB0,pB1,pA0,pA1,t,(t+3<NT),(t+1<NT),(t+1<NT));       ENDW(t);   RESC(); ROT();
    STEP(pA0,pA1,pB0,pB1,t+1,(t+4<NT),(t+2<NT),(t+2<NT));     ENDW(t+1); RESC(); ROT();
  }
  STEP(pB0,pB1,pA0,pA1,NT-1,false,false,false); RESC();
  { float sacc=pB0[0]+pB0[1]; _Pragma("unroll") for(int r=2;r<16;++r)sacc+=pB0[r]; _Pragma("unroll") for(int r=0;r<16;++r)sacc+=pB1[r]; l_reg+=sacc;
    pw0=(u32x4){PKW(pB0,0),PKW(pB0,2),PKW(pB0,4),PKW(pB0,6)};pw1=(u32x4){PKW(pB0,8),PKW(pB0,10),PKW(pB0,12),PKW(pB0,14)};pw2=(u32x4){PKW(pB1,0),PKW(pB1,2),PKW(pB1,4),PKW(pB1,6)};pw3=(u32x4){PKW(pB1,8),PKW(pB1,10),PKW(pB1,12),PKW(pB1,14)};
    SBAR(); pv(o,vb0+sl_cur,PAF(0),PAF(1),PAF(2),PAF(3)); }
  #undef PKW
  #undef PAF
  #undef VFR
  #undef PIN
  #undef MX3
  #undef GAPA
  #undef GAPB
  #undef EX
  #undef VRD
  #undef KRD
  #undef STEP
  #undef ENDW
  {auto rr=__builtin_amdgcn_permlane32_swap(__float_as_uint(l_reg),__float_as_uint(l_reg),false,false);l_reg=__uint_as_float(rr[0])+__uint_as_float(rr[1]);}
  if(hi==0)wsf[32+r32]=l_reg;asm volatile("s_waitcnt lgkmcnt(0)":::"memory");
  float rli[16];
  #pragma unroll
  for(int r=0;r<16;++r)rli[r]=__builtin_amdgcn_rcpf(wsf[32+crow(r,hi)]);
  bf16*Ow=O+(rowbase+q0+wid*QBLK)*OPITCH+h*D; float*Sw=SSQ+(rowbase+q0+wid*QBLK)*NHEAD+h;
  { bf16*stg=(bf16*)(shm+LDS_OST)+wid*2048;
    #pragma unroll
    for(int r=0;r<16;++r){const int orow=crow(r,hi);
      #pragma unroll
      for(int d0=0;d0<2;++d0)stg[orow*64+d0*32+r32]=__float2bfloat16(o[d0][r]*rli[r]);}
    asm volatile("s_waitcnt lgkmcnt(0)":::"memory");
    #pragma unroll
    for(int i=0;i<4;++i){const int row=i*8+(lane>>3),ch=lane&7; const u32x4 v=*(const u32x4*)(stg+row*64+ch*8); ATTN_STORE16(Ow+(long)row*OPITCH+ch*8,v);
      float sq=0.f;
      #pragma unroll
      for(int j=0;j<4;++j){ const float lo_=__uint_as_float(v[j]<<16), hi_=__uint_as_float(v[j]&0xffff0000u); sq+=lo_*lo_+hi_*hi_; }
      sq+=__shfl_xor(sq,1); sq+=__shfl_xor(sq,2); sq+=__shfl_xor(sq,4);
      if(ch==0)Sw[(long)row*NHEAD]=sq; } }
  asm volatile("s_waitcnt lgkmcnt(0)\n\ts_barrier":::"memory");
  #undef DMA_K
  #undef BIAS4
  #undef INIT4
  #undef INITT
  #undef DMA_V
  #undef CMASK
  #undef START
  #undef RESC
  #undef ROT
}
constexpr int ATTN_LDS_BYTES=LDS_BYTES;
struct AttnTensors { const bf16* Q; const bf16* K; const bf16* V; bf16* O; const float* LOGF2; float* SSQ; };
struct AttnUnit { int bh; int qb; };
struct StaticOrder {
  int vcu,G;
  __device__ __forceinline__ explicit StaticOrder(int grid,int vcu_):vcu(vcu_),G(grid){}
  __device__ __forceinline__ bool next(int i,AttnUnit&u)const{ const int L=(i>>1)*G+vcu; if(L>=BATCH*NHEAD*4)return false; const int s=L&3; u.bh=L>>2; u.qb=(i&1)?7-s:s; return true; }
  __device__ __forceinline__ void a_ready(const AttnUnit&)const{}
  __device__ __forceinline__ void done(const AttnUnit&)const{}
};
template<class Sched,int THRL=8> __device__ __forceinline__ void attn_phase(char*lds,const AttnTensors&T,const Sched&S){
  AttnUnit u;
  for(int i=0;S.next(i,u);++i){ S.a_ready(u); attn_unit<THRL>(u.bh/NHEAD,u.bh%NHEAD,u.qb,T.Q,T.K,T.V,T.O,T.LOGF2,T.SSQ,lds); S.done(u); }
}
#undef SBAR
#undef WAIT_BAR
}

constexpr int NWAVES = 8;
constexpr int NPHASES = 11;

constexpr size_t MiB = 1u << 20, KiB = 1u << 10;
constexpr size_t WS_CTL = 0, CTL_ZERO_BYTES = 1 * MiB;
constexpr size_t WS_MOD = 1 * MiB;
constexpr size_t WS_LOGF2 = 1 * MiB + 256 * KiB;
constexpr size_t WS_SSQ = 1 * MiB + 768 * KiB;
constexpr size_t WS_TOPI = 2 * MiB + 256 * KiB;
constexpr size_t WS_TOPW = 2 * MiB + 512 * KiB;
constexpr size_t WS_WGCNT = 2 * MiB + 768 * KiB;
constexpr size_t WS_LSUM = 3 * MiB;
constexpr size_t WS_ROWTOK = 4 * MiB, WS_ROWPAIR = 4 * MiB + 512 * KiB, WS_ROWW = 5 * MiB, WS_MTEXP = 5 * MiB + 512 * KiB;
constexpr size_t WS_LWT = 6 * MiB;
constexpr size_t WS_WFT = 6 * MiB + 512 * KiB;
constexpr size_t WS_WRT = 7 * MiB;
constexpr size_t WS_WIN = 8 * MiB;
constexpr size_t WS_WOUT = 13 * MiB;
constexpr size_t WS_WUP = 16 * MiB;
constexpr size_t WS_WDN = 144 * MiB;
constexpr size_t WS_H1 = 208 * MiB;
constexpr size_t WS_PJ = 240 * MiB;
constexpr size_t PJ_STRIDE = (size_t)NTOK * 512;
constexpr size_t WS_MRG = 320 * MiB;
constexpr size_t WS_Y = 352 * MiB;
constexpr size_t WS_H2 = 416 * MiB;
constexpr size_t WS_ACT = 448 * MiB;
constexpr size_t WS_YP = 592 * MiB;
constexpr size_t WS_END = 720 * MiB;
static_assert(WS_ACT + (size_t)MAXROWS * 1024 * 2 <= WS_YP && WS_YP + (size_t)NTOK * 4 * 1024 * 2 <= WS_END, "d_ws map");
constexpr int CW_BAR = 4096;

constexpr int LDS_BYTES = 147456;
constexpr int LDSCTL_OFF = LDS_BYTES - 512, MISC_OFF = LDSCTL_OFF + 320;
constexpr int SCRATCH_BYTES = LDSCTL_OFF;

#define GAS __attribute__((address_space(1)))
#define LAS __attribute__((address_space(3)))
typedef unsigned short bf16;
typedef unsigned v4u __attribute__((ext_vector_type(4)));
typedef unsigned v2u __attribute__((ext_vector_type(2)));
typedef float f32x4 __attribute__((ext_vector_type(4)));
typedef float f32x16 __attribute__((ext_vector_type(16)));
typedef short bf16x8 __attribute__((ext_vector_type(8)));
typedef GAS unsigned gu32;
#define RLX_AGENT __ATOMIC_RELAXED, __HIP_MEMORY_SCOPE_AGENT
#define LDS_WAIT() asm volatile("s_waitcnt lgkmcnt(0)" ::: "memory")
#define VM_WAIT() asm volatile("s_waitcnt vmcnt(0)" ::: "memory")
__device__ __forceinline__ unsigned f2bf(float f) { unsigned u = __builtin_bit_cast(unsigned, f); return (u + 0x7fffu + ((u >> 16) & 1u)) >> 16; }
__device__ __forceinline__ unsigned pk2(float lo, float hi) { return f2bf(lo) | (f2bf(hi) << 16); }
__device__ __forceinline__ float bflo(unsigned w) { return __uint_as_float(w << 16); }
__device__ __forceinline__ float bfhi(unsigned w) { return __uint_as_float(w & 0xffff0000u); }
__device__ __forceinline__ float bf1(bf16 h) { return __uint_as_float((unsigned)h << 16); }

#define XB_TMO      128
#define XB_XCNT(j)  (256  + 64 * (j))
#define XB_XSUB(j)  (1280 + 64 * (j))
#define XB_XGEN(j)  (2304 + 64 * (j))
#define XB_TOP      3328
#define XB_TOPGEN   3392
#define XCD_BAR_WORDS 3456
#define XB_SPIN_CAP (1u << 18)
__device__ __forceinline__ unsigned xb_ld(unsigned* p)              { return __hip_atomic_load(p, __ATOMIC_RELAXED, __HIP_MEMORY_SCOPE_AGENT); }
__device__ __forceinline__ unsigned xb_add(unsigned* p, unsigned v) { return __hip_atomic_fetch_add(p, v, __ATOMIC_RELAXED, __HIP_MEMORY_SCOPE_AGENT); }
__device__ __forceinline__ unsigned xb_xcc_id() { return (unsigned)__builtin_amdgcn_s_getreg((3 << 11) | 20) & 0xFu; }
#define XB_SPIN(cond, bar) do { unsigned _sp = 0; while (cond) { __builtin_amdgcn_s_sleep(1); \
    if ((++_sp & 255u) == 0u) { if (xb_ld(&(bar)[XB_TMO])) break; if (_sp > XB_SPIN_CAP) { atomicAdd(&(bar)[XB_TMO], 1u); break; } } } } while (0)
struct XcdBarrier { unsigned* bar; unsigned x; volatile LAS unsigned* st; };
__device__ __forceinline__ XcdBarrier xcd_barrier_post(unsigned* bar, volatile LAS unsigned* st) {
    XcdBarrier b; b.bar = bar; b.x = xb_xcc_id(); b.st = st;
    if (threadIdx.x == 0) (void)xb_add(&bar[XB_XCNT(b.x)], 1u);
    return b;
}
__device__ __forceinline__ void xcd_barrier_complete(unsigned* bar, unsigned x, unsigned& nloc, unsigned& nx) {
    const unsigned G = gridDim.x * gridDim.y * gridDim.z;
    unsigned sum, cnt, mine, sp = 0u;
    for (;;) {
        sum = 0u; cnt = 0u; mine = 0u;
#pragma unroll
        for (unsigned j = 0; j < 16; ++j) { const unsigned c = xb_ld(&bar[XB_XCNT(j)]); sum += c; cnt += (c > 0u) ? 1u : 0u; mine = (j == x) ? c : mine; }
        if (sum == G) break;
        __builtin_amdgcn_s_sleep(1);
        if ((++sp & 255u) == 0u) { if (xb_ld(&bar[XB_TMO])) break; if (sp > XB_SPIN_CAP) { atomicAdd(&bar[XB_TMO], 1u); break; } }
    }
    nloc = mine > 0u ? mine : 1u; nx = cnt > 0u ? cnt : 1u;
}
__device__ __forceinline__ void xcd_barrier(const XcdBarrier& b) {
    asm volatile("s_waitcnt vmcnt(0)" ::: "memory");
    __syncthreads();
    if (threadIdx.x == 0) {
        unsigned* bar = b.bar;
        __builtin_amdgcn_s_waitcnt(0);
        unsigned nloc = b.st[0], nx = b.st[1];
        if (nloc == 0u) { xcd_barrier_complete(bar, b.x, nloc, nx); b.st[0] = nloc; b.st[1] = nx; }
        const unsigned old = xb_add(&bar[XB_XSUB(b.x)], 1u);
        const unsigned gen = old / nloc;
        if (old + 1u == (gen + 1u) * nloc) {
            __builtin_amdgcn_fence(__ATOMIC_RELEASE, "agent");
            asm volatile("s_waitcnt vmcnt(0)" ::: "memory");
            const unsigned og = xb_add(&bar[XB_TOP], 1u);
            const unsigned tg = og / nx;
            if (og + 1u == (tg + 1u) * nx) xb_add(&bar[XB_TOPGEN], 1u);
            else XB_SPIN(xb_ld(&bar[XB_TOPGEN]) == tg, bar);
            __builtin_amdgcn_fence(__ATOMIC_ACQUIRE, "agent");
            xb_add(&bar[XB_XGEN(b.x)], 1u);
            asm volatile("s_waitcnt vmcnt(0)" ::: "memory");
        } else {
            XB_SPIN(xb_ld(&bar[XB_XGEN(b.x)]) == gen, bar);
            __builtin_amdgcn_fence(__ATOMIC_ACQUIRE, "agent");
            asm volatile("s_waitcnt vmcnt(0)" ::: "memory");
        }
    }
    __syncthreads();
}

struct Args { const float* in[26]; float* out; unsigned char* ws; int ph_lo, ph_hi, li, pad; };
struct Frame {
    LAS unsigned char* lds;
    int tid, lane, wave, vcu, G;
    float* out; unsigned char* ws;
    __device__ __forceinline__ const float* in(int k) const { const LAS unsigned* t = (const LAS unsigned*)(lds + LDSCTL_OFF) + 2 * k;
        const unsigned lo = (unsigned)__builtin_amdgcn_readfirstlane((int)t[0]), hi = (unsigned)__builtin_amdgcn_readfirstlane((int)t[1]);
        return (const float*)(const GAS float*)(((unsigned long long)hi << 32) | lo); }
};
__device__ __forceinline__ float wave_sum(float v) {
#pragma unroll
    for (int o = 1; o < 64; o <<= 1) v += __shfl_xor(v, o);
    return v;
}
__device__ __forceinline__ float wave_max(float v) {
#pragma unroll
    for (int o = 1; o < 64; o <<= 1) v = fmaxf(v, __shfl_xor(v, o));
    return v;
}
__device__ __forceinline__ float sigmoid_f(float x) { return __builtin_amdgcn_rcpf(1.0f + __builtin_amdgcn_exp2f(-1.4426950408889634f * x)); }
__device__ __forceinline__ float gelu_tanh_f(float x) { const float u = 0.7978845608028654f * (x + 0.044715f * x * x * x); const float e = __builtin_amdgcn_exp2f(2.8853900817779268f * u); return x * (1.0f - __builtin_amdgcn_rcpf(e + 1.0f)); }
__device__ __forceinline__ float log_sigmoid_f(float z) { return z >= 0.f ? -log1pf(expf(-z)) : z - log1pf(expf(z)); }
__device__ __forceinline__ float softplus_f(float z) { return z > 0.f ? z + log1pf(expf(-z)) : log1pf(expf(z)); }

__device__ __forceinline__ void p0_transpose_item(const float* W, int ldw, bf16* WT, int k0, int n0, int kdst0, const float* gain, LAS float* scr, int lane) {
#pragma unroll 8
    for (int i = 0; i < 32; ++i) { const int kk = 2 * i + (lane >> 5); float v = W[(size_t)(k0 + kk) * ldw + n0 + (lane & 31)]; if (gain) v *= gain[k0 + kk]; scr[kk * 33 + (lane & 31)] = v; }
    LDS_WAIT(); asm volatile("" ::: "memory");
    const int c = lane & 7;
#pragma unroll
    for (int j = 0; j < 4; ++j) { const int n = (lane >> 3) + 8 * j; const LAS float* s = scr + (8 * c) * 33 + n;
        v4u o; o.x = pk2(s[0 * 33], s[1 * 33]); o.y = pk2(s[2 * 33], s[3 * 33]); o.z = pk2(s[4 * 33], s[5 * 33]); o.w = pk2(s[6 * 33], s[7 * 33]);
        *(GAS v4u*)(WT + (size_t)(n0 + n) * 1024 + kdst0 + 8 * c) = o; }
    LDS_WAIT(); asm volatile("" ::: "memory");
}
constexpr int CV_UP_ITEMS = NE * 16 * 32, CV_DN_ITEMS = NE * 16 * 16;
constexpr int CV_UP_TAIL = 8192, CV_DN_TAIL = 4096;
__device__ __forceinline__ void cvt_block_f8(const float* W, int ldw, unsigned char* WT, LAS unsigned char* scr, int lane) {
    float v[64];
#pragma unroll
    for (int i = 0; i < 64; ++i) v[i] = W[(size_t)i * ldw + lane];
#pragma unroll
    for (int q = 0; q < 4; ++q) { int w[4];
#pragma unroll
        for (int j = 0; j < 4; ++j) { int t = 0; t = __builtin_amdgcn_cvt_pk_fp8_f32(v[16 * q + 4 * j] * 64.0f, v[16 * q + 4 * j + 1] * 64.0f, t, false); t = __builtin_amdgcn_cvt_pk_fp8_f32(v[16 * q + 4 * j + 2] * 64.0f, v[16 * q + 4 * j + 3] * 64.0f, t, true); w[j] = t; }
        *(LAS v4u*)(scr + lane * 80 + 16 * q) = (v4u){(unsigned)w[0], (unsigned)w[1], (unsigned)w[2], (unsigned)w[3]}; }
    LDS_WAIT(); asm volatile("" ::: "memory");
#pragma unroll
    for (int j = 0; j < 4; ++j) { const int row = 16 * j + (lane >> 2), c = lane & 3;
        *(GAS v4u*)(WT + (size_t)row * 1024 + 16 * c) = *(const LAS v4u*)(scr + row * 80 + 16 * c); }
    LDS_WAIT(); asm volatile("" ::: "memory");
}
__device__ __forceinline__ void cvt_up_item(Frame& F, int u) { const int e = u >> 9, q = u & 511, kb = q >> 5, nb = q & 31;
    cvt_block_f8(F.in(22) + (size_t)e * DM * 2 * DEXP + (size_t)(64 * kb) * (2 * DEXP) + 64 * nb, 2 * DEXP, (unsigned char*)(F.ws + WS_WUP) + ((size_t)e * 2 * DEXP + 64 * nb) * 1024 + 64 * kb, F.lds + F.wave * 16384, F.lane); }
__device__ __forceinline__ void cvt_dn_item(Frame& F, int d) { const int e = d >> 8, q = d & 255, kb = q >> 4, nb = q & 15;
    cvt_block_f8(F.in(24) + (size_t)e * DEXP * DM + (size_t)(64 * kb) * DM + 64 * nb, DM, (unsigned char*)(F.ws + WS_WDN) + ((size_t)e * DM + 64 * nb) * 1024 + 64 * kb, F.lds + F.wave * 16384, F.lane); }
template <bool UP> __device__ __forceinline__ void cvt_range(Frame& F, int lo, int hi, int wr_, int nw) {
    for (int it = lo + wr_; it < hi; it += nw) { if (UP) cvt_up_item(F, it); else cvt_dn_item(F, it); }
}
__device__ __forceinline__ void p0_transpose_item_f8(const float* W, int ldw, unsigned char* WT, int k0, int n0, float scale, LAS float* scr, int lane) {
#pragma unroll 8
    for (int i = 0; i < 32; ++i) { const int kk = 2 * i + (lane >> 5); scr[kk * 33 + (lane & 31)] = W[(size_t)(k0 + kk) * ldw + n0 + (lane & 31)] * scale; }
    LDS_WAIT(); asm volatile("" ::: "memory");
    const int c = lane & 7;
#pragma unroll
    for (int j = 0; j < 4; ++j) { const int n = (lane >> 3) + 8 * j; const LAS float* s = scr + (8 * c) * 33 + n;
        int w0 = 0, w1 = 0; w0 = __builtin_amdgcn_cvt_pk_fp8_f32(s[0 * 33], s[1 * 33], w0, false); w0 = __builtin_amdgcn_cvt_pk_fp8_f32(s[2 * 33], s[3 * 33], w0, true);
        w1 = __builtin_amdgcn_cvt_pk_fp8_f32(s[4 * 33], s[5 * 33], w1, false); w1 = __builtin_amdgcn_cvt_pk_fp8_f32(s[6 * 33], s[7 * 33], w1, true);
        typedef int i32x2_ __attribute__((ext_vector_type(2))); *(GAS i32x2_*)(WT + (size_t)(n0 + n) * 1024 + k0 + 8 * c) = (i32x2_){w0, w1}; }
    LDS_WAIT(); asm volatile("" ::: "memory");
}
template <int PARTS = 7> __device__ __forceinline__ void p0_phase(Frame& F) {
    const float* c_in = F.in(1); const float* w_ada = F.in(2); const float* b_ada = F.in(3);
    float* MOD = (float*)(F.ws + WS_MOD);
    if ((PARTS & 1) && F.vcu < 192) {
        LAS float* sc = (LAS float*)F.lds;
        LAS float* red = (LAS float*)(F.lds + 32768);
        for (int i = F.tid; i < BATCH * DM; i += NWAVES * 64) { const int b = i >> 10, k = i & 1023; const float v = c_in[i]; sc[k * 8 + b] = v * sigmoid_f(v); }
        __syncthreads();
        for (int ci = F.vcu; ci < 192; ci += F.G) {
            const int col = F.lane & 31, ks = F.lane >> 5;
            float acc[8];
#pragma unroll
            for (int b = 0; b < 8; ++b) acc[b] = 0.f;
            const float* wp = w_ada + (size_t)(128 * F.wave + ks) * (NMOD * DM) + ci * 32 + col;
#pragma unroll 1
            for (int i0 = 0; i0 < 64; i0 += 32) {
                float wv[32];
#pragma unroll
                for (int i = 0; i < 32; ++i) wv[i] = wp[(size_t)(2 * (i0 + i)) * (NMOD * DM)];
#pragma unroll
                for (int i = 0; i < 32; ++i) { const LAS f32x4* sp = (const LAS f32x4*)(sc + (128 * F.wave + 2 * (i0 + i) + ks) * 8); const f32x4 s0 = sp[0], s1 = sp[1];
                    acc[0] += s0[0] * wv[i]; acc[1] += s0[1] * wv[i]; acc[2] += s0[2] * wv[i]; acc[3] += s0[3] * wv[i]; acc[4] += s1[0] * wv[i]; acc[5] += s1[1] * wv[i]; acc[6] += s1[2] * wv[i]; acc[7] += s1[3] * wv[i]; }
            }
#pragma unroll
            for (int b = 0; b < 8; ++b) { acc[b] += __shfl_xor(acc[b], 32); if (ks == 0) red[(F.wave * 8 + b) * 32 + col] = acc[b]; }
            __syncthreads();
            if (F.tid < 256) { const int b = F.tid >> 5, cl = F.tid & 31; float s = 0.f;
#pragma unroll
              for (int w = 0; w < 8; ++w) s += red[(w * 8 + b) * 32 + cl];
              MOD[b * NMOD * DM + ci * 32 + cl] = s + b_ada[ci * 32 + cl]; }
            __syncthreads();
        }
    }
    __syncthreads();
    const float* w_in = F.in(6); const float* w_out = F.in(17); const float* gn_attn = F.in(16);
    bf16* WIN = (bf16*)(F.ws + WS_WIN); bf16* WOUT = (bf16*)(F.ws + WS_WOUT);
    LAS float* scr = (LAS float*)(F.lds + F.wave * 16384);
    const int gw = F.vcu * NWAVES + F.wave, NGW = F.G * NWAVES;
    constexpr int I_IN = 16 * (NPJ / 32), I_OUT = 16 * (DM / 32);
    constexpr int NITEMS = I_IN + I_OUT;
    if (PARTS & 2) for (int it = gw; it < NITEMS; it += NGW) {
        int r = it;
        if (r < I_IN) { const int kb = r / (NPJ / 32), nb = r % (NPJ / 32); p0_transpose_item(w_in, NPROJ, WIN, 64 * kb, 32 * nb, 64 * kb, nullptr, scr, F.lane); continue; } r -= I_IN;
        { const int kb = r / (DM / 32), nb = r % (DM / 32); const int k0 = 64 * kb;
            p0_transpose_item(w_out, DM, WOUT, k0, 32 * nb, (k0 + 512) & 1023, k0 >= 512 ? gn_attn - 512 : nullptr, scr, F.lane); }
    }
    if (PARTS & 4) { const bool tails = (F.G == 256);
      cvt_range<true>(F, tails ? CV_UP_TAIL : 0, CV_UP_ITEMS, gw, NGW);
      cvt_range<false>(F, tails ? CV_DN_TAIL : 0, CV_DN_ITEMS, gw, NGW); }
    if (PARTS & 2) { const float* w_in2 = F.in(6); float* WFT = (float*)(F.ws + WS_WFT);
      for (int idx = F.vcu * (NWAVES * 64) + F.tid; idx < 8 * DM; idx += F.G * NWAVES * 64) { const int h = idx >> 10, k = idx & 1023; WFT[idx] = w_in2[(size_t)k * NPROJ + NPJ + h]; } }
    { const float* w_router = F.in(20); float* WRT = (float*)(F.ws + WS_WRT);
      for (int idx = F.vcu * (NWAVES * 64) + F.tid; idx < NE * DM; idx += F.G * NWAVES * 64) { const int e = idx >> 10, k = idx & 1023; WRT[idx] = w_router[k * NE + e]; } }
    { const float* wa = F.in(9); const float* wx = F.in(11); bf16* LWT = (bf16*)(F.ws + WS_LWT);
      for (int idx = F.vcu * (NWAVES * 64) + F.tid; idx < 2 * 8 * 64 * 64; idx += F.G * NWAVES * 64) { const int gate = idx >> 15, g = (idx >> 12) & 7, j = (idx >> 6) & 63, i = idx & 63;
          LWT[idx] = (bf16)f2bf((gate ? wx : wa)[(g * 64 + i) * 64 + j]); } }
}

__device__ __forceinline__ void p1_phase(Frame& F) {
    const float* x = F.in(0); const float* gpre = F.in(4); const float* fb = F.in(14);
    const float* MOD = (const float*)(F.ws + WS_MOD); bf16* H1 = (bf16*)(F.ws + WS_H1); float* LOGF2 = (float*)(F.ws + WS_LOGF2);
    LAS float* wf = (LAS float*)F.lds;
    { const float* WFT = (const float*)(F.ws + WS_WFT);
#pragma unroll
      for (int i = F.tid; i < 8 * DM / 4; i += NWAVES * 64) *(LAS f32x4*)(wf + 4 * i) = *(const f32x4*)(WFT + 4 * i); }
    __syncthreads();
    const int gw = F.vcu * NWAVES + F.wave;
    if (F.G * NWAVES * 8 != NTOK) return;
    const int row0 = gw * 8, b = row0 / SEQ;
    f32x4 gm[4], sh[4];
#pragma unroll
    for (int j = 0; j < 4; ++j) { const int k = 4 * F.lane + 256 * j; const f32x4 g = *(const f32x4*)(gpre + k), s = *(const f32x4*)(MOD + b * NMOD * DM + DM + k); gm[j] = g * (s + 1.0f); sh[j] = *(const f32x4*)(MOD + b * NMOD * DM + k); }
    f32x4 nx[4];
#pragma unroll
    for (int j = 0; j < 4; ++j) nx[j] = *(const f32x4*)(x + (size_t)row0 * DM + 4 * F.lane + 256 * j);
    for (int r = 0; r < 8; ++r) { const int row = row0 + r;
        f32x4 v[4]; float ss = 0.f;
#pragma unroll
        for (int j = 0; j < 4; ++j) { v[j] = nx[j]; ss += (v[j][0] * v[j][0] + v[j][1] * v[j][1]) + (v[j][2] * v[j][2] + v[j][3] * v[j][3]); }
        if (r < 7) {
#pragma unroll
            for (int j = 0; j < 4; ++j) nx[j] = *(const f32x4*)(x + (size_t)(row + 1) * DM + 4 * F.lane + 256 * j); }
        const float rinv = 1.0f / sqrtf(wave_sum(ss) * (1.0f / DM) + RMS_EPS);
        float fl[8];
#pragma unroll
        for (int h = 0; h < 8; ++h) fl[h] = 0.f;
#pragma unroll
        for (int j = 0; j < 4; ++j) { const f32x4 hv = v[j] * rinv * gm[j] + sh[j];
            v2u o; o.x = pk2(hv[0], hv[1]); o.y = pk2(hv[2], hv[3]); *(GAS v2u*)(H1 + (size_t)row * DM + 4 * F.lane + 256 * j) = o;
#pragma unroll
            for (int h = 0; h < 8; ++h) { const f32x4 w = *(const LAS f32x4*)(wf + h * DM + 4 * F.lane + 256 * j); fl[h] += (hv[0] * w[0] + hv[1] * w[1]) + (hv[2] * w[2] + hv[3] * w[3]); } }
#pragma unroll
        for (int h = 0; h < 8; ++h) fl[h] = wave_sum(fl[h]);
        if (F.lane < 8) { float f = fl[0];
#pragma unroll
            for (int h = 1; h < 8; ++h) f = (F.lane == h) ? fl[h] : f;
            LOGF2[(size_t)row * 8 + F.lane] = log_sigmoid_f(f + fb[F.lane]) * 1.4426950408889634f; }
    }
}

constexpr int LRU_XP = 1040;
constexpr int LRU_XT = 0, LRU_XC = 69696, LRU_CAR = 136256;
constexpr int CW_LRU = 131072;
static_assert(LRU_CAR + 2048 <= SCRATCH_BYTES && 67 * LRU_XP <= LRU_XC && LRU_XC + 64 * LRU_XP <= LRU_CAR, "LRU LDS map");
__device__ __forceinline__ float one_minus_exp(float x) { const float p = -x * (1.0f + x * (0.5f + x * (0.16666667f + x * (0.041666668f + x * (0.0083333338f + x * (0.0013888889f + x * 0.00019841270f)))))); const float d = 1.0f - __builtin_amdgcn_exp2f(1.4426950408889634f * x); return x > -0.25f ? p : d; }
__device__ __forceinline__ void lru_item(Frame& F, int b, int c) {
    LAS unsigned char* XT = F.lds + LRU_XT; LAS unsigned char* XC = F.lds + LRU_XC; LAS float* CAR = (LAS float*)(F.lds + LRU_CAR);
    const bf16* XL = (const bf16*)(F.ws + WS_PJ); const bf16* YL = XL + PJ_STRIDE; const bf16* LWT = (const bf16*)(F.ws + WS_LWT);
    float* LSUM = (float*)(F.ws + WS_LSUM); bf16* MRG = (bf16*)(F.ws + WS_MRG); unsigned* flags = (unsigned*)(F.ws + WS_CTL) + CW_LRU;
    const float* conv_w = F.in(7); const float* conv_b = F.in(8); const float* ba = F.in(10); const float* bx = F.in(12); const float* lam = F.in(13); const float* gn_lru = F.in(15);
    const int t0 = c * 64; const size_t rowb = (size_t)b * SEQ;
    { v4u xv[9];
#pragma unroll
      for (int q = 0; q < 9; ++q) { const int p = F.tid + q * (NWAVES * 64), i = p >> 6, c8 = p & 63, t = t0 - 3 + i; xv[q] = (v4u){0u, 0u, 0u, 0u};
          if (p < 67 * 64 && t >= 0) xv[q] = *(const GAS v4u*)(XL + (rowb + t) * 512 + c8 * 8); }
#pragma unroll
      for (int q = 0; q < 9; ++q) { const int p = F.tid + q * (NWAVES * 64), i = p >> 6, c8 = p & 63; if (p < 67 * 64) *(LAS v4u*)(XT + i * LRU_XP + c8 * 16) = xv[q]; } }
    v4u yv8[8];
#pragma unroll
    for (int q = 0; q < 8; ++q) { const int p = F.tid + q * (NWAVES * 64), i = p >> 6, c8 = p & 63; yv8[q] = *(const GAS v4u*)(YL + (rowb + t0 + i) * 512 + c8 * 8); }
    __syncthreads();
    { const int ch = F.tid; const float w0 = conv_w[ch], w1 = conv_w[512 + ch], w2 = conv_w[1024 + ch], w3 = conv_w[1536 + ch], cb = conv_b[ch];
      float xa = bf1(*(const LAS bf16*)(XT + 0 * LRU_XP + ch * 2)), xb = bf1(*(const LAS bf16*)(XT + 1 * LRU_XP + ch * 2)), xc = bf1(*(const LAS bf16*)(XT + 2 * LRU_XP + ch * 2));
#pragma unroll 8
      for (int t = 0; t < 64; ++t) { const float xd = bf1(*(const LAS bf16*)(XT + (t + 3) * LRU_XP + ch * 2)); const float v = ((w0 * xa + w1 * xb) + (w2 * xc + w3 * xd)) + cb;
          *(LAS bf16*)(XC + t * LRU_XP + ch * 2) = (bf16)f2bf(v); xa = xb; xb = xc; xc = xd; } }
    __syncthreads();
#pragma unroll
    for (int q = 0; q < 8; ++q) { const int p = F.tid + q * (NWAVES * 64), i = p >> 6, c8 = p & 63; *(LAS v4u*)(XT + i * LRU_XP + c8 * 16) = yv8[q]; }
    const int g = F.wave, l31 = F.lane & 31, hi = F.lane >> 5;
    __syncthreads();
#pragma unroll 1
    for (int hp = 0; hp < 2; ++hp) {
        const int chl = g * 64 + 32 * hp + l31;
        f32x16 cumA[2], hloc[2];
#pragma unroll
        for (int tg = 0; tg < 2; ++tg) { cumA[tg] = f32x16{}; hloc[tg] = f32x16{}; }
#pragma unroll
        for (int s = 0; s < 4; ++s) {
            const bf16x8 wa = *(const GAS bf16x8*)(LWT + ((size_t)((0 * 8 + g) * 64 + 32 * hp + l31)) * 64 + 16 * s + 8 * hi);
            const bf16x8 wx = *(const GAS bf16x8*)(LWT + ((size_t)((1 * 8 + g) * 64 + 32 * hp + l31)) * 64 + 16 * s + 8 * hi);
#pragma unroll
            for (int tg = 0; tg < 2; ++tg) { const bf16x8 bfr = *(const LAS bf16x8*)(XC + (32 * tg + l31) * LRU_XP + (g * 64 + 16 * s + 8 * hi) * 2);
                cumA[tg] = __builtin_amdgcn_mfma_f32_32x32x16_bf16(bfr, wa, cumA[tg], 0, 0, 0); hloc[tg] = __builtin_amdgcn_mfma_f32_32x32x16_bf16(bfr, wx, hloc[tg], 0, 0, 0); }
        }
        const float pba = ba[chl], pbx = bx[chl], psp = 8.0f * softplus_f(-lam[chl]);
        float cA = 1.0f, cB = 0.0f;
#pragma unroll
        for (int tg = 0; tg < 2; ++tg) {
            f32x16& A = cumA[tg]; f32x16& X = hloc[tg];
#pragma unroll
            for (int r = 0; r < 16; ++r) { const int tok = 32 * tg + (r & 3) + 8 * (r >> 2) + 4 * hi; const float xv = bf1(*(const LAS bf16*)(XC + tok * LRU_XP + chl * 2));
                const float rg = sigmoid_f(A[r] + pba), ig = sigmoid_f(X[r] + pbx); const float la = -rg * psp;
                A[r] = __builtin_amdgcn_exp2f(1.4426950408889634f * la); X[r] = __builtin_amdgcn_sqrtf(one_minus_exp(2.0f * la)) * (ig * xv); }
#pragma unroll
            for (int q = 0; q < 4; ++q)
#pragma unroll
                for (int i = 1; i < 4; ++i) { X[4 * q + i] = A[4 * q + i] * X[4 * q + i - 1] + X[4 * q + i]; A[4 * q + i] = A[4 * q + i] * A[4 * q + i - 1]; }
#pragma unroll
            for (int q2 = 0; q2 < 8; ++q2) { const int q = q2 >> 1; const bool own = (hi == (q2 & 1));
#pragma unroll
                for (int i = 0; i < 4; ++i) { const float nb = A[4 * q + i] * cB + X[4 * q + i], na = A[4 * q + i] * cA; X[4 * q + i] = own ? nb : X[4 * q + i]; A[4 * q + i] = own ? na : A[4 * q + i]; }
                const float ra = __shfl_xor(A[4 * q + 3], 32), rb = __shfl_xor(X[4 * q + 3], 32);
                cA = own ? A[4 * q + 3] : ra; cB = own ? X[4 * q + 3] : rb; }
        }
        if (hi == 0) { float* d0 = LSUM + (((size_t)b * 32 + c) * 2 + 0) * 512 + chl; __hip_atomic_store(d0, cA, __ATOMIC_RELAXED, __HIP_MEMORY_SCOPE_AGENT); __hip_atomic_store(d0 + 512, cB, __ATOMIC_RELAXED, __HIP_MEMORY_SCOPE_AGENT); }
        asm volatile("s_waitcnt vmcnt(0)" ::: "memory");
        __syncthreads();
        if (F.wave == 0) {
            if (F.lane == 0) __hip_atomic_store(flags + 64 * ((32 * b + c) * 2 + hp), 1u, __ATOMIC_RELAXED, __HIP_MEMORY_SCOPE_AGENT);
            unsigned sp = 0;
            for (;;) { const unsigned v = (F.lane < c) ? __hip_atomic_load(flags + 64 * ((32 * b + F.lane) * 2 + hp), __ATOMIC_RELAXED, __HIP_MEMORY_SCOPE_AGENT) : 1u;
                if (__all(v != 0u)) break; __builtin_amdgcn_s_sleep(1); if (++sp > (1u << 20)) break; }
        }
        __syncthreads();
        if (F.tid < 256) { const int ch = (F.tid >> 5) * 64 + 32 * hp + (F.tid & 31); float cr = 0.f; float* LS = LSUM + (size_t)b * 32 * 2 * 512 + ch;
          for (int c0 = 0; c0 < c; c0 += 32) { float A8[32], B8[32];
#pragma unroll
              for (int u = 0; u < 32; ++u) { const bool ok = (c0 + u) < c; A8[u] = 1.0f; B8[u] = 0.0f; if (ok) { A8[u] = __hip_atomic_load(LS + (size_t)(c0 + u) * 1024, __ATOMIC_RELAXED, __HIP_MEMORY_SCOPE_AGENT); B8[u] = __hip_atomic_load(LS + (size_t)(c0 + u) * 1024 + 512, __ATOMIC_RELAXED, __HIP_MEMORY_SCOPE_AGENT); } }
#pragma unroll
              for (int u = 0; u < 32; ++u) cr = A8[u] * cr + B8[u]; }
          CAR[ch] = cr; }
        __syncthreads();
        { const float cin = CAR[chl];
#pragma unroll
          for (int tg = 0; tg < 2; ++tg)
#pragma unroll
              for (int r = 0; r < 16; ++r) { const int tok = 32 * tg + (r & 3) + 8 * (r >> 2) + 4 * hi; LAS bf16* yp = (LAS bf16*)(XT + tok * LRU_XP + chl * 2);
                  const float h = hloc[tg][r] + cumA[tg][r] * cin; *yp = (bf16)f2bf(h * gelu_tanh_f(bf1(*yp))); } }
    }
    __syncthreads();
#pragma unroll 2
    for (int q = 0; q < 8; ++q) { const int i = F.wave + 8 * q, c8 = F.lane;
        const v4u w = *(const LAS v4u*)(XT + i * LRU_XP + c8 * 16);
        const float v0 = bflo(w.x), v1 = bfhi(w.x), v2 = bflo(w.y), v3 = bfhi(w.y), v4 = bflo(w.z), v5 = bfhi(w.z), v6 = bflo(w.w), v7 = bfhi(w.w);
        const float ss = wave_sum(((v0 * v0 + v1 * v1) + (v2 * v2 + v3 * v3)) + ((v4 * v4 + v5 * v5) + (v6 * v6 + v7 * v7)));
        const float rinv = 1.0f / sqrtf(ss * (1.0f / DLRU) + RMS_EPS);
        const f32x4 g0 = *(const f32x4*)(gn_lru + c8 * 8), g1 = *(const f32x4*)(gn_lru + c8 * 8 + 4);
        v4u o; o.x = pk2(v0 * rinv * g0[0], v1 * rinv * g0[1]); o.y = pk2(v2 * rinv * g0[2], v3 * rinv * g0[3]); o.z = pk2(v4 * rinv * g1[0], v5 * rinv * g1[1]); o.w = pk2(v6 * rinv * g1[2], v7 * rinv * g1[3]);
        *(GAS v4u*)(MRG + (rowb + t0 + i) * 1024 + 512 + c8 * 8) = o; }
    __syncthreads();
}
__device__ __forceinline__ void lru_phase(Frame& F) { for (int it = F.vcu; it < BATCH * 32; it += F.G) lru_item(F, it >> 5, it & 31); }

__device__ __forceinline__ void p6_phase(Frame& F) {
    const float* x = F.in(0); const float* gpost = F.in(5); const float* gffn = F.in(18); const float* b_router = F.in(21);
    const float* MOD = (const float*)(F.ws + WS_MOD); const bf16* Y = (const bf16*)(F.ws + WS_Y); unsigned char* H2 = (unsigned char*)(F.ws + WS_H2);
    int* TOPI = (int*)(F.ws + WS_TOPI); float* TOPW = (float*)(F.ws + WS_TOPW); int* WGCNT = (int*)(F.ws + WS_WGCNT);
    LAS float* wrl = (LAS float*)F.lds;
    LAS int* hist = (LAS int*)(F.lds + 131072);
    { const float* WRT = (const float*)(F.ws + WS_WRT);
#pragma unroll 4
      for (int i = F.tid; i < NE * DM / 4; i += NWAVES * 64) *(LAS f32x4*)(wrl + 4 * i) = *(const f32x4*)(WRT + 4 * i); }
    if (F.tid < NE) hist[F.tid] = 0;
    __syncthreads();
    if (F.G * 64 == NTOK) {
    const int bx = blockIdx.x, row0 = bx * 64 + F.wave * 8, b = row0 / SEQ;
    f32x4 gpm[4], gf[4], shf[4];
#pragma unroll
    for (int j = 0; j < 4; ++j) { const int k = 4 * F.lane + 256 * j; const float* mb = MOD + b * NMOD * DM + k;
        gpm[j] = *(const f32x4*)(mb + 2 * DM) * *(const f32x4*)(gpost + k); gf[j] = *(const f32x4*)(gffn + k) * (*(const f32x4*)(mb + 4 * DM) + 1.0f); shf[j] = *(const f32x4*)(mb + 3 * DM); }
    v2u ywn[2][4]; f32x4 xn[2][4];
#pragma unroll
    for (int u = 0; u < 2; ++u)
#pragma unroll
        for (int j = 0; j < 4; ++j) { ywn[u][j] = *(const GAS v2u*)(Y + (size_t)(row0 + u) * DM + 4 * F.lane + 256 * j); xn[u][j] = *(const f32x4*)(x + (size_t)(row0 + u) * DM + 4 * F.lane + 256 * j); }
    for (int rp = 0; rp < 4; ++rp) {
        f32x4 hv[2][4];
        v2u ywc[2][4]; f32x4 xc[2][4];
#pragma unroll
        for (int u = 0; u < 2; ++u)
#pragma unroll
            for (int j = 0; j < 4; ++j) { ywc[u][j] = ywn[u][j]; xc[u][j] = xn[u][j]; }
        if (rp < 3) {
#pragma unroll
            for (int u = 0; u < 2; ++u)
#pragma unroll
                for (int j = 0; j < 4; ++j) { ywn[u][j] = *(const GAS v2u*)(Y + (size_t)(row0 + 2 * rp + 2 + u) * DM + 4 * F.lane + 256 * j); xn[u][j] = *(const f32x4*)(x + (size_t)(row0 + 2 * rp + 2 + u) * DM + 4 * F.lane + 256 * j); } }
#pragma unroll
        for (int u = 0; u < 2; ++u) { const int row = row0 + 2 * rp + u;
            f32x4 yv[4]; float ss = 0.f;
#pragma unroll
            for (int j = 0; j < 4; ++j) { const v2u yw = ywc[u][j]; yv[j] = (f32x4){bflo(yw.x), bfhi(yw.x), bflo(yw.y), bfhi(yw.y)}; ss += (yv[j][0] * yv[j][0] + yv[j][1] * yv[j][1]) + (yv[j][2] * yv[j][2] + yv[j][3] * yv[j][3]); }
            const float rinv = 1.0f / sqrtf(wave_sum(ss) * (1.0f / DM) + RMS_EPS);
            float s2 = 0.f;
#pragma unroll
            for (int j = 0; j < 4; ++j) { const f32x4 xm = xc[u][j] + gpm[j] * (yv[j] * rinv);
                yv[j] = xm; s2 += (xm[0] * xm[0] + xm[1] * xm[1]) + (xm[2] * xm[2] + xm[3] * xm[3]); }
            const float rinv2 = 1.0f / sqrtf(wave_sum(s2) * (1.0f / DM) + RMS_EPS);
#pragma unroll
            for (int j = 0; j < 4; ++j) { const f32x4 h = yv[j] * rinv2 * gf[j] + shf[j]; hv[u][j] = h;
                int w8 = 0; w8 = __builtin_amdgcn_cvt_pk_fp8_f32(h[0], h[1], w8, false); w8 = __builtin_amdgcn_cvt_pk_fp8_f32(h[2], h[3], w8, true); *(GAS int*)(H2 + (size_t)row * DM + 4 * F.lane + 256 * j) = w8; }
        }
        float pa[32], pb[32];
#pragma unroll
        for (int e = 0; e < 32; ++e) { float sa = 0.f, sb = 0.f;
#pragma unroll
            for (int j = 0; j < 4; ++j) { const f32x4 w = *(const LAS f32x4*)(wrl + e * DM + 4 * F.lane + 256 * j);
                sa += (hv[0][j][0] * w[0] + hv[0][j][1] * w[1]) + (hv[0][j][2] * w[2] + hv[0][j][3] * w[3]); sb += (hv[1][j][0] * w[0] + hv[1][j][1] * w[1]) + (hv[1][j][2] * w[2] + hv[1][j][3] * w[3]); }
            pa[e] = sa; pb[e] = sb; }
#define TR_STEP(N, OFF, BIT) _Pragma("unroll") for (int i = 0; i < N; ++i) { const bool up = (F.lane & BIT) != 0; \
            const float ka = up ? pa[N + i] : pa[i], sa_ = up ? pa[i] : pa[N + i], kb = up ? pb[N + i] : pb[i], sb_ = up ? pb[i] : pb[N + i]; \
            pa[i] = ka + __shfl_xor(sa_, OFF); pb[i] = kb + __shfl_xor(sb_, OFF); }
        TR_STEP(16, 32, 32) TR_STEP(8, 16, 16) TR_STEP(4, 8, 8) TR_STEP(2, 4, 4) TR_STEP(1, 2, 2)
#undef TR_STEP
        const int e = (F.lane >> 1) & 31; const float br = b_router[e];
#pragma unroll
        for (int u = 0; u < 2; ++u) { const int row = row0 + 2 * rp + u; float v = (u ? pb[0] : pa[0]); v += __shfl_xor(v, 1); v += br;
            int rank = 0;
#pragma unroll
            for (int j = 0; j < 32; ++j) { const float vj = __uint_as_float((unsigned)__builtin_amdgcn_readlane((int)__float_as_uint(v), 2 * j)); rank += (vj > v || (vj == v && j < e)) ? 1 : 0; }
            const bool sel = rank < TOPK; const float vmax = wave_max(v); const float ex = sel ? __expf(v - vmax) : 0.f; const float den = wave_sum(ex) * 0.5f;
            if (sel && !(F.lane & 1)) { TOPI[(size_t)row * TOPK + rank] = e; TOPW[(size_t)row * TOPK + rank] = ex / den; __hip_atomic_fetch_add((LAS int*)&hist[e], 1, __ATOMIC_RELAXED, __HIP_MEMORY_SCOPE_WORKGROUP); } }
    }
    __syncthreads();
    if (F.tid < NE) WGCNT[bx * NE + F.tid] = hist[F.tid];
    }
}

__device__ __forceinline__ void p7_phase(Frame& F) {
    const int* TOPI = (const int*)(F.ws + WS_TOPI); const float* TOPW = (const float*)(F.ws + WS_TOPW); const int* WGCNT = (const int*)(F.ws + WS_WGCNT);
    int* ROWTOK = (int*)(F.ws + WS_ROWTOK); int* ROWPAIR = (int*)(F.ws + WS_ROWPAIR); float* ROWW = (float*)(F.ws + WS_ROWW); int* MTEXP = (int*)(F.ws + WS_MTEXP);
    LAS int* ptot = (LAS int*)F.lds; LAS int* pbef = ptot + 512; LAS int* cnt = pbef + 512; LAS int* wgb = cnt + 32; LAS int* pst = wgb + 32; LAS int* pad = pst + 64; LAS int* ep = pad + 32;
    if (F.G != 256) return;
    const int bx = blockIdx.x;
    { const int e = F.tid & 31, part = F.tid >> 5; int tt = 0, tb = 0;
      for (int w = part * 16; w < part * 16 + 16; ++w) { const int v = WGCNT[w * NE + e]; tt += v; tb += (w < bx) ? v : 0; }
      ptot[part * 32 + e] = tt; pbef[part * 32 + e] = tb; }
    __syncthreads();
    if (F.tid < NE) { int tt = 0, tb = 0; for (int p = 0; p < 16; ++p) { tt += ptot[p * 32 + F.tid]; tb += pbef[p * 32 + F.tid]; } cnt[F.tid] = tt; wgb[F.tid] = tb; pad[F.tid] = (tt + 255) & ~255; }
    __syncthreads();
    if (F.tid == 0) { int s = 0; for (int e = 0; e < NE; ++e) { pst[e] = s; s += pad[e]; } pst[NE] = s; }
    if (F.tid < 256) ep[F.tid] = TOPI[(size_t)bx * 256 + F.tid];
    __syncthreads();
    if (F.tid < 256) { const int p = F.tid, e = ep[p]; int rk = 0; for (int q = 0; q < p; ++q) rk += (ep[q] == e) ? 1 : 0;
        const int dest = pst[e] + wgb[e] + rk; const int pair = bx * 256 + p; ROWTOK[dest] = pair >> 2; ROWPAIR[dest] = pair; ROWW[dest] = TOPW[pair]; }
    if (bx < NE) { const int e = bx; for (int i = pst[e] + cnt[e] + F.tid; i < pst[e] + pad[e]; i += NWAVES * 64) { ROWTOK[i] = 0; ROWPAIR[i] = -1; ROWW[i] = 0.f; } }
    if (bx == 0) { if (F.tid < NE) { for (int mt = pst[F.tid] >> 8; mt < (pst[F.tid] + pad[F.tid]) >> 8; ++mt) MTEXP[mt] = F.tid; } if (F.tid == 0) MTEXP[512] = pst[NE] >> 8; }
}

__device__ __forceinline__ void p10_phase(Frame& F) {
    const float* x = F.in(0); const float* gpostm = F.in(5); const float* gpost = F.in(19); const float* MOD = (const float*)(F.ws + WS_MOD);
    const unsigned char* YP = (const unsigned char*)(F.ws + WS_YP); const bf16* Y = (const bf16*)(F.ws + WS_Y);
    const int gw = F.vcu * NWAVES + F.wave;
    if (F.G * NWAVES * 8 != NTOK) return;
    const int row0 = gw * 8, b = row0 / SEQ;
    f32x4 gg[4], gpm[4];
#pragma unroll
    for (int j = 0; j < 4; ++j) { const int k = 4 * F.lane + 256 * j; gg[j] = *(const f32x4*)(MOD + b * NMOD * DM + 5 * DM + k) * *(const f32x4*)(gpost + k); gpm[j] = *(const f32x4*)(MOD + b * NMOD * DM + 2 * DM + k) * *(const f32x4*)(gpostm + k); }
    int nw[4][TOPK]; v2u ny[4]; f32x4 nx[4];
#pragma unroll
    for (int j = 0; j < 4; ++j) { ny[j] = *(const GAS v2u*)(Y + (size_t)row0 * DM + 4 * F.lane + 256 * j); nx[j] = *(const f32x4*)(x + (size_t)row0 * DM + 4 * F.lane + 256 * j);
#pragma unroll
        for (int k = 0; k < TOPK; ++k) nw[j][k] = *(const GAS int*)(YP + ((size_t)row0 * TOPK + k) * DM + 4 * F.lane + 256 * j); }
    for (int r = 0; r < 8; ++r) { const int row = row0 + r;
        f32x4 y[4], ym[4], xr[4]; float ss = 0.f, sm = 0.f;
#pragma unroll
        for (int j = 0; j < 4; ++j) { f32x4 s = (f32x4){0.f, 0.f, 0.f, 0.f};
#pragma unroll
            for (int k = 0; k < TOPK; ++k) { const int w = nw[j][k]; s += (f32x4){__builtin_amdgcn_cvt_f32_fp8(w, 0), __builtin_amdgcn_cvt_f32_fp8(w, 1), __builtin_amdgcn_cvt_f32_fp8(w, 2), __builtin_amdgcn_cvt_f32_fp8(w, 3)}; }
            y[j] = s; ss += (s[0] * s[0] + s[1] * s[1]) + (s[2] * s[2] + s[3] * s[3]);
            const v2u yw = ny[j]; const f32x4 m = (f32x4){bflo(yw.x), bfhi(yw.x), bflo(yw.y), bfhi(yw.y)}; ym[j] = m; sm += (m[0] * m[0] + m[1] * m[1]) + (m[2] * m[2] + m[3] * m[3]); xr[j] = nx[j]; }
        if (r < 7) {
#pragma unroll
            for (int j = 0; j < 4; ++j) { ny[j] = *(const GAS v2u*)(Y + (size_t)(row + 1) * DM + 4 * F.lane + 256 * j); nx[j] = *(const f32x4*)(x + (size_t)(row + 1) * DM + 4 * F.lane + 256 * j);
#pragma unroll
                for (int k = 0; k < TOPK; ++k) nw[j][k] = *(const GAS int*)(YP + ((size_t)(row + 1) * TOPK + k) * DM + 4 * F.lane + 256 * j); } }
        const float rinv = 1.0f / sqrtf(wave_sum(ss) * (1.0f / DM) + RMS_EPS * 16.0f), rinvm = 1.0f / sqrtf(wave_sum(sm) * (1.0f / DM) + RMS_EPS);
#pragma unroll
        for (int j = 0; j < 4; ++j) *(f32x4*)(F.out + (size_t)row * DM + 4 * F.lane + 256 * j) = (xr[j] + gpm[j] * (ym[j] * rinvm)) + gg[j] * (y[j] * rinv);
    }
}

__global__ void __launch_bounds__(NWAVES * 64, 2) mega_fwd(Args args) {
    extern __shared__ __attribute__((aligned(16))) unsigned char lds[];
    Frame F;
    F.lds = (LAS unsigned char*)lds;
    F.tid = threadIdx.x; F.lane = F.tid & 63; F.wave = __builtin_amdgcn_readfirstlane(F.tid >> 6);
    F.G = gridDim.x; { const int bx = blockIdx.x; F.vcu = (F.G % 8 == 0) ? (bx % 8) * (F.G / 8) + bx / 8 : bx; }
    F.out = args.out; F.ws = args.ws;
    volatile LAS unsigned* MISC = (volatile LAS unsigned*)(F.lds + MISC_OFF);
    for (int u = F.tid; u < (LDS_BYTES - LDSCTL_OFF) / 4; u += NWAVES * 64) ((LAS unsigned*)(F.lds + LDSCTL_OFF))[u] = 0u;
    __syncthreads();
    if (F.tid < 26) ((LAS unsigned long long*)(F.lds + LDSCTL_OFF))[F.tid] = (unsigned long long)args.in[F.tid];
    __syncthreads();
    gu32* ctl = (gu32*)(F.ws + WS_CTL);
    XcdBarrier bar = xcd_barrier_post((unsigned*)(ctl + CW_BAR) + args.li * XCD_BAR_WORDS, MISC + 8);
    const int lo = args.ph_lo, hi = args.ph_hi;
#ifndef PHMASK
#define PHMASK 0x7ff
#endif
#define IN(k) (((PHMASK >> (k)) & 1) && lo <= (k) && (k) < hi)
#ifndef REPMASK
#define REPMASK 0
#endif
#define NREP(k) (((REPMASK >> (k)) & 1) ? 2 : 1)
#define SEAM(k) do { if ((k) != 3 && IN(k) && IN((k) + 1)) xcd_barrier(bar); if ((k) == 3 && IN(3) && IN(5)) xcd_barrier(bar); } while (0)
#define REFRESH() do { int t_; asm volatile("v_mov_b32 %0, %1" : "=v"(t_) : "v"(threadIdx.x)); F.tid = t_; F.lane = t_ & 63; } while (0)
    if (IN(0)) { { REFRESH(); p0_phase(F);  }
      if (NREP(0) > 1) { xcd_barrier(bar); REFRESH(); p0_phase(F);  } } SEAM(0);

    if (IN(1)) { { REFRESH(); p1_phase(F);  }
      if (NREP(1) > 1) { xcd_barrier(bar); REFRESH(); p1_phase(F);  } } SEAM(1);

    if (IN(2)) { { REFRESH();
        pg8::DenseOrder S; S.init((const pg8::bf16_t*)(F.ws + WS_H1), (const pg8::bf16_t*)(F.ws + WS_WIN), NTOK, NPJ, F.G, (int)blockIdx.x);
        pg8::EpiProj E{(pg8::bf16_t*)(F.ws + WS_PJ), PJ_STRIDE, attn_body::C2};
        pg8::gemm_phase<pg8::EpiProj, pg8::DenseOrder>(F.lds, S, E);
        if (F.G == 256 && blockIdx.x >= 128) { REFRESH(); cvt_range<true>(F, 0, CV_UP_TAIL, ((int)blockIdx.x - 128) * NWAVES + F.wave, 128 * NWAVES); } }
      if (NREP(2) > 1) { xcd_barrier(bar); REFRESH();
        pg8::DenseOrder S; S.init((const pg8::bf16_t*)(F.ws + WS_H1), (const pg8::bf16_t*)(F.ws + WS_WIN), NTOK, NPJ, F.G, (int)blockIdx.x);
        pg8::EpiProj E{(pg8::bf16_t*)(F.ws + WS_PJ), PJ_STRIDE, attn_body::C2};
        pg8::gemm_phase<pg8::EpiProj, pg8::DenseOrder>(F.lds, S, E);
        if (F.G == 256 && blockIdx.x >= 128) { REFRESH(); cvt_range<true>(F, 0, CV_UP_TAIL, ((int)blockIdx.x - 128) * NWAVES + F.wave, 128 * NWAVES); } }     } SEAM(2);

    if (IN(3)) { { REFRESH();
        lru_phase(F);
        const attn_body::AttnTensors AT{(const attn_body::bf16*)(F.ws + WS_PJ) + 2 * PJ_STRIDE, (const attn_body::bf16*)(F.ws + WS_PJ) + 3 * PJ_STRIDE, (const attn_body::bf16*)(F.ws + WS_PJ) + 4 * PJ_STRIDE,
                                        (attn_body::bf16*)(F.ws + WS_MRG), (const float*)(F.ws + WS_LOGF2), (float*)(F.ws + WS_SSQ)};
        const attn_body::StaticOrder S((int)F.G, F.vcu);
        attn_body::attn_phase<attn_body::StaticOrder>((char*)lds, AT, S); }
      if (NREP(3) > 1) { xcd_barrier(bar); REFRESH();
        lru_phase(F);
        const attn_body::AttnTensors AT{(const attn_body::bf16*)(F.ws + WS_PJ) + 2 * PJ_STRIDE, (const attn_body::bf16*)(F.ws + WS_PJ) + 3 * PJ_STRIDE, (const attn_body::bf16*)(F.ws + WS_PJ) + 4 * PJ_STRIDE,
                                        (attn_body::bf16*)(F.ws + WS_MRG), (const float*)(F.ws + WS_LOGF2), (float*)(F.ws + WS_SSQ)};
        const attn_body::StaticOrder S((int)F.G, F.vcu);
        attn_body::attn_phase<attn_body::StaticOrder>((char*)lds, AT, S); } } SEAM(3);


    if (IN(5)) { { REFRESH();
        pg8::DenseOrder S; S.init((const pg8::bf16_t*)(F.ws + WS_MRG), (const pg8::bf16_t*)(F.ws + WS_WOUT), NTOK, DM, F.G, (int)blockIdx.x);
        pg8::EpiOut E{(pg8::bf16_t*)(F.ws + WS_Y), (const float*)(F.ws + WS_SSQ)};
        pg8::gemm_phase<pg8::EpiOut, pg8::DenseOrder>(F.lds, S, E); }
      if (NREP(5) > 1) { xcd_barrier(bar); REFRESH();
        pg8::DenseOrder S; S.init((const pg8::bf16_t*)(F.ws + WS_MRG), (const pg8::bf16_t*)(F.ws + WS_WOUT), NTOK, DM, F.G, (int)blockIdx.x);
        pg8::EpiOut E{(pg8::bf16_t*)(F.ws + WS_Y), (const float*)(F.ws + WS_SSQ)};
        pg8::gemm_phase<pg8::EpiOut, pg8::DenseOrder>(F.lds, S, E); } } SEAM(5);

    if (IN(6)) { { REFRESH(); p6_phase(F);  }
      if (NREP(6) > 1) { xcd_barrier(bar); REFRESH(); p6_phase(F);  } } SEAM(6);

    if (IN(7)) { { REFRESH(); p7_phase(F);  }
      if (NREP(7) > 1) { xcd_barrier(bar); REFRESH(); p7_phase(F);  } } SEAM(7);

    if (IN(8)) { { REFRESH();
        const int nmt = ((const int*)(F.ws + WS_MTEXP))[512];
        pg8::UpOrder S{(const unsigned char*)(F.ws + WS_H2), (const unsigned char*)(F.ws + WS_WUP), (const int*)(F.ws + WS_ROWTOK), (const int*)(F.ws + WS_MTEXP), nmt * 8, F.G, F.vcu};
        pg8::EpiUp E{(unsigned char*)(F.ws + WS_ACT), F.in(23)};
        pg8::gemm_phase<pg8::EpiUp, pg8::UpOrder, true>(F.lds, S, E);
        if (F.G == 256) {
            const int units = nmt * 8, maxu = (units + 255) >> 8, nfull = units - (maxu - 1) * 256, nidle = 256 - nfull;
            REFRESH();
            if (nidle >= 32) { if (F.vcu >= nfull) cvt_range<false>(F, 0, CV_DN_TAIL, (F.vcu - nfull) * NWAVES + F.wave, nidle * NWAVES); }
            else cvt_range<false>(F, 0, CV_DN_TAIL, F.vcu * NWAVES + F.wave, 256 * NWAVES); } }
      if (NREP(8) > 1) { xcd_barrier(bar); REFRESH();
        const int nmt = ((const int*)(F.ws + WS_MTEXP))[512];
        pg8::UpOrder S{(const unsigned char*)(F.ws + WS_H2), (const unsigned char*)(F.ws + WS_WUP), (const int*)(F.ws + WS_ROWTOK), (const int*)(F.ws + WS_MTEXP), nmt * 8, F.G, F.vcu};
        pg8::EpiUp E{(unsigned char*)(F.ws + WS_ACT), F.in(23)};
        pg8::gemm_phase<pg8::EpiUp, pg8::UpOrder, true>(F.lds, S, E);
        if (F.G == 256) {
            const int units = nmt * 8, maxu = (units + 255) >> 8, nfull = units - (maxu - 1) * 256, nidle = 256 - nfull;
            REFRESH();
            if (nidle >= 32) { if (F.vcu >= nfull) cvt_range<false>(F, 0, CV_DN_TAIL, (F.vcu - nfull) * NWAVES + F.wave, nidle * NWAVES); }
            else cvt_range<false>(F, 0, CV_DN_TAIL, F.vcu * NWAVES + F.wave, 256 * NWAVES); } } } SEAM(8);

    if (IN(9)) { { REFRESH();
        const int nmt = ((const int*)(F.ws + WS_MTEXP))[512];
        pg8::DownOrder S{(const unsigned char*)(F.ws + WS_ACT), (const unsigned char*)(F.ws + WS_WDN), (const int*)(F.ws + WS_MTEXP), nmt * 4, F.G, F.vcu};
        pg8::EpiDown E{(unsigned char*)(F.ws + WS_YP), F.in(25), (const int*)(F.ws + WS_ROWPAIR), (const float*)(F.ws + WS_ROWW)};
        pg8::gemm_phase<pg8::EpiDown, pg8::DownOrder, true>(F.lds, S, E); }
      if (NREP(9) > 1) { xcd_barrier(bar); REFRESH();
        const int nmt = ((const int*)(F.ws + WS_MTEXP))[512];
        pg8::DownOrder S{(const unsigned char*)(F.ws + WS_ACT), (const unsigned char*)(F.ws + WS_WDN), (const int*)(F.ws + WS_MTEXP), nmt * 4, F.G, F.vcu};
        pg8::EpiDown E{(unsigned char*)(F.ws + WS_YP), F.in(25), (const int*)(F.ws + WS_ROWPAIR), (const float*)(F.ws + WS_ROWW)};
        pg8::gemm_phase<pg8::EpiDown, pg8::DownOrder, true>(F.lds, S, E); } } SEAM(9);

    if (IN(10)) { { REFRESH(); p10_phase(F);  }
      if (NREP(10) > 1) { xcd_barrier(bar); REFRESH(); p10_phase(F);  } }
    if (lo == 11) { REFRESH(); lru_phase(F); }
    if (lo == 17) { for (int i = 0; i < 10; ++i) xcd_barrier(bar); }
    if (lo == 18 || lo == 19) { REFRESH();
        const int nmt = ((const int*)(F.ws + WS_MTEXP))[512];
        pg8::DownOrder S{(const unsigned char*)(F.ws + WS_ACT), (const unsigned char*)(F.ws + WS_WDN), (const int*)(F.ws + WS_MTEXP), nmt * 4, F.G, F.vcu};
        if (lo == 18) { pg8::EpiDown E{(unsigned char*)(F.ws + WS_H1), F.in(25), (const int*)(F.ws + WS_ROWPAIR), (const float*)(F.ws + WS_ROWW)}; pg8::gemm_phase<pg8::EpiDown, pg8::DownOrder, true>(F.lds, S, E); }
        else { pg8::EpiDownDense E{(pg8::bf16_t*)(F.ws + WS_H1), F.in(25)}; pg8::gemm_phase<pg8::EpiDownDense, pg8::DownOrder, true>(F.lds, S, E); } }
    if (lo == 20 || lo == 21) { REFRESH();
        pg8::DenseOrder S; S.init((const pg8::bf16_t*)(F.ws + WS_H1), (const pg8::bf16_t*)(F.ws + WS_WIN), NTOK, NPJ, F.G, (int)blockIdx.x);
        pg8::EpiProj E{(pg8::bf16_t*)(F.ws + WS_ACT), PJ_STRIDE, attn_body::C2};
        if (lo == 20) pg8::gemm_phase<pg8::EpiProj, pg8::DenseOrder, false, 1>(F.lds, S, E); else pg8::gemm_phase<pg8::EpiProj, pg8::DenseOrder, false, 2>(F.lds, S, E); }
    if (lo == 22 || lo == 23) { REFRESH();
        const int nmt = ((const int*)(F.ws + WS_MTEXP))[512];
        pg8::UpOrder S{(const unsigned char*)(F.ws + WS_H2), (const unsigned char*)(F.ws + WS_WUP), (const int*)(F.ws + WS_ROWTOK), (const int*)(F.ws + WS_MTEXP), nmt * 8, F.G, F.vcu};
        pg8::EpiUp E{(unsigned char*)(F.ws + WS_H1), F.in(23)};
        if (lo == 22) pg8::gemm_phase<pg8::EpiUp, pg8::UpOrder, true, 1>(F.lds, S, E); else pg8::gemm_phase<pg8::EpiUp, pg8::UpOrder, true, 2>(F.lds, S, E); }
    if (lo == 25) { REFRESH();
        if (blockIdx.x & 1) { for (int i = 0; i < 4; ++i) __builtin_amdgcn_s_sleep(127); }
        pg8::DenseOrder S; S.init((const pg8::bf16_t*)(F.ws + WS_H1), (const pg8::bf16_t*)(F.ws + WS_WIN), NTOK, NPJ, F.G, (int)blockIdx.x);
        pg8::EpiProj E{(pg8::bf16_t*)(F.ws + WS_ACT), PJ_STRIDE, attn_body::C2};
        pg8::gemm_phase<pg8::EpiProj, pg8::DenseOrder, false, 1>(F.lds, S, E); }
    if (lo == 24) { REFRESH();
        pg8::DenseOrder S; S.init((const pg8::bf16_t*)(F.ws + WS_H1), (const pg8::bf16_t*)(F.ws + WS_WIN), NTOK, NPJ, F.G, (int)blockIdx.x);
        pg8::EpiProjNoStore E{}; pg8::gemm_phase<pg8::EpiProjNoStore, pg8::DenseOrder, false, 1>(F.lds, S, E); }
    if (lo == 14) { REFRESH(); p0_phase<1>(F); }
    if (lo == 15) { REFRESH(); p0_phase<2>(F); }
    if (lo == 16) { REFRESH(); p0_phase<4>(F); }
    if (lo == 12) { REFRESH();
        const attn_body::AttnTensors AT{(const attn_body::bf16*)(F.ws + WS_PJ) + 2 * PJ_STRIDE, (const attn_body::bf16*)(F.ws + WS_PJ) + 3 * PJ_STRIDE, (const attn_body::bf16*)(F.ws + WS_PJ) + 4 * PJ_STRIDE,
                                        (attn_body::bf16*)(F.ws + WS_MRG), (const float*)(F.ws + WS_LOGF2), (float*)(F.ws + WS_SSQ)};
        const attn_body::StaticOrder S((int)F.G, F.vcu);
        attn_body::attn_phase<attn_body::StaticOrder>((char*)lds, AT, S); }
#undef IN
#undef SEAM
#undef REFRESH
}

static void launch_mega(hipStream_t stream, void* const* d_in, void* d_out, void* d_ws, int lo, int hi, int li, int grid) {
    Args a{};
    for (int i = 0; i < 26; ++i) a.in[i] = (const float*)d_in[i];
    a.out = (float*)d_out; a.ws = (unsigned char*)d_ws; a.ph_lo = lo; a.ph_hi = hi; a.li = li; a.pad = 0;
    hipLaunchKernelGGL(mega_fwd, dim3(grid), dim3(NWAVES * 64), LDS_BYTES, stream, a);
}

#if MIX < 4
namespace simple {
__device__ __forceinline__ float sigmoidf_(float x) { return 1.f / (1.f + __expf(-x)); }
__device__ __forceinline__ float gelu_tanh(float x) { const float u = 0.7978845608028654f * (x + 0.044715f * x * x * x); return 0.5f * x * (1.f + tanhf(u)); }
__device__ __forceinline__ float log_sigmoid(float z) { return z >= 0.f ? -log1pf(expf(-z)) : z - log1pf(expf(z)); }
__device__ __forceinline__ float softplusf_(float z) { return z > 0.f ? z + log1pf(expf(-z)) : log1pf(expf(z)); }

__device__ __forceinline__ float block_sum_256(float v, float* red) {
    for (int o = 32; o > 0; o >>= 1) v += __shfl_xor(v, o);
    const int w = threadIdx.x >> 6, l = threadIdx.x & 63;
    __syncthreads();
    if (l == 0) red[w] = v;
    __syncthreads();
    return red[0] + red[1] + red[2] + red[3];
}

__global__ void k_ada(const float* c, const float* w_ada, const float* b_ada, float* mod) {
    const int j = blockIdx.x * 256 + threadIdx.x, b = blockIdx.y;
    float acc = b_ada[j];
    for (int k = 0; k < DM; ++k) { const float cv = c[b * DM + k]; acc += cv * sigmoidf_(cv) * w_ada[(size_t)k * (NMOD * DM) + j]; }
    mod[b * NMOD * DM + j] = acc;
}

__global__ void k_prep(const float* x, const float* g, const float* mod, int sh_off, int sc_off, float* h) {
    __shared__ float red[4];
    const int row = blockIdx.x, b = row / SEQ;
    const float* xr = x + (size_t)row * DM;
    float v[4], s = 0.f;
#pragma unroll
    for (int i = 0; i < 4; ++i) { v[i] = xr[threadIdx.x + 256 * i]; s += v[i] * v[i]; }
    const float tot = block_sum_256(s, red);
    const float rinv = rsqrtf(tot / DM + RMS_EPS);
#pragma unroll
    for (int i = 0; i < 4; ++i) { const int k = threadIdx.x + 256 * i;
        h[(size_t)row * DM + k] = v[i] * rinv * g[k] * (1.f + mod[b * NMOD * DM + sc_off + k]) + mod[b * NMOD * DM + sh_off + k]; }
}

struct GemmArgs { const float* A; const float* B; float* C; const float* bias; const int* rowidx; const int* Mptr; int M, N, K, lda, ldb, ldc;
                  size_t gB, gC, gbias; int gidx; };
__global__ void __launch_bounds__(256) k_sgemm(GemmArgs a) {
    __shared__ float As[8][128 + 4], Bs[8][128 + 4];
    const int z = blockIdx.z;
    const float* B = a.B + z * a.gB; float* C = a.C + z * a.gC; const float* bias = a.bias ? a.bias + z * a.gbias : nullptr;
    const int* rowidx = a.rowidx ? a.rowidx + (size_t)z * a.gidx : nullptr;
    const int M = a.Mptr ? a.Mptr[z] : a.M;
    const int m0 = blockIdx.y * 128, n0 = blockIdx.x * 128;
    if (m0 >= M) return;
    const int tid = threadIdx.x, tx = tid & 15, ty = tid >> 4;
    float acc[8][8];
#pragma unroll
    for (int i = 0; i < 8; ++i)
#pragma unroll
        for (int j = 0; j < 8; ++j) acc[i][j] = 0.f;
    const int ar = tid >> 1, ak = (tid & 1) * 4;
    const int am = m0 + ar; const bool aok = am < M;
    const int arow = aok ? (rowidx ? rowidx[am] : am) : 0;
    const float* Ap = a.A + (size_t)arow * a.lda + ak;
    const int bk = tid >> 5, bn = (tid & 31) * 4;
    for (int k0 = 0; k0 < a.K; k0 += 8) {
        float4 av = aok ? *(const float4*)(Ap + k0) : make_float4(0.f, 0.f, 0.f, 0.f);
        float bv[4];
#pragma unroll
        for (int j = 0; j < 4; ++j) { const int n = n0 + bn + j; bv[j] = n < a.N ? B[(size_t)(k0 + bk) * a.ldb + n] : 0.f; }
        __syncthreads();
        As[ak + 0][ar] = av.x; As[ak + 1][ar] = av.y; As[ak + 2][ar] = av.z; As[ak + 3][ar] = av.w;
#pragma unroll
        for (int j = 0; j < 4; ++j) Bs[bk][bn + j] = bv[j];
        __syncthreads();
#pragma unroll
        for (int k = 0; k < 8; ++k) {
            float af[8], bf[8];
#pragma unroll
            for (int i = 0; i < 8; ++i) af[i] = As[k][ty * 8 + i];
#pragma unroll
            for (int j = 0; j < 8; ++j) bf[j] = Bs[k][tx * 8 + j];
#pragma unroll
            for (int i = 0; i < 8; ++i)
#pragma unroll
                for (int j = 0; j < 8; ++j) acc[i][j] += af[i] * bf[j];
        }
    }
#pragma unroll
    for (int i = 0; i < 8; ++i) { const int m = m0 + ty * 8 + i; if (m >= M) continue;
#pragma unroll
        for (int j = 0; j < 8; ++j) { const int n = n0 + tx * 8 + j; if (n < a.N) C[(size_t)m * a.ldc + n] = acc[i][j] + (bias ? bias[n] : 0.f); } }
}

__global__ void __launch_bounds__(64) k_lru(const float* proj, const float* conv_w, const float* conv_b, const float* wa, const float* ba, const float* wx, const float* bx,
                                            const float* lam, float* lru_out) {
    __shared__ float xc[64];
    const int b = blockIdx.x >> 3, g = blockIdx.x & 7, j = threadIdx.x, ch = g * 64 + j;
    float wac[64], wxc[64];
#pragma unroll
    for (int i = 0; i < 64; ++i) { wac[i] = wa[(g * 64 + i) * 64 + j]; wxc[i] = wx[(g * 64 + i) * 64 + j]; }
    const float cw0 = conv_w[0 * DLRU + ch], cw1 = conv_w[1 * DLRU + ch], cw2 = conv_w[2 * DLRU + ch], cw3 = conv_w[3 * DLRU + ch], cb = conv_b[ch];
    const float baj = ba[ch], bxj = bx[ch], sp = softplusf_(-lam[ch]);
    float x1 = 0.f, x2 = 0.f, x3 = 0.f, h = 0.f;
    for (int t = 0; t < SEQ; ++t) {
        const size_t row = (size_t)b * SEQ + t;
        const float x0 = proj[row * NPROJ + ch];
        const float y = proj[row * NPROJ + DLRU + ch];
        const float xcv = cw0 * x3 + cw1 * x2 + cw2 * x1 + cw3 * x0 + cb;
        x3 = x2; x2 = x1; x1 = x0;
        __syncthreads();
        xc[j] = xcv;
        __syncthreads();
        float ra = baj, ri = bxj;
#pragma unroll
        for (int i = 0; i < 64; ++i) { const float xi = xc[i]; ra += xi * wac[i]; ri += xi * wxc[i]; }
        const float r = sigmoidf_(ra), ig = sigmoidf_(ri);
        const float log_a = -8.0f * r * sp;
        const float av = expf(log_a);
        const float gx = sqrtf(1.f - expf(2.f * log_a)) * (ig * xcv);
        h = av * h + gx;
        lru_out[row * DLRU + ch] = h * gelu_tanh(y);
    }
}

__global__ void k_cum(const float* proj, const float* fb, float* cum) {
    const int b = blockIdx.x, h = threadIdx.x;
    float c = 0.f;
    for (int t = 0; t < SEQ; ++t) { c += log_sigmoid(proj[((size_t)b * SEQ + t) * NPROJ + 2 * DLRU + 3 * DATT + h] + fb[h]); cum[((size_t)b * NH + h) * SEQ + t] = c; }
}
__global__ void __launch_bounds__(256) k_attn(const float* proj, const float* cum, float* attn_out) {
    __shared__ float Ks[64][64], Vs[64][64], Cs[64];
    const int qb = blockIdx.x, h = blockIdx.y, b = blockIdx.z, t = qb * 256 + threadIdx.x;
    const size_t rowq = (size_t)b * SEQ + t;
    float q[64], acc[64];
#pragma unroll
    for (int d = 0; d < 64; ++d) { q[d] = proj[rowq * NPROJ + 2 * DLRU + h * 64 + d] * 0.125f; acc[d] = 0.f; }
    const float ct = cum[((size_t)b * NH + h) * SEQ + t];
    float m = -INFINITY, l = 0.f;
    const int send = qb * 256 + 256;
    for (int s0 = 0; s0 < send; s0 += 64) {
        __syncthreads();
        for (int i = threadIdx.x; i < 64 * 64; i += 256) { const int r = i >> 6, d = i & 63; const size_t rk = (size_t)b * SEQ + s0 + r;
            Ks[r][d] = proj[rk * NPROJ + 2 * DLRU + DATT + h * 64 + d]; Vs[r][d] = proj[rk * NPROJ + 2 * DLRU + 2 * DATT + h * 64 + d]; }
        if (threadIdx.x < 64) Cs[threadIdx.x] = cum[((size_t)b * NH + h) * SEQ + s0 + threadIdx.x];
        __syncthreads();
        for (int r = 0; r < 64; ++r) {
            const int s = s0 + r; if (s > t) break;
            float dot = 0.f;
#pragma unroll
            for (int d = 0; d < 64; ++d) dot += q[d] * Ks[r][d];
            const float lg = dot + ct - Cs[r];
            const float mn = fmaxf(m, lg), sc = expf(m - mn), p = expf(lg - mn);
            l = l * sc + p;
#pragma unroll
            for (int d = 0; d < 64; ++d) acc[d] = acc[d] * sc + p * Vs[r][d];
            m = mn;
        }
    }
    const float li = 1.f / l;
#pragma unroll
    for (int d = 0; d < 64; ++d) attn_out[rowq * DATT + h * 64 + d] = acc[d] * li;
}

__global__ void k_merge(const float* lru_out, const float* attn_out, const float* gn_lru, const float* gn_attn, float* merged) {
    __shared__ float red[4];
    const int row = blockIdx.x, tid = threadIdx.x;
    const float a0 = lru_out[(size_t)row * DLRU + tid], a1 = lru_out[(size_t)row * DLRU + 256 + tid];
    const float b0 = attn_out[(size_t)row * DATT + tid], b1 = attn_out[(size_t)row * DATT + 256 + tid];
    const float sa = block_sum_256(a0 * a0 + a1 * a1, red);
    const float sb = block_sum_256(b0 * b0 + b1 * b1, red);
    const float ra = rsqrtf(sa / DLRU + RMS_EPS), rb = rsqrtf(sb / DATT + RMS_EPS);
    float* o = merged + (size_t)row * DM;
    o[tid] = a0 * ra * gn_lru[tid]; o[256 + tid] = a1 * ra * gn_lru[256 + tid];
    o[512 + tid] = b0 * rb * gn_attn[tid]; o[768 + tid] = b1 * rb * gn_attn[256 + tid];
}

__global__ void k_resid(const float* xin, const float* y, const float* gpost, const float* mod, int gate_off, float* xo) {
    __shared__ float red[4];
    const int row = blockIdx.x, b = row / SEQ;
    float v[4], s = 0.f;
#pragma unroll
    for (int i = 0; i < 4; ++i) { v[i] = y[(size_t)row * DM + threadIdx.x + 256 * i]; s += v[i] * v[i]; }
    const float rinv = rsqrtf(block_sum_256(s, red) / DM + RMS_EPS);
#pragma unroll
    for (int i = 0; i < 4; ++i) { const int k = threadIdx.x + 256 * i;
        xo[(size_t)row * DM + k] = xin[(size_t)row * DM + k] + mod[b * NMOD * DM + gate_off + k] * (v[i] * rinv * gpost[k]); }
}

__global__ void k_route(const float* logits, int* cnt, int* list_tok, int* list_pair, float* pair_w) {
    const int tok = blockIdx.x * 256 + threadIdx.x;
    float lg[NE];
#pragma unroll
    for (int e = 0; e < NE; ++e) lg[e] = logits[(size_t)tok * NE + e];
    int idx[TOPK]; float val[TOPK];
#pragma unroll
    for (int k = 0; k < TOPK; ++k) { int bi = 0; float bv = -INFINITY;
#pragma unroll
        for (int e = 0; e < NE; ++e) { if (lg[e] > bv) { bv = lg[e]; bi = e; } }
        idx[k] = bi; val[k] = bv;
#pragma unroll
        for (int e = 0; e < NE; ++e) if (e == bi) lg[e] = -INFINITY; }
    float den = 0.f; float p[TOPK];
#pragma unroll
    for (int k = 0; k < TOPK; ++k) { p[k] = expf(val[k] - val[0]); den += p[k]; }
#pragma unroll
    for (int k = 0; k < TOPK; ++k) { const int e = idx[k]; const int pos = atomicAdd(&cnt[e], 1);
        list_tok[(size_t)e * NTOK + pos] = tok; list_pair[(size_t)e * NTOK + pos] = tok * TOPK + k; pair_w[tok * TOPK + k] = p[k] / den; }
}
__global__ void k_act(const float* gu, const int* cnt, float* act) {
    const int e = blockIdx.z, pos = blockIdx.y; if (pos >= cnt[e]) return;
    const size_t r = (size_t)e * NTOK + pos;
    for (int j = threadIdx.x; j < DEXP; j += 256) { const float gl = fminf(gu[r * 2 * DEXP + j], 7.f); const float li = fminf(fmaxf(gu[r * 2 * DEXP + DEXP + j], -7.f), 7.f);
        act[r * DEXP + j] = gl * sigmoidf_(1.702f * gl) * (li + 1.f); }
}
__global__ void k_scatter(const float* dn, const int* cnt, const int* list_pair, float* ypair) {
    const int e = blockIdx.z, pos = blockIdx.y; if (pos >= cnt[e]) return;
    const size_t r = (size_t)e * NTOK + pos; const int pair = list_pair[r];
    for (int j = threadIdx.x; j < DM; j += 256) ypair[(size_t)pair * DM + j] = dn[r * DM + j];
}
__global__ void k_combine(const float* ypair, const float* pair_w, float* y) {
    const int tok = blockIdx.x;
    for (int j = threadIdx.x; j < DM; j += 256) { float s = 0.f; for (int k = 0; k < TOPK; ++k) s += pair_w[tok * TOPK + k] * ypair[((size_t)tok * TOPK + k) * DM + j]; y[(size_t)tok * DM + j] = s; }
}


__global__ void k_conv_proj(const float* proj, const float* fb, unsigned short* PJ, float* LOGF2) {
    const int row = blockIdx.x;
    for (int c = threadIdx.x; c < 2560; c += 256) { const int t = c >> 9, cc = c & 511; float v = proj[(size_t)row * NPROJ + c]; if (t == 2) v *= attn_body::C2; PJ[(size_t)t * PJ_STRIDE + (size_t)row * 512 + cc] = (unsigned short)f2bf(v); }
    if (threadIdx.x < 8) LOGF2[(size_t)row * 8 + threadIdx.x] = log_sigmoid(proj[(size_t)row * NPROJ + 2560 + threadIdx.x] + fb[threadIdx.x]) * 1.4426950408889634f;
}
__global__ void k_conv_mix(const float* lru_out, const float* attn_out, const float* gn_lru, unsigned short* MRG, float* SSQ) {
    __shared__ float red[4];
    const int row = blockIdx.x, tid = threadIdx.x;
    const float a0 = lru_out[(size_t)row * DLRU + tid], a1 = lru_out[(size_t)row * DLRU + 256 + tid];
    const float ra = rsqrtf(block_sum_256(a0 * a0 + a1 * a1, red) / DLRU + RMS_EPS);
    MRG[(size_t)row * 1024 + 512 + tid] = (unsigned short)f2bf(a0 * ra * gn_lru[tid]); MRG[(size_t)row * 1024 + 768 + tid] = (unsigned short)f2bf(a1 * ra * gn_lru[256 + tid]);
    for (int i = 0; i < 2; ++i) { const int c = tid + 256 * i; const unsigned short hb = (unsigned short)f2bf(attn_out[(size_t)row * DATT + c]); MRG[(size_t)row * 1024 + c] = hb;
        float q = bf1(hb); q = q * q; for (int o = 1; o < 64; o <<= 1) q += __shfl_xor(q, o); if ((tid & 63) == 0) SSQ[(size_t)row * 8 + (c >> 6)] = q; }
}
static void sgemm(hipStream_t st, const float* A, const float* B, float* C, const float* bias, int M, int N, int K, int lda, int ldb, int ldc) {
    GemmArgs a{}; a.A = A; a.B = B; a.C = C; a.bias = bias; a.M = M; a.N = N; a.K = K; a.lda = lda; a.ldb = ldb; a.ldc = ldc;
    hipLaunchKernelGGL(k_sgemm, dim3((N + 127) / 128, (M + 127) / 128, 1), dim3(256), 0, st, a);
}
}
#endif

extern "C" void kernel_launch(void* const* d_in, const int* in_sizes, int n_in, void* d_out, int out_size, void* d_ws, size_t ws_size, hipStream_t stream) {
    static int grid = 0;
    if (grid == 0) {
        int dev = 0, cus = 0;
        if (n_in != 26 || out_size != NTOK * DM || ws_size < WS_END) { fprintf(stderr, "kernel_launch: unexpected problem shape / workspace (%d inputs, out %d, ws %zu)\n", n_in, out_size, ws_size); grid = -1; return; }
        if (hipGetDevice(&dev) != hipSuccess || hipDeviceGetAttribute(&cus, hipDeviceAttributeMultiprocessorCount, dev) != hipSuccess) { grid = -1; return; }
        if (hipFuncSetAttribute((const void*)mega_fwd, hipFuncAttributeMaxDynamicSharedMemorySize, LDS_BYTES) != hipSuccess) { fprintf(stderr, "kernel_launch: hipFuncSetAttribute failed\n"); grid = -1; return; }
        grid = cus;
        if (grid != 256) fprintf(stderr, "kernel_launch: %d CUs; this kernel is laid out for 256\n", grid);
    }
    if (grid < 0) return;
    (void)hipMemsetAsync((char*)d_ws + WS_CTL, 0, CTL_ZERO_BYTES, stream);
#if MIX >= 4
    launch_mega(stream, d_in, d_out, d_ws, 0, NPHASES, 0, grid);
#ifdef EXTRA_LO
    launch_mega(stream, d_in, d_out, d_ws, EXTRA_LO, EXTRA_HI, 1, grid);
#endif
#else
    using namespace simple;
    const float* x = (const float*)d_in[0]; const float* c = (const float*)d_in[1]; const float* w_ada = (const float*)d_in[2]; const float* b_ada = (const float*)d_in[3];
    const float* g_mix_pre = (const float*)d_in[4]; const float* w_in = (const float*)d_in[6];
    const float* conv_w = (const float*)d_in[7]; const float* conv_b = (const float*)d_in[8]; const float* wa = (const float*)d_in[9]; const float* ba = (const float*)d_in[10];
    const float* wx = (const float*)d_in[11]; const float* bx = (const float*)d_in[12]; const float* lam = (const float*)d_in[13]; const float* fb = (const float*)d_in[14];
    const float* gn_lru = (const float*)d_in[15]; const float* gn_attn = (const float*)d_in[16]; const float* w_out = (const float*)d_in[17];
    char* ws = (char*)d_ws;
    float* mod_s = (float*)(ws + 7 * MiB + 512 * KiB);
    float* h1 = (float*)(ws + 416 * MiB); float* proj = (float*)(ws + 480 * MiB); float* lru_out = (float*)(ws + 641 * MiB); float* attn_out = (float*)(ws + 673 * MiB); float* cum = (float*)(ws + 705 * MiB);
    float* merged = h1; float* Yb = (float*)(ws + WS_Y);
    launch_mega(stream, d_in, d_out, d_ws, 0, 1, 0, grid);
    hipLaunchKernelGGL(k_ada, dim3(NMOD * DM / 256, BATCH), dim3(256), 0, stream, c, w_ada, b_ada, mod_s);
    hipLaunchKernelGGL(k_prep, dim3(NTOK), dim3(256), 0, stream, x, g_mix_pre, mod_s, 0 * DM, 1 * DM, h1);
    sgemm(stream, h1, w_in, proj, nullptr, NTOK, NPROJ, DM, DM, NPROJ, NPROJ);
#if MIX <= 2
    hipLaunchKernelGGL(k_lru, dim3(BATCH * 8), dim3(64), 0, stream, proj, conv_w, conv_b, wa, ba, wx, bx, lam, lru_out);
    hipLaunchKernelGGL(k_cum, dim3(BATCH), dim3(NH), 0, stream, proj, fb, cum);
    hipLaunchKernelGGL(k_attn, dim3(SEQ / 256, NH, BATCH), dim3(256), 0, stream, proj, cum, attn_out);
#endif
#if MIX == 1
    hipLaunchKernelGGL(k_merge, dim3(NTOK), dim3(256), 0, stream, lru_out, attn_out, gn_lru, gn_attn, merged);
    sgemm(stream, merged, w_out, Yb, nullptr, NTOK, DM, DM, DM, DM, DM);
    launch_mega(stream, d_in, d_out, d_ws, 6, NPHASES, 1, grid);
#elif MIX == 2
    hipLaunchKernelGGL(k_conv_mix, dim3(NTOK), dim3(256), 0, stream, lru_out, attn_out, gn_lru, (unsigned short*)(ws + WS_MRG), (float*)(ws + WS_SSQ));
    launch_mega(stream, d_in, d_out, d_ws, 5, NPHASES, 1, grid);
#elif MIX == 3
    hipLaunchKernelGGL(k_conv_proj, dim3(NTOK), dim3(256), 0, stream, proj, fb, (unsigned short*)(ws + WS_PJ), (float*)(ws + WS_LOGF2));
    launch_mega(stream, d_in, d_out, d_ws, 3, NPHASES, 1, grid);
#endif
    (void)gn_attn; (void)w_out; (void)cum; (void)lru_out; (void)attn_out; (void)merged; (void)Yb;
#endif
}
```

```cpp
#include <hip/hip_runtime.h>
#include <hip/hip_bf16.h>
#include <cstdio>
#include <cstdint>
#include <cmath>

#define MIX 4

constexpr int DM = 1024, BATCH = 8, SEQ = 2048, NTOK = BATCH * SEQ;
constexpr int DLRU = 512, DATT = 512, NH = 8, HD = 64, NPROJ = 2 * DLRU + 3 * DATT + NH, NPJ = 2560;
constexpr int NE = 32, TOPK = 4, DEXP = 1024, NMOD = 6;
constexpr float RMS_EPS = 1e-6f;
constexpr int MAXROWS = NTOK * TOPK + NE * 256;
constexpr int MAXMT = MAXROWS / 256;

namespace pg8 {
#define PG8_LAS __attribute__((address_space(3)))
typedef unsigned short bf16_t;
typedef short bf16x8 __attribute__((ext_vector_type(8)));
typedef float f32x4 __attribute__((ext_vector_type(4)));
typedef float f32x2 __attribute__((ext_vector_type(2)));
typedef unsigned u32x4 __attribute__((ext_vector_type(4)));
constexpr int BM = 256, BK = 64, HALF = 128, HTB = HALF * BK * 2  , STAGE_BYTES = 8 * HTB, NXCD = 8, WGM = 8;
constexpr int GK = 1024, GNT = GK / BK;
typedef int i32x8 __attribute__((ext_vector_type(8)));
typedef int i32x4 __attribute__((ext_vector_type(4)));
constexpr int F8_SCALE_W = 0x79797979, F8_SCALE_A = 0x7f7f7f7f;

__host__ __device__ __forceinline__ int lds_byte(int r, int c) { const int st = (r >> 4) * 2 + (c >> 5), rr = r & 15, cc = c & 31, ob = rr * 64 + cc * 2; return st * 1024 + (ob ^ (((ob >> 9) & 1) << 5)); }
__host__ __device__ __forceinline__ void stage_rc(int b, int& R, int& C) { const int st = b / 1024, sb = b % 1024, swz = sb ^ (((sb >> 9) & 1) << 5); R = (st >> 1) * 16 + swz / 64; C = (st & 1) * 32 + (swz % 64) / 2; }
__host__ __device__ __forceinline__ int perm32(int rho) { const int n = rho >> 4, i = rho & 15; return 8 * (i >> 2) + 4 * n + (i & 3); }

struct Unit { const char* A0; const char* A1; const char* B0; const char* B1; int pm, pn, e; };

__device__ __forceinline__ void mfma_f8_acc(f32x4& acc, const i32x8& b, const i32x8& a, int sw, int sa) {
    asm volatile("v_mfma_scale_f32_16x16x128_f8f6f4 %0, %1, %2, %0, %3, %4 op_sel_hi:[0,0,0]" : "+v"(acc) : "v"(b), "v"(a), "v"(sw), "v"(sa)); }
__device__ __forceinline__ unsigned cvt_pk_bf16(float lo, float hi) { unsigned r; asm volatile("v_cvt_pk_bf16_f32 %0, %1, %2" : "=v"(r) : "v"(lo), "v"(hi)); return r; }

template <class Epi, class Sched, bool F8 = false, int KREP = 1>
__device__ __forceinline__ void gemm_phase(PG8_LAS unsigned char* lds, const Sched& S, const Epi& E) {
    const int tid = threadIdx.x, wid = __builtin_amdgcn_readfirstlane(tid >> 6), lane = tid & 63, wr = wid >> 2, wc = wid & 3, fr = lane & 15, fq = lane >> 4;
    constexpr int KB = F8 ? GK : GK * 2, nt1 = F8 ? GK / 128 : GNT, nt = nt1 * KREP;
    int Rr[2], Cc[2];
    unsigned voffB[2], cvA[2][2], nvA[2][2];
#pragma unroll
    for (int i = 0; i < 2; ++i) { stage_rc(tid * 16 + i * 8192, Rr[i], Cc[i]); const int Rb = Epi::PERM ? ((Rr[i] & ~31) + perm32(Rr[i] & 31)) : Rr[i]; voffB[i] = (unsigned)(Rb * KB + Cc[i] * 2); }
    constexpr size_t kstep = (size_t)(BK * 2);
    const unsigned ldsw = (unsigned)wid * 1024u;
    const int aoff = lds_byte(wr * 64 + fr, fq * 8), boff = lds_byte(wc * 32 + fr, fq * 8);
#define PG8_SA(b, h) (((b) * 2 + (h)) * HTB)
#define PG8_SB(b, h) ((4 + (b) * 2 + (h)) * HTB)
#define PG8_STAGE(bufoff, gbase, voff) do { _Pragma("unroll") for (int _i = 0; _i < 2; ++_i) \
        __builtin_amdgcn_global_load_lds((const unsigned*)((const char*)(gbase) + (voff)[_i]), (PG8_LAS unsigned*)(lds + (bufoff) + ldsw + _i * 8192), 16, 0, 0); } while (0)
#define PG8_LD8(p) __builtin_shufflevector(*(const PG8_LAS i32x4*)(p), *(const PG8_LAS i32x4*)((p) + 1024), 0, 1, 2, 3, 4, 5, 6, 7)
#define PG8_LDA(dst, b, h) do { _Pragma("unroll") for (int m = 0; m < 4; ++m) { if constexpr (F8) { dst##8[m] = PG8_LD8(lds + PG8_SA(b, h) + aoff + m * 2048); } \
        else { _Pragma("unroll") for (int k = 0; k < 2; ++k) dst[m][k] = *(const PG8_LAS bf16x8*)(lds + PG8_SA(b, h) + aoff + m * 2048 + k * 1024); } } } while (0)
#define PG8_LDB(dst, b, h) do { _Pragma("unroll") for (int n = 0; n < 2; ++n) { if constexpr (F8) { dst##8[n] = PG8_LD8(lds + PG8_SB(b, h) + boff + n * 2048); } \
        else { _Pragma("unroll") for (int k = 0; k < 2; ++k) dst[n][k] = *(const PG8_LAS bf16x8*)(lds + PG8_SB(b, h) + boff + n * 2048 + k * 1024); } } } while (0)
#define PG8_MMA(ai, bj, At, Bt) do { __builtin_amdgcn_s_setprio(1); _Pragma("unroll") for (int m = 0; m < 4; ++m) _Pragma("unroll") for (int n = 0; n < 2; ++n) { \
        if constexpr (F8) { mfma_f8_acc(acc[ai][bj][m][n], Bt##8[n], At##8[m], scw, sca); } \
        else { _Pragma("unroll") for (int k = 0; k < 2; ++k) acc[ai][bj][m][n] = __builtin_amdgcn_mfma_f32_16x16x32_bf16(Bt[n][k], At[m][k], acc[ai][bj][m][n], 0, 0, 0); } } \
        __builtin_amdgcn_s_setprio(0); } while (0)
#define PG8_WAIT_V(n) asm volatile("s_waitcnt vmcnt(" #n ")" ::: "memory")
    constexpr int RELAX = 8 + Epi::NST + (Sched::GATHER ? 4 : 0);
#define PG8_WAIT_V8R(rx) do { if (rx) { if constexpr (RELAX == 12) PG8_WAIT_V(12); else if constexpr (RELAX == 16) PG8_WAIT_V(16); else if constexpr (RELAX == 20) PG8_WAIT_V(20); \
        else if constexpr (RELAX == 24) PG8_WAIT_V(24); else if constexpr (RELAX == 28) PG8_WAIT_V(28); else PG8_WAIT_V(8); } else PG8_WAIT_V(8); } while (0)
#define PG8_WAIT_L(n) asm volatile("s_waitcnt lgkmcnt(" #n ")" ::: "memory")
#define PG8_BAR __builtin_amdgcn_s_barrier()
#define PG8_SCHED __builtin_amdgcn_sched_barrier(0)
#define PG8_VOFF(dst, u) do { _Pragma("unroll") for (int _h = 0; _h < 2; ++_h) _Pragma("unroll") for (int _i = 0; _i < 2; ++_i) { \
        const int _row = Sched::GATHER ? S.row_of(u, _h * HALF + Rr[_i]) : Rr[_i]; dst[_h][_i] = (unsigned)(_row * KB + Cc[_i] * 2); } } while (0)
    Unit cur, nxt; int ui = 0;
    if (!S.next(0, cur)) return;
    f32x4 acc[2][2][4][2];
#pragma unroll
    for (int a = 0; a < 2; ++a)
#pragma unroll
        for (int b = 0; b < 2; ++b)
#pragma unroll
            for (int m = 0; m < 4; ++m)
#pragma unroll
                for (int n = 0; n < 2; ++n) acc[a][b][m][n] = (f32x4){0.f, 0.f, 0.f, 0.f};
    const int scw = F8_SCALE_W, sca = F8_SCALE_A;
    bf16x8 At[4][2], B0[2][2], B1[2][2]; i32x8 At8[4], B08[2], B18[2];
    PG8_VOFF(cvA, cur);
    if (Sched::GATHER) { asm volatile("s_waitcnt vmcnt(0)" ::: "memory"); }
    PG8_STAGE(PG8_SB(0, 0), cur.B0, voffB); PG8_STAGE(PG8_SB(0, 1), cur.B1, voffB); PG8_STAGE(PG8_SA(0, 0), cur.A0, cvA[0]); PG8_STAGE(PG8_SA(0, 1), cur.A1, cvA[1]);
    if (wr == 1) PG8_BAR;
    PG8_WAIT_V(2); PG8_BAR;
    PG8_STAGE(PG8_SB(1, 0), cur.B0 + kstep, voffB); PG8_STAGE(PG8_SA(1, 0), cur.A0 + kstep, cvA[0]); PG8_STAGE(PG8_SB(1, 1), cur.B1 + kstep, voffB);
    PG8_WAIT_V(6); PG8_BAR;
    for (;;) {
        const bool has_next = S.next(ui + 1, nxt);
        if (!has_next) nxt = cur;
        int nraw[2][2];
        if (Sched::GATHER && has_next) {
#pragma unroll
            for (int _h = 0; _h < 2; ++_h)
#pragma unroll
                for (int _i = 0; _i < 2; ++_i) { const int* p_ = S.row_ptr(nxt, _h * HALF + Rr[_i]); asm volatile("global_load_dword %0, %1, off" : "=v"(nraw[_h][_i]) : "v"(p_) : "memory"); }
        }
        if (has_next) { if (!Sched::GATHER) { PG8_VOFF(nvA, nxt); } }
        else {
#pragma unroll
            for (int _h = 0; _h < 2; ++_h)
#pragma unroll
                for (int _i = 0; _i < 2; ++_i) nvA[_h][_i] = cvA[_h][_i]; }
#pragma unroll 1
        for (int t = 0; t < nt; t += 2) {
            const bool last = (t == nt - 2); const bool rx = (t == 0) && (ui > 0);
            if (Epi::MID && t == nt / 2) E.mid(acc, cur, wr, wc, fr, fq);
            const char* a1_1 = cur.A1 + (size_t)((t + 1) % nt1) * kstep;
            const char* a2_0 = last ? nxt.A0 : cur.A0 + (size_t)((t + 2) % nt1) * kstep; const char* a2_1 = last ? nxt.A1 : cur.A1 + (size_t)((t + 2) % nt1) * kstep;
            const char* b2_0 = last ? nxt.B0 : cur.B0 + (size_t)((t + 2) % nt1) * kstep; const char* b2_1 = last ? nxt.B1 : cur.B1 + (size_t)((t + 2) % nt1) * kstep;
            const char* a3_0 = a2_0 + kstep; const char* a3_1 = a2_1 + kstep; const char* b3_0 = b2_0 + kstep; const char* b3_1 = b2_1 + kstep;
            if (Sched::GATHER && last && has_next) {
#pragma unroll
                for (int _h = 0; _h < 2; ++_h)
#pragma unroll
                    for (int _i = 0; _i < 2; ++_i) { int r_ = nraw[_h][_i]; asm volatile("" : "+v"(r_));
                        nvA[_h][_i] = (unsigned)(r_ * KB + Cc[_i] * 2); } }
            unsigned sv0[2], sv1[2];
#pragma unroll
            for (int _i = 0; _i < 2; ++_i) { sv0[_i] = last ? nvA[0][_i] : cvA[0][_i]; sv1[_i] = last ? nvA[1][_i] : cvA[1][_i]; }
            PG8_LDB(B0, 0, 0); PG8_LDB(B1, 0, 1); PG8_SCHED; PG8_LDA(At, 0, 0); PG8_STAGE(PG8_SA(1, 1), a1_1, cvA[1]);
            PG8_WAIT_V8R(rx); PG8_WAIT_L(0); PG8_BAR; PG8_MMA(0, 0, At, B0); PG8_MMA(0, 1, At, B1); PG8_BAR; PG8_SCHED;
            PG8_LDA(At, 0, 1); PG8_STAGE(PG8_SB(0, 0), b2_0, voffB); PG8_STAGE(PG8_SB(0, 1), b2_1, voffB); PG8_STAGE(PG8_SA(0, 0), a2_0, sv0);
            PG8_WAIT_V8R(rx); PG8_WAIT_L(0); PG8_BAR; PG8_MMA(1, 0, At, B0); PG8_MMA(1, 1, At, B1); PG8_BAR; PG8_SCHED;
            PG8_LDB(B0, 1, 0); PG8_LDB(B1, 1, 1); PG8_SCHED; PG8_LDA(At, 1, 0); PG8_STAGE(PG8_SA(0, 1), a2_1, sv1);
            PG8_WAIT_V(8); PG8_WAIT_L(0); PG8_BAR; PG8_MMA(0, 0, At, B0); PG8_MMA(0, 1, At, B1); PG8_BAR; PG8_SCHED;
            PG8_LDA(At, 1, 1); PG8_STAGE(PG8_SB(1, 0), b3_0, voffB); PG8_STAGE(PG8_SB(1, 1), b3_1, voffB); PG8_STAGE(PG8_SA(1, 0), a3_0, sv0);
            PG8_WAIT_V(8); PG8_WAIT_L(0); PG8_BAR; PG8_MMA(1, 0, At, B0); PG8_MMA(1, 1, At, B1); PG8_BAR; PG8_SCHED;
            (void)a3_1; (void)b3_1;
        }
        if (wr == 0) PG8_BAR;
        if constexpr (F8) { asm volatile("s_nop 15\n\ts_nop 15\n\ts_nop 7" ::: "memory"); }
        E(acc, cur, wr, wc, fr, fq);
        if (!has_next) break;
#pragma unroll
        for (int a = 0; a < 2; ++a)
#pragma unroll
            for (int b = 0; b < 2; ++b)
#pragma unroll
                for (int m = 0; m < 4; ++m)
#pragma unroll
                    for (int n = 0; n < 2; ++n) acc[a][b][m][n] = (f32x4){0.f, 0.f, 0.f, 0.f};
        cur = nxt; ++ui;
#pragma unroll
        for (int _h = 0; _h < 2; ++_h)
#pragma unroll
            for (int _i = 0; _i < 2; ++_i) cvA[_h][_i] = nvA[_h][_i];
        if (wr == 1) PG8_BAR;
    }
    PG8_WAIT_V(0);
    PG8_BAR;
#undef PG8_SA
#undef PG8_SB
#undef PG8_STAGE
#undef PG8_LDA
#undef PG8_LDB
#undef PG8_MMA
#undef PG8_LD8
#undef PG8_WAIT_V
#undef PG8_WAIT_V8R
#undef PG8_WAIT_L
#undef PG8_BAR
#undef PG8_SCHED
#undef PG8_VOFF
}
}

namespace pg8 {

struct DenseOrder {
    static constexpr bool GATHER = false;
    const bf16_t* A; const bf16_t* Bt; int nM, nN, nwg, G, c;
    __device__ __forceinline__ void init(const bf16_t* A_, const bf16_t* Bt_, int M, int N, int G_, int c_) { A = A_; Bt = Bt_; nM = M / BM; nN = N / BM; nwg = nM * nN; G = G_; c = c_; }
    __device__ __forceinline__ bool next(int i, Unit& u) const {
        const long L = (long)i * G + c; if (L >= nwg) return false;
        int wgid = (int)L; { const int q = nwg / NXCD, r = nwg % NXCD, xcd = wgid % NXCD, off = wgid / NXCD; wgid = (xcd < r ? xcd * (q + 1) : r * (q + 1) + (xcd - r) * q) + off; }
        const int nig = WGM * nN, gid = wgid / nig, fm = gid * WGM, gsz = (nM - fm) < WGM ? (nM - fm) : WGM;
        u.pm = fm + ((wgid % nig) % gsz); u.pn = (wgid % nig) / gsz; u.e = 0;
        u.A0 = (const char*)A + (size_t)u.pm * BM * GK * 2; u.A1 = u.A0 + (size_t)HALF * GK * 2;
        u.B0 = (const char*)Bt + (size_t)u.pn * BM * GK * 2; u.B1 = u.B0 + (size_t)HALF * GK * 2;
        return true;
    }
    __device__ __forceinline__ int row_of(const Unit&, int r) const { return r; }
    __device__ __forceinline__ const int* row_ptr(const Unit&, int) const { return nullptr; }
};
struct UpOrder {
    static constexpr bool GATHER = true;
    const unsigned char* H2; const unsigned char* WupT; const int* row_tok; const int* mt_exp; int nunits, G, c;
    __device__ __forceinline__ bool next(int i, Unit& u) const {
        const int L = i * G + c; if (L >= nunits) return false;
        u.pm = L >> 3; u.pn = L & 7; u.e = mt_exp[u.pm];
        u.A0 = (const char*)H2; u.A1 = (const char*)H2;
        u.B0 = (const char*)WupT + ((size_t)u.e * 2 * DEXP + (size_t)u.pn * HALF) * GK; u.B1 = u.B0 + (size_t)DEXP * GK;
        return true;
    }
    __device__ __forceinline__ int row_of(const Unit& u, int r) const { return row_tok[u.pm * BM + r]; }
    __device__ __forceinline__ const int* row_ptr(const Unit& u, int r) const { return row_tok + u.pm * BM + r; }
};
struct DownOrder {
    static constexpr bool GATHER = false;
    const unsigned char* ACT; const unsigned char* WdnT; const int* mt_exp; int nunits, G, c;
    __device__ __forceinline__ bool next(int i, Unit& u) const {
        const int L = i * G + c; if (L >= nunits) return false;
        u.pm = L >> 2; u.pn = L & 3; u.e = mt_exp[u.pm];
        u.A0 = (const char*)ACT + (size_t)u.pm * BM * GK; u.A1 = u.A0 + (size_t)HALF * GK;
        u.B0 = (const char*)WdnT + ((size_t)u.e * DM + (size_t)u.pn * BM) * GK; u.B1 = u.B0 + (size_t)HALF * GK;
        return true;
    }
    __device__ __forceinline__ int row_of(const Unit&, int r) const { return r; }
    __device__ __forceinline__ const int* row_ptr(const Unit&, int) const { return nullptr; }
};

struct EpiProj {
    static constexpr bool PERM = true, MID = false; static constexpr int NST = 16;
    bf16_t* O; size_t tstride; float qscale;
    __device__ __forceinline__ void mid(f32x4 (&)[2][2][4][2], const Unit&, int, int, int, int) const {}
    __device__ __forceinline__ void operator()(const f32x4 (&acc)[2][2][4][2], const Unit& u, int wr, int wc, int fr, int fq) const {
        const int t = u.pn >> 1; bf16_t* base = O + (size_t)t * tstride; const float sc = (t == 2) ? qscale : 1.f;
        const int row0 = u.pm * BM + wr * 64 + fr, col0 = (u.pn & 1) * BM + wc * 32 + 8 * fq;
#pragma unroll
        for (int ai = 0; ai < 2; ++ai)
#pragma unroll
            for (int m = 0; m < 4; ++m) { bf16_t* rowp = base + (size_t)(row0 + ai * HALF + m * 16) * 512 + col0;
#pragma unroll
                for (int bj = 0; bj < 2; ++bj) { const f32x4 v0 = acc[ai][bj][m][0] * sc, v1 = acc[ai][bj][m][1] * sc;
                    u32x4 w; w.x = cvt_pk_bf16(v0[0], v0[1]); w.y = cvt_pk_bf16(v0[2], v0[3]); w.z = cvt_pk_bf16(v1[0], v1[1]); w.w = cvt_pk_bf16(v1[2], v1[3]);
                    *(u32x4*)(rowp + bj * HALF) = w; } }
    }
};
struct EpiOut {
    static constexpr bool PERM = true, MID = true; static constexpr int NST = 0;
    bf16_t* Y; const float* ssq;
    __device__ __forceinline__ void mid(f32x4 (&acc)[2][2][4][2], const Unit& u, int wr, int wc, int fr, int fq) const {
#pragma unroll
        for (int ai = 0; ai < 2; ++ai)
#pragma unroll
            for (int m = 0; m < 4; ++m) { const int row = u.pm * BM + ai * HALF + wr * 64 + m * 16 + fr;
                const f32x4 s0 = *(const f32x4*)(ssq + (size_t)row * 8), s1 = *(const f32x4*)(ssq + (size_t)row * 8 + 4);
                const float tot = ((s0[0] + s0[1]) + (s0[2] + s0[3])) + ((s1[0] + s1[1]) + (s1[2] + s1[3]));
                const float ri = 1.0f / sqrtf(tot * (1.0f / DATT) + RMS_EPS);
#pragma unroll
                for (int bj = 0; bj < 2; ++bj)
#pragma unroll
                    for (int n = 0; n < 2; ++n) acc[ai][bj][m][n] = acc[ai][bj][m][n] * ri; }
    }
    __device__ __forceinline__ void operator()(const f32x4 (&acc)[2][2][4][2], const Unit& u, int wr, int wc, int fr, int fq) const {
        const int row0 = u.pm * BM + wr * 64 + fr, col0 = u.pn * BM + wc * 32 + 8 * fq;
#pragma unroll
        for (int ai = 0; ai < 2; ++ai)
#pragma unroll
            for (int m = 0; m < 4; ++m) { bf16_t* rowp = Y + (size_t)(row0 + ai * HALF + m * 16) * DM + col0;
#pragma unroll
                for (int bj = 0; bj < 2; ++bj) { const f32x4 v0 = acc[ai][bj][m][0], v1 = acc[ai][bj][m][1];
                    u32x4 w; w.x = cvt_pk_bf16(v0[0], v0[1]); w.y = cvt_pk_bf16(v0[2], v0[3]); w.z = cvt_pk_bf16(v1[0], v1[1]); w.w = cvt_pk_bf16(v1[2], v1[3]);
                    *(u32x4*)(rowp + bj * HALF) = w; } }
    }
};
struct EpiUp {
    static constexpr bool PERM = true, MID = false; static constexpr int NST = 8;
    unsigned char* ACT; const float* b_up;
    __device__ __forceinline__ void mid(f32x4 (&)[2][2][4][2], const Unit&, int, int, int, int) const {}
    __device__ __forceinline__ void operator()(const f32x4 (&acc)[2][2][4][2], const Unit& u, int wr, int wc, int fr, int fq) const {
        const int row0 = u.pm * BM + wr * 64 + fr, col0 = u.pn * HALF + wc * 32 + 8 * fq;
        const float* bg = b_up + (size_t)u.e * 2 * DEXP + col0;
        f32x4 bgl[2], bli[2];
#pragma unroll
        for (int n = 0; n < 2; ++n) { bgl[n] = *(const f32x4*)(bg + 4 * n); bli[n] = *(const f32x4*)(bg + DEXP + 4 * n); }
#pragma unroll
        for (int ai = 0; ai < 2; ++ai)
#pragma unroll
            for (int m = 0; m < 4; ++m) { unsigned char* rowp = ACT + (size_t)(row0 + ai * HALF + m * 16) * DEXP + col0;
                float o[8];
#pragma unroll
                for (int n = 0; n < 2; ++n)
#pragma unroll
                    for (int j = 0; j < 4; ++j) { const float gl = fminf(acc[ai][0][m][n][j] + bgl[n][j], 7.0f); const float li = fminf(fmaxf(acc[ai][1][m][n][j] + bli[n][j], -7.0f), 7.0f);
                        const float sg = __builtin_amdgcn_rcpf(1.0f + __builtin_amdgcn_exp2f(-1.702f * 1.4426950408889634f * gl)); o[4 * n + j] = gl * sg * (li + 1.0f); }
                int w0 = 0, w1 = 0; w0 = __builtin_amdgcn_cvt_pk_fp8_f32(o[0], o[1], w0, false); w0 = __builtin_amdgcn_cvt_pk_fp8_f32(o[2], o[3], w0, true);
                w1 = __builtin_amdgcn_cvt_pk_fp8_f32(o[4], o[5], w1, false); w1 = __builtin_amdgcn_cvt_pk_fp8_f32(o[6], o[7], w1, true);
                typedef int i32x2_ __attribute__((ext_vector_type(2))); *(i32x2_*)rowp = (i32x2_){w0, w1}; }
    }
};
struct EpiDown {
    static constexpr bool PERM = true, MID = false; static constexpr int NST = 16;
    unsigned char* YP; const float* b_down; const int* row_pair; const float* row_w;
    __device__ __forceinline__ void mid(f32x4 (&)[2][2][4][2], const Unit&, int, int, int, int) const {}
    __device__ __forceinline__ void operator()(const f32x4 (&acc)[2][2][4][2], const Unit& u, int wr, int wc, int fr, int fq) const {
        const int row0 = u.pm * BM + wr * 64 + fr, col0 = u.pn * BM + wc * 32 + 8 * fq;
        const float* bd = b_down + (size_t)u.e * DM + col0;
        f32x4 bv[2][2];
#pragma unroll
        for (int bj = 0; bj < 2; ++bj)
#pragma unroll
            for (int n = 0; n < 2; ++n) bv[bj][n] = *(const f32x4*)(bd + bj * HALF + 4 * n);
        int pr[2][4]; float wt[2][4];
#pragma unroll
        for (int ai = 0; ai < 2; ++ai)
#pragma unroll
            for (int m = 0; m < 4; ++m) { const int pos = row0 + ai * HALF + m * 16; pr[ai][m] = row_pair[pos]; wt[ai][m] = row_w[pos] * 4.0f; }
#pragma unroll
        for (int ai = 0; ai < 2; ++ai)
#pragma unroll
            for (int m = 0; m < 4; ++m) { const int pair = pr[ai][m] >= 0 ? pr[ai][m] : NTOK * TOPK; const float w = wt[ai][m];
                { unsigned char* rowp = YP + (size_t)pair * DM + col0;
#pragma unroll
                    for (int bj = 0; bj < 2; ++bj) { const f32x4 v0 = (acc[ai][bj][m][0] + bv[bj][0]) * w, v1 = (acc[ai][bj][m][1] + bv[bj][1]) * w;
                        int q0 = 0, q1 = 0; q0 = __builtin_amdgcn_cvt_pk_fp8_f32(v0[0], v0[1], q0, false); q0 = __builtin_amdgcn_cvt_pk_fp8_f32(v0[2], v0[3], q0, true);
                        q1 = __builtin_amdgcn_cvt_pk_fp8_f32(v1[0], v1[1], q1, false); q1 = __builtin_amdgcn_cvt_pk_fp8_f32(v1[2], v1[3], q1, true);
                        typedef int i32x2_ __attribute__((ext_vector_type(2))); *(i32x2_*)(rowp + bj * HALF) = (i32x2_){q0, q1}; } } }
    }
};
}

namespace attn_body {
using bf16=__hip_bfloat16;
using bf16x8=__attribute__((ext_vector_type(8)))short;
using s16x4=__attribute__((ext_vector_type(4)))short;
using f32x16=__attribute__((ext_vector_type(16)))float;
using u32x4=__attribute__((ext_vector_type(4)))unsigned;
constexpr int BATCH=8,NHEAD=8,SEQ=2048,D=64,DM=NHEAD*D,OPITCH=1024;
constexpr int NW=8,QBLK=32,QB=QBLK*NW,KVBLK=64,NQB=SEQ/QB;
constexpr int ATTN_PITCH=DM, ATTN_UNIT_ROWS=QB;
__device__ __forceinline__ int crow(int r,int hi){return (r&3)+8*(r>>2)+4*hi;}
#define SBAR() __builtin_amdgcn_sched_barrier(0)
__device__ __forceinline__ void cmask(f32x16&p0,f32x16&p1,int jb,int qrel,int hi){
  const float NEG=-INFINITY; int kb=64*jb+4*hi;
  #pragma unroll
  for(int r=0;r<16;++r){int kv=kb+(r&3)+8*(r>>2); if(kv>qrel)p0[r]=NEG; if(kv+32>qrel)p1[r]=NEG;}
}

constexpr int NSLOT=3, SLOTB=8192;
constexpr int LDS_K=0, LDS_V=NSLOT*SLOTB, LDS_WS=2*NSLOT*SLOTB, LDS_OST=LDS_WS+NW*64*4, LDS_BIAS=LDS_OST+NW*4096, LDS_SCAN=LDS_BIAS+(SEQ+64)*4, LDS_BYTES=LDS_SCAN+256;
constexpr float C2=0.125f*1.4426950408889634f;
__device__ __forceinline__ void glds16(const void*gsrc,unsigned lds_dst){unsigned keep;
  asm volatile("s_mov_b32 %0, m0\n\ts_mov_b32 m0, %2\n\ts_nop 0\n\tglobal_load_lds_dwordx4 %1, off\n\ts_mov_b32 m0, %0":"=&s"(keep):"v"(gsrc),"s"(lds_dst):"memory");}
__device__ __forceinline__ float max3f(float a,float b,float c){float r;asm("v_max3_f32 %0, %1, %2, %3":"=v"(r):"v"(a),"v"(b),"v"(c));return r;}
__device__ __forceinline__ float max2f(float a,float b){float r;asm("v_max_f32_e32 %0, %1, %2":"=v"(r):"v"(a),"v"(b));return r;}
__device__ __forceinline__ float fadd_s(float a,float b){float r;asm("v_add_f32_e32 %0, %1, %2":"=v"(r):"v"(a),"v"(b));return r;}
__device__ __forceinline__ float fsub_s(float a,float b){float r;asm("v_sub_f32_e32 %0, %1, %2":"=v"(r):"v"(a),"v"(b));return r;}
typedef float f32x2_t __attribute__((ext_vector_type(2))); typedef float f32x4_t __attribute__((ext_vector_type(4))); typedef __bf16 bf16x2_t __attribute__((ext_vector_type(2)));
__device__ __forceinline__ unsigned cvtpk_s(float lo,float hi){f32x2_t v={lo,hi};bf16x2_t b=__builtin_convertvector(v,bf16x2_t);return __builtin_bit_cast(unsigned,b);}
#define WAIT_BAR(N) asm volatile("s_waitcnt vmcnt(" #N ") lgkmcnt(0)\n\ts_barrier":::"memory")

__device__ __forceinline__ void qkt(f32x16&p0,f32x16&p1,const char*Kslot,const bf16x8*qr,int r32,int hi){
  const char*kb=Kslot+hi*1024+r32*16;
  #pragma unroll
  for(int d0=0;d0<4;++d0){
    const bf16x8 b0=*reinterpret_cast<const bf16x8*>(kb+d0*2048);
    const bf16x8 b1=*reinterpret_cast<const bf16x8*>(kb+d0*2048+512);
    p0=__builtin_amdgcn_mfma_f32_32x32x16_bf16(b0,qr[d0],p0,0,0,0);p1=__builtin_amdgcn_mfma_f32_32x32x16_bf16(b1,qr[d0],p1,0,0,0);}
}
typedef __attribute__((address_space(3))) const char* lds_cptr;
typedef short v4i16_t __attribute__((ext_vector_type(4)));
__device__ __forceinline__ void kload8(bf16x8*kf,lds_cptr kp){
  kf[0]=*(const __attribute__((address_space(3))) bf16x8*)(kp);      kf[1]=*(const __attribute__((address_space(3))) bf16x8*)(kp+512);
  kf[2]=*(const __attribute__((address_space(3))) bf16x8*)(kp+2048); kf[3]=*(const __attribute__((address_space(3))) bf16x8*)(kp+2560);
  kf[4]=*(const __attribute__((address_space(3))) bf16x8*)(kp+4096); kf[5]=*(const __attribute__((address_space(3))) bf16x8*)(kp+4608);
  kf[6]=*(const __attribute__((address_space(3))) bf16x8*)(kp+6144); kf[7]=*(const __attribute__((address_space(3))) bf16x8*)(kp+6656);
}
__device__ __forceinline__ void kload2(bf16x8*kf,lds_cptr kp,int j){ kf[2*j]=*(const __attribute__((address_space(3))) bf16x8*)(kp+j*2048); kf[2*j+1]=*(const __attribute__((address_space(3))) bf16x8*)(kp+j*2048+512); }
__device__ __forceinline__ s16x4 vtr(lds_cptr p){ return __builtin_bit_cast(s16x4,__builtin_amdgcn_ds_read_tr16_b64_v4i16((__attribute__((address_space(3))) v4i16_t*)p)); }
__device__ __forceinline__ float rowmax(const f32x16&p0,const f32x16&p1){
  float a=max3f(p0[0],p0[1],p1[0]),b=max3f(p0[2],p0[3],p1[1]);a=max3f(a,p1[2],p1[3]);
  #pragma unroll
  for(int r=4;r<16;r+=4){a=max3f(a,p0[r],p0[r+1]);b=max3f(b,p0[r+2],p0[r+3]);a=max3f(a,p1[r],p1[r+1]);b=max3f(b,p1[r+2],p1[r+3]);}
  const float m=max2f(a,b);
  auto rr=__builtin_amdgcn_permlane32_swap(__float_as_uint(m),__float_as_uint(m),false,false);
  return max2f(__uint_as_float(rr[0]),__uint_as_float(rr[1]));
}
__device__ __forceinline__ void pv(f32x16*o,int vb,bf16x8 pa0,bf16x8 pa1,bf16x8 pa2,bf16x8 pa3){
  #pragma unroll
  for(int d0=0;d0<2;++d0){s16x4 lo[4],hi[4];
    #pragma unroll
    for(int ks=0;ks<4;++ks){
      asm volatile("ds_read_b64_tr_b16 %0,%1 offset:%c2":"=&v"(lo[ks]):"v"(vb),"i"(d0*4096+ks*1024):"memory");
      asm volatile("ds_read_b64_tr_b16 %0,%1 offset:%c2":"=&v"(hi[ks]):"v"(vb),"i"(d0*4096+ks*1024+512):"memory");}
    asm volatile("s_waitcnt lgkmcnt(0)":::"memory");SBAR();
    #define PK(k) (bf16x8){lo[k][0],lo[k][1],lo[k][2],lo[k][3],hi[k][0],hi[k][1],hi[k][2],hi[k][3]}
    o[d0]=__builtin_amdgcn_mfma_f32_32x32x16_bf16(pa0,PK(0),o[d0],0,0,0);
    o[d0]=__builtin_amdgcn_mfma_f32_32x32x16_bf16(pa1,PK(1),o[d0],0,0,0);
    o[d0]=__builtin_amdgcn_mfma_f32_32x32x16_bf16(pa2,PK(2),o[d0],0,0,0);
    o[d0]=__builtin_amdgcn_mfma_f32_32x32x16_bf16(pa3,PK(3),o[d0],0,0,0);
    #undef PK
  }
}

#ifndef ATTN_STORE16
#define ATTN_STORE16(p,v) (*(u32x4*)(p)=(v))
#endif
template<int THRL> __device__ __forceinline__ void attn_unit(int b,int h,int qb,const bf16*Q,const bf16*__restrict__ K,const bf16*__restrict__ V,bf16*O,const float*__restrict__ LOGF2,float*SSQ,char*shm){
  const int tid=threadIdx.x,lane=tid&63,r32=lane&31,hi=lane>>5; const int wid=__builtin_amdgcn_readfirstlane(tid>>6);
  const long rowbase=(long)b*SEQ; const int q0=qb*QB;
  const bf16*Qw=Q+(rowbase+q0+wid*QBLK)*DM+h*D;
  const bf16*Kh=K+rowbase*DM+h*D,*Vh=V+rowbase*DM+h*D;
  const unsigned lds0=(unsigned)(uintptr_t)shm;
  float*wsf=(float*)(shm+LDS_WS)+wid*64;
  const bf16*ksrc=Kh+(long)lane*DM+wid*8;
  const bf16*vsrc=Vh+(long)(16*(wid&3)+(lane>>2))*DM+(wid>>2)*32+(lane&3)*8;
  const unsigned kdst=lds0+LDS_K+wid*1024, vdst=lds0+LDS_V+wid*1024;
  #define DMA_K(t,slot) glds16(ksrc+(long)(t)*KVBLK*DM,(unsigned)__builtin_amdgcn_readfirstlane(kdst+(slot)))
  #define DMA_V(t,slot) glds16(vsrc+(long)(t)*KVBLK*DM,(unsigned)__builtin_amdgcn_readfirstlane(vdst+(slot)))
  const int vb0=(int)(lds0+LDS_V)+((lane>>4)&1)*32+(lane&3)*8+(4*hi+((lane&15)>>2))*64;
  const char*Kbase=shm+LDS_K; bf16x8 kf[8];
  const lds_cptr shm3=(lds_cptr)shm; const lds_cptr kp0=shm3+LDS_K+hi*1024+r32*16; const lds_cptr vp0=shm3+LDS_V+((lane>>4)&1)*32+(lane&3)*8+(4*hi+((lane&15)>>2))*64;
  const int NT=(q0+QB)/KVBLK;
  { float*biasl=(float*)(shm+LDS_BIAS); float*scn=(float*)(shm+LDS_SCAN);
    const float*lf=LOGF2+rowbase*NHEAD+h;
    float v0=0.f,v1=0.f,v2=0.f,v3=0.f; const int i0=4*tid;
    if(i0<q0){ v0=lf[(long)(q0-1-i0)*NHEAD]; v1=lf[(long)(q0-2-i0)*NHEAD]; v2=lf[(long)(q0-3-i0)*NHEAD]; v3=lf[(long)(q0-4-i0)*NHEAD]; }
    const float tsum=(v0+v1)+(v2+v3); float inc=tsum;
    #pragma unroll
    for(int o=1;o<64;o<<=1){ const float n_=__shfl_up(inc,o); if(lane>=o)inc+=n_; }
    if(lane==63)scn[wid]=inc;
    const float f0=lf[(long)(q0+4*lane)*NHEAD],f1=lf[(long)(q0+4*lane+1)*NHEAD],f2=lf[(long)(q0+4*lane+2)*NHEAD],f3=lf[(long)(q0+4*lane+3)*NHEAD];
    float finc=(f0+f1)+(f2+f3);
    #pragma unroll
    for(int o=1;o<64;o<<=1){ const float n_=__shfl_up(finc,o); if(lane>=o)finc+=n_; }
    const float fex=finc-((f0+f1)+(f2+f3));
    if(wid==0){ biasl[q0+4*lane]=-(fex+f0); biasl[q0+4*lane+1]=-(fex+f0+f1); biasl[q0+4*lane+2]=-(fex+f0+f1+f2); biasl[q0+4*lane+3]=-(fex+f0+f1+f2+f3); }
    __syncthreads();
    float woff=0.f;
    #pragma unroll
    for(int w_=0;w_<NW;++w_) woff+=(w_<wid)?scn[w_]:0.f;
    const float ex=woff+inc-tsum;
    if(i0<q0){ biasl[q0-1-i0]=ex; biasl[q0-2-i0]=ex+v0; biasl[q0-3-i0]=ex+v0+v1; biasl[q0-4-i0]=ex+v0+v1+v2; }
    __syncthreads(); }
  const lds_cptr biasr=(lds_cptr)shm+LDS_BIAS+16*hi;
  #define BIAS4(t,o) (*(const __attribute__((address_space(3))) f32x4_t*)(biasr+(t)*(KVBLK*4)+(o)*4))
  #define INIT4(Y,g,t,o) do{ const f32x4_t x_=BIAS4(t,(o)+8*(g)); Y[4*(g)]=x_[0]-mhat; Y[4*(g)+1]=x_[1]-mhat; Y[4*(g)+2]=x_[2]-mhat; Y[4*(g)+3]=x_[3]-mhat; }while(0)
  #define INITT(Y0,Y1,t) do{ INIT4(Y0,0,t,0);INIT4(Y0,1,t,0);INIT4(Y0,2,t,0);INIT4(Y0,3,t,0); INIT4(Y1,0,t,32);INIT4(Y1,1,t,32);INIT4(Y1,2,t,32);INIT4(Y1,3,t,32); }while(0)
  DMA_K(0,0);DMA_V(0,0);DMA_K(1,SLOTB);
  bf16x8 qr[4];
  #pragma unroll
  for(int d0=0;d0<4;++d0)qr[d0]=*reinterpret_cast<const bf16x8*>(&Qw[(long)r32*DM+d0*16+hi*8]);
  float mhat=0.f,l_reg=0.f;f32x16 o[2];o[0]=f32x16{};o[1]=f32x16{};
  const int qrel=wid*QBLK+r32;
  #define CMASK(P0,P1,t) do{int jb_=(t)-(NT-4); if(jb_>=0)cmask(P0,P1,jb_,qrel,hi);}while(0)
  bool resc=false;
  #define START(P0,P1) do{ const float rm=rowmax(P0,P1); resc=false; \
    { const float dl=rm; mhat=fadd_s(mhat,dl); \
      _Pragma("unroll") for(int r=0;r<16;++r){P0[r]=fsub_s(P0[r],dl);P1[r]=fsub_s(P1[r],dl);} } \
    _Pragma("unroll") for(int r=0;r<16;++r)P0[r]=__builtin_amdgcn_exp2f(P0[r]); }while(0)
  #define RESC() do{ if(resc){ asm volatile("s_waitcnt lgkmcnt(0)":::"memory"); \
      _Pragma("unroll") for(int d_=0;d_<2;++d_) _Pragma("unroll") for(int r=0;r<16;++r)o[d_][r]*=wsf[crow(r,hi)]; } }while(0)
  f32x16 pA0,pA1,pB0,pB1;
  int sl_prev=0,sl_cur=0,sl_next=SLOTB;
  #define ROT() do{sl_prev=sl_cur;sl_cur=sl_next;sl_next=(sl_next==(NSLOT-1)*SLOTB)?0:sl_next+SLOTB;}while(0)
  DMA_K(2,2*SLOTB);
  WAIT_BAR(3);
  INITT(pA0,pA1,0); qkt(pA0,pA1,Kbase,qr,r32,hi);asm volatile("s_nop 15\n\ts_nop 7":"+v"(pA0),"+v"(pA1));CMASK(pA0,pA1,0);
  START(pA0,pA1);
  _Pragma("unroll") for(int r=0;r<16;++r)pA1[r]=__builtin_amdgcn_exp2f(pA1[r]);
  INITT(pB0,pB1,1);
  WAIT_BAR(0);
  DMA_K(3,0);DMA_V(1,SLOTB);
  ROT();
  kload8(kf,kp0+sl_cur);
  WAIT_BAR(2);
  s16x4 vlo[8],vhi[8]; u32x4 pw0,pw1,pw2,pw3;
  #define PKW(P,B) cvtpk_s(P[B],P[B+1])
  #define PAF(k) __builtin_bit_cast(bf16x8,pw##k)
  #define VFR(i) (bf16x8){vlo[i][0],vlo[i][1],vlo[i][2],vlo[i][3],vhi[i][0],vhi[i][1],vhi[i][2],vhi[i][3]}
  #define PIN(x) asm volatile("":"+v"(x))
  #define MX3(a,b,c) __builtin_fmaxf(__builtin_fmaxf((a),(b)),(c))
  #define GAPA(MF,A0,A1,A2,A3,W0,W1,PW) do{ MF; sacc+=A0; sacc+=A1; sacc+=A2; sacc+=A3; PIN(sacc); W0; W1; PIN(PW); SBAR(); }while(0)
  #define EX(v) __builtin_amdgcn_exp2f(v)
  #define GAPB(MF,X,B,GN,Y,tn,o) do{ MF; X[B]=EX(X[B]); X[B+1]=EX(X[B+1]); X[B+2]=EX(X[B+2]); X[B+3]=EX(X[B+3]); PIN(X); if(GN){ INIT4(Y,(B)/4,tn,o); PIN(Y); } SBAR(); }while(0)
  #define VRD(i) do{ vlo[i]=vtr(vp_+(((i)>>2)*4096+((i)&3)*1024)); vhi[i]=vtr(vp_+(((i)>>2)*4096+((i)&3)*1024+512)); }while(0)
  #define KRD(G,j) do{ if(G){ kload2(kf,kp0+sl_next,j); SBAR(); } }while(0)
  #define STEP(C0,C1,P0,P1,t,GK,GV,GL) do{ SBAR(); \
    const lds_cptr vp_=vp0+sl_prev; \
    VRD(0); SBAR(); float sacc=(P0[0]+P0[1]); \
    GAPA(C0=__builtin_amdgcn_mfma_f32_32x32x16_bf16(kf[0],qr[0],C0,0,0,0), P0[2],P0[3],P0[4],P0[5],     pw0[0]=PKW(P0,0), pw0[1]=PKW(P0,2), pw0); \
    VRD(4); SBAR(); GAPA(C1=__builtin_amdgcn_mfma_f32_32x32x16_bf16(kf[1],qr[0],C1,0,0,0), P0[6],P0[7],P0[8],P0[9],     pw0[2]=PKW(P0,4), pw0[3]=PKW(P0,6), pw0); \
    VRD(1); SBAR(); GAPA(C0=__builtin_amdgcn_mfma_f32_32x32x16_bf16(kf[2],qr[1],C0,0,0,0),   P0[10],P0[11],P0[12],P0[13], pw1[0]=PKW(P0,8), pw1[1]=PKW(P0,10), pw1); \
    VRD(5); SBAR(); GAPA(C1=__builtin_amdgcn_mfma_f32_32x32x16_bf16(kf[3],qr[1],C1,0,0,0),   P0[14],P0[15],P1[0],P1[1],   pw1[2]=PKW(P0,12),pw1[3]=PKW(P0,14), pw1); \
    VRD(2); SBAR(); GAPA(C0=__builtin_amdgcn_mfma_f32_32x32x16_bf16(kf[4],qr[2],C0,0,0,0),   P1[2],P1[3],P1[4],P1[5],     pw2[0]=PKW(P1,0), pw2[1]=PKW(P1,2), pw2); \
    VRD(6); SBAR(); GAPA(C1=__builtin_amdgcn_mfma_f32_32x32x16_bf16(kf[5],qr[2],C1,0,0,0),   P1[6],P1[7],P1[8],P1[9],     pw2[2]=PKW(P1,4), pw2[3]=PKW(P1,6), pw2); \
    VRD(3); SBAR(); GAPA(C0=__builtin_amdgcn_mfma_f32_32x32x16_bf16(kf[6],qr[3],C0,0,0,0),   P1[10],P1[11],P1[12],P1[13], pw3[0]=PKW(P1,8), pw3[1]=PKW(P1,10), pw3); \
    VRD(7); SBAR(); GAPA(C1=__builtin_amdgcn_mfma_f32_32x32x16_bf16(kf[7],qr[3],C1,0,0,0),   P1[14],P1[15],0.f,0.f,       pw3[2]=PKW(P1,12),pw3[3]=PKW(P1,14), pw3); \
    l_reg+=sacc; \
    if(GK){DMA_K((t)+3,sl_cur);} if(GV){DMA_V((t)+1,sl_next);} \
    CMASK(C0,C1,t); \
    { float a=MX3(C0[0],C0[1],C1[0]),b=MX3(C0[2],C0[3],C1[1]); a=MX3(a,C1[2],C1[3]); \
      _Pragma("unroll") for(int r=4;r<16;r+=4){a=MX3(a,C0[r],C0[r+1]);b=MX3(b,C0[r+2],C0[r+3]);a=MX3(a,C1[r],C1[r+1]);b=MX3(b,C1[r+2],C1[r+3]);} \
      float rm=__builtin_fmaxf(a,b); { auto rr=__builtin_amdgcn_permlane32_swap(__float_as_uint(rm),__float_as_uint(rm),false,false); rm=__builtin_fmaxf(__uint_as_float(rr[0]),__uint_as_float(rr[1])); } \
      resc=false; \
      if(__builtin_expect(__any(rm>(float)THRL),0)){ const float dl=__builtin_fmaxf(rm,0.f); mhat+=dl; \
        _Pragma("unroll") for(int r=0;r<16;++r){C0[r]-=dl;C1[r]-=dl;} \
        const float f=__builtin_amdgcn_exp2f(-dl); l_reg*=f; if(hi==0)wsf[r32]=f; resc=true; } } \
    SBAR(); \
    GAPB(o[0]=__builtin_amdgcn_mfma_f32_32x32x16_bf16(PAF(0),VFR(0),o[0],0,0,0), C0,0,  GL,P0,(t)+1,0); \
    GAPB(o[1]=__builtin_amdgcn_mfma_f32_32x32x16_bf16(PAF(0),VFR(4),o[1],0,0,0), C0,4,  GL,P0,(t)+1,0); \
    KRD(GL,0); GAPB(o[0]=__builtin_amdgcn_mfma_f32_32x32x16_bf16(PAF(1),VFR(1),o[0],0,0,0), C0,8,  GL,P0,(t)+1,0); \
    KRD(GL,1); GAPB(o[1]=__builtin_amdgcn_mfma_f32_32x32x16_bf16(PAF(1),VFR(5),o[1],0,0,0), C0,12, GL,P0,(t)+1,0); \
    KRD(GL,2); GAPB(o[0]=__builtin_amdgcn_mfma_f32_32x32x16_bf16(PAF(2),VFR(2),o[0],0,0,0), C1,0,  GL,P1,(t)+1,32); \
    KRD(GL,3); GAPB(o[1]=__builtin_amdgcn_mfma_f32_32x32x16_bf16(PAF(2),VFR(6),o[1],0,0,0), C1,4,  GL,P1,(t)+1,32); \
    GAPB(o[0]=__builtin_amdgcn_mfma_f32_32x32x16_bf16(PAF(3),VFR(3),o[0],0,0,0), C1,8,  GL,P1,(t)+1,32); \
    GAPB(o[1]=__builtin_amdgcn_mfma_f32_32x32x16_bf16(PAF(3),VFR(7),o[1],0,0,0), C1,12, GL,P1,(t)+1,32); \
    }while(0)
  int t=1;
  #undef CMASK
  #define CMASK(P0,P1,t) do{}while(0)
  for(;t+5<NT;t+=2){
    STEP(pB0,pB1,pA0,pA1,t,true,true,true);     WAIT_BAR(2); RESC(); ROT();
    STEP(pA0,pA1,pB0,pB1,t+1,true,true,true);   WAIT_BAR(2); RESC(); ROT();
  }
  #undef CMASK
  #define CMASK(P0,P1,t) do{int jb_=(t)-(NT-4); if(jb_>=0)cmask(P0,P1,jb_,qrel,hi);}while(0)
  #define ENDW(tt) do{ if((tt)+3<NT){WAIT_BAR(2);} else if((tt)+2<NT){WAIT_BAR(1);} else {WAIT_BAR(0);} }while(0)
  for(;t+1<NT;t+=2){
    STEP(pB0,pB1,pA0,pA1,t,(t+3<NT),(t+1<NT),(t+1<NT));       ENDW(t);   RESC(); ROT();
    STEP(pA0,pA1,pB0,pB1,t+1,(t+4<NT),(t+2<NT),(t+2<NT));     ENDW(t+1); RESC(); ROT();
  }
  STEP(pB0,pB1,pA0,pA1,NT-1,false,false,false); RESC();
  { float sacc=pB0[0]+pB0[1]; _Pragma("unroll") for(int r=2;r<16;++r)sacc+=pB0[r]; _Pragma("unroll") for(int r=0;r<16;++r)sacc+=pB1[r]; l_reg+=sacc;
    pw0=(u32x4){PKW(pB0,0),PKW(pB0,2),PKW(pB0,4),PKW(pB0,6)};pw1=(u32x4){PKW(pB0,8),PKW(pB0,10),PKW(pB0,12),PKW(pB0,14)};pw2=(u32x4){PKW(pB1,0),PKW(pB1,2),PKW(pB1,4),PKW(pB1,6)};pw3=(u32x4){PKW(pB1,8),PKW(pB1,10),PKW(pB1,12),PKW(pB1,14)};
    SBAR(); pv(o,vb0+sl_cur,PAF(0),PAF(1),PAF(2),PAF(3)); }
  #undef PKW
  #undef PAF
  #undef VFR
  #undef PIN
  #undef MX3
  #undef GAPA
  #undef GAPB
  #undef EX
  #undef VRD
  #undef KRD
  #undef STEP
  #undef ENDW
  {auto rr=__builtin_amdgcn_permlane32_swap(__float_as_uint(l_reg),__float_as_uint(l_reg),false,false);l_reg=__uint_as_float(rr[0])+__uint_as_float(rr[1]);}
  if(hi==0)wsf[32+r32]=l_reg;asm volatile("s_waitcnt lgkmcnt(0)":::"memory");
  float rli[16];
  #pragma unroll
  for(int r=0;r<16;++r)rli[r]=__builtin_amdgcn_rcpf(wsf[32+crow(r,hi)]);
  bf16*Ow=O+(rowbase+q0+wid*QBLK)*OPITCH+h*D; float*Sw=SSQ+(rowbase+q0+wid*QBLK)*NHEAD+h;
  { bf16*stg=(bf16*)(shm+LDS_OST)+wid*2048;
    #pragma unroll
    for(int r=0;r<16;++r){const int orow=crow(r,hi);
      #pragma unroll
      for(int d0=0;d0<2;++d0)stg[orow*64+d0*32+r32]=__float2bfloat16(o[d0][r]*rli[r]);}
    asm volatile("s_waitcnt lgkmcnt(0)":::"memory");
    #pragma unroll
    for(int i=0;i<4;++i){const int row=i*8+(lane>>3),ch=lane&7; const u32x4 v=*(const u32x4*)(stg+row*64+ch*8); ATTN_STORE16(Ow+(long)row*OPITCH+ch*8,v);
      float sq=0.f;
      #pragma unroll
      for(int j=0;j<4;++j){ const float lo_=__uint_as_float(v[j]<<16), hi_=__uint_as_float(v[j]&0xffff0000u); sq+=lo_*lo_+hi_*hi_; }
      sq+=__shfl_xor(sq,1); sq+=__shfl_xor(sq,2); sq+=__shfl_xor(sq,4);
      if(ch==0)Sw[(long)row*NHEAD]=sq; } }
  asm volatile("s_waitcnt lgkmcnt(0)\n\ts_barrier":::"memory");
  #undef DMA_K
  #undef BIAS4
  #undef INIT4
  #undef INITT
  #undef DMA_V
  #undef CMASK
  #undef START
  #undef RESC
  #undef ROT
}
constexpr int ATTN_LDS_BYTES=LDS_BYTES;
struct AttnTensors { const bf16* Q; const bf16* K; const bf16* V; bf16* O; const float* LOGF2; float* SSQ; };
struct AttnUnit { int bh; int qb; };
struct StaticOrder {
  int vcu,G;
  __device__ __forceinline__ explicit StaticOrder(int grid,int vcu_):vcu(vcu_),G(grid){}
  __device__ __forceinline__ bool next(int i,AttnUnit&u)const{ const int L=(i>>1)*G+vcu; if(L>=BATCH*NHEAD*4)return false; const int s=L&3; u.bh=L>>2; u.qb=(i&1)?7-s:s; return true; }
  __device__ __forceinline__ void a_ready(const AttnUnit&)const{}
  __device__ __forceinline__ void done(const AttnUnit&)const{}
};
template<class Sched,int THRL=8> __device__ __forceinline__ void attn_phase(char*lds,const AttnTensors&T,const Sched&S){
  AttnUnit u;
  for(int i=0;S.next(i,u);++i){ S.a_ready(u); attn_unit<THRL>(u.bh/NHEAD,u.bh%NHEAD,u.qb,T.Q,T.K,T.V,T.O,T.LOGF2,T.SSQ,lds); S.done(u); }
}
#undef SBAR
#undef WAIT_BAR
}

constexpr int NWAVES = 8;
constexpr int NPHASES = 11;

constexpr size_t MiB = 1u << 20, KiB = 1u << 10;
constexpr size_t WS_CTL = 0, CTL_ZERO_BYTES = 1 * MiB;
constexpr size_t WS_MOD = 1 * MiB;
constexpr size_t WS_LOGF2 = 1 * MiB + 256 * KiB;
constexpr size_t WS_SSQ = 1 * MiB + 768 * KiB;
constexpr size_t WS_TOPI = 2 * MiB + 256 * KiB;
constexpr size_t WS_TOPW = 2 * MiB + 512 * KiB;
constexpr size_t WS_WGCNT = 2 * MiB + 768 * KiB;
constexpr size_t WS_LSUM = 3 * MiB;
constexpr size_t WS_ROWTOK = 4 * MiB, WS_ROWPAIR = 4 * MiB + 512 * KiB, WS_ROWW = 5 * MiB, WS_MTEXP = 5 * MiB + 512 * KiB;
constexpr size_t WS_LWT = 6 * MiB;
constexpr size_t WS_WFT = 6 * MiB + 512 * KiB;
constexpr size_t WS_WRT = 7 * MiB;
constexpr size_t WS_WIN = 8 * MiB;
constexpr size_t WS_WOUT = 13 * MiB;
constexpr size_t WS_WUP = 16 * MiB;
constexpr size_t WS_WDN = 144 * MiB;
constexpr size_t WS_H1 = 208 * MiB;
constexpr size_t WS_PJ = 240 * MiB;
constexpr size_t PJ_STRIDE = (size_t)NTOK * 512;
constexpr size_t WS_MRG = 320 * MiB;
constexpr size_t WS_Y = 352 * MiB;
constexpr size_t WS_H2 = 416 * MiB;
constexpr size_t WS_ACT = 448 * MiB;
constexpr size_t WS_YP = 592 * MiB;
constexpr size_t WS_LTOK = 720 * MiB, WS_LPAIR = 722 * MiB, WS_LW = 724 * MiB;
constexpr size_t WS_END = 726 * MiB;
static_assert(WS_ACT + (size_t)MAXROWS * 1024 * 2 <= WS_YP && WS_YP + (size_t)NTOK * 4 * 1024 * 2 <= WS_END, "d_ws map");
constexpr int CW_CNT = 200000;
constexpr int CW_BAR = 4096;

constexpr int LDS_BYTES = 147456;
constexpr int LDSCTL_OFF = LDS_BYTES - 512, MISC_OFF = LDSCTL_OFF + 320;
constexpr int SCRATCH_BYTES = LDSCTL_OFF;

#define GAS __attribute__((address_space(1)))
#define LAS __attribute__((address_space(3)))
typedef unsigned short bf16;
typedef unsigned v4u __attribute__((ext_vector_type(4)));
typedef unsigned v2u __attribute__((ext_vector_type(2)));
typedef float f32x4 __attribute__((ext_vector_type(4)));
typedef float f32x16 __attribute__((ext_vector_type(16)));
typedef short bf16x8 __attribute__((ext_vector_type(8)));
typedef GAS unsigned gu32;
#define RLX_AGENT __ATOMIC_RELAXED, __HIP_MEMORY_SCOPE_AGENT
#define LDS_WAIT() asm volatile("s_waitcnt lgkmcnt(0)" ::: "memory")
#define VM_WAIT() asm volatile("s_waitcnt vmcnt(0)" ::: "memory")
__device__ __forceinline__ unsigned f2bf(float f) { unsigned u = __builtin_bit_cast(unsigned, f); return (u + 0x7fffu + ((u >> 16) & 1u)) >> 16; }
__device__ __forceinline__ unsigned pk2(float lo, float hi) { return f2bf(lo) | (f2bf(hi) << 16); }
__device__ __forceinline__ float bflo(unsigned w) { return __uint_as_float(w << 16); }
__device__ __forceinline__ float bfhi(unsigned w) { return __uint_as_float(w & 0xffff0000u); }
__device__ __forceinline__ float bf1(bf16 h) { return __uint_as_float((unsigned)h << 16); }

#define XB_TMO      128
#define XB_XCNT(j)  (256  + 64 * (j))
#define XB_XSUB(j)  (1280 + 64 * (j))
#define XB_XGEN(j)  (2304 + 64 * (j))
#define XB_TOP      3328
#define XB_TOPGEN   3392
#define XCD_BAR_WORDS 3456
#define XB_SPIN_CAP (1u << 18)
__device__ __forceinline__ unsigned xb_ld(unsigned* p)              { return __hip_atomic_load(p, __ATOMIC_RELAXED, __HIP_MEMORY_SCOPE_AGENT); }
__device__ __forceinline__ unsigned xb_add(unsigned* p, unsigned v) { return __hip_atomic_fetch_add(p, v, __ATOMIC_RELAXED, __HIP_MEMORY_SCOPE_AGENT); }
__device__ __forceinline__ unsigned xb_xcc_id() { return (unsigned)__builtin_amdgcn_s_getreg((3 << 11) | 20) & 0xFu; }
#define XB_SPIN(cond, bar) do { unsigned _sp = 0; while (cond) { __builtin_amdgcn_s_sleep(1); \
    if ((++_sp & 255u) == 0u) { if (xb_ld(&(bar)[XB_TMO])) break; if (_sp > XB_SPIN_CAP) { atomicAdd(&(bar)[XB_TMO], 1u); break; } } } } while (0)
struct XcdBarrier { unsigned* bar; unsigned x; volatile LAS unsigned* st; };
__device__ __forceinline__ XcdBarrier xcd_barrier_post(unsigned* bar, volatile LAS unsigned* st) {
    XcdBarrier b; b.bar = bar; b.x = xb_xcc_id(); b.st = st;
    if (threadIdx.x == 0) (void)xb_add(&bar[XB_XCNT(b.x)], 1u);
    return b;
}
__device__ __forceinline__ void xcd_barrier_complete(unsigned* bar, unsigned x, unsigned& nloc, unsigned& nx) {
    const unsigned G = gridDim.x * gridDim.y * gridDim.z;
    unsigned sum, cnt, mine, sp = 0u;
    for (;;) {
        sum = 0u; cnt = 0u; mine = 0u;
#pragma unroll
        for (unsigned j = 0; j < 16; ++j) { const unsigned c = xb_ld(&bar[XB_XCNT(j)]); sum += c; cnt += (c > 0u) ? 1u : 0u; mine = (j == x) ? c : mine; }
        if (sum == G) break;
        __builtin_amdgcn_s_sleep(1);
        if ((++sp & 255u) == 0u) { if (xb_ld(&bar[XB_TMO])) break; if (sp > XB_SPIN_CAP) { atomicAdd(&bar[XB_TMO], 1u); break; } }
    }
    nloc = mine > 0u ? mine : 1u; nx = cnt > 0u ? cnt : 1u;
}
__device__ __forceinline__ void xcd_barrier(const XcdBarrier& b) {
    asm volatile("s_waitcnt vmcnt(0)" ::: "memory");
    __syncthreads();
    if (threadIdx.x == 0) {
        unsigned* bar = b.bar;
        __builtin_amdgcn_s_waitcnt(0);
        unsigned nloc = b.st[0], nx = b.st[1];
        if (nloc == 0u) { xcd_barrier_complete(bar, b.x, nloc, nx); b.st[0] = nloc; b.st[1] = nx; }
        const unsigned old = xb_add(&bar[XB_XSUB(b.x)], 1u);
        const unsigned gen = old / nloc;
        if (old + 1u == (gen + 1u) * nloc) {
            __builtin_amdgcn_fence(__ATOMIC_RELEASE, "agent");
            asm volatile("s_waitcnt vmcnt(0)" ::: "memory");
            const unsigned og = xb_add(&bar[XB_TOP], 1u);
            const unsigned tg = og / nx;
            if (og + 1u == (tg + 1u) * nx) xb_add(&bar[XB_TOPGEN], 1u);
            else XB_SPIN(xb_ld(&bar[XB_TOPGEN]) == tg, bar);
            __builtin_amdgcn_fence(__ATOMIC_ACQUIRE, "agent");
            xb_add(&bar[XB_XGEN(b.x)], 1u);
            asm volatile("s_waitcnt vmcnt(0)" ::: "memory");
        } else {
            XB_SPIN(xb_ld(&bar[XB_XGEN(b.x)]) == gen, bar);
            __builtin_amdgcn_fence(__ATOMIC_ACQUIRE, "agent");
            asm volatile("s_waitcnt vmcnt(0)" ::: "memory");
        }
    }
    __syncthreads();
}

struct Args { const float* in[26]; float* out; unsigned char* ws; int ph_lo, ph_hi, li, pad; };
struct Frame {
    LAS unsigned char* lds;
    int tid, lane, wave, vcu, G;
    float* out; unsigned char* ws;
    __device__ __forceinline__ const float* in(int k) const { const LAS unsigned* t = (const LAS unsigned*)(lds + LDSCTL_OFF) + 2 * k;
        const unsigned lo = (unsigned)__builtin_amdgcn_readfirstlane((int)t[0]), hi = (unsigned)__builtin_amdgcn_readfirstlane((int)t[1]);
        return (const float*)(const GAS float*)(((unsigned long long)hi << 32) | lo); }
};
__device__ __forceinline__ float wave_sum(float v) {
#pragma unroll
    for (int o = 1; o < 64; o <<= 1) v += __shfl_xor(v, o);
    return v;
}
__device__ __forceinline__ float wave_max(float v) {
#pragma unroll
    for (int o = 1; o < 64; o <<= 1) v = fmaxf(v, __shfl_xor(v, o));
    return v;
}
__device__ __forceinline__ float sigmoid_f(float x) { return __builtin_amdgcn_rcpf(1.0f + __builtin_amdgcn_exp2f(-1.4426950408889634f * x)); }
__device__ __forceinline__ float gelu_tanh_f(float x) { const float u = 0.7978845608028654f * (x + 0.044715f * x * x * x); const float e = __builtin_amdgcn_exp2f(2.8853900817779268f * u); return x * (1.0f - __builtin_amdgcn_rcpf(e + 1.0f)); }
__device__ __forceinline__ float log_sigmoid_f(float z) { return z >= 0.f ? -log1pf(expf(-z)) : z - log1pf(expf(z)); }
__device__ __forceinline__ float softplus_f(float z) { return z > 0.f ? z + log1pf(expf(-z)) : log1pf(expf(z)); }

__device__ __forceinline__ void p0_transpose_item(const float* W, int ldw, bf16* WT, int k0, int n0, int kdst0, const float* gain, LAS float* scr, int lane) {
#pragma unroll 8
    for (int i = 0; i < 32; ++i) { const int kk = 2 * i + (lane >> 5); float v = W[(size_t)(k0 + kk) * ldw + n0 + (lane & 31)]; if (gain) v *= gain[k0 + kk]; scr[kk * 33 + (lane & 31)] = v; }
    LDS_WAIT(); asm volatile("" ::: "memory");
    const int c = lane & 7;
#pragma unroll
    for (int j = 0; j < 4; ++j) { const int n = (lane >> 3) + 8 * j; const LAS float* s = scr + (8 * c) * 33 + n;
        v4u o; o.x = pk2(s[0 * 33], s[1 * 33]); o.y = pk2(s[2 * 33], s[3 * 33]); o.z = pk2(s[4 * 33], s[5 * 33]); o.w = pk2(s[6 * 33], s[7 * 33]);
        *(GAS v4u*)(WT + (size_t)(n0 + n) * 1024 + kdst0 + 8 * c) = o; }
    LDS_WAIT(); asm volatile("" ::: "memory");
}
constexpr int CV_UP_ITEMS = NE * 16 * 32, CV_DN_ITEMS = NE * 16 * 16;
constexpr int CV_UP_TAIL = 8192, CV_DN_TAIL = 4096;
__device__ __forceinline__ void cvt_block_f8(const float* W, int ldw, unsigned char* WT, LAS unsigned char* scr, int lane) {
    float v[64];
#pragma unroll
    for (int i = 0; i < 64; ++i) v[i] = W[(size_t)i * ldw + lane];
#pragma unroll
    for (int q = 0; q < 4; ++q) { int w[4];
#pragma unroll
        for (int j = 0; j < 4; ++j) { int t = 0; t = __builtin_amdgcn_cvt_pk_fp8_f32(v[16 * q + 4 * j] * 64.0f, v[16 * q + 4 * j + 1] * 64.0f, t, false); t = __builtin_amdgcn_cvt_pk_fp8_f32(v[16 * q + 4 * j + 2] * 64.0f, v[16 * q + 4 * j + 3] * 64.0f, t, true); w[j] = t; }
        *(LAS v4u*)(scr + lane * 80 + 16 * q) = (v4u){(unsigned)w[0], (unsigned)w[1], (unsigned)w[2], (unsigned)w[3]}; }
    LDS_WAIT(); asm volatile("" ::: "memory");
#pragma unroll
    for (int j = 0; j < 4; ++j) { const int row = 16 * j + (lane >> 2), c = lane & 3;
        *(GAS v4u*)(WT + (size_t)row * 1024 + 16 * c) = *(const LAS v4u*)(scr + row * 80 + 16 * c); }
    LDS_WAIT(); asm volatile("" ::: "memory");
}
__device__ __forceinline__ void cvt_up_item(Frame& F, int u) { const int e = u >> 9, q = u & 511, kb = q >> 5, nb = q & 31;
    cvt_block_f8(F.in(22) + (size_t)e * DM * 2 * DEXP + (size_t)(64 * kb) * (2 * DEXP) + 64 * nb, 2 * DEXP, (unsigned char*)(F.ws + WS_WUP) + ((size_t)e * 2 * DEXP + 64 * nb) * 1024 + 64 * kb, F.lds + F.wave * 16384, F.lane); }
__device__ __forceinline__ void cvt_dn_item(Frame& F, int d) { const int e = d >> 8, q = d & 255, kb = q >> 4, nb = q & 15;
    cvt_block_f8(F.in(24) + (size_t)e * DEXP * DM + (size_t)(64 * kb) * DM + 64 * nb, DM, (unsigned char*)(F.ws + WS_WDN) + ((size_t)e * DM + 64 * nb) * 1024 + 64 * kb, F.lds + F.wave * 16384, F.lane); }
template <bool UP> __device__ __forceinline__ void cvt_range(Frame& F, int lo, int hi, int wr_, int nw) {
    for (int it = lo + wr_; it < hi; it += nw) { if (UP) cvt_up_item(F, it); else cvt_dn_item(F, it); }
}
__device__ __forceinline__ void p0_transpose_item_f8(const float* W, int ldw, unsigned char* WT, int k0, int n0, float scale, LAS float* scr, int lane) {
#pragma unroll 8
    for (int i = 0; i < 32; ++i) { const int kk = 2 * i + (lane >> 5); scr[kk * 33 + (lane & 31)] = W[(size_t)(k0 + kk) * ldw + n0 + (lane & 31)] * scale; }
    LDS_WAIT(); asm volatile("" ::: "memory");
    const int c = lane & 7;
#pragma unroll
    for (int j = 0; j < 4; ++j) { const int n = (lane >> 3) + 8 * j; const LAS float* s = scr + (8 * c) * 33 + n;
        int w0 = 0, w1 = 0; w0 = __builtin_amdgcn_cvt_pk_fp8_f32(s[0 * 33], s[1 * 33], w0, false); w0 = __builtin_amdgcn_cvt_pk_fp8_f32(s[2 * 33], s[3 * 33], w0, true);
        w1 = __builtin_amdgcn_cvt_pk_fp8_f32(s[4 * 33], s[5 * 33], w1, false); w1 = __builtin_amdgcn_cvt_pk_fp8_f32(s[6 * 33], s[7 * 33], w1, true);
        typedef int i32x2_ __attribute__((ext_vector_type(2))); *(GAS i32x2_*)(WT + (size_t)(n0 + n) * 1024 + k0 + 8 * c) = (i32x2_){w0, w1}; }
    LDS_WAIT(); asm volatile("" ::: "memory");
}
template <int PARTS = 7> __device__ __forceinline__ void p0_phase(Frame& F) {
    const float* c_in = F.in(1); const float* w_ada = F.in(2); const float* b_ada = F.in(3);
    float* MOD = (float*)(F.ws + WS_MOD);
    if ((PARTS & 1) && F.vcu < 192) {
        LAS float* sc = (LAS float*)F.lds;
        LAS float* red = (LAS float*)(F.lds + 32768);
        for (int i = F.tid; i < BATCH * DM; i += NWAVES * 64) { const int b = i >> 10, k = i & 1023; const float v = c_in[i]; sc[k * 8 + b] = v * sigmoid_f(v); }
        __syncthreads();
        for (int ci = F.vcu; ci < 192; ci += F.G) {
            const int col = F.lane & 31, ks = F.lane >> 5;
            float acc[8];
#pragma unroll
            for (int b = 0; b < 8; ++b) acc[b] = 0.f;
            const float* wp = w_ada + (size_t)(128 * F.wave + ks) * (NMOD * DM) + ci * 32 + col;
#pragma unroll 1
            for (int i0 = 0; i0 < 64; i0 += 32) {
                float wv[32];
#pragma unroll
                for (int i = 0; i < 32; ++i) wv[i] = wp[(size_t)(2 * (i0 + i)) * (NMOD * DM)];
#pragma unroll
                for (int i = 0; i < 32; ++i) { const LAS f32x4* sp = (const LAS f32x4*)(sc + (128 * F.wave + 2 * (i0 + i) + ks) * 8); const f32x4 s0 = sp[0], s1 = sp[1];
                    acc[0] += s0[0] * wv[i]; acc[1] += s0[1] * wv[i]; acc[2] += s0[2] * wv[i]; acc[3] += s0[3] * wv[i]; acc[4] += s1[0] * wv[i]; acc[5] += s1[1] * wv[i]; acc[6] += s1[2] * wv[i]; acc[7] += s1[3] * wv[i]; }
            }
#pragma unroll
            for (int b = 0; b < 8; ++b) { acc[b] += __shfl_xor(acc[b], 32); if (ks == 0) red[(F.wave * 8 + b) * 32 + col] = acc[b]; }
            __syncthreads();
            if (F.tid < 256) { const int b = F.tid >> 5, cl = F.tid & 31; float s = 0.f;
#pragma unroll
              for (int w = 0; w < 8; ++w) s += red[(w * 8 + b) * 32 + cl];
              MOD[b * NMOD * DM + ci * 32 + cl] = s + b_ada[ci * 32 + cl]; }
            __syncthreads();
        }
    }
    __syncthreads();
    const float* w_in = F.in(6); const float* w_out = F.in(17); const float* gn_attn = F.in(16);
    bf16* WIN = (bf16*)(F.ws + WS_WIN); bf16* WOUT = (bf16*)(F.ws + WS_WOUT);
    LAS float* scr = (LAS float*)(F.lds + F.wave * 16384);
    const int gw = F.vcu * NWAVES + F.wave, NGW = F.G * NWAVES;
    constexpr int I_IN = 16 * (NPJ / 32), I_OUT = 16 * (DM / 32);
    constexpr int NITEMS = I_IN + I_OUT;
    if (PARTS & 2) for (int it = gw; it < NITEMS; it += NGW) {
        int r = it;
        if (r < I_IN) { const int kb = r / (NPJ / 32), nb = r % (NPJ / 32); p0_transpose_item(w_in, NPROJ, WIN, 64 * kb, 32 * nb, 64 * kb, nullptr, scr, F.lane); continue; } r -= I_IN;
        { const int kb = r / (DM / 32), nb = r % (DM / 32); const int k0 = 64 * kb;
            p0_transpose_item(w_out, DM, WOUT, k0, 32 * nb, (k0 + 512) & 1023, k0 >= 512 ? gn_attn - 512 : nullptr, scr, F.lane); }
    }
    if (PARTS & 4) {
        if (F.G == 256) {
            constexpr int NU = CV_UP_ITEMS - CV_UP_TAIL, NV = NU + (CV_DN_ITEMS - CV_DN_TAIL);
            auto run = [&](int v) { if (v < NU) cvt_up_item(F, CV_UP_TAIL + v); else cvt_dn_item(F, CV_DN_TAIL + (v - NU)); };
            constexpr int A_END = 2048 * 5;
            for (int v = gw; v < A_END && v < NV; v += NGW) run(v);
            if (F.vcu >= 192) { const int r = (F.vcu - 192) * NWAVES + F.wave; for (int v = A_END + r; v < A_END + 1536 && v < NV; v += 512) run(v); }
            else { const int r = F.vcu * NWAVES + F.wave; if (r < 512) { const int v = A_END + 1536 + r; if (v < NV) run(v); } }
            static_assert(A_END + 1536 + 512 >= NV, "phase-0 conversion shares cover the list");
        } else { cvt_range<true>(F, 0, CV_UP_ITEMS, gw, NGW); cvt_range<false>(F, 0, CV_DN_ITEMS, gw, NGW); }
    }
    if (PARTS & 2) { const float* w_in2 = F.in(6); float* WFT = (float*)(F.ws + WS_WFT);
      for (int idx = F.vcu * (NWAVES * 64) + F.tid; idx < 8 * DM; idx += F.G * NWAVES * 64) { const int h = idx >> 10, k = idx & 1023; WFT[idx] = w_in2[(size_t)k * NPROJ + NPJ + h]; } }
    { const float* w_router = F.in(20); float* WRT = (float*)(F.ws + WS_WRT);
      for (int idx = F.vcu * (NWAVES * 64) + F.tid; idx < NE * DM; idx += F.G * NWAVES * 64) { const int e = idx >> 10, k = idx & 1023; WRT[idx] = w_router[k * NE + e]; } }
    { const float* wa = F.in(9); const float* wx = F.in(11); bf16* LWT = (bf16*)(F.ws + WS_LWT);
      for (int idx = F.vcu * (NWAVES * 64) + F.tid; idx < 2 * 8 * 64 * 64; idx += F.G * NWAVES * 64) { const int gate = idx >> 15, g = (idx >> 12) & 7, j = (idx >> 6) & 63, i = idx & 63;
          LWT[idx] = (bf16)f2bf((gate ? wx : wa)[(g * 64 + i) * 64 + j]); } }
}

__device__ __forceinline__ void p1_phase(Frame& F) {
    const float* x = F.in(0); const float* gpre = F.in(4); const float* fb = F.in(14);
    const float* MOD = (const float*)(F.ws + WS_MOD); bf16* H1 = (bf16*)(F.ws + WS_H1); float* LOGF2 = (float*)(F.ws + WS_LOGF2);
    LAS float* wf = (LAS float*)F.lds;
    { const float* WFT = (const float*)(F.ws + WS_WFT);
#pragma unroll
      for (int i = F.tid; i < 8 * DM / 4; i += NWAVES * 64) *(LAS f32x4*)(wf + 4 * i) = *(const f32x4*)(WFT + 4 * i); }
    __syncthreads();
    const int gw = F.vcu * NWAVES + F.wave;
    if (F.G * NWAVES * 8 != NTOK) return;
    const int row0 = gw * 8, b = row0 / SEQ;
    f32x4 gm[4], sh[4];
#pragma unroll
    for (int j = 0; j < 4; ++j) { const int k = 4 * F.lane + 256 * j; const f32x4 g = *(const f32x4*)(gpre + k), s = *(const f32x4*)(MOD + b * NMOD * DM + DM + k); gm[j] = g * (s + 1.0f); sh[j] = *(const f32x4*)(MOD + b * NMOD * DM + k); }
    f32x4 nx[4];
#pragma unroll
    for (int j = 0; j < 4; ++j) nx[j] = *(const f32x4*)(x + (size_t)row0 * DM + 4 * F.lane + 256 * j);
    for (int r = 0; r < 8; ++r) { const int row = row0 + r;
        f32x4 v[4]; float ss = 0.f;
#pragma unroll
        for (int j = 0; j < 4; ++j) { v[j] = nx[j]; ss += (v[j][0] * v[j][0] + v[j][1] * v[j][1]) + (v[j][2] * v[j][2] + v[j][3] * v[j][3]); }
        if (r < 7) {
#pragma unroll
            for (int j = 0; j < 4; ++j) nx[j] = *(const f32x4*)(x + (size_t)(row + 1) * DM + 4 * F.lane + 256 * j); }
        const float rinv = 1.0f / sqrtf(wave_sum(ss) * (1.0f / DM) + RMS_EPS);
        float fl[8];
#pragma unroll
        for (int h = 0; h < 8; ++h) fl[h] = 0.f;
#pragma unroll
        for (int j = 0; j < 4; ++j) { const f32x4 hv = v[j] * rinv * gm[j] + sh[j];
            v2u o; o.x = pk2(hv[0], hv[1]); o.y = pk2(hv[2], hv[3]); *(GAS v2u*)(H1 + (size_t)row * DM + 4 * F.lane + 256 * j) = o;
#pragma unroll
            for (int h = 0; h < 8; ++h) { const f32x4 w = *(const LAS f32x4*)(wf + h * DM + 4 * F.lane + 256 * j); fl[h] += (hv[0] * w[0] + hv[1] * w[1]) + (hv[2] * w[2] + hv[3] * w[3]); } }
#pragma unroll
        for (int h = 0; h < 8; ++h) fl[h] = wave_sum(fl[h]);
        if (F.lane < 8) { float f = fl[0];
#pragma unroll
            for (int h = 1; h < 8; ++h) f = (F.lane == h) ? fl[h] : f;
            LOGF2[(size_t)row * 8 + F.lane] = log_sigmoid_f(f + fb[F.lane]) * 1.4426950408889634f; }
    }
}

constexpr int LRU_XP = 1040;
constexpr int LRU_XT = 0, LRU_XC = 69696, LRU_CAR = 136256;
constexpr int CW_LRU = 131072;
static_assert(LRU_CAR + 2048 <= SCRATCH_BYTES && 67 * LRU_XP <= LRU_XC && LRU_XC + 64 * LRU_XP <= LRU_CAR, "LRU LDS map");
__device__ __forceinline__ float one_minus_exp(float x) { const float p = -x * (1.0f + x * (0.5f + x * (0.16666667f + x * (0.041666668f + x * (0.0083333338f + x * (0.0013888889f + x * 0.00019841270f)))))); const float d = 1.0f - __builtin_amdgcn_exp2f(1.4426950408889634f * x); return x > -0.25f ? p : d; }
__device__ __forceinline__ void lru_item(Frame& F, int b, int c) {
    LAS unsigned char* XT = F.lds + LRU_XT; LAS unsigned char* XC = F.lds + LRU_XC; LAS float* CAR = (LAS float*)(F.lds + LRU_CAR);
    const bf16* XL = (const bf16*)(F.ws + WS_PJ); const bf16* YL = XL + PJ_STRIDE; const bf16* LWT = (const bf16*)(F.ws + WS_LWT);
    float* LSUM = (float*)(F.ws + WS_LSUM); bf16* MRG = (bf16*)(F.ws + WS_MRG); unsigned* flags = (unsigned*)(F.ws + WS_CTL) + CW_LRU;
    const float* conv_w = F.in(7); const float* conv_b = F.in(8); const float* ba = F.in(10); const float* bx = F.in(12); const float* lam = F.in(13); const float* gn_lru = F.in(15);
    const int t0 = c * 64; const size_t rowb = (size_t)b * SEQ;
    { v4u xv[9];
#pragma unroll
      for (int q = 0; q < 9; ++q) { const int p = F.tid + q * (NWAVES * 64), i = p >> 6, c8 = p & 63, t = t0 - 3 + i; xv[q] = (v4u){0u, 0u, 0u, 0u};
          if (p < 67 * 64 && t >= 0) xv[q] = *(const GAS v4u*)(XL + (rowb + t) * 512 + c8 * 8); }
#pragma unroll
      for (int q = 0; q < 9; ++q) { const int p = F.tid + q * (NWAVES * 64), i = p >> 6, c8 = p & 63; if (p < 67 * 64) *(LAS v4u*)(XT + i * LRU_XP + c8 * 16) = xv[q]; } }
    v4u yv8[8];
#pragma unroll
    for (int q = 0; q < 8; ++q) { const int p = F.tid + q * (NWAVES * 64), i = p >> 6, c8 = p & 63; yv8[q] = *(const GAS v4u*)(YL + (rowb + t0 + i) * 512 + c8 * 8); }
    __syncthreads();
    { const int ch = F.tid; const float w0 = conv_w[ch], w1 = conv_w[512 + ch], w2 = conv_w[1024 + ch], w3 = conv_w[1536 + ch], cb = conv_b[ch];
      float xa = bf1(*(const LAS bf16*)(XT + 0 * LRU_XP + ch * 2)), xb = bf1(*(const LAS bf16*)(XT + 1 * LRU_XP + ch * 2)), xc = bf1(*(const LAS bf16*)(XT + 2 * LRU_XP + ch * 2));
#pragma unroll 8
      for (int t = 0; t < 64; ++t) { const float xd = bf1(*(const LAS bf16*)(XT + (t + 3) * LRU_XP + ch * 2)); const float v = ((w0 * xa + w1 * xb) + (w2 * xc + w3 * xd)) + cb;
          *(LAS bf16*)(XC + t * LRU_XP + ch * 2) = (bf16)f2bf(v); xa = xb; xb = xc; xc = xd; } }
    __syncthreads();
#pragma unroll
    for (int q = 0; q < 8; ++q) { const int p = F.tid + q * (NWAVES * 64), i = p >> 6, c8 = p & 63; *(LAS v4u*)(XT + i * LRU_XP + c8 * 16) = yv8[q]; }
    const int g = F.wave, l31 = F.lane & 31, hi = F.lane >> 5;
    __syncthreads();
#pragma unroll 1
    for (int hp = 0; hp < 2; ++hp) {
        const int chl = g * 64 + 32 * hp + l31;
        f32x16 cumA[2], hloc[2];
#pragma unroll
        for (int tg = 0; tg < 2; ++tg) { cumA[tg] = f32x16{}; hloc[tg] = f32x16{}; }
#pragma unroll
        for (int s = 0; s < 4; ++s) {
            const bf16x8 wa = *(const GAS bf16x8*)(LWT + ((size_t)((0 * 8 + g) * 64 + 32 * hp + l31)) * 64 + 16 * s + 8 * hi);
            const bf16x8 wx = *(const GAS bf16x8*)(LWT + ((size_t)((1 * 8 + g) * 64 + 32 * hp + l31)) * 64 + 16 * s + 8 * hi);
#pragma unroll
            for (int tg = 0; tg < 2; ++tg) { const bf16x8 bfr = *(const LAS bf16x8*)(XC + (32 * tg + l31) * LRU_XP + (g * 64 + 16 * s + 8 * hi) * 2);
                cumA[tg] = __builtin_amdgcn_mfma_f32_32x32x16_bf16(bfr, wa, cumA[tg], 0, 0, 0); hloc[tg] = __builtin_amdgcn_mfma_f32_32x32x16_bf16(bfr, wx, hloc[tg], 0, 0, 0); }
        }
        const float pba = ba[chl], pbx = bx[chl], psp = 8.0f * softplus_f(-lam[chl]);
        float cA = 1.0f, cB = 0.0f;
#pragma unroll
        for (int tg = 0; tg < 2; ++tg) {
            f32x16& A = cumA[tg]; f32x16& X = hloc[tg];
#pragma unroll
            for (int r = 0; r < 16; ++r) { const int tok = 32 * tg + (r & 3) + 8 * (r >> 2) + 4 * hi; const float xv = bf1(*(const LAS bf16*)(XC + tok * LRU_XP + chl * 2));
                const float rg = sigmoid_f(A[r] + pba), ig = sigmoid_f(X[r] + pbx); const float la = -rg * psp;
                A[r] = __builtin_amdgcn_exp2f(1.4426950408889634f * la); X[r] = __builtin_amdgcn_sqrtf(one_minus_exp(2.0f * la)) * (ig * xv); }
#pragma unroll
            for (int q = 0; q < 4; ++q)
#pragma unroll
                for (int i = 1; i < 4; ++i) { X[4 * q + i] = A[4 * q + i] * X[4 * q + i - 1] + X[4 * q + i]; A[4 * q + i] = A[4 * q + i] * A[4 * q + i - 1]; }
#pragma unroll
            for (int q2 = 0; q2 < 8; ++q2) { const int q = q2 >> 1; const bool own = (hi == (q2 & 1));
#pragma unroll
                for (int i = 0; i < 4; ++i) { const float nb = A[4 * q + i] * cB + X[4 * q + i], na = A[4 * q + i] * cA; X[4 * q + i] = own ? nb : X[4 * q + i]; A[4 * q + i] = own ? na : A[4 * q + i]; }
                const float ra = __shfl_xor(A[4 * q + 3], 32), rb = __shfl_xor(X[4 * q + 3], 32);
                cA = own ? A[4 * q + 3] : ra; cB = own ? X[4 * q + 3] : rb; }
        }
        if (hi == 0) { float* d0 = LSUM + (((size_t)b * 32 + c) * 2 + 0) * 512 + chl; __hip_atomic_store(d0, cA, __ATOMIC_RELAXED, __HIP_MEMORY_SCOPE_AGENT); __hip_atomic_store(d0 + 512, cB, __ATOMIC_RELAXED, __HIP_MEMORY_SCOPE_AGENT); }
        asm volatile("s_waitcnt vmcnt(0)" ::: "memory");
        __syncthreads();
        if (F.wave == 0) {
            if (F.lane == 0) __hip_atomic_store(flags + 64 * ((32 * b + c) * 2 + hp), 1u, __ATOMIC_RELAXED, __HIP_MEMORY_SCOPE_AGENT);
            unsigned sp = 0;
            for (;;) { const unsigned v = (F.lane < c) ? __hip_atomic_load(flags + 64 * ((32 * b + F.lane) * 2 + hp), __ATOMIC_RELAXED, __HIP_MEMORY_SCOPE_AGENT) : 1u;
                if (__all(v != 0u)) break; __builtin_amdgcn_s_sleep(1); if (++sp > (1u << 20)) break; }
        }
        __syncthreads();
        if (F.tid < 256) { const int ch = (F.tid >> 5) * 64 + 32 * hp + (F.tid & 31); float cr = 0.f; float* LS = LSUM + (size_t)b * 32 * 2 * 512 + ch;
          for (int c0 = 0; c0 < c; c0 += 32) { float A8[32], B8[32];
#pragma unroll
              for (int u = 0; u < 32; ++u) { const bool ok = (c0 + u) < c; A8[u] = 1.0f; B8[u] = 0.0f; if (ok) { A8[u] = __hip_atomic_load(LS + (size_t)(c0 + u) * 1024, __ATOMIC_RELAXED, __HIP_MEMORY_SCOPE_AGENT); B8[u] = __hip_atomic_load(LS + (size_t)(c0 + u) * 1024 + 512, __ATOMIC_RELAXED, __HIP_MEMORY_SCOPE_AGENT); } }
#pragma unroll
              for (int u = 0; u < 32; ++u) cr = A8[u] * cr + B8[u]; }
          CAR[ch] = cr; }
        __syncthreads();
        { const float cin = CAR[chl];
#pragma unroll
          for (int tg = 0; tg < 2; ++tg)
#pragma unroll
              for (int r = 0; r < 16; ++r) { const int tok = 32 * tg + (r & 3) + 8 * (r >> 2) + 4 * hi; LAS bf16* yp = (LAS bf16*)(XT + tok * LRU_XP + chl * 2);
                  const float h = hloc[tg][r] + cumA[tg][r] * cin; *yp = (bf16)f2bf(h * gelu_tanh_f(bf1(*yp))); } }
    }
    __syncthreads();
#pragma unroll 2
    for (int q = 0; q < 8; ++q) { const int i = F.wave + 8 * q, c8 = F.lane;
        const v4u w = *(const LAS v4u*)(XT + i * LRU_XP + c8 * 16);
        const float v0 = bflo(w.x), v1 = bfhi(w.x), v2 = bflo(w.y), v3 = bfhi(w.y), v4 = bflo(w.z), v5 = bfhi(w.z), v6 = bflo(w.w), v7 = bfhi(w.w);
        const float ss = wave_sum(((v0 * v0 + v1 * v1) + (v2 * v2 + v3 * v3)) + ((v4 * v4 + v5 * v5) + (v6 * v6 + v7 * v7)));
        const float rinv = 1.0f / sqrtf(ss * (1.0f / DLRU) + RMS_EPS);
        const f32x4 g0 = *(const f32x4*)(gn_lru + c8 * 8), g1 = *(const f32x4*)(gn_lru + c8 * 8 + 4);
        v4u o; o.x = pk2(v0 * rinv * g0[0], v1 * rinv * g0[1]); o.y = pk2(v2 * rinv * g0[2], v3 * rinv * g0[3]); o.z = pk2(v4 * rinv * g1[0], v5 * rinv * g1[1]); o.w = pk2(v6 * rinv * g1[2], v7 * rinv * g1[3]);
        *(GAS v4u*)(MRG + (rowb + t0 + i) * 1024 + 512 + c8 * 8) = o; }
    __syncthreads();
}
__device__ __forceinline__ void lru_phase(Frame& F) { for (int it = F.vcu; it < BATCH * 32; it += F.G) lru_item(F, it >> 5, it & 31); }

__device__ __forceinline__ void p6_phase(Frame& F) {
    const float* x = F.in(0); const float* gpost = F.in(5); const float* gffn = F.in(18); const float* b_router = F.in(21);
    const float* MOD = (const float*)(F.ws + WS_MOD); const bf16* Y = (const bf16*)(F.ws + WS_Y); unsigned char* H2 = (unsigned char*)(F.ws + WS_H2);
    int* TOPI = (int*)(F.ws + WS_TOPI); float* TOPW = (float*)(F.ws + WS_TOPW); int* WGCNT = (int*)(F.ws + WS_WGCNT);
    LAS float* wrl = (LAS float*)F.lds;
    LAS int* hist = (LAS int*)(F.lds + 131072);
    { const float* WRT = (const float*)(F.ws + WS_WRT);
#pragma unroll 4
      for (int i = F.tid; i < NE * DM / 4; i += NWAVES * 64) *(LAS f32x4*)(wrl + 4 * i) = *(const f32x4*)(WRT + 4 * i); }
    if (F.tid < NE) hist[F.tid] = 0;
    __syncthreads();
    if (F.G * 64 == NTOK) {
    const int bx = blockIdx.x, row0 = bx * 64 + F.wave * 8, b = row0 / SEQ;
    f32x4 gpm[4], gf[4], shf[4];
#pragma unroll
    for (int j = 0; j < 4; ++j) { const int k = 4 * F.lane + 256 * j; const float* mb = MOD + b * NMOD * DM + k;
        gpm[j] = *(const f32x4*)(mb + 2 * DM) * *(const f32x4*)(gpost + k); gf[j] = *(const f32x4*)(gffn + k) * (*(const f32x4*)(mb + 4 * DM) + 1.0f); shf[j] = *(const f32x4*)(mb + 3 * DM); }
    v2u ywn[2][4]; f32x4 xn[2][4];
#pragma unroll
    for (int u = 0; u < 2; ++u)
#pragma unroll
        for (int j = 0; j < 4; ++j) { ywn[u][j] = *(const GAS v2u*)(Y + (size_t)(row0 + u) * DM + 4 * F.lane + 256 * j); xn[u][j] = *(const f32x4*)(x + (size_t)(row0 + u) * DM + 4 * F.lane + 256 * j); }
    for (int rp = 0; rp < 4; ++rp) {
        f32x4 hv[2][4];
        v2u ywc[2][4]; f32x4 xc[2][4];
#pragma unroll
        for (int u = 0; u < 2; ++u)
#pragma unroll
            for (int j = 0; j < 4; ++j) { ywc[u][j] = ywn[u][j]; xc[u][j] = xn[u][j]; }
        if (rp < 3) {
#pragma unroll
            for (int u = 0; u < 2; ++u)
#pragma unroll
                for (int j = 0; j < 4; ++j) { ywn[u][j] = *(const GAS v2u*)(Y + (size_t)(row0 + 2 * rp + 2 + u) * DM + 4 * F.lane + 256 * j); xn[u][j] = *(const f32x4*)(x + (size_t)(row0 + 2 * rp + 2 + u) * DM + 4 * F.lane + 256 * j); } }
#pragma unroll
        for (int u = 0; u < 2; ++u) { const int row = row0 + 2 * rp + u;
            f32x4 yv[4]; float ss = 0.f;
#pragma unroll
            for (int j = 0; j < 4; ++j) { const v2u yw = ywc[u][j]; yv[j] = (f32x4){bflo(yw.x), bfhi(yw.x), bflo(yw.y), bfhi(yw.y)}; ss += (yv[j][0] * yv[j][0] + yv[j][1] * yv[j][1]) + (yv[j][2] * yv[j][2] + yv[j][3] * yv[j][3]); }
            const float rinv = 1.0f / sqrtf(wave_sum(ss) * (1.0f / DM) + RMS_EPS);
            float s2 = 0.f;
#pragma unroll
            for (int j = 0; j < 4; ++j) { const f32x4 xm = xc[u][j] + gpm[j] * (yv[j] * rinv);
                yv[j] = xm; s2 += (xm[0] * xm[0] + xm[1] * xm[1]) + (xm[2] * xm[2] + xm[3] * xm[3]); }
            const float rinv2 = 1.0f / sqrtf(wave_sum(s2) * (1.0f / DM) + RMS_EPS);
#pragma unroll
            for (int j = 0; j < 4; ++j) { const f32x4 h = yv[j] * rinv2 * gf[j] + shf[j]; hv[u][j] = h;
                int w8 = 0; w8 = __builtin_amdgcn_cvt_pk_fp8_f32(h[0], h[1], w8, false); w8 = __builtin_amdgcn_cvt_pk_fp8_f32(h[2], h[3], w8, true); *(GAS int*)(H2 + (size_t)row * DM + 4 * F.lane + 256 * j) = w8; }
        }
        float pa[32], pb[32];
#pragma unroll
        for (int e = 0; e < 32; ++e) { float sa = 0.f, sb = 0.f;
#pragma unroll
            for (int j = 0; j < 4; ++j) { const f32x4 w = *(const LAS f32x4*)(wrl + e * DM + 4 * F.lane + 256 * j);
                sa += (hv[0][j][0] * w[0] + hv[0][j][1] * w[1]) + (hv[0][j][2] * w[2] + hv[0][j][3] * w[3]); sb += (hv[1][j][0] * w[0] + hv[1][j][1] * w[1]) + (hv[1][j][2] * w[2] + hv[1][j][3] * w[3]); }
            pa[e] = sa; pb[e] = sb; }
#define TR_STEP(N, OFF, BIT) _Pragma("unroll") for (int i = 0; i < N; ++i) { const bool up = (F.lane & BIT) != 0; \
            const float ka = up ? pa[N + i] : pa[i], sa_ = up ? pa[i] : pa[N + i], kb = up ? pb[N + i] : pb[i], sb_ = up ? pb[i] : pb[N + i]; \
            pa[i] = ka + __shfl_xor(sa_, OFF); pb[i] = kb + __shfl_xor(sb_, OFF); }
        TR_STEP(16, 32, 32) TR_STEP(8, 16, 16) TR_STEP(4, 8, 8) TR_STEP(2, 4, 4) TR_STEP(1, 2, 2)
#undef TR_STEP
        const int e = (F.lane >> 1) & 31; const float br = b_router[e];
#pragma unroll
        for (int u = 0; u < 2; ++u) { const int row = row0 + 2 * rp + u; float v = (u ? pb[0] : pa[0]); v += __shfl_xor(v, 1); v += br;
            int rank = 0;
#pragma unroll
            for (int j = 0; j < 32; ++j) { const float vj = __uint_as_float((unsigned)__builtin_amdgcn_readlane((int)__float_as_uint(v), 2 * j)); rank += (vj > v || (vj == v && j < e)) ? 1 : 0; }
            const bool sel = rank < TOPK; const float vmax = wave_max(v); const float ex = sel ? __expf(v - vmax) : 0.f; const float den = wave_sum(ex) * 0.5f;
            if (sel && !(F.lane & 1)) { TOPI[(size_t)row * TOPK + rank] = e; TOPW[(size_t)row * TOPK + rank] = ex / den; __hip_atomic_fetch_add((LAS int*)&hist[e], 1, __ATOMIC_RELAXED, __HIP_MEMORY_SCOPE_WORKGROUP); } }
    }
    __syncthreads();
    if (F.tid < NE) WGCNT[bx * NE + F.tid] = hist[F.tid];
    }
}

__device__ __forceinline__ void p7_phase(Frame& F) {
    const int* TOPI = (const int*)(F.ws + WS_TOPI); const float* TOPW = (const float*)(F.ws + WS_TOPW); const int* WGCNT = (const int*)(F.ws + WS_WGCNT);
    int* ROWTOK = (int*)(F.ws + WS_ROWTOK); int* ROWPAIR = (int*)(F.ws + WS_ROWPAIR); float* ROWW = (float*)(F.ws + WS_ROWW); int* MTEXP = (int*)(F.ws + WS_MTEXP);
    LAS int* ptot = (LAS int*)F.lds; LAS int* pbef = ptot + 512; LAS int* cnt = pbef + 512; LAS int* wgb = cnt + 32; LAS int* pst = wgb + 32; LAS int* pad = pst + 64; LAS int* ep = pad + 32;
    if (F.G != 256) return;
    const int bx = blockIdx.x;
    { const int e = F.tid & 31, part = F.tid >> 5; int tt = 0, tb = 0;
      for (int w = part * 16; w < part * 16 + 16; ++w) { const int v = WGCNT[w * NE + e]; tt += v; tb += (w < bx) ? v : 0; }
      ptot[part * 32 + e] = tt; pbef[part * 32 + e] = tb; }
    __syncthreads();
    if (F.tid < NE) { int tt = 0, tb = 0; for (int p = 0; p < 16; ++p) { tt += ptot[p * 32 + F.tid]; tb += pbef[p * 32 + F.tid]; } cnt[F.tid] = tt; wgb[F.tid] = tb; pad[F.tid] = (tt + 255) & ~255; }
    __syncthreads();
    if (F.tid == 0) { int s = 0; for (int e = 0; e < NE; ++e) { pst[e] = s; s += pad[e]; } pst[NE] = s; }
    if (F.tid < 256) ep[F.tid] = TOPI[(size_t)bx * 256 + F.tid];
    __syncthreads();
    if (F.tid < 256) { const int p = F.tid, e = ep[p]; int rk = 0; for (int q = 0; q < p; ++q) rk += (ep[q] == e) ? 1 : 0;
        const int dest = pst[e] + wgb[e] + rk; const int pair = bx * 256 + p; ROWTOK[dest] = pair >> 2; ROWPAIR[dest] = pair; ROWW[dest] = TOPW[pair]; }
    if (bx < NE) { const int e = bx; for (int i = pst[e] + cnt[e] + F.tid; i < pst[e] + pad[e]; i += NWAVES * 64) { ROWTOK[i] = 0; ROWPAIR[i] = -1; ROWW[i] = 0.f; } }
    if (bx == 0) { if (F.tid < NE) { for (int mt = pst[F.tid] >> 8; mt < (pst[F.tid] + pad[F.tid]) >> 8; ++mt) MTEXP[mt] = F.tid; } if (F.tid == 0) MTEXP[512] = pst[NE] >> 8; }
}

__device__ __forceinline__ void p10_phase(Frame& F) {
    const float* x = F.in(0); const float* gpostm = F.in(5); const float* gpost = F.in(19); const float* MOD = (const float*)(F.ws + WS_MOD);
    const unsigned char* YP = (const unsigned char*)(F.ws + WS_YP); const bf16* Y = (const bf16*)(F.ws + WS_Y);
    const int gw = F.vcu * NWAVES + F.wave;
    if (F.G * NWAVES * 8 != NTOK) return;
    const int row0 = gw * 8, b = row0 / SEQ;
    f32x4 gg[4], gpm[4];
#pragma unroll
    for (int j = 0; j < 4; ++j) { const int k = 4 * F.lane + 256 * j; gg[j] = *(const f32x4*)(MOD + b * NMOD * DM + 5 * DM + k) * *(const f32x4*)(gpost + k); gpm[j] = *(const f32x4*)(MOD + b * NMOD * DM + 2 * DM + k) * *(const f32x4*)(gpostm + k); }
    int nw[4][TOPK]; v2u ny[4]; f32x4 nx[4];
#pragma unroll
    for (int j = 0; j < 4; ++j) { ny[j] = *(const GAS v2u*)(Y + (size_t)row0 * DM + 4 * F.lane + 256 * j); nx[j] = *(const f32x4*)(x + (size_t)row0 * DM + 4 * F.lane + 256 * j);
#pragma unroll
        for (int k = 0; k < TOPK; ++k) nw[j][k] = *(const GAS int*)(YP + ((size_t)row0 * TOPK + k) * DM + 4 * F.lane + 256 * j); }
    for (int r = 0; r < 8; ++r) { const int row = row0 + r;
        f32x4 y[4], ym[4], xr[4]; float ss = 0.f, sm = 0.f;
#pragma unroll
        for (int j = 0; j < 4; ++j) { f32x4 s = (f32x4){0.f, 0.f, 0.f, 0.f};
#pragma unroll
            for (int k = 0; k < TOPK; ++k) { const int w = nw[j][k]; s += (f32x4){__builtin_amdgcn_cvt_f32_fp8(w, 0), __builtin_amdgcn_cvt_f32_fp8(w, 1), __builtin_amdgcn_cvt_f32_fp8(w, 2), __builtin_amdgcn_cvt_f32_fp8(w, 3)}; }
            y[j] = s; ss += (s[0] * s[0] + s[1] * s[1]) + (s[2] * s[2] + s[3] * s[3]);
            const v2u yw = ny[j]; const f32x4 m = (f32x4){bflo(yw.x), bfhi(yw.x), bflo(yw.y), bfhi(yw.y)}; ym[j] = m; sm += (m[0] * m[0] + m[1] * m[1]) + (m[2] * m[2] + m[3] * m[3]); xr[j] = nx[j]; }
        if (r < 7) {
#pragma unroll
            for (int j = 0; j < 4; ++j) { ny[j] = *(const GAS v2u*)(Y + (size_t)(row + 1) * DM + 4 * F.lane + 256 * j); nx[j] = *(const f32x4*)(x + (size_t)(row + 1) * DM + 4 * F.lane + 256 * j);
#pragma unroll
                for (int k = 0; k < TOPK; ++k) nw[j][k] = *(const GAS int*)(YP + ((size_t)(row + 1) * TOPK + k) * DM + 4 * F.lane + 256 * j); } }
        const float rinv = 1.0f / sqrtf(wave_sum(ss) * (1.0f / DM) + RMS_EPS * 16.0f), rinvm = 1.0f / sqrtf(wave_sum(sm) * (1.0f / DM) + RMS_EPS);
#pragma unroll
        for (int j = 0; j < 4; ++j) *(f32x4*)(F.out + (size_t)row * DM + 4 * F.lane + 256 * j) = (xr[j] + gpm[j] * (ym[j] * rinvm)) + gg[j] * (y[j] * rinv);
    }
}

__global__ void __launch_bounds__(NWAVES * 64, 2) mega_fwd(Args args) {
    extern __shared__ __attribute__((aligned(16))) unsigned char lds[];
    Frame F;
    F.lds = (LAS unsigned char*)lds;
    F.tid = threadIdx.x; F.lane = F.tid & 63; F.wave = __builtin_amdgcn_readfirstlane(F.tid >> 6);
    F.G = gridDim.x; { const int bx = blockIdx.x; F.vcu = (F.G % 8 == 0) ? (bx % 8) * (F.G / 8) + bx / 8 : bx; }
    F.out = args.out; F.ws = args.ws;
    volatile LAS unsigned* MISC = (volatile LAS unsigned*)(F.lds + MISC_OFF);
    for (int u = F.tid; u < (LDS_BYTES - LDSCTL_OFF) / 4; u += NWAVES * 64) ((LAS unsigned*)(F.lds + LDSCTL_OFF))[u] = 0u;
    __syncthreads();
    if (F.tid < 26) ((LAS unsigned long long*)(F.lds + LDSCTL_OFF))[F.tid] = (unsigned long long)args.in[F.tid];
    __syncthreads();
    gu32* ctl = (gu32*)(F.ws + WS_CTL);
    XcdBarrier bar = xcd_barrier_post((unsigned*)(ctl + CW_BAR) + args.li * XCD_BAR_WORDS, MISC + 8);
    const int lo = args.ph_lo, hi = args.ph_hi;
#ifndef PHMASK
#define PHMASK 0x7ff
#endif
#define IN(k) (((PHMASK >> (k)) & 1) && lo <= (k) && (k) < hi)
#ifndef REPMASK
#define REPMASK 0
#endif
#define NREP(k) (((REPMASK >> (k)) & 1) ? 2 : 1)
#define SEAM(k) do { if ((k) != 3 && IN(k) && IN((k) + 1)) xcd_barrier(bar); if ((k) == 3 && IN(3) && IN(5)) xcd_barrier(bar); } while (0)
#define REFRESH() do { int t_; asm volatile("v_mov_b32 %0, %1" : "=v"(t_) : "v"(threadIdx.x)); F.tid = t_; F.lane = t_ & 63; } while (0)
    if (IN(0)) { { REFRESH(); p0_phase(F);  }
      if (NREP(0) > 1) { xcd_barrier(bar); REFRESH(); p0_phase(F);  } } SEAM(0);

    if (IN(1)) { { REFRESH(); p1_phase(F);  }
      if (NREP(1) > 1) { xcd_barrier(bar); REFRESH(); p1_phase(F);  } } SEAM(1);

    if (IN(2)) { { REFRESH();
        pg8::DenseOrder S; S.init((const pg8::bf16_t*)(F.ws + WS_H1), (const pg8::bf16_t*)(F.ws + WS_WIN), NTOK, NPJ, F.G, (int)blockIdx.x);
        pg8::EpiProj E{(pg8::bf16_t*)(F.ws + WS_PJ), PJ_STRIDE, attn_body::C2};
        pg8::gemm_phase<pg8::EpiProj, pg8::DenseOrder>(F.lds, S, E);
        if (F.G == 256 && blockIdx.x >= 128) { REFRESH(); cvt_range<true>(F, 0, CV_UP_TAIL, ((int)blockIdx.x - 128) * NWAVES + F.wave, 128 * NWAVES); } }
      if (NREP(2) > 1) { xcd_barrier(bar); REFRESH();
        pg8::DenseOrder S; S.init((const pg8::bf16_t*)(F.ws + WS_H1), (const pg8::bf16_t*)(F.ws + WS_WIN), NTOK, NPJ, F.G, (int)blockIdx.x);
        pg8::EpiProj E{(pg8::bf16_t*)(F.ws + WS_PJ), PJ_STRIDE, attn_body::C2};
        pg8::gemm_phase<pg8::EpiProj, pg8::DenseOrder>(F.lds, S, E);
        if (F.G == 256 && blockIdx.x >= 128) { REFRESH(); cvt_range<true>(F, 0, CV_UP_TAIL, ((int)blockIdx.x - 128) * NWAVES + F.wave, 128 * NWAVES); } }     } SEAM(2);

    if (IN(3)) { { REFRESH();
        lru_phase(F);
        const attn_body::AttnTensors AT{(const attn_body::bf16*)(F.ws + WS_PJ) + 2 * PJ_STRIDE, (const attn_body::bf16*)(F.ws + WS_PJ) + 3 * PJ_STRIDE, (const attn_body::bf16*)(F.ws + WS_PJ) + 4 * PJ_STRIDE,
                                        (attn_body::bf16*)(F.ws + WS_MRG), (const float*)(F.ws + WS_LOGF2), (float*)(F.ws + WS_SSQ)};
        const attn_body::StaticOrder S((int)F.G, F.vcu);
        attn_body::attn_phase<attn_body::StaticOrder>((char*)lds, AT, S); }
      if (NREP(3) > 1) { xcd_barrier(bar); REFRESH();
        lru_phase(F);
        const attn_body::AttnTensors AT{(const attn_body::bf16*)(F.ws + WS_PJ) + 2 * PJ_STRIDE, (const attn_body::bf16*)(F.ws + WS_PJ) + 3 * PJ_STRIDE, (const attn_body::bf16*)(F.ws + WS_PJ) + 4 * PJ_STRIDE,
                                        (attn_body::bf16*)(F.ws + WS_MRG), (const float*)(F.ws + WS_LOGF2), (float*)(F.ws + WS_SSQ)};
        const attn_body::StaticOrder S((int)F.G, F.vcu);
        attn_body::attn_phase<attn_body::StaticOrder>((char*)lds, AT, S); } } SEAM(3);


    if (IN(5)) { { REFRESH();
        pg8::DenseOrder S; S.init((const pg8::bf16_t*)(F.ws + WS_MRG), (const pg8::bf16_t*)(F.ws + WS_WOUT), NTOK, DM, F.G, (int)blockIdx.x);
        pg8::EpiOut E{(pg8::bf16_t*)(F.ws + WS_Y), (const float*)(F.ws + WS_SSQ)};
        pg8::gemm_phase<pg8::EpiOut, pg8::DenseOrder>(F.lds, S, E); }
      if (NREP(5) > 1) { xcd_barrier(bar); REFRESH();
        pg8::DenseOrder S; S.init((const pg8::bf16_t*)(F.ws + WS_MRG), (const pg8::bf16_t*)(F.ws + WS_WOUT), NTOK, DM, F.G, (int)blockIdx.x);
        pg8::EpiOut E{(pg8::bf16_t*)(F.ws + WS_Y), (const float*)(F.ws + WS_SSQ)};
        pg8::gemm_phase<pg8::EpiOut, pg8::DenseOrder>(F.lds, S, E); } } SEAM(5);

    if (IN(6)) { { REFRESH(); p6_phase(F);  }
      if (NREP(6) > 1) { xcd_barrier(bar); REFRESH(); p6_phase(F);  } } SEAM(6);

    if (IN(7)) { { REFRESH(); p7_phase(F);  }
      if (NREP(7) > 1) { xcd_barrier(bar); REFRESH(); p7_phase(F);  } } SEAM(7);

    if (IN(8)) { { REFRESH();
        const int nmt = ((const int*)(F.ws + WS_MTEXP))[512];
        pg8::UpOrder S{(const unsigned char*)(F.ws + WS_H2), (const unsigned char*)(F.ws + WS_WUP), (const int*)(F.ws + WS_ROWTOK), (const int*)(F.ws + WS_MTEXP), nmt * 8, F.G, F.vcu};
        pg8::EpiUp E{(unsigned char*)(F.ws + WS_ACT), F.in(23)};
        pg8::gemm_phase<pg8::EpiUp, pg8::UpOrder, true>(F.lds, S, E);
        if (F.G == 256) {
            const int units = nmt * 8, maxu = (units + 255) >> 8, nfull = units - (maxu - 1) * 256, nidle = 256 - nfull;
            REFRESH();
            if (nidle >= 32) { if (F.vcu >= nfull) cvt_range<false>(F, 0, CV_DN_TAIL, (F.vcu - nfull) * NWAVES + F.wave, nidle * NWAVES); }
            else cvt_range<false>(F, 0, CV_DN_TAIL, F.vcu * NWAVES + F.wave, 256 * NWAVES); } }
      if (NREP(8) > 1) { xcd_barrier(bar); REFRESH();
        const int nmt = ((const int*)(F.ws + WS_MTEXP))[512];
        pg8::UpOrder S{(const unsigned char*)(F.ws + WS_H2), (const unsigned char*)(F.ws + WS_WUP), (const int*)(F.ws + WS_ROWTOK), (const int*)(F.ws + WS_MTEXP), nmt * 8, F.G, F.vcu};
        pg8::EpiUp E{(unsigned char*)(F.ws + WS_ACT), F.in(23)};
        pg8::gemm_phase<pg8::EpiUp, pg8::UpOrder, true>(F.lds, S, E);
        if (F.G == 256) {
            const int units = nmt * 8, maxu = (units + 255) >> 8, nfull = units - (maxu - 1) * 256, nidle = 256 - nfull;
            REFRESH();
            if (nidle >= 32) { if (F.vcu >= nfull) cvt_range<false>(F, 0, CV_DN_TAIL, (F.vcu - nfull) * NWAVES + F.wave, nidle * NWAVES); }
            else cvt_range<false>(F, 0, CV_DN_TAIL, F.vcu * NWAVES + F.wave, 256 * NWAVES); } } } SEAM(8);

    if (IN(9)) { { REFRESH();
        const int nmt = ((const int*)(F.ws + WS_MTEXP))[512];
        pg8::DownOrder S{(const unsigned char*)(F.ws + WS_ACT), (const unsigned char*)(F.ws + WS_WDN), (const int*)(F.ws + WS_MTEXP), nmt * 4, F.G, F.vcu};
        pg8::EpiDown E{(unsigned char*)(F.ws + WS_YP), F.in(25), (const int*)(F.ws + WS_ROWPAIR), (const float*)(F.ws + WS_ROWW)};
        pg8::gemm_phase<pg8::EpiDown, pg8::DownOrder, true>(F.lds, S, E); }
      if (NREP(9) > 1) { xcd_barrier(bar); REFRESH();
        const int nmt = ((const int*)(F.ws + WS_MTEXP))[512];
        pg8::DownOrder S{(const unsigned char*)(F.ws + WS_ACT), (const unsigned char*)(F.ws + WS_WDN), (const int*)(F.ws + WS_MTEXP), nmt * 4, F.G, F.vcu};
        pg8::EpiDown E{(unsigned char*)(F.ws + WS_YP), F.in(25), (const int*)(F.ws + WS_ROWPAIR), (const float*)(F.ws + WS_ROWW)};
        pg8::gemm_phase<pg8::EpiDown, pg8::DownOrder, true>(F.lds, S, E); } } SEAM(9);

    if (IN(10)) { { REFRESH(); p10_phase(F);  }
      if (NREP(10) > 1) { xcd_barrier(bar); REFRESH(); p10_phase(F);  } }
    if (lo == 11) { REFRESH(); lru_phase(F); }
    if (lo == 17) { for (int i = 0; i < 10; ++i) xcd_barrier(bar); }
    if (lo == 14) { REFRESH(); p0_phase<1>(F); }
    if (lo == 15) { REFRESH(); p0_phase<2>(F); }
    if (lo == 16) { REFRESH(); p0_phase<4>(F); }
    if (lo == 12) { REFRESH();
        const attn_body::AttnTensors AT{(const attn_body::bf16*)(F.ws + WS_PJ) + 2 * PJ_STRIDE, (const attn_body::bf16*)(F.ws + WS_PJ) + 3 * PJ_STRIDE, (const attn_body::bf16*)(F.ws + WS_PJ) + 4 * PJ_STRIDE,
                                        (attn_body::bf16*)(F.ws + WS_MRG), (const float*)(F.ws + WS_LOGF2), (float*)(F.ws + WS_SSQ)};
        const attn_body::StaticOrder S((int)F.G, F.vcu);
        attn_body::attn_phase<attn_body::StaticOrder>((char*)lds, AT, S); }
#undef IN
#undef SEAM
#undef REFRESH
}

static void launch_mega(hipStream_t stream, void* const* d_in, void* d_out, void* d_ws, int lo, int hi, int li, int grid) {
    Args a{};
    for (int i = 0; i < 26; ++i) a.in[i] = (const float*)d_in[i];
    a.out = (float*)d_out; a.ws = (unsigned char*)d_ws; a.ph_lo = lo; a.ph_hi = hi; a.li = li; a.pad = 0;
    hipLaunchKernelGGL(mega_fwd, dim3(grid), dim3(NWAVES * 64), LDS_BYTES, stream, a);
}

#if MIX < 4
namespace simple {
__device__ __forceinline__ float sigmoidf_(float x) { return 1.f / (1.f + __expf(-x)); }
__device__ __forceinline__ float gelu_tanh(float x) { const float u = 0.7978845608028654f * (x + 0.044715f * x * x * x); return 0.5f * x * (1.f + tanhf(u)); }
__device__ __forceinline__ float log_sigmoid(float z) { return z >= 0.f ? -log1pf(expf(-z)) : z - log1pf(expf(z)); }
__device__ __forceinline__ float softplusf_(float z) { return z > 0.f ? z + log1pf(expf(-z)) : log1pf(expf(z)); }

__device__ __forceinline__ float block_sum_256(float v, float* red) {
    for (int o = 32; o > 0; o >>= 1) v += __shfl_xor(v, o);
    const int w = threadIdx.x >> 6, l = threadIdx.x & 63;
    __syncthreads();
    if (l == 0) red[w] = v;
    __syncthreads();
    return red[0] + red[1] + red[2] + red[3];
}

__global__ void k_ada(const float* c, const float* w_ada, const float* b_ada, float* mod) {
    const int j = blockIdx.x * 256 + threadIdx.x, b = blockIdx.y;
    float acc = b_ada[j];
    for (int k = 0; k < DM; ++k) { const float cv = c[b * DM + k]; acc += cv * sigmoidf_(cv) * w_ada[(size_t)k * (NMOD * DM) + j]; }
    mod[b * NMOD * DM + j] = acc;
}

__global__ void k_prep(const float* x, const float* g, const float* mod, int sh_off, int sc_off, float* h) {
    __shared__ float red[4];
    const int row = blockIdx.x, b = row / SEQ;
    const float* xr = x + (size_t)row * DM;
    float v[4], s = 0.f;
#pragma unroll
    for (int i = 0; i < 4; ++i) { v[i] = xr[threadIdx.x + 256 * i]; s += v[i] * v[i]; }
    const float tot = block_sum_256(s, red);
    const float rinv = rsqrtf(tot / DM + RMS_EPS);
#pragma unroll
    for (int i = 0; i < 4; ++i) { const int k = threadIdx.x + 256 * i;
        h[(size_t)row * DM + k] = v[i] * rinv * g[k] * (1.f + mod[b * NMOD * DM + sc_off + k]) + mod[b * NMOD * DM + sh_off + k]; }
}

struct GemmArgs { const float* A; const float* B; float* C; const float* bias; const int* rowidx; const int* Mptr; int M, N, K, lda, ldb, ldc;
                  size_t gB, gC, gbias; int gidx; };
__global__ void __launch_bounds__(256) k_sgemm(GemmArgs a) {
    __shared__ float As[8][128 + 4], Bs[8][128 + 4];
    const int z = blockIdx.z;
    const float* B = a.B + z * a.gB; float* C = a.C + z * a.gC; const float* bias = a.bias ? a.bias + z * a.gbias : nullptr;
    const int* rowidx = a.rowidx ? a.rowidx + (size_t)z * a.gidx : nullptr;
    const int M = a.Mptr ? a.Mptr[z] : a.M;
    const int m0 = blockIdx.y * 128, n0 = blockIdx.x * 128;
    if (m0 >= M) return;
    const int tid = threadIdx.x, tx = tid & 15, ty = tid >> 4;
    float acc[8][8];
#pragma unroll
    for (int i = 0; i < 8; ++i)
#pragma unroll
        for (int j = 0; j < 8; ++j) acc[i][j] = 0.f;
    const int ar = tid >> 1, ak = (tid & 1) * 4;
    const int am = m0 + ar; const bool aok = am < M;
    const int arow = aok ? (rowidx ? rowidx[am] : am) : 0;
    const float* Ap = a.A + (size_t)arow * a.lda + ak;
    const int bk = tid >> 5, bn = (tid & 31) * 4;
    for (int k0 = 0; k0 < a.K; k0 += 8) {
        float4 av = aok ? *(const float4*)(Ap + k0) : make_float4(0.f, 0.f, 0.f, 0.f);
        float bv[4];
#pragma unroll
        for (int j = 0; j < 4; ++j) { const int n = n0 + bn + j; bv[j] = n < a.N ? B[(size_t)(k0 + bk) * a.ldb + n] : 0.f; }
        __syncthreads();
        As[ak + 0][ar] = av.x; As[ak + 1][ar] = av.y; As[ak + 2][ar] = av.z; As[ak + 3][ar] = av.w;
#pragma unroll
        for (int j = 0; j < 4; ++j) Bs[bk][bn + j] = bv[j];
        __syncthreads();
#pragma unroll
        for (int k = 0; k < 8; ++k) {
            float af[8], bf[8];
#pragma unroll
            for (int i = 0; i < 8; ++i) af[i] = As[k][ty * 8 + i];
#pragma unroll
            for (int j = 0; j < 8; ++j) bf[j] = Bs[k][tx * 8 + j];
#pragma unroll
            for (int i = 0; i < 8; ++i)
#pragma unroll
                for (int j = 0; j < 8; ++j) acc[i][j] += af[i] * bf[j];
        }
    }
#pragma unroll
    for (int i = 0; i < 8; ++i) { const int m = m0 + ty * 8 + i; if (m >= M) continue;
#pragma unroll
        for (int j = 0; j < 8; ++j) { const int n = n0 + tx * 8 + j; if (n < a.N) C[(size_t)m * a.ldc + n] = acc[i][j] + (bias ? bias[n] : 0.f); } }
}

__global__ void __launch_bounds__(64) k_lru(const float* proj, const float* conv_w, const float* conv_b, const float* wa, const float* ba, const float* wx, const float* bx,
                                            const float* lam, float* lru_out) {
    __shared__ float xc[64];
    const int b = blockIdx.x >> 3, g = blockIdx.x & 7, j = threadIdx.x, ch = g * 64 + j;
    float wac[64], wxc[64];
#pragma unroll
    for (int i = 0; i < 64; ++i) { wac[i] = wa[(g * 64 + i) * 64 + j]; wxc[i] = wx[(g * 64 + i) * 64 + j]; }
    const float cw0 = conv_w[0 * DLRU + ch], cw1 = conv_w[1 * DLRU + ch], cw2 = conv_w[2 * DLRU + ch], cw3 = conv_w[3 * DLRU + ch], cb = conv_b[ch];
    const float baj = ba[ch], bxj = bx[ch], sp = softplusf_(-lam[ch]);
    float x1 = 0.f, x2 = 0.f, x3 = 0.f, h = 0.f;
    for (int t = 0; t < SEQ; ++t) {
        const size_t row = (size_t)b * SEQ + t;
        const float x0 = proj[row * NPROJ + ch];
        const float y = proj[row * NPROJ + DLRU + ch];
        const float xcv = cw0 * x3 + cw1 * x2 + cw2 * x1 + cw3 * x0 + cb;
        x3 = x2; x2 = x1; x1 = x0;
        __syncthreads();
        xc[j] = xcv;
        __syncthreads();
        float ra = baj, ri = bxj;
#pragma unroll
        for (int i = 0; i < 64; ++i) { const float xi = xc[i]; ra += xi * wac[i]; ri += xi * wxc[i]; }
        const float r = sigmoidf_(ra), ig = sigmoidf_(ri);
        const float log_a = -8.0f * r * sp;
        const float av = expf(log_a);
        const float gx = sqrtf(1.f - expf(2.f * log_a)) * (ig * xcv);
        h = av * h + gx;
        lru_out[row * DLRU + ch] = h * gelu_tanh(y);
    }
}

__global__ void k_cum(const float* proj, const float* fb, float* cum) {
    const int b = blockIdx.x, h = threadIdx.x;
    float c = 0.f;
    for (int t = 0; t < SEQ; ++t) { c += log_sigmoid(proj[((size_t)b * SEQ + t) * NPROJ + 2 * DLRU + 3 * DATT + h] + fb[h]); cum[((size_t)b * NH + h) * SEQ + t] = c; }
}
__global__ void __launch_bounds__(256) k_attn(const float* proj, const float* cum, float* attn_out) {
    __shared__ float Ks[64][64], Vs[64][64], Cs[64];
    const int qb = blockIdx.x, h = blockIdx.y, b = blockIdx.z, t = qb * 256 + threadIdx.x;
    const size_t rowq = (size_t)b * SEQ + t;
    float q[64], acc[64];
#pragma unroll
    for (int d = 0; d < 64; ++d) { q[d] = proj[rowq * NPROJ + 2 * DLRU + h * 64 + d] * 0.125f; acc[d] = 0.f; }
    const float ct = cum[((size_t)b * NH + h) * SEQ + t];
    float m = -INFINITY, l = 0.f;
    const int send = qb * 256 + 256;
    for (int s0 = 0; s0 < send; s0 += 64) {
        __syncthreads();
        for (int i = threadIdx.x; i < 64 * 64; i += 256) { const int r = i >> 6, d = i & 63; const size_t rk = (size_t)b * SEQ + s0 + r;
            Ks[r][d] = proj[rk * NPROJ + 2 * DLRU + DATT + h * 64 + d]; Vs[r][d] = proj[rk * NPROJ + 2 * DLRU + 2 * DATT + h * 64 + d]; }
        if (threadIdx.x < 64) Cs[threadIdx.x] = cum[((size_t)b * NH + h) * SEQ + s0 + threadIdx.x];
        __syncthreads();
        for (int r = 0; r < 64; ++r) {
            const int s = s0 + r; if (s > t) break;
            float dot = 0.f;
#pragma unroll
            for (int d = 0; d < 64; ++d) dot += q[d] * Ks[r][d];
            const float lg = dot + ct - Cs[r];
            const float mn = fmaxf(m, lg), sc = expf(m - mn), p = expf(lg - mn);
            l = l * sc + p;
#pragma unroll
            for (int d = 0; d < 64; ++d) acc[d] = acc[d] * sc + p * Vs[r][d];
            m = mn;
        }
    }
    const float li = 1.f / l;
#pragma unroll
    for (int d = 0; d < 64; ++d) attn_out[rowq * DATT + h * 64 + d] = acc[d] * li;
}

__global__ void k_merge(const float* lru_out, const float* attn_out, const float* gn_lru, const float* gn_attn, float* merged) {
    __shared__ float red[4];
    const int row = blockIdx.x, tid = threadIdx.x;
    const float a0 = lru_out[(size_t)row * DLRU + tid], a1 = lru_out[(size_t)row * DLRU + 256 + tid];
    const float b0 = attn_out[(size_t)row * DATT + tid], b1 = attn_out[(size_t)row * DATT + 256 + tid];
    const float sa = block_sum_256(a0 * a0 + a1 * a1, red);
    const float sb = block_sum_256(b0 * b0 + b1 * b1, red);
    const float ra = rsqrtf(sa / DLRU + RMS_EPS), rb = rsqrtf(sb / DATT + RMS_EPS);
    float* o = merged + (size_t)row * DM;
    o[tid] = a0 * ra * gn_lru[tid]; o[256 + tid] = a1 * ra * gn_lru[256 + tid];
    o[512 + tid] = b0 * rb * gn_attn[tid]; o[768 + tid] = b1 * rb * gn_attn[256 + tid];
}

__global__ void k_resid(const float* xin, const float* y, const float* gpost, const float* mod, int gate_off, float* xo) {
    __shared__ float red[4];
    const int row = blockIdx.x, b = row / SEQ;
    float v[4], s = 0.f;
#pragma unroll
    for (int i = 0; i < 4; ++i) { v[i] = y[(size_t)row * DM + threadIdx.x + 256 * i]; s += v[i] * v[i]; }
    const float rinv = rsqrtf(block_sum_256(s, red) / DM + RMS_EPS);
#pragma unroll
    for (int i = 0; i < 4; ++i) { const int k = threadIdx.x + 256 * i;
        xo[(size_t)row * DM + k] = xin[(size_t)row * DM + k] + mod[b * NMOD * DM + gate_off + k] * (v[i] * rinv * gpost[k]); }
}

__global__ void k_route(const float* logits, int* cnt, int* list_tok, int* list_pair, float* pair_w) {
    const int tok = blockIdx.x * 256 + threadIdx.x;
    float lg[NE];
#pragma unroll
    for (int e = 0; e < NE; ++e) lg[e] = logits[(size_t)tok * NE + e];
    int idx[TOPK]; float val[TOPK];
#pragma unroll
    for (int k = 0; k < TOPK; ++k) { int bi = 0; float bv = -INFINITY;
#pragma unroll
        for (int e = 0; e < NE; ++e) { if (lg[e] > bv) { bv = lg[e]; bi = e; } }
        idx[k] = bi; val[k] = bv;
#pragma unroll
        for (int e = 0; e < NE; ++e) if (e == bi) lg[e] = -INFINITY; }
    float den = 0.f; float p[TOPK];
#pragma unroll
    for (int k = 0; k < TOPK; ++k) { p[k] = expf(val[k] - val[0]); den += p[k]; }
#pragma unroll
    for (int k = 0; k < TOPK; ++k) { const int e = idx[k]; const int pos = atomicAdd(&cnt[e], 1);
        list_tok[(size_t)e * NTOK + pos] = tok; list_pair[(size_t)e * NTOK + pos] = tok * TOPK + k; pair_w[tok * TOPK + k] = p[k] / den; }
}
__global__ void k_act(const float* gu, const int* cnt, float* act) {
    const int e = blockIdx.z, pos = blockIdx.y; if (pos >= cnt[e]) return;
    const size_t r = (size_t)e * NTOK + pos;
    for (int j = threadIdx.x; j < DEXP; j += 256) { const float gl = fminf(gu[r * 2 * DEXP + j], 7.f); const float li = fminf(fmaxf(gu[r * 2 * DEXP + DEXP + j], -7.f), 7.f);
        act[r * DEXP + j] = gl * sigmoidf_(1.702f * gl) * (li + 1.f); }
}
__global__ void k_scatter(const float* dn, const int* cnt, const int* list_pair, float* ypair) {
    const int e = blockIdx.z, pos = blockIdx.y; if (pos >= cnt[e]) return;
    const size_t r = (size_t)e * NTOK + pos; const int pair = list_pair[r];
    for (int j = threadIdx.x; j < DM; j += 256) ypair[(size_t)pair * DM + j] = dn[r * DM + j];
}
__global__ void k_combine(const float* ypair, const float* pair_w, float* y) {
    const int tok = blockIdx.x;
    for (int j = threadIdx.x; j < DM; j += 256) { float s = 0.f; for (int k = 0; k < TOPK; ++k) s += pair_w[tok * TOPK + k] * ypair[((size_t)tok * TOPK + k) * DM + j]; y[(size_t)tok * DM + j] = s; }
}


__global__ void k_conv_proj(const float* proj, const float* fb, unsigned short* PJ, float* LOGF2) {
    const int row = blockIdx.x;
    for (int c = threadIdx.x; c < 2560; c += 256) { const int t = c >> 9, cc = c & 511; float v = proj[(size_t)row * NPROJ + c]; if (t == 2) v *= attn_body::C2; PJ[(size_t)t * PJ_STRIDE + (size_t)row * 512 + cc] = (unsigned short)f2bf(v); }
    if (threadIdx.x < 8) LOGF2[(size_t)row * 8 + threadIdx.x] = log_sigmoid(proj[(size_t)row * NPROJ + 2560 + threadIdx.x] + fb[threadIdx.x]) * 1.4426950408889634f;
}
__global__ void k_conv_mix(const float* lru_out, const float* attn_out, const float* gn_lru, unsigned short* MRG, float* SSQ) {
    __shared__ float red[4];
    const int row = blockIdx.x, tid = threadIdx.x;
    const float a0 = lru_out[(size_t)row * DLRU + tid], a1 = lru_out[(size_t)row * DLRU + 256 + tid];
    const float ra = rsqrtf(block_sum_256(a0 * a0 + a1 * a1, red) / DLRU + RMS_EPS);
    MRG[(size_t)row * 1024 + 512 + tid] = (unsigned short)f2bf(a0 * ra * gn_lru[tid]); MRG[(size_t)row * 1024 + 768 + tid] = (unsigned short)f2bf(a1 * ra * gn_lru[256 + tid]);
    for (int i = 0; i < 2; ++i) { const int c = tid + 256 * i; const unsigned short hb = (unsigned short)f2bf(attn_out[(size_t)row * DATT + c]); MRG[(size_t)row * 1024 + c] = hb;
        float q = bf1(hb); q = q * q; for (int o = 1; o < 64; o <<= 1) q += __shfl_xor(q, o); if ((tid & 63) == 0) SSQ[(size_t)row * 8 + (c >> 6)] = q; }
}
static void sgemm(hipStream_t st, const float* A, const float* B, float* C, const float* bias, int M, int N, int K, int lda, int ldb, int ldc) {
    GemmArgs a{}; a.A = A; a.B = B; a.C = C; a.bias = bias; a.M = M; a.N = N; a.K = K; a.lda = lda; a.ldb = ldb; a.ldc = ldc;
    hipLaunchKernelGGL(k_sgemm, dim3((N + 127) / 128, (M + 127) / 128, 1), dim3(256), 0, st, a);
}
}
#endif

extern "C" void kernel_launch(void* const* d_in, const int* in_sizes, int n_in, void* d_out, int out_size, void* d_ws, size_t ws_size, hipStream_t stream) {
    static int grid = 0;
    if (grid == 0) {
        int dev = 0, cus = 0;
        if (n_in != 26 || out_size != NTOK * DM || ws_size < WS_END) { fprintf(stderr, "kernel_launch: unexpected problem shape / workspace (%d inputs, out %d, ws %zu)\n", n_in, out_size, ws_size); grid = -1; return; }
        if (hipGetDevice(&dev) != hipSuccess || hipDeviceGetAttribute(&cus, hipDeviceAttributeMultiprocessorCount, dev) != hipSuccess) { grid = -1; return; }
        if (hipFuncSetAttribute((const void*)mega_fwd, hipFuncAttributeMaxDynamicSharedMemorySize, LDS_BYTES) != hipSuccess) { fprintf(stderr, "kernel_launch: hipFuncSetAttribute failed\n"); grid = -1; return; }
        grid = cus;
        if (grid != 256) fprintf(stderr, "kernel_launch: %d CUs; this kernel is laid out for 256\n", grid);
    }
    if (grid < 0) return;
    (void)hipMemsetAsync((char*)d_ws + WS_CTL, 0, CTL_ZERO_BYTES, stream);
#if MIX >= 4
    launch_mega(stream, d_in, d_out, d_ws, 0, NPHASES, 0, grid);
#ifdef EXTRA_LO
    launch_mega(stream, d_in, d_out, d_ws, EXTRA_LO, EXTRA_HI, 1, grid);
#endif
#else
    using namespace simple;
    const float* x = (const float*)d_in[0]; const float* c = (const float*)d_in[1]; const float* w_ada = (const float*)d_in[2]; const float* b_ada = (const float*)d_in[3];
    const float* g_mix_pre = (const float*)d_in[4]; const float* w_in = (const float*)d_in[6];
    const float* conv_w = (const float*)d_in[7]; const float* conv_b = (const float*)d_in[8]; const float* wa = (const float*)d_in[9]; const float* ba = (const float*)d_in[10];
    const float* wx = (const float*)d_in[11]; const float* bx = (const float*)d_in[12]; const float* lam = (const float*)d_in[13]; const float* fb = (const float*)d_in[14];
    const float* gn_lru = (const float*)d_in[15]; const float* gn_attn = (const float*)d_in[16]; const float* w_out = (const float*)d_in[17];
    char* ws = (char*)d_ws;
    float* mod_s = (float*)(ws + 7 * MiB + 512 * KiB);
    float* h1 = (float*)(ws + 416 * MiB); float* proj = (float*)(ws + 480 * MiB); float* lru_out = (float*)(ws + 641 * MiB); float* attn_out = (float*)(ws + 673 * MiB); float* cum = (float*)(ws + 705 * MiB);
    float* merged = h1; float* Yb = (float*)(ws + WS_Y);
    launch_mega(stream, d_in, d_out, d_ws, 0, 1, 0, grid);
    hipLaunchKernelGGL(k_ada, dim3(NMOD * DM / 256, BATCH), dim3(256), 0, stream, c, w_ada, b_ada, mod_s);
    hipLaunchKernelGGL(k_prep, dim3(NTOK), dim3(256), 0, stream, x, g_mix_pre, mod_s, 0 * DM, 1 * DM, h1);
    sgemm(stream, h1, w_in, proj, nullptr, NTOK, NPROJ, DM, DM, NPROJ, NPROJ);
#if MIX <= 2
    hipLaunchKernelGGL(k_lru, dim3(BATCH * 8), dim3(64), 0, stream, proj, conv_w, conv_b, wa, ba, wx, bx, lam, lru_out);
    hipLaunchKernelGGL(k_cum, dim3(BATCH), dim3(NH), 0, stream, proj, fb, cum);
    hipLaunchKernelGGL(k_attn, dim3(SEQ / 256, NH, BATCH), dim3(256), 0, stream, proj, cum, attn_out);
#endif
#if MIX == 1
    hipLaunchKernelGGL(k_merge, dim3(NTOK), dim3(256), 0, stream, lru_out, attn_out, gn_lru, gn_attn, merged);
    sgemm(stream, merged, w_out, Yb, nullptr, NTOK, DM, DM, DM, DM, DM);
    launch_mega(stream, d_in, d_out, d_ws, 6, NPHASES, 1, grid);
#elif MIX == 2
    hipLaunchKernelGGL(k_conv_mix, dim3(NTOK), dim3(256), 0, stream, lru_out, attn_out, gn_lru, (unsigned short*)(ws + WS_MRG), (float*)(ws + WS_SSQ));
    launch_mega(stream, d_in, d_out, d_ws, 5, NPHASES, 1, grid);
#elif MIX == 3
    hipLaunchKernelGGL(k_conv_proj, dim3(NTOK), dim3(256), 0, stream, proj, fb, (unsigned short*)(ws + WS_PJ), (float*)(ws + WS_LOGF2));
    launch_mega(stream, d_in, d_out, d_ws, 3, NPHASES, 1, grid);
#endif
    (void)gn_attn; (void)w_out; (void)cum; (void)lru_out; (void)attn_out; (void)merged; (void)Yb;
#endif
}
```

```cpp
#include <hip/hip_runtime.h>
#include <hip/hip_bf16.h>
#include <cstdio>
#include <cstdint>
#include <cmath>

constexpr int DM = 1024, BATCH = 8, SEQ = 2048, NTOK = BATCH * SEQ;
constexpr int DLRU = 512, DATT = 512, NH = 8, HD = 64, NPROJ = 2 * DLRU + 3 * DATT + NH, NPJ = 2560;
constexpr int NE = 32, TOPK = 4, DEXP = 1024, NMOD = 6;
constexpr float RMS_EPS = 1e-6f;
constexpr int MAXROWS = NTOK * TOPK + NE * 256;
constexpr int MAXMT = MAXROWS / 256;

namespace pg8 {
#define PG8_LAS __attribute__((address_space(3)))
typedef unsigned short bf16_t;
typedef short bf16x8 __attribute__((ext_vector_type(8)));
typedef float f32x4 __attribute__((ext_vector_type(4)));
typedef float f32x2 __attribute__((ext_vector_type(2)));
typedef unsigned u32x4 __attribute__((ext_vector_type(4)));
constexpr int BM = 256, BK = 64, HALF = 128, HTB = HALF * BK * 2  , STAGE_BYTES = 8 * HTB, NXCD = 8, WGM = 8;
constexpr int GK = 1024, GNT = GK / BK;
typedef int i32x8 __attribute__((ext_vector_type(8)));
typedef int i32x4 __attribute__((ext_vector_type(4)));
constexpr int F8_SCALE_W = 0x79797979, F8_SCALE_A = 0x7f7f7f7f;

__host__ __device__ __forceinline__ int lds_byte(int r, int c) { const int st = (r >> 4) * 2 + (c >> 5), rr = r & 15, cc = c & 31, ob = rr * 64 + cc * 2; return st * 1024 + (ob ^ (((ob >> 9) & 1) << 5)); }
__host__ __device__ __forceinline__ void stage_rc(int b, int& R, int& C) { const int st = b / 1024, sb = b % 1024, swz = sb ^ (((sb >> 9) & 1) << 5); R = (st >> 1) * 16 + swz / 64; C = (st & 1) * 32 + (swz % 64) / 2; }
__host__ __device__ __forceinline__ int perm32(int rho) { const int n = rho >> 4, i = rho & 15; return 8 * (i >> 2) + 4 * n + (i & 3); }

struct Unit { const char* A0; const char* A1; const char* B0; const char* B1; int pm, pn, e, ord; };

__device__ __forceinline__ void mfma_f8_acc(f32x4& acc, const i32x8& b, const i32x8& a, int sw, int sa) {
    asm volatile("v_mfma_scale_f32_16x16x128_f8f6f4 %0, %1, %2, %0, %3, %4 op_sel_hi:[0,0,0]" : "+v"(acc) : "v"(b), "v"(a), "v"(sw), "v"(sa)); }
__device__ __forceinline__ unsigned cvt_pk_bf16(float lo, float hi) { unsigned r; asm volatile("v_cvt_pk_bf16_f32 %0, %1, %2" : "=v"(r) : "v"(lo), "v"(hi)); return r; }

template <class Epi, class Sched, bool F8 = false, int KREP = 1>
__device__ __forceinline__ void gemm_phase(PG8_LAS unsigned char* lds, const Sched& S, const Epi& E) {
    const int tid = threadIdx.x, wid = __builtin_amdgcn_readfirstlane(tid >> 6), lane = tid & 63, wr = wid >> 2, wc = wid & 3, fr = lane & 15, fq = lane >> 4;
    constexpr int KB = F8 ? GK : GK * 2, nt1 = F8 ? GK / 128 : GNT, nt = nt1 * KREP;
    int Rr[2], Cc[2];
    unsigned voffB[2], cvA[2][2], nvA[2][2];
#pragma unroll
    for (int i = 0; i < 2; ++i) { stage_rc(tid * 16 + i * 8192, Rr[i], Cc[i]); const int Rb = Epi::PERM ? ((Rr[i] & ~31) + perm32(Rr[i] & 31)) : Rr[i]; voffB[i] = (unsigned)(Rb * KB + Cc[i] * 2); }
    constexpr size_t kstep = (size_t)(BK * 2);
    const unsigned ldsw = (unsigned)wid * 1024u;
    const int aoff = lds_byte(wr * 64 + fr, fq * 8), boff = lds_byte(wc * 32 + fr, fq * 8);
#define PG8_SA(b, h) (((b) * 2 + (h)) * HTB)
#define PG8_SB(b, h) ((4 + (b) * 2 + (h)) * HTB)
#define PG8_STAGE(bufoff, gbase, voff) do { _Pragma("unroll") for (int _i = 0; _i < 2; ++_i) \
        __builtin_amdgcn_global_load_lds((const unsigned*)((const char*)(gbase) + (voff)[_i]), (PG8_LAS unsigned*)(lds + (bufoff) + ldsw + _i * 8192), 16, 0, 0); } while (0)
#define PG8_LD8(p) __builtin_shufflevector(*(const PG8_LAS i32x4*)(p), *(const PG8_LAS i32x4*)((p) + 1024), 0, 1, 2, 3, 4, 5, 6, 7)
#define PG8_LDA(dst, b, h) do { _Pragma("unroll") for (int m = 0; m < 4; ++m) { if constexpr (F8) { dst##8[m] = PG8_LD8(lds + PG8_SA(b, h) + aoff + m * 2048); } \
        else { _Pragma("unroll") for (int k = 0; k < 2; ++k) dst[m][k] = *(const PG8_LAS bf16x8*)(lds + PG8_SA(b, h) + aoff + m * 2048 + k * 1024); } } } while (0)
#define PG8_LDB(dst, b, h) do { _Pragma("unroll") for (int n = 0; n < 2; ++n) { if constexpr (F8) { dst##8[n] = PG8_LD8(lds + PG8_SB(b, h) + boff + n * 2048); } \
        else { _Pragma("unroll") for (int k = 0; k < 2; ++k) dst[n][k] = *(const PG8_LAS bf16x8*)(lds + PG8_SB(b, h) + boff + n * 2048 + k * 1024); } } } while (0)
#define PG8_MMA(ai, bj, At, Bt) do { __builtin_amdgcn_s_setprio(1); _Pragma("unroll") for (int m = 0; m < 4; ++m) _Pragma("unroll") for (int n = 0; n < 2; ++n) { \
        if constexpr (F8) { mfma_f8_acc(acc[ai][bj][m][n], Bt##8[n], At##8[m], scw, sca); } \
        else { _Pragma("unroll") for (int k = 0; k < 2; ++k) acc[ai][bj][m][n] = __builtin_amdgcn_mfma_f32_16x16x32_bf16(Bt[n][k], At[m][k], acc[ai][bj][m][n], 0, 0, 0); } } \
        __builtin_amdgcn_s_setprio(0); } while (0)
#define PG8_WAIT_V(n) asm volatile("s_waitcnt vmcnt(" #n ")" ::: "memory")
    constexpr int RELAX = 8 + Epi::NST + (Sched::GATHER ? 4 : 0);
#define PG8_WAIT_V8R(rx) do { if (rx) { if constexpr (RELAX == 12) PG8_WAIT_V(12); else if constexpr (RELAX == 16) PG8_WAIT_V(16); else if constexpr (RELAX == 20) PG8_WAIT_V(20); \
        else if constexpr (RELAX == 24) PG8_WAIT_V(24); else if constexpr (RELAX == 28) PG8_WAIT_V(28); else PG8_WAIT_V(8); } else PG8_WAIT_V(8); } while (0)
#define PG8_WAIT_L(n) asm volatile("s_waitcnt lgkmcnt(" #n ")" ::: "memory")
#define PG8_BAR __builtin_amdgcn_s_barrier()
#define PG8_SCHED __builtin_amdgcn_sched_barrier(0)
#define PG8_VOFF(dst, u) do { _Pragma("unroll") for (int _h = 0; _h < 2; ++_h) _Pragma("unroll") for (int _i = 0; _i < 2; ++_i) { \
        const int _row = Sched::GATHER ? S.row_of(u, _h * HALF + Rr[_i]) : Rr[_i]; dst[_h][_i] = (unsigned)(_row * KB + Cc[_i] * 2); } } while (0)
    Unit cur, nxt; int ui = 0;
    if (!S.next(0, cur)) return;
    f32x4 acc[2][2][4][2];
#pragma unroll
    for (int a = 0; a < 2; ++a)
#pragma unroll
        for (int b = 0; b < 2; ++b)
#pragma unroll
            for (int m = 0; m < 4; ++m)
#pragma unroll
                for (int n = 0; n < 2; ++n) acc[a][b][m][n] = (f32x4){0.f, 0.f, 0.f, 0.f};
    const int scw = F8_SCALE_W, sca = F8_SCALE_A;
    bf16x8 At[4][2], B0[2][2], B1[2][2]; i32x8 At8[4], B08[2], B18[2];
    PG8_VOFF(cvA, cur);
    if (Sched::GATHER) { asm volatile("s_waitcnt vmcnt(0)" ::: "memory"); }
    PG8_STAGE(PG8_SB(0, 0), cur.B0, voffB); PG8_STAGE(PG8_SB(0, 1), cur.B1, voffB); PG8_STAGE(PG8_SA(0, 0), cur.A0, cvA[0]); PG8_STAGE(PG8_SA(0, 1), cur.A1, cvA[1]);
    if (wr == 1) PG8_BAR;
    PG8_WAIT_V(2); PG8_BAR;
    PG8_STAGE(PG8_SB(1, 0), cur.B0 + kstep, voffB); PG8_STAGE(PG8_SA(1, 0), cur.A0 + kstep, cvA[0]); PG8_STAGE(PG8_SB(1, 1), cur.B1 + kstep, voffB);
    PG8_WAIT_V(6); PG8_BAR;
    for (;;) {
        const bool has_next = S.next(ui + 1, nxt);
        if (!has_next) nxt = cur;
        int nraw[2][2];
        if (Sched::GATHER && has_next) {
#pragma unroll
            for (int _h = 0; _h < 2; ++_h)
#pragma unroll
                for (int _i = 0; _i < 2; ++_i) { const int* p_ = S.row_ptr(nxt, _h * HALF + Rr[_i]); asm volatile("global_load_dword %0, %1, off" : "=v"(nraw[_h][_i]) : "v"(p_) : "memory"); }
        }
        if (has_next) { if (!Sched::GATHER) { PG8_VOFF(nvA, nxt); } }
        else {
#pragma unroll
            for (int _h = 0; _h < 2; ++_h)
#pragma unroll
                for (int _i = 0; _i < 2; ++_i) nvA[_h][_i] = cvA[_h][_i]; }
#pragma unroll 1
        for (int t = 0; t < nt; t += 2) {
            const bool last = (t == nt - 2); const bool rx = (t == 0) && (ui > 0);
            if (Epi::MID && t == nt / 2) E.mid(acc, cur, wr, wc, fr, fq);
            const char* a1_1 = cur.A1 + (size_t)((t + 1) % nt1) * kstep;
            const char* a2_0 = last ? nxt.A0 : cur.A0 + (size_t)((t + 2) % nt1) * kstep; const char* a2_1 = last ? nxt.A1 : cur.A1 + (size_t)((t + 2) % nt1) * kstep;
            const char* b2_0 = last ? nxt.B0 : cur.B0 + (size_t)((t + 2) % nt1) * kstep; const char* b2_1 = last ? nxt.B1 : cur.B1 + (size_t)((t + 2) % nt1) * kstep;
            const char* a3_0 = a2_0 + kstep; const char* a3_1 = a2_1 + kstep; const char* b3_0 = b2_0 + kstep; const char* b3_1 = b2_1 + kstep;
            if (Sched::GATHER && last && has_next) {
#pragma unroll
                for (int _h = 0; _h < 2; ++_h)
#pragma unroll
                    for (int _i = 0; _i < 2; ++_i) { int r_ = nraw[_h][_i]; asm volatile("" : "+v"(r_));
                        nvA[_h][_i] = (unsigned)(r_ * KB + Cc[_i] * 2); } }
            unsigned sv0[2], sv1[2];
#pragma unroll
            for (int _i = 0; _i < 2; ++_i) { sv0[_i] = last ? nvA[0][_i] : cvA[0][_i]; sv1[_i] = last ? nvA[1][_i] : cvA[1][_i]; }
            PG8_LDB(B0, 0, 0); PG8_LDB(B1, 0, 1); PG8_SCHED; PG8_LDA(At, 0, 0); PG8_STAGE(PG8_SA(1, 1), a1_1, cvA[1]);
            PG8_WAIT_V8R(rx); PG8_WAIT_L(0); PG8_BAR; PG8_MMA(0, 0, At, B0); PG8_MMA(0, 1, At, B1); PG8_BAR; PG8_SCHED;
            PG8_LDA(At, 0, 1); PG8_STAGE(PG8_SB(0, 0), b2_0, voffB); PG8_STAGE(PG8_SB(0, 1), b2_1, voffB); PG8_STAGE(PG8_SA(0, 0), a2_0, sv0);
            PG8_WAIT_V8R(rx); PG8_WAIT_L(0); PG8_BAR; PG8_MMA(1, 0, At, B0); PG8_MMA(1, 1, At, B1); PG8_BAR; PG8_SCHED;
            PG8_LDB(B0, 1, 0); PG8_LDB(B1, 1, 1); PG8_SCHED; PG8_LDA(At, 1, 0); PG8_STAGE(PG8_SA(0, 1), a2_1, sv1);
            PG8_WAIT_V(8); PG8_WAIT_L(0); PG8_BAR; PG8_MMA(0, 0, At, B0); PG8_MMA(0, 1, At, B1); PG8_BAR; PG8_SCHED;
            PG8_LDA(At, 1, 1); PG8_STAGE(PG8_SB(1, 0), b3_0, voffB); PG8_STAGE(PG8_SB(1, 1), b3_1, voffB); PG8_STAGE(PG8_SA(1, 0), a3_0, sv0);
            PG8_WAIT_V(8); PG8_WAIT_L(0); PG8_BAR; PG8_MMA(1, 0, At, B0); PG8_MMA(1, 1, At, B1); PG8_BAR; PG8_SCHED;
            (void)a3_1; (void)b3_1;
        }
        if (wr == 0) PG8_BAR;
        if constexpr (F8) { asm volatile("s_nop 15\n\ts_nop 15\n\ts_nop 7" ::: "memory"); }
        E(acc, cur, wr, wc, fr, fq);
        if (!has_next) break;
#pragma unroll
        for (int a = 0; a < 2; ++a)
#pragma unroll
            for (int b = 0; b < 2; ++b)
#pragma unroll
                for (int m = 0; m < 4; ++m)
#pragma unroll
                    for (int n = 0; n < 2; ++n) acc[a][b][m][n] = (f32x4){0.f, 0.f, 0.f, 0.f};
        cur = nxt; ++ui;
#pragma unroll
        for (int _h = 0; _h < 2; ++_h)
#pragma unroll
            for (int _i = 0; _i < 2; ++_i) cvA[_h][_i] = nvA[_h][_i];
        if (wr == 1) PG8_BAR;
    }
    PG8_WAIT_V(0);
    PG8_BAR;
#undef PG8_SA
#undef PG8_SB
#undef PG8_STAGE
#undef PG8_LDA
#undef PG8_LDB
#undef PG8_MMA
#undef PG8_LD8
#undef PG8_WAIT_V
#undef PG8_WAIT_V8R
#undef PG8_WAIT_L
#undef PG8_BAR
#undef PG8_SCHED
#undef PG8_VOFF
}
}

namespace pg8 {

struct DenseOrder {
    static constexpr bool GATHER = false;
    const bf16_t* A; const bf16_t* Bt; int nM, nN, nwg, G, c;
    __device__ __forceinline__ void init(const bf16_t* A_, const bf16_t* Bt_, int M, int N, int G_, int c_) { A = A_; Bt = Bt_; nM = M / BM; nN = N / BM; nwg = nM * nN; G = G_; c = c_; }
    __device__ __forceinline__ bool next(int i, Unit& u) const {
        const long L = (long)i * G + c; if (L >= nwg) return false;
        int wgid = (int)L; { const int q = nwg / NXCD, r = nwg % NXCD, xcd = wgid % NXCD, off = wgid / NXCD; wgid = (xcd < r ? xcd * (q + 1) : r * (q + 1) + (xcd - r) * q) + off; }
        const int nig = WGM * nN, gid = wgid / nig, fm = gid * WGM, gsz = (nM - fm) < WGM ? (nM - fm) : WGM;
        u.pm = fm + ((wgid % nig) % gsz); u.pn = (wgid % nig) / gsz; u.e = 0; u.ord = i;
        u.A0 = (const char*)A + (size_t)u.pm * BM * GK * 2; u.A1 = u.A0 + (size_t)HALF * GK * 2;
        u.B0 = (const char*)Bt + (size_t)u.pn * BM * GK * 2; u.B1 = u.B0 + (size_t)HALF * GK * 2;
        return true;
    }
    __device__ __forceinline__ int row_of(const Unit&, int r) const { return r; }
    __device__ __forceinline__ const int* row_ptr(const Unit&, int) const { return nullptr; }
};
struct UpOrder {
    static constexpr bool GATHER = true;
    const unsigned char* H2; const unsigned char* WupT; const int* row_tok; const PG8_LAS int* mt_exp; int nunits, G, c;
    __device__ __forceinline__ bool next(int i, Unit& u) const {
        const int L = i * G + c; if (L >= nunits) return false;
        u.pm = L >> 3; u.pn = L & 7; u.e = __builtin_amdgcn_readfirstlane(mt_exp[u.pm]); u.ord = i;
        u.A0 = (const char*)H2; u.A1 = (const char*)H2;
        u.B0 = (const char*)WupT + ((size_t)u.e * 2 * DEXP + (size_t)u.pn * HALF) * GK; u.B1 = u.B0 + (size_t)DEXP * GK;
        return true;
    }
    __device__ __forceinline__ int row_of(const Unit& u, int r) const { return row_tok[u.pm * BM + r]; }
    __device__ __forceinline__ const int* row_ptr(const Unit& u, int r) const { return row_tok + u.pm * BM + r; }
};
struct DownOrder {
    static constexpr bool GATHER = false;
    const unsigned char* ACT; const unsigned char* WdnT; const PG8_LAS int* mt_exp; int nunits, G, c;
    __device__ __forceinline__ bool next(int i, Unit& u) const {
        const int L = i * G + c; if (L >= nunits) return false;
        u.pm = L >> 2; u.pn = L & 3; u.e = __builtin_amdgcn_readfirstlane(mt_exp[u.pm]); u.ord = i;
        u.A0 = (const char*)ACT + (size_t)u.pm * BM * GK; u.A1 = u.A0 + (size_t)HALF * GK;
        u.B0 = (const char*)WdnT + ((size_t)u.e * DM + (size_t)u.pn * BM) * GK; u.B1 = u.B0 + (size_t)HALF * GK;
        return true;
    }
    __device__ __forceinline__ int row_of(const Unit&, int r) const { return r; }
    __device__ __forceinline__ const int* row_ptr(const Unit&, int) const { return nullptr; }
};

struct EpiProj {
    static constexpr bool PERM = true, MID = false; static constexpr int NST = 16;
    bf16_t* O; size_t tstride; float qscale;
    __device__ __forceinline__ void mid(f32x4 (&)[2][2][4][2], const Unit&, int, int, int, int) const {}
    __device__ __forceinline__ void operator()(const f32x4 (&acc)[2][2][4][2], const Unit& u, int wr, int wc, int fr, int fq) const {
        const int t = u.pn >> 1; bf16_t* base = O + (size_t)t * tstride; const float sc = (t == 2) ? qscale : 1.f;
        const int row0 = u.pm * BM + wr * 64 + fr, col0 = (u.pn & 1) * BM + wc * 32 + 8 * fq;
#pragma unroll
        for (int ai = 0; ai < 2; ++ai)
#pragma unroll
            for (int m = 0; m < 4; ++m) { bf16_t* rowp = base + (size_t)(row0 + ai * HALF + m * 16) * 512 + col0;
#pragma unroll
                for (int bj = 0; bj < 2; ++bj) { const f32x4 v0 = acc[ai][bj][m][0] * sc, v1 = acc[ai][bj][m][1] * sc;
                    u32x4 w; w.x = cvt_pk_bf16(v0[0], v0[1]); w.y = cvt_pk_bf16(v0[2], v0[3]); w.z = cvt_pk_bf16(v1[0], v1[1]); w.w = cvt_pk_bf16(v1[2], v1[3]);
                    *(u32x4*)(rowp + bj * HALF) = w; } }
    }
};
struct EpiOut {
    static constexpr bool PERM = true, MID = true; static constexpr int NST = 0;
    bf16_t* Y; const float* ssq;
    __device__ __forceinline__ void mid(f32x4 (&acc)[2][2][4][2], const Unit& u, int wr, int wc, int fr, int fq) const {
#pragma unroll
        for (int ai = 0; ai < 2; ++ai)
#pragma unroll
            for (int m = 0; m < 4; ++m) { const int row = u.pm * BM + ai * HALF + wr * 64 + m * 16 + fr;
                const f32x4 s0 = *(const f32x4*)(ssq + (size_t)row * 8), s1 = *(const f32x4*)(ssq + (size_t)row * 8 + 4);
                const float tot = ((s0[0] + s0[1]) + (s0[2] + s0[3])) + ((s1[0] + s1[1]) + (s1[2] + s1[3]));
                const float ri = 1.0f / sqrtf(tot * (1.0f / DATT) + RMS_EPS);
#pragma unroll
                for (int bj = 0; bj < 2; ++bj)
#pragma unroll
                    for (int n = 0; n < 2; ++n) acc[ai][bj][m][n] = acc[ai][bj][m][n] * ri; }
    }
    __device__ __forceinline__ void operator()(const f32x4 (&acc)[2][2][4][2], const Unit& u, int wr, int wc, int fr, int fq) const {
        const int row0 = u.pm * BM + wr * 64 + fr, col0 = u.pn * BM + wc * 32 + 8 * fq;
#pragma unroll
        for (int ai = 0; ai < 2; ++ai)
#pragma unroll
            for (int m = 0; m < 4; ++m) { bf16_t* rowp = Y + (size_t)(row0 + ai * HALF + m * 16) * DM + col0;
#pragma unroll
                for (int bj = 0; bj < 2; ++bj) { const f32x4 v0 = acc[ai][bj][m][0], v1 = acc[ai][bj][m][1];
                    u32x4 w; w.x = cvt_pk_bf16(v0[0], v0[1]); w.y = cvt_pk_bf16(v0[2], v0[3]); w.z = cvt_pk_bf16(v1[0], v1[1]); w.w = cvt_pk_bf16(v1[2], v1[3]);
                    *(u32x4*)(rowp + bj * HALF) = w; } }
    }
};
struct EpiUp {
    static constexpr bool PERM = true, MID = false; static constexpr int NST = 8;
    unsigned char* ACT; const PG8_LAS float* bias;
    __device__ __forceinline__ void mid(f32x4 (&)[2][2][4][2], const Unit&, int, int, int, int) const {}
    __device__ __forceinline__ void operator()(const f32x4 (&acc)[2][2][4][2], const Unit& u, int wr, int wc, int fr, int fq) const {
        const int row0 = u.pm * BM + wr * 64 + fr, col0 = u.pn * HALF + wc * 32 + 8 * fq;
        const PG8_LAS float* bg = bias + u.ord * 256 + wc * 32 + 8 * fq;
        f32x4 bgl[2], bli[2];
#pragma unroll
        for (int n = 0; n < 2; ++n) { bgl[n] = *(const PG8_LAS f32x4*)(bg + 4 * n); bli[n] = *(const PG8_LAS f32x4*)(bg + HALF + 4 * n); }
#pragma unroll
        for (int ai = 0; ai < 2; ++ai)
#pragma unroll
            for (int m = 0; m < 4; ++m) { unsigned char* rowp = ACT + (size_t)(row0 + ai * HALF + m * 16) * DEXP + col0;
                float o[8];
#pragma unroll
                for (int n = 0; n < 2; ++n)
#pragma unroll
                    for (int j = 0; j < 4; ++j) { const float gl = fminf(acc[ai][0][m][n][j] + bgl[n][j], 7.0f); const float li = fminf(fmaxf(acc[ai][1][m][n][j] + bli[n][j], -7.0f), 7.0f);
                        const float sg = __builtin_amdgcn_rcpf(1.0f + __builtin_amdgcn_exp2f(-1.702f * 1.4426950408889634f * gl)); o[4 * n + j] = gl * sg * (li + 1.0f); }
                int w0 = 0, w1 = 0; w0 = __builtin_amdgcn_cvt_pk_fp8_f32(o[0], o[1], w0, false); w0 = __builtin_amdgcn_cvt_pk_fp8_f32(o[2], o[3], w0, true);
                w1 = __builtin_amdgcn_cvt_pk_fp8_f32(o[4], o[5], w1, false); w1 = __builtin_amdgcn_cvt_pk_fp8_f32(o[6], o[7], w1, true);
                typedef int i32x2_ __attribute__((ext_vector_type(2))); *(i32x2_*)rowp = (i32x2_){w0, w1}; }
    }
};
struct EpiDown {
    static constexpr bool PERM = true, MID = false; static constexpr int NST = 16;
    unsigned char* YP; const PG8_LAS float* bias; const int* row_pair; const float* row_w;
    __device__ __forceinline__ void mid(f32x4 (&)[2][2][4][2], const Unit&, int, int, int, int) const {}
    __device__ __forceinline__ void operator()(const f32x4 (&acc)[2][2][4][2], const Unit& u, int wr, int wc, int fr, int fq) const {
        const int row0 = u.pm * BM + wr * 64 + fr, col0 = u.pn * BM + wc * 32 + 8 * fq;
        const PG8_LAS float* bd = bias + u.ord * 256 + wc * 32 + 8 * fq;
        f32x4 bv[2][2];
#pragma unroll
        for (int bj = 0; bj < 2; ++bj)
#pragma unroll
            for (int n = 0; n < 2; ++n) bv[bj][n] = *(const PG8_LAS f32x4*)(bd + bj * HALF + 4 * n);
        int pr[2][4]; float wt[2][4];
#pragma unroll
        for (int ai = 0; ai < 2; ++ai)
#pragma unroll
            for (int m = 0; m < 4; ++m) { const int pos = row0 + ai * HALF + m * 16; pr[ai][m] = row_pair[pos]; wt[ai][m] = row_w[pos] * 4.0f; }
#pragma unroll
        for (int ai = 0; ai < 2; ++ai)
#pragma unroll
            for (int m = 0; m < 4; ++m) { const int pair = pr[ai][m] >= 0 ? pr[ai][m] : NTOK * TOPK; const float w = wt[ai][m];
                { unsigned char* rowp = YP + (size_t)pair * DM + col0;
#pragma unroll
                    for (int bj = 0; bj < 2; ++bj) { const f32x4 v0 = (acc[ai][bj][m][0] + bv[bj][0]) * w, v1 = (acc[ai][bj][m][1] + bv[bj][1]) * w;
                        int q0 = 0, q1 = 0; q0 = __builtin_amdgcn_cvt_pk_fp8_f32(v0[0], v0[1], q0, false); q0 = __builtin_amdgcn_cvt_pk_fp8_f32(v0[2], v0[3], q0, true);
                        q1 = __builtin_amdgcn_cvt_pk_fp8_f32(v1[0], v1[1], q1, false); q1 = __builtin_amdgcn_cvt_pk_fp8_f32(v1[2], v1[3], q1, true);
                        typedef int i32x2_ __attribute__((ext_vector_type(2))); *(i32x2_*)(rowp + bj * HALF) = (i32x2_){q0, q1}; } } }
    }
};
}

namespace attn_body {
using bf16=__hip_bfloat16;
using bf16x8=__attribute__((ext_vector_type(8)))short;
using s16x4=__attribute__((ext_vector_type(4)))short;
using f32x16=__attribute__((ext_vector_type(16)))float;
using u32x4=__attribute__((ext_vector_type(4)))unsigned;
constexpr int BATCH=8,NHEAD=8,SEQ=2048,D=64,DM=NHEAD*D,OPITCH=1024;
constexpr int NW=8,QBLK=32,QB=QBLK*NW,KVBLK=64,NQB=SEQ/QB;
constexpr int ATTN_PITCH=DM, ATTN_UNIT_ROWS=QB;
__device__ __forceinline__ int crow(int r,int hi){return (r&3)+8*(r>>2)+4*hi;}
#define SBAR() __builtin_amdgcn_sched_barrier(0)
__device__ __forceinline__ void cmask(f32x16&p0,f32x16&p1,int jb,int qrel,int hi){
  const float NEG=-INFINITY; int kb=64*jb+4*hi;
  #pragma unroll
  for(int r=0;r<16;++r){int kv=kb+(r&3)+8*(r>>2); if(kv>qrel)p0[r]=NEG; if(kv+32>qrel)p1[r]=NEG;}
}

constexpr int NSLOT=3, SLOTB=8192;
constexpr int LDS_K=0, LDS_V=NSLOT*SLOTB, LDS_WS=2*NSLOT*SLOTB, LDS_OST=LDS_WS+NW*64*4, LDS_BIAS=LDS_OST+NW*4096, LDS_SCAN=LDS_BIAS+(SEQ+64)*4, LDS_BYTES=LDS_SCAN+256;
constexpr float C2=0.125f*1.4426950408889634f;
__device__ __forceinline__ void glds16(const void*gsrc,unsigned lds_dst){unsigned keep;
  asm volatile("s_mov_b32 %0, m0\n\ts_mov_b32 m0, %2\n\ts_nop 0\n\tglobal_load_lds_dwordx4 %1, off\n\ts_mov_b32 m0, %0":"=&s"(keep):"v"(gsrc),"s"(lds_dst):"memory");}
__device__ __forceinline__ float max3f(float a,float b,float c){float r;asm("v_max3_f32 %0, %1, %2, %3":"=v"(r):"v"(a),"v"(b),"v"(c));return r;}
__device__ __forceinline__ float max2f(float a,float b){float r;asm("v_max_f32_e32 %0, %1, %2":"=v"(r):"v"(a),"v"(b));return r;}
__device__ __forceinline__ float fadd_s(float a,float b){float r;asm("v_add_f32_e32 %0, %1, %2":"=v"(r):"v"(a),"v"(b));return r;}
__device__ __forceinline__ float fsub_s(float a,float b){float r;asm("v_sub_f32_e32 %0, %1, %2":"=v"(r):"v"(a),"v"(b));return r;}
typedef float f32x2_t __attribute__((ext_vector_type(2))); typedef float f32x4_t __attribute__((ext_vector_type(4))); typedef __bf16 bf16x2_t __attribute__((ext_vector_type(2)));
__device__ __forceinline__ unsigned cvtpk_s(float lo,float hi){f32x2_t v={lo,hi};bf16x2_t b=__builtin_convertvector(v,bf16x2_t);return __builtin_bit_cast(unsigned,b);}
#define WAIT_BAR(N) asm volatile("s_waitcnt vmcnt(" #N ") lgkmcnt(0)\n\ts_barrier":::"memory")

__device__ __forceinline__ void qkt(f32x16&p0,f32x16&p1,const char*Kslot,const bf16x8*qr,int r32,int hi){
  const char*kb=Kslot+hi*1024+r32*16;
  #pragma unroll
  for(int d0=0;d0<4;++d0){
    const bf16x8 b0=*reinterpret_cast<const bf16x8*>(kb+d0*2048);
    const bf16x8 b1=*reinterpret_cast<const bf16x8*>(kb+d0*2048+512);
    p0=__builtin_amdgcn_mfma_f32_32x32x16_bf16(b0,qr[d0],p0,0,0,0);p1=__builtin_amdgcn_mfma_f32_32x32x16_bf16(b1,qr[d0],p1,0,0,0);}
}
typedef __attribute__((address_space(3))) const char* lds_cptr;
typedef short v4i16_t __attribute__((ext_vector_type(4)));
__device__ __forceinline__ void kload8(bf16x8*kf,lds_cptr kp){
  kf[0]=*(const __attribute__((address_space(3))) bf16x8*)(kp);      kf[1]=*(const __attribute__((address_space(3))) bf16x8*)(kp+512);
  kf[2]=*(const __attribute__((address_space(3))) bf16x8*)(kp+2048); kf[3]=*(const __attribute__((address_space(3))) bf16x8*)(kp+2560);
  kf[4]=*(const __attribute__((address_space(3))) bf16x8*)(kp+4096); kf[5]=*(const __attribute__((address_space(3))) bf16x8*)(kp+4608);
  kf[6]=*(const __attribute__((address_space(3))) bf16x8*)(kp+6144); kf[7]=*(const __attribute__((address_space(3))) bf16x8*)(kp+6656);
}
__device__ __forceinline__ void kload2(bf16x8*kf,lds_cptr kp,int j){ kf[2*j]=*(const __attribute__((address_space(3))) bf16x8*)(kp+j*2048); kf[2*j+1]=*(const __attribute__((address_space(3))) bf16x8*)(kp+j*2048+512); }
__device__ __forceinline__ s16x4 vtr(lds_cptr p){ return __builtin_bit_cast(s16x4,__builtin_amdgcn_ds_read_tr16_b64_v4i16((__attribute__((address_space(3))) v4i16_t*)p)); }
__device__ __forceinline__ float rowmax(const f32x16&p0,const f32x16&p1){
  float a=max3f(p0[0],p0[1],p1[0]),b=max3f(p0[2],p0[3],p1[1]);a=max3f(a,p1[2],p1[3]);
  #pragma unroll
  for(int r=4;r<16;r+=4){a=max3f(a,p0[r],p0[r+1]);b=max3f(b,p0[r+2],p0[r+3]);a=max3f(a,p1[r],p1[r+1]);b=max3f(b,p1[r+2],p1[r+3]);}
  const float m=max2f(a,b);
  auto rr=__builtin_amdgcn_permlane32_swap(__float_as_uint(m),__float_as_uint(m),false,false);
  return max2f(__uint_as_float(rr[0]),__uint_as_float(rr[1]));
}
__device__ __forceinline__ void pv(f32x16*o,int vb,bf16x8 pa0,bf16x8 pa1,bf16x8 pa2,bf16x8 pa3){
  #pragma unroll
  for(int d0=0;d0<2;++d0){s16x4 lo[4],hi[4];
    #pragma unroll
    for(int ks=0;ks<4;++ks){
      asm volatile("ds_read_b64_tr_b16 %0,%1 offset:%c2":"=&v"(lo[ks]):"v"(vb),"i"(d0*4096+ks*1024):"memory");
      asm volatile("ds_read_b64_tr_b16 %0,%1 offset:%c2":"=&v"(hi[ks]):"v"(vb),"i"(d0*4096+ks*1024+512):"memory");}
    asm volatile("s_waitcnt lgkmcnt(0)":::"memory");SBAR();
    #define PK(k) (bf16x8){lo[k][0],lo[k][1],lo[k][2],lo[k][3],hi[k][0],hi[k][1],hi[k][2],hi[k][3]}
    o[d0]=__builtin_amdgcn_mfma_f32_32x32x16_bf16(pa0,PK(0),o[d0],0,0,0);
    o[d0]=__builtin_amdgcn_mfma_f32_32x32x16_bf16(pa1,PK(1),o[d0],0,0,0);
    o[d0]=__builtin_amdgcn_mfma_f32_32x32x16_bf16(pa2,PK(2),o[d0],0,0,0);
    o[d0]=__builtin_amdgcn_mfma_f32_32x32x16_bf16(pa3,PK(3),o[d0],0,0,0);
    #undef PK
  }
}

#ifndef ATTN_STORE16
#define ATTN_STORE16(p,v) (*(u32x4*)(p)=(v))
#endif
template<int THRL> __device__ __forceinline__ void attn_unit(int b,int h,int qb,const bf16*Q,const bf16*__restrict__ K,const bf16*__restrict__ V,bf16*O,const float*__restrict__ LOGF2,float*SSQ,char*shm){
  const int tid=threadIdx.x,lane=tid&63,r32=lane&31,hi=lane>>5; const int wid=__builtin_amdgcn_readfirstlane(tid>>6);
  const long rowbase=(long)b*SEQ; const int q0=qb*QB;
  const bf16*Qw=Q+(rowbase+q0+wid*QBLK)*DM+h*D;
  const bf16*Kh=K+rowbase*DM+h*D,*Vh=V+rowbase*DM+h*D;
  const unsigned lds0=(unsigned)(uintptr_t)shm;
  float*wsf=(float*)(shm+LDS_WS)+wid*64;
  const bf16*ksrc=Kh+(long)lane*DM+wid*8;
  const bf16*vsrc=Vh+(long)(16*(wid&3)+(lane>>2))*DM+(wid>>2)*32+(lane&3)*8;
  const unsigned kdst=lds0+LDS_K+wid*1024, vdst=lds0+LDS_V+wid*1024;
  #define DMA_K(t,slot) glds16(ksrc+(long)(t)*KVBLK*DM,(unsigned)__builtin_amdgcn_readfirstlane(kdst+(slot)))
  #define DMA_V(t,slot) glds16(vsrc+(long)(t)*KVBLK*DM,(unsigned)__builtin_amdgcn_readfirstlane(vdst+(slot)))
  const int vb0=(int)(lds0+LDS_V)+((lane>>4)&1)*32+(lane&3)*8+(4*hi+((lane&15)>>2))*64;
  const char*Kbase=shm+LDS_K; bf16x8 kf[8];
  const lds_cptr shm3=(lds_cptr)shm; const lds_cptr kp0=shm3+LDS_K+hi*1024+r32*16; const lds_cptr vp0=shm3+LDS_V+((lane>>4)&1)*32+(lane&3)*8+(4*hi+((lane&15)>>2))*64;
  const int NT=(q0+QB)/KVBLK;
  { float*biasl=(float*)(shm+LDS_BIAS); float*scn=(float*)(shm+LDS_SCAN);
    const float*lf=LOGF2+rowbase*NHEAD+h;
    float v0=0.f,v1=0.f,v2=0.f,v3=0.f; const int i0=4*tid;
    if(i0<q0){ v0=lf[(long)(q0-1-i0)*NHEAD]; v1=lf[(long)(q0-2-i0)*NHEAD]; v2=lf[(long)(q0-3-i0)*NHEAD]; v3=lf[(long)(q0-4-i0)*NHEAD]; }
    const float tsum=(v0+v1)+(v2+v3); float inc=tsum;
    #pragma unroll
    for(int o=1;o<64;o<<=1){ const float n_=__shfl_up(inc,o); if(lane>=o)inc+=n_; }
    if(lane==63)scn[wid]=inc;
    const float f0=lf[(long)(q0+4*lane)*NHEAD],f1=lf[(long)(q0+4*lane+1)*NHEAD],f2=lf[(long)(q0+4*lane+2)*NHEAD],f3=lf[(long)(q0+4*lane+3)*NHEAD];
    float finc=(f0+f1)+(f2+f3);
    #pragma unroll
    for(int o=1;o<64;o<<=1){ const float n_=__shfl_up(finc,o); if(lane>=o)finc+=n_; }
    const float fex=finc-((f0+f1)+(f2+f3));
    if(wid==0){ biasl[q0+4*lane]=-(fex+f0); biasl[q0+4*lane+1]=-(fex+f0+f1); biasl[q0+4*lane+2]=-(fex+f0+f1+f2); biasl[q0+4*lane+3]=-(fex+f0+f1+f2+f3); }
    __syncthreads();
    float woff=0.f;
    #pragma unroll
    for(int w_=0;w_<NW;++w_) woff+=(w_<wid)?scn[w_]:0.f;
    const float ex=woff+inc-tsum;
    if(i0<q0){ biasl[q0-1-i0]=ex; biasl[q0-2-i0]=ex+v0; biasl[q0-3-i0]=ex+v0+v1; biasl[q0-4-i0]=ex+v0+v1+v2; }
    __syncthreads(); }
  const lds_cptr biasr=(lds_cptr)shm+LDS_BIAS+16*hi;
  #define BIAS4(t,o) (*(const __attribute__((address_space(3))) f32x4_t*)(biasr+(t)*(KVBLK*4)+(o)*4))
  #define INIT4(Y,g,t,o) do{ const f32x4_t x_=BIAS4(t,(o)+8*(g)); Y[4*(g)]=x_[0]-mhat; Y[4*(g)+1]=x_[1]-mhat; Y[4*(g)+2]=x_[2]-mhat; Y[4*(g)+3]=x_[3]-mhat; }while(0)
  #define INITT(Y0,Y1,t) do{ INIT4(Y0,0,t,0);INIT4(Y0,1,t,0);INIT4(Y0,2,t,0);INIT4(Y0,3,t,0); INIT4(Y1,0,t,32);INIT4(Y1,1,t,32);INIT4(Y1,2,t,32);INIT4(Y1,3,t,32); }while(0)
  DMA_K(0,0);DMA_V(0,0);DMA_K(1,SLOTB);
  bf16x8 qr[4];
  #pragma unroll
  for(int d0=0;d0<4;++d0)qr[d0]=*reinterpret_cast<const bf16x8*>(&Qw[(long)r32*DM+d0*16+hi*8]);
  float mhat=((const float*)(shm+LDS_BIAS))[q0+wid*QBLK+r32]+8.0f,l_reg=0.f;f32x16 o[2];o[0]=f32x16{};o[1]=f32x16{};
  const int qrel=wid*QBLK+r32;
  #define CMASK(P0,P1,t) do{int jb_=(t)-(NT-4); if(jb_>=0)cmask(P0,P1,jb_,qrel,hi);}while(0)
  bool resc=false;
  #define START(P0,P1) do{ const float rm=rowmax(P0,P1); resc=false; \
    { const float dl=__builtin_fmaxf(rm,0.f); mhat=fadd_s(mhat,dl); \
      _Pragma("unroll") for(int r=0;r<16;++r){P0[r]=fsub_s(P0[r],dl);P1[r]=fsub_s(P1[r],dl);} } \
    _Pragma("unroll") for(int r=0;r<16;++r)P0[r]=__builtin_amdgcn_exp2f(P0[r]); }while(0)
  #define RESC() do{ if(resc){ asm volatile("s_waitcnt lgkmcnt(0)":::"memory"); \
      _Pragma("unroll") for(int d_=0;d_<2;++d_) _Pragma("unroll") for(int r=0;r<16;++r)o[d_][r]*=wsf[crow(r,hi)]; } }while(0)
  f32x16 pA0,pA1,pB0,pB1;
  int sl_prev=0,sl_cur=0,sl_next=SLOTB;
  #define ROT() do{sl_prev=sl_cur;sl_cur=sl_next;sl_next=(sl_next==(NSLOT-1)*SLOTB)?0:sl_next+SLOTB;}while(0)
  DMA_K(2,2*SLOTB);
  WAIT_BAR(3);
  INITT(pA0,pA1,0); qkt(pA0,pA1,Kbase,qr,r32,hi);asm volatile("s_nop 15\n\ts_nop 7":"+v"(pA0),"+v"(pA1));CMASK(pA0,pA1,0);
  START(pA0,pA1);
  _Pragma("unroll") for(int r=0;r<16;++r)pA1[r]=__builtin_amdgcn_exp2f(pA1[r]);
  INITT(pB0,pB1,1);
  WAIT_BAR(0);
  DMA_K(3,0);DMA_V(1,SLOTB);
  ROT();
  kload8(kf,kp0+sl_cur);
  WAIT_BAR(2);
  s16x4 vlo[8],vhi[8]; u32x4 pw0,pw1,pw2,pw3;
  #define PKW(P,B) cvtpk_s(P[B],P[B+1])
  #define PAF(k) __builtin_bit_cast(bf16x8,pw##k)
  #define VFR(i) (bf16x8){vlo[i][0],vlo[i][1],vlo[i][2],vlo[i][3],vhi[i][0],vhi[i][1],vhi[i][2],vhi[i][3]}
  #define PIN(x) asm volatile("":"+v"(x))
  #define MX3(a,b,c) __builtin_fmaxf(__builtin_fmaxf((a),(b)),(c))
  #define GAPA(MF,A0,A1,A2,A3,W0,W1,PW) do{ MF; sacc+=A0; sacc+=A1; sacc+=A2; sacc+=A3; PIN(sacc); W0; W1; PIN(PW); SBAR(); }while(0)
  #define EX(v) __builtin_amdgcn_exp2f(v)
  #define GAPB(MF,X,B,GN,Y,tn,o) do{ MF; X[B]=EX(X[B]); X[B+1]=EX(X[B+1]); X[B+2]=EX(X[B+2]); X[B+3]=EX(X[B+3]); PIN(X); if(GN){ INIT4(Y,(B)/4,tn,o); PIN(Y); } SBAR(); }while(0)
  #define VRD(i) do{ vlo[i]=vtr(vp_+(((i)>>2)*4096+((i)&3)*1024)); vhi[i]=vtr(vp_+(((i)>>2)*4096+((i)&3)*1024+512)); }while(0)
  #define KRD(G,j) do{ if(G){ kload2(kf,kp0+sl_next,j); SBAR(); } }while(0)
  #define STEP(C0,C1,P0,P1,t,GK,GV,GL) do{ SBAR(); \
    const lds_cptr vp_=vp0+sl_prev; \
    VRD(0); SBAR(); float sacc=(P0[0]+P0[1]); \
    GAPA(C0=__builtin_amdgcn_mfma_f32_32x32x16_bf16(kf[0],qr[0],C0,0,0,0), P0[2],P0[3],P0[4],P0[5],     pw0[0]=PKW(P0,0), pw0[1]=PKW(P0,2), pw0); \
    VRD(4); SBAR(); GAPA(C1=__builtin_amdgcn_mfma_f32_32x32x16_bf16(kf[1],qr[0],C1,0,0,0), P0[6],P0[7],P0[8],P0[9],     pw0[2]=PKW(P0,4), pw0[3]=PKW(P0,6), pw0); \
    VRD(1); SBAR(); GAPA(C0=__builtin_amdgcn_mfma_f32_32x32x16_bf16(kf[2],qr[1],C0,0,0,0),   P0[10],P0[11],P0[12],P0[13], pw1[0]=PKW(P0,8), pw1[1]=PKW(P0,10), pw1); \
    VRD(5); SBAR(); GAPA(C1=__builtin_amdgcn_mfma_f32_32x32x16_bf16(kf[3],qr[1],C1,0,0,0),   P0[14],P0[15],P1[0],P1[1],   pw1[2]=PKW(P0,12),pw1[3]=PKW(P0,14), pw1); \
    VRD(2); SBAR(); GAPA(C0=__builtin_amdgcn_mfma_f32_32x32x16_bf16(kf[4],qr[2],C0,0,0,0),   P1[2],P1[3],P1[4],P1[5],     pw2[0]=PKW(P1,0), pw2[1]=PKW(P1,2), pw2); \
    VRD(6); SBAR(); GAPA(C1=__builtin_amdgcn_mfma_f32_32x32x16_bf16(kf[5],qr[2],C1,0,0,0),   P1[6],P1[7],P1[8],P1[9],     pw2[2]=PKW(P1,4), pw2[3]=PKW(P1,6), pw2); \
    VRD(3); SBAR(); GAPA(C0=__builtin_amdgcn_mfma_f32_32x32x16_bf16(kf[6],qr[3],C0,0,0,0),   P1[10],P1[11],P1[12],P1[13], pw3[0]=PKW(P1,8), pw3[1]=PKW(P1,10), pw3); \
    VRD(7); SBAR(); GAPA(C1=__builtin_amdgcn_mfma_f32_32x32x16_bf16(kf[7],qr[3],C1,0,0,0),   P1[14],P1[15],0.f,0.f,       pw3[2]=PKW(P1,12),pw3[3]=PKW(P1,14), pw3); \
    l_reg+=sacc; \
    if(GK){DMA_K((t)+3,sl_cur);} if(GV){DMA_V((t)+1,sl_next);} \
    CMASK(C0,C1,t); \
    { float a=MX3(C0[0],C0[1],C1[0]),b=MX3(C0[2],C0[3],C1[1]); a=MX3(a,C1[2],C1[3]); \
      _Pragma("unroll") for(int r=4;r<16;r+=4){a=MX3(a,C0[r],C0[r+1]);b=MX3(b,C0[r+2],C0[r+3]);a=MX3(a,C1[r],C1[r+1]);b=MX3(b,C1[r+2],C1[r+3]);} \
      float rm=__builtin_fmaxf(a,b); { auto rr=__builtin_amdgcn_permlane32_swap(__float_as_uint(rm),__float_as_uint(rm),false,false); rm=__builtin_fmaxf(__uint_as_float(rr[0]),__uint_as_float(rr[1])); } \
      resc=false; \
      if(__builtin_expect(__any(rm>(float)THRL),0)){ const float dl=__builtin_fmaxf(rm,0.f); mhat+=dl; \
        _Pragma("unroll") for(int r=0;r<16;++r){C0[r]-=dl;C1[r]-=dl;} \
        const float f=__builtin_amdgcn_exp2f(-dl); l_reg*=f; if(hi==0)wsf[r32]=f; resc=true; } } \
    SBAR(); \
    GAPB(o[0]=__builtin_amdgcn_mfma_f32_32x32x16_bf16(PAF(0),VFR(0),o[0],0,0,0), C0,0,  GL,P0,(t)+1,0); \
    GAPB(o[1]=__builtin_amdgcn_mfma_f32_32x32x16_bf16(PAF(0),VFR(4),o[1],0,0,0), C0,4,  GL,P0,(t)+1,0); \
    KRD(GL,0); GAPB(o[0]=__builtin_amdgcn_mfma_f32_32x32x16_bf16(PAF(1),VFR(1),o[0],0,0,0), C0,8,  GL,P0,(t)+1,0); \
    KRD(GL,1); GAPB(o[1]=__builtin_amdgcn_mfma_f32_32x32x16_bf16(PAF(1),VFR(5),o[1],0,0,0), C0,12, GL,P0,(t)+1,0); \
    KRD(GL,2); GAPB(o[0]=__builtin_amdgcn_mfma_f32_32x32x16_bf16(PAF(2),VFR(2),o[0],0,0,0), C1,0,  GL,P1,(t)+1,32); \
    KRD(GL,3); GAPB(o[1]=__builtin_amdgcn_mfma_f32_32x32x16_bf16(PAF(2),VFR(6),o[1],0,0,0), C1,4,  GL,P1,(t)+1,32); \
    GAPB(o[0]=__builtin_amdgcn_mfma_f32_32x32x16_bf16(PAF(3),VFR(3),o[0],0,0,0), C1,8,  GL,P1,(t)+1,32); \
    GAPB(o[1]=__builtin_amdgcn_mfma_f32_32x32x16_bf16(PAF(3),VFR(7),o[1],0,0,0), C1,12, GL,P1,(t)+1,32); \
    }while(0)
  int t=1;
  #undef CMASK
  #define CMASK(P0,P1,t) do{}while(0)
  for(;t+5<NT;t+=2){
    STEP(pB0,pB1,pA0,pA1,t,true,true,true);     WAIT_BAR(2); RESC(); ROT();
    STEP(pA0,pA1,pB0,pB1,t+1,true,true,true);   WAIT_BAR(2); RESC(); ROT();
  }
  #undef CMASK
  #define CMASK(P0,P1,t) do{int jb_=(t)-(NT-4); if(jb_>=0)cmask(P0,P1,jb_,qrel,hi);}while(0)
  #define ENDW(tt) do{ if((tt)+3<NT){WAIT_BAR(2);} else if((tt)+2<NT){WAIT_BAR(1);} else {WAIT_BAR(0);} }while(0)
  for(;t+1<NT;t+=2){
    STEP(pB0,pB1,pA0,pA1,t,(t+3<NT),(t+1<NT),(t+1<NT));       ENDW(t);   RESC(); ROT();
    STEP(pA0,pA1,pB0,pB1,t+1,(t+4<NT),(t+2<NT),(t+2<NT));     ENDW(t+1); RESC(); ROT();
  }
  STEP(pB0,pB1,pA0,pA1,NT-1,false,false,false); RESC();
  { float sacc=pB0[0]+pB0[1]; _Pragma("unroll") for(int r=2;r<16;++r)sacc+=pB0[r]; _Pragma("unroll") for(int r=0;r<16;++r)sacc+=pB1[r]; l_reg+=sacc;
    pw0=(u32x4){PKW(pB0,0),PKW(pB0,2),PKW(pB0,4),PKW(pB0,6)};pw1=(u32x4){PKW(pB0,8),PKW(pB0,10),PKW(pB0,12),PKW(pB0,14)};pw2=(u32x4){PKW(pB1,0),PKW(pB1,2),PKW(pB1,4),PKW(pB1,6)};pw3=(u32x4){PKW(pB1,8),PKW(pB1,10),PKW(pB1,12),PKW(pB1,14)};
    SBAR(); pv(o,vb0+sl_cur,PAF(0),PAF(1),PAF(2),PAF(3)); }
  #undef PKW
  #undef PAF
  #undef VFR
  #undef PIN
  #undef MX3
  #undef GAPA
  #undef GAPB
  #undef EX
  #undef VRD
  #undef KRD
  #undef STEP
  #undef ENDW
  {auto rr=__builtin_amdgcn_permlane32_swap(__float_as_uint(l_reg),__float_as_uint(l_reg),false,false);l_reg=__uint_as_float(rr[0])+__uint_as_float(rr[1]);}
  if(hi==0)wsf[32+r32]=l_reg;asm volatile("s_waitcnt lgkmcnt(0)":::"memory");
  float rli[16];
  #pragma unroll
  for(int r=0;r<16;++r)rli[r]=__builtin_amdgcn_rcpf(wsf[32+crow(r,hi)]);
  bf16*Ow=O+(rowbase+q0+wid*QBLK)*OPITCH+h*D; float*Sw=SSQ+(rowbase+q0+wid*QBLK)*NHEAD+h;
  { bf16*stg=(bf16*)(shm+LDS_OST)+wid*2048;
    #pragma unroll
    for(int r=0;r<16;++r){const int orow=crow(r,hi);
      #pragma unroll
      for(int d0=0;d0<2;++d0)stg[orow*64+d0*32+r32]=__float2bfloat16(o[d0][r]*rli[r]);}
    asm volatile("s_waitcnt lgkmcnt(0)":::"memory");
    #pragma unroll
    for(int i=0;i<4;++i){const int row=i*8+(lane>>3),ch=lane&7; const u32x4 v=*(const u32x4*)(stg+row*64+ch*8); ATTN_STORE16(Ow+(long)row*OPITCH+ch*8,v);
      float sq=0.f;
      #pragma unroll
      for(int j=0;j<4;++j){ const float lo_=__uint_as_float(v[j]<<16), hi_=__uint_as_float(v[j]&0xffff0000u); sq+=lo_*lo_+hi_*hi_; }
      sq+=__shfl_xor(sq,1); sq+=__shfl_xor(sq,2); sq+=__shfl_xor(sq,4);
      if(ch==0)Sw[(long)row*NHEAD]=sq; } }
  asm volatile("s_waitcnt lgkmcnt(0)\n\ts_barrier":::"memory");
  #undef DMA_K
  #undef BIAS4
  #undef INIT4
  #undef INITT
  #undef DMA_V
  #undef CMASK
  #undef START
  #undef RESC
  #undef ROT
}
constexpr int ATTN_LDS_BYTES=LDS_BYTES;
struct AttnTensors { const bf16* Q; const bf16* K; const bf16* V; bf16* O; const float* LOGF2; float* SSQ; };
struct AttnUnit { int bh; int qb; };
struct StaticOrder {
  int vcu,G;
  __device__ __forceinline__ explicit StaticOrder(int grid,int vcu_):vcu(vcu_),G(grid){}
  __device__ __forceinline__ bool next(int i,AttnUnit&u)const{ const int L=(i>>1)*G+vcu; if(L>=BATCH*NHEAD*4)return false; const int s=L&3; u.bh=L>>2; u.qb=(i&1)?7-s:s; return true; }
  __device__ __forceinline__ void a_ready(const AttnUnit&)const{}
  __device__ __forceinline__ void done(const AttnUnit&)const{}
};
template<class Sched,int THRL=8> __device__ __forceinline__ void attn_phase(char*lds,const AttnTensors&T,const Sched&S){
  AttnUnit u;
  for(int i=0;S.next(i,u);++i){ S.a_ready(u); attn_unit<THRL>(u.bh/NHEAD,u.bh%NHEAD,u.qb,T.Q,T.K,T.V,T.O,T.LOGF2,T.SSQ,lds); S.done(u); }
}
#undef SBAR
#undef WAIT_BAR
}

constexpr int NWAVES = 8;
constexpr int NPHASES = 11;

constexpr size_t MiB = 1u << 20, KiB = 1u << 10;
constexpr size_t WS_CTL = 0, CTL_ZERO_BYTES = 1 * MiB;
constexpr size_t WS_MOD = 1 * MiB;
constexpr size_t WS_LOGF2 = 1 * MiB + 256 * KiB;
constexpr size_t WS_SSQ = 1 * MiB + 768 * KiB;
constexpr size_t WS_TOPI = 2 * MiB + 256 * KiB;
constexpr size_t WS_TOPW = 2 * MiB + 512 * KiB;
constexpr size_t WS_WGCNT = 2 * MiB + 768 * KiB;
constexpr size_t WS_LSUM = 3 * MiB;
constexpr size_t WS_ROWTOK = 4 * MiB, WS_ROWPAIR = 4 * MiB + 512 * KiB, WS_ROWW = 5 * MiB, WS_MTEXP = 5 * MiB + 512 * KiB;
constexpr size_t WS_LWT = 6 * MiB;
constexpr size_t WS_WFT = 6 * MiB + 512 * KiB;
constexpr size_t WS_WRT = 7 * MiB;
constexpr size_t WS_WIN = 8 * MiB;
constexpr size_t WS_WOUT = 13 * MiB;
constexpr size_t WS_WUP = 16 * MiB;
constexpr size_t WS_WDN = 144 * MiB;
constexpr size_t WS_H1 = 208 * MiB;
constexpr size_t WS_PJ = 240 * MiB;
constexpr size_t PJ_STRIDE = (size_t)NTOK * 512;
constexpr size_t WS_MRG = 320 * MiB;
constexpr size_t WS_Y = 352 * MiB;
constexpr size_t WS_H2 = 416 * MiB;
constexpr size_t WS_ACT = 448 * MiB;
constexpr size_t WS_YP = 592 * MiB;
constexpr size_t WS_LTOK = 720 * MiB, WS_LPAIR = 722 * MiB, WS_LW = 724 * MiB;
constexpr size_t WS_END = 726 * MiB;
static_assert(WS_ACT + (size_t)MAXROWS * 1024 * 2 <= WS_YP && WS_YP + (size_t)NTOK * 4 * 1024 * 2 <= WS_END, "d_ws map");
constexpr int CW_CNT = 200000;
constexpr int CW_BAR = 4096;

constexpr int LDS_BYTES = 147456;
constexpr int LDSCTL_OFF = LDS_BYTES - 512, MISC_OFF = LDSCTL_OFF + 320;
constexpr int SCRATCH_BYTES = LDSCTL_OFF;

#define GAS __attribute__((address_space(1)))
#define LAS __attribute__((address_space(3)))
typedef unsigned short bf16;
typedef unsigned v4u __attribute__((ext_vector_type(4)));
typedef unsigned v2u __attribute__((ext_vector_type(2)));
typedef float f32x4 __attribute__((ext_vector_type(4)));
typedef float f32x16 __attribute__((ext_vector_type(16)));
typedef short bf16x8 __attribute__((ext_vector_type(8)));
typedef GAS unsigned gu32;
#define RLX_AGENT __ATOMIC_RELAXED, __HIP_MEMORY_SCOPE_AGENT
#define LDS_WAIT() asm volatile("s_waitcnt lgkmcnt(0)" ::: "memory")
#define VM_WAIT() asm volatile("s_waitcnt vmcnt(0)" ::: "memory")
__device__ __forceinline__ unsigned f2bf(float f) { unsigned u = __builtin_bit_cast(unsigned, f); return (u + 0x7fffu + ((u >> 16) & 1u)) >> 16; }
__device__ __forceinline__ unsigned pk2(float lo, float hi) { return f2bf(lo) | (f2bf(hi) << 16); }
__device__ __forceinline__ float bflo(unsigned w) { return __uint_as_float(w << 16); }
__device__ __forceinline__ float bfhi(unsigned w) { return __uint_as_float(w & 0xffff0000u); }
__device__ __forceinline__ float bf1(bf16 h) { return __uint_as_float((unsigned)h << 16); }

#define XB_TMO      128
#define XB_XCNT(j)  (256  + 64 * (j))
#define XB_XSUB(j)  (1280 + 64 * (j))
#define XB_XGEN(j)  (2304 + 64 * (j))
#define XB_TOP      3328
#define XB_TOPGEN   3392
#define XCD_BAR_WORDS 3456
#define XB_SPIN_CAP (1u << 18)
__device__ __forceinline__ unsigned xb_ld(unsigned* p)              { return __hip_atomic_load(p, __ATOMIC_RELAXED, __HIP_MEMORY_SCOPE_AGENT); }
__device__ __forceinline__ unsigned xb_add(unsigned* p, unsigned v) { return __hip_atomic_fetch_add(p, v, __ATOMIC_RELAXED, __HIP_MEMORY_SCOPE_AGENT); }
__device__ __forceinline__ unsigned xb_xcc_id() { return (unsigned)__builtin_amdgcn_s_getreg((3 << 11) | 20) & 0xFu; }
#define XB_SPIN(cond, bar) do { unsigned _sp = 0; while (cond) { __builtin_amdgcn_s_sleep(1); \
    if ((++_sp & 255u) == 0u) { if (xb_ld(&(bar)[XB_TMO])) break; if (_sp > XB_SPIN_CAP) { atomicAdd(&(bar)[XB_TMO], 1u); break; } } } } while (0)
struct XcdBarrier { unsigned* bar; unsigned x; volatile LAS unsigned* st; };
__device__ __forceinline__ XcdBarrier xcd_barrier_post(unsigned* bar, volatile LAS unsigned* st) {
    XcdBarrier b; b.bar = bar; b.x = xb_xcc_id(); b.st = st;
    if (threadIdx.x == 0) (void)xb_add(&bar[XB_XCNT(b.x)], 1u);
    return b;
}
__device__ __forceinline__ void xcd_barrier_complete(unsigned* bar, unsigned x, unsigned& nloc, unsigned& nx) {
    const unsigned G = gridDim.x * gridDim.y * gridDim.z;
    unsigned sum, cnt, mine, sp = 0u;
    for (;;) {
        sum = 0u; cnt = 0u; mine = 0u;
#pragma unroll
        for (unsigned j = 0; j < 16; ++j) { const unsigned c = xb_ld(&bar[XB_XCNT(j)]); sum += c; cnt += (c > 0u) ? 1u : 0u; mine = (j == x) ? c : mine; }
        if (sum == G) break;
        __builtin_amdgcn_s_sleep(1);
        if ((++sp & 255u) == 0u) { if (xb_ld(&bar[XB_TMO])) break; if (sp > XB_SPIN_CAP) { atomicAdd(&bar[XB_TMO], 1u); break; } }
    }
    nloc = mine > 0u ? mine : 1u; nx = cnt > 0u ? cnt : 1u;
}
__device__ __forceinline__ void xcd_barrier(const XcdBarrier& b) {
    asm volatile("s_waitcnt vmcnt(0)" ::: "memory");
    __syncthreads();
    if (threadIdx.x == 0) {
        unsigned* bar = b.bar;
        __builtin_amdgcn_s_waitcnt(0);
        unsigned nloc = b.st[0], nx = b.st[1];
        if (nloc == 0u) { xcd_barrier_complete(bar, b.x, nloc, nx); b.st[0] = nloc; b.st[1] = nx; }
        const unsigned old = xb_add(&bar[XB_XSUB(b.x)], 1u);
        const unsigned gen = old / nloc;
        if (old + 1u == (gen + 1u) * nloc) {
            __builtin_amdgcn_fence(__ATOMIC_RELEASE, "agent");
            asm volatile("s_waitcnt vmcnt(0)" ::: "memory");
            const unsigned og = xb_add(&bar[XB_TOP], 1u);
            const unsigned tg = og / nx;
            if (og + 1u == (tg + 1u) * nx) xb_add(&bar[XB_TOPGEN], 1u);
            else XB_SPIN(xb_ld(&bar[XB_TOPGEN]) == tg, bar);
            __builtin_amdgcn_fence(__ATOMIC_ACQUIRE, "agent");
            xb_add(&bar[XB_XGEN(b.x)], 1u);
            asm volatile("s_waitcnt vmcnt(0)" ::: "memory");
        } else {
            XB_SPIN(xb_ld(&bar[XB_XGEN(b.x)]) == gen, bar);
            __builtin_amdgcn_fence(__ATOMIC_ACQUIRE, "agent");
            asm volatile("s_waitcnt vmcnt(0)" ::: "memory");
        }
    }
    __syncthreads();
}

struct Args { const float* in[26]; float* out; unsigned char* ws; int ph_lo, ph_hi, li, pad; };
struct Frame {
    LAS unsigned char* lds;
    int tid, lane, wave, vcu, G;
    float* out; unsigned char* ws;
    __device__ __forceinline__ const float* in(int k) const { const LAS unsigned* t = (const LAS unsigned*)(lds + LDSCTL_OFF) + 2 * k;
        const unsigned lo = (unsigned)__builtin_amdgcn_readfirstlane((int)t[0]), hi = (unsigned)__builtin_amdgcn_readfirstlane((int)t[1]);
        return (const float*)(const GAS float*)(((unsigned long long)hi << 32) | lo); }
};
template <int CTRL> __device__ __forceinline__ float dpp_mov(float x) { return __builtin_bit_cast(float, __builtin_amdgcn_update_dpp(0, __builtin_bit_cast(int, x), CTRL, 0xF, 0xF, false)); }
__device__ __forceinline__ float lane_xor1(float x) { return dpp_mov<0xB1>(x); }
__device__ __forceinline__ float lane_xor2(float x) { return dpp_mov<0x4E>(x); }
__device__ __forceinline__ float lane_xor4(float x) { return dpp_mov<0x1B>(dpp_mov<0x141>(x)); }
__device__ __forceinline__ float lane_xor8(float x) { return dpp_mov<0x128>(x); }
__device__ __forceinline__ void swap_rows16(float& a, float& b) { asm volatile("s_nop 1\n\tv_permlane16_swap_b32 %0, %1" : "+v"(a), "+v"(b)); }
__device__ __forceinline__ void swap_half32(float& a, float& b) { asm volatile("s_nop 1\n\tv_permlane32_swap_b32 %0, %1" : "+v"(a), "+v"(b)); }
__device__ __forceinline__ float wave_sum(float v) {
    v += lane_xor1(v); v += lane_xor2(v); v += lane_xor4(v); v += lane_xor8(v);
    { float a = v, b = v; swap_rows16(a, b); v = a + b; }
    { float a = v, b = v; swap_half32(a, b); v = a + b; }
    return v;
}
__device__ __forceinline__ float wave_max(float v) {
    v = fmaxf(v, lane_xor1(v)); v = fmaxf(v, lane_xor2(v)); v = fmaxf(v, lane_xor4(v)); v = fmaxf(v, lane_xor8(v));
    { float a = v, b = v; swap_rows16(a, b); v = fmaxf(a, b); }
    { float a = v, b = v; swap_half32(a, b); v = fmaxf(a, b); }
    return v;
}
__device__ __forceinline__ float sigmoid_f(float x) { return __builtin_amdgcn_rcpf(1.0f + __builtin_amdgcn_exp2f(-1.4426950408889634f * x)); }
__device__ __forceinline__ float gelu_tanh_f(float x) { const float u = 0.7978845608028654f * (x + 0.044715f * x * x * x); const float e = __builtin_amdgcn_exp2f(2.8853900817779268f * u); return x * (1.0f - __builtin_amdgcn_rcpf(e + 1.0f)); }
__device__ __forceinline__ float log_sigmoid_f(float z) { return z >= 0.f ? -log1pf(expf(-z)) : z - log1pf(expf(z)); }
__device__ __forceinline__ float softplus_f(float z) { return z > 0.f ? z + log1pf(expf(-z)) : log1pf(expf(z)); }

__device__ __forceinline__ void p0_transpose_item(const float* W, int ldw, bf16* WT, int k0, int n0, int kdst0, const float* gain, LAS float* scr, int lane) {
#pragma unroll 8
    for (int i = 0; i < 32; ++i) { const int kk = 2 * i + (lane >> 5); float v = W[(size_t)(k0 + kk) * ldw + n0 + (lane & 31)]; if (gain) v *= gain[k0 + kk]; scr[kk * 33 + (lane & 31)] = v; }
    LDS_WAIT(); asm volatile("" ::: "memory");
    const int c = lane & 7;
#pragma unroll
    for (int j = 0; j < 4; ++j) { const int n = (lane >> 3) + 8 * j; const LAS float* s = scr + (8 * c) * 33 + n;
        v4u o; o.x = pk2(s[0 * 33], s[1 * 33]); o.y = pk2(s[2 * 33], s[3 * 33]); o.z = pk2(s[4 * 33], s[5 * 33]); o.w = pk2(s[6 * 33], s[7 * 33]);
        *(GAS v4u*)(WT + (size_t)(n0 + n) * 1024 + kdst0 + 8 * c) = o; }
    LDS_WAIT(); asm volatile("" ::: "memory");
}
constexpr int CV_UP_ITEMS = NE * 16 * 32, CV_DN_ITEMS = NE * 16 * 16;
constexpr int CV_UP_TAIL = 8192, CV_DN_TAIL = 4096;
__device__ __forceinline__ void cvt_block_f8(const float* W, int ldw, unsigned char* WT, LAS unsigned char* scr, int lane) {
    float v[64];
#pragma unroll
    for (int i = 0; i < 64; ++i) v[i] = W[(size_t)i * ldw + lane];
#pragma unroll
    for (int q = 0; q < 4; ++q) { int w[4];
#pragma unroll
        for (int j = 0; j < 4; ++j) { int t = 0; t = __builtin_amdgcn_cvt_pk_fp8_f32(v[16 * q + 4 * j] * 64.0f, v[16 * q + 4 * j + 1] * 64.0f, t, false); t = __builtin_amdgcn_cvt_pk_fp8_f32(v[16 * q + 4 * j + 2] * 64.0f, v[16 * q + 4 * j + 3] * 64.0f, t, true); w[j] = t; }
        *(LAS v4u*)(scr + lane * 80 + 16 * q) = (v4u){(unsigned)w[0], (unsigned)w[1], (unsigned)w[2], (unsigned)w[3]}; }
    LDS_WAIT(); asm volatile("" ::: "memory");
#pragma unroll
    for (int j = 0; j < 4; ++j) { const int row = 16 * j + (lane >> 2), c = lane & 3;
        *(GAS v4u*)(WT + (size_t)row * 1024 + 16 * c) = *(const LAS v4u*)(scr + row * 80 + 16 * c); }
    LDS_WAIT(); asm volatile("" ::: "memory");
}
__device__ __forceinline__ void cvt_up_item(Frame& F, int u) { const int e = u >> 9, q = u & 511, kb = q >> 5, nb = q & 31;
    cvt_block_f8(F.in(22) + (size_t)e * DM * 2 * DEXP + (size_t)(64 * kb) * (2 * DEXP) + 64 * nb, 2 * DEXP, (unsigned char*)(F.ws + WS_WUP) + ((size_t)e * 2 * DEXP + 64 * nb) * 1024 + 64 * kb, F.lds + F.wave * 16384, F.lane); }
__device__ __forceinline__ void cvt_dn_item(Frame& F, int d) { const int e = d >> 8, q = d & 255, kb = q >> 4, nb = q & 15;
    cvt_block_f8(F.in(24) + (size_t)e * DEXP * DM + (size_t)(64 * kb) * DM + 64 * nb, DM, (unsigned char*)(F.ws + WS_WDN) + ((size_t)e * DM + 64 * nb) * 1024 + 64 * kb, F.lds + F.wave * 16384, F.lane); }
template <bool UP> __device__ __forceinline__ void cvt_range(Frame& F, int lo, int hi, int wr_, int nw) {
    for (int it = lo + wr_; it < hi; it += nw) { if (UP) cvt_up_item(F, it); else cvt_dn_item(F, it); }
}
__device__ __forceinline__ void p0_transpose_item_f8(const float* W, int ldw, unsigned char* WT, int k0, int n0, float scale, LAS float* scr, int lane) {
#pragma unroll 8
    for (int i = 0; i < 32; ++i) { const int kk = 2 * i + (lane >> 5); scr[kk * 33 + (lane & 31)] = W[(size_t)(k0 + kk) * ldw + n0 + (lane & 31)] * scale; }
    LDS_WAIT(); asm volatile("" ::: "memory");
    const int c = lane & 7;
#pragma unroll
    for (int j = 0; j < 4; ++j) { const int n = (lane >> 3) + 8 * j; const LAS float* s = scr + (8 * c) * 33 + n;
        int w0 = 0, w1 = 0; w0 = __builtin_amdgcn_cvt_pk_fp8_f32(s[0 * 33], s[1 * 33], w0, false); w0 = __builtin_amdgcn_cvt_pk_fp8_f32(s[2 * 33], s[3 * 33], w0, true);
        w1 = __builtin_amdgcn_cvt_pk_fp8_f32(s[4 * 33], s[5 * 33], w1, false); w1 = __builtin_amdgcn_cvt_pk_fp8_f32(s[6 * 33], s[7 * 33], w1, true);
        typedef int i32x2_ __attribute__((ext_vector_type(2))); *(GAS i32x2_*)(WT + (size_t)(n0 + n) * 1024 + k0 + 8 * c) = (i32x2_){w0, w1}; }
    LDS_WAIT(); asm volatile("" ::: "memory");
}
template <int PARTS = 7> __device__ __forceinline__ void p0_phase(Frame& F) {
    const float* c_in = F.in(1); const float* w_ada = F.in(2); const float* b_ada = F.in(3);
    float* MOD = (float*)(F.ws + WS_MOD);
    if ((PARTS & 1) && F.vcu < 192) {
        LAS float* sc = (LAS float*)F.lds;
        LAS float* red = (LAS float*)(F.lds + 32768);
        for (int i = F.tid; i < BATCH * DM; i += NWAVES * 64) { const int b = i >> 10, k = i & 1023; const float v = c_in[i]; sc[k * 8 + b] = v * sigmoid_f(v); }
        __syncthreads();
        for (int ci = F.vcu; ci < 192; ci += F.G) {
            const int col = F.lane & 31, ks = F.lane >> 5;
            float acc[8];
#pragma unroll
            for (int b = 0; b < 8; ++b) acc[b] = 0.f;
            const float* wp = w_ada + (size_t)(128 * F.wave + ks) * (NMOD * DM) + ci * 32 + col;
#pragma unroll 1
            for (int i0 = 0; i0 < 64; i0 += 32) {
                float wv[32];
#pragma unroll
                for (int i = 0; i < 32; ++i) wv[i] = wp[(size_t)(2 * (i0 + i)) * (NMOD * DM)];
#pragma unroll
                for (int i = 0; i < 32; ++i) { const LAS f32x4* sp = (const LAS f32x4*)(sc + (128 * F.wave + 2 * (i0 + i) + ks) * 8); const f32x4 s0 = sp[0], s1 = sp[1];
                    acc[0] += s0[0] * wv[i]; acc[1] += s0[1] * wv[i]; acc[2] += s0[2] * wv[i]; acc[3] += s0[3] * wv[i]; acc[4] += s1[0] * wv[i]; acc[5] += s1[1] * wv[i]; acc[6] += s1[2] * wv[i]; acc[7] += s1[3] * wv[i]; }
            }
#pragma unroll
            for (int b = 0; b < 8; ++b) { acc[b] += __shfl_xor(acc[b], 32); if (ks == 0) red[(F.wave * 8 + b) * 32 + col] = acc[b]; }
            __syncthreads();
            if (F.tid < 256) { const int b = F.tid >> 5, cl = F.tid & 31; float s = 0.f;
#pragma unroll
              for (int w = 0; w < 8; ++w) s += red[(w * 8 + b) * 32 + cl];
              MOD[b * NMOD * DM + ci * 32 + cl] = s + b_ada[ci * 32 + cl]; }
            __syncthreads();
        }
    }
    __syncthreads();
    const float* w_in = F.in(6); const float* w_out = F.in(17); const float* gn_attn = F.in(16);
    bf16* WIN = (bf16*)(F.ws + WS_WIN); bf16* WOUT = (bf16*)(F.ws + WS_WOUT);
    LAS float* scr = (LAS float*)(F.lds + F.wave * 16384);
    const int gw = F.vcu * NWAVES + F.wave, NGW = F.G * NWAVES;
    constexpr int I_IN = 16 * (NPJ / 32), I_OUT = 16 * (DM / 32);
    constexpr int NITEMS = I_IN + I_OUT;
    if (PARTS & 2) for (int it = gw; it < NITEMS; it += NGW) {
        int r = it;
        if (r < I_IN) { const int kb = r / (NPJ / 32), nb = r % (NPJ / 32); p0_transpose_item(w_in, NPROJ, WIN, 64 * kb, 32 * nb, 64 * kb, nullptr, scr, F.lane); continue; } r -= I_IN;
        { const int kb = r / (DM / 32), nb = r % (DM / 32); const int k0 = 64 * kb;
            p0_transpose_item(w_out, DM, WOUT, k0, 32 * nb, (k0 + 512) & 1023, k0 >= 512 ? gn_attn - 512 : nullptr, scr, F.lane); }
    }
    if (PARTS & 4) {
        if (F.G == 256) {
            constexpr int NU = CV_UP_ITEMS - CV_UP_TAIL, NV = NU + (CV_DN_ITEMS - CV_DN_TAIL);
            auto run = [&](int v) { if (v < NU) cvt_up_item(F, CV_UP_TAIL + v); else cvt_dn_item(F, CV_DN_TAIL + (v - NU)); };
            constexpr int A_END = 2048 * 5;
            for (int v = gw; v < A_END && v < NV; v += NGW) run(v);
            if (F.vcu >= 192) { const int r = (F.vcu - 192) * NWAVES + F.wave; for (int v = A_END + r; v < A_END + 1536 && v < NV; v += 512) run(v); }
            else { const int r = F.vcu * NWAVES + F.wave; if (r < 512) { const int v = A_END + 1536 + r; if (v < NV) run(v); } }
            static_assert(A_END + 1536 + 512 >= NV, "phase-0 conversion shares cover the list");
        } else { cvt_range<true>(F, 0, CV_UP_ITEMS, gw, NGW); cvt_range<false>(F, 0, CV_DN_ITEMS, gw, NGW); }
    }
    if (PARTS & 2) { const float* w_in2 = F.in(6); float* WFT = (float*)(F.ws + WS_WFT);
      for (int idx = F.vcu * (NWAVES * 64) + F.tid; idx < 8 * DM; idx += F.G * NWAVES * 64) { const int h = idx >> 10, k = idx & 1023; WFT[idx] = w_in2[(size_t)k * NPROJ + NPJ + h]; } }
    { const float* w_router = F.in(20); float* WRT = (float*)(F.ws + WS_WRT);
      for (int idx = F.vcu * (NWAVES * 64) + F.tid; idx < NE * DM; idx += F.G * NWAVES * 64) { const int e = idx >> 10, k = idx & 1023; WRT[idx] = w_router[k * NE + e]; } }
    { const float* wa = F.in(9); const float* wx = F.in(11); bf16* LWT = (bf16*)(F.ws + WS_LWT);
      for (int idx = F.vcu * (NWAVES * 64) + F.tid; idx < 2 * 8 * 64 * 64; idx += F.G * NWAVES * 64) { const int gate = idx >> 15, g = (idx >> 12) & 7, j = (idx >> 6) & 63, i = idx & 63;
          LWT[idx] = (bf16)f2bf((gate ? wx : wa)[(g * 64 + i) * 64 + j]); } }
}

__device__ __forceinline__ void p1_phase(Frame& F) {
    const float* x = F.in(0); const float* gpre = F.in(4); const float* fb = F.in(14);
    const float* MOD = (const float*)(F.ws + WS_MOD); bf16* H1 = (bf16*)(F.ws + WS_H1); float* LOGF2 = (float*)(F.ws + WS_LOGF2);
    LAS float* wf = (LAS float*)F.lds;
    { const float* WFT = (const float*)(F.ws + WS_WFT);
#pragma unroll
      for (int i = F.tid; i < 8 * DM / 4; i += NWAVES * 64) *(LAS f32x4*)(wf + 4 * i) = *(const f32x4*)(WFT + 4 * i); }
    __syncthreads();
    const int gw = F.vcu * NWAVES + F.wave;
    if (F.G * NWAVES * 8 != NTOK) return;
    const int row0 = gw * 8, b = row0 / SEQ;
    f32x4 gm[4], sh[4];
#pragma unroll
    for (int j = 0; j < 4; ++j) { const int k = 4 * F.lane + 256 * j; const f32x4 g = *(const f32x4*)(gpre + k), s = *(const f32x4*)(MOD + b * NMOD * DM + DM + k); gm[j] = g * (s + 1.0f); sh[j] = *(const f32x4*)(MOD + b * NMOD * DM + k); }
    f32x4 nx[4];
#pragma unroll
    for (int j = 0; j < 4; ++j) nx[j] = *(const f32x4*)(x + (size_t)row0 * DM + 4 * F.lane + 256 * j);
    for (int r = 0; r < 8; ++r) { const int row = row0 + r;
        f32x4 v[4]; float ss = 0.f;
#pragma unroll
        for (int j = 0; j < 4; ++j) { v[j] = nx[j]; ss += (v[j][0] * v[j][0] + v[j][1] * v[j][1]) + (v[j][2] * v[j][2] + v[j][3] * v[j][3]); }
        if (r < 7) {
#pragma unroll
            for (int j = 0; j < 4; ++j) nx[j] = *(const f32x4*)(x + (size_t)(row + 1) * DM + 4 * F.lane + 256 * j); }
        const float rinv = 1.0f / sqrtf(wave_sum(ss) * (1.0f / DM) + RMS_EPS);
        float fl[8];
#pragma unroll
        for (int h = 0; h < 8; ++h) fl[h] = 0.f;
#pragma unroll
        for (int j = 0; j < 4; ++j) { const f32x4 hv = v[j] * rinv * gm[j] + sh[j];
            v2u o; o.x = pk2(hv[0], hv[1]); o.y = pk2(hv[2], hv[3]); *(GAS v2u*)(H1 + (size_t)row * DM + 4 * F.lane + 256 * j) = o;
#pragma unroll
            for (int h = 0; h < 8; ++h) { const f32x4 w = *(const LAS f32x4*)(wf + h * DM + 4 * F.lane + 256 * j); fl[h] += (hv[0] * w[0] + hv[1] * w[1]) + (hv[2] * w[2] + hv[3] * w[3]); } }
#pragma unroll
        for (int h = 0; h < 8; ++h) fl[h] = wave_sum(fl[h]);
        if (F.lane < 8) { float f = fl[0];
#pragma unroll
            for (int h = 1; h < 8; ++h) f = (F.lane == h) ? fl[h] : f;
            LOGF2[(size_t)row * 8 + F.lane] = log_sigmoid_f(f + fb[F.lane]) * 1.4426950408889634f; }
    }
}

constexpr int LRU_XP = 1040;
constexpr int LRU_XT = 0, LRU_XC = 69696, LRU_CAR = 136256;
constexpr int CW_LRU = 131072;
static_assert(LRU_CAR + 2048 <= SCRATCH_BYTES && 67 * LRU_XP <= LRU_XC && LRU_XC + 64 * LRU_XP <= LRU_CAR, "LRU LDS map");
__device__ __forceinline__ float one_minus_exp(float x) { const float p = -x * (1.0f + x * (0.5f + x * (0.16666667f + x * (0.041666668f + x * (0.0083333338f + x * (0.0013888889f + x * 0.00019841270f)))))); const float d = 1.0f - __builtin_amdgcn_exp2f(1.4426950408889634f * x); return x > -0.25f ? p : d; }
__device__ __forceinline__ void lru_item(Frame& F, int b, int c) {
    LAS unsigned char* XT = F.lds + LRU_XT; LAS unsigned char* XC = F.lds + LRU_XC; LAS float* CAR = (LAS float*)(F.lds + LRU_CAR);
    const bf16* XL = (const bf16*)(F.ws + WS_PJ); const bf16* YL = XL + PJ_STRIDE; const bf16* LWT = (const bf16*)(F.ws + WS_LWT);
    float* LSUM = (float*)(F.ws + WS_LSUM); bf16* MRG = (bf16*)(F.ws + WS_MRG); unsigned* flags = (unsigned*)(F.ws + WS_CTL) + CW_LRU;
    const float* conv_w = F.in(7); const float* conv_b = F.in(8); const float* ba = F.in(10); const float* bx = F.in(12); const float* lam = F.in(13); const float* gn_lru = F.in(15);
    const int t0 = c * 64; const size_t rowb = (size_t)b * SEQ;
    { v4u xv[9];
#pragma unroll
      for (int q = 0; q < 9; ++q) { const int p = F.tid + q * (NWAVES * 64), i = p >> 6, c8 = p & 63, t = t0 - 3 + i; xv[q] = (v4u){0u, 0u, 0u, 0u};
          if (p < 67 * 64 && t >= 0) xv[q] = *(const GAS v4u*)(XL + (rowb + t) * 512 + c8 * 8); }
#pragma unroll
      for (int q = 0; q < 9; ++q) { const int p = F.tid + q * (NWAVES * 64), i = p >> 6, c8 = p & 63; if (p < 67 * 64) *(LAS v4u*)(XT + i * LRU_XP + c8 * 16) = xv[q]; } }
    v4u yv8[8];
#pragma unroll
    for (int q = 0; q < 8; ++q) { const int p = F.tid + q * (NWAVES * 64), i = p >> 6, c8 = p & 63; yv8[q] = *(const GAS v4u*)(YL + (rowb + t0 + i) * 512 + c8 * 8); }
    __syncthreads();
    { const int ch = F.tid; const float w0 = conv_w[ch], w1 = conv_w[512 + ch], w2 = conv_w[1024 + ch], w3 = conv_w[1536 + ch], cb = conv_b[ch];
      float xa = bf1(*(const LAS bf16*)(XT + 0 * LRU_XP + ch * 2)), xb = bf1(*(const LAS bf16*)(XT + 1 * LRU_XP + ch * 2)), xc = bf1(*(const LAS bf16*)(XT + 2 * LRU_XP + ch * 2));
#pragma unroll 8
      for (int t = 0; t < 64; ++t) { const float xd = bf1(*(const LAS bf16*)(XT + (t + 3) * LRU_XP + ch * 2)); const float v = ((w0 * xa + w1 * xb) + (w2 * xc + w3 * xd)) + cb;
          *(LAS bf16*)(XC + t * LRU_XP + ch * 2) = (bf16)f2bf(v); xa = xb; xb = xc; xc = xd; } }
    __syncthreads();
#pragma unroll
    for (int q = 0; q < 8; ++q) { const int p = F.tid + q * (NWAVES * 64), i = p >> 6, c8 = p & 63; *(LAS v4u*)(XT + i * LRU_XP + c8 * 16) = yv8[q]; }
    const int g = F.wave, l31 = F.lane & 31, hi = F.lane >> 5;
    __syncthreads();
#pragma unroll 1
    for (int hp = 0; hp < 2; ++hp) {
        const int chl = g * 64 + 32 * hp + l31;
        f32x16 cumA[2], hloc[2];
#pragma unroll
        for (int tg = 0; tg < 2; ++tg) { cumA[tg] = f32x16{}; hloc[tg] = f32x16{}; }
#pragma unroll
        for (int s = 0; s < 4; ++s) {
            const bf16x8 wa = *(const GAS bf16x8*)(LWT + ((size_t)((0 * 8 + g) * 64 + 32 * hp + l31)) * 64 + 16 * s + 8 * hi);
            const bf16x8 wx = *(const GAS bf16x8*)(LWT + ((size_t)((1 * 8 + g) * 64 + 32 * hp + l31)) * 64 + 16 * s + 8 * hi);
#pragma unroll
            for (int tg = 0; tg < 2; ++tg) { const bf16x8 bfr = *(const LAS bf16x8*)(XC + (32 * tg + l31) * LRU_XP + (g * 64 + 16 * s + 8 * hi) * 2);
                cumA[tg] = __builtin_amdgcn_mfma_f32_32x32x16_bf16(bfr, wa, cumA[tg], 0, 0, 0); hloc[tg] = __builtin_amdgcn_mfma_f32_32x32x16_bf16(bfr, wx, hloc[tg], 0, 0, 0); }
        }
        const float pba = ba[chl], pbx = bx[chl], psp = 8.0f * softplus_f(-lam[chl]);
        float cA = 1.0f, cB = 0.0f;
#pragma unroll
        for (int tg = 0; tg < 2; ++tg) {
            f32x16& A = cumA[tg]; f32x16& X = hloc[tg];
#pragma unroll
            for (int r = 0; r < 16; ++r) { const int tok = 32 * tg + (r & 3) + 8 * (r >> 2) + 4 * hi; const float xv = bf1(*(const LAS bf16*)(XC + tok * LRU_XP + chl * 2));
                const float rg = sigmoid_f(A[r] + pba), ig = sigmoid_f(X[r] + pbx); const float la = -rg * psp;
                A[r] = __builtin_amdgcn_exp2f(1.4426950408889634f * la); X[r] = __builtin_amdgcn_sqrtf(one_minus_exp(2.0f * la)) * (ig * xv); }
#pragma unroll
            for (int q = 0; q < 4; ++q)
#pragma unroll
                for (int i = 1; i < 4; ++i) { X[4 * q + i] = A[4 * q + i] * X[4 * q + i - 1] + X[4 * q + i]; A[4 * q + i] = A[4 * q + i] * A[4 * q + i - 1]; }
#pragma unroll
            for (int q2 = 0; q2 < 8; ++q2) { const int q = q2 >> 1; const bool own = (hi == (q2 & 1));
#pragma unroll
                for (int i = 0; i < 4; ++i) { const float nb = A[4 * q + i] * cB + X[4 * q + i], na = A[4 * q + i] * cA; X[4 * q + i] = own ? nb : X[4 * q + i]; A[4 * q + i] = own ? na : A[4 * q + i]; }
                float ra, rb; { float a0 = A[4 * q + 3], a1 = a0; swap_half32(a0, a1); ra = hi ? a0 : a1; float b0 = X[4 * q + 3], b1 = b0; swap_half32(b0, b1); rb = hi ? b0 : b1; }
                cA = own ? A[4 * q + 3] : ra; cB = own ? X[4 * q + 3] : rb; }
        }
        if (hi == 0) { float* d0 = LSUM + (((size_t)b * 32 + c) * 2 + 0) * 512 + chl; __hip_atomic_store(d0, cA, __ATOMIC_RELAXED, __HIP_MEMORY_SCOPE_AGENT); __hip_atomic_store(d0 + 512, cB, __ATOMIC_RELAXED, __HIP_MEMORY_SCOPE_AGENT); }
        asm volatile("s_waitcnt vmcnt(0)" ::: "memory");
        __syncthreads();
        if (F.wave == 0) {
            if (F.lane == 0) __hip_atomic_store(flags + 64 * ((32 * b + c) * 2 + hp), 1u, __ATOMIC_RELAXED, __HIP_MEMORY_SCOPE_AGENT);
            unsigned sp = 0;
            for (;;) { const unsigned v = (F.lane < c) ? __hip_atomic_load(flags + 64 * ((32 * b + F.lane) * 2 + hp), __ATOMIC_RELAXED, __HIP_MEMORY_SCOPE_AGENT) : 1u;
                if (__all(v != 0u)) break; __builtin_amdgcn_s_sleep(1); if (++sp > (1u << 20)) break; }
        }
        __syncthreads();
        if (F.tid < 256) { const int ch = (F.tid >> 5) * 64 + 32 * hp + (F.tid & 31); float cr = 0.f; float* LS = LSUM + (size_t)b * 32 * 2 * 512 + ch;
          for (int c0 = 0; c0 < c; c0 += 32) { float A8[32], B8[32];
#pragma unroll
              for (int u = 0; u < 32; ++u) { const bool ok = (c0 + u) < c; A8[u] = 1.0f; B8[u] = 0.0f; if (ok) { A8[u] = __hip_atomic_load(LS + (size_t)(c0 + u) * 1024, __ATOMIC_RELAXED, __HIP_MEMORY_SCOPE_AGENT); B8[u] = __hip_atomic_load(LS + (size_t)(c0 + u) * 1024 + 512, __ATOMIC_RELAXED, __HIP_MEMORY_SCOPE_AGENT); } }
#pragma unroll
              for (int u = 0; u < 32; ++u) cr = A8[u] * cr + B8[u]; }
          CAR[ch] = cr; }
        __syncthreads();
        { const float cin = CAR[chl];
#pragma unroll
          for (int tg = 0; tg < 2; ++tg)
#pragma unroll
              for (int r = 0; r < 16; ++r) { const int tok = 32 * tg + (r & 3) + 8 * (r >> 2) + 4 * hi; LAS bf16* yp = (LAS bf16*)(XT + tok * LRU_XP + chl * 2);
                  const float h = hloc[tg][r] + cumA[tg][r] * cin; *yp = (bf16)f2bf(h * gelu_tanh_f(bf1(*yp))); } }
    }
    __syncthreads();
#pragma unroll 2
    for (int q = 0; q < 8; ++q) { const int i = F.wave + 8 * q, c8 = F.lane;
        const v4u w = *(const LAS v4u*)(XT + i * LRU_XP + c8 * 16);
        const float v0 = bflo(w.x), v1 = bfhi(w.x), v2 = bflo(w.y), v3 = bfhi(w.y), v4 = bflo(w.z), v5 = bfhi(w.z), v6 = bflo(w.w), v7 = bfhi(w.w);
        const float ss = wave_sum(((v0 * v0 + v1 * v1) + (v2 * v2 + v3 * v3)) + ((v4 * v4 + v5 * v5) + (v6 * v6 + v7 * v7)));
        const float rinv = 1.0f / sqrtf(ss * (1.0f / DLRU) + RMS_EPS);
        const f32x4 g0 = *(const f32x4*)(gn_lru + c8 * 8), g1 = *(const f32x4*)(gn_lru + c8 * 8 + 4);
        v4u o; o.x = pk2(v0 * rinv * g0[0], v1 * rinv * g0[1]); o.y = pk2(v2 * rinv * g0[2], v3 * rinv * g0[3]); o.z = pk2(v4 * rinv * g1[0], v5 * rinv * g1[1]); o.w = pk2(v6 * rinv * g1[2], v7 * rinv * g1[3]);
        *(GAS v4u*)(MRG + (rowb + t0 + i) * 1024 + 512 + c8 * 8) = o; }
    __syncthreads();
}
__device__ __forceinline__ void lru_phase(Frame& F) { for (int it = F.vcu; it < BATCH * 32; it += F.G) lru_item(F, it >> 5, it & 31); }

template <int VAR = 0> __device__ __forceinline__ void p6_phase(Frame& F) {
    const float* x = F.in(0); const float* gpost = F.in(5); const float* gffn = F.in(18); const float* b_router = F.in(21);
    const float* MOD = (const float*)(F.ws + WS_MOD); const bf16* Y = (const bf16*)(F.ws + WS_Y); unsigned char* H2 = (unsigned char*)(F.ws + WS_H2);
    int* TOPI = (int*)(F.ws + WS_TOPI); float* TOPW = (float*)(F.ws + WS_TOPW); int* WGCNT = (int*)(F.ws + WS_WGCNT);
    LAS float* wrl = (LAS float*)F.lds;
    LAS int* hist = (LAS int*)(F.lds + 131072);
    { const float* WRT = (const float*)(F.ws + WS_WRT);
#pragma unroll 4
      for (int i = F.tid; i < NE * DM / 4; i += NWAVES * 64) *(LAS f32x4*)(wrl + 4 * i) = *(const f32x4*)(WRT + 4 * i); }
    if (F.tid < NE) hist[F.tid] = 0;
    __syncthreads();
    if (F.G * 64 == NTOK) {
    const int bx = blockIdx.x, row0 = bx * 64 + F.wave * 8, b = row0 / SEQ;
    f32x4 gpm[4], gf[4], shf[4];
#pragma unroll
    for (int j = 0; j < 4; ++j) { const int k = 4 * F.lane + 256 * j; const float* mb = MOD + b * NMOD * DM + k;
        gpm[j] = *(const f32x4*)(mb + 2 * DM) * *(const f32x4*)(gpost + k); gf[j] = *(const f32x4*)(gffn + k) * (*(const f32x4*)(mb + 4 * DM) + 1.0f); shf[j] = *(const f32x4*)(mb + 3 * DM); }
    v2u ywn[2][4]; f32x4 xn[2][4];
#pragma unroll
    for (int u = 0; u < 2; ++u)
#pragma unroll
        for (int j = 0; j < 4; ++j) { ywn[u][j] = *(const GAS v2u*)(Y + (size_t)(row0 + u) * DM + 4 * F.lane + 256 * j); xn[u][j] = *(const f32x4*)(x + (size_t)(row0 + u) * DM + 4 * F.lane + 256 * j); }
    for (int rp = 0; rp < 4; ++rp) {
        f32x4 hv[2][4];
        v2u ywc[2][4]; f32x4 xc[2][4];
#pragma unroll
        for (int u = 0; u < 2; ++u)
#pragma unroll
            for (int j = 0; j < 4; ++j) { ywc[u][j] = ywn[u][j]; xc[u][j] = xn[u][j]; }
        if (rp < 3) {
#pragma unroll
            for (int u = 0; u < 2; ++u)
#pragma unroll
                for (int j = 0; j < 4; ++j) { ywn[u][j] = *(const GAS v2u*)(Y + (size_t)(row0 + 2 * rp + 2 + u) * DM + 4 * F.lane + 256 * j); xn[u][j] = *(const f32x4*)(x + (size_t)(row0 + 2 * rp + 2 + u) * DM + 4 * F.lane + 256 * j); } }
#pragma unroll
        for (int u = 0; u < 2; ++u) { const int row = row0 + 2 * rp + u;
            f32x4 yv[4]; float ss = 0.f;
#pragma unroll
            for (int j = 0; j < 4; ++j) { const v2u yw = ywc[u][j]; yv[j] = (f32x4){bflo(yw.x), bfhi(yw.x), bflo(yw.y), bfhi(yw.y)}; ss += (yv[j][0] * yv[j][0] + yv[j][1] * yv[j][1]) + (yv[j][2] * yv[j][2] + yv[j][3] * yv[j][3]); }
            const float rinv = 1.0f / sqrtf(wave_sum(ss) * (1.0f / DM) + RMS_EPS);
            float s2 = 0.f;
#pragma unroll
            for (int j = 0; j < 4; ++j) { const f32x4 xm = xc[u][j] + gpm[j] * (yv[j] * rinv);
                yv[j] = xm; s2 += (xm[0] * xm[0] + xm[1] * xm[1]) + (xm[2] * xm[2] + xm[3] * xm[3]); }
            const float rinv2 = 1.0f / sqrtf(wave_sum(s2) * (1.0f / DM) + RMS_EPS);
#pragma unroll
            for (int j = 0; j < 4; ++j) { const f32x4 h = yv[j] * rinv2 * gf[j] + shf[j]; hv[u][j] = h;
                int w8 = 0; w8 = __builtin_amdgcn_cvt_pk_fp8_f32(h[0], h[1], w8, false); w8 = __builtin_amdgcn_cvt_pk_fp8_f32(h[2], h[3], w8, true); *(GAS int*)(H2 + (size_t)row * DM + 4 * F.lane + 256 * j) = w8; }
        }
        typedef float f32x2 __attribute__((ext_vector_type(2)));
        f32x2 hp[4][4];
#pragma unroll
        for (int j = 0; j < 4; ++j)
#pragma unroll
            for (int i = 0; i < 4; ++i) hp[j][i] = (f32x2){hv[0][j][i], hv[1][j][i]};
        float pa[32], pb[32];
#pragma unroll
        for (int e = 0; e < 32; ++e) { f32x2 s2 = (f32x2){0.f, 0.f};
#pragma unroll
            for (int j = 0; j < (VAR == 1 ? 0 : 4); ++j) { const f32x4 w = *(const LAS f32x4*)(wrl + e * DM + 4 * F.lane + 256 * j);
#pragma unroll
                for (int i = 0; i < 4; ++i) s2 = __builtin_elementwise_fma(hp[j][i], (f32x2){w[i], w[i]}, s2); }
            pa[e] = s2[0]; pb[e] = s2[1]; }
#pragma unroll
        for (int i = 0; i < 16; ++i) { float a = pa[i], b = pa[16 + i]; swap_half32(a, b); pa[i] = a + b; float c2 = pb[i], d2 = pb[16 + i]; swap_half32(c2, d2); pb[i] = c2 + d2; }
#pragma unroll
        for (int i = 0; i < 8; ++i) { float a = pa[i], b = pa[8 + i]; swap_rows16(a, b); pa[i] = a + b; float c2 = pb[i], d2 = pb[8 + i]; swap_rows16(c2, d2); pb[i] = c2 + d2; }
#define TR_STEP(N, XOR, BIT) _Pragma("unroll") for (int i = 0; i < N; ++i) { const bool up = (F.lane & BIT) != 0; \
            const float ka = up ? pa[N + i] : pa[i], sa_ = up ? pa[i] : pa[N + i], kb = up ? pb[N + i] : pb[i], sb_ = up ? pb[i] : pb[N + i]; \
            pa[i] = ka + XOR(sa_); pb[i] = kb + XOR(sb_); }
        TR_STEP(4, lane_xor8, 8) TR_STEP(2, lane_xor4, 4) TR_STEP(1, lane_xor2, 2)
#undef TR_STEP
        const int e = (F.lane >> 1) & 31; const float br = b_router[e];
#pragma unroll
        for (int u = 0; u < 2; ++u) { const int row = row0 + 2 * rp + u; float v = (u ? pb[0] : pa[0]); v += lane_xor1(v); v += br;
            int rank = 0;
#pragma unroll
            for (int j = 0; j < 32; ++j) { const float vj = __uint_as_float((unsigned)__builtin_amdgcn_readlane((int)__float_as_uint(v), 2 * j)); rank += (vj > v || (vj == v && j < e)) ? 1 : 0; }
            const bool sel = rank < TOPK; const float vmax = wave_max(v); const float ex = sel ? __expf(v - vmax) : 0.f; const float den = wave_sum(ex) * 0.5f;
            if (sel && !(F.lane & 1)) { TOPI[(size_t)row * TOPK + rank] = e; TOPW[(size_t)row * TOPK + rank] = ex / den; __hip_atomic_fetch_add((LAS int*)&hist[e], 1, __ATOMIC_RELAXED, __HIP_MEMORY_SCOPE_WORKGROUP); } }
    }
    __syncthreads();
    if (F.tid < NE) WGCNT[bx * NE + F.tid] = hist[F.tid];
    }
}

__device__ __forceinline__ void p7_phase(Frame& F) {
    const int* TOPI = (const int*)(F.ws + WS_TOPI); const float* TOPW = (const float*)(F.ws + WS_TOPW); const int* WGCNT = (const int*)(F.ws + WS_WGCNT);
    int* ROWTOK = (int*)(F.ws + WS_ROWTOK); int* ROWPAIR = (int*)(F.ws + WS_ROWPAIR); float* ROWW = (float*)(F.ws + WS_ROWW); int* MTEXP = (int*)(F.ws + WS_MTEXP);
    LAS int* ptot = (LAS int*)F.lds; LAS int* pbef = ptot + 512; LAS int* cnt = pbef + 512; LAS int* wgb = cnt + 32; LAS int* pst = wgb + 32; LAS int* pad = pst + 64; LAS int* ep = pad + 32;
    if (F.G != 256) return;
    const int bx = blockIdx.x;
    { const int e = F.tid & 31, part = F.tid >> 5; int tt = 0, tb = 0;
      for (int w = part * 16; w < part * 16 + 16; ++w) { const int v = WGCNT[w * NE + e]; tt += v; tb += (w < bx) ? v : 0; }
      ptot[part * 32 + e] = tt; pbef[part * 32 + e] = tb; }
    __syncthreads();
    if (F.tid < NE) { int tt = 0, tb = 0; for (int p = 0; p < 16; ++p) { tt += ptot[p * 32 + F.tid]; tb += pbef[p * 32 + F.tid]; } cnt[F.tid] = tt; wgb[F.tid] = tb; pad[F.tid] = (tt + 255) & ~255; }
    __syncthreads();
    if (F.tid == 0) { int s = 0; for (int e = 0; e < NE; ++e) { pst[e] = s; s += pad[e]; } pst[NE] = s; }
    if (F.tid < 256) ep[F.tid] = TOPI[(size_t)bx * 256 + F.tid];
    __syncthreads();
    if (F.tid < 256) { const int p = F.tid, e = ep[p]; int rk = 0; for (int q = 0; q < p; ++q) rk += (ep[q] == e) ? 1 : 0;
        const int dest = pst[e] + wgb[e] + rk; const int pair = bx * 256 + p; ROWTOK[dest] = pair >> 2; ROWPAIR[dest] = pair; ROWW[dest] = TOPW[pair]; }
    if (bx < NE) { const int e = bx; for (int i = pst[e] + cnt[e] + F.tid; i < pst[e] + pad[e]; i += NWAVES * 64) { ROWTOK[i] = 0; ROWPAIR[i] = -1; ROWW[i] = 0.f; } }
    if (bx == 0) { if (F.tid < NE) { for (int mt = pst[F.tid] >> 8; mt < (pst[F.tid] + pad[F.tid]) >> 8; ++mt) MTEXP[mt] = F.tid; } if (F.tid == 0) MTEXP[512] = pst[NE] >> 8; }
}

__device__ __forceinline__ void p10_phase(Frame& F) {
    const float* x = F.in(0); const float* gpostm = F.in(5); const float* gpost = F.in(19); const float* MOD = (const float*)(F.ws + WS_MOD);
    const unsigned char* YP = (const unsigned char*)(F.ws + WS_YP); const bf16* Y = (const bf16*)(F.ws + WS_Y);
    const int gw = F.vcu * NWAVES + F.wave;
    if (F.G * NWAVES * 8 != NTOK) return;
    const int row0 = gw * 8, b = row0 / SEQ;
    f32x4 gg[4], gpm[4];
#pragma unroll
    for (int j = 0; j < 4; ++j) { const int k = 4 * F.lane + 256 * j; gg[j] = *(const f32x4*)(MOD + b * NMOD * DM + 5 * DM + k) * *(const f32x4*)(gpost + k); gpm[j] = *(const f32x4*)(MOD + b * NMOD * DM + 2 * DM + k) * *(const f32x4*)(gpostm + k); }
    int nw[4][TOPK]; v2u ny[4]; f32x4 nx[4];
#pragma unroll
    for (int j = 0; j < 4; ++j) { ny[j] = *(const GAS v2u*)(Y + (size_t)row0 * DM + 4 * F.lane + 256 * j); nx[j] = *(const f32x4*)(x + (size_t)row0 * DM + 4 * F.lane + 256 * j);
#pragma unroll
        for (int k = 0; k < TOPK; ++k) nw[j][k] = *(const GAS int*)(YP + ((size_t)row0 * TOPK + k) * DM + 4 * F.lane + 256 * j); }
    for (int r = 0; r < 8; ++r) { const int row = row0 + r;
        f32x4 y[4], ym[4], xr[4]; float ss = 0.f, sm = 0.f;
#pragma unroll
        for (int j = 0; j < 4; ++j) { f32x4 s = (f32x4){0.f, 0.f, 0.f, 0.f};
#pragma unroll
            for (int k = 0; k < TOPK; ++k) { const int w = nw[j][k]; s += (f32x4){__builtin_amdgcn_cvt_f32_fp8(w, 0), __builtin_amdgcn_cvt_f32_fp8(w, 1), __builtin_amdgcn_cvt_f32_fp8(w, 2), __builtin_amdgcn_cvt_f32_fp8(w, 3)}; }
            y[j] = s; ss += (s[0] * s[0] + s[1] * s[1]) + (s[2] * s[2] + s[3] * s[3]);
            const v2u yw = ny[j]; const f32x4 m = (f32x4){bflo(yw.x), bfhi(yw.x), bflo(yw.y), bfhi(yw.y)}; ym[j] = m; sm += (m[0] * m[0] + m[1] * m[1]) + (m[2] * m[2] + m[3] * m[3]); xr[j] = nx[j]; }
        if (r < 7) {
#pragma unroll
            for (int j = 0; j < 4; ++j) { ny[j] = *(const GAS v2u*)(Y + (size_t)(row + 1) * DM + 4 * F.lane + 256 * j); nx[j] = *(const f32x4*)(x + (size_t)(row + 1) * DM + 4 * F.lane + 256 * j);
#pragma unroll
                for (int k = 0; k < TOPK; ++k) nw[j][k] = *(const GAS int*)(YP + ((size_t)(row + 1) * TOPK + k) * DM + 4 * F.lane + 256 * j); } }
        const float rinv = 1.0f / sqrtf(wave_sum(ss) * (1.0f / DM) + RMS_EPS * 16.0f), rinvm = 1.0f / sqrtf(wave_sum(sm) * (1.0f / DM) + RMS_EPS);
#pragma unroll
        for (int j = 0; j < 4; ++j) *(f32x4*)(F.out + (size_t)row * DM + 4 * F.lane + 256 * j) = (xr[j] + gpm[j] * (ym[j] * rinvm)) + gg[j] * (y[j] * rinv);
    }
}

__global__ void __launch_bounds__(NWAVES * 64, 2) mega_fwd(Args args) {
    extern __shared__ __attribute__((aligned(16))) unsigned char lds[];
    Frame F;
    F.lds = (LAS unsigned char*)lds;
    F.tid = threadIdx.x; F.lane = F.tid & 63; F.wave = __builtin_amdgcn_readfirstlane(F.tid >> 6);
    F.G = gridDim.x; { const int bx = blockIdx.x; F.vcu = (F.G % 8 == 0) ? (bx % 8) * (F.G / 8) + bx / 8 : bx; }
    F.out = args.out; F.ws = args.ws;
    volatile LAS unsigned* MISC = (volatile LAS unsigned*)(F.lds + MISC_OFF);
    for (int u = F.tid; u < (LDS_BYTES - LDSCTL_OFF) / 4; u += NWAVES * 64) ((LAS unsigned*)(F.lds + LDSCTL_OFF))[u] = 0u;
    __syncthreads();
    if (F.tid < 26) ((LAS unsigned long long*)(F.lds + LDSCTL_OFF))[F.tid] = (unsigned long long)args.in[F.tid];
    __syncthreads();
    gu32* ctl = (gu32*)(F.ws + WS_CTL);
    XcdBarrier bar = xcd_barrier_post((unsigned*)(ctl + CW_BAR) + args.li * XCD_BAR_WORDS, MISC + 8);
    const int lo = args.ph_lo, hi = args.ph_hi;
#ifndef PHMASK
#define PHMASK 0x7ff
#endif
#define IN(k) (((PHMASK >> (k)) & 1) && lo <= (k) && (k) < hi)
#define SEAM(k, n) do { if (IN(k) && IN(n)) xcd_barrier(bar); } while (0)
#define REFRESH() do { int t_; asm volatile("v_mov_b32 %0, %1" : "=v"(t_) : "v"(threadIdx.x)); F.tid = t_; F.lane = t_ & 63; } while (0)
#define ATTN_TENSORS attn_body::AttnTensors{(const attn_body::bf16*)(F.ws + WS_PJ) + 2 * PJ_STRIDE, (const attn_body::bf16*)(F.ws + WS_PJ) + 3 * PJ_STRIDE, (const attn_body::bf16*)(F.ws + WS_PJ) + 4 * PJ_STRIDE, \
                                          (attn_body::bf16*)(F.ws + WS_MRG), (const float*)(F.ws + WS_LOGF2), (float*)(F.ws + WS_SSQ)}
    if (IN(0)) { REFRESH(); p0_phase(F); } SEAM(0, 1);
    if (IN(1)) { REFRESH(); p1_phase(F); } SEAM(1, 2);
    if (IN(2)) { REFRESH();
        pg8::DenseOrder S; S.init((const pg8::bf16_t*)(F.ws + WS_H1), (const pg8::bf16_t*)(F.ws + WS_WIN), NTOK, NPJ, F.G, (int)blockIdx.x);
        pg8::EpiProj E{(pg8::bf16_t*)(F.ws + WS_PJ), PJ_STRIDE, attn_body::C2};
        pg8::gemm_phase<pg8::EpiProj, pg8::DenseOrder>(F.lds, S, E);
        if (F.G == 256 && blockIdx.x >= 128) { REFRESH(); cvt_range<true>(F, 0, CV_UP_TAIL, ((int)blockIdx.x - 128) * NWAVES + F.wave, 128 * NWAVES); }
    } SEAM(2, 3);
    if (IN(3)) { REFRESH();
        lru_phase(F);
        const attn_body::AttnTensors AT = ATTN_TENSORS; const attn_body::StaticOrder S((int)F.G, F.vcu);
        attn_body::attn_phase<attn_body::StaticOrder>((char*)lds, AT, S);
    } SEAM(3, 5);
    if (IN(5)) { REFRESH();
        pg8::DenseOrder S; S.init((const pg8::bf16_t*)(F.ws + WS_MRG), (const pg8::bf16_t*)(F.ws + WS_WOUT), NTOK, DM, F.G, (int)blockIdx.x);
        pg8::EpiOut E{(pg8::bf16_t*)(F.ws + WS_Y), (const float*)(F.ws + WS_SSQ)};
        pg8::gemm_phase<pg8::EpiOut, pg8::DenseOrder>(F.lds, S, E);
    } SEAM(5, 6);
    if (IN(6)) { REFRESH(); p6_phase<0>(F); } SEAM(6, 7);
    if (IN(7)) { REFRESH(); p7_phase(F); } SEAM(7, 8);
    if (IN(8)) { REFRESH();
        const int nmt = ((const int*)(F.ws + WS_MTEXP))[512];
        LAS int* mtl = (LAS int*)(F.lds + 131072); LAS float* bsl = (LAS float*)(F.lds + 131072 + 2048);
        for (int i = F.tid; i < nmt; i += NWAVES * 64) mtl[i] = ((const int*)(F.ws + WS_MTEXP))[i];
        __syncthreads();
        { const float* b_up = F.in(23);
          for (int i = 0; i < 12; ++i) { const int L = i * F.G + F.vcu; if (L >= nmt * 8) break; const int ex = mtl[L >> 3], pn = L & 7;
              if (F.tid < 256) bsl[i * 256 + F.tid] = b_up[(size_t)ex * 2 * DEXP + (F.tid >> 7) * DEXP + pn * 128 + (F.tid & 127)]; } }
        __syncthreads();
        pg8::UpOrder S{(const unsigned char*)(F.ws + WS_H2), (const unsigned char*)(F.ws + WS_WUP), (const int*)(F.ws + WS_ROWTOK), mtl, nmt * 8, F.G, F.vcu};
        pg8::EpiUp E{(unsigned char*)(F.ws + WS_ACT), bsl};
        pg8::gemm_phase<pg8::EpiUp, pg8::UpOrder, true>(F.lds, S, E);
        if (F.G == 256) {
            const int units = nmt * 8, maxu = (units + 255) >> 8, nfull = units - (maxu - 1) * 256, nidle = 256 - nfull;
            REFRESH();
            if (nidle >= 32) { if (F.vcu >= nfull) cvt_range<false>(F, 0, CV_DN_TAIL, (F.vcu - nfull) * NWAVES + F.wave, nidle * NWAVES); }
            else cvt_range<false>(F, 0, CV_DN_TAIL, F.vcu * NWAVES + F.wave, 256 * NWAVES); }
    } SEAM(8, 9);
    if (IN(9)) { REFRESH();
        const int nmt = ((const int*)(F.ws + WS_MTEXP))[512];
        LAS int* mtl = (LAS int*)(F.lds + 131072); LAS float* bsl = (LAS float*)(F.lds + 131072 + 2048);
        for (int i = F.tid; i < nmt; i += NWAVES * 64) mtl[i] = ((const int*)(F.ws + WS_MTEXP))[i];
        __syncthreads();
        { const float* b_dn = F.in(25);
          for (int i = 0; i < 12; ++i) { const int L = i * F.G + F.vcu; if (L >= nmt * 4) break; const int ex = mtl[L >> 2], pn = L & 3;
              if (F.tid < 256) bsl[i * 256 + F.tid] = b_dn[(size_t)ex * DM + pn * 256 + F.tid]; } }
        __syncthreads();
        pg8::DownOrder S{(const unsigned char*)(F.ws + WS_ACT), (const unsigned char*)(F.ws + WS_WDN), mtl, nmt * 4, F.G, F.vcu};
        pg8::EpiDown E{(unsigned char*)(F.ws + WS_YP), bsl, (const int*)(F.ws + WS_ROWPAIR), (const float*)(F.ws + WS_ROWW)};
        pg8::gemm_phase<pg8::EpiDown, pg8::DownOrder, true>(F.lds, S, E);
    } SEAM(9, 10);
    if (IN(10)) { REFRESH(); p10_phase(F); }
#ifdef MK_PROBES
    if (lo == 11) { REFRESH(); lru_phase(F); }
    if (lo == 12) { REFRESH(); const attn_body::AttnTensors AT = ATTN_TENSORS; const attn_body::StaticOrder S((int)F.G, F.vcu); attn_body::attn_phase<attn_body::StaticOrder>((char*)lds, AT, S); }
    if (lo == 14) { REFRESH(); p0_phase<1>(F); }
    if (lo == 15) { REFRESH(); p0_phase<2>(F); }
    if (lo == 16) { REFRESH(); p0_phase<4>(F); }
    if (lo == 17) { for (int i = 0; i < 10; ++i) xcd_barrier(bar); }
    if (lo == 18) { REFRESH(); p6_phase<1>(F); }
#endif
#undef IN
#undef SEAM
#undef REFRESH
#undef ATTN_TENSORS
}

static void launch_mega(hipStream_t stream, void* const* d_in, void* d_out, void* d_ws, int lo, int hi, int li, int grid) {
    Args a{};
    for (int i = 0; i < 26; ++i) a.in[i] = (const float*)d_in[i];
    a.out = (float*)d_out; a.ws = (unsigned char*)d_ws; a.ph_lo = lo; a.ph_hi = hi; a.li = li; a.pad = 0;
    hipLaunchKernelGGL(mega_fwd, dim3(grid), dim3(NWAVES * 64), LDS_BYTES, stream, a);
}

extern "C" void kernel_launch(void* const* d_in, const int* in_sizes, int n_in, void* d_out, int out_size, void* d_ws, size_t ws_size, hipStream_t stream) {
    static int grid = 0;
    if (grid == 0) {
        int dev = 0, cus = 0;
        if (n_in != 26 || out_size != NTOK * DM || ws_size < WS_END) { fprintf(stderr, "kernel_launch: unexpected problem shape / workspace (%d inputs, out %d, ws %zu)\n", n_in, out_size, ws_size); grid = -1; return; }
        if (hipGetDevice(&dev) != hipSuccess || hipDeviceGetAttribute(&cus, hipDeviceAttributeMultiprocessorCount, dev) != hipSuccess) { grid = -1; return; }
        if (hipFuncSetAttribute((const void*)mega_fwd, hipFuncAttributeMaxDynamicSharedMemorySize, LDS_BYTES) != hipSuccess) { fprintf(stderr, "kernel_launch: hipFuncSetAttribute failed\n"); grid = -1; return; }
        grid = cus;
        if (grid != 256) fprintf(stderr, "kernel_launch: %d CUs; this kernel is laid out for 256\n", grid);
    }
    if (grid < 0) return;
    (void)in_sizes;
    (void)hipMemsetAsync((char*)d_ws + WS_CTL, 0, CTL_ZERO_BYTES, stream);
    launch_mega(stream, d_in, d_out, d_ws, 0, NPHASES, 0, grid);
#ifdef MK_PROBES
#ifdef EXTRA_LO
    launch_mega(stream, d_in, d_out, d_ws, EXTRA_LO, EXTRA_HI, 1, grid);
#endif
#endif
}
```

```cpp
#include <hip/hip_runtime.h>
#include <hip/hip_bf16.h>
#include <cstdio>
#include <cstdint>
#include <cmath>

constexpr int DM = 1024, BATCH = 8, SEQ = 2048, NTOK = BATCH * SEQ;
constexpr int DLRU = 512, DATT = 512, NH = 8, HD = 64, NPROJ = 2 * DLRU + 3 * DATT + NH, NPJ = 2560;
constexpr int NE = 32, TOPK = 4, DEXP = 1024, NMOD = 6;
constexpr float RMS_EPS = 1e-6f;
constexpr int MAXROWS = NTOK * TOPK + NE * 256;
constexpr int MAXMT = MAXROWS / 256;

namespace pg8 {
#define PG8_LAS __attribute__((address_space(3)))
typedef unsigned short bf16_t;
typedef short bf16x8 __attribute__((ext_vector_type(8)));
typedef float f32x4 __attribute__((ext_vector_type(4)));
typedef float f32x2 __attribute__((ext_vector_type(2)));
typedef unsigned u32x4 __attribute__((ext_vector_type(4)));
constexpr int BM = 256, BK = 64, HALF = 128, HTB = HALF * BK * 2  , STAGE_BYTES = 8 * HTB, NXCD = 8, WGM = 8;
constexpr int GK = 1024, GNT = GK / BK;
typedef int i32x8 __attribute__((ext_vector_type(8)));
typedef int i32x4 __attribute__((ext_vector_type(4)));
constexpr int F8_SCALE_W = 0x79797979, F8_SCALE_A = 0x7f7f7f7f;

__host__ __device__ __forceinline__ int lds_byte(int r, int c) { const int st = (r >> 4) * 2 + (c >> 5), rr = r & 15, cc = c & 31, ob = rr * 64 + cc * 2; return st * 1024 + (ob ^ (((ob >> 9) & 1) << 5)); }
__host__ __device__ __forceinline__ void stage_rc(int b, int& R, int& C) { const int st = b / 1024, sb = b % 1024, swz = sb ^ (((sb >> 9) & 1) << 5); R = (st >> 1) * 16 + swz / 64; C = (st & 1) * 32 + (swz % 64) / 2; }
__host__ __device__ __forceinline__ int perm32(int rho) { const int n = rho >> 4, i = rho & 15; return 8 * (i >> 2) + 4 * n + (i & 3); }

struct Unit { const char* A0; const char* A1; const char* B0; const char* B1; int pm, pn, e, ord; };

__device__ __forceinline__ void mfma_f8_acc(f32x4& acc, const i32x8& b, const i32x8& a, int sw, int sa) {
    asm volatile("v_mfma_scale_f32_16x16x128_f8f6f4 %0, %1, %2, %0, %3, %4 op_sel_hi:[0,0,0]" : "+v"(acc) : "v"(b), "v"(a), "v"(sw), "v"(sa)); }
__device__ __forceinline__ unsigned cvt_pk_bf16(float lo, float hi) { unsigned r; asm volatile("v_cvt_pk_bf16_f32 %0, %1, %2" : "=v"(r) : "v"(lo), "v"(hi)); return r; }

template <class Epi, class Sched, bool F8 = false, int KREP = 1>
__device__ __forceinline__ void gemm_phase(PG8_LAS unsigned char* lds, const Sched& S, const Epi& E) {
    const int tid = threadIdx.x, wid = __builtin_amdgcn_readfirstlane(tid >> 6), lane = tid & 63, wr = wid >> 2, wc = wid & 3, fr = lane & 15, fq = lane >> 4;
    constexpr int KB = F8 ? GK : GK * 2, nt1 = F8 ? GK / 128 : GNT, nt = nt1 * KREP;
    int Rr[2], Cc[2];
    unsigned voffB[2], cvA[2][2], nvA[2][2];
#pragma unroll
    for (int i = 0; i < 2; ++i) { stage_rc(tid * 16 + i * 8192, Rr[i], Cc[i]); const int Rb = Epi::PERM ? ((Rr[i] & ~31) + perm32(Rr[i] & 31)) : Rr[i]; voffB[i] = (unsigned)(Rb * KB + Cc[i] * 2); }
    constexpr size_t kstep = (size_t)(BK * 2);
    const unsigned ldsw = (unsigned)wid * 1024u;
    const int aoff = lds_byte(wr * 64 + fr, fq * 8), boff = lds_byte(wc * 32 + fr, fq * 8);
#define PG8_SA(b, h) (((b) * 2 + (h)) * HTB)
#define PG8_SB(b, h) ((4 + (b) * 2 + (h)) * HTB)
#define PG8_STAGE(bufoff, gbase, voff) do { _Pragma("unroll") for (int _i = 0; _i < 2; ++_i) \
        __builtin_amdgcn_global_load_lds((const unsigned*)((const char*)(gbase) + (voff)[_i]), (PG8_LAS unsigned*)(lds + (bufoff) + ldsw + _i * 8192), 16, 0, 0); } while (0)
#define PG8_LD8(p) __builtin_shufflevector(*(const PG8_LAS i32x4*)(p), *(const PG8_LAS i32x4*)((p) + 1024), 0, 1, 2, 3, 4, 5, 6, 7)
#define PG8_LDA(dst, b, h) do { _Pragma("unroll") for (int m = 0; m < 4; ++m) { if constexpr (F8) { dst##8[m] = PG8_LD8(lds + PG8_SA(b, h) + aoff + m * 2048); } \
        else { _Pragma("unroll") for (int k = 0; k < 2; ++k) dst[m][k] = *(const PG8_LAS bf16x8*)(lds + PG8_SA(b, h) + aoff + m * 2048 + k * 1024); } } } while (0)
#define PG8_LDB(dst, b, h) do { _Pragma("unroll") for (int n = 0; n < 2; ++n) { if constexpr (F8) { dst##8[n] = PG8_LD8(lds + PG8_SB(b, h) + boff + n * 2048); } \
        else { _Pragma("unroll") for (int k = 0; k < 2; ++k) dst[n][k] = *(const PG8_LAS bf16x8*)(lds + PG8_SB(b, h) + boff + n * 2048 + k * 1024); } } } while (0)
#define PG8_MMA(ai, bj, At, Bt) do { __builtin_amdgcn_s_setprio(1); _Pragma("unroll") for (int m = 0; m < 4; ++m) _Pragma("unroll") for (int n = 0; n < 2; ++n) { \
        if constexpr (F8) { mfma_f8_acc(acc[ai][bj][m][n], Bt##8[n], At##8[m], scw, sca); } \
        else { _Pragma("unroll") for (int k = 0; k < 2; ++k) acc[ai][bj][m][n] = __builtin_amdgcn_mfma_f32_16x16x32_bf16(Bt[n][k], At[m][k], acc[ai][bj][m][n], 0, 0, 0); } } \
        __builtin_amdgcn_s_setprio(0); } while (0)
#define PG8_WAIT_V(n) asm volatile("s_waitcnt vmcnt(" #n ")" ::: "memory")
    constexpr int RELAX = 8 + Epi::NST + (Sched::GATHER ? 4 : 0);
#define PG8_WAIT_V8R(rx) do { if (rx) { if constexpr (RELAX == 12) PG8_WAIT_V(12); else if constexpr (RELAX == 16) PG8_WAIT_V(16); else if constexpr (RELAX == 20) PG8_WAIT_V(20); \
        else if constexpr (RELAX == 24) PG8_WAIT_V(24); else if constexpr (RELAX == 28) PG8_WAIT_V(28); else PG8_WAIT_V(8); } else PG8_WAIT_V(8); } while (0)
#define PG8_WAIT_L(n) asm volatile("s_waitcnt lgkmcnt(" #n ")" ::: "memory")
#define PG8_BAR __builtin_amdgcn_s_barrier()
#define PG8_SCHED __builtin_amdgcn_sched_barrier(0)
#define PG8_VOFF(dst, u) do { _Pragma("unroll") for (int _h = 0; _h < 2; ++_h) _Pragma("unroll") for (int _i = 0; _i < 2; ++_i) { \
        const int _row = Sched::GATHER ? S.row_of(u, _h * HALF + Rr[_i]) : Rr[_i]; dst[_h][_i] = (unsigned)(_row * KB + Cc[_i] * 2); } } while (0)
    Unit cur, nxt; int ui = 0;
    if (!S.next(0, cur)) return;
    f32x4 acc[2][2][4][2];
#pragma unroll
    for (int a = 0; a < 2; ++a)
#pragma unroll
        for (int b = 0; b < 2; ++b)
#pragma unroll
            for (int m = 0; m < 4; ++m)
#pragma unroll
                for (int n = 0; n < 2; ++n) acc[a][b][m][n] = (f32x4){0.f, 0.f, 0.f, 0.f};
    const int scw = F8_SCALE_W, sca = F8_SCALE_A;
    bf16x8 At[4][2], B0[2][2], B1[2][2]; i32x8 At8[4], B08[2], B18[2];
    PG8_VOFF(cvA, cur);
    if (Sched::GATHER) { asm volatile("s_waitcnt vmcnt(0)" ::: "memory"); }
    PG8_STAGE(PG8_SB(0, 0), cur.B0, voffB); PG8_STAGE(PG8_SB(0, 1), cur.B1, voffB); PG8_STAGE(PG8_SA(0, 0), cur.A0, cvA[0]); PG8_STAGE(PG8_SA(0, 1), cur.A1, cvA[1]);
    if (wr == 1) PG8_BAR;
    PG8_WAIT_V(2); PG8_BAR;
    PG8_STAGE(PG8_SB(1, 0), cur.B0 + kstep, voffB); PG8_STAGE(PG8_SA(1, 0), cur.A0 + kstep, cvA[0]); PG8_STAGE(PG8_SB(1, 1), cur.B1 + kstep, voffB);
    PG8_WAIT_V(6); PG8_BAR;
    for (;;) {
        const bool has_next = S.next(ui + 1, nxt);
        if (!has_next) nxt = cur;
        int nraw[2][2];
        if (Sched::GATHER && has_next) {
#pragma unroll
            for (int _h = 0; _h < 2; ++_h)
#pragma unroll
                for (int _i = 0; _i < 2; ++_i) { const int* p_ = S.row_ptr(nxt, _h * HALF + Rr[_i]); asm volatile("global_load_dword %0, %1, off" : "=v"(nraw[_h][_i]) : "v"(p_) : "memory"); }
        }
        if (has_next) { if (!Sched::GATHER) { PG8_VOFF(nvA, nxt); } }
        else {
#pragma unroll
            for (int _h = 0; _h < 2; ++_h)
#pragma unroll
                for (int _i = 0; _i < 2; ++_i) nvA[_h][_i] = cvA[_h][_i]; }
#pragma unroll 1
        for (int t = 0; t < nt; t += 2) {
            const bool last = (t == nt - 2); const bool rx = (t == 0) && (ui > 0);
            if (Epi::MID && t == nt / 2) E.mid(acc, cur, wr, wc, fr, fq);
            const char* a1_1 = cur.A1 + (size_t)((t + 1) % nt1) * kstep;
            const char* a2_0 = last ? nxt.A0 : cur.A0 + (size_t)((t + 2) % nt1) * kstep; const char* a2_1 = last ? nxt.A1 : cur.A1 + (size_t)((t + 2) % nt1) * kstep;
            const char* b2_0 = last ? nxt.B0 : cur.B0 + (size_t)((t + 2) % nt1) * kstep; const char* b2_1 = last ? nxt.B1 : cur.B1 + (size_t)((t + 2) % nt1) * kstep;
            const char* a3_0 = a2_0 + kstep; const char* a3_1 = a2_1 + kstep; const char* b3_0 = b2_0 + kstep; const char* b3_1 = b2_1 + kstep;
            if (Sched::GATHER && last && has_next) {
#pragma unroll
                for (int _h = 0; _h < 2; ++_h)
#pragma unroll
                    for (int _i = 0; _i < 2; ++_i) { int r_ = nraw[_h][_i]; asm volatile("" : "+v"(r_));
                        nvA[_h][_i] = (unsigned)(r_ * KB + Cc[_i] * 2); } }
            unsigned sv0[2], sv1[2];
#pragma unroll
            for (int _i = 0; _i < 2; ++_i) { sv0[_i] = last ? nvA[0][_i] : cvA[0][_i]; sv1[_i] = last ? nvA[1][_i] : cvA[1][_i]; }
            PG8_LDB(B0, 0, 0); PG8_LDB(B1, 0, 1); PG8_SCHED; PG8_LDA(At, 0, 0); PG8_STAGE(PG8_SA(1, 1), a1_1, cvA[1]);
            PG8_WAIT_V8R(rx); PG8_WAIT_L(0); PG8_BAR; PG8_MMA(0, 0, At, B0); PG8_MMA(0, 1, At, B1); PG8_BAR; PG8_SCHED;
            PG8_LDA(At, 0, 1); PG8_STAGE(PG8_SB(0, 0), b2_0, voffB); PG8_STAGE(PG8_SB(0, 1), b2_1, voffB); PG8_STAGE(PG8_SA(0, 0), a2_0, sv0);
            PG8_WAIT_V8R(rx); PG8_WAIT_L(0); PG8_BAR; PG8_MMA(1, 0, At, B0); PG8_MMA(1, 1, At, B1); PG8_BAR; PG8_SCHED;
            PG8_LDB(B0, 1, 0); PG8_LDB(B1, 1, 1); PG8_SCHED; PG8_LDA(At, 1, 0); PG8_STAGE(PG8_SA(0, 1), a2_1, sv1);
            PG8_WAIT_V(8); PG8_WAIT_L(0); PG8_BAR; PG8_MMA(0, 0, At, B0); PG8_MMA(0, 1, At, B1); PG8_BAR; PG8_SCHED;
            PG8_LDA(At, 1, 1); PG8_STAGE(PG8_SB(1, 0), b3_0, voffB); PG8_STAGE(PG8_SB(1, 1), b3_1, voffB); PG8_STAGE(PG8_SA(1, 0), a3_0, sv0);
            PG8_WAIT_V(8); PG8_WAIT_L(0); PG8_BAR; PG8_MMA(1, 0, At, B0); PG8_MMA(1, 1, At, B1); PG8_BAR; PG8_SCHED;
            (void)a3_1; (void)b3_1;
        }
        if (wr == 0) PG8_BAR;
        if constexpr (F8) { asm volatile("s_nop 15\n\ts_nop 15\n\ts_nop 7" ::: "memory"); }
        E(acc, cur, wr, wc, fr, fq);
        if (!has_next) break;
#pragma unroll
        for (int a = 0; a < 2; ++a)
#pragma unroll
            for (int b = 0; b < 2; ++b)
#pragma unroll
                for (int m = 0; m < 4; ++m)
#pragma unroll
                    for (int n = 0; n < 2; ++n) acc[a][b][m][n] = (f32x4){0.f, 0.f, 0.f, 0.f};
        cur = nxt; ++ui;
#pragma unroll
        for (int _h = 0; _h < 2; ++_h)
#pragma unroll
            for (int _i = 0; _i < 2; ++_i) cvA[_h][_i] = nvA[_h][_i];
        if (wr == 1) PG8_BAR;
    }
    PG8_WAIT_V(0);
    PG8_BAR;
#undef PG8_SA
#undef PG8_SB
#undef PG8_STAGE
#undef PG8_LDA
#undef PG8_LDB
#undef PG8_MMA
#undef PG8_LD8
#undef PG8_WAIT_V
#undef PG8_WAIT_V8R
#undef PG8_WAIT_L
#undef PG8_BAR
#undef PG8_SCHED
#undef PG8_VOFF
}
}

namespace pg8 {

struct DenseOrder {
    static constexpr bool GATHER = false;
    const bf16_t* A; const bf16_t* Bt; int nM, nN, nwg, G, c;
    __device__ __forceinline__ void init(const bf16_t* A_, const bf16_t* Bt_, int M, int N, int G_, int c_) { A = A_; Bt = Bt_; nM = M / BM; nN = N / BM; nwg = nM * nN; G = G_; c = c_; }
    __device__ __forceinline__ bool next(int i, Unit& u) const {
        const long L = (long)i * G + c; if (L >= nwg) return false;
        int wgid = (int)L; { const int q = nwg / NXCD, r = nwg % NXCD, xcd = wgid % NXCD, off = wgid / NXCD; wgid = (xcd < r ? xcd * (q + 1) : r * (q + 1) + (xcd - r) * q) + off; }
        const int nig = WGM * nN, gid = wgid / nig, fm = gid * WGM, gsz = (nM - fm) < WGM ? (nM - fm) : WGM;
        u.pm = fm + ((wgid % nig) % gsz); u.pn = (wgid % nig) / gsz; u.e = 0; u.ord = i;
        u.A0 = (const char*)A + (size_t)u.pm * BM * GK * 2; u.A1 = u.A0 + (size_t)HALF * GK * 2;
        u.B0 = (const char*)Bt + (size_t)u.pn * BM * GK * 2; u.B1 = u.B0 + (size_t)HALF * GK * 2;
        return true;
    }
    __device__ __forceinline__ int row_of(const Unit&, int r) const { return r; }
    __device__ __forceinline__ const int* row_ptr(const Unit&, int) const { return nullptr; }
};
struct UpOrder {
    static constexpr bool GATHER = true;
    const unsigned char* H2; const unsigned char* WupT; const int* row_tok; const PG8_LAS int* mt_exp; int nunits, G, c;
    __device__ __forceinline__ bool next(int i, Unit& u) const {
        const int L = i * G + c; if (L >= nunits) return false;
        u.pm = L >> 3; u.pn = L & 7; u.e = __builtin_amdgcn_readfirstlane(mt_exp[u.pm]); u.ord = i;
        u.A0 = (const char*)H2; u.A1 = (const char*)H2;
        u.B0 = (const char*)WupT + ((size_t)u.e * 2 * DEXP + (size_t)u.pn * HALF) * GK; u.B1 = u.B0 + (size_t)DEXP * GK;
        return true;
    }
    __device__ __forceinline__ int row_of(const Unit& u, int r) const { return row_tok[u.pm * BM + r]; }
    __device__ __forceinline__ const int* row_ptr(const Unit& u, int r) const { return row_tok + u.pm * BM + r; }
};
struct DownOrder {
    static constexpr bool GATHER = false;
    const unsigned char* ACT; const unsigned char* WdnT; const PG8_LAS int* mt_exp; int nunits, G, c;
    __device__ __forceinline__ bool next(int i, Unit& u) const {
        const int L = i * G + c; if (L >= nunits) return false;
        u.pm = L >> 2; u.pn = L & 3; u.e = __builtin_amdgcn_readfirstlane(mt_exp[u.pm]); u.ord = i;
        u.A0 = (const char*)ACT + (size_t)u.pm * BM * GK; u.A1 = u.A0 + (size_t)HALF * GK;
        u.B0 = (const char*)WdnT + ((size_t)u.e * DM + (size_t)u.pn * BM) * GK; u.B1 = u.B0 + (size_t)HALF * GK;
        return true;
    }
    __device__ __forceinline__ int row_of(const Unit&, int r) const { return r; }
    __device__ __forceinline__ const int* row_ptr(const Unit&, int) const { return nullptr; }
};

struct EpiProj {
    static constexpr bool PERM = true, MID = false; static constexpr int NST = 16;
    bf16_t* O; size_t tstride; float qscale;
    __device__ __forceinline__ void mid(f32x4 (&)[2][2][4][2], const Unit&, int, int, int, int) const {}
    __device__ __forceinline__ void operator()(const f32x4 (&acc)[2][2][4][2], const Unit& u, int wr, int wc, int fr, int fq) const {
        const int t = u.pn >> 1; bf16_t* base = O + (size_t)t * tstride; const float sc = (t == 2) ? qscale : 1.f;
        const int row0 = u.pm * BM + wr * 64 + fr, col0 = (u.pn & 1) * BM + wc * 32 + 8 * fq;
#pragma unroll
        for (int ai = 0; ai < 2; ++ai)
#pragma unroll
            for (int m = 0; m < 4; ++m) { bf16_t* rowp = base + (size_t)(row0 + ai * HALF + m * 16) * 512 + col0;
#pragma unroll
                for (int bj = 0; bj < 2; ++bj) { const f32x4 v0 = acc[ai][bj][m][0] * sc, v1 = acc[ai][bj][m][1] * sc;
                    u32x4 w; w.x = cvt_pk_bf16(v0[0], v0[1]); w.y = cvt_pk_bf16(v0[2], v0[3]); w.z = cvt_pk_bf16(v1[0], v1[1]); w.w = cvt_pk_bf16(v1[2], v1[3]);
                    *(u32x4*)(rowp + bj * HALF) = w; } }
    }
};
struct EpiOut {
    static constexpr bool PERM = true, MID = true; static constexpr int NST = 0;
    bf16_t* Y; const float* ssq;
    __device__ __forceinline__ void mid(f32x4 (&acc)[2][2][4][2], const Unit& u, int wr, int wc, int fr, int fq) const {
#pragma unroll
        for (int ai = 0; ai < 2; ++ai)
#pragma unroll
            for (int m = 0; m < 4; ++m) { const int row = u.pm * BM + ai * HALF + wr * 64 + m * 16 + fr;
                const f32x4 s0 = *(const f32x4*)(ssq + (size_t)row * 8), s1 = *(const f32x4*)(ssq + (size_t)row * 8 + 4);
                const float tot = ((s0[0] + s0[1]) + (s0[2] + s0[3])) + ((s1[0] + s1[1]) + (s1[2] + s1[3]));
                const float ri = 1.0f / sqrtf(tot * (1.0f / DATT) + RMS_EPS);
#pragma unroll
                for (int bj = 0; bj < 2; ++bj)
#pragma unroll
                    for (int n = 0; n < 2; ++n) acc[ai][bj][m][n] = acc[ai][bj][m][n] * ri; }
    }
    __device__ __forceinline__ void operator()(const f32x4 (&acc)[2][2][4][2], const Unit& u, int wr, int wc, int fr, int fq) const {
        const int row0 = u.pm * BM + wr * 64 + fr, col0 = u.pn * BM + wc * 32 + 8 * fq;
#pragma unroll
        for (int ai = 0; ai < 2; ++ai)
#pragma unroll
            for (int m = 0; m < 4; ++m) { bf16_t* rowp = Y + (size_t)(row0 + ai * HALF + m * 16) * DM + col0;
#pragma unroll
                for (int bj = 0; bj < 2; ++bj) { const f32x4 v0 = acc[ai][bj][m][0], v1 = acc[ai][bj][m][1];
                    u32x4 w; w.x = cvt_pk_bf16(v0[0], v0[1]); w.y = cvt_pk_bf16(v0[2], v0[3]); w.z = cvt_pk_bf16(v1[0], v1[1]); w.w = cvt_pk_bf16(v1[2], v1[3]);
                    *(u32x4*)(rowp + bj * HALF) = w; } }
    }
};
template <bool STORE = true> struct EpiUpT {
    static constexpr bool PERM = true, MID = false; static constexpr int NST = STORE ? 8 : 0;
    unsigned char* ACT; const PG8_LAS float* bias;
    __device__ __forceinline__ void mid(f32x4 (&)[2][2][4][2], const Unit&, int, int, int, int) const {}
    __device__ __forceinline__ void operator()(const f32x4 (&acc)[2][2][4][2], const Unit& u, int wr, int wc, int fr, int fq) const {
        const int row0 = u.pm * BM + wr * 64 + fr, col0 = u.pn * HALF + wc * 32 + 8 * fq;
        const PG8_LAS float* bg = bias + u.ord * 256 + wc * 32 + 8 * fq;
        f32x4 bgl[2], bli[2];
#pragma unroll
        for (int n = 0; n < 2; ++n) { bgl[n] = *(const PG8_LAS f32x4*)(bg + 4 * n); bli[n] = *(const PG8_LAS f32x4*)(bg + HALF + 4 * n) + 1.0f; }
#pragma unroll
        for (int ai = 0; ai < 2; ++ai)
#pragma unroll
            for (int m = 0; m < 4; ++m) { unsigned char* rowp = ACT + (size_t)(row0 + ai * HALF + m * 16) * DEXP + col0;
                f32x4 o[2];
#pragma unroll
                for (int n = 0; n < 2; ++n) { f32x4 g = acc[ai][0][m][n] + bgl[n], l = acc[ai][1][m][n] + bli[n];
#pragma unroll
                    for (int j = 0; j < 4; ++j) { g[j] = fminf(g[j], 7.0f); l[j] = __builtin_amdgcn_fmed3f(l[j], -6.0f, 8.0f); }
                    f32x4 t = g * (-1.702f * 1.4426950408889634f);
#pragma unroll
                    for (int j = 0; j < 4; ++j) t[j] = __builtin_amdgcn_exp2f(t[j]);
                    t = t + 1.0f;
#pragma unroll
                    for (int j = 0; j < 4; ++j) t[j] = __builtin_amdgcn_rcpf(t[j]);
                    o[n] = (g * t) * l; }
                int w0 = 0, w1 = 0; w0 = __builtin_amdgcn_cvt_pk_fp8_f32(o[0][0], o[0][1], w0, false); w0 = __builtin_amdgcn_cvt_pk_fp8_f32(o[0][2], o[0][3], w0, true);
                w1 = __builtin_amdgcn_cvt_pk_fp8_f32(o[1][0], o[1][1], w1, false); w1 = __builtin_amdgcn_cvt_pk_fp8_f32(o[1][2], o[1][3], w1, true);
                typedef int i32x2_ __attribute__((ext_vector_type(2))); if (STORE) *(i32x2_*)rowp = (i32x2_){w0, w1}; else asm volatile("" :: "v"(w0), "v"(w1)); }
    }
};
typedef EpiUpT<true> EpiUp;
struct EpiDown {
    static constexpr bool PERM = true, MID = false; static constexpr int NST = 16;
    unsigned char* YP; const PG8_LAS float* bias; const int* row_pair; const float* row_w;
    __device__ __forceinline__ void mid(f32x4 (&)[2][2][4][2], const Unit&, int, int, int, int) const {}
    __device__ __forceinline__ void operator()(const f32x4 (&acc)[2][2][4][2], const Unit& u, int wr, int wc, int fr, int fq) const {
        const int row0 = u.pm * BM + wr * 64 + fr, col0 = u.pn * BM + wc * 32 + 8 * fq;
        const PG8_LAS float* bd = bias + u.ord * 256 + wc * 32 + 8 * fq;
        f32x4 bv[2][2];
#pragma unroll
        for (int bj = 0; bj < 2; ++bj)
#pragma unroll
            for (int n = 0; n < 2; ++n) bv[bj][n] = *(const PG8_LAS f32x4*)(bd + bj * HALF + 4 * n);
        int pr[2][4]; float wt[2][4];
#pragma unroll
        for (int ai = 0; ai < 2; ++ai)
#pragma unroll
            for (int m = 0; m < 4; ++m) { const int pos = row0 + ai * HALF + m * 16; pr[ai][m] = row_pair[pos]; wt[ai][m] = row_w[pos] * 4.0f; }
#pragma unroll
        for (int ai = 0; ai < 2; ++ai)
#pragma unroll
            for (int m = 0; m < 4; ++m) { const int pair = pr[ai][m] >= 0 ? pr[ai][m] : NTOK * TOPK; const float w = wt[ai][m];
                { unsigned char* rowp = YP + (size_t)pair * DM + col0;
#pragma unroll
                    for (int bj = 0; bj < 2; ++bj) { const f32x4 v0 = (acc[ai][bj][m][0] + bv[bj][0]) * w, v1 = (acc[ai][bj][m][1] + bv[bj][1]) * w;
                        int q0 = 0, q1 = 0; q0 = __builtin_amdgcn_cvt_pk_fp8_f32(v0[0], v0[1], q0, false); q0 = __builtin_amdgcn_cvt_pk_fp8_f32(v0[2], v0[3], q0, true);
                        q1 = __builtin_amdgcn_cvt_pk_fp8_f32(v1[0], v1[1], q1, false); q1 = __builtin_amdgcn_cvt_pk_fp8_f32(v1[2], v1[3], q1, true);
                        typedef int i32x2_ __attribute__((ext_vector_type(2))); *(i32x2_*)(rowp + bj * HALF) = (i32x2_){q0, q1}; } } }
    }
};
#ifdef MK_PROBES
struct EpiNop {
    static constexpr bool PERM = true, MID = false; static constexpr int NST = 0;
    __device__ __forceinline__ void mid(f32x4 (&)[2][2][4][2], const Unit&, int, int, int, int) const {}
    __device__ __forceinline__ void operator()(const f32x4 (&)[2][2][4][2], const Unit&, int, int, int, int) const {}
};
#endif
}

namespace attn_body {
using bf16=__hip_bfloat16;
using bf16x8=__attribute__((ext_vector_type(8)))short;
using s16x4=__attribute__((ext_vector_type(4)))short;
using f32x16=__attribute__((ext_vector_type(16)))float;
using u32x4=__attribute__((ext_vector_type(4)))unsigned;
constexpr int BATCH=8,NHEAD=8,SEQ=2048,D=64,DM=NHEAD*D,OPITCH=1024;
constexpr int NW=8,QBLK=32,QB=QBLK*NW,KVBLK=64,NQB=SEQ/QB;
constexpr int ATTN_PITCH=DM, ATTN_UNIT_ROWS=QB;
__device__ __forceinline__ int crow(int r,int hi){return (r&3)+8*(r>>2)+4*hi;}
#define SBAR() __builtin_amdgcn_sched_barrier(0)
__device__ __forceinline__ void cmask(f32x16&p0,f32x16&p1,int jb,int qrel,int hi){
  const float NEG=-INFINITY; int kb=64*jb+4*hi;
  #pragma unroll
  for(int r=0;r<16;++r){int kv=kb+(r&3)+8*(r>>2); if(kv>qrel)p0[r]=NEG; if(kv+32>qrel)p1[r]=NEG;}
}

constexpr int NSLOT=3, SLOTB=8192;
constexpr int LDS_K=0, LDS_V=NSLOT*SLOTB, LDS_WS=2*NSLOT*SLOTB, LDS_OST=LDS_WS+NW*64*4, LDS_BIAS=LDS_OST+NW*4096, LDS_SCAN=LDS_BIAS+(SEQ+64)*4, LDS_BYTES=LDS_SCAN+256;
constexpr float C2=0.125f*1.4426950408889634f;
__device__ __forceinline__ void glds16(const void*gsrc,unsigned lds_dst){unsigned keep;
  asm volatile("s_mov_b32 %0, m0\n\ts_mov_b32 m0, %2\n\ts_nop 0\n\tglobal_load_lds_dwordx4 %1, off\n\ts_mov_b32 m0, %0":"=&s"(keep):"v"(gsrc),"s"(lds_dst):"memory");}
__device__ __forceinline__ float max3f(float a,float b,float c){float r;asm("v_max3_f32 %0, %1, %2, %3":"=v"(r):"v"(a),"v"(b),"v"(c));return r;}
__device__ __forceinline__ float max2f(float a,float b){float r;asm("v_max_f32_e32 %0, %1, %2":"=v"(r):"v"(a),"v"(b));return r;}
__device__ __forceinline__ float fadd_s(float a,float b){float r;asm("v_add_f32_e32 %0, %1, %2":"=v"(r):"v"(a),"v"(b));return r;}
__device__ __forceinline__ float fsub_s(float a,float b){float r;asm("v_sub_f32_e32 %0, %1, %2":"=v"(r):"v"(a),"v"(b));return r;}
typedef float f32x2_t __attribute__((ext_vector_type(2))); typedef float f32x4_t __attribute__((ext_vector_type(4))); typedef __bf16 bf16x2_t __attribute__((ext_vector_type(2)));
__device__ __forceinline__ unsigned cvtpk_s(float lo,float hi){f32x2_t v={lo,hi};bf16x2_t b=__builtin_convertvector(v,bf16x2_t);return __builtin_bit_cast(unsigned,b);}
#define WAIT_BAR(N) asm volatile("s_waitcnt vmcnt(" #N ") lgkmcnt(0)\n\ts_barrier":::"memory")

__device__ __forceinline__ void qkt(f32x16&p0,f32x16&p1,const char*Kslot,const bf16x8*qr,int r32,int hi){
  const char*kb=Kslot+hi*1024+r32*16;
  #pragma unroll
  for(int d0=0;d0<4;++d0){
    const bf16x8 b0=*reinterpret_cast<const bf16x8*>(kb+d0*2048);
    const bf16x8 b1=*reinterpret_cast<const bf16x8*>(kb+d0*2048+512);
    p0=__builtin_amdgcn_mfma_f32_32x32x16_bf16(b0,qr[d0],p0,0,0,0);p1=__builtin_amdgcn_mfma_f32_32x32x16_bf16(b1,qr[d0],p1,0,0,0);}
}
typedef __attribute__((address_space(3))) const char* lds_cptr;
typedef short v4i16_t __attribute__((ext_vector_type(4)));
__device__ __forceinline__ void kload8(bf16x8*kf,lds_cptr kp){
  kf[0]=*(const __attribute__((address_space(3))) bf16x8*)(kp);      kf[1]=*(const __attribute__((address_space(3))) bf16x8*)(kp+512);
  kf[2]=*(const __attribute__((address_space(3))) bf16x8*)(kp+2048); kf[3]=*(const __attribute__((address_space(3))) bf16x8*)(kp+2560);
  kf[4]=*(const __attribute__((address_space(3))) bf16x8*)(kp+4096); kf[5]=*(const __attribute__((address_space(3))) bf16x8*)(kp+4608);
  kf[6]=*(const __attribute__((address_space(3))) bf16x8*)(kp+6144); kf[7]=*(const __attribute__((address_space(3))) bf16x8*)(kp+6656);
}
__device__ __forceinline__ void kload2(bf16x8*kf,lds_cptr kp,int j){ kf[2*j]=*(const __attribute__((address_space(3))) bf16x8*)(kp+j*2048); kf[2*j+1]=*(const __attribute__((address_space(3))) bf16x8*)(kp+j*2048+512); }
__device__ __forceinline__ s16x4 vtr(lds_cptr p){ return __builtin_bit_cast(s16x4,__builtin_amdgcn_ds_read_tr16_b64_v4i16((__attribute__((address_space(3))) v4i16_t*)p)); }
__device__ __forceinline__ float rowmax(const f32x16&p0,const f32x16&p1){
  float a=max3f(p0[0],p0[1],p1[0]),b=max3f(p0[2],p0[3],p1[1]);a=max3f(a,p1[2],p1[3]);
  #pragma unroll
  for(int r=4;r<16;r+=4){a=max3f(a,p0[r],p0[r+1]);b=max3f(b,p0[r+2],p0[r+3]);a=max3f(a,p1[r],p1[r+1]);b=max3f(b,p1[r+2],p1[r+3]);}
  const float m=max2f(a,b);
  auto rr=__builtin_amdgcn_permlane32_swap(__float_as_uint(m),__float_as_uint(m),false,false);
  return max2f(__uint_as_float(rr[0]),__uint_as_float(rr[1]));
}
__device__ __forceinline__ void pv(f32x16*o,int vb,bf16x8 pa0,bf16x8 pa1,bf16x8 pa2,bf16x8 pa3){
  #pragma unroll
  for(int d0=0;d0<2;++d0){s16x4 lo[4],hi[4];
    #pragma unroll
    for(int ks=0;ks<4;++ks){
      asm volatile("ds_read_b64_tr_b16 %0,%1 offset:%c2":"=&v"(lo[ks]):"v"(vb),"i"(d0*4096+ks*1024):"memory");
      asm volatile("ds_read_b64_tr_b16 %0,%1 offset:%c2":"=&v"(hi[ks]):"v"(vb),"i"(d0*4096+ks*1024+512):"memory");}
    asm volatile("s_waitcnt lgkmcnt(0)":::"memory");SBAR();
    #define PK(k) (bf16x8){lo[k][0],lo[k][1],lo[k][2],lo[k][3],hi[k][0],hi[k][1],hi[k][2],hi[k][3]}
    o[d0]=__builtin_amdgcn_mfma_f32_32x32x16_bf16(pa0,PK(0),o[d0],0,0,0);
    o[d0]=__builtin_amdgcn_mfma_f32_32x32x16_bf16(pa1,PK(1),o[d0],0,0,0);
    o[d0]=__builtin_amdgcn_mfma_f32_32x32x16_bf16(pa2,PK(2),o[d0],0,0,0);
    o[d0]=__builtin_amdgcn_mfma_f32_32x32x16_bf16(pa3,PK(3),o[d0],0,0,0);
    #undef PK
  }
}

#ifndef ATTN_STORE16
#define ATTN_STORE16(p,v) (*(u32x4*)(p)=(v))
#endif
template<int THRL> __device__ __forceinline__ void attn_unit(int b,int h,int qb,const bf16*Q,const bf16*__restrict__ K,const bf16*__restrict__ V,bf16*O,const float*__restrict__ LOGF2,float*SSQ,char*shm){
  const int tid=threadIdx.x,lane=tid&63,r32=lane&31,hi=lane>>5; const int wid=__builtin_amdgcn_readfirstlane(tid>>6);
  const long rowbase=(long)b*SEQ; const int q0=qb*QB;
  const bf16*Qw=Q+(rowbase+q0+wid*QBLK)*DM+h*D;
  const bf16*Kh=K+rowbase*DM+h*D,*Vh=V+rowbase*DM+h*D;
  const unsigned lds0=(unsigned)(uintptr_t)shm;
  float*wsf=(float*)(shm+LDS_WS)+wid*64;
  const bf16*ksrc=Kh+(long)lane*DM+wid*8;
  const bf16*vsrc=Vh+(long)(16*(wid&3)+(lane>>2))*DM+(wid>>2)*32+(lane&3)*8;
  const unsigned kdst=lds0+LDS_K+wid*1024, vdst=lds0+LDS_V+wid*1024;
  #define DMA_K(t,slot) glds16(ksrc+(long)(t)*KVBLK*DM,(unsigned)__builtin_amdgcn_readfirstlane(kdst+(slot)))
  #define DMA_V(t,slot) glds16(vsrc+(long)(t)*KVBLK*DM,(unsigned)__builtin_amdgcn_readfirstlane(vdst+(slot)))
  const int vb0=(int)(lds0+LDS_V)+((lane>>4)&1)*32+(lane&3)*8+(4*hi+((lane&15)>>2))*64;
  const char*Kbase=shm+LDS_K; bf16x8 kf[8];
  const lds_cptr shm3=(lds_cptr)shm; const lds_cptr kp0=shm3+LDS_K+hi*1024+r32*16; const lds_cptr vp0=shm3+LDS_V+((lane>>4)&1)*32+(lane&3)*8+(4*hi+((lane&15)>>2))*64;
  const int NT=(q0+QB)/KVBLK;
  { float*biasl=(float*)(shm+LDS_BIAS); float*scn=(float*)(shm+LDS_SCAN);
    const float*lf=LOGF2+rowbase*NHEAD+h;
    float v0=0.f,v1=0.f,v2=0.f,v3=0.f; const int i0=4*tid;
    if(i0<q0){ v0=lf[(long)(q0-1-i0)*NHEAD]; v1=lf[(long)(q0-2-i0)*NHEAD]; v2=lf[(long)(q0-3-i0)*NHEAD]; v3=lf[(long)(q0-4-i0)*NHEAD]; }
    const float tsum=(v0+v1)+(v2+v3); float inc=tsum;
    #pragma unroll
    for(int o=1;o<64;o<<=1){ const float n_=__shfl_up(inc,o); if(lane>=o)inc+=n_; }
    if(lane==63)scn[wid]=inc;
    const float f0=lf[(long)(q0+4*lane)*NHEAD],f1=lf[(long)(q0+4*lane+1)*NHEAD],f2=lf[(long)(q0+4*lane+2)*NHEAD],f3=lf[(long)(q0+4*lane+3)*NHEAD];
    float finc=(f0+f1)+(f2+f3);
    #pragma unroll
    for(int o=1;o<64;o<<=1){ const float n_=__shfl_up(finc,o); if(lane>=o)finc+=n_; }
    const float fex=finc-((f0+f1)+(f2+f3));
    if(wid==0){ biasl[q0+4*lane]=-(fex+f0); biasl[q0+4*lane+1]=-(fex+f0+f1); biasl[q0+4*lane+2]=-(fex+f0+f1+f2); biasl[q0+4*lane+3]=-(fex+f0+f1+f2+f3); }
    __syncthreads();
    float woff=0.f;
    #pragma unroll
    for(int w_=0;w_<NW;++w_) woff+=(w_<wid)?scn[w_]:0.f;
    const float ex=woff+inc-tsum;
    if(i0<q0){ biasl[q0-1-i0]=ex; biasl[q0-2-i0]=ex+v0; biasl[q0-3-i0]=ex+v0+v1; biasl[q0-4-i0]=ex+v0+v1+v2; }
    __syncthreads(); }
  const lds_cptr biasr=(lds_cptr)shm+LDS_BIAS+16*hi;
  #define BIAS4(t,o) (*(const __attribute__((address_space(3))) f32x4_t*)(biasr+(t)*(KVBLK*4)+(o)*4))
  #define INIT4(Y,g,t,o) do{ const f32x4_t x_=BIAS4(t,(o)+8*(g)); Y[4*(g)]=x_[0]-mhat; Y[4*(g)+1]=x_[1]-mhat; Y[4*(g)+2]=x_[2]-mhat; Y[4*(g)+3]=x_[3]-mhat; }while(0)
  #define INITT(Y0,Y1,t) do{ INIT4(Y0,0,t,0);INIT4(Y0,1,t,0);INIT4(Y0,2,t,0);INIT4(Y0,3,t,0); INIT4(Y1,0,t,32);INIT4(Y1,1,t,32);INIT4(Y1,2,t,32);INIT4(Y1,3,t,32); }while(0)
  DMA_K(0,0);DMA_V(0,0);DMA_K(1,SLOTB);
  bf16x8 qr[4];
  #pragma unroll
  for(int d0=0;d0<4;++d0)qr[d0]=*reinterpret_cast<const bf16x8*>(&Qw[(long)r32*DM+d0*16+hi*8]);
  float mhat=((const float*)(shm+LDS_BIAS))[q0+wid*QBLK+r32]+8.0f,l_reg=0.f;f32x16 o[2];o[0]=f32x16{};o[1]=f32x16{};
  const int qrel=wid*QBLK+r32;
  #define CMASK(P0,P1,t) do{int jb_=(t)-(NT-4); if(jb_>=0)cmask(P0,P1,jb_,qrel,hi);}while(0)
  bool resc=false;
  #define START(P0,P1) do{ const float rm=rowmax(P0,P1); resc=false; \
    { const float dl=__builtin_fmaxf(rm,0.f); mhat=fadd_s(mhat,dl); \
      _Pragma("unroll") for(int r=0;r<16;++r){P0[r]=fsub_s(P0[r],dl);P1[r]=fsub_s(P1[r],dl);} } \
    _Pragma("unroll") for(int r=0;r<16;++r)P0[r]=__builtin_amdgcn_exp2f(P0[r]); }while(0)
  #define RESC() do{ if(resc){ asm volatile("s_waitcnt lgkmcnt(0)":::"memory"); \
      _Pragma("unroll") for(int d_=0;d_<2;++d_) _Pragma("unroll") for(int r=0;r<16;++r)o[d_][r]*=wsf[crow(r,hi)]; } }while(0)
  f32x16 pA0,pA1,pB0,pB1;
  int sl_prev=0,sl_cur=0,sl_next=SLOTB;
  #define ROT() do{sl_prev=sl_cur;sl_cur=sl_next;sl_next=(sl_next==(NSLOT-1)*SLOTB)?0:sl_next+SLOTB;}while(0)
  DMA_K(2,2*SLOTB);
  WAIT_BAR(3);
  INITT(pA0,pA1,0); qkt(pA0,pA1,Kbase,qr,r32,hi);asm volatile("s_nop 15\n\ts_nop 7":"+v"(pA0),"+v"(pA1));CMASK(pA0,pA1,0);
  START(pA0,pA1);
  _Pragma("unroll") for(int r=0;r<16;++r)pA1[r]=__builtin_amdgcn_exp2f(pA1[r]);
  INITT(pB0,pB1,1);
  WAIT_BAR(0);
  DMA_K(3,0);DMA_V(1,SLOTB);
  ROT();
  kload8(kf,kp0+sl_cur);
  WAIT_BAR(2);
  s16x4 vlo[8],vhi[8]; u32x4 pw0,pw1,pw2,pw3;
  #define PKW(P,B) cvtpk_s(P[B],P[B+1])
  #define PAF(k) __builtin_bit_cast(bf16x8,pw##k)
  #define VFR(i) (bf16x8){vlo[i][0],vlo[i][1],vlo[i][2],vlo[i][3],vhi[i][0],vhi[i][1],vhi[i][2],vhi[i][3]}
  #define PIN(x) asm volatile("":"+v"(x))
  #define MX3(a,b,c) __builtin_fmaxf(__builtin_fmaxf((a),(b)),(c))
  #define GAPA(MF,A0,A1,A2,A3,W0,W1,PW) do{ MF; sacc+=A0; sacc+=A1; sacc+=A2; sacc+=A3; PIN(sacc); W0; W1; PIN(PW); SBAR(); }while(0)
  #define EX(v) __builtin_amdgcn_exp2f(v)
  #define GAPB(MF,X,B,GN,Y,tn,o) do{ MF; X[B]=EX(X[B]); X[B+1]=EX(X[B+1]); X[B+2]=EX(X[B+2]); X[B+3]=EX(X[B+3]); PIN(X); if(GN){ INIT4(Y,(B)/4,tn,o); PIN(Y); } SBAR(); }while(0)
  #define VRD(i) do{ vlo[i]=vtr(vp_+(((i)>>2)*4096+((i)&3)*1024)); vhi[i]=vtr(vp_+(((i)>>2)*4096+((i)&3)*1024+512)); }while(0)
  #define KRD(G,j) do{ if(G){ kload2(kf,kp0+sl_next,j); SBAR(); } }while(0)
  #define STEP(C0,C1,P0,P1,t,GK,GV,GL) do{ SBAR(); \
    const lds_cptr vp_=vp0+sl_prev; \
    VRD(0); SBAR(); float sacc=(P0[0]+P0[1]); \
    GAPA(C0=__builtin_amdgcn_mfma_f32_32x32x16_bf16(kf[0],qr[0],C0,0,0,0), P0[2],P0[3],P0[4],P0[5],     pw0[0]=PKW(P0,0), pw0[1]=PKW(P0,2), pw0); \
    VRD(4); SBAR(); GAPA(C1=__builtin_amdgcn_mfma_f32_32x32x16_bf16(kf[1],qr[0],C1,0,0,0), P0[6],P0[7],P0[8],P0[9],     pw0[2]=PKW(P0,4), pw0[3]=PKW(P0,6), pw0); \
    VRD(1); SBAR(); GAPA(C0=__builtin_amdgcn_mfma_f32_32x32x16_bf16(kf[2],qr[1],C0,0,0,0),   P0[10],P0[11],P0[12],P0[13], pw1[0]=PKW(P0,8), pw1[1]=PKW(P0,10), pw1); \
    VRD(5); SBAR(); GAPA(C1=__builtin_amdgcn_mfma_f32_32x32x16_bf16(kf[3],qr[1],C1,0,0,0),   P0[14],P0[15],P1[0],P1[1],   pw1[2]=PKW(P0,12),pw1[3]=PKW(P0,14), pw1); \
    VRD(2); SBAR(); GAPA(C0=__builtin_amdgcn_mfma_f32_32x32x16_bf16(kf[4],qr[2],C0,0,0,0),   P1[2],P1[3],P1[4],P1[5],     pw2[0]=PKW(P1,0), pw2[1]=PKW(P1,2), pw2); \
    VRD(6); SBAR(); GAPA(C1=__builtin_amdgcn_mfma_f32_32x32x16_bf16(kf[5],qr[2],C1,0,0,0),   P1[6],P1[7],P1[8],P1[9],     pw2[2]=PKW(P1,4), pw2[3]=PKW(P1,6), pw2); \
    VRD(3); SBAR(); GAPA(C0=__builtin_amdgcn_mfma_f32_32x32x16_bf16(kf[6],qr[3],C0,0,0,0),   P1[10],P1[11],P1[12],P1[13], pw3[0]=PKW(P1,8), pw3[1]=PKW(P1,10), pw3); \
    VRD(7); SBAR(); GAPA(C1=__builtin_amdgcn_mfma_f32_32x32x16_bf16(kf[7],qr[3],C1,0,0,0),   P1[14],P1[15],0.f,0.f,       pw3[2]=PKW(P1,12),pw3[3]=PKW(P1,14), pw3); \
    l_reg+=sacc; \
    if(GK){DMA_K((t)+3,sl_cur);} if(GV){DMA_V((t)+1,sl_next);} \
    CMASK(C0,C1,t); \
    { float a=MX3(C0[0],C0[1],C1[0]),b=MX3(C0[2],C0[3],C1[1]); a=MX3(a,C1[2],C1[3]); \
      _Pragma("unroll") for(int r=4;r<16;r+=4){a=MX3(a,C0[r],C0[r+1]);b=MX3(b,C0[r+2],C0[r+3]);a=MX3(a,C1[r],C1[r+1]);b=MX3(b,C1[r+2],C1[r+3]);} \
      float rm=__builtin_fmaxf(a,b); { auto rr=__builtin_amdgcn_permlane32_swap(__float_as_uint(rm),__float_as_uint(rm),false,false); rm=__builtin_fmaxf(__uint_as_float(rr[0]),__uint_as_float(rr[1])); } \
      resc=false; \
      if(__builtin_expect(__any(rm>(float)THRL),0)){ const float dl=__builtin_fmaxf(rm,0.f); mhat+=dl; \
        _Pragma("unroll") for(int r=0;r<16;++r){C0[r]-=dl;C1[r]-=dl;} \
        const float f=__builtin_amdgcn_exp2f(-dl); l_reg*=f; if(hi==0)wsf[r32]=f; resc=true; } } \
    SBAR(); \
    GAPB(o[0]=__builtin_amdgcn_mfma_f32_32x32x16_bf16(PAF(0),VFR(0),o[0],0,0,0), C0,0,  GL,P0,(t)+1,0); \
    GAPB(o[1]=__builtin_amdgcn_mfma_f32_32x32x16_bf16(PAF(0),VFR(4),o[1],0,0,0), C0,4,  GL,P0,(t)+1,0); \
    KRD(GL,0); GAPB(o[0]=__builtin_amdgcn_mfma_f32_32x32x16_bf16(PAF(1),VFR(1),o[0],0,0,0), C0,8,  GL,P0,(t)+1,0); \
    KRD(GL,1); GAPB(o[1]=__builtin_amdgcn_mfma_f32_32x32x16_bf16(PAF(1),VFR(5),o[1],0,0,0), C0,12, GL,P0,(t)+1,0); \
    KRD(GL,2); GAPB(o[0]=__builtin_amdgcn_mfma_f32_32x32x16_bf16(PAF(2),VFR(2),o[0],0,0,0), C1,0,  GL,P1,(t)+1,32); \
    KRD(GL,3); GAPB(o[1]=__builtin_amdgcn_mfma_f32_32x32x16_bf16(PAF(2),VFR(6),o[1],0,0,0), C1,4,  GL,P1,(t)+1,32); \
    GAPB(o[0]=__builtin_amdgcn_mfma_f32_32x32x16_bf16(PAF(3),VFR(3),o[0],0,0,0), C1,8,  GL,P1,(t)+1,32); \
    GAPB(o[1]=__builtin_amdgcn_mfma_f32_32x32x16_bf16(PAF(3),VFR(7),o[1],0,0,0), C1,12, GL,P1,(t)+1,32); \
    }while(0)
  int t=1;
  #undef CMASK
  #define CMASK(P0,P1,t) do{}while(0)
  for(;t+5<NT;t+=2){
    STEP(pB0,pB1,pA0,pA1,t,true,true,true);     WAIT_BAR(2); RESC(); ROT();
    STEP(pA0,pA1,pB0,pB1,t+1,true,true,true);   WAIT_BAR(2); RESC(); ROT();
  }
  #undef CMASK
  #define CMASK(P0,P1,t) do{int jb_=(t)-(NT-4); if(jb_>=0)cmask(P0,P1,jb_,qrel,hi);}while(0)
  #define ENDW(tt) do{ if((tt)+3<NT){WAIT_BAR(2);} else if((tt)+2<NT){WAIT_BAR(1);} else {WAIT_BAR(0);} }while(0)
  for(;t+1<NT;t+=2){
    STEP(pB0,pB1,pA0,pA1,t,(t+3<NT),(t+1<NT),(t+1<NT));       ENDW(t);   RESC(); ROT();
    STEP(pA0,pA1,pB0,pB1,t+1,(t+4<NT),(t+2<NT),(t+2<NT));     ENDW(t+1); RESC(); ROT();
  }
  STEP(pB0,pB1,pA0,pA1,NT-1,false,false,false); RESC();
  { float sacc=pB0[0]+pB0[1]; _Pragma("unroll") for(int r=2;r<16;++r)sacc+=pB0[r]; _Pragma("unroll") for(int r=0;r<16;++r)sacc+=pB1[r]; l_reg+=sacc;
    pw0=(u32x4){PKW(pB0,0),PKW(pB0,2),PKW(pB0,4),PKW(pB0,6)};pw1=(u32x4){PKW(pB0,8),PKW(pB0,10),PKW(pB0,12),PKW(pB0,14)};pw2=(u32x4){PKW(pB1,0),PKW(pB1,2),PKW(pB1,4),PKW(pB1,6)};pw3=(u32x4){PKW(pB1,8),PKW(pB1,10),PKW(pB1,12),PKW(pB1,14)};
    SBAR(); pv(o,vb0+sl_cur,PAF(0),PAF(1),PAF(2),PAF(3)); }
  #undef PKW
  #undef PAF
  #undef VFR
  #undef PIN
  #undef MX3
  #undef GAPA
  #undef GAPB
  #undef EX
  #undef VRD
  #undef KRD
  #undef STEP
  #undef ENDW
  {auto rr=__builtin_amdgcn_permlane32_swap(__float_as_uint(l_reg),__float_as_uint(l_reg),false,false);l_reg=__uint_as_float(rr[0])+__uint_as_float(rr[1]);}
  if(hi==0)wsf[32+r32]=l_reg;asm volatile("s_waitcnt lgkmcnt(0)":::"memory");
  float rli[16];
  #pragma unroll
  for(int r=0;r<16;++r)rli[r]=__builtin_amdgcn_rcpf(wsf[32+crow(r,hi)]);
  bf16*Ow=O+(rowbase+q0+wid*QBLK)*OPITCH+h*D; float*Sw=SSQ+(rowbase+q0+wid*QBLK)*NHEAD+h;
  { bf16*stg=(bf16*)(shm+LDS_OST)+wid*2048;
    #pragma unroll
    for(int r=0;r<16;++r){const int orow=crow(r,hi);
      #pragma unroll
      for(int d0=0;d0<2;++d0)stg[orow*64+d0*32+r32]=__float2bfloat16(o[d0][r]*rli[r]);}
    asm volatile("s_waitcnt lgkmcnt(0)":::"memory");
    #pragma unroll
    for(int i=0;i<4;++i){const int row=i*8+(lane>>3),ch=lane&7; const u32x4 v=*(const u32x4*)(stg+row*64+ch*8); ATTN_STORE16(Ow+(long)row*OPITCH+ch*8,v);
      float sq=0.f;
      #pragma unroll
      for(int j=0;j<4;++j){ const float lo_=__uint_as_float(v[j]<<16), hi_=__uint_as_float(v[j]&0xffff0000u); sq+=lo_*lo_+hi_*hi_; }
      sq+=__shfl_xor(sq,1); sq+=__shfl_xor(sq,2); sq+=__shfl_xor(sq,4);
      if(ch==0)Sw[(long)row*NHEAD]=sq; } }
  asm volatile("s_waitcnt lgkmcnt(0)\n\ts_barrier":::"memory");
  #undef DMA_K
  #undef BIAS4
  #undef INIT4
  #undef INITT
  #undef DMA_V
  #undef CMASK
  #undef START
  #undef RESC
  #undef ROT
}
constexpr int ATTN_LDS_BYTES=LDS_BYTES;
struct AttnTensors { const bf16* Q; const bf16* K; const bf16* V; bf16* O; const float* LOGF2; float* SSQ; };
struct AttnUnit { int bh; int qb; };
struct StaticOrder {
  int vcu,G;
  __device__ __forceinline__ explicit StaticOrder(int grid,int vcu_):vcu(vcu_),G(grid){}
  __device__ __forceinline__ bool next(int i,AttnUnit&u)const{ const int L=(i>>1)*G+vcu; if(L>=BATCH*NHEAD*4)return false; const int s=L&3; u.bh=L>>2; u.qb=(i&1)?7-s:s; return true; }
  __device__ __forceinline__ void a_ready(const AttnUnit&)const{}
  __device__ __forceinline__ void done(const AttnUnit&)const{}
};
template<class Sched,int THRL=8> __device__ __forceinline__ void attn_phase(char*lds,const AttnTensors&T,const Sched&S){
  AttnUnit u;
  for(int i=0;S.next(i,u);++i){ S.a_ready(u); attn_unit<THRL>(u.bh/NHEAD,u.bh%NHEAD,u.qb,T.Q,T.K,T.V,T.O,T.LOGF2,T.SSQ,lds); S.done(u); }
}
#undef SBAR
#undef WAIT_BAR
}

constexpr int NWAVES = 8;
constexpr int NPHASES = 11;

constexpr size_t MiB = 1u << 20, KiB = 1u << 10;
constexpr size_t WS_CTL = 0, CTL_ZERO_BYTES = 1 * MiB;
constexpr size_t WS_MOD = 1 * MiB;
constexpr size_t WS_LOGF2 = 1 * MiB + 256 * KiB;
constexpr size_t WS_SSQ = 1 * MiB + 768 * KiB;
constexpr size_t WS_TOPI = 2 * MiB + 256 * KiB;
constexpr size_t WS_TOPW = 2 * MiB + 512 * KiB;
constexpr size_t WS_WGCNT = 2 * MiB + 768 * KiB;
constexpr size_t WS_LSUM = 3 * MiB;
constexpr size_t WS_ROWTOK = 4 * MiB, WS_ROWPAIR = 4 * MiB + 512 * KiB, WS_ROWW = 5 * MiB, WS_MTEXP = 5 * MiB + 512 * KiB;
constexpr size_t WS_LWT = 6 * MiB;
constexpr size_t WS_WFT = 6 * MiB + 512 * KiB;
constexpr size_t WS_WRT = 7 * MiB;
constexpr size_t WS_WIN = 8 * MiB;
constexpr size_t WS_WOUT = 13 * MiB;
constexpr size_t WS_WUP = 16 * MiB;
constexpr size_t WS_WDN = 144 * MiB;
constexpr size_t WS_H1 = 208 * MiB;
constexpr size_t WS_PJ = 240 * MiB;
constexpr size_t PJ_STRIDE = (size_t)NTOK * 512;
constexpr size_t WS_MRG = 320 * MiB;
constexpr size_t WS_Y = 352 * MiB;
constexpr size_t WS_H2 = 416 * MiB;
constexpr size_t WS_ACT = 448 * MiB;
constexpr size_t WS_YP = 592 * MiB;
constexpr size_t WS_LTOK = 720 * MiB, WS_LPAIR = 722 * MiB, WS_LW = 724 * MiB;
constexpr size_t WS_END = 726 * MiB;
static_assert(WS_ACT + (size_t)MAXROWS * 1024 * 2 <= WS_YP && WS_YP + (size_t)NTOK * 4 * 1024 * 2 <= WS_END, "d_ws map");
constexpr int CW_CNT = 200000;
constexpr int CW_BAR = 4096;

constexpr int LDS_BYTES = 147456;
constexpr int LDSCTL_OFF = LDS_BYTES - 512, MISC_OFF = LDSCTL_OFF + 320;
constexpr int SCRATCH_BYTES = LDSCTL_OFF;

#define GAS __attribute__((address_space(1)))
#define LAS __attribute__((address_space(3)))
typedef unsigned short bf16;
typedef unsigned v4u __attribute__((ext_vector_type(4)));
typedef unsigned v2u __attribute__((ext_vector_type(2)));
typedef float f32x4 __attribute__((ext_vector_type(4)));
typedef float f32x16 __attribute__((ext_vector_type(16)));
typedef short bf16x8 __attribute__((ext_vector_type(8)));
typedef GAS unsigned gu32;
#define RLX_AGENT __ATOMIC_RELAXED, __HIP_MEMORY_SCOPE_AGENT
#define LDS_WAIT() asm volatile("s_waitcnt lgkmcnt(0)" ::: "memory")
#define VM_WAIT() asm volatile("s_waitcnt vmcnt(0)" ::: "memory")
typedef float f32x2_cv __attribute__((ext_vector_type(2))); typedef __bf16 bf16x2_cv __attribute__((ext_vector_type(2)));
__device__ __forceinline__ unsigned pk2(float lo, float hi) { const f32x2_cv v = {lo, hi}; return __builtin_bit_cast(unsigned, __builtin_convertvector(v, bf16x2_cv)); }
__device__ __forceinline__ unsigned f2bf(float f) { return pk2(f, 0.f) & 0xffffu; }
__device__ __forceinline__ float bflo(unsigned w) { return __uint_as_float(w << 16); }
__device__ __forceinline__ float bfhi(unsigned w) { return __uint_as_float(w & 0xffff0000u); }
__device__ __forceinline__ float bf1(bf16 h) { return __uint_as_float((unsigned)h << 16); }

#define XB_TMO      128
#define XB_XCNT(j)  (256  + 64 * (j))
#define XB_XSUB(j)  (1280 + 64 * (j))
#define XB_XGEN(j)  (2304 + 64 * (j))
#define XB_TOP      3328
#define XB_TOPGEN   3392
#define XCD_BAR_WORDS 3456
#define XB_SPIN_CAP (1u << 18)
__device__ __forceinline__ unsigned xb_ld(unsigned* p)              { return __hip_atomic_load(p, __ATOMIC_RELAXED, __HIP_MEMORY_SCOPE_AGENT); }
__device__ __forceinline__ unsigned xb_add(unsigned* p, unsigned v) { return __hip_atomic_fetch_add(p, v, __ATOMIC_RELAXED, __HIP_MEMORY_SCOPE_AGENT); }
__device__ __forceinline__ unsigned xb_xcc_id() { return (unsigned)__builtin_amdgcn_s_getreg((3 << 11) | 20) & 0xFu; }
#define XB_SPIN(cond, bar) do { unsigned _sp = 0; while (cond) { __builtin_amdgcn_s_sleep(1); \
    if ((++_sp & 255u) == 0u) { if (xb_ld(&(bar)[XB_TMO])) break; if (_sp > XB_SPIN_CAP) { atomicAdd(&(bar)[XB_TMO], 1u); break; } } } } while (0)
struct XcdBarrier { unsigned* bar; unsigned x; volatile LAS unsigned* st; };
__device__ __forceinline__ XcdBarrier xcd_barrier_post(unsigned* bar, volatile LAS unsigned* st) {
    XcdBarrier b; b.bar = bar; b.x = xb_xcc_id(); b.st = st;
    if (threadIdx.x == 0) (void)xb_add(&bar[XB_XCNT(b.x)], 1u);
    return b;
}
__device__ __forceinline__ void xcd_barrier_complete(unsigned* bar, unsigned x, unsigned& nloc, unsigned& nx) {
    const unsigned G = gridDim.x * gridDim.y * gridDim.z;
    unsigned sum, cnt, mine, sp = 0u;
    for (;;) {
        sum = 0u; cnt = 0u; mine = 0u;
#pragma unroll
        for (unsigned j = 0; j < 16; ++j) { const unsigned c = xb_ld(&bar[XB_XCNT(j)]); sum += c; cnt += (c > 0u) ? 1u : 0u; mine = (j == x) ? c : mine; }
        if (sum == G) break;
        __builtin_amdgcn_s_sleep(1);
        if ((++sp & 255u) == 0u) { if (xb_ld(&bar[XB_TMO])) break; if (sp > XB_SPIN_CAP) { atomicAdd(&bar[XB_TMO], 1u); break; } }
    }
    nloc = mine > 0u ? mine : 1u; nx = cnt > 0u ? cnt : 1u;
}
__device__ __forceinline__ void xcd_barrier(const XcdBarrier& b) {
    asm volatile("s_waitcnt vmcnt(0)" ::: "memory");
    __syncthreads();
    if (threadIdx.x == 0) {
        unsigned* bar = b.bar;
        __builtin_amdgcn_s_waitcnt(0);
        unsigned nloc = b.st[0], nx = b.st[1];
        if (nloc == 0u) { xcd_barrier_complete(bar, b.x, nloc, nx); b.st[0] = nloc; b.st[1] = nx; }
        const unsigned old = xb_add(&bar[XB_XSUB(b.x)], 1u);
        const unsigned gen = old / nloc;
        if (old + 1u == (gen + 1u) * nloc) {
            __builtin_amdgcn_fence(__ATOMIC_RELEASE, "agent");
            asm volatile("s_waitcnt vmcnt(0)" ::: "memory");
            const unsigned og = xb_add(&bar[XB_TOP], 1u);
            const unsigned tg = og / nx;
            if (og + 1u == (tg + 1u) * nx) xb_add(&bar[XB_TOPGEN], 1u);
            else XB_SPIN(xb_ld(&bar[XB_TOPGEN]) == tg, bar);
            __builtin_amdgcn_fence(__ATOMIC_ACQUIRE, "agent");
            xb_add(&bar[XB_XGEN(b.x)], 1u);
            asm volatile("s_waitcnt vmcnt(0)" ::: "memory");
        } else {
            XB_SPIN(xb_ld(&bar[XB_XGEN(b.x)]) == gen, bar);
            __builtin_amdgcn_fence(__ATOMIC_ACQUIRE, "agent");
            asm volatile("s_waitcnt vmcnt(0)" ::: "memory");
        }
    }
    __syncthreads();
}

struct Args { const float* in[26]; float* out; unsigned char* ws; int ph_lo, ph_hi, li, pad; };
struct Frame {
    LAS unsigned char* lds;
    int tid, lane, wave, vcu, G;
    float* out; unsigned char* ws;
    __device__ __forceinline__ const float* in(int k) const { const LAS unsigned* t = (const LAS unsigned*)(lds + LDSCTL_OFF) + 2 * k;
        const unsigned lo = (unsigned)__builtin_amdgcn_readfirstlane((int)t[0]), hi = (unsigned)__builtin_amdgcn_readfirstlane((int)t[1]);
        return (const float*)(const GAS float*)(((unsigned long long)hi << 32) | lo); }
};
template <int CTRL> __device__ __forceinline__ float dpp_mov(float x) { return __builtin_bit_cast(float, __builtin_amdgcn_update_dpp(0, __builtin_bit_cast(int, x), CTRL, 0xF, 0xF, false)); }
__device__ __forceinline__ float lane_xor1(float x) { return dpp_mov<0xB1>(x); }
__device__ __forceinline__ float lane_xor2(float x) { return dpp_mov<0x4E>(x); }
__device__ __forceinline__ float lane_xor4(float x) { return dpp_mov<0x1B>(dpp_mov<0x141>(x)); }
__device__ __forceinline__ float lane_xor8(float x) { return dpp_mov<0x128>(x); }
__device__ __forceinline__ void swap_rows16(float& a, float& b) { asm volatile("s_nop 1\n\tv_permlane16_swap_b32 %0, %1" : "+v"(a), "+v"(b)); }
__device__ __forceinline__ void swap_half32(float& a, float& b) { asm volatile("s_nop 1\n\tv_permlane32_swap_b32 %0, %1" : "+v"(a), "+v"(b)); }
__device__ __forceinline__ float wave_sum(float v) {
    v += lane_xor1(v); v += lane_xor2(v); v += lane_xor4(v); v += lane_xor8(v);
    { float a = v, b = v; swap_rows16(a, b); v = a + b; }
    { float a = v, b = v; swap_half32(a, b); v = a + b; }
    return v;
}
__device__ __forceinline__ float wave_max(float v) {
    v = fmaxf(v, lane_xor1(v)); v = fmaxf(v, lane_xor2(v)); v = fmaxf(v, lane_xor4(v)); v = fmaxf(v, lane_xor8(v));
    { float a = v, b = v; swap_rows16(a, b); v = fmaxf(a, b); }
    { float a = v, b = v; swap_half32(a, b); v = fmaxf(a, b); }
    return v;
}
__device__ __forceinline__ float sigmoid_f(float x) { return __builtin_amdgcn_rcpf(1.0f + __builtin_amdgcn_exp2f(-1.4426950408889634f * x)); }
__device__ __forceinline__ float gelu_tanh_f(float x) { const float u = 0.7978845608028654f * (x + 0.044715f * x * x * x); const float e = __builtin_amdgcn_exp2f(2.8853900817779268f * u); return x * (1.0f - __builtin_amdgcn_rcpf(e + 1.0f)); }
__device__ __forceinline__ float log_sigmoid_f(float z) { return z >= 0.f ? -log1pf(expf(-z)) : z - log1pf(expf(z)); }
__device__ __forceinline__ float softplus_f(float z) { return z > 0.f ? z + log1pf(expf(-z)) : log1pf(expf(z)); }

__device__ __forceinline__ void p0_transpose_item(const float* W, int ldw, bf16* WT, int k0, int n0, int kdst0, const float* gain, LAS float* scr, int lane) {
#pragma unroll 8
    for (int i = 0; i < 32; ++i) { const int kk = 2 * i + (lane >> 5); float v = W[(size_t)(k0 + kk) * ldw + n0 + (lane & 31)]; if (gain) v *= gain[k0 + kk]; scr[kk * 33 + (lane & 31)] = v; }
    LDS_WAIT(); asm volatile("" ::: "memory");
    const int c = lane & 7;
#pragma unroll
    for (int j = 0; j < 4; ++j) { const int n = (lane >> 3) + 8 * j; const LAS float* s = scr + (8 * c) * 33 + n;
        v4u o; o.x = pk2(s[0 * 33], s[1 * 33]); o.y = pk2(s[2 * 33], s[3 * 33]); o.z = pk2(s[4 * 33], s[5 * 33]); o.w = pk2(s[6 * 33], s[7 * 33]);
        *(GAS v4u*)(WT + (size_t)(n0 + n) * 1024 + kdst0 + 8 * c) = o; }
    LDS_WAIT(); asm volatile("" ::: "memory");
}
constexpr int CV_UP_ITEMS = NE * 16 * 32, CV_DN_ITEMS = NE * 16 * 16;
constexpr int CV_UP_TAIL = 8192, CV_DN_TAIL = 4096;
__device__ __forceinline__ void cvt_block_f8(const float* W, int ldw, unsigned char* WT, LAS unsigned char* scr, int lane) {
    float v[64];
#pragma unroll
    for (int i = 0; i < 64; ++i) v[i] = W[(size_t)i * ldw + lane];
#pragma unroll
    for (int q = 0; q < 4; ++q) { int w[4];
#pragma unroll
        for (int j = 0; j < 4; ++j) { int t = 0; t = __builtin_amdgcn_cvt_pk_fp8_f32(v[16 * q + 4 * j] * 64.0f, v[16 * q + 4 * j + 1] * 64.0f, t, false); t = __builtin_amdgcn_cvt_pk_fp8_f32(v[16 * q + 4 * j + 2] * 64.0f, v[16 * q + 4 * j + 3] * 64.0f, t, true); w[j] = t; }
        *(LAS v4u*)(scr + lane * 80 + 16 * q) = (v4u){(unsigned)w[0], (unsigned)w[1], (unsigned)w[2], (unsigned)w[3]}; }
    LDS_WAIT(); asm volatile("" ::: "memory");
#pragma unroll
    for (int j = 0; j < 4; ++j) { const int row = 16 * j + (lane >> 2), c = lane & 3;
        *(GAS v4u*)(WT + (size_t)row * 1024 + 16 * c) = *(const LAS v4u*)(scr + row * 80 + 16 * c); }
    LDS_WAIT(); asm volatile("" ::: "memory");
}
__device__ __forceinline__ void cvt_up_item(Frame& F, int u) { const int e = u >> 9, q = u & 511, kb = q >> 5, nb = q & 31;
    cvt_block_f8(F.in(22) + (size_t)e * DM * 2 * DEXP + (size_t)(64 * kb) * (2 * DEXP) + 64 * nb, 2 * DEXP, (unsigned char*)(F.ws + WS_WUP) + ((size_t)e * 2 * DEXP + 64 * nb) * 1024 + 64 * kb, F.lds + F.wave * 16384, F.lane); }
__device__ __forceinline__ void cvt_dn_item(Frame& F, int d) { const int e = d >> 8, q = d & 255, kb = q >> 4, nb = q & 15;
    cvt_block_f8(F.in(24) + (size_t)e * DEXP * DM + (size_t)(64 * kb) * DM + 64 * nb, DM, (unsigned char*)(F.ws + WS_WDN) + ((size_t)e * DM + 64 * nb) * 1024 + 64 * kb, F.lds + F.wave * 16384, F.lane); }
template <bool UP> __device__ __forceinline__ void cvt_range(Frame& F, int lo, int hi, int wr_, int nw) {
    for (int it = lo + wr_; it < hi; it += nw) { if (UP) cvt_up_item(F, it); else cvt_dn_item(F, it); }
}
__device__ __forceinline__ void p0_transpose_item_f8(const float* W, int ldw, unsigned char* WT, int k0, int n0, float scale, LAS float* scr, int lane) {
#pragma unroll 8
    for (int i = 0; i < 32; ++i) { const int kk = 2 * i + (lane >> 5); scr[kk * 33 + (lane & 31)] = W[(size_t)(k0 + kk) * ldw + n0 + (lane & 31)] * scale; }
    LDS_WAIT(); asm volatile("" ::: "memory");
    const int c = lane & 7;
#pragma unroll
    for (int j = 0; j < 4; ++j) { const int n = (lane >> 3) + 8 * j; const LAS float* s = scr + (8 * c) * 33 + n;
        int w0 = 0, w1 = 0; w0 = __builtin_amdgcn_cvt_pk_fp8_f32(s[0 * 33], s[1 * 33], w0, false); w0 = __builtin_amdgcn_cvt_pk_fp8_f32(s[2 * 33], s[3 * 33], w0, true);
        w1 = __builtin_amdgcn_cvt_pk_fp8_f32(s[4 * 33], s[5 * 33], w1, false); w1 = __builtin_amdgcn_cvt_pk_fp8_f32(s[6 * 33], s[7 * 33], w1, true);
        typedef int i32x2_ __attribute__((ext_vector_type(2))); *(GAS i32x2_*)(WT + (size_t)(n0 + n) * 1024 + k0 + 8 * c) = (i32x2_){w0, w1}; }
    LDS_WAIT(); asm volatile("" ::: "memory");
}
template <int PARTS = 7> __device__ __forceinline__ void p0_phase(Frame& F) {
    const float* c_in = F.in(1); const float* w_ada = F.in(2); const float* b_ada = F.in(3);
    float* MOD = (float*)(F.ws + WS_MOD);
    if ((PARTS & 1) && F.vcu < 192) {
        LAS float* sc = (LAS float*)F.lds;
        LAS float* red = (LAS float*)(F.lds + 32768);
        for (int i = F.tid; i < BATCH * DM; i += NWAVES * 64) { const int b = i >> 10, k = i & 1023; const float v = c_in[i]; sc[k * 8 + b] = v * sigmoid_f(v); }
        __syncthreads();
        for (int ci = F.vcu; ci < 192; ci += F.G) {
            const int col = F.lane & 31, ks = F.lane >> 5;
            float acc[8];
#pragma unroll
            for (int b = 0; b < 8; ++b) acc[b] = 0.f;
            const float* wp = w_ada + (size_t)(128 * F.wave + ks) * (NMOD * DM) + ci * 32 + col;
#pragma unroll 1
            for (int i0 = 0; i0 < 64; i0 += 32) {
                float wv[32];
#pragma unroll
                for (int i = 0; i < 32; ++i) wv[i] = wp[(size_t)(2 * (i0 + i)) * (NMOD * DM)];
#pragma unroll
                for (int i = 0; i < 32; ++i) { const LAS f32x4* sp = (const LAS f32x4*)(sc + (128 * F.wave + 2 * (i0 + i) + ks) * 8); const f32x4 s0 = sp[0], s1 = sp[1];
                    acc[0] += s0[0] * wv[i]; acc[1] += s0[1] * wv[i]; acc[2] += s0[2] * wv[i]; acc[3] += s0[3] * wv[i]; acc[4] += s1[0] * wv[i]; acc[5] += s1[1] * wv[i]; acc[6] += s1[2] * wv[i]; acc[7] += s1[3] * wv[i]; }
            }
#pragma unroll
            for (int b = 0; b < 8; ++b) { acc[b] += __shfl_xor(acc[b], 32); if (ks == 0) red[(F.wave * 8 + b) * 32 + col] = acc[b]; }
            __syncthreads();
            if (F.tid < 256) { const int b = F.tid >> 5, cl = F.tid & 31; float s = 0.f;
#pragma unroll
              for (int w = 0; w < 8; ++w) s += red[(w * 8 + b) * 32 + cl];
              MOD[b * NMOD * DM + ci * 32 + cl] = s + b_ada[ci * 32 + cl]; }
            __syncthreads();
        }
    }
    __syncthreads();
    const float* w_in = F.in(6); const float* w_out = F.in(17); const float* gn_attn = F.in(16);
    bf16* WIN = (bf16*)(F.ws + WS_WIN); bf16* WOUT = (bf16*)(F.ws + WS_WOUT);
    LAS float* scr = (LAS float*)(F.lds + F.wave * 16384);
    const int gw = F.vcu * NWAVES + F.wave, NGW = F.G * NWAVES;
    constexpr int I_IN = 16 * (NPJ / 32), I_OUT = 16 * (DM / 32);
    constexpr int NITEMS = I_IN + I_OUT;
    if (PARTS & 2) for (int it = gw; it < NITEMS; it += NGW) {
        int r = it;
        if (r < I_IN) { const int kb = r / (NPJ / 32), nb = r % (NPJ / 32); p0_transpose_item(w_in, NPROJ, WIN, 64 * kb, 32 * nb, 64 * kb, nullptr, scr, F.lane); continue; } r -= I_IN;
        { const int kb = r / (DM / 32), nb = r % (DM / 32); const int k0 = 64 * kb;
            p0_transpose_item(w_out, DM, WOUT, k0, 32 * nb, (k0 + 512) & 1023, k0 >= 512 ? gn_attn - 512 : nullptr, scr, F.lane); }
    }
    if (PARTS & 4) {
        if (F.G == 256) {
            constexpr int NU = CV_UP_ITEMS - CV_UP_TAIL, NV = NU + (CV_DN_ITEMS - CV_DN_TAIL);
            auto run = [&](int v) { if (v < NU) cvt_up_item(F, CV_UP_TAIL + v); else cvt_dn_item(F, CV_DN_TAIL + (v - NU)); };
            constexpr int A_END = 2048 * 5;
            for (int v = gw; v < A_END && v < NV; v += NGW) run(v);
            if (F.vcu >= 192) { const int r = (F.vcu - 192) * NWAVES + F.wave; for (int v = A_END + r; v < A_END + 1536 && v < NV; v += 512) run(v); }
            else { const int r = F.vcu * NWAVES + F.wave; if (r < 512) { const int v = A_END + 1536 + r; if (v < NV) run(v); } }
            static_assert(A_END + 1536 + 512 >= NV, "phase-0 conversion shares cover the list");
        } else { cvt_range<true>(F, 0, CV_UP_ITEMS, gw, NGW); cvt_range<false>(F, 0, CV_DN_ITEMS, gw, NGW); }
    }
    if (PARTS & 2) { const float* w_in2 = F.in(6); float* WFT = (float*)(F.ws + WS_WFT);
      for (int idx = F.vcu * (NWAVES * 64) + F.tid; idx < 8 * DM; idx += F.G * NWAVES * 64) { const int h = idx >> 10, k = idx & 1023; WFT[idx] = w_in2[(size_t)k * NPROJ + NPJ + h]; } }
    { const float* w_router = F.in(20); float* WRT = (float*)(F.ws + WS_WRT);
      for (int idx = F.vcu * (NWAVES * 64) + F.tid; idx < NE * DM; idx += F.G * NWAVES * 64) { const int e = idx >> 10, k = idx & 1023; WRT[idx] = w_router[k * NE + e]; } }
    { const float* wa = F.in(9); const float* wx = F.in(11); bf16* LWT = (bf16*)(F.ws + WS_LWT);
      for (int idx = F.vcu * (NWAVES * 64) + F.tid; idx < 2 * 8 * 64 * 64; idx += F.G * NWAVES * 64) { const int gate = idx >> 15, g = (idx >> 12) & 7, j = (idx >> 6) & 63, i = idx & 63;
          LWT[idx] = (bf16)f2bf((gate ? wx : wa)[(g * 64 + i) * 64 + j]); } }
}

__device__ __forceinline__ void p1_phase(Frame& F) {
    const float* x = F.in(0); const float* gpre = F.in(4); const float* fb = F.in(14);
    const float* MOD = (const float*)(F.ws + WS_MOD); bf16* H1 = (bf16*)(F.ws + WS_H1); float* LOGF2 = (float*)(F.ws + WS_LOGF2);
    LAS float* wf = (LAS float*)F.lds;
    { const float* WFT = (const float*)(F.ws + WS_WFT);
#pragma unroll
      for (int i = F.tid; i < 8 * DM / 4; i += NWAVES * 64) *(LAS f32x4*)(wf + 4 * i) = *(const f32x4*)(WFT + 4 * i); }
    __syncthreads();
    const int gw = F.vcu * NWAVES + F.wave;
    if (F.G * NWAVES * 8 != NTOK) return;
    const int row0 = gw * 8, b = row0 / SEQ;
    f32x4 gm[4], sh[4];
#pragma unroll
    for (int j = 0; j < 4; ++j) { const int k = 4 * F.lane + 256 * j; const f32x4 g = *(const f32x4*)(gpre + k), s = *(const f32x4*)(MOD + b * NMOD * DM + DM + k); gm[j] = g * (s + 1.0f); sh[j] = *(const f32x4*)(MOD + b * NMOD * DM + k); }
    f32x4 nx[4];
#pragma unroll
    for (int j = 0; j < 4; ++j) nx[j] = *(const f32x4*)(x + (size_t)row0 * DM + 4 * F.lane + 256 * j);
    for (int r = 0; r < 8; ++r) { const int row = row0 + r;
        f32x4 v[4]; float ss = 0.f;
#pragma unroll
        for (int j = 0; j < 4; ++j) { v[j] = nx[j]; ss += (v[j][0] * v[j][0] + v[j][1] * v[j][1]) + (v[j][2] * v[j][2] + v[j][3] * v[j][3]); }
        if (r < 7) {
#pragma unroll
            for (int j = 0; j < 4; ++j) nx[j] = *(const f32x4*)(x + (size_t)(row + 1) * DM + 4 * F.lane + 256 * j); }
        const float rinv = 1.0f / sqrtf(wave_sum(ss) * (1.0f / DM) + RMS_EPS);
        float fl[8];
#pragma unroll
        for (int h = 0; h < 8; ++h) fl[h] = 0.f;
#pragma unroll
        for (int j = 0; j < 4; ++j) { const f32x4 hv = v[j] * rinv * gm[j] + sh[j];
            v2u o; o.x = pk2(hv[0], hv[1]); o.y = pk2(hv[2], hv[3]); *(GAS v2u*)(H1 + (size_t)row * DM + 4 * F.lane + 256 * j) = o;
#pragma unroll
            for (int h = 0; h < 8; ++h) { const f32x4 w = *(const LAS f32x4*)(wf + h * DM + 4 * F.lane + 256 * j); fl[h] += (hv[0] * w[0] + hv[1] * w[1]) + (hv[2] * w[2] + hv[3] * w[3]); } }
#pragma unroll
        for (int h = 0; h < 8; ++h) fl[h] = wave_sum(fl[h]);
        if (F.lane < 8) { float f = fl[0];
#pragma unroll
            for (int h = 1; h < 8; ++h) f = (F.lane == h) ? fl[h] : f;
            LOGF2[(size_t)row * 8 + F.lane] = log_sigmoid_f(f + fb[F.lane]) * 1.4426950408889634f; }
    }
}

constexpr int LRU_XP = 1040;
constexpr int LRU_XT = 0, LRU_XC = 69696, LRU_CAR = 136256;
constexpr int CW_LRU = 131072;
static_assert(LRU_CAR + 2048 <= SCRATCH_BYTES && 67 * LRU_XP <= LRU_XC && LRU_XC + 64 * LRU_XP <= LRU_CAR, "LRU LDS map");
__device__ __forceinline__ float one_minus_exp(float x) {
    float p = -x * (1.0f + x * (0.5f + x * (0.16666667f + x * (0.041666668f + x * (0.0083333338f + x * 0.0013888889f)))));
    if (__builtin_expect(__any(x <= -0.25f), 0)) { const float d = 1.0f - __builtin_amdgcn_exp2f(1.4426950408889634f * x); p = x > -0.25f ? p : d; }
    return p;
}
__device__ __forceinline__ void lru_item(Frame& F, int b, int c) {
    LAS unsigned char* XT = F.lds + LRU_XT; LAS unsigned char* XC = F.lds + LRU_XC; LAS float* CAR = (LAS float*)(F.lds + LRU_CAR);
    const bf16* XL = (const bf16*)(F.ws + WS_PJ); const bf16* YL = XL + PJ_STRIDE; const bf16* LWT = (const bf16*)(F.ws + WS_LWT);
    float* LSUM = (float*)(F.ws + WS_LSUM); bf16* MRG = (bf16*)(F.ws + WS_MRG); unsigned* flags = (unsigned*)(F.ws + WS_CTL) + CW_LRU;
    const float* conv_w = F.in(7); const float* conv_b = F.in(8); const float* ba = F.in(10); const float* bx = F.in(12); const float* lam = F.in(13); const float* gn_lru = F.in(15);
    const int t0 = c * 64; const size_t rowb = (size_t)b * SEQ;
    { v4u xv[9];
#pragma unroll
      for (int q = 0; q < 9; ++q) { const int p = F.tid + q * (NWAVES * 64), i = p >> 6, c8 = p & 63, t = t0 - 3 + i; xv[q] = (v4u){0u, 0u, 0u, 0u};
          if (p < 67 * 64 && t >= 0) xv[q] = *(const GAS v4u*)(XL + (rowb + t) * 512 + c8 * 8); }
#pragma unroll
      for (int q = 0; q < 9; ++q) { const int p = F.tid + q * (NWAVES * 64), i = p >> 6, c8 = p & 63; if (p < 67 * 64) *(LAS v4u*)(XT + i * LRU_XP + c8 * 16) = xv[q]; } }
    v4u yv8[8];
#pragma unroll
    for (int q = 0; q < 8; ++q) { const int p = F.tid + q * (NWAVES * 64), i = p >> 6, c8 = p & 63; yv8[q] = *(const GAS v4u*)(YL + (rowb + t0 + i) * 512 + c8 * 8); }
    __syncthreads();
    { const int ch = F.tid; const float w0 = conv_w[ch], w1 = conv_w[512 + ch], w2 = conv_w[1024 + ch], w3 = conv_w[1536 + ch], cb = conv_b[ch];
      float xa = bf1(*(const LAS bf16*)(XT + 0 * LRU_XP + ch * 2)), xb = bf1(*(const LAS bf16*)(XT + 1 * LRU_XP + ch * 2)), xc = bf1(*(const LAS bf16*)(XT + 2 * LRU_XP + ch * 2));
#pragma unroll 8
      for (int t = 0; t < 64; ++t) { const float xd = bf1(*(const LAS bf16*)(XT + (t + 3) * LRU_XP + ch * 2)); const float v = ((w0 * xa + w1 * xb) + (w2 * xc + w3 * xd)) + cb;
          *(LAS bf16*)(XC + t * LRU_XP + ch * 2) = (bf16)f2bf(v); xa = xb; xb = xc; xc = xd; } }
    __syncthreads();
#pragma unroll
    for (int q = 0; q < 8; ++q) { const int p = F.tid + q * (NWAVES * 64), i = p >> 6, c8 = p & 63; *(LAS v4u*)(XT + i * LRU_XP + c8 * 16) = yv8[q]; }
    const int g = F.wave, l31 = F.lane & 31, hi = F.lane >> 5;
    __syncthreads();
#pragma unroll 1
    for (int hp = 0; hp < 2; ++hp) {
        const int chl = g * 64 + 32 * hp + l31;
        f32x16 cumA[2], hloc[2];
#pragma unroll
        for (int tg = 0; tg < 2; ++tg) { cumA[tg] = f32x16{}; hloc[tg] = f32x16{}; }
#pragma unroll
        for (int s = 0; s < 4; ++s) {
            const bf16x8 wa = *(const GAS bf16x8*)(LWT + ((size_t)((0 * 8 + g) * 64 + 32 * hp + l31)) * 64 + 16 * s + 8 * hi);
            const bf16x8 wx = *(const GAS bf16x8*)(LWT + ((size_t)((1 * 8 + g) * 64 + 32 * hp + l31)) * 64 + 16 * s + 8 * hi);
#pragma unroll
            for (int tg = 0; tg < 2; ++tg) { const bf16x8 bfr = *(const LAS bf16x8*)(XC + (32 * tg + l31) * LRU_XP + (g * 64 + 16 * s + 8 * hi) * 2);
                cumA[tg] = __builtin_amdgcn_mfma_f32_32x32x16_bf16(bfr, wa, cumA[tg], 0, 0, 0); hloc[tg] = __builtin_amdgcn_mfma_f32_32x32x16_bf16(bfr, wx, hloc[tg], 0, 0, 0); }
        }
        const float pba = ba[chl], pbx = bx[chl], psp = 8.0f * softplus_f(-lam[chl]);
        float cA = 1.0f, cB = 0.0f;
#pragma unroll
        for (int tg = 0; tg < 2; ++tg) {
            f32x16& A = cumA[tg]; f32x16& X = hloc[tg];
#pragma unroll
            for (int r = 0; r < 16; ++r) { const int tok = 32 * tg + (r & 3) + 8 * (r >> 2) + 4 * hi; const float xv = bf1(*(const LAS bf16*)(XC + tok * LRU_XP + chl * 2));
                const float rg = sigmoid_f(A[r] + pba), ig = sigmoid_f(X[r] + pbx); const float la = -rg * psp;
                A[r] = __builtin_amdgcn_exp2f(1.4426950408889634f * la); X[r] = __builtin_amdgcn_sqrtf(one_minus_exp(2.0f * la)) * (ig * xv); }
#pragma unroll
            for (int q = 0; q < 4; ++q)
#pragma unroll
                for (int i = 1; i < 4; ++i) { X[4 * q + i] = A[4 * q + i] * X[4 * q + i - 1] + X[4 * q + i]; A[4 * q + i] = A[4 * q + i] * A[4 * q + i - 1]; }
#pragma unroll
            for (int q2 = 0; q2 < 8; ++q2) { const int q = q2 >> 1; const bool own = (hi == (q2 & 1));
#pragma unroll
                for (int i = 0; i < 4; ++i) { const float nb = A[4 * q + i] * cB + X[4 * q + i], na = A[4 * q + i] * cA; X[4 * q + i] = own ? nb : X[4 * q + i]; A[4 * q + i] = own ? na : A[4 * q + i]; }
                float ra, rb; { float a0 = A[4 * q + 3], a1 = a0; swap_half32(a0, a1); ra = hi ? a0 : a1; float b0 = X[4 * q + 3], b1 = b0; swap_half32(b0, b1); rb = hi ? b0 : b1; }
                cA = own ? A[4 * q + 3] : ra; cB = own ? X[4 * q + 3] : rb; }
        }
        if (hi == 0) { float* d0 = LSUM + (((size_t)b * 32 + c) * 2 + 0) * 512 + chl; __hip_atomic_store(d0, cA, __ATOMIC_RELAXED, __HIP_MEMORY_SCOPE_AGENT); __hip_atomic_store(d0 + 512, cB, __ATOMIC_RELAXED, __HIP_MEMORY_SCOPE_AGENT); }
        asm volatile("s_waitcnt vmcnt(0)" ::: "memory");
        __syncthreads();
        if (F.wave == 0) {
            if (F.lane == 0) __hip_atomic_store(flags + 64 * ((32 * b + c) * 2 + hp), 1u, __ATOMIC_RELAXED, __HIP_MEMORY_SCOPE_AGENT);
            unsigned sp = 0;
            for (;;) { const unsigned v = (F.lane < c) ? __hip_atomic_load(flags + 64 * ((32 * b + F.lane) * 2 + hp), __ATOMIC_RELAXED, __HIP_MEMORY_SCOPE_AGENT) : 1u;
                if (__all(v != 0u)) break; __builtin_amdgcn_s_sleep(1); if (++sp > (1u << 20)) break; }
        }
        __syncthreads();
        if (F.tid < 256) { const int ch = (F.tid >> 5) * 64 + 32 * hp + (F.tid & 31); float cr = 0.f; float* LS = LSUM + (size_t)b * 32 * 2 * 512 + ch;
          for (int c0 = 0; c0 < c; c0 += 32) { float A8[32], B8[32];
#pragma unroll
              for (int u = 0; u < 32; ++u) { const bool ok = (c0 + u) < c; A8[u] = 1.0f; B8[u] = 0.0f; if (ok) { A8[u] = __hip_atomic_load(LS + (size_t)(c0 + u) * 1024, __ATOMIC_RELAXED, __HIP_MEMORY_SCOPE_AGENT); B8[u] = __hip_atomic_load(LS + (size_t)(c0 + u) * 1024 + 512, __ATOMIC_RELAXED, __HIP_MEMORY_SCOPE_AGENT); } }
#pragma unroll
              for (int u = 0; u < 32; ++u) cr = A8[u] * cr + B8[u]; }
          CAR[ch] = cr; }
        __syncthreads();
        { const float cin = CAR[chl];
#pragma unroll
          for (int tg = 0; tg < 2; ++tg)
#pragma unroll
              for (int r = 0; r < 16; ++r) { const int tok = 32 * tg + (r & 3) + 8 * (r >> 2) + 4 * hi; LAS bf16* yp = (LAS bf16*)(XT + tok * LRU_XP + chl * 2);
                  const float h = hloc[tg][r] + cumA[tg][r] * cin; *yp = (bf16)f2bf(h * gelu_tanh_f(bf1(*yp))); } }
    }
    __syncthreads();
#pragma unroll 2
    for (int q = 0; q < 8; ++q) { const int i = F.wave + 8 * q, c8 = F.lane;
        const v4u w = *(const LAS v4u*)(XT + i * LRU_XP + c8 * 16);
        const float v0 = bflo(w.x), v1 = bfhi(w.x), v2 = bflo(w.y), v3 = bfhi(w.y), v4 = bflo(w.z), v5 = bfhi(w.z), v6 = bflo(w.w), v7 = bfhi(w.w);
        const float ss = wave_sum(((v0 * v0 + v1 * v1) + (v2 * v2 + v3 * v3)) + ((v4 * v4 + v5 * v5) + (v6 * v6 + v7 * v7)));
        const float rinv = 1.0f / sqrtf(ss * (1.0f / DLRU) + RMS_EPS);
        const f32x4 g0 = *(const f32x4*)(gn_lru + c8 * 8), g1 = *(const f32x4*)(gn_lru + c8 * 8 + 4);
        v4u o; o.x = pk2(v0 * rinv * g0[0], v1 * rinv * g0[1]); o.y = pk2(v2 * rinv * g0[2], v3 * rinv * g0[3]); o.z = pk2(v4 * rinv * g1[0], v5 * rinv * g1[1]); o.w = pk2(v6 * rinv * g1[2], v7 * rinv * g1[3]);
        *(GAS v4u*)(MRG + (rowb + t0 + i) * 1024 + 512 + c8 * 8) = o; }
    __syncthreads();
}
__device__ __forceinline__ void lru_phase(Frame& F) { for (int it = F.vcu; it < BATCH * 32; it += F.G) lru_item(F, it >> 5, it & 31); }

template <int VAR = 0> __device__ __forceinline__ void p6_phase(Frame& F) {
    const float* x = F.in(0); const float* gpost = F.in(5); const float* gffn = F.in(18); const float* b_router = F.in(21);
    const float* MOD = (const float*)(F.ws + WS_MOD); const bf16* Y = (const bf16*)(F.ws + WS_Y); unsigned char* H2 = (unsigned char*)(F.ws + WS_H2);
    int* TOPI = (int*)(F.ws + WS_TOPI); float* TOPW = (float*)(F.ws + WS_TOPW); int* WGCNT = (int*)(F.ws + WS_WGCNT);
    LAS float* wrl = (LAS float*)F.lds;
    LAS int* hist = (LAS int*)(F.lds + 131072);
    { const float* WRT = (const float*)(F.ws + WS_WRT);
#pragma unroll 4
      for (int i = F.tid; i < NE * DM / 4; i += NWAVES * 64) *(LAS f32x4*)(wrl + 4 * i) = *(const f32x4*)(WRT + 4 * i); }
    if (F.tid < NE) hist[F.tid] = 0;
    __syncthreads();
    if (F.G * 64 == NTOK) {
    const int bx = blockIdx.x, row0 = bx * 64 + F.wave * 8, b = row0 / SEQ;
    f32x4 gpm[4], gf[4], shf[4];
#pragma unroll
    for (int j = 0; j < 4; ++j) { const int k = 4 * F.lane + 256 * j; const float* mb = MOD + b * NMOD * DM + k;
        gpm[j] = *(const f32x4*)(mb + 2 * DM) * *(const f32x4*)(gpost + k); gf[j] = *(const f32x4*)(gffn + k) * (*(const f32x4*)(mb + 4 * DM) + 1.0f); shf[j] = *(const f32x4*)(mb + 3 * DM); }
    v2u ywn[2][4]; f32x4 xn[2][4];
#pragma unroll
    for (int u = 0; u < 2; ++u)
#pragma unroll
        for (int j = 0; j < 4; ++j) { ywn[u][j] = *(const GAS v2u*)(Y + (size_t)(row0 + u) * DM + 4 * F.lane + 256 * j); xn[u][j] = *(const f32x4*)(x + (size_t)(row0 + u) * DM + 4 * F.lane + 256 * j); }
    for (int rp = 0; rp < 4; ++rp) {
        f32x4 hv[2][4];
        v2u ywc[2][4]; f32x4 xc[2][4];
#pragma unroll
        for (int u = 0; u < 2; ++u)
#pragma unroll
            for (int j = 0; j < 4; ++j) { ywc[u][j] = ywn[u][j]; xc[u][j] = xn[u][j]; }
        if (rp < 3) {
#pragma unroll
            for (int u = 0; u < 2; ++u)
#pragma unroll
                for (int j = 0; j < 4; ++j) { ywn[u][j] = *(const GAS v2u*)(Y + (size_t)(row0 + 2 * rp + 2 + u) * DM + 4 * F.lane + 256 * j); xn[u][j] = *(const f32x4*)(x + (size_t)(row0 + 2 * rp + 2 + u) * DM + 4 * F.lane + 256 * j); } }
#pragma unroll
        for (int u = 0; u < 2; ++u) { const int row = row0 + 2 * rp + u;
            f32x4 yv[4]; float ss = 0.f;
#pragma unroll
            for (int j = 0; j < 4; ++j) { const v2u yw = ywc[u][j]; yv[j] = (f32x4){bflo(yw.x), bfhi(yw.x), bflo(yw.y), bfhi(yw.y)}; ss += (yv[j][0] * yv[j][0] + yv[j][1] * yv[j][1]) + (yv[j][2] * yv[j][2] + yv[j][3] * yv[j][3]); }
            const float rinv = 1.0f / sqrtf(wave_sum(ss) * (1.0f / DM) + RMS_EPS);
            float s2 = 0.f;
#pragma unroll
            for (int j = 0; j < 4; ++j) { const f32x4 xm = xc[u][j] + gpm[j] * (yv[j] * rinv);
                yv[j] = xm; s2 += (xm[0] * xm[0] + xm[1] * xm[1]) + (xm[2] * xm[2] + xm[3] * xm[3]); }
            const float rinv2 = 1.0f / sqrtf(wave_sum(s2) * (1.0f / DM) + RMS_EPS);
#pragma unroll
            for (int j = 0; j < 4; ++j) { const f32x4 h = yv[j] * rinv2 * gf[j] + shf[j]; hv[u][j] = h;
                int w8 = 0; w8 = __builtin_amdgcn_cvt_pk_fp8_f32(h[0], h[1], w8, false); w8 = __builtin_amdgcn_cvt_pk_fp8_f32(h[2], h[3], w8, true); *(GAS int*)(H2 + (size_t)row * DM + 4 * F.lane + 256 * j) = w8; }
        }
        typedef float f32x2 __attribute__((ext_vector_type(2)));
        f32x2 hp[4][4];
#pragma unroll
        for (int j = 0; j < 4; ++j)
#pragma unroll
            for (int i = 0; i < 4; ++i) hp[j][i] = (f32x2){hv[0][j][i], hv[1][j][i]};
        float pa[32], pb[32];
#pragma unroll
        for (int e = 0; e < 32; ++e) { f32x2 s2 = (f32x2){0.f, 0.f};
#pragma unroll
            for (int j = 0; j < (VAR == 1 ? 0 : 4); ++j) { const f32x4 w = *(const LAS f32x4*)(wrl + e * DM + 4 * F.lane + 256 * j);
#pragma unroll
                for (int i = 0; i < 4; ++i) s2 = __builtin_elementwise_fma(hp[j][i], (f32x2){w[i], w[i]}, s2); }
            pa[e] = s2[0]; pb[e] = s2[1]; }
#pragma unroll
        for (int i = 0; i < 16; ++i) { float a = pa[i], b = pa[16 + i]; swap_half32(a, b); pa[i] = a + b; float c2 = pb[i], d2 = pb[16 + i]; swap_half32(c2, d2); pb[i] = c2 + d2; }
#pragma unroll
        for (int i = 0; i < 8; ++i) { float a = pa[i], b = pa[8 + i]; swap_rows16(a, b); pa[i] = a + b; float c2 = pb[i], d2 = pb[8 + i]; swap_rows16(c2, d2); pb[i] = c2 + d2; }
#define TR_STEP(N, XOR, BIT) _Pragma("unroll") for (int i = 0; i < N; ++i) { const bool up = (F.lane & BIT) != 0; \
            const float ka = up ? pa[N + i] : pa[i], sa_ = up ? pa[i] : pa[N + i], kb = up ? pb[N + i] : pb[i], sb_ = up ? pb[i] : pb[N + i]; \
            pa[i] = ka + XOR(sa_); pb[i] = kb + XOR(sb_); }
        TR_STEP(4, lane_xor8, 8) TR_STEP(2, lane_xor4, 4) TR_STEP(1, lane_xor2, 2)
#undef TR_STEP
        const int e = (F.lane >> 1) & 31; const float br = b_router[e];
#pragma unroll
        for (int u = 0; u < 2; ++u) { const int row = row0 + 2 * rp + u; float v = (u ? pb[0] : pa[0]); v += lane_xor1(v); v += br;
            int rank = 0;
#pragma unroll
            for (int j = 0; j < 32; ++j) { const float vj = __uint_as_float((unsigned)__builtin_amdgcn_readlane((int)__float_as_uint(v), 2 * j)); rank += (vj > v || (vj == v && j < e)) ? 1 : 0; }
            const bool sel = rank < TOPK; const float vmax = wave_max(v); const float ex = sel ? __expf(v - vmax) : 0.f; const float den = wave_sum(ex) * 0.5f;
            if (sel && !(F.lane & 1)) { TOPI[(size_t)row * TOPK + rank] = e; TOPW[(size_t)row * TOPK + rank] = ex / den; __hip_atomic_fetch_add((LAS int*)&hist[e], 1, __ATOMIC_RELAXED, __HIP_MEMORY_SCOPE_WORKGROUP); } }
    }
    __syncthreads();
    if (F.tid < NE) WGCNT[bx * NE + F.tid] = hist[F.tid];
    }
}

__device__ __forceinline__ void p7_phase(Frame& F) {
    const int* TOPI = (const int*)(F.ws + WS_TOPI); const float* TOPW = (const float*)(F.ws + WS_TOPW); const int* WGCNT = (const int*)(F.ws + WS_WGCNT);
    int* ROWTOK = (int*)(F.ws + WS_ROWTOK); int* ROWPAIR = (int*)(F.ws + WS_ROWPAIR); float* ROWW = (float*)(F.ws + WS_ROWW); int* MTEXP = (int*)(F.ws + WS_MTEXP);
    LAS int* ptot = (LAS int*)F.lds; LAS int* pbef = ptot + 512; LAS int* cnt = pbef + 512; LAS int* wgb = cnt + 32; LAS int* pst = wgb + 32; LAS int* pad = pst + 64; LAS int* ep = pad + 32;
    if (F.G != 256) return;
    const int bx = blockIdx.x;
    { const int e = F.tid & 31, part = F.tid >> 5; int tt = 0, tb = 0;
      for (int w = part * 16; w < part * 16 + 16; ++w) { const int v = WGCNT[w * NE + e]; tt += v; tb += (w < bx) ? v : 0; }
      ptot[part * 32 + e] = tt; pbef[part * 32 + e] = tb; }
    __syncthreads();
    if (F.tid < NE) { int tt = 0, tb = 0; for (int p = 0; p < 16; ++p) { tt += ptot[p * 32 + F.tid]; tb += pbef[p * 32 + F.tid]; } cnt[F.tid] = tt; wgb[F.tid] = tb; pad[F.tid] = (tt + 255) & ~255; }
    __syncthreads();
    if (F.tid == 0) { int s = 0; for (int e = 0; e < NE; ++e) { pst[e] = s; s += pad[e]; } pst[NE] = s; }
    if (F.tid < 256) ep[F.tid] = TOPI[(size_t)bx * 256 + F.tid];
    __syncthreads();
    if (F.tid < 256) { const int p = F.tid, e = ep[p]; int rk = 0; for (int q = 0; q < p; ++q) rk += (ep[q] == e) ? 1 : 0;
        const int dest = pst[e] + wgb[e] + rk; const int pair = bx * 256 + p; ROWTOK[dest] = pair >> 2; ROWPAIR[dest] = pair; ROWW[dest] = TOPW[pair]; }
    if (bx < NE) { const int e = bx; for (int i = pst[e] + cnt[e] + F.tid; i < pst[e] + pad[e]; i += NWAVES * 64) { ROWTOK[i] = 0; ROWPAIR[i] = -1; ROWW[i] = 0.f; } }
    if (bx == 0) { if (F.tid < NE) { for (int mt = pst[F.tid] >> 8; mt < (pst[F.tid] + pad[F.tid]) >> 8; ++mt) MTEXP[mt] = F.tid; } if (F.tid == 0) MTEXP[512] = pst[NE] >> 8; }
}

__device__ __forceinline__ void p10_phase(Frame& F) {
    const float* x = F.in(0); const float* gpostm = F.in(5); const float* gpost = F.in(19); const float* MOD = (const float*)(F.ws + WS_MOD);
    const unsigned char* YP = (const unsigned char*)(F.ws + WS_YP); const bf16* Y = (const bf16*)(F.ws + WS_Y);
    const int gw = F.vcu * NWAVES + F.wave;
    if (F.G * NWAVES * 8 != NTOK) return;
    const int row0 = gw * 8, b = row0 / SEQ;
    f32x4 gg[4], gpm[4];
#pragma unroll
    for (int j = 0; j < 4; ++j) { const int k = 4 * F.lane + 256 * j; gg[j] = *(const f32x4*)(MOD + b * NMOD * DM + 5 * DM + k) * *(const f32x4*)(gpost + k); gpm[j] = *(const f32x4*)(MOD + b * NMOD * DM + 2 * DM + k) * *(const f32x4*)(gpostm + k); }
    int nw[4][TOPK]; v2u ny[4]; f32x4 nx[4];
#pragma unroll
    for (int j = 0; j < 4; ++j) { ny[j] = *(const GAS v2u*)(Y + (size_t)row0 * DM + 4 * F.lane + 256 * j); nx[j] = *(const f32x4*)(x + (size_t)row0 * DM + 4 * F.lane + 256 * j);
#pragma unroll
        for (int k = 0; k < TOPK; ++k) nw[j][k] = *(const GAS int*)(YP + ((size_t)row0 * TOPK + k) * DM + 4 * F.lane + 256 * j); }
    for (int r = 0; r < 8; ++r) { const int row = row0 + r;
        f32x4 y[4], ym[4], xr[4]; float ss = 0.f, sm = 0.f;
#pragma unroll
        for (int j = 0; j < 4; ++j) { f32x4 s = (f32x4){0.f, 0.f, 0.f, 0.f};
#pragma unroll
            for (int k = 0; k < TOPK; ++k) { const int w = nw[j][k]; s += (f32x4){__builtin_amdgcn_cvt_f32_fp8(w, 0), __builtin_amdgcn_cvt_f32_fp8(w, 1), __builtin_amdgcn_cvt_f32_fp8(w, 2), __builtin_amdgcn_cvt_f32_fp8(w, 3)}; }
            y[j] = s; ss += (s[0] * s[0] + s[1] * s[1]) + (s[2] * s[2] + s[3] * s[3]);
            const v2u yw = ny[j]; const f32x4 m = (f32x4){bflo(yw.x), bfhi(yw.x), bflo(yw.y), bfhi(yw.y)}; ym[j] = m; sm += (m[0] * m[0] + m[1] * m[1]) + (m[2] * m[2] + m[3] * m[3]); xr[j] = nx[j]; }
        if (r < 7) {
#pragma unroll
            for (int j = 0; j < 4; ++j) { ny[j] = *(const GAS v2u*)(Y + (size_t)(row + 1) * DM + 4 * F.lane + 256 * j); nx[j] = *(const f32x4*)(x + (size_t)(row + 1) * DM + 4 * F.lane + 256 * j);
#pragma unroll
                for (int k = 0; k < TOPK; ++k) nw[j][k] = *(const GAS int*)(YP + ((size_t)(row + 1) * TOPK + k) * DM + 4 * F.lane + 256 * j); } }
        const float rinv = 1.0f / sqrtf(wave_sum(ss) * (1.0f / DM) + RMS_EPS * 16.0f), rinvm = 1.0f / sqrtf(wave_sum(sm) * (1.0f / DM) + RMS_EPS);
#pragma unroll
        for (int j = 0; j < 4; ++j) *(f32x4*)(F.out + (size_t)row * DM + 4 * F.lane + 256 * j) = (xr[j] + gpm[j] * (ym[j] * rinvm)) + gg[j] * (y[j] * rinv);
    }
}

__global__ void __launch_bounds__(NWAVES * 64, 2) mega_fwd(Args args) {
    extern __shared__ __attribute__((aligned(16))) unsigned char lds[];
    Frame F;
    F.lds = (LAS unsigned char*)lds;
    F.tid = threadIdx.x; F.lane = F.tid & 63; F.wave = __builtin_amdgcn_readfirstlane(F.tid >> 6);
    F.G = gridDim.x; { const int bx = blockIdx.x; F.vcu = (F.G % 8 == 0) ? (bx % 8) * (F.G / 8) + bx / 8 : bx; }
    F.out = args.out; F.ws = args.ws;
    volatile LAS unsigned* MISC = (volatile LAS unsigned*)(F.lds + MISC_OFF);
    for (int u = F.tid; u < (LDS_BYTES - LDSCTL_OFF) / 4; u += NWAVES * 64) ((LAS unsigned*)(F.lds + LDSCTL_OFF))[u] = 0u;
    __syncthreads();
    if (F.tid < 26) ((LAS unsigned long long*)(F.lds + LDSCTL_OFF))[F.tid] = (unsigned long long)args.in[F.tid];
    __syncthreads();
    gu32* ctl = (gu32*)(F.ws + WS_CTL);
    XcdBarrier bar = xcd_barrier_post((unsigned*)(ctl + CW_BAR) + args.li * XCD_BAR_WORDS, MISC + 8);
    const int lo = args.ph_lo, hi = args.ph_hi;
#ifndef PHMASK
#define PHMASK 0x7ff
#endif
#define IN(k) (((PHMASK >> (k)) & 1) && lo <= (k) && (k) < hi)
#define SEAM(k, n) do { if (IN(k) && IN(n)) xcd_barrier(bar); } while (0)
#define REFRESH() do { int t_; asm volatile("v_mov_b32 %0, %1" : "=v"(t_) : "v"(threadIdx.x)); F.tid = t_; F.lane = t_ & 63; } while (0)
#define ATTN_TENSORS attn_body::AttnTensors{(const attn_body::bf16*)(F.ws + WS_PJ) + 2 * PJ_STRIDE, (const attn_body::bf16*)(F.ws + WS_PJ) + 3 * PJ_STRIDE, (const attn_body::bf16*)(F.ws + WS_PJ) + 4 * PJ_STRIDE, \
                                          (attn_body::bf16*)(F.ws + WS_MRG), (const float*)(F.ws + WS_LOGF2), (float*)(F.ws + WS_SSQ)}
    if (IN(0)) { REFRESH(); p0_phase(F); } SEAM(0, 1);
    if (IN(1)) { REFRESH(); p1_phase(F); } SEAM(1, 2);
    if (IN(2)) { REFRESH();
        pg8::DenseOrder S; S.init((const pg8::bf16_t*)(F.ws + WS_H1), (const pg8::bf16_t*)(F.ws + WS_WIN), NTOK, NPJ, F.G, (int)blockIdx.x);
        pg8::EpiProj E{(pg8::bf16_t*)(F.ws + WS_PJ), PJ_STRIDE, attn_body::C2};
        pg8::gemm_phase<pg8::EpiProj, pg8::DenseOrder>(F.lds, S, E);
        if (F.G == 256 && blockIdx.x >= 128) { REFRESH(); cvt_range<true>(F, 0, CV_UP_TAIL, ((int)blockIdx.x - 128) * NWAVES + F.wave, 128 * NWAVES); }
    } SEAM(2, 3);
    if (IN(3)) { REFRESH();
        lru_phase(F);
        const attn_body::AttnTensors AT = ATTN_TENSORS; const attn_body::StaticOrder S((int)F.G, F.vcu);
        attn_body::attn_phase<attn_body::StaticOrder>((char*)lds, AT, S);
    } SEAM(3, 5);
    if (IN(5)) { REFRESH();
        pg8::DenseOrder S; S.init((const pg8::bf16_t*)(F.ws + WS_MRG), (const pg8::bf16_t*)(F.ws + WS_WOUT), NTOK, DM, F.G, (int)blockIdx.x);
        pg8::EpiOut E{(pg8::bf16_t*)(F.ws + WS_Y), (const float*)(F.ws + WS_SSQ)};
        pg8::gemm_phase<pg8::EpiOut, pg8::DenseOrder>(F.lds, S, E);
    } SEAM(5, 6);
    if (IN(6)) { REFRESH(); p6_phase<0>(F); } SEAM(6, 7);
    if (IN(7)) { REFRESH(); p7_phase(F); } SEAM(7, 8);
    if (IN(8)) { REFRESH();
        const int nmt = ((const int*)(F.ws + WS_MTEXP))[512];
        LAS int* mtl = (LAS int*)(F.lds + 131072); LAS float* bsl = (LAS float*)(F.lds + 131072 + 2048);
        for (int i = F.tid; i < nmt; i += NWAVES * 64) mtl[i] = ((const int*)(F.ws + WS_MTEXP))[i];
        __syncthreads();
        { const float* b_up = F.in(23);
          for (int i = 0; i < 12; ++i) { const int L = i * F.G + F.vcu; if (L >= nmt * 8) break; const int ex = mtl[L >> 3], pn = L & 7;
              if (F.tid < 256) bsl[i * 256 + F.tid] = b_up[(size_t)ex * 2 * DEXP + (F.tid >> 7) * DEXP + pn * 128 + (F.tid & 127)]; } }
        __syncthreads();
        pg8::UpOrder S{(const unsigned char*)(F.ws + WS_H2), (const unsigned char*)(F.ws + WS_WUP), (const int*)(F.ws + WS_ROWTOK), mtl, nmt * 8, F.G, F.vcu};
        pg8::EpiUp E{(unsigned char*)(F.ws + WS_ACT), bsl};
        pg8::gemm_phase<pg8::EpiUp, pg8::UpOrder, true>(F.lds, S, E);
        if (F.G == 256) {
            const int units = nmt * 8, maxu = (units + 255) >> 8, nfull = units - (maxu - 1) * 256, nidle = 256 - nfull;
            REFRESH();
            if (nidle >= 32) { if (F.vcu >= nfull) cvt_range<false>(F, 0, CV_DN_TAIL, (F.vcu - nfull) * NWAVES + F.wave, nidle * NWAVES); }
            else cvt_range<false>(F, 0, CV_DN_TAIL, F.vcu * NWAVES + F.wave, 256 * NWAVES); }
    } SEAM(8, 9);
    if (IN(9)) { REFRESH();
        const int nmt = ((const int*)(F.ws + WS_MTEXP))[512];
        LAS int* mtl = (LAS int*)(F.lds + 131072); LAS float* bsl = (LAS float*)(F.lds + 131072 + 2048);
        for (int i = F.tid; i < nmt; i += NWAVES * 64) mtl[i] = ((const int*)(F.ws + WS_MTEXP))[i];
        __syncthreads();
        { const float* b_dn = F.in(25);
          for (int i = 0; i < 12; ++i) { const int L = i * F.G + F.vcu; if (L >= nmt * 4) break; const int ex = mtl[L >> 2], pn = L & 3;
              if (F.tid < 256) bsl[i * 256 + F.tid] = b_dn[(size_t)ex * DM + pn * 256 + F.tid]; } }
        __syncthreads();
        pg8::DownOrder S{(const unsigned char*)(F.ws + WS_ACT), (const unsigned char*)(F.ws + WS_WDN), mtl, nmt * 4, F.G, F.vcu};
        pg8::EpiDown E{(unsigned char*)(F.ws + WS_YP), bsl, (const int*)(F.ws + WS_ROWPAIR), (const float*)(F.ws + WS_ROWW)};
        pg8::gemm_phase<pg8::EpiDown, pg8::DownOrder, true>(F.lds, S, E);
    } SEAM(9, 10);
    if (IN(10)) { REFRESH(); p10_phase(F); }
#ifdef MK_PROBES
    if (lo == 11) { REFRESH(); lru_phase(F); }
    if (lo == 12) { REFRESH(); const attn_body::AttnTensors AT = ATTN_TENSORS; const attn_body::StaticOrder S((int)F.G, F.vcu); attn_body::attn_phase<attn_body::StaticOrder>((char*)lds, AT, S); }
    if (lo == 14) { REFRESH(); p0_phase<1>(F); }
    if (lo == 15) { REFRESH(); p0_phase<2>(F); }
    if (lo == 16) { REFRESH(); p0_phase<4>(F); }
    if (lo == 17) { for (int i = 0; i < 10; ++i) xcd_barrier(bar); }
    if (lo == 18) { REFRESH(); p6_phase<1>(F); }
    if (lo >= 21 && lo <= 24) { REFRESH();
        const int nmt = ((const int*)(F.ws + WS_MTEXP))[512];
        LAS int* mtl = (LAS int*)(F.lds + 131072); LAS float* bsl = (LAS float*)(F.lds + 131072 + 2048);
        for (int i = F.tid; i < nmt; i += NWAVES * 64) mtl[i] = ((const int*)(F.ws + WS_MTEXP))[i];
        for (int i = F.tid; i < 12 * 256; i += NWAVES * 64) bsl[i] = 0.f;
        __syncthreads();
        pg8::UpOrder S{(const unsigned char*)(F.ws + WS_H2), (const unsigned char*)(F.ws + WS_WUP), (const int*)(F.ws + WS_ROWTOK), mtl, nmt * 8, F.G, F.vcu};
        if (lo == 21) { pg8::EpiNop E{}; pg8::gemm_phase<pg8::EpiNop, pg8::UpOrder, true, 1>(F.lds, S, E); }
        else if (lo == 22) { pg8::EpiNop E{}; pg8::gemm_phase<pg8::EpiNop, pg8::UpOrder, true, 2>(F.lds, S, E); }
        else if (lo == 23) { pg8::EpiUp E{(unsigned char*)(F.ws + WS_H1), bsl}; pg8::gemm_phase<pg8::EpiUp, pg8::UpOrder, true, 1>(F.lds, S, E); }
        else { pg8::EpiUpT<false> E{(unsigned char*)(F.ws + WS_H1), bsl}; pg8::gemm_phase<pg8::EpiUpT<false>, pg8::UpOrder, true, 1>(F.lds, S, E); } }
#endif
#undef IN
#undef SEAM
#undef REFRESH
#undef ATTN_TENSORS
}

static void launch_mega(hipStream_t stream, void* const* d_in, void* d_out, void* d_ws, int lo, int hi, int li, int grid) {
    Args a{};
    for (int i = 0; i < 26; ++i) a.in[i] = (const float*)d_in[i];
    a.out = (float*)d_out; a.ws = (unsigned char*)d_ws; a.ph_lo = lo; a.ph_hi = hi; a.li = li; a.pad = 0;
    hipLaunchKernelGGL(mega_fwd, dim3(grid), dim3(NWAVES * 64), LDS_BYTES, stream, a);
}

extern "C" void kernel_launch(void* const* d_in, const int* in_sizes, int n_in, void* d_out, int out_size, void* d_ws, size_t ws_size, hipStream_t stream) {
    static int grid = 0;
    if (grid == 0) {
        int dev = 0, cus = 0;
        if (n_in != 26 || out_size != NTOK * DM || ws_size < WS_END) { fprintf(stderr, "kernel_launch: unexpected problem shape / workspace (%d inputs, out %d, ws %zu)\n", n_in, out_size, ws_size); grid = -1; return; }
        if (hipGetDevice(&dev) != hipSuccess || hipDeviceGetAttribute(&cus, hipDeviceAttributeMultiprocessorCount, dev) != hipSuccess) { grid = -1; return; }
        if (hipFuncSetAttribute((const void*)mega_fwd, hipFuncAttributeMaxDynamicSharedMemorySize, LDS_BYTES) != hipSuccess) { fprintf(stderr, "kernel_launch: hipFuncSetAttribute failed\n"); grid = -1; return; }
        grid = cus;
        if (grid != 256) fprintf(stderr, "kernel_launch: %d CUs; this kernel is laid out for 256\n", grid);
    }
    if (grid < 0) return;
    (void)in_sizes;
    (void)hipMemsetAsync((char*)d_ws + WS_CTL, 0, CTL_ZERO_BYTES, stream);
    launch_mega(stream, d_in, d_out, d_ws, 0, NPHASES, 0, grid);
#ifdef MK_PROBES
#ifdef EXTRA_LO
    launch_mega(stream, d_in, d_out, d_ws, EXTRA_LO, EXTRA_HI, 1, grid);
#endif
#endif
}
```

```cpp
#include <hip/hip_runtime.h>
#include <hip/hip_bf16.h>
#include <cstdio>
#include <cstdint>
#include <cmath>

constexpr int DM = 1024, BATCH = 8, SEQ = 2048, NTOK = BATCH * SEQ;
constexpr int DLRU = 512, DATT = 512, NH = 8, HD = 64, NPROJ = 2 * DLRU + 3 * DATT + NH, NPJ = 2560;
constexpr int NE = 32, TOPK = 4, DEXP = 1024, NMOD = 6;
constexpr float RMS_EPS = 1e-6f;
constexpr int MAXROWS = NTOK * TOPK + NE * 256;
constexpr int MAXMT = MAXROWS / 256;

namespace pg8 {
#define PG8_LAS __attribute__((address_space(3)))
typedef unsigned short bf16_t;
typedef short bf16x8 __attribute__((ext_vector_type(8)));
typedef float f32x4 __attribute__((ext_vector_type(4)));
typedef float f32x2 __attribute__((ext_vector_type(2)));
typedef unsigned u32x4 __attribute__((ext_vector_type(4)));
constexpr int BM = 256, BK = 64, HALF = 128, HTB = HALF * BK * 2  , STAGE_BYTES = 8 * HTB, NXCD = 8, WGM = 4;
constexpr int GK = 1024, GNT = GK / BK;
typedef int i32x8 __attribute__((ext_vector_type(8)));
typedef int i32x4 __attribute__((ext_vector_type(4)));
constexpr int F8_SCALE_W = 0x79797979, F8_SCALE_A = 0x7f7f7f7f;

__host__ __device__ __forceinline__ int lds_byte(int r, int c) { const int st = (r >> 4) * 2 + (c >> 5), rr = r & 15, cc = c & 31, ob = rr * 64 + cc * 2; return st * 1024 + (ob ^ (((ob >> 9) & 1) << 5)); }
__host__ __device__ __forceinline__ void stage_rc(int b, int& R, int& C) { const int st = b / 1024, sb = b % 1024, swz = sb ^ (((sb >> 9) & 1) << 5); R = (st >> 1) * 16 + swz / 64; C = (st & 1) * 32 + (swz % 64) / 2; }
__host__ __device__ __forceinline__ int perm32(int rho) { const int n = rho >> 4, i = rho & 15; return 8 * (i >> 2) + 4 * n + (i & 3); }

struct Unit { const char* A0; const char* A1; const char* B0; const char* B1; int pm, pn, e, ord; };

__device__ __forceinline__ void mfma_f8_acc(f32x4& acc, const i32x8& b, const i32x8& a, int sw, int sa) {
    asm volatile("v_mfma_scale_f32_16x16x128_f8f6f4 %0, %1, %2, %0, %3, %4 op_sel_hi:[0,0,0]" : "+v"(acc) : "v"(b), "v"(a), "v"(sw), "v"(sa)); }
__device__ __forceinline__ unsigned cvt_pk_bf16(float lo, float hi) { unsigned r; asm volatile("v_cvt_pk_bf16_f32 %0, %1, %2" : "=v"(r) : "v"(lo), "v"(hi)); return r; }

template <class Epi, class Sched, bool F8 = false, int KREP = 1>
__device__ __forceinline__ void gemm_phase(PG8_LAS unsigned char* lds, const Sched& S, const Epi& E) {
    const int tid = threadIdx.x, wid = __builtin_amdgcn_readfirstlane(tid >> 6), lane = tid & 63, wr = wid >> 2, wc = wid & 3, fr = lane & 15, fq = lane >> 4;
    constexpr int KB = F8 ? GK : GK * 2, nt1 = F8 ? GK / 128 : GNT, nt = nt1 * KREP;
    int Rr[2], Cc[2];
    unsigned voffB[2], cvA[2][2], nvA[2][2];
#pragma unroll
    for (int i = 0; i < 2; ++i) { stage_rc(tid * 16 + i * 8192, Rr[i], Cc[i]); const int Rb = Epi::PERM ? ((Rr[i] & ~31) + perm32(Rr[i] & 31)) : Rr[i]; voffB[i] = (unsigned)(Rb * KB + Cc[i] * 2); }
    constexpr size_t kstep = (size_t)(BK * 2);
    const unsigned ldsw = (unsigned)wid * 1024u;
    const int aoff = lds_byte(wr * 64 + fr, fq * 8), boff = lds_byte(wc * 32 + fr, fq * 8);
#define PG8_SA(b, h) (((b) * 2 + (h)) * HTB)
#define PG8_SB(b, h) ((4 + (b) * 2 + (h)) * HTB)
#define PG8_STAGE(bufoff, gbase, voff) do { _Pragma("unroll") for (int _i = 0; _i < 2; ++_i) \
        __builtin_amdgcn_global_load_lds((const unsigned*)((const char*)(gbase) + (voff)[_i]), (PG8_LAS unsigned*)(lds + (bufoff) + ldsw + _i * 8192), 16, 0, 0); } while (0)
#define PG8_LD8(p) __builtin_shufflevector(*(const PG8_LAS i32x4*)(p), *(const PG8_LAS i32x4*)((p) + 1024), 0, 1, 2, 3, 4, 5, 6, 7)
#define PG8_LDA(dst, b, h) do { _Pragma("unroll") for (int m = 0; m < 4; ++m) { if constexpr (F8) { dst##8[m] = PG8_LD8(lds + PG8_SA(b, h) + aoff + m * 2048); } \
        else { _Pragma("unroll") for (int k = 0; k < 2; ++k) dst[m][k] = *(const PG8_LAS bf16x8*)(lds + PG8_SA(b, h) + aoff + m * 2048 + k * 1024); } } } while (0)
#define PG8_LDB(dst, b, h) do { _Pragma("unroll") for (int n = 0; n < 2; ++n) { if constexpr (F8) { dst##8[n] = PG8_LD8(lds + PG8_SB(b, h) + boff + n * 2048); } \
        else { _Pragma("unroll") for (int k = 0; k < 2; ++k) dst[n][k] = *(const PG8_LAS bf16x8*)(lds + PG8_SB(b, h) + boff + n * 2048 + k * 1024); } } } while (0)
#define PG8_MMA(ai, bj, At, Bt) do { __builtin_amdgcn_s_setprio(1); _Pragma("unroll") for (int m = 0; m < 4; ++m) _Pragma("unroll") for (int n = 0; n < 2; ++n) { \
        if constexpr (F8) { mfma_f8_acc(acc[ai][bj][m][n], Bt##8[n], At##8[m], scw, sca); } \
        else { _Pragma("unroll") for (int k = 0; k < 2; ++k) acc[ai][bj][m][n] = __builtin_amdgcn_mfma_f32_16x16x32_bf16(Bt[n][k], At[m][k], acc[ai][bj][m][n], 0, 0, 0); } } \
        __builtin_amdgcn_s_setprio(0); } while (0)
#define PG8_WAIT_V(n) asm volatile("s_waitcnt vmcnt(" #n ")" ::: "memory")
    constexpr int RELAX = 8 + Epi::NST + (Sched::GATHER ? 4 : 0);
#define PG8_WAIT_V8R(rx) do { if (rx) { if constexpr (RELAX == 12) PG8_WAIT_V(12); else if constexpr (RELAX == 16) PG8_WAIT_V(16); else if constexpr (RELAX == 20) PG8_WAIT_V(20); \
        else if constexpr (RELAX == 24) PG8_WAIT_V(24); else if constexpr (RELAX == 28) PG8_WAIT_V(28); else PG8_WAIT_V(8); } else PG8_WAIT_V(8); } while (0)
#define PG8_WAIT_L(n) asm volatile("s_waitcnt lgkmcnt(" #n ")" ::: "memory")
#define PG8_BAR __builtin_amdgcn_s_barrier()
#define PG8_SCHED __builtin_amdgcn_sched_barrier(0)
#define PG8_VOFF(dst, u) do { _Pragma("unroll") for (int _h = 0; _h < 2; ++_h) _Pragma("unroll") for (int _i = 0; _i < 2; ++_i) { \
        const int _row = Sched::GATHER ? S.row_of(u, _h * HALF + Rr[_i]) : Rr[_i]; dst[_h][_i] = (unsigned)(_row * KB + Cc[_i] * 2); } } while (0)
    Unit cur, nxt; int ui = 0;
    if (!S.next(0, cur)) return;
    f32x4 acc[2][2][4][2];
#pragma unroll
    for (int a = 0; a < 2; ++a)
#pragma unroll
        for (int b = 0; b < 2; ++b)
#pragma unroll
            for (int m = 0; m < 4; ++m)
#pragma unroll
                for (int n = 0; n < 2; ++n) acc[a][b][m][n] = (f32x4){0.f, 0.f, 0.f, 0.f};
    const int scw = F8_SCALE_W, sca = F8_SCALE_A;
    bf16x8 At[4][2], B0[2][2], B1[2][2]; i32x8 At8[4], B08[2], B18[2];
    PG8_VOFF(cvA, cur);
    if (Sched::GATHER) { asm volatile("s_waitcnt vmcnt(0)" ::: "memory"); }
    PG8_STAGE(PG8_SB(0, 0), cur.B0, voffB); PG8_STAGE(PG8_SB(0, 1), cur.B1, voffB); PG8_STAGE(PG8_SA(0, 0), cur.A0, cvA[0]); PG8_STAGE(PG8_SA(0, 1), cur.A1, cvA[1]);
    if (wr == 1) PG8_BAR;
    PG8_WAIT_V(2); PG8_BAR;
    PG8_STAGE(PG8_SB(1, 0), cur.B0 + kstep, voffB); PG8_STAGE(PG8_SA(1, 0), cur.A0 + kstep, cvA[0]); PG8_STAGE(PG8_SB(1, 1), cur.B1 + kstep, voffB);
    PG8_WAIT_V(6); PG8_BAR;
    for (;;) {
        const bool has_next = S.next(ui + 1, nxt);
        if (!has_next) nxt = cur;
        int nraw[2][2];
        if (Sched::GATHER && has_next) {
#pragma unroll
            for (int _h = 0; _h < 2; ++_h)
#pragma unroll
                for (int _i = 0; _i < 2; ++_i) { const int* p_ = S.row_ptr(nxt, _h * HALF + Rr[_i]); asm volatile("global_load_dword %0, %1, off" : "=v"(nraw[_h][_i]) : "v"(p_) : "memory"); }
        }
        if (has_next) { if (!Sched::GATHER) { PG8_VOFF(nvA, nxt); } }
        else {
#pragma unroll
            for (int _h = 0; _h < 2; ++_h)
#pragma unroll
                for (int _i = 0; _i < 2; ++_i) nvA[_h][_i] = cvA[_h][_i]; }
#pragma unroll 1
        for (int t = 0; t < nt; t += 2) {
            const bool last = (t == nt - 2); const bool rx = (t == 0) && (ui > 0);
            if (Epi::MID && t == nt / 2) E.mid(acc, cur, wr, wc, fr, fq);
            const char* a1_1 = cur.A1 + (size_t)((t + 1) % nt1) * kstep;
            const char* a2_0 = last ? nxt.A0 : cur.A0 + (size_t)((t + 2) % nt1) * kstep; const char* a2_1 = last ? nxt.A1 : cur.A1 + (size_t)((t + 2) % nt1) * kstep;
            const char* b2_0 = last ? nxt.B0 : cur.B0 + (size_t)((t + 2) % nt1) * kstep; const char* b2_1 = last ? nxt.B1 : cur.B1 + (size_t)((t + 2) % nt1) * kstep;
            const char* a3_0 = a2_0 + kstep; const char* a3_1 = a2_1 + kstep; const char* b3_0 = b2_0 + kstep; const char* b3_1 = b2_1 + kstep;
            if (Sched::GATHER && last && has_next) {
#pragma unroll
                for (int _h = 0; _h < 2; ++_h)
#pragma unroll
                    for (int _i = 0; _i < 2; ++_i) { int r_ = nraw[_h][_i]; asm volatile("" : "+v"(r_));
                        nvA[_h][_i] = (unsigned)(r_ * KB + Cc[_i] * 2); } }
            unsigned sv0[2], sv1[2];
#pragma unroll
            for (int _i = 0; _i < 2; ++_i) { sv0[_i] = last ? nvA[0][_i] : cvA[0][_i]; sv1[_i] = last ? nvA[1][_i] : cvA[1][_i]; }
            PG8_LDB(B0, 0, 0); PG8_LDB(B1, 0, 1); PG8_SCHED; PG8_LDA(At, 0, 0); PG8_STAGE(PG8_SA(1, 1), a1_1, cvA[1]);
            PG8_WAIT_V8R(rx); PG8_WAIT_L(0); PG8_BAR; PG8_MMA(0, 0, At, B0); PG8_MMA(0, 1, At, B1); PG8_BAR; PG8_SCHED;
            PG8_LDA(At, 0, 1); PG8_STAGE(PG8_SB(0, 0), b2_0, voffB); PG8_STAGE(PG8_SB(0, 1), b2_1, voffB); PG8_STAGE(PG8_SA(0, 0), a2_0, sv0);
            PG8_WAIT_V8R(rx); PG8_WAIT_L(0); PG8_BAR; PG8_MMA(1, 0, At, B0); PG8_MMA(1, 1, At, B1); PG8_BAR; PG8_SCHED;
            PG8_LDB(B0, 1, 0); PG8_LDB(B1, 1, 1); PG8_SCHED; PG8_LDA(At, 1, 0); PG8_STAGE(PG8_SA(0, 1), a2_1, sv1);
            PG8_WAIT_V(8); PG8_WAIT_L(0); PG8_BAR; PG8_MMA(0, 0, At, B0); PG8_MMA(0, 1, At, B1); PG8_BAR; PG8_SCHED;
            PG8_LDA(At, 1, 1); PG8_STAGE(PG8_SB(1, 0), b3_0, voffB); PG8_STAGE(PG8_SB(1, 1), b3_1, voffB); PG8_STAGE(PG8_SA(1, 0), a3_0, sv0);
            PG8_WAIT_V(8); PG8_WAIT_L(0); PG8_BAR; PG8_MMA(1, 0, At, B0); PG8_MMA(1, 1, At, B1); PG8_BAR; PG8_SCHED;
            (void)a3_1; (void)b3_1;
        }
        if (wr == 0) PG8_BAR;
        if constexpr (F8) { asm volatile("s_nop 15\n\ts_nop 15\n\ts_nop 7" ::: "memory"); }
        E(acc, cur, wr, wc, fr, fq);
        if (!has_next) break;
#pragma unroll
        for (int a = 0; a < 2; ++a)
#pragma unroll
            for (int b = 0; b < 2; ++b)
#pragma unroll
                for (int m = 0; m < 4; ++m)
#pragma unroll
                    for (int n = 0; n < 2; ++n) acc[a][b][m][n] = (f32x4){0.f, 0.f, 0.f, 0.f};
        cur = nxt; ++ui;
#pragma unroll
        for (int _h = 0; _h < 2; ++_h)
#pragma unroll
            for (int _i = 0; _i < 2; ++_i) cvA[_h][_i] = nvA[_h][_i];
        if (wr == 1) PG8_BAR;
    }
    PG8_WAIT_V(0);
    PG8_BAR;
#undef PG8_SA
#undef PG8_SB
#undef PG8_STAGE
#undef PG8_LDA
#undef PG8_LDB
#undef PG8_MMA
#undef PG8_LD8
#undef PG8_WAIT_V
#undef PG8_WAIT_V8R
#undef PG8_WAIT_L
#undef PG8_BAR
#undef PG8_SCHED
#undef PG8_VOFF
}
}

namespace pg8 {

struct DenseOrder {
    static constexpr bool GATHER = false;
    const bf16_t* A; const bf16_t* Bt; int nM, nN, nwg, G, c;
    __device__ __forceinline__ void init(const bf16_t* A_, const bf16_t* Bt_, int M, int N, int G_, int c_) { A = A_; Bt = Bt_; nM = M / BM; nN = N / BM; nwg = nM * nN; G = G_; c = c_; }
    __device__ __forceinline__ bool next(int i, Unit& u) const {
        const long L = (long)i * G + c; if (L >= nwg) return false;
        int wgid = (int)L; { const int q = nwg / NXCD, r = nwg % NXCD, xcd = wgid % NXCD, off = wgid / NXCD; wgid = (xcd < r ? xcd * (q + 1) : r * (q + 1) + (xcd - r) * q) + off; }
        const int nig = WGM * nN, gid = wgid / nig, fm = gid * WGM, gsz = (nM - fm) < WGM ? (nM - fm) : WGM;
        u.pm = fm + ((wgid % nig) % gsz); u.pn = (wgid % nig) / gsz; u.e = 0; u.ord = i;
        u.A0 = (const char*)A + (size_t)u.pm * BM * GK * 2; u.A1 = u.A0 + (size_t)HALF * GK * 2;
        u.B0 = (const char*)Bt + (size_t)u.pn * BM * GK * 2; u.B1 = u.B0 + (size_t)HALF * GK * 2;
        return true;
    }
    __device__ __forceinline__ int row_of(const Unit&, int r) const { return r; }
    __device__ __forceinline__ const int* row_ptr(const Unit&, int) const { return nullptr; }
};
struct UpOrder {
    static constexpr bool GATHER = true;
    const unsigned char* H2; const unsigned char* WupT; const int* row_tok; const PG8_LAS int* mt_exp; int nunits, G, c;
    __device__ __forceinline__ bool next(int i, Unit& u) const {
        const int L = i * G + c; if (L >= nunits) return false;
        u.pm = L >> 3; u.pn = L & 7; u.e = __builtin_amdgcn_readfirstlane(mt_exp[u.pm]); u.ord = i;
        u.A0 = (const char*)H2; u.A1 = (const char*)H2;
        u.B0 = (const char*)WupT + ((size_t)u.e * 2 * DEXP + (size_t)u.pn * HALF) * GK; u.B1 = u.B0 + (size_t)DEXP * GK;
        return true;
    }
    __device__ __forceinline__ int row_of(const Unit& u, int r) const { return row_tok[u.pm * BM + r]; }
    __device__ __forceinline__ const int* row_ptr(const Unit& u, int r) const { return row_tok + u.pm * BM + r; }
};
struct DownOrder {
    static constexpr bool GATHER = false;
    const unsigned char* ACT; const unsigned char* WdnT; const PG8_LAS int* mt_exp; int nunits, G, c;
    __device__ __forceinline__ bool next(int i, Unit& u) const {
        const int L = i * G + c; if (L >= nunits) return false;
        u.pm = L >> 2; u.pn = L & 3; u.e = __builtin_amdgcn_readfirstlane(mt_exp[u.pm]); u.ord = i;
        u.A0 = (const char*)ACT + (size_t)u.pm * BM * GK; u.A1 = u.A0 + (size_t)HALF * GK;
        u.B0 = (const char*)WdnT + ((size_t)u.e * DM + (size_t)u.pn * BM) * GK; u.B1 = u.B0 + (size_t)HALF * GK;
        return true;
    }
    __device__ __forceinline__ int row_of(const Unit&, int r) const { return r; }
    __device__ __forceinline__ const int* row_ptr(const Unit&, int) const { return nullptr; }
};

struct EpiProj {
    static constexpr bool PERM = true, MID = false; static constexpr int NST = 16;
    bf16_t* O; size_t tstride; float qscale;
    __device__ __forceinline__ void mid(f32x4 (&)[2][2][4][2], const Unit&, int, int, int, int) const {}
    __device__ __forceinline__ void operator()(const f32x4 (&acc)[2][2][4][2], const Unit& u, int wr, int wc, int fr, int fq) const {
        const int t = u.pn >> 1; bf16_t* base = O + (size_t)t * tstride; const float sc = (t == 2) ? qscale : 1.f;
        const int row0 = u.pm * BM + wr * 64 + fr, col0 = (u.pn & 1) * BM + wc * 32 + 8 * fq;
#pragma unroll
        for (int ai = 0; ai < 2; ++ai)
#pragma unroll
            for (int m = 0; m < 4; ++m) { bf16_t* rowp = base + (size_t)(row0 + ai * HALF + m * 16) * 512 + col0;
#pragma unroll
                for (int bj = 0; bj < 2; ++bj) { const f32x4 v0 = acc[ai][bj][m][0] * sc, v1 = acc[ai][bj][m][1] * sc;
                    u32x4 w; w.x = cvt_pk_bf16(v0[0], v0[1]); w.y = cvt_pk_bf16(v0[2], v0[3]); w.z = cvt_pk_bf16(v1[0], v1[1]); w.w = cvt_pk_bf16(v1[2], v1[3]);
                    *(u32x4*)(rowp + bj * HALF) = w; } }
    }
};
struct EpiOut {
    static constexpr bool PERM = true, MID = true; static constexpr int NST = 0;
    bf16_t* Y; const float* ssq;
    __device__ __forceinline__ void mid(f32x4 (&acc)[2][2][4][2], const Unit& u, int wr, int wc, int fr, int fq) const {
#pragma unroll
        for (int ai = 0; ai < 2; ++ai)
#pragma unroll
            for (int m = 0; m < 4; ++m) { const int row = u.pm * BM + ai * HALF + wr * 64 + m * 16 + fr;
                const f32x4 s0 = *(const f32x4*)(ssq + (size_t)row * 8), s1 = *(const f32x4*)(ssq + (size_t)row * 8 + 4);
                const float tot = ((s0[0] + s0[1]) + (s0[2] + s0[3])) + ((s1[0] + s1[1]) + (s1[2] + s1[3]));
                const float ri = 1.0f / sqrtf(tot * (1.0f / DATT) + RMS_EPS);
#pragma unroll
                for (int bj = 0; bj < 2; ++bj)
#pragma unroll
                    for (int n = 0; n < 2; ++n) acc[ai][bj][m][n] = acc[ai][bj][m][n] * ri; }
    }
    __device__ __forceinline__ void operator()(const f32x4 (&acc)[2][2][4][2], const Unit& u, int wr, int wc, int fr, int fq) const {
        const int row0 = u.pm * BM + wr * 64 + fr, col0 = u.pn * BM + wc * 32 + 8 * fq;
#pragma unroll
        for (int ai = 0; ai < 2; ++ai)
#pragma unroll
            for (int m = 0; m < 4; ++m) { bf16_t* rowp = Y + (size_t)(row0 + ai * HALF + m * 16) * DM + col0;
#pragma unroll
                for (int bj = 0; bj < 2; ++bj) { const f32x4 v0 = acc[ai][bj][m][0], v1 = acc[ai][bj][m][1];
                    u32x4 w; w.x = cvt_pk_bf16(v0[0], v0[1]); w.y = cvt_pk_bf16(v0[2], v0[3]); w.z = cvt_pk_bf16(v1[0], v1[1]); w.w = cvt_pk_bf16(v1[2], v1[3]);
                    *(u32x4*)(rowp + bj * HALF) = w; } }
    }
};
template <bool STORE = true> struct EpiUpT {
    static constexpr bool PERM = true, MID = false; static constexpr int NST = STORE ? 8 : 0;
    unsigned char* ACT; const PG8_LAS float* bias;
    __device__ __forceinline__ void mid(f32x4 (&)[2][2][4][2], const Unit&, int, int, int, int) const {}
    __device__ __forceinline__ void operator()(const f32x4 (&acc)[2][2][4][2], const Unit& u, int wr, int wc, int fr, int fq) const {
        const int row0 = u.pm * BM + wr * 64 + fr, col0 = u.pn * HALF + wc * 32 + 8 * fq;
        const PG8_LAS float* bg = bias + u.ord * 256 + wc * 32 + 8 * fq;
        f32x4 bgl[2], bli[2];
#pragma unroll
        for (int n = 0; n < 2; ++n) { bgl[n] = *(const PG8_LAS f32x4*)(bg + 4 * n); bli[n] = *(const PG8_LAS f32x4*)(bg + HALF + 4 * n) + 1.0f; }
#pragma unroll
        for (int ai = 0; ai < 2; ++ai)
#pragma unroll
            for (int m = 0; m < 4; ++m) { unsigned char* rowp = ACT + (size_t)(row0 + ai * HALF + m * 16) * DEXP + col0;
                f32x4 o[2];
#pragma unroll
                for (int n = 0; n < 2; ++n) { f32x4 g = acc[ai][0][m][n] + bgl[n], l = acc[ai][1][m][n] + bli[n];
#pragma unroll
                    for (int j = 0; j < 4; ++j) { g[j] = fminf(g[j], 7.0f); l[j] = __builtin_amdgcn_fmed3f(l[j], -6.0f, 8.0f); }
                    f32x4 t = g * (-1.702f * 1.4426950408889634f);
#pragma unroll
                    for (int j = 0; j < 4; ++j) t[j] = __builtin_amdgcn_exp2f(t[j]);
                    t = t + 1.0f;
#pragma unroll
                    for (int j = 0; j < 4; ++j) t[j] = __builtin_amdgcn_rcpf(t[j]);
                    o[n] = (g * t) * l; }
                int w0 = 0, w1 = 0; w0 = __builtin_amdgcn_cvt_pk_fp8_f32(o[0][0], o[0][1], w0, false); w0 = __builtin_amdgcn_cvt_pk_fp8_f32(o[0][2], o[0][3], w0, true);
                w1 = __builtin_amdgcn_cvt_pk_fp8_f32(o[1][0], o[1][1], w1, false); w1 = __builtin_amdgcn_cvt_pk_fp8_f32(o[1][2], o[1][3], w1, true);
                typedef int i32x2_ __attribute__((ext_vector_type(2))); if (STORE) *(i32x2_*)rowp = (i32x2_){w0, w1}; else asm volatile("" :: "v"(w0), "v"(w1)); }
    }
};
typedef EpiUpT<true> EpiUp;
struct EpiDown {
    static constexpr bool PERM = true, MID = false; static constexpr int NST = 16;
    unsigned char* YP; const PG8_LAS float* bias; const int* row_pair; const float* row_w;
    __device__ __forceinline__ void mid(f32x4 (&)[2][2][4][2], const Unit&, int, int, int, int) const {}
    __device__ __forceinline__ void operator()(const f32x4 (&acc)[2][2][4][2], const Unit& u, int wr, int wc, int fr, int fq) const {
        const int row0 = u.pm * BM + wr * 64 + fr, col0 = u.pn * BM + wc * 32 + 8 * fq;
        const PG8_LAS float* bd = bias + u.ord * 256 + wc * 32 + 8 * fq;
        f32x4 bv[2][2];
#pragma unroll
        for (int bj = 0; bj < 2; ++bj)
#pragma unroll
            for (int n = 0; n < 2; ++n) bv[bj][n] = *(const PG8_LAS f32x4*)(bd + bj * HALF + 4 * n);
        int pr[2][4]; float wt[2][4];
#pragma unroll
        for (int ai = 0; ai < 2; ++ai)
#pragma unroll
            for (int m = 0; m < 4; ++m) { const int pos = row0 + ai * HALF + m * 16; pr[ai][m] = row_pair[pos]; wt[ai][m] = row_w[pos] * 4.0f; }
#pragma unroll
        for (int ai = 0; ai < 2; ++ai)
#pragma unroll
            for (int m = 0; m < 4; ++m) { const int pair = pr[ai][m] >= 0 ? pr[ai][m] : NTOK * TOPK; const float w = wt[ai][m];
                { unsigned char* rowp = YP + (size_t)pair * DM + col0;
#pragma unroll
                    for (int bj = 0; bj < 2; ++bj) { const f32x4 v0 = (acc[ai][bj][m][0] + bv[bj][0]) * w, v1 = (acc[ai][bj][m][1] + bv[bj][1]) * w;
                        int q0 = 0, q1 = 0; q0 = __builtin_amdgcn_cvt_pk_fp8_f32(v0[0], v0[1], q0, false); q0 = __builtin_amdgcn_cvt_pk_fp8_f32(v0[2], v0[3], q0, true);
                        q1 = __builtin_amdgcn_cvt_pk_fp8_f32(v1[0], v1[1], q1, false); q1 = __builtin_amdgcn_cvt_pk_fp8_f32(v1[2], v1[3], q1, true);
                        typedef int i32x2_ __attribute__((ext_vector_type(2))); *(i32x2_*)(rowp + bj * HALF) = (i32x2_){q0, q1}; } } }
    }
};
#ifdef MK_PROBES
struct EpiNop {
    static constexpr bool PERM = true, MID = false; static constexpr int NST = 0;
    __device__ __forceinline__ void mid(f32x4 (&)[2][2][4][2], const Unit&, int, int, int, int) const {}
    __device__ __forceinline__ void operator()(const f32x4 (&)[2][2][4][2], const Unit&, int, int, int, int) const {}
};
#endif
}

namespace attn_body {
using bf16=__hip_bfloat16;
using bf16x8=__attribute__((ext_vector_type(8)))short;
using s16x4=__attribute__((ext_vector_type(4)))short;
using f32x16=__attribute__((ext_vector_type(16)))float;
using u32x4=__attribute__((ext_vector_type(4)))unsigned;
constexpr int BATCH=8,NHEAD=8,SEQ=2048,D=64,DM=NHEAD*D,OPITCH=1024;
constexpr int NW=8,QBLK=32,QB=QBLK*NW,KVBLK=64,NQB=SEQ/QB;
constexpr int ATTN_PITCH=DM, ATTN_UNIT_ROWS=QB;
__device__ __forceinline__ int crow(int r,int hi){return (r&3)+8*(r>>2)+4*hi;}
#define SBAR() __builtin_amdgcn_sched_barrier(0)
__device__ __forceinline__ void cmask(f32x16&p0,f32x16&p1,int jb,int qrel,int hi){
  const float NEG=-INFINITY; int kb=64*jb+4*hi;
  #pragma unroll
  for(int r=0;r<16;++r){int kv=kb+(r&3)+8*(r>>2); if(kv>qrel)p0[r]=NEG; if(kv+32>qrel)p1[r]=NEG;}
}

constexpr int NSLOT=3, SLOTB=8192;
constexpr int LDS_K=0, LDS_V=NSLOT*SLOTB, LDS_WS=2*NSLOT*SLOTB, LDS_OST=LDS_WS+NW*64*4, LDS_BIAS=LDS_OST+NW*4096, LDS_SCAN=LDS_BIAS+(SEQ+64)*4, LDS_BYTES=LDS_SCAN+256;
constexpr float C2=0.125f*1.4426950408889634f;
__device__ __forceinline__ void glds16(const void*gsrc,unsigned lds_dst){unsigned keep;
  asm volatile("s_mov_b32 %0, m0\n\ts_mov_b32 m0, %2\n\ts_nop 0\n\tglobal_load_lds_dwordx4 %1, off\n\ts_mov_b32 m0, %0":"=&s"(keep):"v"(gsrc),"s"(lds_dst):"memory");}
__device__ __forceinline__ float max3f(float a,float b,float c){float r;asm("v_max3_f32 %0, %1, %2, %3":"=v"(r):"v"(a),"v"(b),"v"(c));return r;}
__device__ __forceinline__ float max2f(float a,float b){float r;asm("v_max_f32_e32 %0, %1, %2":"=v"(r):"v"(a),"v"(b));return r;}
__device__ __forceinline__ float fadd_s(float a,float b){float r;asm("v_add_f32_e32 %0, %1, %2":"=v"(r):"v"(a),"v"(b));return r;}
__device__ __forceinline__ float fsub_s(float a,float b){float r;asm("v_sub_f32_e32 %0, %1, %2":"=v"(r):"v"(a),"v"(b));return r;}
typedef float f32x2_t __attribute__((ext_vector_type(2))); typedef float f32x4_t __attribute__((ext_vector_type(4))); typedef __bf16 bf16x2_t __attribute__((ext_vector_type(2)));
__device__ __forceinline__ unsigned cvtpk_s(float lo,float hi){f32x2_t v={lo,hi};bf16x2_t b=__builtin_convertvector(v,bf16x2_t);return __builtin_bit_cast(unsigned,b);}
#define WAIT_BAR(N) asm volatile("s_waitcnt vmcnt(" #N ") lgkmcnt(0)\n\ts_barrier":::"memory")

__device__ __forceinline__ void qkt(f32x16&p0,f32x16&p1,const char*Kslot,const bf16x8*qr,int r32,int hi){
  const char*kb=Kslot+hi*1024+r32*16;
  #pragma unroll
  for(int d0=0;d0<4;++d0){
    const bf16x8 b0=*reinterpret_cast<const bf16x8*>(kb+d0*2048);
    const bf16x8 b1=*reinterpret_cast<const bf16x8*>(kb+d0*2048+512);
    p0=__builtin_amdgcn_mfma_f32_32x32x16_bf16(b0,qr[d0],p0,0,0,0);p1=__builtin_amdgcn_mfma_f32_32x32x16_bf16(b1,qr[d0],p1,0,0,0);}
}
typedef __attribute__((address_space(3))) const char* lds_cptr;
typedef short v4i16_t __attribute__((ext_vector_type(4)));
__device__ __forceinline__ void kload8(bf16x8*kf,lds_cptr kp){
  kf[0]=*(const __attribute__((address_space(3))) bf16x8*)(kp);      kf[1]=*(const __attribute__((address_space(3))) bf16x8*)(kp+512);
  kf[2]=*(const __attribute__((address_space(3))) bf16x8*)(kp+2048); kf[3]=*(const __attribute__((address_space(3))) bf16x8*)(kp+2560);
  kf[4]=*(const __attribute__((address_space(3))) bf16x8*)(kp+4096); kf[5]=*(const __attribute__((address_space(3))) bf16x8*)(kp+4608);
  kf[6]=*(const __attribute__((address_space(3))) bf16x8*)(kp+6144); kf[7]=*(const __attribute__((address_space(3))) bf16x8*)(kp+6656);
}
__device__ __forceinline__ void kload2(bf16x8*kf,lds_cptr kp,int j){ kf[2*j]=*(const __attribute__((address_space(3))) bf16x8*)(kp+j*2048); kf[2*j+1]=*(const __attribute__((address_space(3))) bf16x8*)(kp+j*2048+512); }
__device__ __forceinline__ s16x4 vtr(lds_cptr p){ return __builtin_bit_cast(s16x4,__builtin_amdgcn_ds_read_tr16_b64_v4i16((__attribute__((address_space(3))) v4i16_t*)p)); }
__device__ __forceinline__ float rowmax(const f32x16&p0,const f32x16&p1){
  float a=max3f(p0[0],p0[1],p1[0]),b=max3f(p0[2],p0[3],p1[1]);a=max3f(a,p1[2],p1[3]);
  #pragma unroll
  for(int r=4;r<16;r+=4){a=max3f(a,p0[r],p0[r+1]);b=max3f(b,p0[r+2],p0[r+3]);a=max3f(a,p1[r],p1[r+1]);b=max3f(b,p1[r+2],p1[r+3]);}
  const float m=max2f(a,b);
  auto rr=__builtin_amdgcn_permlane32_swap(__float_as_uint(m),__float_as_uint(m),false,false);
  return max2f(__uint_as_float(rr[0]),__uint_as_float(rr[1]));
}
__device__ __forceinline__ void pv(f32x16*o,int vb,bf16x8 pa0,bf16x8 pa1,bf16x8 pa2,bf16x8 pa3){
  #pragma unroll
  for(int d0=0;d0<2;++d0){s16x4 lo[4],hi[4];
    #pragma unroll
    for(int ks=0;ks<4;++ks){
      asm volatile("ds_read_b64_tr_b16 %0,%1 offset:%c2":"=&v"(lo[ks]):"v"(vb),"i"(d0*4096+ks*1024):"memory");
      asm volatile("ds_read_b64_tr_b16 %0,%1 offset:%c2":"=&v"(hi[ks]):"v"(vb),"i"(d0*4096+ks*1024+512):"memory");}
    asm volatile("s_waitcnt lgkmcnt(0)":::"memory");SBAR();
    #define PK(k) (bf16x8){lo[k][0],lo[k][1],lo[k][2],lo[k][3],hi[k][0],hi[k][1],hi[k][2],hi[k][3]}
    o[d0]=__builtin_amdgcn_mfma_f32_32x32x16_bf16(pa0,PK(0),o[d0],0,0,0);
    o[d0]=__builtin_amdgcn_mfma_f32_32x32x16_bf16(pa1,PK(1),o[d0],0,0,0);
    o[d0]=__builtin_amdgcn_mfma_f32_32x32x16_bf16(pa2,PK(2),o[d0],0,0,0);
    o[d0]=__builtin_amdgcn_mfma_f32_32x32x16_bf16(pa3,PK(3),o[d0],0,0,0);
    #undef PK
  }
}

#ifndef ATTN_STORE16
#define ATTN_STORE16(p,v) (*(u32x4*)(p)=(v))
#endif
template<int THRL> __device__ __forceinline__ void attn_unit(int b,int h,int qb,const bf16*Q,const bf16*__restrict__ K,const bf16*__restrict__ V,bf16*O,const float*__restrict__ LOGF2,float*SSQ,char*shm){
  const int tid=threadIdx.x,lane=tid&63,r32=lane&31,hi=lane>>5; const int wid=__builtin_amdgcn_readfirstlane(tid>>6);
  const long rowbase=(long)b*SEQ; const int q0=qb*QB;
  const bf16*Qw=Q+(rowbase+q0+wid*QBLK)*DM+h*D;
  const bf16*Kh=K+rowbase*DM+h*D,*Vh=V+rowbase*DM+h*D;
  const unsigned lds0=(unsigned)(uintptr_t)shm;
  float*wsf=(float*)(shm+LDS_WS)+wid*64;
  const bf16*ksrc=Kh+(long)lane*DM+wid*8;
  const bf16*vsrc=Vh+(long)(16*(wid&3)+(lane>>2))*DM+(wid>>2)*32+(lane&3)*8;
  const unsigned kdst=lds0+LDS_K+wid*1024, vdst=lds0+LDS_V+wid*1024;
  #define DMA_K(t,slot) glds16(ksrc+(long)(t)*KVBLK*DM,(unsigned)__builtin_amdgcn_readfirstlane(kdst+(slot)))
  #define DMA_V(t,slot) glds16(vsrc+(long)(t)*KVBLK*DM,(unsigned)__builtin_amdgcn_readfirstlane(vdst+(slot)))
  const int vb0=(int)(lds0+LDS_V)+((lane>>4)&1)*32+(lane&3)*8+(4*hi+((lane&15)>>2))*64;
  const char*Kbase=shm+LDS_K; bf16x8 kf[8];
  const lds_cptr shm3=(lds_cptr)shm; const lds_cptr kp0=shm3+LDS_K+hi*1024+r32*16; const lds_cptr vp0=shm3+LDS_V+((lane>>4)&1)*32+(lane&3)*8+(4*hi+((lane&15)>>2))*64;
  const int NT=(q0+QB)/KVBLK;
  const lds_cptr biasr=(lds_cptr)shm+LDS_BIAS+16*hi;
  #define BIAS4(t,o) (*(const __attribute__((address_space(3))) f32x4_t*)(biasr+(t)*(KVBLK*4)+(o)*4))
  #define INIT4(Y,g,t,o) do{ const f32x4_t x_=BIAS4(t,(o)+8*(g)); Y[4*(g)]=x_[0]-mhat; Y[4*(g)+1]=x_[1]-mhat; Y[4*(g)+2]=x_[2]-mhat; Y[4*(g)+3]=x_[3]-mhat; }while(0)
  #define INITT(Y0,Y1,t) do{ INIT4(Y0,0,t,0);INIT4(Y0,1,t,0);INIT4(Y0,2,t,0);INIT4(Y0,3,t,0); INIT4(Y1,0,t,32);INIT4(Y1,1,t,32);INIT4(Y1,2,t,32);INIT4(Y1,3,t,32); }while(0)
  DMA_K(0,0);DMA_V(0,0);DMA_K(1,SLOTB);
  bf16x8 qr[4];
  #pragma unroll
  for(int d0=0;d0<4;++d0)qr[d0]=*reinterpret_cast<const bf16x8*>(&Qw[(long)r32*DM+d0*16+hi*8]);
  float mhat,l_reg=0.f;f32x16 o[2];o[0]=f32x16{};o[1]=f32x16{};
  const int qrel=wid*QBLK+r32;
  #define CMASK(P0,P1,t) do{int jb_=(t)-(NT-4); if(jb_>=0)cmask(P0,P1,jb_,qrel,hi);}while(0)
  bool resc=false;
  #define START(P0,P1) do{ const float rm=rowmax(P0,P1); resc=false; \
    { const float dl=__builtin_fmaxf(rm,0.f); mhat=fadd_s(mhat,dl); \
      _Pragma("unroll") for(int r=0;r<16;++r){P0[r]=fsub_s(P0[r],dl);P1[r]=fsub_s(P1[r],dl);} } \
    _Pragma("unroll") for(int r=0;r<16;++r)P0[r]=__builtin_amdgcn_exp2f(P0[r]); }while(0)
  #define RESC() do{ if(resc){ asm volatile("s_waitcnt lgkmcnt(0)":::"memory"); \
      _Pragma("unroll") for(int d_=0;d_<2;++d_) _Pragma("unroll") for(int r=0;r<16;++r)o[d_][r]*=wsf[crow(r,hi)]; } }while(0)
  f32x16 pA0,pA1,pB0,pB1;
  int sl_prev=0,sl_cur=0,sl_next=SLOTB;
  #define ROT() do{sl_prev=sl_cur;sl_cur=sl_next;sl_next=(sl_next==(NSLOT-1)*SLOTB)?0:sl_next+SLOTB;}while(0)
  DMA_K(2,2*SLOTB);
  { float*biasl=(float*)(shm+LDS_BIAS); float*scn=(float*)(shm+LDS_SCAN);
    const float*lf=LOGF2+rowbase*NHEAD+h;
    float v0=0.f,v1=0.f,v2=0.f,v3=0.f; const int i0=4*tid;
    if(i0<q0){ v0=lf[(long)(q0-1-i0)*NHEAD]; v1=lf[(long)(q0-2-i0)*NHEAD]; v2=lf[(long)(q0-3-i0)*NHEAD]; v3=lf[(long)(q0-4-i0)*NHEAD]; }
    const float tsum=(v0+v1)+(v2+v3); float inc=tsum;
    #pragma unroll
    for(int o=1;o<64;o<<=1){ const float n_=__shfl_up(inc,o); if(lane>=o)inc+=n_; }
    if(lane==63)scn[wid]=inc;
    const float f0=lf[(long)(q0+4*lane)*NHEAD],f1=lf[(long)(q0+4*lane+1)*NHEAD],f2=lf[(long)(q0+4*lane+2)*NHEAD],f3=lf[(long)(q0+4*lane+3)*NHEAD];
    float finc=(f0+f1)+(f2+f3);
    #pragma unroll
    for(int o=1;o<64;o<<=1){ const float n_=__shfl_up(finc,o); if(lane>=o)finc+=n_; }
    const float fex=finc-((f0+f1)+(f2+f3));
    if(wid==0){ biasl[q0+4*lane]=-(fex+f0); biasl[q0+4*lane+1]=-(fex+f0+f1); biasl[q0+4*lane+2]=-(fex+f0+f1+f2); biasl[q0+4*lane+3]=-(fex+f0+f1+f2+f3); }
    __syncthreads();
    float woff=0.f;
    #pragma unroll
    for(int w_=0;w_<NW;++w_) woff+=(w_<wid)?scn[w_]:0.f;
    const float ex=woff+inc-tsum;
    if(i0<q0){ biasl[q0-1-i0]=ex; biasl[q0-2-i0]=ex+v0; biasl[q0-3-i0]=ex+v0+v1; biasl[q0-4-i0]=ex+v0+v1+v2; }
    __syncthreads(); }
  mhat=((const float*)(shm+LDS_BIAS))[q0+wid*QBLK+r32]+8.0f;

  WAIT_BAR(3);
  INITT(pA0,pA1,0); qkt(pA0,pA1,Kbase,qr,r32,hi);asm volatile("s_nop 15\n\ts_nop 7":"+v"(pA0),"+v"(pA1));CMASK(pA0,pA1,0);
  START(pA0,pA1);
  _Pragma("unroll") for(int r=0;r<16;++r)pA1[r]=__builtin_amdgcn_exp2f(pA1[r]);
  INITT(pB0,pB1,1);
  WAIT_BAR(0);
  DMA_K(3,0);DMA_V(1,SLOTB);
  ROT();
  kload8(kf,kp0+sl_cur);
  WAIT_BAR(2);
  s16x4 vlo[8],vhi[8]; u32x4 pw0,pw1,pw2,pw3;
  #define PKW(P,B) cvtpk_s(P[B],P[B+1])
  #define PAF(k) __builtin_bit_cast(bf16x8,pw##k)
  #define VFR(i) (bf16x8){vlo[i][0],vlo[i][1],vlo[i][2],vlo[i][3],vhi[i][0],vhi[i][1],vhi[i][2],vhi[i][3]}
  #define PIN(x) asm volatile("":"+v"(x))
  #define MX3(a,b,c) __builtin_fmaxf(__builtin_fmaxf((a),(b)),(c))
  #define GAPA(MF,A0,A1,A2,A3,W0,W1,PW) do{ MF; sacc+=A0; sacc+=A1; sacc+=A2; sacc+=A3; PIN(sacc); W0; W1; PIN(PW); SBAR(); }while(0)
  #define EX(v) __builtin_amdgcn_exp2f(v)
  #define GAPB(MF,X,B,GN,Y,tn,o) do{ MF; X[B]=EX(X[B]); X[B+1]=EX(X[B+1]); X[B+2]=EX(X[B+2]); X[B+3]=EX(X[B+3]); PIN(X); if(GN){ INIT4(Y,(B)/4,tn,o); PIN(Y); } SBAR(); }while(0)
  #define VRD(i) do{ vlo[i]=vtr(vp_+(((i)>>2)*4096+((i)&3)*1024)); vhi[i]=vtr(vp_+(((i)>>2)*4096+((i)&3)*1024+512)); }while(0)
  #define KRD(G,j) do{ if(G){ kload2(kf,kp0+sl_next,j); SBAR(); } }while(0)
  #define STEP(C0,C1,P0,P1,t,GK,GV,GL) do{ SBAR(); \
    const lds_cptr vp_=vp0+sl_prev; \
    VRD(0); SBAR(); float sacc=(P0[0]+P0[1]); \
    GAPA(C0=__builtin_amdgcn_mfma_f32_32x32x16_bf16(kf[0],qr[0],C0,0,0,0), P0[2],P0[3],P0[4],P0[5],     pw0[0]=PKW(P0,0), pw0[1]=PKW(P0,2), pw0); \
    VRD(4); SBAR(); GAPA(C1=__builtin_amdgcn_mfma_f32_32x32x16_bf16(kf[1],qr[0],C1,0,0,0), P0[6],P0[7],P0[8],P0[9],     pw0[2]=PKW(P0,4), pw0[3]=PKW(P0,6), pw0); \
    VRD(1); SBAR(); GAPA(C0=__builtin_amdgcn_mfma_f32_32x32x16_bf16(kf[2],qr[1],C0,0,0,0),   P0[10],P0[11],P0[12],P0[13], pw1[0]=PKW(P0,8), pw1[1]=PKW(P0,10), pw1); \
    VRD(5); SBAR(); GAPA(C1=__builtin_amdgcn_mfma_f32_32x32x16_bf16(kf[3],qr[1],C1,0,0,0),   P0[14],P0[15],P1[0],P1[1],   pw1[2]=PKW(P0,12),pw1[3]=PKW(P0,14), pw1); \
    VRD(2); SBAR(); GAPA(C0=__builtin_amdgcn_mfma_f32_32x32x16_bf16(kf[4],qr[2],C0,0,0,0),   P1[2],P1[3],P1[4],P1[5],     pw2[0]=PKW(P1,0), pw2[1]=PKW(P1,2), pw2); \
    VRD(6); SBAR(); GAPA(C1=__builtin_amdgcn_mfma_f32_32x32x16_bf16(kf[5],qr[2],C1,0,0,0),   P1[6],P1[7],P1[8],P1[9],     pw2[2]=PKW(P1,4), pw2[3]=PKW(P1,6), pw2); \
    VRD(3); SBAR(); GAPA(C0=__builtin_amdgcn_mfma_f32_32x32x16_bf16(kf[6],qr[3],C0,0,0,0),   P1[10],P1[11],P1[12],P1[13], pw3[0]=PKW(P1,8), pw3[1]=PKW(P1,10), pw3); \
    VRD(7); SBAR(); GAPA(C1=__builtin_amdgcn_mfma_f32_32x32x16_bf16(kf[7],qr[3],C1,0,0,0),   P1[14],P1[15],0.f,0.f,       pw3[2]=PKW(P1,12),pw3[3]=PKW(P1,14), pw3); \
    l_reg+=sacc; \
    if(GK){DMA_K((t)+3,sl_cur);} if(GV){DMA_V((t)+1,sl_next);} \
    CMASK(C0,C1,t); \
    { float a=MX3(C0[0],C0[1],C1[0]),b=MX3(C0[2],C0[3],C1[1]); a=MX3(a,C1[2],C1[3]); \
      _Pragma("unroll") for(int r=4;r<16;r+=4){a=MX3(a,C0[r],C0[r+1]);b=MX3(b,C0[r+2],C0[r+3]);a=MX3(a,C1[r],C1[r+1]);b=MX3(b,C1[r+2],C1[r+3]);} \
      float rm=__builtin_fmaxf(a,b); { auto rr=__builtin_amdgcn_permlane32_swap(__float_as_uint(rm),__float_as_uint(rm),false,false); rm=__builtin_fmaxf(__uint_as_float(rr[0]),__uint_as_float(rr[1])); } \
      resc=false; \
      if(__builtin_expect(__any(rm>(float)THRL),0)){ const float dl=__builtin_fmaxf(rm,0.f); mhat+=dl; \
        _Pragma("unroll") for(int r=0;r<16;++r){C0[r]-=dl;C1[r]-=dl;} \
        const float f=__builtin_amdgcn_exp2f(-dl); l_reg*=f; if(hi==0)wsf[r32]=f; resc=true; } } \
    SBAR(); \
    GAPB(o[0]=__builtin_amdgcn_mfma_f32_32x32x16_bf16(PAF(0),VFR(0),o[0],0,0,0), C0,0,  GL,P0,(t)+1,0); \
    GAPB(o[1]=__builtin_amdgcn_mfma_f32_32x32x16_bf16(PAF(0),VFR(4),o[1],0,0,0), C0,4,  GL,P0,(t)+1,0); \
    KRD(GL,0); GAPB(o[0]=__builtin_amdgcn_mfma_f32_32x32x16_bf16(PAF(1),VFR(1),o[0],0,0,0), C0,8,  GL,P0,(t)+1,0); \
    KRD(GL,1); GAPB(o[1]=__builtin_amdgcn_mfma_f32_32x32x16_bf16(PAF(1),VFR(5),o[1],0,0,0), C0,12, GL,P0,(t)+1,0); \
    KRD(GL,2); GAPB(o[0]=__builtin_amdgcn_mfma_f32_32x32x16_bf16(PAF(2),VFR(2),o[0],0,0,0), C1,0,  GL,P1,(t)+1,32); \
    KRD(GL,3); GAPB(o[1]=__builtin_amdgcn_mfma_f32_32x32x16_bf16(PAF(2),VFR(6),o[1],0,0,0), C1,4,  GL,P1,(t)+1,32); \
    GAPB(o[0]=__builtin_amdgcn_mfma_f32_32x32x16_bf16(PAF(3),VFR(3),o[0],0,0,0), C1,8,  GL,P1,(t)+1,32); \
    GAPB(o[1]=__builtin_amdgcn_mfma_f32_32x32x16_bf16(PAF(3),VFR(7),o[1],0,0,0), C1,12, GL,P1,(t)+1,32); \
    }while(0)
  int t=1;
  #undef CMASK
  #define CMASK(P0,P1,t) do{}while(0)
  for(;t+5<NT;t+=2){
    STEP(pB0,pB1,pA0,pA1,t,true,true,true);     WAIT_BAR(2); RESC(); ROT();
    STEP(pA0,pA1,pB0,pB1,t+1,true,true,true);   WAIT_BAR(2); RESC(); ROT();
  }
  #undef CMASK
  #define CMASK(P0,P1,t) do{int jb_=(t)-(NT-4); if(jb_>=0)cmask(P0,P1,jb_,qrel,hi);}while(0)
  #define ENDW(tt) do{ if((tt)+3<NT){WAIT_BAR(2);} else if((tt)+2<NT){WAIT_BAR(1);} else {WAIT_BAR(0);} }while(0)
  for(;t+1<NT;t+=2){
    STEP(pB0,pB1,pA0,pA1,t,(t+3<NT),(t+1<NT),(t+1<NT));       ENDW(t);   RESC(); ROT();
    STEP(pA0,pA1,pB0,pB1,t+1,(t+4<NT),(t+2<NT),(t+2<NT));     ENDW(t+1); RESC(); ROT();
  }
  STEP(pB0,pB1,pA0,pA1,NT-1,false,false,false); RESC();
  { float sacc=pB0[0]+pB0[1]; _Pragma("unroll") for(int r=2;r<16;++r)sacc+=pB0[r]; _Pragma("unroll") for(int r=0;r<16;++r)sacc+=pB1[r]; l_reg+=sacc;
    pw0=(u32x4){PKW(pB0,0),PKW(pB0,2),PKW(pB0,4),PKW(pB0,6)};pw1=(u32x4){PKW(pB0,8),PKW(pB0,10),PKW(pB0,12),PKW(pB0,14)};pw2=(u32x4){PKW(pB1,0),PKW(pB1,2),PKW(pB1,4),PKW(pB1,6)};pw3=(u32x4){PKW(pB1,8),PKW(pB1,10),PKW(pB1,12),PKW(pB1,14)};
    SBAR(); pv(o,vb0+sl_cur,PAF(0),PAF(1),PAF(2),PAF(3)); }
  #undef PKW
  #undef PAF
  #undef VFR
  #undef PIN
  #undef MX3
  #undef GAPA
  #undef GAPB
  #undef EX
  #undef VRD
  #undef KRD
  #undef STEP
  #undef ENDW
  {auto rr=__builtin_amdgcn_permlane32_swap(__float_as_uint(l_reg),__float_as_uint(l_reg),false,false);l_reg=__uint_as_float(rr[0])+__uint_as_float(rr[1]);}
  if(hi==0)wsf[32+r32]=l_reg;asm volatile("s_waitcnt lgkmcnt(0)":::"memory");
  float rli[16];
  #pragma unroll
  for(int r=0;r<16;++r)rli[r]=__builtin_amdgcn_rcpf(wsf[32+crow(r,hi)]);
  bf16*Ow=O+(rowbase+q0+wid*QBLK)*OPITCH+h*D; float*Sw=SSQ+(rowbase+q0+wid*QBLK)*NHEAD+h;
  { bf16*stg=(bf16*)(shm+LDS_OST)+wid*2048;
    #pragma unroll
    for(int r=0;r<16;++r){const int orow=crow(r,hi);
      #pragma unroll
      for(int d0=0;d0<2;++d0)stg[orow*64+d0*32+r32]=__float2bfloat16(o[d0][r]*rli[r]);}
    asm volatile("s_waitcnt lgkmcnt(0)":::"memory");
    #pragma unroll
    for(int i=0;i<4;++i){const int row=i*8+(lane>>3),ch=lane&7; const u32x4 v=*(const u32x4*)(stg+row*64+ch*8); ATTN_STORE16(Ow+(long)row*OPITCH+ch*8,v);
      float sq=0.f;
      #pragma unroll
      for(int j=0;j<4;++j){ const float lo_=__uint_as_float(v[j]<<16), hi_=__uint_as_float(v[j]&0xffff0000u); sq+=lo_*lo_+hi_*hi_; }
      sq+=__shfl_xor(sq,1); sq+=__shfl_xor(sq,2); sq+=__shfl_xor(sq,4);
      if(ch==0)Sw[(long)row*NHEAD]=sq; } }
  asm volatile("s_waitcnt lgkmcnt(0)\n\ts_barrier":::"memory");
  #undef DMA_K
  #undef BIAS4
  #undef INIT4
  #undef INITT
  #undef DMA_V
  #undef CMASK
  #undef START
  #undef RESC
  #undef ROT
}
constexpr int ATTN_LDS_BYTES=LDS_BYTES;
struct AttnTensors { const bf16* Q; const bf16* K; const bf16* V; bf16* O; const float* LOGF2; float* SSQ; };
struct AttnUnit { int bh; int qb; };
struct StaticOrder {
  int vcu,G;
  __device__ __forceinline__ explicit StaticOrder(int grid,int vcu_):vcu(vcu_),G(grid){}
  __device__ __forceinline__ bool next(int i,AttnUnit&u)const{ const int L=(i>>1)*G+vcu; if(L>=BATCH*NHEAD*4)return false; const int s=L&3; u.bh=L>>2; u.qb=(i&1)?7-s:s; return true; }
  __device__ __forceinline__ void a_ready(const AttnUnit&)const{}
  __device__ __forceinline__ void done(const AttnUnit&)const{}
};
template<class Sched,int THRL=8> __device__ __forceinline__ void attn_phase(char*lds,const AttnTensors&T,const Sched&S){
  AttnUnit u;
  for(int i=0;S.next(i,u);++i){ S.a_ready(u); attn_unit<THRL>(u.bh/NHEAD,u.bh%NHEAD,u.qb,T.Q,T.K,T.V,T.O,T.LOGF2,T.SSQ,lds); S.done(u); }
}
#undef SBAR
#undef WAIT_BAR
}

constexpr int NWAVES = 8;
constexpr int NPHASES = 11;

constexpr size_t MiB = 1u << 20, KiB = 1u << 10;
constexpr size_t WS_CTL = 0, CTL_ZERO_BYTES = 1 * MiB;
constexpr size_t WS_MOD = 1 * MiB;
constexpr size_t WS_LOGF2 = 1 * MiB + 256 * KiB;
constexpr size_t WS_SSQ = 1 * MiB + 768 * KiB;
constexpr size_t WS_TOPI = 2 * MiB + 256 * KiB;
constexpr size_t WS_TOPW = 2 * MiB + 512 * KiB;
constexpr size_t WS_WGCNT = 2 * MiB + 768 * KiB;
constexpr size_t WS_LSUM = 3 * MiB;
constexpr size_t WS_ROWTOK = 4 * MiB, WS_ROWPAIR = 4 * MiB + 512 * KiB, WS_ROWW = 5 * MiB, WS_MTEXP = 5 * MiB + 512 * KiB;
constexpr size_t WS_LWT = 6 * MiB;
constexpr size_t WS_WFT = 6 * MiB + 512 * KiB;
constexpr size_t WS_WRT = 7 * MiB;
constexpr size_t WS_WIN = 8 * MiB;
constexpr size_t WS_WOUT = 13 * MiB;
constexpr size_t WS_WUP = 16 * MiB;
constexpr size_t WS_WDN = 144 * MiB;
constexpr size_t WS_H1 = 208 * MiB;
constexpr size_t WS_PJ = 240 * MiB;
constexpr size_t PJ_STRIDE = (size_t)NTOK * 512;
constexpr size_t WS_MRG = 320 * MiB;
constexpr size_t WS_Y = 352 * MiB;
constexpr size_t WS_H2 = 416 * MiB;
constexpr size_t WS_ACT = 448 * MiB;
constexpr size_t WS_YP = 592 * MiB;
constexpr size_t WS_LTOK = 720 * MiB, WS_LPAIR = 722 * MiB, WS_LW = 724 * MiB;
constexpr size_t WS_END = 726 * MiB;
static_assert(WS_ACT + (size_t)MAXROWS * 1024 * 2 <= WS_YP && WS_YP + (size_t)NTOK * 4 * 1024 * 2 <= WS_END, "d_ws map");
constexpr int CW_CNT = 200000;
constexpr int CW_BAR = 4096;

constexpr int LDS_BYTES = 147456;
constexpr int LDSCTL_OFF = LDS_BYTES - 512, MISC_OFF = LDSCTL_OFF + 320;
constexpr int SCRATCH_BYTES = LDSCTL_OFF;

#define GAS __attribute__((address_space(1)))
#define LAS __attribute__((address_space(3)))
typedef unsigned short bf16;
typedef unsigned v4u __attribute__((ext_vector_type(4)));
typedef unsigned v2u __attribute__((ext_vector_type(2)));
typedef float f32x4 __attribute__((ext_vector_type(4)));
typedef float f32x16 __attribute__((ext_vector_type(16)));
typedef short bf16x8 __attribute__((ext_vector_type(8)));
typedef GAS unsigned gu32;
#define RLX_AGENT __ATOMIC_RELAXED, __HIP_MEMORY_SCOPE_AGENT
#define LDS_WAIT() asm volatile("s_waitcnt lgkmcnt(0)" ::: "memory")
#define VM_WAIT() asm volatile("s_waitcnt vmcnt(0)" ::: "memory")
typedef float f32x2_cv __attribute__((ext_vector_type(2))); typedef __bf16 bf16x2_cv __attribute__((ext_vector_type(2)));
__device__ __forceinline__ unsigned pk2(float lo, float hi) { const f32x2_cv v = {lo, hi}; return __builtin_bit_cast(unsigned, __builtin_convertvector(v, bf16x2_cv)); }
__device__ __forceinline__ unsigned f2bf(float f) { return pk2(f, 0.f) & 0xffffu; }
__device__ __forceinline__ float bflo(unsigned w) { return __uint_as_float(w << 16); }
__device__ __forceinline__ float bfhi(unsigned w) { return __uint_as_float(w & 0xffff0000u); }
__device__ __forceinline__ float bf1(bf16 h) { return __uint_as_float((unsigned)h << 16); }

#define XB_TMO      128
#define XB_XCNT(j)  (256  + 64 * (j))
#define XB_XSUB(j)  (1280 + 64 * (j))
#define XB_XGEN(j)  (2304 + 64 * (j))
#define XB_TOP      3328
#define XB_TOPGEN   3392
#define XCD_BAR_WORDS 3456
#define XB_SPIN_CAP (1u << 18)
__device__ __forceinline__ unsigned xb_ld(unsigned* p)              { return __hip_atomic_load(p, __ATOMIC_RELAXED, __HIP_MEMORY_SCOPE_AGENT); }
__device__ __forceinline__ unsigned xb_add(unsigned* p, unsigned v) { return __hip_atomic_fetch_add(p, v, __ATOMIC_RELAXED, __HIP_MEMORY_SCOPE_AGENT); }
__device__ __forceinline__ unsigned xb_xcc_id() { return (unsigned)__builtin_amdgcn_s_getreg((3 << 11) | 20) & 0xFu; }
#define XB_SPIN(cond, bar) do { unsigned _sp = 0; while (cond) { __builtin_amdgcn_s_sleep(1); \
    if ((++_sp & 255u) == 0u) { if (xb_ld(&(bar)[XB_TMO])) break; if (_sp > XB_SPIN_CAP) { atomicAdd(&(bar)[XB_TMO], 1u); break; } } } } while (0)
struct XcdBarrier { unsigned* bar; unsigned x; volatile LAS unsigned* st; };
__device__ __forceinline__ XcdBarrier xcd_barrier_post(unsigned* bar, volatile LAS unsigned* st) {
    XcdBarrier b; b.bar = bar; b.x = xb_xcc_id(); b.st = st;
    if (threadIdx.x == 0) (void)xb_add(&bar[XB_XCNT(b.x)], 1u);
    return b;
}
__device__ __forceinline__ void xcd_barrier_complete(unsigned* bar, unsigned x, unsigned& nloc, unsigned& nx) {
    const unsigned G = gridDim.x * gridDim.y * gridDim.z;
    unsigned sum, cnt, mine, sp = 0u;
    for (;;) {
        sum = 0u; cnt = 0u; mine = 0u;
#pragma unroll
        for (unsigned j = 0; j < 16; ++j) { const unsigned c = xb_ld(&bar[XB_XCNT(j)]); sum += c; cnt += (c > 0u) ? 1u : 0u; mine = (j == x) ? c : mine; }
        if (sum == G) break;
        __builtin_amdgcn_s_sleep(1);
        if ((++sp & 255u) == 0u) { if (xb_ld(&bar[XB_TMO])) break; if (sp > XB_SPIN_CAP) { atomicAdd(&bar[XB_TMO], 1u); break; } }
    }
    nloc = mine > 0u ? mine : 1u; nx = cnt > 0u ? cnt : 1u;
}
__device__ __forceinline__ void xcd_barrier(const XcdBarrier& b) {
    asm volatile("s_waitcnt vmcnt(0)" ::: "memory");
    __syncthreads();
    if (threadIdx.x == 0) {
        unsigned* bar = b.bar;
        __builtin_amdgcn_s_waitcnt(0);
        unsigned nloc = b.st[0], nx = b.st[1];
        if (nloc == 0u) { xcd_barrier_complete(bar, b.x, nloc, nx); b.st[0] = nloc; b.st[1] = nx; }
        const unsigned old = xb_add(&bar[XB_XSUB(b.x)], 1u);
        const unsigned gen = old / nloc;
        if (old + 1u == (gen + 1u) * nloc) {
            __builtin_amdgcn_fence(__ATOMIC_RELEASE, "agent");
            asm volatile("s_waitcnt vmcnt(0)" ::: "memory");
            const unsigned og = xb_add(&bar[XB_TOP], 1u);
            const unsigned tg = og / nx;
            if (og + 1u == (tg + 1u) * nx) xb_add(&bar[XB_TOPGEN], 1u);
            else XB_SPIN(xb_ld(&bar[XB_TOPGEN]) == tg, bar);
            __builtin_amdgcn_fence(__ATOMIC_ACQUIRE, "agent");
            xb_add(&bar[XB_XGEN(b.x)], 1u);
            asm volatile("s_waitcnt vmcnt(0)" ::: "memory");
        } else {
            XB_SPIN(xb_ld(&bar[XB_XGEN(b.x)]) == gen, bar);
            __builtin_amdgcn_fence(__ATOMIC_ACQUIRE, "agent");
            asm volatile("s_waitcnt vmcnt(0)" ::: "memory");
        }
    }
    __syncthreads();
}

struct Args { const float* in[26]; float* out; unsigned char* ws; int ph_lo, ph_hi, li, pad; };
struct Frame {
    LAS unsigned char* lds;
    int tid, lane, wave, vcu, G;
    float* out; unsigned char* ws;
    __device__ __forceinline__ const float* in(int k) const { const LAS unsigned* t = (const LAS unsigned*)(lds + LDSCTL_OFF) + 2 * k;
        const unsigned lo = (unsigned)__builtin_amdgcn_readfirstlane((int)t[0]), hi = (unsigned)__builtin_amdgcn_readfirstlane((int)t[1]);
        return (const float*)(const GAS float*)(((unsigned long long)hi << 32) | lo); }
};
template <int CTRL> __device__ __forceinline__ float dpp_mov(float x) { return __builtin_bit_cast(float, __builtin_amdgcn_update_dpp(0, __builtin_bit_cast(int, x), CTRL, 0xF, 0xF, false)); }
__device__ __forceinline__ float lane_xor1(float x) { return dpp_mov<0xB1>(x); }
__device__ __forceinline__ float lane_xor2(float x) { return dpp_mov<0x4E>(x); }
__device__ __forceinline__ float lane_xor4(float x) { return dpp_mov<0x1B>(dpp_mov<0x141>(x)); }
__device__ __forceinline__ float lane_xor8(float x) { return dpp_mov<0x128>(x); }
__device__ __forceinline__ void swap_rows16(float& a, float& b) { asm volatile("s_nop 1\n\tv_permlane16_swap_b32 %0, %1" : "+v"(a), "+v"(b)); }
__device__ __forceinline__ void swap_half32(float& a, float& b) { asm volatile("s_nop 1\n\tv_permlane32_swap_b32 %0, %1" : "+v"(a), "+v"(b)); }
__device__ __forceinline__ float wave_sum(float v) {
    v += lane_xor1(v); v += lane_xor2(v); v += lane_xor4(v); v += lane_xor8(v);
    { float a = v, b = v; swap_rows16(a, b); v = a + b; }
    { float a = v, b = v; swap_half32(a, b); v = a + b; }
    return v;
}
__device__ __forceinline__ float wave_max(float v) {
    v = fmaxf(v, lane_xor1(v)); v = fmaxf(v, lane_xor2(v)); v = fmaxf(v, lane_xor4(v)); v = fmaxf(v, lane_xor8(v));
    { float a = v, b = v; swap_rows16(a, b); v = fmaxf(a, b); }
    { float a = v, b = v; swap_half32(a, b); v = fmaxf(a, b); }
    return v;
}
__device__ __forceinline__ float sigmoid_f(float x) { return __builtin_amdgcn_rcpf(1.0f + __builtin_amdgcn_exp2f(-1.4426950408889634f * x)); }
__device__ __forceinline__ float gelu_tanh_f(float x) { const float u = 0.7978845608028654f * (x + 0.044715f * x * x * x); const float e = __builtin_amdgcn_exp2f(2.8853900817779268f * u); return x * (1.0f - __builtin_amdgcn_rcpf(e + 1.0f)); }
__device__ __forceinline__ float log_sigmoid_f(float z) { return z >= 0.f ? -log1pf(expf(-z)) : z - log1pf(expf(z)); }
__device__ __forceinline__ float softplus_f(float z) { return z > 0.f ? z + log1pf(expf(-z)) : log1pf(expf(z)); }

__device__ __forceinline__ void p0_transpose_item(const float* W, int ldw, bf16* WT, int k0, int n0, int kdst0, const float* gain, LAS float* scr, int lane) {
#pragma unroll 8
    for (int i = 0; i < 32; ++i) { const int kk = 2 * i + (lane >> 5); float v = W[(size_t)(k0 + kk) * ldw + n0 + (lane & 31)]; if (gain) v *= gain[k0 + kk]; scr[kk * 33 + (lane & 31)] = v; }
    LDS_WAIT(); asm volatile("" ::: "memory");
    const int c = lane & 7;
#pragma unroll
    for (int j = 0; j < 4; ++j) { const int n = (lane >> 3) + 8 * j; const LAS float* s = scr + (8 * c) * 33 + n;
        v4u o; o.x = pk2(s[0 * 33], s[1 * 33]); o.y = pk2(s[2 * 33], s[3 * 33]); o.z = pk2(s[4 * 33], s[5 * 33]); o.w = pk2(s[6 * 33], s[7 * 33]);
        *(GAS v4u*)(WT + (size_t)(n0 + n) * 1024 + kdst0 + 8 * c) = o; }
    LDS_WAIT(); asm volatile("" ::: "memory");
}
constexpr int CV_UP_ITEMS = NE * 16 * 32, CV_DN_ITEMS = NE * 16 * 16;
constexpr int CV_UP_TAIL = 8192, CV_DN_TAIL = 4096;
__device__ __forceinline__ void cvt_block_f8(const float* W, int ldw, unsigned char* WT, LAS unsigned char* scr, int lane) {
    float v[64];
#pragma unroll
    for (int i = 0; i < 64; ++i) v[i] = W[(size_t)i * ldw + lane];
#pragma unroll
    for (int q = 0; q < 4; ++q) { int w[4];
#pragma unroll
        for (int j = 0; j < 4; ++j) { int t = 0; t = __builtin_amdgcn_cvt_pk_fp8_f32(v[16 * q + 4 * j] * 64.0f, v[16 * q + 4 * j + 1] * 64.0f, t, false); t = __builtin_amdgcn_cvt_pk_fp8_f32(v[16 * q + 4 * j + 2] * 64.0f, v[16 * q + 4 * j + 3] * 64.0f, t, true); w[j] = t; }
        *(LAS v4u*)(scr + lane * 80 + 16 * q) = (v4u){(unsigned)w[0], (unsigned)w[1], (unsigned)w[2], (unsigned)w[3]}; }
    LDS_WAIT(); asm volatile("" ::: "memory");
#pragma unroll
    for (int j = 0; j < 4; ++j) { const int row = 16 * j + (lane >> 2), c = lane & 3;
        *(GAS v4u*)(WT + (size_t)row * 1024 + 16 * c) = *(const LAS v4u*)(scr + row * 80 + 16 * c); }
    LDS_WAIT(); asm volatile("" ::: "memory");
}
__device__ __forceinline__ void cvt_up_item(Frame& F, int u) { const int e = u >> 9, q = u & 511, kb = q >> 5, nb = q & 31;
    cvt_block_f8(F.in(22) + (size_t)e * DM * 2 * DEXP + (size_t)(64 * kb) * (2 * DEXP) + 64 * nb, 2 * DEXP, (unsigned char*)(F.ws + WS_WUP) + ((size_t)e * 2 * DEXP + 64 * nb) * 1024 + 64 * kb, F.lds + F.wave * 16384, F.lane); }
__device__ __forceinline__ void cvt_dn_item(Frame& F, int d) { const int e = d >> 8, q = d & 255, kb = q >> 4, nb = q & 15;
    cvt_block_f8(F.in(24) + (size_t)e * DEXP * DM + (size_t)(64 * kb) * DM + 64 * nb, DM, (unsigned char*)(F.ws + WS_WDN) + ((size_t)e * DM + 64 * nb) * 1024 + 64 * kb, F.lds + F.wave * 16384, F.lane); }
template <bool UP> __device__ __forceinline__ void cvt_range(Frame& F, int lo, int hi, int wr_, int nw) {
    for (int it = lo + wr_; it < hi; it += nw) { if (UP) cvt_up_item(F, it); else cvt_dn_item(F, it); }
}
__device__ __forceinline__ void p0_transpose_item_f8(const float* W, int ldw, unsigned char* WT, int k0, int n0, float scale, LAS float* scr, int lane) {
#pragma unroll 8
    for (int i = 0; i < 32; ++i) { const int kk = 2 * i + (lane >> 5); scr[kk * 33 + (lane & 31)] = W[(size_t)(k0 + kk) * ldw + n0 + (lane & 31)] * scale; }
    LDS_WAIT(); asm volatile("" ::: "memory");
    const int c = lane & 7;
#pragma unroll
    for (int j = 0; j < 4; ++j) { const int n = (lane >> 3) + 8 * j; const LAS float* s = scr + (8 * c) * 33 + n;
        int w0 = 0, w1 = 0; w0 = __builtin_amdgcn_cvt_pk_fp8_f32(s[0 * 33], s[1 * 33], w0, false); w0 = __builtin_amdgcn_cvt_pk_fp8_f32(s[2 * 33], s[3 * 33], w0, true);
        w1 = __builtin_amdgcn_cvt_pk_fp8_f32(s[4 * 33], s[5 * 33], w1, false); w1 = __builtin_amdgcn_cvt_pk_fp8_f32(s[6 * 33], s[7 * 33], w1, true);
        typedef int i32x2_ __attribute__((ext_vector_type(2))); *(GAS i32x2_*)(WT + (size_t)(n0 + n) * 1024 + k0 + 8 * c) = (i32x2_){w0, w1}; }
    LDS_WAIT(); asm volatile("" ::: "memory");
}
template <int PARTS = 7> __device__ __forceinline__ void p0_phase(Frame& F) {
    const float* c_in = F.in(1); const float* w_ada = F.in(2); const float* b_ada = F.in(3);
    float* MOD = (float*)(F.ws + WS_MOD);
    if ((PARTS & 1) && F.vcu < 192) {
        LAS float* sc = (LAS float*)F.lds;
        LAS float* red = (LAS float*)(F.lds + 32768);
        for (int i = F.tid; i < BATCH * DM; i += NWAVES * 64) { const int b = i >> 10, k = i & 1023; const float v = c_in[i]; sc[k * 8 + b] = v * sigmoid_f(v); }
        __syncthreads();
        for (int ci = F.vcu; ci < 192; ci += F.G) {
            const int col = F.lane & 31, ks = F.lane >> 5;
            float acc[8];
#pragma unroll
            for (int b = 0; b < 8; ++b) acc[b] = 0.f;
            const float* wp = w_ada + (size_t)(128 * F.wave + ks) * (NMOD * DM) + ci * 32 + col;
#pragma unroll 1
            for (int i0 = 0; i0 < 64; i0 += 32) {
                float wv[32];
#pragma unroll
                for (int i = 0; i < 32; ++i) wv[i] = wp[(size_t)(2 * (i0 + i)) * (NMOD * DM)];
#pragma unroll
                for (int i = 0; i < 32; ++i) { const LAS f32x4* sp = (const LAS f32x4*)(sc + (128 * F.wave + 2 * (i0 + i) + ks) * 8); const f32x4 s0 = sp[0], s1 = sp[1];
                    acc[0] += s0[0] * wv[i]; acc[1] += s0[1] * wv[i]; acc[2] += s0[2] * wv[i]; acc[3] += s0[3] * wv[i]; acc[4] += s1[0] * wv[i]; acc[5] += s1[1] * wv[i]; acc[6] += s1[2] * wv[i]; acc[7] += s1[3] * wv[i]; }
            }
#pragma unroll
            for (int b = 0; b < 8; ++b) { acc[b] += __shfl_xor(acc[b], 32); if (ks == 0) red[(F.wave * 8 + b) * 32 + col] = acc[b]; }
            __syncthreads();
            if (F.tid < 256) { const int b = F.tid >> 5, cl = F.tid & 31; float s = 0.f;
#pragma unroll
              for (int w = 0; w < 8; ++w) s += red[(w * 8 + b) * 32 + cl];
              MOD[b * NMOD * DM + ci * 32 + cl] = s + b_ada[ci * 32 + cl]; }
            __syncthreads();
        }
    }
    __syncthreads();
    const float* w_in = F.in(6); const float* w_out = F.in(17); const float* gn_attn = F.in(16);
    bf16* WIN = (bf16*)(F.ws + WS_WIN); bf16* WOUT = (bf16*)(F.ws + WS_WOUT);
    LAS float* scr = (LAS float*)(F.lds + F.wave * 16384);
    const int gw = F.vcu * NWAVES + F.wave, NGW = F.G * NWAVES;
    constexpr int I_IN = 16 * (NPJ / 32), I_OUT = 16 * (DM / 32);
    constexpr int NITEMS = I_IN + I_OUT;
    if (PARTS & 2) for (int it = gw; it < NITEMS; it += NGW) {
        int r = it;
        if (r < I_IN) { const int kb = r / (NPJ / 32), nb = r % (NPJ / 32); p0_transpose_item(w_in, NPROJ, WIN, 64 * kb, 32 * nb, 64 * kb, nullptr, scr, F.lane); continue; } r -= I_IN;
        { const int kb = r / (DM / 32), nb = r % (DM / 32); const int k0 = 64 * kb;
            p0_transpose_item(w_out, DM, WOUT, k0, 32 * nb, (k0 + 512) & 1023, k0 >= 512 ? gn_attn - 512 : nullptr, scr, F.lane); }
    }
    if (PARTS & 4) {
        if (F.G == 256) {
            constexpr int NU = CV_UP_ITEMS - CV_UP_TAIL, NV = NU + (CV_DN_ITEMS - CV_DN_TAIL);
            auto run = [&](int v) { if (v < NU) cvt_up_item(F, CV_UP_TAIL + v); else cvt_dn_item(F, CV_DN_TAIL + (v - NU)); };
            constexpr int A_END = 2048 * 5;
            for (int v = gw; v < A_END && v < NV; v += NGW) run(v);
            if (F.vcu >= 192) { const int r = (F.vcu - 192) * NWAVES + F.wave; for (int v = A_END + r; v < A_END + 1536 && v < NV; v += 512) run(v); }
            else { const int r = F.vcu * NWAVES + F.wave; if (r < 512) { const int v = A_END + 1536 + r; if (v < NV) run(v); } }
            static_assert(A_END + 1536 + 512 >= NV, "phase-0 conversion shares cover the list");
        } else { cvt_range<true>(F, 0, CV_UP_ITEMS, gw, NGW); cvt_range<false>(F, 0, CV_DN_ITEMS, gw, NGW); }
    }
    if (PARTS & 2) { const float* w_in2 = F.in(6); float* WFT = (float*)(F.ws + WS_WFT);
      for (int idx = F.vcu * (NWAVES * 64) + F.tid; idx < 8 * DM; idx += F.G * NWAVES * 64) { const int h = idx >> 10, k = idx & 1023; WFT[idx] = w_in2[(size_t)k * NPROJ + NPJ + h]; } }
    { const float* w_router = F.in(20); float* WRT = (float*)(F.ws + WS_WRT);
      for (int idx = F.vcu * (NWAVES * 64) + F.tid; idx < NE * DM; idx += F.G * NWAVES * 64) { const int e = idx >> 10, k = idx & 1023; WRT[idx] = w_router[k * NE + e]; } }
    { const float* wa = F.in(9); const float* wx = F.in(11); bf16* LWT = (bf16*)(F.ws + WS_LWT);
      for (int idx = F.vcu * (NWAVES * 64) + F.tid; idx < 2 * 8 * 64 * 64; idx += F.G * NWAVES * 64) { const int gate = idx >> 15, g = (idx >> 12) & 7, j = (idx >> 6) & 63, i = idx & 63;
          LWT[idx] = (bf16)f2bf((gate ? wx : wa)[(g * 64 + i) * 64 + j]); } }
}

__device__ __forceinline__ void p1_phase(Frame& F) {
    const float* x = F.in(0); const float* gpre = F.in(4); const float* fb = F.in(14);
    const float* MOD = (const float*)(F.ws + WS_MOD); bf16* H1 = (bf16*)(F.ws + WS_H1); float* LOGF2 = (float*)(F.ws + WS_LOGF2);
    LAS float* wf = (LAS float*)F.lds;
    { const float* WFT = (const float*)(F.ws + WS_WFT);
#pragma unroll
      for (int i = F.tid; i < 8 * DM / 4; i += NWAVES * 64) *(LAS f32x4*)(wf + 4 * i) = *(const f32x4*)(WFT + 4 * i); }
    __syncthreads();
    const int gw = F.vcu * NWAVES + F.wave;
    if (F.G * NWAVES * 8 != NTOK) return;
    const int row0 = gw * 8, b = row0 / SEQ;
    f32x4 gm[4], sh[4];
#pragma unroll
    for (int j = 0; j < 4; ++j) { const int k = 4 * F.lane + 256 * j; const f32x4 g = *(const f32x4*)(gpre + k), s = *(const f32x4*)(MOD + b * NMOD * DM + DM + k); gm[j] = g * (s + 1.0f); sh[j] = *(const f32x4*)(MOD + b * NMOD * DM + k); }
    f32x4 nx[4];
#pragma unroll
    for (int j = 0; j < 4; ++j) nx[j] = *(const f32x4*)(x + (size_t)row0 * DM + 4 * F.lane + 256 * j);
    for (int r = 0; r < 8; ++r) { const int row = row0 + r;
        f32x4 v[4]; float ss = 0.f;
#pragma unroll
        for (int j = 0; j < 4; ++j) { v[j] = nx[j]; ss += (v[j][0] * v[j][0] + v[j][1] * v[j][1]) + (v[j][2] * v[j][2] + v[j][3] * v[j][3]); }
        if (r < 7) {
#pragma unroll
            for (int j = 0; j < 4; ++j) nx[j] = *(const f32x4*)(x + (size_t)(row + 1) * DM + 4 * F.lane + 256 * j); }
        const float rinv = 1.0f / sqrtf(wave_sum(ss) * (1.0f / DM) + RMS_EPS);
        float fl[8];
#pragma unroll
        for (int h = 0; h < 8; ++h) fl[h] = 0.f;
#pragma unroll
        for (int j = 0; j < 4; ++j) { const f32x4 hv = v[j] * rinv * gm[j] + sh[j];
            v2u o; o.x = pk2(hv[0], hv[1]); o.y = pk2(hv[2], hv[3]); *(GAS v2u*)(H1 + (size_t)row * DM + 4 * F.lane + 256 * j) = o;
#pragma unroll
            for (int h = 0; h < 8; ++h) { const f32x4 w = *(const LAS f32x4*)(wf + h * DM + 4 * F.lane + 256 * j); fl[h] += (hv[0] * w[0] + hv[1] * w[1]) + (hv[2] * w[2] + hv[3] * w[3]); } }
#pragma unroll
        for (int h = 0; h < 8; ++h) fl[h] = wave_sum(fl[h]);
        if (F.lane < 8) { float f = fl[0];
#pragma unroll
            for (int h = 1; h < 8; ++h) f = (F.lane == h) ? fl[h] : f;
            LOGF2[(size_t)row * 8 + F.lane] = log_sigmoid_f(f + fb[F.lane]) * 1.4426950408889634f; }
    }
}

constexpr int LRU_XP = 1040;
constexpr int LRU_XT = 0, LRU_XC = 69696, LRU_CAR = 136256;
constexpr int CW_LRU = 131072;
static_assert(LRU_CAR + 2048 <= SCRATCH_BYTES && 67 * LRU_XP <= LRU_XC && LRU_XC + 64 * LRU_XP <= LRU_CAR, "LRU LDS map");
__device__ __forceinline__ float one_minus_exp(float x) {
    float p = -x * (1.0f + x * (0.5f + x * (0.16666667f + x * (0.041666668f + x * (0.0083333338f + x * 0.0013888889f)))));
    if (__builtin_expect(__any(x <= -0.25f), 0)) { const float d = 1.0f - __builtin_amdgcn_exp2f(1.4426950408889634f * x); p = x > -0.25f ? p : d; }
    return p;
}
__device__ __forceinline__ void lru_item(Frame& F, int b, int c) {
    LAS unsigned char* XT = F.lds + LRU_XT; LAS unsigned char* XC = F.lds + LRU_XC; LAS float* CAR = (LAS float*)(F.lds + LRU_CAR);
    const bf16* XL = (const bf16*)(F.ws + WS_PJ); const bf16* YL = XL + PJ_STRIDE; const bf16* LWT = (const bf16*)(F.ws + WS_LWT);
    float* LSUM = (float*)(F.ws + WS_LSUM); bf16* MRG = (bf16*)(F.ws + WS_MRG); unsigned* flags = (unsigned*)(F.ws + WS_CTL) + CW_LRU;
    const float* conv_w = F.in(7); const float* conv_b = F.in(8); const float* ba = F.in(10); const float* bx = F.in(12); const float* lam = F.in(13); const float* gn_lru = F.in(15);
    const int t0 = c * 64; const size_t rowb = (size_t)b * SEQ;
    { v4u xv[9];
#pragma unroll
      for (int q = 0; q < 9; ++q) { const int p = F.tid + q * (NWAVES * 64), i = p >> 6, c8 = p & 63, t = t0 - 3 + i; xv[q] = (v4u){0u, 0u, 0u, 0u};
          if (p < 67 * 64 && t >= 0) xv[q] = *(const GAS v4u*)(XL + (rowb + t) * 512 + c8 * 8); }
#pragma unroll
      for (int q = 0; q < 9; ++q) { const int p = F.tid + q * (NWAVES * 64), i = p >> 6, c8 = p & 63; if (p < 67 * 64) *(LAS v4u*)(XT + i * LRU_XP + c8 * 16) = xv[q]; } }
    v4u yv8[8];
#pragma unroll
    for (int q = 0; q < 8; ++q) { const int p = F.tid + q * (NWAVES * 64), i = p >> 6, c8 = p & 63; yv8[q] = *(const GAS v4u*)(YL + (rowb + t0 + i) * 512 + c8 * 8); }
    __syncthreads();
    { const int ch = F.tid; const float w0 = conv_w[ch], w1 = conv_w[512 + ch], w2 = conv_w[1024 + ch], w3 = conv_w[1536 + ch], cb = conv_b[ch];
      float xa = bf1(*(const LAS bf16*)(XT + 0 * LRU_XP + ch * 2)), xb = bf1(*(const LAS bf16*)(XT + 1 * LRU_XP + ch * 2)), xc = bf1(*(const LAS bf16*)(XT + 2 * LRU_XP + ch * 2));
#pragma unroll 8
      for (int t = 0; t < 64; ++t) { const float xd = bf1(*(const LAS bf16*)(XT + (t + 3) * LRU_XP + ch * 2)); const float v = ((w0 * xa + w1 * xb) + (w2 * xc + w3 * xd)) + cb;
          *(LAS bf16*)(XC + t * LRU_XP + ch * 2) = (bf16)f2bf(v); xa = xb; xb = xc; xc = xd; } }
    __syncthreads();
#pragma unroll
    for (int q = 0; q < 8; ++q) { const int p = F.tid + q * (NWAVES * 64), i = p >> 6, c8 = p & 63; *(LAS v4u*)(XT + i * LRU_XP + c8 * 16) = yv8[q]; }
    const int g = F.wave, l31 = F.lane & 31, hi = F.lane >> 5;
    __syncthreads();
#pragma unroll 1
    for (int hp = 0; hp < 2; ++hp) {
        const int chl = g * 64 + 32 * hp + l31;
        f32x16 cumA[2], hloc[2];
#pragma unroll
        for (int tg = 0; tg < 2; ++tg) { cumA[tg] = f32x16{}; hloc[tg] = f32x16{}; }
#pragma unroll
        for (int s = 0; s < 4; ++s) {
            const bf16x8 wa = *(const GAS bf16x8*)(LWT + ((size_t)((0 * 8 + g) * 64 + 32 * hp + l31)) * 64 + 16 * s + 8 * hi);
            const bf16x8 wx = *(const GAS bf16x8*)(LWT + ((size_t)((1 * 8 + g) * 64 + 32 * hp + l31)) * 64 + 16 * s + 8 * hi);
#pragma unroll
            for (int tg = 0; tg < 2; ++tg) { const bf16x8 bfr = *(const LAS bf16x8*)(XC + (32 * tg + l31) * LRU_XP + (g * 64 + 16 * s + 8 * hi) * 2);
                cumA[tg] = __builtin_amdgcn_mfma_f32_32x32x16_bf16(bfr, wa, cumA[tg], 0, 0, 0); hloc[tg] = __builtin_amdgcn_mfma_f32_32x32x16_bf16(bfr, wx, hloc[tg], 0, 0, 0); }
        }
        const float pba = ba[chl], pbx = bx[chl], psp = 8.0f * softplus_f(-lam[chl]);
        float cA = 1.0f, cB = 0.0f;
#pragma unroll
        for (int tg = 0; tg < 2; ++tg) {
            f32x16& A = cumA[tg]; f32x16& X = hloc[tg];
#pragma unroll
            for (int r = 0; r < 16; ++r) { const int tok = 32 * tg + (r & 3) + 8 * (r >> 2) + 4 * hi; const float xv = bf1(*(const LAS bf16*)(XC + tok * LRU_XP + chl * 2));
                const float rg = sigmoid_f(A[r] + pba), ig = sigmoid_f(X[r] + pbx); const float la = -rg * psp;
                A[r] = __builtin_amdgcn_exp2f(1.4426950408889634f * la); X[r] = __builtin_amdgcn_sqrtf(one_minus_exp(2.0f * la)) * (ig * xv); }
#pragma unroll
            for (int q = 0; q < 4; ++q)
#pragma unroll
                for (int i = 1; i < 4; ++i) { X[4 * q + i] = A[4 * q + i] * X[4 * q + i - 1] + X[4 * q + i]; A[4 * q + i] = A[4 * q + i] * A[4 * q + i - 1]; }
#pragma unroll
            for (int q2 = 0; q2 < 8; ++q2) { const int q = q2 >> 1; const bool own = (hi == (q2 & 1));
#pragma unroll
                for (int i = 0; i < 4; ++i) { const float nb = A[4 * q + i] * cB + X[4 * q + i], na = A[4 * q + i] * cA; X[4 * q + i] = own ? nb : X[4 * q + i]; A[4 * q + i] = own ? na : A[4 * q + i]; }
                float ra, rb; { float a0 = A[4 * q + 3], a1 = a0; swap_half32(a0, a1); ra = hi ? a0 : a1; float b0 = X[4 * q + 3], b1 = b0; swap_half32(b0, b1); rb = hi ? b0 : b1; }
                cA = own ? A[4 * q + 3] : ra; cB = own ? X[4 * q + 3] : rb; }
        }
        if (hi == 0) { float* d0 = LSUM + (((size_t)b * 32 + c) * 2 + 0) * 512 + chl; __hip_atomic_store(d0, cA, __ATOMIC_RELAXED, __HIP_MEMORY_SCOPE_AGENT); __hip_atomic_store(d0 + 512, cB, __ATOMIC_RELAXED, __HIP_MEMORY_SCOPE_AGENT); }
        asm volatile("s_waitcnt vmcnt(0)" ::: "memory");
        __syncthreads();
        if (F.wave == 0) {
            if (F.lane == 0) __hip_atomic_store(flags + 64 * ((32 * b + c) * 2 + hp), 1u, __ATOMIC_RELAXED, __HIP_MEMORY_SCOPE_AGENT);
            unsigned sp = 0;
            for (;;) { const unsigned v = (F.lane < c) ? __hip_atomic_load(flags + 64 * ((32 * b + F.lane) * 2 + hp), __ATOMIC_RELAXED, __HIP_MEMORY_SCOPE_AGENT) : 1u;
                if (__all(v != 0u)) break; __builtin_amdgcn_s_sleep(1); if (++sp > (1u << 20)) break; }
        }
        __syncthreads();
        if (F.tid < 256) { const int ch = (F.tid >> 5) * 64 + 32 * hp + (F.tid & 31); float cr = 0.f; float* LS = LSUM + (size_t)b * 32 * 2 * 512 + ch;
          for (int c0 = 0; c0 < c; c0 += 32) { float A8[32], B8[32];
#pragma unroll
              for (int u = 0; u < 32; ++u) { const bool ok = (c0 + u) < c; A8[u] = 1.0f; B8[u] = 0.0f; if (ok) { A8[u] = __hip_atomic_load(LS + (size_t)(c0 + u) * 1024, __ATOMIC_RELAXED, __HIP_MEMORY_SCOPE_AGENT); B8[u] = __hip_atomic_load(LS + (size_t)(c0 + u) * 1024 + 512, __ATOMIC_RELAXED, __HIP_MEMORY_SCOPE_AGENT); } }
#pragma unroll
              for (int u = 0; u < 32; ++u) cr = A8[u] * cr + B8[u]; }
          CAR[ch] = cr; }
        __syncthreads();
        { const float cin = CAR[chl];
#pragma unroll
          for (int tg = 0; tg < 2; ++tg)
#pragma unroll
              for (int r = 0; r < 16; ++r) { const int tok = 32 * tg + (r & 3) + 8 * (r >> 2) + 4 * hi; LAS bf16* yp = (LAS bf16*)(XT + tok * LRU_XP + chl * 2);
                  const float h = hloc[tg][r] + cumA[tg][r] * cin; *yp = (bf16)f2bf(h * gelu_tanh_f(bf1(*yp))); } }
    }
    __syncthreads();
#pragma unroll 2
    for (int q = 0; q < 8; ++q) { const int i = F.wave + 8 * q, c8 = F.lane;
        const v4u w = *(const LAS v4u*)(XT + i * LRU_XP + c8 * 16);
        const float v0 = bflo(w.x), v1 = bfhi(w.x), v2 = bflo(w.y), v3 = bfhi(w.y), v4 = bflo(w.z), v5 = bfhi(w.z), v6 = bflo(w.w), v7 = bfhi(w.w);
        const float ss = wave_sum(((v0 * v0 + v1 * v1) + (v2 * v2 + v3 * v3)) + ((v4 * v4 + v5 * v5) + (v6 * v6 + v7 * v7)));
        const float rinv = 1.0f / sqrtf(ss * (1.0f / DLRU) + RMS_EPS);
        const f32x4 g0 = *(const f32x4*)(gn_lru + c8 * 8), g1 = *(const f32x4*)(gn_lru + c8 * 8 + 4);
        v4u o; o.x = pk2(v0 * rinv * g0[0], v1 * rinv * g0[1]); o.y = pk2(v2 * rinv * g0[2], v3 * rinv * g0[3]); o.z = pk2(v4 * rinv * g1[0], v5 * rinv * g1[1]); o.w = pk2(v6 * rinv * g1[2], v7 * rinv * g1[3]);
        *(GAS v4u*)(MRG + (rowb + t0 + i) * 1024 + 512 + c8 * 8) = o; }
    __syncthreads();
}
__device__ __forceinline__ void lru_phase(Frame& F) { for (int it = F.vcu; it < BATCH * 32; it += F.G) lru_item(F, it >> 5, it & 31); }

template <int VAR = 0> __device__ __forceinline__ void p6_phase(Frame& F) {
    const float* x = F.in(0); const float* gpost = F.in(5); const float* gffn = F.in(18); const float* b_router = F.in(21);
    const float* MOD = (const float*)(F.ws + WS_MOD); const bf16* Y = (const bf16*)(F.ws + WS_Y); unsigned char* H2 = (unsigned char*)(F.ws + WS_H2);
    int* TOPI = (int*)(F.ws + WS_TOPI); float* TOPW = (float*)(F.ws + WS_TOPW); int* WGCNT = (int*)(F.ws + WS_WGCNT);
    LAS float* wrl = (LAS float*)F.lds;
    LAS int* hist = (LAS int*)(F.lds + 131072);
    { const float* WRT = (const float*)(F.ws + WS_WRT);
#pragma unroll 4
      for (int i = F.tid; i < NE * DM / 4; i += NWAVES * 64) *(LAS f32x4*)(wrl + 4 * i) = *(const f32x4*)(WRT + 4 * i); }
    if (F.tid < NE) hist[F.tid] = 0;
    __syncthreads();
    if (F.G * 64 == NTOK) {
    const int bx = blockIdx.x, row0 = bx * 64 + F.wave * 8, b = row0 / SEQ;
    f32x4 gpm[4], gf[4], shf[4];
#pragma unroll
    for (int j = 0; j < 4; ++j) { const int k = 4 * F.lane + 256 * j; const float* mb = MOD + b * NMOD * DM + k;
        gpm[j] = *(const f32x4*)(mb + 2 * DM) * *(const f32x4*)(gpost + k); gf[j] = *(const f32x4*)(gffn + k) * (*(const f32x4*)(mb + 4 * DM) + 1.0f); shf[j] = *(const f32x4*)(mb + 3 * DM); }
    v2u ywn[2][4]; f32x4 xn[2][4];
#pragma unroll
    for (int u = 0; u < 2; ++u)
#pragma unroll
        for (int j = 0; j < 4; ++j) { ywn[u][j] = *(const GAS v2u*)(Y + (size_t)(row0 + u) * DM + 4 * F.lane + 256 * j); xn[u][j] = *(const f32x4*)(x + (size_t)(row0 + u) * DM + 4 * F.lane + 256 * j); }
    for (int rp = 0; rp < 4; ++rp) {
        f32x4 hv[2][4];
        v2u ywc[2][4]; f32x4 xc[2][4];
#pragma unroll
        for (int u = 0; u < 2; ++u)
#pragma unroll
            for (int j = 0; j < 4; ++j) { ywc[u][j] = ywn[u][j]; xc[u][j] = xn[u][j]; }
        if (rp < 3) {
#pragma unroll
            for (int u = 0; u < 2; ++u)
#pragma unroll
                for (int j = 0; j < 4; ++j) { ywn[u][j] = *(const GAS v2u*)(Y + (size_t)(row0 + 2 * rp + 2 + u) * DM + 4 * F.lane + 256 * j); xn[u][j] = *(const f32x4*)(x + (size_t)(row0 + 2 * rp + 2 + u) * DM + 4 * F.lane + 256 * j); } }
#pragma unroll
        for (int u = 0; u < 2; ++u) { const int row = row0 + 2 * rp + u;
            f32x4 yv[4]; float ss = 0.f;
#pragma unroll
            for (int j = 0; j < 4; ++j) { const v2u yw = ywc[u][j]; yv[j] = (f32x4){bflo(yw.x), bfhi(yw.x), bflo(yw.y), bfhi(yw.y)}; ss += (yv[j][0] * yv[j][0] + yv[j][1] * yv[j][1]) + (yv[j][2] * yv[j][2] + yv[j][3] * yv[j][3]); }
            const float rinv = 1.0f / sqrtf(wave_sum(ss) * (1.0f / DM) + RMS_EPS);
            float s2 = 0.f;
#pragma unroll
            for (int j = 0; j < 4; ++j) { const f32x4 xm = xc[u][j] + gpm[j] * (yv[j] * rinv);
                yv[j] = xm; s2 += (xm[0] * xm[0] + xm[1] * xm[1]) + (xm[2] * xm[2] + xm[3] * xm[3]); }
            const float rinv2 = 1.0f / sqrtf(wave_sum(s2) * (1.0f / DM) + RMS_EPS);
#pragma unroll
            for (int j = 0; j < 4; ++j) { const f32x4 h = yv[j] * rinv2 * gf[j] + shf[j]; hv[u][j] = h;
                int w8 = 0; w8 = __builtin_amdgcn_cvt_pk_fp8_f32(h[0], h[1], w8, false); w8 = __builtin_amdgcn_cvt_pk_fp8_f32(h[2], h[3], w8, true); *(GAS int*)(H2 + (size_t)row * DM + 4 * F.lane + 256 * j) = w8; }
        }
        typedef float f32x2 __attribute__((ext_vector_type(2)));
        f32x2 hp[4][4];
#pragma unroll
        for (int j = 0; j < 4; ++j)
#pragma unroll
            for (int i = 0; i < 4; ++i) hp[j][i] = (f32x2){hv[0][j][i], hv[1][j][i]};
        float pa[32], pb[32];
#pragma unroll
        for (int e = 0; e < 32; ++e) { f32x2 s2 = (f32x2){0.f, 0.f};
#pragma unroll
            for (int j = 0; j < (VAR == 1 ? 0 : 4); ++j) { const f32x4 w = *(const LAS f32x4*)(wrl + e * DM + 4 * F.lane + 256 * j);
#pragma unroll
                for (int i = 0; i < 4; ++i) s2 = __builtin_elementwise_fma(hp[j][i], (f32x2){w[i], w[i]}, s2); }
            pa[e] = s2[0]; pb[e] = s2[1]; }
#pragma unroll
        for (int i = 0; i < 16; ++i) { float a = pa[i], b = pa[16 + i]; swap_half32(a, b); pa[i] = a + b; float c2 = pb[i], d2 = pb[16 + i]; swap_half32(c2, d2); pb[i] = c2 + d2; }
#pragma unroll
        for (int i = 0; i < 8; ++i) { float a = pa[i], b = pa[8 + i]; swap_rows16(a, b); pa[i] = a + b; float c2 = pb[i], d2 = pb[8 + i]; swap_rows16(c2, d2); pb[i] = c2 + d2; }
#define TR_STEP(N, XOR, BIT) _Pragma("unroll") for (int i = 0; i < N; ++i) { const bool up = (F.lane & BIT) != 0; \
            const float ka = up ? pa[N + i] : pa[i], sa_ = up ? pa[i] : pa[N + i], kb = up ? pb[N + i] : pb[i], sb_ = up ? pb[i] : pb[N + i]; \
            pa[i] = ka + XOR(sa_); pb[i] = kb + XOR(sb_); }
        TR_STEP(4, lane_xor8, 8) TR_STEP(2, lane_xor4, 4) TR_STEP(1, lane_xor2, 2)
#undef TR_STEP
        const int e = (F.lane >> 1) & 31; const float br = b_router[e];
#pragma unroll
        for (int u = 0; u < 2; ++u) { const int row = row0 + 2 * rp + u; float v = (u ? pb[0] : pa[0]); v += lane_xor1(v); v += br;
            int rank = 0;
#pragma unroll
            for (int j = 0; j < 32; ++j) { const float vj = __uint_as_float((unsigned)__builtin_amdgcn_readlane((int)__float_as_uint(v), 2 * j)); rank += (vj > v || (vj == v && j < e)) ? 1 : 0; }
            const bool sel = rank < TOPK; const float vmax = wave_max(v); const float ex = sel ? __expf(v - vmax) : 0.f; const float den = wave_sum(ex) * 0.5f;
            if (sel && !(F.lane & 1)) { TOPI[(size_t)row * TOPK + rank] = e; TOPW[(size_t)row * TOPK + rank] = ex / den; __hip_atomic_fetch_add((LAS int*)&hist[e], 1, __ATOMIC_RELAXED, __HIP_MEMORY_SCOPE_WORKGROUP); } }
    }
    __syncthreads();
    if (F.tid < NE) WGCNT[bx * NE + F.tid] = hist[F.tid];
    }
}

__device__ __forceinline__ void p7_phase(Frame& F) {
    const int* TOPI = (const int*)(F.ws + WS_TOPI); const float* TOPW = (const float*)(F.ws + WS_TOPW); const int* WGCNT = (const int*)(F.ws + WS_WGCNT);
    int* ROWTOK = (int*)(F.ws + WS_ROWTOK); int* ROWPAIR = (int*)(F.ws + WS_ROWPAIR); float* ROWW = (float*)(F.ws + WS_ROWW); int* MTEXP = (int*)(F.ws + WS_MTEXP);
    LAS int* ptot = (LAS int*)F.lds; LAS int* pbef = ptot + 512; LAS int* cnt = pbef + 512; LAS int* wgb = cnt + 32; LAS int* pst = wgb + 32; LAS int* pad = pst + 64; LAS int* ep = pad + 32;
    if (F.G != 256) return;
    const int bx = blockIdx.x;
    { const int e = F.tid & 31, part = F.tid >> 5; int tt = 0, tb = 0;
      for (int w = part * 16; w < part * 16 + 16; ++w) { const int v = WGCNT[w * NE + e]; tt += v; tb += (w < bx) ? v : 0; }
      ptot[part * 32 + e] = tt; pbef[part * 32 + e] = tb; }
    __syncthreads();
    if (F.tid < NE) { int tt = 0, tb = 0; for (int p = 0; p < 16; ++p) { tt += ptot[p * 32 + F.tid]; tb += pbef[p * 32 + F.tid]; } cnt[F.tid] = tt; wgb[F.tid] = tb; pad[F.tid] = (tt + 255) & ~255; }
    __syncthreads();
    if (F.tid == 0) { int s = 0; for (int e = 0; e < NE; ++e) { pst[e] = s; s += pad[e]; } pst[NE] = s; }
    if (F.tid < 256) ep[F.tid] = TOPI[(size_t)bx * 256 + F.tid];
    __syncthreads();
    if (F.tid < 256) { const int p = F.tid, e = ep[p]; int rk = 0; for (int q = 0; q < p; ++q) rk += (ep[q] == e) ? 1 : 0;
        const int dest = pst[e] + wgb[e] + rk; const int pair = bx * 256 + p; ROWTOK[dest] = pair >> 2; ROWPAIR[dest] = pair; ROWW[dest] = TOPW[pair]; }
    if (bx < NE) { const int e = bx; for (int i = pst[e] + cnt[e] + F.tid; i < pst[e] + pad[e]; i += NWAVES * 64) { ROWTOK[i] = 0; ROWPAIR[i] = -1; ROWW[i] = 0.f; } }
    if (bx == 0) { if (F.tid < NE) { for (int mt = pst[F.tid] >> 8; mt < (pst[F.tid] + pad[F.tid]) >> 8; ++mt) MTEXP[mt] = F.tid; } if (F.tid == 0) MTEXP[512] = pst[NE] >> 8; }
}

__device__ __forceinline__ void p10_phase(Frame& F) {
    const float* x = F.in(0); const float* gpostm = F.in(5); const float* gpost = F.in(19); const float* MOD = (const float*)(F.ws + WS_MOD);
    const unsigned char* YP = (const unsigned char*)(F.ws + WS_YP); const bf16* Y = (const bf16*)(F.ws + WS_Y);
    const int gw = F.vcu * NWAVES + F.wave;
    if (F.G * NWAVES * 8 != NTOK) return;
    const int row0 = gw * 8, b = row0 / SEQ;
    f32x4 gg[4], gpm[4];
#pragma unroll
    for (int j = 0; j < 4; ++j) { const int k = 4 * F.lane + 256 * j; gg[j] = *(const f32x4*)(MOD + b * NMOD * DM + 5 * DM + k) * *(const f32x4*)(gpost + k); gpm[j] = *(const f32x4*)(MOD + b * NMOD * DM + 2 * DM + k) * *(const f32x4*)(gpostm + k); }
    int nw[4][TOPK]; v2u ny[4]; f32x4 nx[4];
#pragma unroll
    for (int j = 0; j < 4; ++j) { ny[j] = *(const GAS v2u*)(Y + (size_t)row0 * DM + 4 * F.lane + 256 * j); nx[j] = *(const f32x4*)(x + (size_t)row0 * DM + 4 * F.lane + 256 * j);
#pragma unroll
        for (int k = 0; k < TOPK; ++k) nw[j][k] = *(const GAS int*)(YP + ((size_t)row0 * TOPK + k) * DM + 4 * F.lane + 256 * j); }
    for (int r = 0; r < 8; ++r) { const int row = row0 + r;
        f32x4 y[4], ym[4], xr[4]; float ss = 0.f, sm = 0.f;
#pragma unroll
        for (int j = 0; j < 4; ++j) { f32x4 s = (f32x4){0.f, 0.f, 0.f, 0.f};
#pragma unroll
            for (int k = 0; k < TOPK; ++k) { const int w = nw[j][k]; s += (f32x4){__builtin_amdgcn_cvt_f32_fp8(w, 0), __builtin_amdgcn_cvt_f32_fp8(w, 1), __builtin_amdgcn_cvt_f32_fp8(w, 2), __builtin_amdgcn_cvt_f32_fp8(w, 3)}; }
            y[j] = s; ss += (s[0] * s[0] + s[1] * s[1]) + (s[2] * s[2] + s[3] * s[3]);
            const v2u yw = ny[j]; const f32x4 m = (f32x4){bflo(yw.x), bfhi(yw.x), bflo(yw.y), bfhi(yw.y)}; ym[j] = m; sm += (m[0] * m[0] + m[1] * m[1]) + (m[2] * m[2] + m[3] * m[3]); xr[j] = nx[j]; }
        if (r < 7) {
#pragma unroll
            for (int j = 0; j < 4; ++j) { ny[j] = *(const GAS v2u*)(Y + (size_t)(row + 1) * DM + 4 * F.lane + 256 * j); nx[j] = *(const f32x4*)(x + (size_t)(row + 1) * DM + 4 * F.lane + 256 * j);
#pragma unroll
                for (int k = 0; k < TOPK; ++k) nw[j][k] = *(const GAS int*)(YP + ((size_t)(row + 1) * TOPK + k) * DM + 4 * F.lane + 256 * j); } }
        const float rinv = 1.0f / sqrtf(wave_sum(ss) * (1.0f / DM) + RMS_EPS * 16.0f), rinvm = 1.0f / sqrtf(wave_sum(sm) * (1.0f / DM) + RMS_EPS);
#pragma unroll
        for (int j = 0; j < 4; ++j) *(f32x4*)(F.out + (size_t)row * DM + 4 * F.lane + 256 * j) = (xr[j] + gpm[j] * (ym[j] * rinvm)) + gg[j] * (y[j] * rinv);
    }
}

__global__ void __launch_bounds__(NWAVES * 64, 2) mega_fwd(Args args) {
    extern __shared__ __attribute__((aligned(16))) unsigned char lds[];
    Frame F;
    F.lds = (LAS unsigned char*)lds;
    F.tid = threadIdx.x; F.lane = F.tid & 63; F.wave = __builtin_amdgcn_readfirstlane(F.tid >> 6);
    F.G = gridDim.x; { const int bx = blockIdx.x; F.vcu = (F.G % 8 == 0) ? (bx % 8) * (F.G / 8) + bx / 8 : bx; }
    F.out = args.out; F.ws = args.ws;
    volatile LAS unsigned* MISC = (volatile LAS unsigned*)(F.lds + MISC_OFF);
    for (int u = F.tid; u < (LDS_BYTES - LDSCTL_OFF) / 4; u += NWAVES * 64) ((LAS unsigned*)(F.lds + LDSCTL_OFF))[u] = 0u;
    __syncthreads();
    if (F.tid < 26) ((LAS unsigned long long*)(F.lds + LDSCTL_OFF))[F.tid] = (unsigned long long)args.in[F.tid];
    __syncthreads();
    gu32* ctl = (gu32*)(F.ws + WS_CTL);
    XcdBarrier bar = xcd_barrier_post((unsigned*)(ctl + CW_BAR) + args.li * XCD_BAR_WORDS, MISC + 8);
    const int lo = args.ph_lo, hi = args.ph_hi;
#ifndef PHMASK
#define PHMASK 0x7ff
#endif
#define IN(k) (((PHMASK >> (k)) & 1) && lo <= (k) && (k) < hi)
#define SEAM(k, n) do { if (IN(k) && IN(n)) xcd_barrier(bar); } while (0)
#define REFRESH() do { int t_; asm volatile("v_mov_b32 %0, %1" : "=v"(t_) : "v"(threadIdx.x)); F.tid = t_; F.lane = t_ & 63; } while (0)
#define ATTN_TENSORS attn_body::AttnTensors{(const attn_body::bf16*)(F.ws + WS_PJ) + 2 * PJ_STRIDE, (const attn_body::bf16*)(F.ws + WS_PJ) + 3 * PJ_STRIDE, (const attn_body::bf16*)(F.ws + WS_PJ) + 4 * PJ_STRIDE, \
                                          (attn_body::bf16*)(F.ws + WS_MRG), (const float*)(F.ws + WS_LOGF2), (float*)(F.ws + WS_SSQ)}
    if (IN(0)) { REFRESH(); p0_phase(F); } SEAM(0, 1);
    if (IN(1)) { REFRESH(); p1_phase(F); } SEAM(1, 2);
    if (IN(2)) { REFRESH();
        pg8::DenseOrder S; S.init((const pg8::bf16_t*)(F.ws + WS_H1), (const pg8::bf16_t*)(F.ws + WS_WIN), NTOK, NPJ, F.G, (int)blockIdx.x);
        pg8::EpiProj E{(pg8::bf16_t*)(F.ws + WS_PJ), PJ_STRIDE, attn_body::C2};
        pg8::gemm_phase<pg8::EpiProj, pg8::DenseOrder>(F.lds, S, E);
        if (F.G == 256 && blockIdx.x >= 128) { REFRESH(); cvt_range<true>(F, 0, CV_UP_TAIL, ((int)blockIdx.x - 128) * NWAVES + F.wave, 128 * NWAVES); }
    } SEAM(2, 3);
    if (IN(3)) { REFRESH();
        lru_phase(F);
        const attn_body::AttnTensors AT = ATTN_TENSORS; const attn_body::StaticOrder S((int)F.G, F.vcu);
        attn_body::attn_phase<attn_body::StaticOrder>((char*)lds, AT, S);
    } SEAM(3, 5);
    if (IN(5)) { REFRESH();
        pg8::DenseOrder S; S.init((const pg8::bf16_t*)(F.ws + WS_MRG), (const pg8::bf16_t*)(F.ws + WS_WOUT), NTOK, DM, F.G, (int)blockIdx.x);
        pg8::EpiOut E{(pg8::bf16_t*)(F.ws + WS_Y), (const float*)(F.ws + WS_SSQ)};
        pg8::gemm_phase<pg8::EpiOut, pg8::DenseOrder>(F.lds, S, E);
    } SEAM(5, 6);
    if (IN(6)) { REFRESH(); p6_phase<0>(F); } SEAM(6, 7);
    if (IN(7)) { REFRESH(); p7_phase(F); } SEAM(7, 8);
    if (IN(8)) { REFRESH();
        const int nmt = ((const int*)(F.ws + WS_MTEXP))[512];
        LAS int* mtl = (LAS int*)(F.lds + 131072); LAS float* bsl = (LAS float*)(F.lds + 131072 + 2048);
        for (int i = F.tid; i < nmt; i += NWAVES * 64) mtl[i] = ((const int*)(F.ws + WS_MTEXP))[i];
        __syncthreads();
        { const float* b_up = F.in(23);
          for (int i = 0; i < 12; ++i) { const int L = i * F.G + F.vcu; if (L >= nmt * 8) break; const int ex = mtl[L >> 3], pn = L & 7;
              if (F.tid < 256) bsl[i * 256 + F.tid] = b_up[(size_t)ex * 2 * DEXP + (F.tid >> 7) * DEXP + pn * 128 + (F.tid & 127)]; } }
        __syncthreads();
        pg8::UpOrder S{(const unsigned char*)(F.ws + WS_H2), (const unsigned char*)(F.ws + WS_WUP), (const int*)(F.ws + WS_ROWTOK), mtl, nmt * 8, F.G, F.vcu};
        pg8::EpiUp E{(unsigned char*)(F.ws + WS_ACT), bsl};
        pg8::gemm_phase<pg8::EpiUp, pg8::UpOrder, true>(F.lds, S, E);
        if (F.G == 256) {
            const int units = nmt * 8, maxu = (units + 255) >> 8, nfull = units - (maxu - 1) * 256, nidle = 256 - nfull;
            REFRESH();
            if (nidle >= 32) { if (F.vcu >= nfull) cvt_range<false>(F, 0, CV_DN_TAIL, (F.vcu - nfull) * NWAVES + F.wave, nidle * NWAVES); }
            else cvt_range<false>(F, 0, CV_DN_TAIL, F.vcu * NWAVES + F.wave, 256 * NWAVES); }
    } SEAM(8, 9);
    if (IN(9)) { REFRESH();
        const int nmt = ((const int*)(F.ws + WS_MTEXP))[512];
        LAS int* mtl = (LAS int*)(F.lds + 131072); LAS float* bsl = (LAS float*)(F.lds + 131072 + 2048);
        for (int i = F.tid; i < nmt; i += NWAVES * 64) mtl[i] = ((const int*)(F.ws + WS_MTEXP))[i];
        __syncthreads();
        { const float* b_dn = F.in(25);
          for (int i = 0; i < 12; ++i) { const int L = i * F.G + F.vcu; if (L >= nmt * 4) break; const int ex = mtl[L >> 2], pn = L & 3;
              if (F.tid < 256) bsl[i * 256 + F.tid] = b_dn[(size_t)ex * DM + pn * 256 + F.tid]; } }
        __syncthreads();
        pg8::DownOrder S{(const unsigned char*)(F.ws + WS_ACT), (const unsigned char*)(F.ws + WS_WDN), mtl, nmt * 4, F.G, F.vcu};
        pg8::EpiDown E{(unsigned char*)(F.ws + WS_YP), bsl, (const int*)(F.ws + WS_ROWPAIR), (const float*)(F.ws + WS_ROWW)};
        pg8::gemm_phase<pg8::EpiDown, pg8::DownOrder, true>(F.lds, S, E);
    } SEAM(9, 10);
    if (IN(10)) { REFRESH(); p10_phase(F); }
#ifdef MK_PROBES
    if (lo == 11) { REFRESH(); lru_phase(F); }
    if (lo == 12) { REFRESH(); const attn_body::AttnTensors AT = ATTN_TENSORS; const attn_body::StaticOrder S((int)F.G, F.vcu); attn_body::attn_phase<attn_body::StaticOrder>((char*)lds, AT, S); }
    if (lo == 14) { REFRESH(); p0_phase<1>(F); }
    if (lo == 15) { REFRESH(); p0_phase<2>(F); }
    if (lo == 16) { REFRESH(); p0_phase<4>(F); }
    if (lo == 17) { for (int i = 0; i < 10; ++i) xcd_barrier(bar); }
    if (lo == 18) { REFRESH(); p6_phase<1>(F); }
    if (lo >= 21 && lo <= 24) { REFRESH();
        const int nmt = ((const int*)(F.ws + WS_MTEXP))[512];
        LAS int* mtl = (LAS int*)(F.lds + 131072); LAS float* bsl = (LAS float*)(F.lds + 131072 + 2048);
        for (int i = F.tid; i < nmt; i += NWAVES * 64) mtl[i] = ((const int*)(F.ws + WS_MTEXP))[i];
        for (int i = F.tid; i < 12 * 256; i += NWAVES * 64) bsl[i] = 0.f;
        __syncthreads();
        pg8::UpOrder S{(const unsigned char*)(F.ws + WS_H2), (const unsigned char*)(F.ws + WS_WUP), (const int*)(F.ws + WS_ROWTOK), mtl, nmt * 8, F.G, F.vcu};
        if (lo == 21) { pg8::EpiNop E{}; pg8::gemm_phase<pg8::EpiNop, pg8::UpOrder, true, 1>(F.lds, S, E); }
        else if (lo == 22) { pg8::EpiNop E{}; pg8::gemm_phase<pg8::EpiNop, pg8::UpOrder, true, 2>(F.lds, S, E); }
        else if (lo == 23) { pg8::EpiUp E{(unsigned char*)(F.ws + WS_H1), bsl}; pg8::gemm_phase<pg8::EpiUp, pg8::UpOrder, true, 1>(F.lds, S, E); }
        else { pg8::EpiUpT<false> E{(unsigned char*)(F.ws + WS_H1), bsl}; pg8::gemm_phase<pg8::EpiUpT<false>, pg8::UpOrder, true, 1>(F.lds, S, E); } }
#endif
#undef IN
#undef SEAM
#undef REFRESH
#undef ATTN_TENSORS
}

static void launch_mega(hipStream_t stream, void* const* d_in, void* d_out, void* d_ws, int lo, int hi, int li, int grid) {
    Args a{};
    for (int i = 0; i < 26; ++i) a.in[i] = (const float*)d_in[i];
    a.out = (float*)d_out; a.ws = (unsigned char*)d_ws; a.ph_lo = lo; a.ph_hi = hi; a.li = li; a.pad = 0;
    hipLaunchKernelGGL(mega_fwd, dim3(grid), dim3(NWAVES * 64), LDS_BYTES, stream, a);
}

extern "C" void kernel_launch(void* const* d_in, const int* in_sizes, int n_in, void* d_out, int out_size, void* d_ws, size_t ws_size, hipStream_t stream) {
    static int grid = 0;
    if (grid == 0) {
        int dev = 0, cus = 0;
        if (n_in != 26 || out_size != NTOK * DM || ws_size < WS_END) { fprintf(stderr, "kernel_launch: unexpected problem shape / workspace (%d inputs, out %d, ws %zu)\n", n_in, out_size, ws_size); grid = -1; return; }
        if (hipGetDevice(&dev) != hipSuccess || hipDeviceGetAttribute(&cus, hipDeviceAttributeMultiprocessorCount, dev) != hipSuccess) { grid = -1; return; }
        if (hipFuncSetAttribute((const void*)mega_fwd, hipFuncAttributeMaxDynamicSharedMemorySize, LDS_BYTES) != hipSuccess) { fprintf(stderr, "kernel_launch: hipFuncSetAttribute failed\n"); grid = -1; return; }
        grid = cus;
        if (grid != 256) fprintf(stderr, "kernel_launch: %d CUs; this kernel is laid out for 256\n", grid);
    }
    if (grid < 0) return;
    (void)in_sizes;
    (void)hipMemsetAsync((char*)d_ws + WS_CTL, 0, CTL_ZERO_BYTES, stream);
    launch_mega(stream, d_in, d_out, d_ws, 0, NPHASES, 0, grid);
#ifdef MK_PROBES
#ifdef EXTRA_LO
    launch_mega(stream, d_in, d_out, d_ws, EXTRA_LO, EXTRA_HI, 1, grid);
#endif
#endif
}
```

```cpp
#include <hip/hip_runtime.h>
#include <hip/hip_bf16.h>
#include <cstdio>
#include <cstdint>
#include <cmath>

constexpr int DM = 1024, BATCH = 8, SEQ = 2048, NTOK = BATCH * SEQ;
constexpr int DLRU = 512, DATT = 512, NH = 8, HD = 64, NPROJ = 2 * DLRU + 3 * DATT + NH, NPJ = 2560;
constexpr int NE = 32, TOPK = 4, DEXP = 1024, NMOD = 6;
constexpr float RMS_EPS = 1e-6f;
constexpr int MAXROWS = NTOK * TOPK + NE * 256;
constexpr int MAXMT = MAXROWS / 256;

namespace pg8 {
#define PG8_LAS __attribute__((address_space(3)))
typedef unsigned short bf16_t;
typedef short bf16x8 __attribute__((ext_vector_type(8)));
typedef float f32x4 __attribute__((ext_vector_type(4)));
typedef float f32x2 __attribute__((ext_vector_type(2)));
typedef unsigned u32x4 __attribute__((ext_vector_type(4)));
constexpr int BM = 256, BK = 64, HALF = 128, HTB = HALF * BK * 2  , STAGE_BYTES = 8 * HTB, NXCD = 8, WGM = 4;
constexpr int GK = 1024, GNT = GK / BK;
typedef int i32x8 __attribute__((ext_vector_type(8)));
typedef int i32x4 __attribute__((ext_vector_type(4)));
constexpr int F8_SCALE_W = 0x79797979, F8_SCALE_A = 0x7f7f7f7f;

__host__ __device__ __forceinline__ int lds_byte(int r, int c) { const int st = (r >> 4) * 2 + (c >> 5), rr = r & 15, cc = c & 31, ob = rr * 64 + cc * 2; return st * 1024 + (ob ^ (((ob >> 9) & 1) << 5)); }
__host__ __device__ __forceinline__ void stage_rc(int b, int& R, int& C) { const int st = b / 1024, sb = b % 1024, swz = sb ^ (((sb >> 9) & 1) << 5); R = (st >> 1) * 16 + swz / 64; C = (st & 1) * 32 + (swz % 64) / 2; }
__host__ __device__ __forceinline__ int perm32(int rho) { const int n = rho >> 4, i = rho & 15; return 8 * (i >> 2) + 4 * n + (i & 3); }

struct Unit { const char* A0; const char* A1; const char* B0; const char* B1; int pm, pn, e, ord; };

__device__ __forceinline__ void mfma_f8_acc(f32x4& acc, const i32x8& b, const i32x8& a, int sw, int sa) {
    asm volatile("v_mfma_scale_f32_16x16x128_f8f6f4 %0, %1, %2, %0, %3, %4 op_sel_hi:[0,0,0]" : "+v"(acc) : "v"(b), "v"(a), "v"(sw), "v"(sa)); }
__device__ __forceinline__ unsigned cvt_pk_bf16(float lo, float hi) { unsigned r; asm volatile("v_cvt_pk_bf16_f32 %0, %1, %2" : "=v"(r) : "v"(lo), "v"(hi)); return r; }

template <class Epi, class Sched, bool F8 = false, int KREP = 1>
__device__ __forceinline__ void gemm_phase(PG8_LAS unsigned char* lds, const Sched& S, const Epi& E) {
    const int tid = threadIdx.x, wid = __builtin_amdgcn_readfirstlane(tid >> 6), lane = tid & 63, wr = wid >> 2, wc = wid & 3, fr = lane & 15, fq = lane >> 4;
    constexpr int KB = F8 ? GK : GK * 2, nt1 = F8 ? GK / 128 : GNT, nt = nt1 * KREP;
    int Rr[2], Cc[2];
    unsigned voffB[2], cvA[2][2], nvA[2][2];
#pragma unroll
    for (int i = 0; i < 2; ++i) { stage_rc(tid * 16 + i * 8192, Rr[i], Cc[i]); const int Rb = Epi::PERM ? ((Rr[i] & ~31) + perm32(Rr[i] & 31)) : Rr[i]; voffB[i] = (unsigned)(Rb * KB + Cc[i] * 2); }
    constexpr size_t kstep = (size_t)(BK * 2);
    const unsigned ldsw = (unsigned)wid * 1024u;
    const int aoff = lds_byte(wr * 64 + fr, fq * 8), boff = lds_byte(wc * 32 + fr, fq * 8);
#define PG8_SA(b, h) (((b) * 2 + (h)) * HTB)
#define PG8_SB(b, h) ((4 + (b) * 2 + (h)) * HTB)
#define PG8_STAGE(bufoff, gbase, voff) do { _Pragma("unroll") for (int _i = 0; _i < 2; ++_i) \
        __builtin_amdgcn_global_load_lds((const unsigned*)((const char*)(gbase) + (voff)[_i]), (PG8_LAS unsigned*)(lds + (bufoff) + ldsw + _i * 8192), 16, 0, 0); } while (0)
#define PG8_LD8(p) __builtin_shufflevector(*(const PG8_LAS i32x4*)(p), *(const PG8_LAS i32x4*)((p) + 1024), 0, 1, 2, 3, 4, 5, 6, 7)
#define PG8_LDA(dst, b, h) do { _Pragma("unroll") for (int m = 0; m < 4; ++m) { if constexpr (F8) { dst##8[m] = PG8_LD8(lds + PG8_SA(b, h) + aoff + m * 2048); } \
        else { _Pragma("unroll") for (int k = 0; k < 2; ++k) dst[m][k] = *(const PG8_LAS bf16x8*)(lds + PG8_SA(b, h) + aoff + m * 2048 + k * 1024); } } } while (0)
#define PG8_LDB(dst, b, h) do { _Pragma("unroll") for (int n = 0; n < 2; ++n) { if constexpr (F8) { dst##8[n] = PG8_LD8(lds + PG8_SB(b, h) + boff + n * 2048); } \
        else { _Pragma("unroll") for (int k = 0; k < 2; ++k) dst[n][k] = *(const PG8_LAS bf16x8*)(lds + PG8_SB(b, h) + boff + n * 2048 + k * 1024); } } } while (0)
#define PG8_MMA(ai, bj, At, Bt) do { __builtin_amdgcn_s_setprio(1); _Pragma("unroll") for (int m = 0; m < 4; ++m) _Pragma("unroll") for (int n = 0; n < 2; ++n) { \
        if constexpr (F8) { mfma_f8_acc(acc[ai][bj][m][n], Bt##8[n], At##8[m], scw, sca); } \
        else { _Pragma("unroll") for (int k = 0; k < 2; ++k) acc[ai][bj][m][n] = __builtin_amdgcn_mfma_f32_16x16x32_bf16(Bt[n][k], At[m][k], acc[ai][bj][m][n], 0, 0, 0); } } \
        __builtin_amdgcn_s_setprio(0); } while (0)
#define PG8_WAIT_V(n) asm volatile("s_waitcnt vmcnt(" #n ")" ::: "memory")
    constexpr int RELAX = 8 + Epi::NST + (Sched::GATHER ? 4 : 0);
#define PG8_WAIT_V8R(rx) do { if (rx) { if constexpr (RELAX == 12) PG8_WAIT_V(12); else if constexpr (RELAX == 16) PG8_WAIT_V(16); else if constexpr (RELAX == 20) PG8_WAIT_V(20); \
        else if constexpr (RELAX == 24) PG8_WAIT_V(24); else if constexpr (RELAX == 28) PG8_WAIT_V(28); else PG8_WAIT_V(8); } else PG8_WAIT_V(8); } while (0)
#define PG8_WAIT_L(n) asm volatile("s_waitcnt lgkmcnt(" #n ")" ::: "memory")
#define PG8_BAR __builtin_amdgcn_s_barrier()
#define PG8_SCHED __builtin_amdgcn_sched_barrier(0)
#define PG8_VOFF(dst, u) do { _Pragma("unroll") for (int _h = 0; _h < 2; ++_h) _Pragma("unroll") for (int _i = 0; _i < 2; ++_i) { \
        const int _row = Sched::GATHER ? S.row_of(u, _h * HALF + Rr[_i]) : Rr[_i]; dst[_h][_i] = (unsigned)(_row * KB + Cc[_i] * 2); } } while (0)
    Unit cur, nxt; int ui = 0;
    if (!S.next(0, cur)) return;
    f32x4 acc[2][2][4][2];
#pragma unroll
    for (int a = 0; a < 2; ++a)
#pragma unroll
        for (int b = 0; b < 2; ++b)
#pragma unroll
            for (int m = 0; m < 4; ++m)
#pragma unroll
                for (int n = 0; n < 2; ++n) acc[a][b][m][n] = (f32x4){0.f, 0.f, 0.f, 0.f};
    const int scw = F8_SCALE_W, sca = F8_SCALE_A;
    bf16x8 At[4][2], B0[2][2], B1[2][2]; i32x8 At8[4], B08[2], B18[2];
    PG8_VOFF(cvA, cur);
    if (Sched::GATHER) { asm volatile("s_waitcnt vmcnt(0)" ::: "memory"); }
    PG8_STAGE(PG8_SB(0, 0), cur.B0, voffB); PG8_STAGE(PG8_SB(0, 1), cur.B1, voffB); PG8_STAGE(PG8_SA(0, 0), cur.A0, cvA[0]); PG8_STAGE(PG8_SA(0, 1), cur.A1, cvA[1]);
    if (wr == 1) PG8_BAR;
    PG8_WAIT_V(2); PG8_BAR;
    PG8_STAGE(PG8_SB(1, 0), cur.B0 + kstep, voffB); PG8_STAGE(PG8_SA(1, 0), cur.A0 + kstep, cvA[0]); PG8_STAGE(PG8_SB(1, 1), cur.B1 + kstep, voffB);
    PG8_WAIT_V(6); PG8_BAR;
    for (;;) {
        const bool has_next = S.next(ui + 1, nxt);
        if (!has_next) nxt = cur;
        int nraw[2][2];
        if (Sched::GATHER && has_next) {
#pragma unroll
            for (int _h = 0; _h < 2; ++_h)
#pragma unroll
                for (int _i = 0; _i < 2; ++_i) { const int* p_ = S.row_ptr(nxt, _h * HALF + Rr[_i]); asm volatile("global_load_dword %0, %1, off" : "=v"(nraw[_h][_i]) : "v"(p_) : "memory"); }
        }
        if (has_next) { if (!Sched::GATHER) { PG8_VOFF(nvA, nxt); } }
        else {
#pragma unroll
            for (int _h = 0; _h < 2; ++_h)
#pragma unroll
                for (int _i = 0; _i < 2; ++_i) nvA[_h][_i] = cvA[_h][_i]; }
#pragma unroll 1
        for (int t = 0; t < nt; t += 2) {
            const bool last = (t == nt - 2); const bool rx = (t == 0) && (ui > 0);
            if (Epi::MID && t == nt / 2) E.mid(acc, cur, wr, wc, fr, fq);
            const char* a1_1 = cur.A1 + (size_t)((t + 1) % nt1) * kstep;
            const char* a2_0 = last ? nxt.A0 : cur.A0 + (size_t)((t + 2) % nt1) * kstep; const char* a2_1 = last ? nxt.A1 : cur.A1 + (size_t)((t + 2) % nt1) * kstep;
            const char* b2_0 = last ? nxt.B0 : cur.B0 + (size_t)((t + 2) % nt1) * kstep; const char* b2_1 = last ? nxt.B1 : cur.B1 + (size_t)((t + 2) % nt1) * kstep;
            const char* a3_0 = a2_0 + kstep; const char* a3_1 = a2_1 + kstep; const char* b3_0 = b2_0 + kstep; const char* b3_1 = b2_1 + kstep;
            if (Sched::GATHER && last && has_next) {
#pragma unroll
                for (int _h = 0; _h < 2; ++_h)
#pragma unroll
                    for (int _i = 0; _i < 2; ++_i) { int r_ = nraw[_h][_i]; asm volatile("" : "+v"(r_));
                        nvA[_h][_i] = (unsigned)(r_ * KB + Cc[_i] * 2); } }
            unsigned sv0[2], sv1[2];
#pragma unroll
            for (int _i = 0; _i < 2; ++_i) { sv0[_i] = last ? nvA[0][_i] : cvA[0][_i]; sv1[_i] = last ? nvA[1][_i] : cvA[1][_i]; }
            PG8_LDB(B0, 0, 0); PG8_LDB(B1, 0, 1); PG8_SCHED; PG8_LDA(At, 0, 0); PG8_STAGE(PG8_SA(1, 1), a1_1, cvA[1]);
            PG8_WAIT_V8R(rx); PG8_WAIT_L(0); PG8_BAR; PG8_MMA(0, 0, At, B0); PG8_MMA(0, 1, At, B1); PG8_BAR; PG8_SCHED;
            PG8_LDA(At, 0, 1); PG8_STAGE(PG8_SB(0, 0), b2_0, voffB); PG8_STAGE(PG8_SB(0, 1), b2_1, voffB); PG8_STAGE(PG8_SA(0, 0), a2_0, sv0);
            PG8_WAIT_V8R(rx); PG8_WAIT_L(0); PG8_BAR; PG8_MMA(1, 0, At, B0); PG8_MMA(1, 1, At, B1); PG8_BAR; PG8_SCHED;
            PG8_LDB(B0, 1, 0); PG8_LDB(B1, 1, 1); PG8_SCHED; PG8_LDA(At, 1, 0); PG8_STAGE(PG8_SA(0, 1), a2_1, sv1);
            PG8_WAIT_V(8); PG8_WAIT_L(0); PG8_BAR; PG8_MMA(0, 0, At, B0); PG8_MMA(0, 1, At, B1); PG8_BAR; PG8_SCHED;
            PG8_LDA(At, 1, 1); PG8_STAGE(PG8_SB(1, 0), b3_0, voffB); PG8_STAGE(PG8_SB(1, 1), b3_1, voffB); PG8_STAGE(PG8_SA(1, 0), a3_0, sv0);
            PG8_WAIT_V(8); PG8_WAIT_L(0); PG8_BAR; PG8_MMA(1, 0, At, B0); PG8_MMA(1, 1, At, B1); PG8_BAR; PG8_SCHED;
            (void)a3_1; (void)b3_1;
        }
        if (wr == 0) PG8_BAR;
        if constexpr (F8) { asm volatile("s_nop 15\n\ts_nop 15\n\ts_nop 7" ::: "memory"); }
        E(acc, cur, wr, wc, fr, fq);
        if (!has_next) break;
#pragma unroll
        for (int a = 0; a < 2; ++a)
#pragma unroll
            for (int b = 0; b < 2; ++b)
#pragma unroll
                for (int m = 0; m < 4; ++m)
#pragma unroll
                    for (int n = 0; n < 2; ++n) acc[a][b][m][n] = (f32x4){0.f, 0.f, 0.f, 0.f};
        cur = nxt; ++ui;
#pragma unroll
        for (int _h = 0; _h < 2; ++_h)
#pragma unroll
            for (int _i = 0; _i < 2; ++_i) cvA[_h][_i] = nvA[_h][_i];
        if (wr == 1) PG8_BAR;
    }
    PG8_WAIT_V(0);
    PG8_BAR;
#undef PG8_SA
#undef PG8_SB
#undef PG8_STAGE
#undef PG8_LDA
#undef PG8_LDB
#undef PG8_MMA
#undef PG8_LD8
#undef PG8_WAIT_V
#undef PG8_WAIT_V8R
#undef PG8_WAIT_L
#undef PG8_BAR
#undef PG8_SCHED
#undef PG8_VOFF
}
}

namespace pg8 {

struct DenseOrder {
    static constexpr bool GATHER = false;
    const bf16_t* A; const bf16_t* Bt; int nM, nN, nwg, G, c;
    __device__ __forceinline__ void init(const bf16_t* A_, const bf16_t* Bt_, int M, int N, int G_, int c_) { A = A_; Bt = Bt_; nM = M / BM; nN = N / BM; nwg = nM * nN; G = G_; c = c_; }
    __device__ __forceinline__ bool next(int i, Unit& u) const {
        const long L = (long)i * G + c; if (L >= nwg) return false;
        int wgid = (int)L; { const int q = nwg / NXCD, r = nwg % NXCD, xcd = wgid % NXCD, off = wgid / NXCD; wgid = (xcd < r ? xcd * (q + 1) : r * (q + 1) + (xcd - r) * q) + off; }
        const int nig = WGM * nN, gid = wgid / nig, fm = gid * WGM, gsz = (nM - fm) < WGM ? (nM - fm) : WGM;
        u.pm = fm + ((wgid % nig) % gsz); u.pn = (wgid % nig) / gsz; u.e = 0; u.ord = i;
        u.A0 = (const char*)A + (size_t)u.pm * BM * GK * 2; u.A1 = u.A0 + (size_t)HALF * GK * 2;
        u.B0 = (const char*)Bt + (size_t)u.pn * BM * GK * 2; u.B1 = u.B0 + (size_t)HALF * GK * 2;
        return true;
    }
    __device__ __forceinline__ int row_of(const Unit&, int r) const { return r; }
    __device__ __forceinline__ const int* row_ptr(const Unit&, int) const { return nullptr; }
};
struct UpOrder {
    static constexpr bool GATHER = true;
    const unsigned char* H2; const unsigned char* WupT; const int* row_tok; const PG8_LAS int* mt_exp; int nunits, G, c;
    __device__ __forceinline__ bool next(int i, Unit& u) const {
        const int L = i * G + c; if (L >= nunits) return false;
        u.pm = L >> 3; u.pn = L & 7; u.e = __builtin_amdgcn_readfirstlane(mt_exp[u.pm]); u.ord = i;
        u.A0 = (const char*)H2; u.A1 = (const char*)H2;
        u.B0 = (const char*)WupT + ((size_t)u.e * 2 * DEXP + (size_t)u.pn * HALF) * GK; u.B1 = u.B0 + (size_t)DEXP * GK;
        return true;
    }
    __device__ __forceinline__ int row_of(const Unit& u, int r) const { return row_tok[u.pm * BM + r]; }
    __device__ __forceinline__ const int* row_ptr(const Unit& u, int r) const { return row_tok + u.pm * BM + r; }
};
struct DownOrder {
    static constexpr bool GATHER = false;
    const unsigned char* ACT; const unsigned char* WdnT; const PG8_LAS int* mt_exp; int nunits, G, c;
    __device__ __forceinline__ bool next(int i, Unit& u) const {
        const int L = i * G + c; if (L >= nunits) return false;
        u.pm = L >> 2; u.pn = L & 3; u.e = __builtin_amdgcn_readfirstlane(mt_exp[u.pm]); u.ord = i;
        u.A0 = (const char*)ACT + (size_t)u.pm * BM * GK; u.A1 = u.A0 + (size_t)HALF * GK;
        u.B0 = (const char*)WdnT + ((size_t)u.e * DM + (size_t)u.pn * BM) * GK; u.B1 = u.B0 + (size_t)HALF * GK;
        return true;
    }
    __device__ __forceinline__ int row_of(const Unit&, int r) const { return r; }
    __device__ __forceinline__ const int* row_ptr(const Unit&, int) const { return nullptr; }
};

struct EpiProj {
    static constexpr bool PERM = true, MID = false; static constexpr int NST = 16;
    bf16_t* O; size_t tstride; float qscale;
    __device__ __forceinline__ void mid(f32x4 (&)[2][2][4][2], const Unit&, int, int, int, int) const {}
    __device__ __forceinline__ void operator()(const f32x4 (&acc)[2][2][4][2], const Unit& u, int wr, int wc, int fr, int fq) const {
        const int t = u.pn >> 1; bf16_t* base = O + (size_t)t * tstride; const float sc = (t == 2) ? qscale : 1.f;
        const int row0 = u.pm * BM + wr * 64 + fr, col0 = (u.pn & 1) * BM + wc * 32 + 8 * fq;
#pragma unroll
        for (int ai = 0; ai < 2; ++ai)
#pragma unroll
            for (int m = 0; m < 4; ++m) { bf16_t* rowp = base + (size_t)(row0 + ai * HALF + m * 16) * 512 + col0;
#pragma unroll
                for (int bj = 0; bj < 2; ++bj) { const f32x4 v0 = acc[ai][bj][m][0] * sc, v1 = acc[ai][bj][m][1] * sc;
                    u32x4 w; w.x = cvt_pk_bf16(v0[0], v0[1]); w.y = cvt_pk_bf16(v0[2], v0[3]); w.z = cvt_pk_bf16(v1[0], v1[1]); w.w = cvt_pk_bf16(v1[2], v1[3]);
                    *(u32x4*)(rowp + bj * HALF) = w; } }
    }
};
struct EpiOut {
    static constexpr bool PERM = true, MID = true; static constexpr int NST = 0;
    bf16_t* Y; const float* ssq;
    __device__ __forceinline__ void mid(f32x4 (&acc)[2][2][4][2], const Unit& u, int wr, int wc, int fr, int fq) const {
#pragma unroll
        for (int ai = 0; ai < 2; ++ai)
#pragma unroll
            for (int m = 0; m < 4; ++m) { const int row = u.pm * BM + ai * HALF + wr * 64 + m * 16 + fr;
                const f32x4 s0 = *(const f32x4*)(ssq + (size_t)row * 8), s1 = *(const f32x4*)(ssq + (size_t)row * 8 + 4);
                const float tot = ((s0[0] + s0[1]) + (s0[2] + s0[3])) + ((s1[0] + s1[1]) + (s1[2] + s1[3]));
                const float ri = 1.0f / sqrtf(tot * (1.0f / DATT) + RMS_EPS);
#pragma unroll
                for (int bj = 0; bj < 2; ++bj)
#pragma unroll
                    for (int n = 0; n < 2; ++n) acc[ai][bj][m][n] = acc[ai][bj][m][n] * ri; }
    }
    __device__ __forceinline__ void operator()(const f32x4 (&acc)[2][2][4][2], const Unit& u, int wr, int wc, int fr, int fq) const {
        const int row0 = u.pm * BM + wr * 64 + fr, col0 = u.pn * BM + wc * 32 + 8 * fq;
#pragma unroll
        for (int ai = 0; ai < 2; ++ai)
#pragma unroll
            for (int m = 0; m < 4; ++m) { bf16_t* rowp = Y + (size_t)(row0 + ai * HALF + m * 16) * DM + col0;
#pragma unroll
                for (int bj = 0; bj < 2; ++bj) { const f32x4 v0 = acc[ai][bj][m][0], v1 = acc[ai][bj][m][1];
                    u32x4 w; w.x = cvt_pk_bf16(v0[0], v0[1]); w.y = cvt_pk_bf16(v0[2], v0[3]); w.z = cvt_pk_bf16(v1[0], v1[1]); w.w = cvt_pk_bf16(v1[2], v1[3]);
                    *(u32x4*)(rowp + bj * HALF) = w; } }
    }
};
template <bool STORE = true> struct EpiUpT {
    static constexpr bool PERM = true, MID = false; static constexpr int NST = STORE ? 8 : 0;
    unsigned char* ACT; const PG8_LAS float* bias;
    __device__ __forceinline__ void mid(f32x4 (&)[2][2][4][2], const Unit&, int, int, int, int) const {}
    __device__ __forceinline__ void operator()(const f32x4 (&acc)[2][2][4][2], const Unit& u, int wr, int wc, int fr, int fq) const {
        const int row0 = u.pm * BM + wr * 64 + fr, col0 = u.pn * HALF + wc * 32 + 8 * fq;
        const PG8_LAS float* bg = bias + u.ord * 256 + wc * 32 + 8 * fq;
        f32x4 bgl[2], bli[2];
#pragma unroll
        for (int n = 0; n < 2; ++n) { bgl[n] = *(const PG8_LAS f32x4*)(bg + 4 * n); bli[n] = *(const PG8_LAS f32x4*)(bg + HALF + 4 * n) + 1.0f; }
#pragma unroll
        for (int ai = 0; ai < 2; ++ai)
#pragma unroll
            for (int m = 0; m < 4; ++m) { unsigned char* rowp = ACT + (size_t)(row0 + ai * HALF + m * 16) * DEXP + col0;
                f32x4 o[2];
#pragma unroll
                for (int n = 0; n < 2; ++n) { f32x4 g = acc[ai][0][m][n] + bgl[n], l = acc[ai][1][m][n] + bli[n];
#pragma unroll
                    for (int j = 0; j < 4; ++j) { g[j] = fminf(g[j], 7.0f); l[j] = __builtin_amdgcn_fmed3f(l[j], -6.0f, 8.0f); }
                    f32x4 t = g * (-1.702f * 1.4426950408889634f);
#pragma unroll
                    for (int j = 0; j < 4; ++j) t[j] = __builtin_amdgcn_exp2f(t[j]);
                    t = t + 1.0f;
#pragma unroll
                    for (int j = 0; j < 4; ++j) t[j] = __builtin_amdgcn_rcpf(t[j]);
                    o[n] = (g * t) * l; }
                int w0 = 0, w1 = 0; w0 = __builtin_amdgcn_cvt_pk_fp8_f32(o[0][0], o[0][1], w0, false); w0 = __builtin_amdgcn_cvt_pk_fp8_f32(o[0][2], o[0][3], w0, true);
                w1 = __builtin_amdgcn_cvt_pk_fp8_f32(o[1][0], o[1][1], w1, false); w1 = __builtin_amdgcn_cvt_pk_fp8_f32(o[1][2], o[1][3], w1, true);
                typedef int i32x2_ __attribute__((ext_vector_type(2))); if (STORE) *(i32x2_*)rowp = (i32x2_){w0, w1}; else asm volatile("" :: "v"(w0), "v"(w1)); }
    }
};
typedef EpiUpT<true> EpiUp;
struct EpiDown {
    static constexpr bool PERM = true, MID = false; static constexpr int NST = 16;
    unsigned char* YP; const PG8_LAS float* bias; const int* row_pair; const float* row_w;
    __device__ __forceinline__ void mid(f32x4 (&)[2][2][4][2], const Unit&, int, int, int, int) const {}
    __device__ __forceinline__ void operator()(const f32x4 (&acc)[2][2][4][2], const Unit& u, int wr, int wc, int fr, int fq) const {
        const int row0 = u.pm * BM + wr * 64 + fr, col0 = u.pn * BM + wc * 32 + 8 * fq;
        const PG8_LAS float* bd = bias + u.ord * 256 + wc * 32 + 8 * fq;
        f32x4 bv[2][2];
#pragma unroll
        for (int bj = 0; bj < 2; ++bj)
#pragma unroll
            for (int n = 0; n < 2; ++n) bv[bj][n] = *(const PG8_LAS f32x4*)(bd + bj * HALF + 4 * n);
        int pr[2][4]; float wt[2][4];
#pragma unroll
        for (int ai = 0; ai < 2; ++ai)
#pragma unroll
            for (int m = 0; m < 4; ++m) { const int pos = row0 + ai * HALF + m * 16; pr[ai][m] = row_pair[pos]; wt[ai][m] = row_w[pos] * 4.0f; }
#pragma unroll
        for (int ai = 0; ai < 2; ++ai)
#pragma unroll
            for (int m = 0; m < 4; ++m) { const int pair = pr[ai][m] >= 0 ? pr[ai][m] : NTOK * TOPK; const float w = wt[ai][m];
                { unsigned char* rowp = YP + (size_t)pair * DM + col0;
#pragma unroll
                    for (int bj = 0; bj < 2; ++bj) { const f32x4 v0 = (acc[ai][bj][m][0] + bv[bj][0]) * w, v1 = (acc[ai][bj][m][1] + bv[bj][1]) * w;
                        int q0 = 0, q1 = 0; q0 = __builtin_amdgcn_cvt_pk_fp8_f32(v0[0], v0[1], q0, false); q0 = __builtin_amdgcn_cvt_pk_fp8_f32(v0[2], v0[3], q0, true);
                        q1 = __builtin_amdgcn_cvt_pk_fp8_f32(v1[0], v1[1], q1, false); q1 = __builtin_amdgcn_cvt_pk_fp8_f32(v1[2], v1[3], q1, true);
                        typedef int i32x2_ __attribute__((ext_vector_type(2))); *(i32x2_*)(rowp + bj * HALF) = (i32x2_){q0, q1}; } } }
    }
};
#ifdef MK_PROBES
struct EpiNop {
    static constexpr bool PERM = true, MID = false; static constexpr int NST = 0;
    __device__ __forceinline__ void mid(f32x4 (&)[2][2][4][2], const Unit&, int, int, int, int) const {}
    __device__ __forceinline__ void operator()(const f32x4 (&)[2][2][4][2], const Unit&, int, int, int, int) const {}
};
#endif
}

namespace attn_body {
using bf16=__hip_bfloat16;
using bf16x8=__attribute__((ext_vector_type(8)))short;
using s16x4=__attribute__((ext_vector_type(4)))short;
using f32x16=__attribute__((ext_vector_type(16)))float;
using u32x4=__attribute__((ext_vector_type(4)))unsigned;
constexpr int BATCH=8,NHEAD=8,SEQ=2048,D=64,DM=NHEAD*D,OPITCH=1024;
constexpr int NW=8,QBLK=32,QB=QBLK*NW,KVBLK=64,NQB=SEQ/QB;
constexpr int ATTN_PITCH=DM, ATTN_UNIT_ROWS=QB;
__device__ __forceinline__ int crow(int r,int hi){return (r&3)+8*(r>>2)+4*hi;}
#define SBAR() __builtin_amdgcn_sched_barrier(0)
__device__ __forceinline__ void cmask(f32x16&p0,f32x16&p1,int jb,int qrel,int hi){
  const float NEG=-INFINITY; int kb=64*jb+4*hi;
  #pragma unroll
  for(int r=0;r<16;++r){int kv=kb+(r&3)+8*(r>>2); if(kv>qrel)p0[r]=NEG; if(kv+32>qrel)p1[r]=NEG;}
}

constexpr int NSLOT=3, SLOTB=8192;
constexpr int LDS_K=0, LDS_V=NSLOT*SLOTB, LDS_WS=2*NSLOT*SLOTB, LDS_OST=LDS_WS+NW*64*4, LDS_BIAS=LDS_OST+NW*4096, LDS_SCAN=LDS_BIAS+(SEQ+64)*4, LDS_BYTES=LDS_SCAN+256;
constexpr float C2=0.125f*1.4426950408889634f;
__device__ __forceinline__ void glds16(const void*gsrc,unsigned lds_dst){unsigned keep;
  asm volatile("s_mov_b32 %0, m0\n\ts_mov_b32 m0, %2\n\ts_nop 0\n\tglobal_load_lds_dwordx4 %1, off\n\ts_mov_b32 m0, %0":"=&s"(keep):"v"(gsrc),"s"(lds_dst):"memory");}
__device__ __forceinline__ float max3f(float a,float b,float c){float r;asm("v_max3_f32 %0, %1, %2, %3":"=v"(r):"v"(a),"v"(b),"v"(c));return r;}
__device__ __forceinline__ float max2f(float a,float b){float r;asm("v_max_f32_e32 %0, %1, %2":"=v"(r):"v"(a),"v"(b));return r;}
__device__ __forceinline__ float fadd_s(float a,float b){float r;asm("v_add_f32_e32 %0, %1, %2":"=v"(r):"v"(a),"v"(b));return r;}
__device__ __forceinline__ float fsub_s(float a,float b){float r;asm("v_sub_f32_e32 %0, %1, %2":"=v"(r):"v"(a),"v"(b));return r;}
typedef float f32x2_t __attribute__((ext_vector_type(2))); typedef float f32x4_t __attribute__((ext_vector_type(4))); typedef __bf16 bf16x2_t __attribute__((ext_vector_type(2)));
__device__ __forceinline__ unsigned cvtpk_s(float lo,float hi){f32x2_t v={lo,hi};bf16x2_t b=__builtin_convertvector(v,bf16x2_t);return __builtin_bit_cast(unsigned,b);}
#define WAIT_BAR(N) asm volatile("s_waitcnt vmcnt(" #N ") lgkmcnt(0)\n\ts_barrier":::"memory")

__device__ __forceinline__ void qkt(f32x16&p0,f32x16&p1,const char*Kslot,const bf16x8*qr,int r32,int hi){
  const char*kb=Kslot+hi*1024+r32*16;
  #pragma unroll
  for(int d0=0;d0<4;++d0){
    const bf16x8 b0=*reinterpret_cast<const bf16x8*>(kb+d0*2048);
    const bf16x8 b1=*reinterpret_cast<const bf16x8*>(kb+d0*2048+512);
    p0=__builtin_amdgcn_mfma_f32_32x32x16_bf16(b0,qr[d0],p0,0,0,0);p1=__builtin_amdgcn_mfma_f32_32x32x16_bf16(b1,qr[d0],p1,0,0,0);}
}
typedef __attribute__((address_space(3))) const char* lds_cptr;
typedef short v4i16_t __attribute__((ext_vector_type(4)));
__device__ __forceinline__ void kload8(bf16x8*kf,lds_cptr kp){
  kf[0]=*(const __attribute__((address_space(3))) bf16x8*)(kp);      kf[1]=*(const __attribute__((address_space(3))) bf16x8*)(kp+512);
  kf[2]=*(const __attribute__((address_space(3))) bf16x8*)(kp+2048); kf[3]=*(const __attribute__((address_space(3))) bf16x8*)(kp+2560);
  kf[4]=*(const __attribute__((address_space(3))) bf16x8*)(kp+4096); kf[5]=*(const __attribute__((address_space(3))) bf16x8*)(kp+4608);
  kf[6]=*(const __attribute__((address_space(3))) bf16x8*)(kp+6144); kf[7]=*(const __attribute__((address_space(3))) bf16x8*)(kp+6656);
}
__device__ __forceinline__ void kload2(bf16x8*kf,lds_cptr kp,int j){ kf[2*j]=*(const __attribute__((address_space(3))) bf16x8*)(kp+j*2048); kf[2*j+1]=*(const __attribute__((address_space(3))) bf16x8*)(kp+j*2048+512); }
__device__ __forceinline__ s16x4 vtr(lds_cptr p){ return __builtin_bit_cast(s16x4,__builtin_amdgcn_ds_read_tr16_b64_v4i16((__attribute__((address_space(3))) v4i16_t*)p)); }
__device__ __forceinline__ float rowmax(const f32x16&p0,const f32x16&p1){
  float a=max3f(p0[0],p0[1],p1[0]),b=max3f(p0[2],p0[3],p1[1]);a=max3f(a,p1[2],p1[3]);
  #pragma unroll
  for(int r=4;r<16;r+=4){a=max3f(a,p0[r],p0[r+1]);b=max3f(b,p0[r+2],p0[r+3]);a=max3f(a,p1[r],p1[r+1]);b=max3f(b,p1[r+2],p1[r+3]);}
  const float m=max2f(a,b);
  auto rr=__builtin_amdgcn_permlane32_swap(__float_as_uint(m),__float_as_uint(m),false,false);
  return max2f(__uint_as_float(rr[0]),__uint_as_float(rr[1]));
}
__device__ __forceinline__ void pv(f32x16*o,int vb,bf16x8 pa0,bf16x8 pa1,bf16x8 pa2,bf16x8 pa3){
  #pragma unroll
  for(int d0=0;d0<2;++d0){s16x4 lo[4],hi[4];
    #pragma unroll
    for(int ks=0;ks<4;++ks){
      asm volatile("ds_read_b64_tr_b16 %0,%1 offset:%c2":"=&v"(lo[ks]):"v"(vb),"i"(d0*4096+ks*1024):"memory");
      asm volatile("ds_read_b64_tr_b16 %0,%1 offset:%c2":"=&v"(hi[ks]):"v"(vb),"i"(d0*4096+ks*1024+512):"memory");}
    asm volatile("s_waitcnt lgkmcnt(0)":::"memory");SBAR();
    #define PK(k) (bf16x8){lo[k][0],lo[k][1],lo[k][2],lo[k][3],hi[k][0],hi[k][1],hi[k][2],hi[k][3]}
    o[d0]=__builtin_amdgcn_mfma_f32_32x32x16_bf16(pa0,PK(0),o[d0],0,0,0);
    o[d0]=__builtin_amdgcn_mfma_f32_32x32x16_bf16(pa1,PK(1),o[d0],0,0,0);
    o[d0]=__builtin_amdgcn_mfma_f32_32x32x16_bf16(pa2,PK(2),o[d0],0,0,0);
    o[d0]=__builtin_amdgcn_mfma_f32_32x32x16_bf16(pa3,PK(3),o[d0],0,0,0);
    #undef PK
  }
}

#ifndef ATTN_STORE16
#define ATTN_STORE16(p,v) (*(u32x4*)(p)=(v))
#endif
template<int THRL> __device__ __forceinline__ void attn_unit(int b,int h,int qb,const bf16*Q,const bf16*__restrict__ K,const bf16*__restrict__ V,bf16*O,const float*__restrict__ LOGF2,float*SSQ,char*shm){
  const int tid=threadIdx.x,lane=tid&63,r32=lane&31,hi=lane>>5; const int wid=__builtin_amdgcn_readfirstlane(tid>>6);
  const long rowbase=(long)b*SEQ; const int q0=qb*QB;
  const bf16*Qw=Q+(rowbase+q0+wid*QBLK)*DM+h*D;
  const bf16*Kh=K+rowbase*DM+h*D,*Vh=V+rowbase*DM+h*D;
  const unsigned lds0=(unsigned)(uintptr_t)shm;
  float*wsf=(float*)(shm+LDS_WS)+wid*64;
  const bf16*ksrc=Kh+(long)lane*DM+wid*8;
  const bf16*vsrc=Vh+(long)(16*(wid&3)+(lane>>2))*DM+(wid>>2)*32+(lane&3)*8;
  const unsigned kdst=lds0+LDS_K+wid*1024, vdst=lds0+LDS_V+wid*1024;
  #define DMA_K(t,slot) glds16(ksrc+(long)(t)*KVBLK*DM,(unsigned)__builtin_amdgcn_readfirstlane(kdst+(slot)))
  #define DMA_V(t,slot) glds16(vsrc+(long)(t)*KVBLK*DM,(unsigned)__builtin_amdgcn_readfirstlane(vdst+(slot)))
  const int vb0=(int)(lds0+LDS_V)+((lane>>4)&1)*32+(lane&3)*8+(4*hi+((lane&15)>>2))*64;
  const char*Kbase=shm+LDS_K; bf16x8 kf[8];
  const lds_cptr shm3=(lds_cptr)shm; const lds_cptr kp0=shm3+LDS_K+hi*1024+r32*16; const lds_cptr vp0=shm3+LDS_V+((lane>>4)&1)*32+(lane&3)*8+(4*hi+((lane&15)>>2))*64;
  const int NT=(q0+QB)/KVBLK;
  const lds_cptr biasr=(lds_cptr)shm+LDS_BIAS+16*hi;
  #define BIAS4(t,o) (*(const __attribute__((address_space(3))) f32x4_t*)(biasr+(t)*(KVBLK*4)+(o)*4))
  #define INIT4(Y,g,t,o) do{ const f32x4_t x_=BIAS4(t,(o)+8*(g)); Y[4*(g)]=x_[0]-mhat; Y[4*(g)+1]=x_[1]-mhat; Y[4*(g)+2]=x_[2]-mhat; Y[4*(g)+3]=x_[3]-mhat; }while(0)
  #define INITT(Y0,Y1,t) do{ INIT4(Y0,0,t,0);INIT4(Y0,1,t,0);INIT4(Y0,2,t,0);INIT4(Y0,3,t,0); INIT4(Y1,0,t,32);INIT4(Y1,1,t,32);INIT4(Y1,2,t,32);INIT4(Y1,3,t,32); }while(0)
  DMA_K(0,0);DMA_V(0,0);DMA_K(1,SLOTB);
  bf16x8 qr[4];
  #pragma unroll
  for(int d0=0;d0<4;++d0)qr[d0]=*reinterpret_cast<const bf16x8*>(&Qw[(long)r32*DM+d0*16+hi*8]);
  float mhat,l_reg=0.f;f32x16 o[2];o[0]=f32x16{};o[1]=f32x16{};
  const int qrel=wid*QBLK+r32;
  #define CMASK(P0,P1,t) do{int jb_=(t)-(NT-4); if(jb_>=0)cmask(P0,P1,jb_,qrel,hi);}while(0)
  bool resc=false;
  #define START(P0,P1) do{ const float rm=rowmax(P0,P1); resc=false; \
    { const float dl=__builtin_fmaxf(rm,0.f); mhat=fadd_s(mhat,dl); \
      _Pragma("unroll") for(int r=0;r<16;++r){P0[r]=fsub_s(P0[r],dl);P1[r]=fsub_s(P1[r],dl);} } \
    _Pragma("unroll") for(int r=0;r<16;++r)P0[r]=__builtin_amdgcn_exp2f(P0[r]); }while(0)
  #define RESC() do{ if(resc){ asm volatile("s_waitcnt lgkmcnt(0)":::"memory"); \
      _Pragma("unroll") for(int d_=0;d_<2;++d_) _Pragma("unroll") for(int r=0;r<16;++r)o[d_][r]*=wsf[crow(r,hi)]; } }while(0)
  f32x16 pA0,pA1,pB0,pB1;
  int sl_prev=0,sl_cur=0,sl_next=SLOTB;
  #define ROT() do{sl_prev=sl_cur;sl_cur=sl_next;sl_next=(sl_next==(NSLOT-1)*SLOTB)?0:sl_next+SLOTB;}while(0)
  DMA_K(2,2*SLOTB);
  { float*biasl=(float*)(shm+LDS_BIAS); float*scn=(float*)(shm+LDS_SCAN);
    const float*lf=LOGF2+rowbase*NHEAD+h;
    float v0=0.f,v1=0.f,v2=0.f,v3=0.f; const int i0=4*tid;
    if(i0<q0){ v0=lf[(long)(q0-1-i0)*NHEAD]; v1=lf[(long)(q0-2-i0)*NHEAD]; v2=lf[(long)(q0-3-i0)*NHEAD]; v3=lf[(long)(q0-4-i0)*NHEAD]; }
    const float tsum=(v0+v1)+(v2+v3); float inc=tsum;
    #pragma unroll
    for(int o=1;o<64;o<<=1){ const float n_=__shfl_up(inc,o); if(lane>=o)inc+=n_; }
    if(lane==63)scn[wid]=inc;
    const float f0=lf[(long)(q0+4*lane)*NHEAD],f1=lf[(long)(q0+4*lane+1)*NHEAD],f2=lf[(long)(q0+4*lane+2)*NHEAD],f3=lf[(long)(q0+4*lane+3)*NHEAD];
    float finc=(f0+f1)+(f2+f3);
    #pragma unroll
    for(int o=1;o<64;o<<=1){ const float n_=__shfl_up(finc,o); if(lane>=o)finc+=n_; }
    const float fex=finc-((f0+f1)+(f2+f3));
    if(wid==0){ biasl[q0+4*lane]=-(fex+f0); biasl[q0+4*lane+1]=-(fex+f0+f1); biasl[q0+4*lane+2]=-(fex+f0+f1+f2); biasl[q0+4*lane+3]=-(fex+f0+f1+f2+f3); }
    __syncthreads();
    float woff=0.f;
    #pragma unroll
    for(int w_=0;w_<NW;++w_) woff+=(w_<wid)?scn[w_]:0.f;
    const float ex=woff+inc-tsum;
    if(i0<q0){ biasl[q0-1-i0]=ex; biasl[q0-2-i0]=ex+v0; biasl[q0-3-i0]=ex+v0+v1; biasl[q0-4-i0]=ex+v0+v1+v2; }
    __syncthreads(); }
  mhat=((const float*)(shm+LDS_BIAS))[q0+wid*QBLK+r32]+8.0f;

  WAIT_BAR(3);
  INITT(pA0,pA1,0); qkt(pA0,pA1,Kbase,qr,r32,hi);asm volatile("s_nop 15\n\ts_nop 7":"+v"(pA0),"+v"(pA1));CMASK(pA0,pA1,0);
  START(pA0,pA1);
  _Pragma("unroll") for(int r=0;r<16;++r)pA1[r]=__builtin_amdgcn_exp2f(pA1[r]);
  INITT(pB0,pB1,1);
  WAIT_BAR(0);
  DMA_K(3,0);DMA_V(1,SLOTB);
  ROT();
  kload8(kf,kp0+sl_cur);
  WAIT_BAR(2);
  s16x4 vlo[8],vhi[8]; u32x4 pw0,pw1,pw2,pw3;
  #define PKW(P,B) cvtpk_s(P[B],P[B+1])
  #define PAF(k) __builtin_bit_cast(bf16x8,pw##k)
  #define VFR(i) (bf16x8){vlo[i][0],vlo[i][1],vlo[i][2],vlo[i][3],vhi[i][0],vhi[i][1],vhi[i][2],vhi[i][3]}
  #define PIN(x) asm volatile("":"+v"(x))
  #define MX3(a,b,c) __builtin_fmaxf(__builtin_fmaxf((a),(b)),(c))
  #define GAPA(MF,A0,A1,A2,A3,W0,W1,PW) do{ MF; sacc+=A0; sacc+=A1; sacc+=A2; sacc+=A3; PIN(sacc); W0; W1; PIN(PW); SBAR(); }while(0)
  #define EX(v) __builtin_amdgcn_exp2f(v)
  #define GAPB(MF,X,B,GN,Y,tn,o) do{ MF; X[B]=EX(X[B]); X[B+1]=EX(X[B+1]); X[B+2]=EX(X[B+2]); X[B+3]=EX(X[B+3]); PIN(X); if(GN){ INIT4(Y,(B)/4,tn,o); PIN(Y); } SBAR(); }while(0)
  #define VRD(i) do{ vlo[i]=vtr(vp_+(((i)>>2)*4096+((i)&3)*1024)); vhi[i]=vtr(vp_+(((i)>>2)*4096+((i)&3)*1024+512)); }while(0)
  #define KRD(G,j) do{ if(G){ kload2(kf,kp0+sl_next,j); SBAR(); } }while(0)
  #define STEP(C0,C1,P0,P1,t,GK,GV,GL) do{ SBAR(); \
    const lds_cptr vp_=vp0+sl_prev; \
    VRD(0); SBAR(); float sacc=(P0[0]+P0[1]); \
    GAPA(C0=__builtin_amdgcn_mfma_f32_32x32x16_bf16(kf[0],qr[0],C0,0,0,0), P0[2],P0[3],P0[4],P0[5],     pw0[0]=PKW(P0,0), pw0[1]=PKW(P0,2), pw0); \
    VRD(4); SBAR(); GAPA(C1=__builtin_amdgcn_mfma_f32_32x32x16_bf16(kf[1],qr[0],C1,0,0,0), P0[6],P0[7],P0[8],P0[9],     pw0[2]=PKW(P0,4), pw0[3]=PKW(P0,6), pw0); \
    VRD(1); SBAR(); GAPA(C0=__builtin_amdgcn_mfma_f32_32x32x16_bf16(kf[2],qr[1],C0,0,0,0),   P0[10],P0[11],P0[12],P0[13], pw1[0]=PKW(P0,8), pw1[1]=PKW(P0,10), pw1); \
    VRD(5); SBAR(); GAPA(C1=__builtin_amdgcn_mfma_f32_32x32x16_bf16(kf[3],qr[1],C1,0,0,0),   P0[14],P0[15],P1[0],P1[1],   pw1[2]=PKW(P0,12),pw1[3]=PKW(P0,14), pw1); \
    VRD(2); SBAR(); GAPA(C0=__builtin_amdgcn_mfma_f32_32x32x16_bf16(kf[4],qr[2],C0,0,0,0),   P1[2],P1[3],P1[4],P1[5],     pw2[0]=PKW(P1,0), pw2[1]=PKW(P1,2), pw2); \
    VRD(6); SBAR(); GAPA(C1=__builtin_amdgcn_mfma_f32_32x32x16_bf16(kf[5],qr[2],C1,0,0,0),   P1[6],P1[7],P1[8],P1[9],     pw2[2]=PKW(P1,4), pw2[3]=PKW(P1,6), pw2); \
    VRD(3); SBAR(); GAPA(C0=__builtin_amdgcn_mfma_f32_32x32x16_bf16(kf[6],qr[3],C0,0,0,0),   P1[10],P1[11],P1[12],P1[13], pw3[0]=PKW(P1,8), pw3[1]=PKW(P1,10), pw3); \
    VRD(7); SBAR(); GAPA(C1=__builtin_amdgcn_mfma_f32_32x32x16_bf16(kf[7],qr[3],C1,0,0,0),   P1[14],P1[15],0.f,0.f,       pw3[2]=PKW(P1,12),pw3[3]=PKW(P1,14), pw3); \
    l_reg+=sacc; \
    if(GK){DMA_K((t)+3,sl_cur);} if(GV){DMA_V((t)+1,sl_next);} \
    CMASK(C0,C1,t); \
    { float a=MX3(C0[0],C0[1],C1[0]),b=MX3(C0[2],C0[3],C1[1]); a=MX3(a,C1[2],C1[3]); \
      _Pragma("unroll") for(int r=4;r<16;r+=4){a=MX3(a,C0[r],C0[r+1]);b=MX3(b,C0[r+2],C0[r+3]);a=MX3(a,C1[r],C1[r+1]);b=MX3(b,C1[r+2],C1[r+3]);} \
      float rm=__builtin_fmaxf(a,b); { auto rr=__builtin_amdgcn_permlane32_swap(__float_as_uint(rm),__float_as_uint(rm),false,false); rm=__builtin_fmaxf(__uint_as_float(rr[0]),__uint_as_float(rr[1])); } \
      resc=false; \
      if(__builtin_expect(__any(rm>(float)THRL),0)){ const float dl=__builtin_fmaxf(rm,0.f); mhat+=dl; \
        _Pragma("unroll") for(int r=0;r<16;++r){C0[r]-=dl;C1[r]-=dl;} \
        const float f=__builtin_amdgcn_exp2f(-dl); l_reg*=f; if(hi==0)wsf[r32]=f; resc=true; } } \
    SBAR(); \
    GAPB(o[0]=__builtin_amdgcn_mfma_f32_32x32x16_bf16(PAF(0),VFR(0),o[0],0,0,0), C0,0,  GL,P0,(t)+1,0); \
    GAPB(o[1]=__builtin_amdgcn_mfma_f32_32x32x16_bf16(PAF(0),VFR(4),o[1],0,0,0), C0,4,  GL,P0,(t)+1,0); \
    KRD(GL,0); GAPB(o[0]=__builtin_amdgcn_mfma_f32_32x32x16_bf16(PAF(1),VFR(1),o[0],0,0,0), C0,8,  GL,P0,(t)+1,0); \
    KRD(GL,1); GAPB(o[1]=__builtin_amdgcn_mfma_f32_32x32x16_bf16(PAF(1),VFR(5),o[1],0,0,0), C0,12, GL,P0,(t)+1,0); \
    KRD(GL,2); GAPB(o[0]=__builtin_amdgcn_mfma_f32_32x32x16_bf16(PAF(2),VFR(2),o[0],0,0,0), C1,0,  GL,P1,(t)+1,32); \
    KRD(GL,3); GAPB(o[1]=__builtin_amdgcn_mfma_f32_32x32x16_bf16(PAF(2),VFR(6),o[1],0,0,0), C1,4,  GL,P1,(t)+1,32); \
    GAPB(o[0]=__builtin_amdgcn_mfma_f32_32x32x16_bf16(PAF(3),VFR(3),o[0],0,0,0), C1,8,  GL,P1,(t)+1,32); \
    GAPB(o[1]=__builtin_amdgcn_mfma_f32_32x32x16_bf16(PAF(3),VFR(7),o[1],0,0,0), C1,12, GL,P1,(t)+1,32); \
    }while(0)
  int t=1;
  #undef CMASK
  #define CMASK(P0,P1,t) do{}while(0)
  for(;t+5<NT;t+=2){
    STEP(pB0,pB1,pA0,pA1,t,true,true,true);     WAIT_BAR(2); RESC(); ROT();
    STEP(pA0,pA1,pB0,pB1,t+1,true,true,true);   WAIT_BAR(2); RESC(); ROT();
  }
  #undef CMASK
  #define CMASK(P0,P1,t) do{int jb_=(t)-(NT-4); if(jb_>=0)cmask(P0,P1,jb_,qrel,hi);}while(0)
  #define ENDW(tt) do{ if((tt)+3<NT){WAIT_BAR(2);} else if((tt)+2<NT){WAIT_BAR(1);} else {WAIT_BAR(0);} }while(0)
  for(;t+1<NT;t+=2){
    STEP(pB0,pB1,pA0,pA1,t,(t+3<NT),(t+1<NT),(t+1<NT));       ENDW(t);   RESC(); ROT();
    STEP(pA0,pA1,pB0,pB1,t+1,(t+4<NT),(t+2<NT),(t+2<NT));     ENDW(t+1); RESC(); ROT();
  }
  STEP(pB0,pB1,pA0,pA1,NT-1,false,false,false); RESC();
  { float sacc=pB0[0]+pB0[1]; _Pragma("unroll") for(int r=2;r<16;++r)sacc+=pB0[r]; _Pragma("unroll") for(int r=0;r<16;++r)sacc+=pB1[r]; l_reg+=sacc;
    pw0=(u32x4){PKW(pB0,0),PKW(pB0,2),PKW(pB0,4),PKW(pB0,6)};pw1=(u32x4){PKW(pB0,8),PKW(pB0,10),PKW(pB0,12),PKW(pB0,14)};pw2=(u32x4){PKW(pB1,0),PKW(pB1,2),PKW(pB1,4),PKW(pB1,6)};pw3=(u32x4){PKW(pB1,8),PKW(pB1,10),PKW(pB1,12),PKW(pB1,14)};
    SBAR(); pv(o,vb0+sl_cur,PAF(0),PAF(1),PAF(2),PAF(3)); }
  #undef PKW
  #undef PAF
  #undef VFR
  #undef PIN
  #undef MX3
  #undef GAPA
  #undef GAPB
  #undef EX
  #undef VRD
  #undef KRD
  #undef STEP
  #undef ENDW
  {auto rr=__builtin_amdgcn_permlane32_swap(__float_as_uint(l_reg),__float_as_uint(l_reg),false,false);l_reg=__uint_as_float(rr[0])+__uint_as_float(rr[1]);}
  if(hi==0)wsf[32+r32]=l_reg;asm volatile("s_waitcnt lgkmcnt(0)":::"memory");
  float rli[16];
  #pragma unroll
  for(int r=0;r<16;++r)rli[r]=__builtin_amdgcn_rcpf(wsf[32+crow(r,hi)]);
  bf16*Ow=O+(rowbase+q0+wid*QBLK)*OPITCH+h*D; float*Sw=SSQ+(rowbase+q0+wid*QBLK)*NHEAD+h;
  { bf16*stg=(bf16*)(shm+LDS_OST)+wid*2048;
    #pragma unroll
    for(int r=0;r<16;++r){const int orow=crow(r,hi);
      #pragma unroll
      for(int d0=0;d0<2;++d0)stg[orow*64+d0*32+r32]=__float2bfloat16(o[d0][r]*rli[r]);}
    asm volatile("s_waitcnt lgkmcnt(0)":::"memory");
    #pragma unroll
    for(int i=0;i<4;++i){const int row=i*8+(lane>>3),ch=lane&7; const u32x4 v=*(const u32x4*)(stg+row*64+ch*8); ATTN_STORE16(Ow+(long)row*OPITCH+ch*8,v);
      float sq=0.f;
      #pragma unroll
      for(int j=0;j<4;++j){ const float lo_=__uint_as_float(v[j]<<16), hi_=__uint_as_float(v[j]&0xffff0000u); sq+=lo_*lo_+hi_*hi_; }
      sq+=__shfl_xor(sq,1); sq+=__shfl_xor(sq,2); sq+=__shfl_xor(sq,4);
      if(ch==0)Sw[(long)row*NHEAD]=sq; } }
  asm volatile("s_waitcnt lgkmcnt(0)\n\ts_barrier":::"memory");
  #undef DMA_K
  #undef BIAS4
  #undef INIT4
  #undef INITT
  #undef DMA_V
  #undef CMASK
  #undef START
  #undef RESC
  #undef ROT
}
constexpr int ATTN_LDS_BYTES=LDS_BYTES;
struct AttnTensors { const bf16* Q; const bf16* K; const bf16* V; bf16* O; const float* LOGF2; float* SSQ; };
struct AttnUnit { int bh; int qb; };
struct StaticOrder {
  int vcu,G;
  __device__ __forceinline__ explicit StaticOrder(int grid,int vcu_):vcu(vcu_),G(grid){}
  __device__ __forceinline__ bool next(int i,AttnUnit&u)const{ const int L=(i>>1)*G+vcu; if(L>=BATCH*NHEAD*4)return false; const int s=L&3; u.bh=L>>2; u.qb=(i&1)?7-s:s; return true; }
  __device__ __forceinline__ void a_ready(const AttnUnit&)const{}
  __device__ __forceinline__ void done(const AttnUnit&)const{}
};
template<class Sched,int THRL=8> __device__ __forceinline__ void attn_phase(char*lds,const AttnTensors&T,const Sched&S){
  AttnUnit u;
  for(int i=0;S.next(i,u);++i){ S.a_ready(u); attn_unit<THRL>(u.bh/NHEAD,u.bh%NHEAD,u.qb,T.Q,T.K,T.V,T.O,T.LOGF2,T.SSQ,lds); S.done(u); }
}
#undef SBAR
#undef WAIT_BAR
}

constexpr int NWAVES = 8;
constexpr int NPHASES = 11;

constexpr size_t MiB = 1u << 20, KiB = 1u << 10;
constexpr size_t WS_CTL = 0, CTL_ZERO_BYTES = 1 * MiB;
constexpr size_t WS_MOD = 1 * MiB;
constexpr size_t WS_LOGF2 = 1 * MiB + 256 * KiB;
constexpr size_t WS_SSQ = 1 * MiB + 768 * KiB;
constexpr size_t WS_TOPI = 2 * MiB + 256 * KiB;
constexpr size_t WS_TOPW = 2 * MiB + 512 * KiB;
constexpr size_t WS_WGCNT = 2 * MiB + 768 * KiB;
constexpr size_t WS_LSUM = 3 * MiB;
constexpr size_t WS_ROWTOK = 4 * MiB, WS_ROWPAIR = 4 * MiB + 512 * KiB, WS_ROWW = 5 * MiB, WS_MTEXP = 5 * MiB + 512 * KiB;
constexpr size_t WS_LWT = 6 * MiB;
constexpr size_t WS_WFT = 6 * MiB + 512 * KiB;
constexpr size_t WS_WRT = 7 * MiB;
constexpr size_t WS_WIN = 8 * MiB;
constexpr size_t WS_WOUT = 13 * MiB;
constexpr size_t WS_WUP = 16 * MiB;
constexpr size_t WS_WDN = 144 * MiB;
constexpr size_t WS_H1 = 208 * MiB;
constexpr size_t WS_PJ = 240 * MiB;
constexpr size_t PJ_STRIDE = (size_t)NTOK * 512;
constexpr size_t WS_MRG = 320 * MiB;
constexpr size_t WS_Y = 352 * MiB;
constexpr size_t WS_H2 = 416 * MiB;
constexpr size_t WS_ACT = 448 * MiB;
constexpr size_t WS_YP = 592 * MiB;
constexpr size_t WS_LTOK = 720 * MiB, WS_LPAIR = 722 * MiB, WS_LW = 724 * MiB;
constexpr size_t WS_END = 726 * MiB;
static_assert(WS_ACT + (size_t)MAXROWS * 1024 * 2 <= WS_YP && WS_YP + (size_t)NTOK * 4 * 1024 * 2 <= WS_END, "d_ws map");
constexpr int CW_CNT = 200000;
constexpr int CW_BAR = 4096;

constexpr int LDS_BYTES = 147456;
constexpr int LDSCTL_OFF = LDS_BYTES - 512, MISC_OFF = LDSCTL_OFF + 320;
constexpr int SCRATCH_BYTES = LDSCTL_OFF;

#define GAS __attribute__((address_space(1)))
#define LAS __attribute__((address_space(3)))
typedef unsigned short bf16;
typedef unsigned v4u __attribute__((ext_vector_type(4)));
typedef unsigned v2u __attribute__((ext_vector_type(2)));
typedef float f32x4 __attribute__((ext_vector_type(4)));
typedef float f32x16 __attribute__((ext_vector_type(16)));
typedef short bf16x8 __attribute__((ext_vector_type(8)));
typedef GAS unsigned gu32;
#define RLX_AGENT __ATOMIC_RELAXED, __HIP_MEMORY_SCOPE_AGENT
#define LDS_WAIT() asm volatile("s_waitcnt lgkmcnt(0)" ::: "memory")
#define VM_WAIT() asm volatile("s_waitcnt vmcnt(0)" ::: "memory")
typedef float f32x2_cv __attribute__((ext_vector_type(2))); typedef __bf16 bf16x2_cv __attribute__((ext_vector_type(2)));
__device__ __forceinline__ unsigned pk2(float lo, float hi) { const f32x2_cv v = {lo, hi}; return __builtin_bit_cast(unsigned, __builtin_convertvector(v, bf16x2_cv)); }
__device__ __forceinline__ unsigned f2bf(float f) { return pk2(f, 0.f) & 0xffffu; }
__device__ __forceinline__ float bflo(unsigned w) { return __uint_as_float(w << 16); }
__device__ __forceinline__ float bfhi(unsigned w) { return __uint_as_float(w & 0xffff0000u); }
__device__ __forceinline__ float bf1(bf16 h) { return __uint_as_float((unsigned)h << 16); }

#define XB_TMO      128
#define XB_XCNT(j)  (256  + 64 * (j))
#define XB_XSUB(j)  (1280 + 64 * (j))
#define XB_XFLAG    3328
#define XCD_BAR_WORDS 3456
#define XB_SPIN_CAP (1u << 18)
__device__ __forceinline__ unsigned xb_ld(unsigned* p)              { return __hip_atomic_load(p, __ATOMIC_RELAXED, __HIP_MEMORY_SCOPE_AGENT); }
__device__ __forceinline__ unsigned xb_add(unsigned* p, unsigned v) { return __hip_atomic_fetch_add(p, v, __ATOMIC_RELAXED, __HIP_MEMORY_SCOPE_AGENT); }
__device__ __forceinline__ unsigned xb_xcc_id() { return (unsigned)__builtin_amdgcn_s_getreg((3 << 11) | 20) & 0xFu; }
struct XcdBarrier { unsigned* bar; unsigned x; volatile LAS unsigned* st; };
__device__ __forceinline__ XcdBarrier xcd_barrier_post(unsigned* bar, volatile LAS unsigned* st) {
    XcdBarrier b; b.bar = bar; b.x = xb_xcc_id(); b.st = st;
    if (threadIdx.x == 0) (void)xb_add(&bar[XB_XCNT(b.x)], 1u);
    return b;
}
__device__ __forceinline__ void xcd_barrier_complete(unsigned* bar, unsigned x, unsigned& nloc, unsigned& mask) {
    const unsigned G = gridDim.x * gridDim.y * gridDim.z;
    unsigned sum, msk, mine, sp = 0u;
    for (;;) {
        sum = 0u; msk = 0u; mine = 0u;
#pragma unroll
        for (unsigned j = 0; j < 16; ++j) { const unsigned c = xb_ld(&bar[XB_XCNT(j)]); sum += c; msk |= (c > 0u) ? (1u << j) : 0u; mine = (j == x) ? c : mine; }
        if (sum == G) break;
        __builtin_amdgcn_s_sleep(1);
        if ((++sp & 255u) == 0u) { if (xb_ld(&bar[XB_TMO])) break; if (sp > XB_SPIN_CAP) { atomicAdd(&bar[XB_TMO], 1u); break; } }
    }
    nloc = mine > 0u ? mine : 1u; mask = msk | (1u << x);
}
__device__ __forceinline__ void xcd_barrier(const XcdBarrier& b) {
    asm volatile("s_waitcnt vmcnt(0)" ::: "memory");
    __syncthreads();
    if (threadIdx.x < 64) {
        unsigned* bar = b.bar;
        const unsigned lane = threadIdx.x;
        unsigned want = 0u, mask = 0u;
        if (lane == 0) {
            __builtin_amdgcn_s_waitcnt(0);
            unsigned nloc = b.st[0], m = b.st[1];
            if (nloc == 0u) { xcd_barrier_complete(bar, b.x, nloc, m); b.st[0] = nloc; b.st[1] = m; }
            const unsigned old = xb_add(&bar[XB_XSUB(b.x)], 1u);
            const unsigned gen = old / nloc;
            if (old + 1u == (gen + 1u) * nloc) {
                __builtin_amdgcn_fence(__ATOMIC_RELEASE, "agent");
                asm volatile("s_waitcnt vmcnt(0)" ::: "memory");
                __hip_atomic_store(&bar[XB_XFLAG + b.x], gen + 1u, __ATOMIC_RELAXED, __HIP_MEMORY_SCOPE_AGENT);
            }
            want = gen + 1u; mask = m;
        }
        want = (unsigned)__builtin_amdgcn_readfirstlane((int)want); mask = (unsigned)__builtin_amdgcn_readfirstlane((int)mask);
        const bool mine = lane < 16u && ((mask >> (lane & 15u)) & 1u) != 0u;
        unsigned sp = 0u;
        for (;;) {
            unsigned v = want; if (mine) v = xb_ld(&bar[XB_XFLAG + lane]);
            if (__builtin_amdgcn_ballot_w64((int)(v - want) < 0) == 0ull) break;
            __builtin_amdgcn_s_sleep(1);
            if ((++sp & 255u) == 0u) { if (xb_ld(&bar[XB_TMO])) break; if (sp > XB_SPIN_CAP) { if (lane == 0) atomicAdd(&bar[XB_TMO], 1u); break; } }
        }
        __builtin_amdgcn_fence(__ATOMIC_ACQUIRE, "agent");
        asm volatile("s_waitcnt vmcnt(0)" ::: "memory");
    }
    __syncthreads();
}

struct Args { const float* in[26]; float* out; unsigned char* ws; int ph_lo, ph_hi, li, pad; };
struct Frame {
    LAS unsigned char* lds;
    int tid, lane, wave, vcu, G;
    float* out; unsigned char* ws;
    __device__ __forceinline__ const float* in(int k) const { const LAS unsigned* t = (const LAS unsigned*)(lds + LDSCTL_OFF) + 2 * k;
        const unsigned lo = (unsigned)__builtin_amdgcn_readfirstlane((int)t[0]), hi = (unsigned)__builtin_amdgcn_readfirstlane((int)t[1]);
        return (const float*)(const GAS float*)(((unsigned long long)hi << 32) | lo); }
};
template <int CTRL> __device__ __forceinline__ float dpp_mov(float x) { return __builtin_bit_cast(float, __builtin_amdgcn_update_dpp(0, __builtin_bit_cast(int, x), CTRL, 0xF, 0xF, false)); }
__device__ __forceinline__ float lane_xor1(float x) { return dpp_mov<0xB1>(x); }
__device__ __forceinline__ float lane_xor2(float x) { return dpp_mov<0x4E>(x); }
__device__ __forceinline__ float lane_xor4(float x) { return dpp_mov<0x1B>(dpp_mov<0x141>(x)); }
__device__ __forceinline__ float lane_xor8(float x) { return dpp_mov<0x128>(x); }
__device__ __forceinline__ void swap_rows16(float& a, float& b) { asm volatile("s_nop 1\n\tv_permlane16_swap_b32 %0, %1" : "+v"(a), "+v"(b)); }
__device__ __forceinline__ void swap_half32(float& a, float& b) { asm volatile("s_nop 1\n\tv_permlane32_swap_b32 %0, %1" : "+v"(a), "+v"(b)); }
__device__ __forceinline__ float wave_sum(float v) {
    v += lane_xor1(v); v += lane_xor2(v); v += lane_xor4(v); v += lane_xor8(v);
    { float a = v, b = v; swap_rows16(a, b); v = a + b; }
    { float a = v, b = v; swap_half32(a, b); v = a + b; }
    return v;
}
__device__ __forceinline__ float wave_max(float v) {
    v = fmaxf(v, lane_xor1(v)); v = fmaxf(v, lane_xor2(v)); v = fmaxf(v, lane_xor4(v)); v = fmaxf(v, lane_xor8(v));
    { float a = v, b = v; swap_rows16(a, b); v = fmaxf(a, b); }
    { float a = v, b = v; swap_half32(a, b); v = fmaxf(a, b); }
    return v;
}
__device__ __forceinline__ float sigmoid_f(float x) { return __builtin_amdgcn_rcpf(1.0f + __builtin_amdgcn_exp2f(-1.4426950408889634f * x)); }
__device__ __forceinline__ float gelu_tanh_f(float x) { const float u = 0.7978845608028654f * (x + 0.044715f * x * x * x); const float e = __builtin_amdgcn_exp2f(2.8853900817779268f * u); return x * (1.0f - __builtin_amdgcn_rcpf(e + 1.0f)); }
__device__ __forceinline__ float log_sigmoid_f(float z) { return z >= 0.f ? -log1pf(expf(-z)) : z - log1pf(expf(z)); }
__device__ __forceinline__ float softplus_f(float z) { return z > 0.f ? z + log1pf(expf(-z)) : log1pf(expf(z)); }

__device__ __forceinline__ void p0_transpose_item(const float* W, int ldw, bf16* WT, int k0, int n0, int kdst0, const float* gain, LAS float* scr, int lane) {
#pragma unroll 8
    for (int i = 0; i < 32; ++i) { const int kk = 2 * i + (lane >> 5); float v = W[(size_t)(k0 + kk) * ldw + n0 + (lane & 31)]; if (gain) v *= gain[k0 + kk]; scr[kk * 33 + (lane & 31)] = v; }
    LDS_WAIT(); asm volatile("" ::: "memory");
    const int c = lane & 7;
#pragma unroll
    for (int j = 0; j < 4; ++j) { const int n = (lane >> 3) + 8 * j; const LAS float* s = scr + (8 * c) * 33 + n;
        v4u o; o.x = pk2(s[0 * 33], s[1 * 33]); o.y = pk2(s[2 * 33], s[3 * 33]); o.z = pk2(s[4 * 33], s[5 * 33]); o.w = pk2(s[6 * 33], s[7 * 33]);
        *(GAS v4u*)(WT + (size_t)(n0 + n) * 1024 + kdst0 + 8 * c) = o; }
    LDS_WAIT(); asm volatile("" ::: "memory");
}
constexpr int CV_UP_ITEMS = NE * 16 * 32, CV_DN_ITEMS = NE * 16 * 16;
constexpr int CV_UP_TAIL = 8192, CV_DN_TAIL = 4096;
__device__ __forceinline__ void cvt_block_f8(const float* W, int ldw, unsigned char* WT, LAS unsigned char* scr, int lane) {
    float v[64];
#pragma unroll
    for (int i = 0; i < 64; ++i) v[i] = W[(size_t)i * ldw + lane];
#pragma unroll
    for (int q = 0; q < 4; ++q) { int w[4];
#pragma unroll
        for (int j = 0; j < 4; ++j) { int t = 0; t = __builtin_amdgcn_cvt_pk_fp8_f32(v[16 * q + 4 * j] * 64.0f, v[16 * q + 4 * j + 1] * 64.0f, t, false); t = __builtin_amdgcn_cvt_pk_fp8_f32(v[16 * q + 4 * j + 2] * 64.0f, v[16 * q + 4 * j + 3] * 64.0f, t, true); w[j] = t; }
        *(LAS v4u*)(scr + lane * 80 + 16 * q) = (v4u){(unsigned)w[0], (unsigned)w[1], (unsigned)w[2], (unsigned)w[3]}; }
    LDS_WAIT(); asm volatile("" ::: "memory");
#pragma unroll
    for (int j = 0; j < 4; ++j) { const int row = 16 * j + (lane >> 2), c = lane & 3;
        *(GAS v4u*)(WT + (size_t)row * 1024 + 16 * c) = *(const LAS v4u*)(scr + row * 80 + 16 * c); }
    LDS_WAIT(); asm volatile("" ::: "memory");
}
__device__ __forceinline__ void cvt_up_item(Frame& F, int u) { const int e = u >> 9, q = u & 511, kb = q >> 5, nb = q & 31;
    cvt_block_f8(F.in(22) + (size_t)e * DM * 2 * DEXP + (size_t)(64 * kb) * (2 * DEXP) + 64 * nb, 2 * DEXP, (unsigned char*)(F.ws + WS_WUP) + ((size_t)e * 2 * DEXP + 64 * nb) * 1024 + 64 * kb, F.lds + F.wave * 16384, F.lane); }
__device__ __forceinline__ void cvt_dn_item(Frame& F, int d) { const int e = d >> 8, q = d & 255, kb = q >> 4, nb = q & 15;
    cvt_block_f8(F.in(24) + (size_t)e * DEXP * DM + (size_t)(64 * kb) * DM + 64 * nb, DM, (unsigned char*)(F.ws + WS_WDN) + ((size_t)e * DM + 64 * nb) * 1024 + 64 * kb, F.lds + F.wave * 16384, F.lane); }
template <bool UP> __device__ __forceinline__ void cvt_range(Frame& F, int lo, int hi, int wr_, int nw) {
    for (int it = lo + wr_; it < hi; it += nw) { if (UP) cvt_up_item(F, it); else cvt_dn_item(F, it); }
}
__device__ __forceinline__ void p0_transpose_item_f8(const float* W, int ldw, unsigned char* WT, int k0, int n0, float scale, LAS float* scr, int lane) {
#pragma unroll 8
    for (int i = 0; i < 32; ++i) { const int kk = 2 * i + (lane >> 5); scr[kk * 33 + (lane & 31)] = W[(size_t)(k0 + kk) * ldw + n0 + (lane & 31)] * scale; }
    LDS_WAIT(); asm volatile("" ::: "memory");
    const int c = lane & 7;
#pragma unroll
    for (int j = 0; j < 4; ++j) { const int n = (lane >> 3) + 8 * j; const LAS float* s = scr + (8 * c) * 33 + n;
        int w0 = 0, w1 = 0; w0 = __builtin_amdgcn_cvt_pk_fp8_f32(s[0 * 33], s[1 * 33], w0, false); w0 = __builtin_amdgcn_cvt_pk_fp8_f32(s[2 * 33], s[3 * 33], w0, true);
        w1 = __builtin_amdgcn_cvt_pk_fp8_f32(s[4 * 33], s[5 * 33], w1, false); w1 = __builtin_amdgcn_cvt_pk_fp8_f32(s[6 * 33], s[7 * 33], w1, true);
        typedef int i32x2_ __attribute__((ext_vector_type(2))); *(GAS i32x2_*)(WT + (size_t)(n0 + n) * 1024 + k0 + 8 * c) = (i32x2_){w0, w1}; }
    LDS_WAIT(); asm volatile("" ::: "memory");
}
template <int PARTS = 7> __device__ __forceinline__ void p0_phase(Frame& F) {
    const float* c_in = F.in(1); const float* w_ada = F.in(2); const float* b_ada = F.in(3);
    float* MOD = (float*)(F.ws + WS_MOD);
    if ((PARTS & 1) && F.vcu < 192) {
        LAS float* sc = (LAS float*)F.lds;
        LAS float* red = (LAS float*)(F.lds + 32768);
        for (int i = F.tid; i < BATCH * DM; i += NWAVES * 64) { const int b = i >> 10, k = i & 1023; const float v = c_in[i]; sc[k * 8 + b] = v * sigmoid_f(v); }
        __syncthreads();
        for (int ci = F.vcu; ci < 192; ci += F.G) {
            const int col = F.lane & 31, ks = F.lane >> 5;
            float acc[8];
#pragma unroll
            for (int b = 0; b < 8; ++b) acc[b] = 0.f;
            const float* wp = w_ada + (size_t)(128 * F.wave + ks) * (NMOD * DM) + ci * 32 + col;
#pragma unroll 1
            for (int i0 = 0; i0 < 64; i0 += 32) {
                float wv[32];
#pragma unroll
                for (int i = 0; i < 32; ++i) wv[i] = wp[(size_t)(2 * (i0 + i)) * (NMOD * DM)];
#pragma unroll
                for (int i = 0; i < 32; ++i) { const LAS f32x4* sp = (const LAS f32x4*)(sc + (128 * F.wave + 2 * (i0 + i) + ks) * 8); const f32x4 s0 = sp[0], s1 = sp[1];
                    acc[0] += s0[0] * wv[i]; acc[1] += s0[1] * wv[i]; acc[2] += s0[2] * wv[i]; acc[3] += s0[3] * wv[i]; acc[4] += s1[0] * wv[i]; acc[5] += s1[1] * wv[i]; acc[6] += s1[2] * wv[i]; acc[7] += s1[3] * wv[i]; }
            }
#pragma unroll
            for (int b = 0; b < 8; ++b) { acc[b] += __shfl_xor(acc[b], 32); if (ks == 0) red[(F.wave * 8 + b) * 32 + col] = acc[b]; }
            __syncthreads();
            if (F.tid < 256) { const int b = F.tid >> 5, cl = F.tid & 31; float s = 0.f;
#pragma unroll
              for (int w = 0; w < 8; ++w) s += red[(w * 8 + b) * 32 + cl];
              MOD[b * NMOD * DM + ci * 32 + cl] = s + b_ada[ci * 32 + cl]; }
            __syncthreads();
        }
    }
    __syncthreads();
    const float* w_in = F.in(6); const float* w_out = F.in(17); const float* gn_attn = F.in(16);
    bf16* WIN = (bf16*)(F.ws + WS_WIN); bf16* WOUT = (bf16*)(F.ws + WS_WOUT);
    LAS float* scr = (LAS float*)(F.lds + F.wave * 16384);
    const int gw = F.vcu * NWAVES + F.wave, NGW = F.G * NWAVES;
    constexpr int I_IN = 16 * (NPJ / 32), I_OUT = 16 * (DM / 32);
    constexpr int NITEMS = I_IN + I_OUT;
    if (PARTS & 2) for (int it = gw; it < NITEMS; it += NGW) {
        int r = it;
        if (r < I_IN) { const int kb = r / (NPJ / 32), nb = r % (NPJ / 32); p0_transpose_item(w_in, NPROJ, WIN, 64 * kb, 32 * nb, 64 * kb, nullptr, scr, F.lane); continue; } r -= I_IN;
        { const int kb = r / (DM / 32), nb = r % (DM / 32); const int k0 = 64 * kb;
            p0_transpose_item(w_out, DM, WOUT, k0, 32 * nb, (k0 + 512) & 1023, k0 >= 512 ? gn_attn - 512 : nullptr, scr, F.lane); }
    }
    if (PARTS & 4) {
        if (F.G == 256) {
            constexpr int NU = CV_UP_ITEMS - CV_UP_TAIL, NV = NU + (CV_DN_ITEMS - CV_DN_TAIL);
            auto run = [&](int v) { if (v < NU) cvt_up_item(F, CV_UP_TAIL + v); else cvt_dn_item(F, CV_DN_TAIL + (v - NU)); };
            constexpr int A_END = 2048 * 5;
            for (int v = gw; v < A_END && v < NV; v += NGW) run(v);
            if (F.vcu >= 192) { const int r = (F.vcu - 192) * NWAVES + F.wave; for (int v = A_END + r; v < A_END + 1536 && v < NV; v += 512) run(v); }
            else { const int r = F.vcu * NWAVES + F.wave; if (r < 512) { const int v = A_END + 1536 + r; if (v < NV) run(v); } }
            static_assert(A_END + 1536 + 512 >= NV, "phase-0 conversion shares cover the list");
        } else { cvt_range<true>(F, 0, CV_UP_ITEMS, gw, NGW); cvt_range<false>(F, 0, CV_DN_ITEMS, gw, NGW); }
    }
    if (PARTS & 2) { const float* w_in2 = F.in(6); float* WFT = (float*)(F.ws + WS_WFT);
      for (int idx = F.vcu * (NWAVES * 64) + F.tid; idx < 8 * DM; idx += F.G * NWAVES * 64) { const int h = idx >> 10, k = idx & 1023; WFT[idx] = w_in2[(size_t)k * NPROJ + NPJ + h]; } }
    { const float* w_router = F.in(20); float* WRT = (float*)(F.ws + WS_WRT);
      for (int idx = F.vcu * (NWAVES * 64) + F.tid; idx < NE * DM; idx += F.G * NWAVES * 64) { const int e = idx >> 10, k = idx & 1023; WRT[idx] = w_router[k * NE + e]; } }
    { const float* wa = F.in(9); const float* wx = F.in(11); bf16* LWT = (bf16*)(F.ws + WS_LWT);
      for (int idx = F.vcu * (NWAVES * 64) + F.tid; idx < 2 * 8 * 64 * 64; idx += F.G * NWAVES * 64) { const int gate = idx >> 15, g = (idx >> 12) & 7, j = (idx >> 6) & 63, i = idx & 63;
          LWT[idx] = (bf16)f2bf((gate ? wx : wa)[(g * 64 + i) * 64 + j]); } }
}

__device__ __forceinline__ void p1_phase(Frame& F) {
    const float* x = F.in(0); const float* gpre = F.in(4); const float* fb = F.in(14);
    const float* MOD = (const float*)(F.ws + WS_MOD); bf16* H1 = (bf16*)(F.ws + WS_H1); float* LOGF2 = (float*)(F.ws + WS_LOGF2);
    LAS float* wf = (LAS float*)F.lds;
    { const float* WFT = (const float*)(F.ws + WS_WFT);
#pragma unroll
      for (int i = F.tid; i < 8 * DM / 4; i += NWAVES * 64) *(LAS f32x4*)(wf + 4 * i) = *(const f32x4*)(WFT + 4 * i); }
    __syncthreads();
    const int gw = F.vcu * NWAVES + F.wave;
    if (F.G * NWAVES * 8 != NTOK) return;
    const int row0 = gw * 8, b = row0 / SEQ;
    f32x4 gm[4], sh[4];
#pragma unroll
    for (int j = 0; j < 4; ++j) { const int k = 4 * F.lane + 256 * j; const f32x4 g = *(const f32x4*)(gpre + k), s = *(const f32x4*)(MOD + b * NMOD * DM + DM + k); gm[j] = g * (s + 1.0f); sh[j] = *(const f32x4*)(MOD + b * NMOD * DM + k); }
    f32x4 nx[4];
#pragma unroll
    for (int j = 0; j < 4; ++j) nx[j] = *(const f32x4*)(x + (size_t)row0 * DM + 4 * F.lane + 256 * j);
    for (int r = 0; r < 8; ++r) { const int row = row0 + r;
        f32x4 v[4]; float ss = 0.f;
#pragma unroll
        for (int j = 0; j < 4; ++j) { v[j] = nx[j]; ss += (v[j][0] * v[j][0] + v[j][1] * v[j][1]) + (v[j][2] * v[j][2] + v[j][3] * v[j][3]); }
        if (r < 7) {
#pragma unroll
            for (int j = 0; j < 4; ++j) nx[j] = *(const f32x4*)(x + (size_t)(row + 1) * DM + 4 * F.lane + 256 * j); }
        const float rinv = 1.0f / sqrtf(wave_sum(ss) * (1.0f / DM) + RMS_EPS);
        float fl[8];
#pragma unroll
        for (int h = 0; h < 8; ++h) fl[h] = 0.f;
#pragma unroll
        for (int j = 0; j < 4; ++j) { const f32x4 hv = v[j] * rinv * gm[j] + sh[j];
            v2u o; o.x = pk2(hv[0], hv[1]); o.y = pk2(hv[2], hv[3]); *(GAS v2u*)(H1 + (size_t)row * DM + 4 * F.lane + 256 * j) = o;
#pragma unroll
            for (int h = 0; h < 8; ++h) { const f32x4 w = *(const LAS f32x4*)(wf + h * DM + 4 * F.lane + 256 * j); fl[h] += (hv[0] * w[0] + hv[1] * w[1]) + (hv[2] * w[2] + hv[3] * w[3]); } }
#pragma unroll
        for (int h = 0; h < 8; ++h) fl[h] = wave_sum(fl[h]);
        if (F.lane < 8) { float f = fl[0];
#pragma unroll
            for (int h = 1; h < 8; ++h) f = (F.lane == h) ? fl[h] : f;
            LOGF2[(size_t)row * 8 + F.lane] = log_sigmoid_f(f + fb[F.lane]) * 1.4426950408889634f; }
    }
}

constexpr int LRU_XP = 1040;
constexpr int LRU_XT = 0, LRU_XC = 69696, LRU_CAR = 136256;
constexpr int CW_LRU = 131072;
static_assert(LRU_CAR + 2048 <= SCRATCH_BYTES && 67 * LRU_XP <= LRU_XC && LRU_XC + 64 * LRU_XP <= LRU_CAR, "LRU LDS map");
__device__ __forceinline__ float one_minus_exp(float x) {
    float p = -x * (1.0f + x * (0.5f + x * (0.16666667f + x * (0.041666668f + x * (0.0083333338f + x * 0.0013888889f)))));
    if (__builtin_expect(__any(x <= -0.25f), 0)) { const float d = 1.0f - __builtin_amdgcn_exp2f(1.4426950408889634f * x); p = x > -0.25f ? p : d; }
    return p;
}
__device__ __forceinline__ void lru_item(Frame& F, int b, int c) {
    LAS unsigned char* XT = F.lds + LRU_XT; LAS unsigned char* XC = F.lds + LRU_XC; LAS float* CAR = (LAS float*)(F.lds + LRU_CAR);
    const bf16* XL = (const bf16*)(F.ws + WS_PJ); const bf16* YL = XL + PJ_STRIDE; const bf16* LWT = (const bf16*)(F.ws + WS_LWT);
    float* LSUM = (float*)(F.ws + WS_LSUM); bf16* MRG = (bf16*)(F.ws + WS_MRG); unsigned* flags = (unsigned*)(F.ws + WS_CTL) + CW_LRU;
    const float* conv_w = F.in(7); const float* conv_b = F.in(8); const float* ba = F.in(10); const float* bx = F.in(12); const float* lam = F.in(13); const float* gn_lru = F.in(15);
    const int t0 = c * 64; const size_t rowb = (size_t)b * SEQ;
    { v4u xv[9];
#pragma unroll
      for (int q = 0; q < 9; ++q) { const int p = F.tid + q * (NWAVES * 64), i = p >> 6, c8 = p & 63, t = t0 - 3 + i; xv[q] = (v4u){0u, 0u, 0u, 0u};
          if (p < 67 * 64 && t >= 0) xv[q] = *(const GAS v4u*)(XL + (rowb + t) * 512 + c8 * 8); }
#pragma unroll
      for (int q = 0; q < 9; ++q) { const int p = F.tid + q * (NWAVES * 64), i = p >> 6, c8 = p & 63; if (p < 67 * 64) *(LAS v4u*)(XT + i * LRU_XP + c8 * 16) = xv[q]; } }
    v4u yv8[8];
#pragma unroll
    for (int q = 0; q < 8; ++q) { const int p = F.tid + q * (NWAVES * 64), i = p >> 6, c8 = p & 63; yv8[q] = *(const GAS v4u*)(YL + (rowb + t0 + i) * 512 + c8 * 8); }
    __syncthreads();
    { const int ch = F.tid; const float w0 = conv_w[ch], w1 = conv_w[512 + ch], w2 = conv_w[1024 + ch], w3 = conv_w[1536 + ch], cb = conv_b[ch];
      float xa = bf1(*(const LAS bf16*)(XT + 0 * LRU_XP + ch * 2)), xb = bf1(*(const LAS bf16*)(XT + 1 * LRU_XP + ch * 2)), xc = bf1(*(const LAS bf16*)(XT + 2 * LRU_XP + ch * 2));
#pragma unroll 8
      for (int t = 0; t < 64; ++t) { const float xd = bf1(*(const LAS bf16*)(XT + (t + 3) * LRU_XP + ch * 2)); const float v = ((w0 * xa + w1 * xb) + (w2 * xc + w3 * xd)) + cb;
          *(LAS bf16*)(XC + t * LRU_XP + ch * 2) = (bf16)f2bf(v); xa = xb; xb = xc; xc = xd; } }
    __syncthreads();
#pragma unroll
    for (int q = 0; q < 8; ++q) { const int p = F.tid + q * (NWAVES * 64), i = p >> 6, c8 = p & 63; *(LAS v4u*)(XT + i * LRU_XP + c8 * 16) = yv8[q]; }
    const int g = F.wave, l31 = F.lane & 31, hi = F.lane >> 5;
    __syncthreads();
#pragma unroll 1
    for (int hp = 0; hp < 2; ++hp) {
        const int chl = g * 64 + 32 * hp + l31;
        f32x16 cumA[2], hloc[2];
#pragma unroll
        for (int tg = 0; tg < 2; ++tg) { cumA[tg] = f32x16{}; hloc[tg] = f32x16{}; }
#pragma unroll
        for (int s = 0; s < 4; ++s) {
            const bf16x8 wa = *(const GAS bf16x8*)(LWT + ((size_t)((0 * 8 + g) * 64 + 32 * hp + l31)) * 64 + 16 * s + 8 * hi);
            const bf16x8 wx = *(const GAS bf16x8*)(LWT + ((size_t)((1 * 8 + g) * 64 + 32 * hp + l31)) * 64 + 16 * s + 8 * hi);
#pragma unroll
            for (int tg = 0; tg < 2; ++tg) { const bf16x8 bfr = *(const LAS bf16x8*)(XC + (32 * tg + l31) * LRU_XP + (g * 64 + 16 * s + 8 * hi) * 2);
                cumA[tg] = __builtin_amdgcn_mfma_f32_32x32x16_bf16(bfr, wa, cumA[tg], 0, 0, 0); hloc[tg] = __builtin_amdgcn_mfma_f32_32x32x16_bf16(bfr, wx, hloc[tg], 0, 0, 0); }
        }
        const float pba = ba[chl], pbx = bx[chl], psp = 8.0f * softplus_f(-lam[chl]);
        float cA = 1.0f, cB = 0.0f;
#pragma unroll
        for (int tg = 0; tg < 2; ++tg) {
            f32x16& A = cumA[tg]; f32x16& X = hloc[tg];
#pragma unroll
            for (int r = 0; r < 16; ++r) { const int tok = 32 * tg + (r & 3) + 8 * (r >> 2) + 4 * hi; const float xv = bf1(*(const LAS bf16*)(XC + tok * LRU_XP + chl * 2));
                const float rg = sigmoid_f(A[r] + pba), ig = sigmoid_f(X[r] + pbx); const float la = -rg * psp;
                A[r] = __builtin_amdgcn_exp2f(1.4426950408889634f * la); X[r] = __builtin_amdgcn_sqrtf(one_minus_exp(2.0f * la)) * (ig * xv); }
#pragma unroll
            for (int q = 0; q < 4; ++q)
#pragma unroll
                for (int i = 1; i < 4; ++i) { X[4 * q + i] = A[4 * q + i] * X[4 * q + i - 1] + X[4 * q + i]; A[4 * q + i] = A[4 * q + i] * A[4 * q + i - 1]; }
#pragma unroll
            for (int q2 = 0; q2 < 8; ++q2) { const int q = q2 >> 1; const bool own = (hi == (q2 & 1));
#pragma unroll
                for (int i = 0; i < 4; ++i) { const float nb = A[4 * q + i] * cB + X[4 * q + i], na = A[4 * q + i] * cA; X[4 * q + i] = own ? nb : X[4 * q + i]; A[4 * q + i] = own ? na : A[4 * q + i]; }
                float ra, rb; { float a0 = A[4 * q + 3], a1 = a0; swap_half32(a0, a1); ra = hi ? a0 : a1; float b0 = X[4 * q + 3], b1 = b0; swap_half32(b0, b1); rb = hi ? b0 : b1; }
                cA = own ? A[4 * q + 3] : ra; cB = own ? X[4 * q + 3] : rb; }
        }
        if (hi == 0) { float* d0 = LSUM + (((size_t)b * 32 + c) * 2 + 0) * 512 + chl; __hip_atomic_store(d0, cA, __ATOMIC_RELAXED, __HIP_MEMORY_SCOPE_AGENT); __hip_atomic_store(d0 + 512, cB, __ATOMIC_RELAXED, __HIP_MEMORY_SCOPE_AGENT); }
        asm volatile("s_waitcnt vmcnt(0)" ::: "memory");
        __syncthreads();
        if (F.wave == 0) {
            if (F.lane == 0) __hip_atomic_store(flags + 64 * ((32 * b + c) * 2 + hp), 1u, __ATOMIC_RELAXED, __HIP_MEMORY_SCOPE_AGENT);
            unsigned sp = 0;
            for (;;) { const unsigned v = (F.lane < c) ? __hip_atomic_load(flags + 64 * ((32 * b + F.lane) * 2 + hp), __ATOMIC_RELAXED, __HIP_MEMORY_SCOPE_AGENT) : 1u;
                if (__all(v != 0u)) break; __builtin_amdgcn_s_sleep(1); if (++sp > (1u << 20)) break; }
        }
        __syncthreads();
        if (F.tid < 256) { const int ch = (F.tid >> 5) * 64 + 32 * hp + (F.tid & 31); float cr = 0.f; float* LS = LSUM + (size_t)b * 32 * 2 * 512 + ch;
          for (int c0 = 0; c0 < c; c0 += 32) { float A8[32], B8[32];
#pragma unroll
              for (int u = 0; u < 32; ++u) { const bool ok = (c0 + u) < c; A8[u] = 1.0f; B8[u] = 0.0f; if (ok) { A8[u] = __hip_atomic_load(LS + (size_t)(c0 + u) * 1024, __ATOMIC_RELAXED, __HIP_MEMORY_SCOPE_AGENT); B8[u] = __hip_atomic_load(LS + (size_t)(c0 + u) * 1024 + 512, __ATOMIC_RELAXED, __HIP_MEMORY_SCOPE_AGENT); } }
#pragma unroll
              for (int u = 0; u < 32; ++u) cr = A8[u] * cr + B8[u]; }
          CAR[ch] = cr; }
        __syncthreads();
        { const float cin = CAR[chl];
#pragma unroll
          for (int tg = 0; tg < 2; ++tg)
#pragma unroll
              for (int r = 0; r < 16; ++r) { const int tok = 32 * tg + (r & 3) + 8 * (r >> 2) + 4 * hi; LAS bf16* yp = (LAS bf16*)(XT + tok * LRU_XP + chl * 2);
                  const float h = hloc[tg][r] + cumA[tg][r] * cin; *yp = (bf16)f2bf(h * gelu_tanh_f(bf1(*yp))); } }
    }
    __syncthreads();
#pragma unroll 2
    for (int q = 0; q < 8; ++q) { const int i = F.wave + 8 * q, c8 = F.lane;
        const v4u w = *(const LAS v4u*)(XT + i * LRU_XP + c8 * 16);
        const float v0 = bflo(w.x), v1 = bfhi(w.x), v2 = bflo(w.y), v3 = bfhi(w.y), v4 = bflo(w.z), v5 = bfhi(w.z), v6 = bflo(w.w), v7 = bfhi(w.w);
        const float ss = wave_sum(((v0 * v0 + v1 * v1) + (v2 * v2 + v3 * v3)) + ((v4 * v4 + v5 * v5) + (v6 * v6 + v7 * v7)));
        const float rinv = 1.0f / sqrtf(ss * (1.0f / DLRU) + RMS_EPS);
        const f32x4 g0 = *(const f32x4*)(gn_lru + c8 * 8), g1 = *(const f32x4*)(gn_lru + c8 * 8 + 4);
        v4u o; o.x = pk2(v0 * rinv * g0[0], v1 * rinv * g0[1]); o.y = pk2(v2 * rinv * g0[2], v3 * rinv * g0[3]); o.z = pk2(v4 * rinv * g1[0], v5 * rinv * g1[1]); o.w = pk2(v6 * rinv * g1[2], v7 * rinv * g1[3]);
        *(GAS v4u*)(MRG + (rowb + t0 + i) * 1024 + 512 + c8 * 8) = o; }
    __syncthreads();
}
__device__ __forceinline__ void lru_phase(Frame& F) { for (int it = F.vcu; it < BATCH * 32; it += F.G) lru_item(F, it >> 5, it & 31); }

template <int VAR = 0> __device__ __forceinline__ void p6_phase(Frame& F) {
    const float* x = F.in(0); const float* gpost = F.in(5); const float* gffn = F.in(18); const float* b_router = F.in(21);
    const float* MOD = (const float*)(F.ws + WS_MOD); const bf16* Y = (const bf16*)(F.ws + WS_Y); unsigned char* H2 = (unsigned char*)(F.ws + WS_H2);
    int* TOPI = (int*)(F.ws + WS_TOPI); float* TOPW = (float*)(F.ws + WS_TOPW); int* WGCNT = (int*)(F.ws + WS_WGCNT);
    LAS float* wrl = (LAS float*)F.lds;
    LAS int* hist = (LAS int*)(F.lds + 131072);
    { const float* WRT = (const float*)(F.ws + WS_WRT);
#pragma unroll 4
      for (int i = F.tid; i < NE * DM / 4; i += NWAVES * 64) *(LAS f32x4*)(wrl + 4 * i) = *(const f32x4*)(WRT + 4 * i); }
    if (F.tid < NE) hist[F.tid] = 0;
    __syncthreads();
    if (F.G * 64 == NTOK) {
    const int bx = blockIdx.x, row0 = bx * 64 + F.wave * 8, b = row0 / SEQ;
    f32x4 gpm[4], gf[4], shf[4];
#pragma unroll
    for (int j = 0; j < 4; ++j) { const int k = 4 * F.lane + 256 * j; const float* mb = MOD + b * NMOD * DM + k;
        gpm[j] = *(const f32x4*)(mb + 2 * DM) * *(const f32x4*)(gpost + k); gf[j] = *(const f32x4*)(gffn + k) * (*(const f32x4*)(mb + 4 * DM) + 1.0f); shf[j] = *(const f32x4*)(mb + 3 * DM); }
    v2u ywn[2][4]; f32x4 xn[2][4];
#pragma unroll
    for (int u = 0; u < 2; ++u)
#pragma unroll
        for (int j = 0; j < 4; ++j) { ywn[u][j] = *(const GAS v2u*)(Y + (size_t)(row0 + u) * DM + 4 * F.lane + 256 * j); xn[u][j] = *(const f32x4*)(x + (size_t)(row0 + u) * DM + 4 * F.lane + 256 * j); }
    for (int rp = 0; rp < 4; ++rp) {
        f32x4 hv[2][4];
        v2u ywc[2][4]; f32x4 xc[2][4];
#pragma unroll
        for (int u = 0; u < 2; ++u)
#pragma unroll
            for (int j = 0; j < 4; ++j) { ywc[u][j] = ywn[u][j]; xc[u][j] = xn[u][j]; }
        if (rp < 3) {
#pragma unroll
            for (int u = 0; u < 2; ++u)
#pragma unroll
                for (int j = 0; j < 4; ++j) { ywn[u][j] = *(const GAS v2u*)(Y + (size_t)(row0 + 2 * rp + 2 + u) * DM + 4 * F.lane + 256 * j); xn[u][j] = *(const f32x4*)(x + (size_t)(row0 + 2 * rp + 2 + u) * DM + 4 * F.lane + 256 * j); } }
#pragma unroll
        for (int u = 0; u < 2; ++u) { const int row = row0 + 2 * rp + u;
            f32x4 yv[4]; float ss = 0.f;
#pragma unroll
            for (int j = 0; j < 4; ++j) { const v2u yw = ywc[u][j]; yv[j] = (f32x4){bflo(yw.x), bfhi(yw.x), bflo(yw.y), bfhi(yw.y)}; ss += (yv[j][0] * yv[j][0] + yv[j][1] * yv[j][1]) + (yv[j][2] * yv[j][2] + yv[j][3] * yv[j][3]); }
            const float rinv = 1.0f / sqrtf(wave_sum(ss) * (1.0f / DM) + RMS_EPS);
            float s2 = 0.f;
#pragma unroll
            for (int j = 0; j < 4; ++j) { const f32x4 xm = xc[u][j] + gpm[j] * (yv[j] * rinv);
                yv[j] = xm; s2 += (xm[0] * xm[0] + xm[1] * xm[1]) + (xm[2] * xm[2] + xm[3] * xm[3]); }
            const float rinv2 = 1.0f / sqrtf(wave_sum(s2) * (1.0f / DM) + RMS_EPS);
#pragma unroll
            for (int j = 0; j < 4; ++j) { const f32x4 h = yv[j] * rinv2 * gf[j] + shf[j]; hv[u][j] = h;
                int w8 = 0; w8 = __builtin_amdgcn_cvt_pk_fp8_f32(h[0], h[1], w8, false); w8 = __builtin_amdgcn_cvt_pk_fp8_f32(h[2], h[3], w8, true); *(GAS int*)(H2 + (size_t)row * DM + 4 * F.lane + 256 * j) = w8; }
        }
        typedef float f32x2 __attribute__((ext_vector_type(2)));
        f32x2 hp[4][4];
#pragma unroll
        for (int j = 0; j < 4; ++j)
#pragma unroll
            for (int i = 0; i < 4; ++i) hp[j][i] = (f32x2){hv[0][j][i], hv[1][j][i]};
        float pa[32], pb[32];
#pragma unroll
        for (int e = 0; e < 32; ++e) { f32x2 s2 = (f32x2){0.f, 0.f};
#pragma unroll
            for (int j = 0; j < (VAR == 1 ? 0 : 4); ++j) { const f32x4 w = *(const LAS f32x4*)(wrl + e * DM + 4 * F.lane + 256 * j);
#pragma unroll
                for (int i = 0; i < 4; ++i) s2 = __builtin_elementwise_fma(hp[j][i], (f32x2){w[i], w[i]}, s2); }
            pa[e] = s2[0]; pb[e] = s2[1]; }
#pragma unroll
        for (int i = 0; i < 16; ++i) { float a = pa[i], b = pa[16 + i]; swap_half32(a, b); pa[i] = a + b; float c2 = pb[i], d2 = pb[16 + i]; swap_half32(c2, d2); pb[i] = c2 + d2; }
#pragma unroll
        for (int i = 0; i < 8; ++i) { float a = pa[i], b = pa[8 + i]; swap_rows16(a, b); pa[i] = a + b; float c2 = pb[i], d2 = pb[8 + i]; swap_rows16(c2, d2); pb[i] = c2 + d2; }
#define TR_STEP(N, XOR, BIT) _Pragma("unroll") for (int i = 0; i < N; ++i) { const bool up = (F.lane & BIT) != 0; \
            const float ka = up ? pa[N + i] : pa[i], sa_ = up ? pa[i] : pa[N + i], kb = up ? pb[N + i] : pb[i], sb_ = up ? pb[i] : pb[N + i]; \
            pa[i] = ka + XOR(sa_); pb[i] = kb + XOR(sb_); }
        TR_STEP(4, lane_xor8, 8) TR_STEP(2, lane_xor4, 4) TR_STEP(1, lane_xor2, 2)
#undef TR_STEP
        const int e = (F.lane >> 1) & 31; const float br = b_router[e];
#pragma unroll
        for (int u = 0; u < 2; ++u) { const int row = row0 + 2 * rp + u; float v = (u ? pb[0] : pa[0]); v += lane_xor1(v); v += br;
            int rank = 0;
#pragma unroll
            for (int j = 0; j < 32; ++j) { const float vj = __uint_as_float((unsigned)__builtin_amdgcn_readlane((int)__float_as_uint(v), 2 * j)); rank += (vj > v || (vj == v && j < e)) ? 1 : 0; }
            const bool sel = rank < TOPK; const float vmax = wave_max(v); const float ex = sel ? __expf(v - vmax) : 0.f; const float den = wave_sum(ex) * 0.5f;
            if (sel && !(F.lane & 1)) { TOPI[(size_t)row * TOPK + rank] = e; TOPW[(size_t)row * TOPK + rank] = ex / den; __hip_atomic_fetch_add((LAS int*)&hist[e], 1, __ATOMIC_RELAXED, __HIP_MEMORY_SCOPE_WORKGROUP); } }
    }
    __syncthreads();
    if (F.tid < NE) WGCNT[bx * NE + F.tid] = hist[F.tid];
    }
}

__device__ __forceinline__ void p7_phase(Frame& F) {
    const int* TOPI = (const int*)(F.ws + WS_TOPI); const float* TOPW = (const float*)(F.ws + WS_TOPW); const int* WGCNT = (const int*)(F.ws + WS_WGCNT);
    int* ROWTOK = (int*)(F.ws + WS_ROWTOK); int* ROWPAIR = (int*)(F.ws + WS_ROWPAIR); float* ROWW = (float*)(F.ws + WS_ROWW); int* MTEXP = (int*)(F.ws + WS_MTEXP);
    LAS int* ptot = (LAS int*)F.lds; LAS int* pbef = ptot + 512; LAS int* cnt = pbef + 512; LAS int* wgb = cnt + 32; LAS int* pst = wgb + 32; LAS int* pad = pst + 64; LAS int* ep = pad + 32;
    if (F.G != 256) return;
    const int bx = blockIdx.x;
    { const int e = F.tid & 31, part = F.tid >> 5; int tt = 0, tb = 0;
      for (int w = part * 16; w < part * 16 + 16; ++w) { const int v = WGCNT[w * NE + e]; tt += v; tb += (w < bx) ? v : 0; }
      ptot[part * 32 + e] = tt; pbef[part * 32 + e] = tb; }
    __syncthreads();
    if (F.tid < NE) { int tt = 0, tb = 0; for (int p = 0; p < 16; ++p) { tt += ptot[p * 32 + F.tid]; tb += pbef[p * 32 + F.tid]; } cnt[F.tid] = tt; wgb[F.tid] = tb; pad[F.tid] = (tt + 255) & ~255; }
    __syncthreads();
    if (F.tid == 0) { int s = 0; for (int e = 0; e < NE; ++e) { pst[e] = s; s += pad[e]; } pst[NE] = s; }
    if (F.tid < 256) ep[F.tid] = TOPI[(size_t)bx * 256 + F.tid];
    __syncthreads();
    if (F.tid < 256) { const int p = F.tid, e = ep[p]; int rk = 0; for (int q = 0; q < p; ++q) rk += (ep[q] == e) ? 1 : 0;
        const int dest = pst[e] + wgb[e] + rk; const int pair = bx * 256 + p; ROWTOK[dest] = pair >> 2; ROWPAIR[dest] = pair; ROWW[dest] = TOPW[pair]; }
    if (bx < NE) { const int e = bx; for (int i = pst[e] + cnt[e] + F.tid; i < pst[e] + pad[e]; i += NWAVES * 64) { ROWTOK[i] = 0; ROWPAIR[i] = -1; ROWW[i] = 0.f; } }
    if (bx == 0) { if (F.tid < NE) { for (int mt = pst[F.tid] >> 8; mt < (pst[F.tid] + pad[F.tid]) >> 8; ++mt) MTEXP[mt] = F.tid; } if (F.tid == 0) MTEXP[512] = pst[NE] >> 8; }
}

__device__ __forceinline__ void p10_phase(Frame& F) {
    const float* x = F.in(0); const float* gpostm = F.in(5); const float* gpost = F.in(19); const float* MOD = (const float*)(F.ws + WS_MOD);
    const unsigned char* YP = (const unsigned char*)(F.ws + WS_YP); const bf16* Y = (const bf16*)(F.ws + WS_Y);
    const int gw = F.vcu * NWAVES + F.wave;
    if (F.G * NWAVES * 8 != NTOK) return;
    const int row0 = gw * 8, b = row0 / SEQ;
    f32x4 gg[4], gpm[4];
#pragma unroll
    for (int j = 0; j < 4; ++j) { const int k = 4 * F.lane + 256 * j; gg[j] = *(const f32x4*)(MOD + b * NMOD * DM + 5 * DM + k) * *(const f32x4*)(gpost + k); gpm[j] = *(const f32x4*)(MOD + b * NMOD * DM + 2 * DM + k) * *(const f32x4*)(gpostm + k); }
    int nw[4][TOPK]; v2u ny[4]; f32x4 nx[4];
#pragma unroll
    for (int j = 0; j < 4; ++j) { ny[j] = *(const GAS v2u*)(Y + (size_t)row0 * DM + 4 * F.lane + 256 * j); nx[j] = *(const f32x4*)(x + (size_t)row0 * DM + 4 * F.lane + 256 * j);
#pragma unroll
        for (int k = 0; k < TOPK; ++k) nw[j][k] = *(const GAS int*)(YP + ((size_t)row0 * TOPK + k) * DM + 4 * F.lane + 256 * j); }
    for (int r = 0; r < 8; ++r) { const int row = row0 + r;
        f32x4 y[4], ym[4], xr[4]; float ss = 0.f, sm = 0.f;
#pragma unroll
        for (int j = 0; j < 4; ++j) { f32x4 s = (f32x4){0.f, 0.f, 0.f, 0.f};
#pragma unroll
            for (int k = 0; k < TOPK; ++k) { const int w = nw[j][k]; s += (f32x4){__builtin_amdgcn_cvt_f32_fp8(w, 0), __builtin_amdgcn_cvt_f32_fp8(w, 1), __builtin_amdgcn_cvt_f32_fp8(w, 2), __builtin_amdgcn_cvt_f32_fp8(w, 3)}; }
            y[j] = s; ss += (s[0] * s[0] + s[1] * s[1]) + (s[2] * s[2] + s[3] * s[3]);
            const v2u yw = ny[j]; const f32x4 m = (f32x4){bflo(yw.x), bfhi(yw.x), bflo(yw.y), bfhi(yw.y)}; ym[j] = m; sm += (m[0] * m[0] + m[1] * m[1]) + (m[2] * m[2] + m[3] * m[3]); xr[j] = nx[j]; }
        if (r < 7) {
#pragma unroll
            for (int j = 0; j < 4; ++j) { ny[j] = *(const GAS v2u*)(Y + (size_t)(row + 1) * DM + 4 * F.lane + 256 * j); nx[j] = *(const f32x4*)(x + (size_t)(row + 1) * DM + 4 * F.lane + 256 * j);
#pragma unroll
                for (int k = 0; k < TOPK; ++k) nw[j][k] = *(const GAS int*)(YP + ((size_t)(row + 1) * TOPK + k) * DM + 4 * F.lane + 256 * j); } }
        const float rinv = 1.0f / sqrtf(wave_sum(ss) * (1.0f / DM) + RMS_EPS * 16.0f), rinvm = 1.0f / sqrtf(wave_sum(sm) * (1.0f / DM) + RMS_EPS);
#pragma unroll
        for (int j = 0; j < 4; ++j) *(f32x4*)(F.out + (size_t)row * DM + 4 * F.lane + 256 * j) = (xr[j] + gpm[j] * (ym[j] * rinvm)) + gg[j] * (y[j] * rinv);
    }
}

__global__ void __launch_bounds__(NWAVES * 64, 2) mega_fwd(Args args) {
    extern __shared__ __attribute__((aligned(16))) unsigned char lds[];
    Frame F;
    F.lds = (LAS unsigned char*)lds;
    F.tid = threadIdx.x; F.lane = F.tid & 63; F.wave = __builtin_amdgcn_readfirstlane(F.tid >> 6);
    F.G = gridDim.x; { const int bx = blockIdx.x; F.vcu = (F.G % 8 == 0) ? (bx % 8) * (F.G / 8) + bx / 8 : bx; }
    F.out = args.out; F.ws = args.ws;
    volatile LAS unsigned* MISC = (volatile LAS unsigned*)(F.lds + MISC_OFF);
    for (int u = F.tid; u < (LDS_BYTES - LDSCTL_OFF) / 4; u += NWAVES * 64) ((LAS unsigned*)(F.lds + LDSCTL_OFF))[u] = 0u;
    __syncthreads();
    if (F.tid < 26) ((LAS unsigned long long*)(F.lds + LDSCTL_OFF))[F.tid] = (unsigned long long)args.in[F.tid];
    __syncthreads();
    gu32* ctl = (gu32*)(F.ws + WS_CTL);
    XcdBarrier bar = xcd_barrier_post((unsigned*)(ctl + CW_BAR) + args.li * XCD_BAR_WORDS, MISC + 8);
    const int lo = args.ph_lo, hi = args.ph_hi;
#ifndef PHMASK
#define PHMASK 0x7ff
#endif
#define IN(k) (((PHMASK >> (k)) & 1) && lo <= (k) && (k) < hi)
#define SEAM(k, n) do { if (IN(k) && IN(n)) xcd_barrier(bar); } while (0)
#define REFRESH() do { int t_; asm volatile("v_mov_b32 %0, %1" : "=v"(t_) : "v"(threadIdx.x)); F.tid = t_; F.lane = t_ & 63; } while (0)
#define ATTN_TENSORS attn_body::AttnTensors{(const attn_body::bf16*)(F.ws + WS_PJ) + 2 * PJ_STRIDE, (const attn_body::bf16*)(F.ws + WS_PJ) + 3 * PJ_STRIDE, (const attn_body::bf16*)(F.ws + WS_PJ) + 4 * PJ_STRIDE, \
                                          (attn_body::bf16*)(F.ws + WS_MRG), (const float*)(F.ws + WS_LOGF2), (float*)(F.ws + WS_SSQ)}
    if (IN(0)) { REFRESH(); p0_phase(F); } SEAM(0, 1);
    if (IN(1)) { REFRESH(); p1_phase(F); } SEAM(1, 2);
    if (IN(2)) { REFRESH();
        pg8::DenseOrder S; S.init((const pg8::bf16_t*)(F.ws + WS_H1), (const pg8::bf16_t*)(F.ws + WS_WIN), NTOK, NPJ, F.G, (int)blockIdx.x);
        pg8::EpiProj E{(pg8::bf16_t*)(F.ws + WS_PJ), PJ_STRIDE, attn_body::C2};
        pg8::gemm_phase<pg8::EpiProj, pg8::DenseOrder>(F.lds, S, E);
        if (F.G == 256 && blockIdx.x >= 128) { REFRESH(); cvt_range<true>(F, 0, CV_UP_TAIL, ((int)blockIdx.x - 128) * NWAVES + F.wave, 128 * NWAVES); }
    } SEAM(2, 3);
    if (IN(3)) { REFRESH();
        lru_phase(F);
        const attn_body::AttnTensors AT = ATTN_TENSORS; const attn_body::StaticOrder S((int)F.G, F.vcu);
        attn_body::attn_phase<attn_body::StaticOrder>((char*)lds, AT, S);
    } SEAM(3, 5);
    if (IN(5)) { REFRESH();
        pg8::DenseOrder S; S.init((const pg8::bf16_t*)(F.ws + WS_MRG), (const pg8::bf16_t*)(F.ws + WS_WOUT), NTOK, DM, F.G, (int)blockIdx.x);
        pg8::EpiOut E{(pg8::bf16_t*)(F.ws + WS_Y), (const float*)(F.ws + WS_SSQ)};
        pg8::gemm_phase<pg8::EpiOut, pg8::DenseOrder>(F.lds, S, E);
    } SEAM(5, 6);
    if (IN(6)) { REFRESH(); p6_phase<0>(F); } SEAM(6, 7);
    if (IN(7)) { REFRESH(); p7_phase(F); } SEAM(7, 8);
    if (IN(8)) { REFRESH();
        const int nmt = ((const int*)(F.ws + WS_MTEXP))[512];
        LAS int* mtl = (LAS int*)(F.lds + 131072); LAS float* bsl = (LAS float*)(F.lds + 131072 + 2048);
        for (int i = F.tid; i < nmt; i += NWAVES * 64) mtl[i] = ((const int*)(F.ws + WS_MTEXP))[i];
        __syncthreads();
        { const float* b_up = F.in(23);
          for (int i = 0; i < 12; ++i) { const int L = i * F.G + F.vcu; if (L >= nmt * 8) break; const int ex = mtl[L >> 3], pn = L & 7;
              if (F.tid < 256) bsl[i * 256 + F.tid] = b_up[(size_t)ex * 2 * DEXP + (F.tid >> 7) * DEXP + pn * 128 + (F.tid & 127)]; } }
        __syncthreads();
        pg8::UpOrder S{(const unsigned char*)(F.ws + WS_H2), (const unsigned char*)(F.ws + WS_WUP), (const int*)(F.ws + WS_ROWTOK), mtl, nmt * 8, F.G, F.vcu};
        pg8::EpiUp E{(unsigned char*)(F.ws + WS_ACT), bsl};
        pg8::gemm_phase<pg8::EpiUp, pg8::UpOrder, true>(F.lds, S, E);
        if (F.G == 256) {
            const int units = nmt * 8, maxu = (units + 255) >> 8, nfull = units - (maxu - 1) * 256, nidle = 256 - nfull;
            REFRESH();
            if (nidle >= 32) { if (F.vcu >= nfull) cvt_range<false>(F, 0, CV_DN_TAIL, (F.vcu - nfull) * NWAVES + F.wave, nidle * NWAVES); }
            else cvt_range<false>(F, 0, CV_DN_TAIL, F.vcu * NWAVES + F.wave, 256 * NWAVES); }
    } SEAM(8, 9);
    if (IN(9)) { REFRESH();
        const int nmt = ((const int*)(F.ws + WS_MTEXP))[512];
        LAS int* mtl = (LAS int*)(F.lds + 131072); LAS float* bsl = (LAS float*)(F.lds + 131072 + 2048);
        for (int i = F.tid; i < nmt; i += NWAVES * 64) mtl[i] = ((const int*)(F.ws + WS_MTEXP))[i];
        __syncthreads();
        { const float* b_dn = F.in(25);
          for (int i = 0; i < 12; ++i) { const int L = i * F.G + F.vcu; if (L >= nmt * 4) break; const int ex = mtl[L >> 2], pn = L & 3;
              if (F.tid < 256) bsl[i * 256 + F.tid] = b_dn[(size_t)ex * DM + pn * 256 + F.tid]; } }
        __syncthreads();
        pg8::DownOrder S{(const unsigned char*)(F.ws + WS_ACT), (const unsigned char*)(F.ws + WS_WDN), mtl, nmt * 4, F.G, F.vcu};
        pg8::EpiDown E{(unsigned char*)(F.ws + WS_YP), bsl, (const int*)(F.ws + WS_ROWPAIR), (const float*)(F.ws + WS_ROWW)};
        pg8::gemm_phase<pg8::EpiDown, pg8::DownOrder, true>(F.lds, S, E);
    } SEAM(9, 10);
    if (IN(10)) { REFRESH(); p10_phase(F); }
#ifdef MK_PROBES
    if (lo == 11) { REFRESH(); lru_phase(F); }
    if (lo == 12) { REFRESH(); const attn_body::AttnTensors AT = ATTN_TENSORS; const attn_body::StaticOrder S((int)F.G, F.vcu); attn_body::attn_phase<attn_body::StaticOrder>((char*)lds, AT, S); }
    if (lo == 14) { REFRESH(); p0_phase<1>(F); }
    if (lo == 15) { REFRESH(); p0_phase<2>(F); }
    if (lo == 16) { REFRESH(); p0_phase<4>(F); }
    if (lo == 17) { for (int i = 0; i < 10; ++i) xcd_barrier(bar); }
    if (lo == 18) { REFRESH(); p6_phase<1>(F); }
    if (lo >= 21 && lo <= 24) { REFRESH();
        const int nmt = ((const int*)(F.ws + WS_MTEXP))[512];
        LAS int* mtl = (LAS int*)(F.lds + 131072); LAS float* bsl = (LAS float*)(F.lds + 131072 + 2048);
        for (int i = F.tid; i < nmt; i += NWAVES * 64) mtl[i] = ((const int*)(F.ws + WS_MTEXP))[i];
        for (int i = F.tid; i < 12 * 256; i += NWAVES * 64) bsl[i] = 0.f;
        __syncthreads();
        pg8::UpOrder S{(const unsigned char*)(F.ws + WS_H2), (const unsigned char*)(F.ws + WS_WUP), (const int*)(F.ws + WS_ROWTOK), mtl, nmt * 8, F.G, F.vcu};
        if (lo == 21) { pg8::EpiNop E{}; pg8::gemm_phase<pg8::EpiNop, pg8::UpOrder, true, 1>(F.lds, S, E); }
        else if (lo == 22) { pg8::EpiNop E{}; pg8::gemm_phase<pg8::EpiNop, pg8::UpOrder, true, 2>(F.lds, S, E); }
        else if (lo == 23) { pg8::EpiUp E{(unsigned char*)(F.ws + WS_H1), bsl}; pg8::gemm_phase<pg8::EpiUp, pg8::UpOrder, true, 1>(F.lds, S, E); }
        else { pg8::EpiUpT<false> E{(unsigned char*)(F.ws + WS_H1), bsl}; pg8::gemm_phase<pg8::EpiUpT<false>, pg8::UpOrder, true, 1>(F.lds, S, E); } }
#endif
#undef IN
#undef SEAM
#undef REFRESH
#undef ATTN_TENSORS
}

static void launch_mega(hipStream_t stream, void* const* d_in, void* d_out, void* d_ws, int lo, int hi, int li, int grid) {
    Args a{};
    for (int i = 0; i < 26; ++i) a.in[i] = (const float*)d_in[i];
    a.out = (float*)d_out; a.ws = (unsigned char*)d_ws; a.ph_lo = lo; a.ph_hi = hi; a.li = li; a.pad = 0;
    hipLaunchKernelGGL(mega_fwd, dim3(grid), dim3(NWAVES * 64), LDS_BYTES, stream, a);
}

extern "C" void kernel_launch(void* const* d_in, const int* in_sizes, int n_in, void* d_out, int out_size, void* d_ws, size_t ws_size, hipStream_t stream) {
    static int grid = 0;
    if (grid == 0) {
        int dev = 0, cus = 0;
        if (n_in != 26 || out_size != NTOK * DM || ws_size < WS_END) { fprintf(stderr, "kernel_launch: unexpected problem shape / workspace (%d inputs, out %d, ws %zu)\n", n_in, out_size, ws_size); grid = -1; return; }
        if (hipGetDevice(&dev) != hipSuccess || hipDeviceGetAttribute(&cus, hipDeviceAttributeMultiprocessorCount, dev) != hipSuccess) { grid = -1; return; }
        if (hipFuncSetAttribute((const void*)mega_fwd, hipFuncAttributeMaxDynamicSharedMemorySize, LDS_BYTES) != hipSuccess) { fprintf(stderr, "kernel_launch: hipFuncSetAttribute failed\n"); grid = -1; return; }
        grid = cus;
        if (grid != 256) fprintf(stderr, "kernel_launch: %d CUs; this kernel is laid out for 256\n", grid);
    }
    if (grid < 0) return;
    (void)in_sizes;
    (void)hipMemsetAsync((char*)d_ws + WS_CTL, 0, CTL_ZERO_BYTES, stream);
    launch_mega(stream, d_in, d_out, d_ws, 0, NPHASES, 0, grid);
#ifdef MK_PROBES
#ifdef EXTRA_LO
    launch_mega(stream, d_in, d_out, d_ws, EXTRA_LO, EXTRA_HI, 1, grid);
#endif
#endif
}
```

```cpp
#include <hip/hip_runtime.h>
#include <hip/hip_bf16.h>
#include <cstdio>
#include <cstdint>
#include <cmath>

constexpr int DM = 1024, BATCH = 8, SEQ = 2048, NTOK = BATCH * SEQ;
constexpr int DLRU = 512, DATT = 512, NH = 8, HD = 64, NPROJ = 2 * DLRU + 3 * DATT + NH, NPJ = 2560;
constexpr int NE = 32, TOPK = 4, DEXP = 1024, NMOD = 6;
constexpr float RMS_EPS = 1e-6f;
constexpr int MAXROWS = NTOK * TOPK + NE * 256;
constexpr int MAXMT = MAXROWS / 256;

namespace pg8 {
#define PG8_LAS __attribute__((address_space(3)))
typedef unsigned short bf16_t;
typedef short bf16x8 __attribute__((ext_vector_type(8)));
typedef float f32x4 __attribute__((ext_vector_type(4)));
typedef float f32x2 __attribute__((ext_vector_type(2)));
typedef unsigned u32x4 __attribute__((ext_vector_type(4)));
constexpr int BM = 256, BK = 64, HALF = 128, HTB = HALF * BK * 2  , STAGE_BYTES = 8 * HTB, NXCD = 8, WGM = 4;
constexpr int GK = 1024, GNT = GK / BK;
typedef int i32x8 __attribute__((ext_vector_type(8)));
typedef int i32x4 __attribute__((ext_vector_type(4)));
constexpr int F8_SCALE_W = 0x79797979, F8_SCALE_A = 0x7f7f7f7f;

__host__ __device__ __forceinline__ int lds_byte(int r, int c) { const int st = (r >> 4) * 2 + (c >> 5), rr = r & 15, cc = c & 31, ob = rr * 64 + cc * 2; return st * 1024 + (ob ^ (((ob >> 9) & 1) << 5)); }
__host__ __device__ __forceinline__ void stage_rc(int b, int& R, int& C) { const int st = b / 1024, sb = b % 1024, swz = sb ^ (((sb >> 9) & 1) << 5); R = (st >> 1) * 16 + swz / 64; C = (st & 1) * 32 + (swz % 64) / 2; }
__host__ __device__ __forceinline__ int perm32(int rho) { const int n = rho >> 4, i = rho & 15; return 8 * (i >> 2) + 4 * n + (i & 3); }

struct Unit { const char* A0; const char* A1; const char* B0; const char* B1; int pm, pn, e, ord; };

__device__ __forceinline__ void mfma_f8_acc(f32x4& acc, const i32x8& b, const i32x8& a, int sw, int sa) {
    asm volatile("v_mfma_scale_f32_16x16x128_f8f6f4 %0, %1, %2, %0, %3, %4 op_sel_hi:[0,0,0]" : "+v"(acc) : "v"(b), "v"(a), "v"(sw), "v"(sa)); }
__device__ __forceinline__ unsigned cvt_pk_bf16(float lo, float hi) { unsigned r; asm volatile("v_cvt_pk_bf16_f32 %0, %1, %2" : "=v"(r) : "v"(lo), "v"(hi)); return r; }

template <class Epi, class Sched, bool F8 = false, int KREP = 1>
__device__ __forceinline__ void gemm_phase(PG8_LAS unsigned char* lds, const Sched& S, const Epi& E) {
    const int tid = threadIdx.x, wid = __builtin_amdgcn_readfirstlane(tid >> 6), lane = tid & 63, wr = wid >> 2, wc = wid & 3, fr = lane & 15, fq = lane >> 4;
    constexpr int KB = F8 ? GK : GK * 2, nt1 = F8 ? GK / 128 : GNT, nt = nt1 * KREP;
    int Rr[2], Cc[2];
    unsigned voffB[2], cvA[2][2], nvA[2][2];
#pragma unroll
    for (int i = 0; i < 2; ++i) { stage_rc(tid * 16 + i * 8192, Rr[i], Cc[i]); const int Rb = Epi::PERM ? ((Rr[i] & ~31) + perm32(Rr[i] & 31)) : Rr[i]; voffB[i] = (unsigned)(Rb * KB + Cc[i] * 2); }
    constexpr size_t kstep = (size_t)(BK * 2);
    const unsigned ldsw = (unsigned)wid * 1024u;
    const int aoff = lds_byte(wr * 64 + fr, fq * 8), boff = lds_byte(wc * 32 + fr, fq * 8);
#define PG8_SA(b, h) (((b) * 2 + (h)) * HTB)
#define PG8_SB(b, h) ((4 + (b) * 2 + (h)) * HTB)
#define PG8_STAGE(bufoff, gbase, voff) do { _Pragma("unroll") for (int _i = 0; _i < 2; ++_i) \
        __builtin_amdgcn_global_load_lds((const unsigned*)((const char*)(gbase) + (voff)[_i]), (PG8_LAS unsigned*)(lds + (bufoff) + ldsw + _i * 8192), 16, 0, 0); } while (0)
#define PG8_LD8(p) __builtin_shufflevector(*(const PG8_LAS i32x4*)(p), *(const PG8_LAS i32x4*)((p) + 1024), 0, 1, 2, 3, 4, 5, 6, 7)
#define PG8_LDA(dst, b, h) do { _Pragma("unroll") for (int m = 0; m < 4; ++m) { if constexpr (F8) { dst##8[m] = PG8_LD8(lds + PG8_SA(b, h) + aoff + m * 2048); } \
        else { _Pragma("unroll") for (int k = 0; k < 2; ++k) dst[m][k] = *(const PG8_LAS bf16x8*)(lds + PG8_SA(b, h) + aoff + m * 2048 + k * 1024); } } } while (0)
#define PG8_LDB(dst, b, h) do { _Pragma("unroll") for (int n = 0; n < 2; ++n) { if constexpr (F8) { dst##8[n] = PG8_LD8(lds + PG8_SB(b, h) + boff + n * 2048); } \
        else { _Pragma("unroll") for (int k = 0; k < 2; ++k) dst[n][k] = *(const PG8_LAS bf16x8*)(lds + PG8_SB(b, h) + boff + n * 2048 + k * 1024); } } } while (0)
#define PG8_MMA(ai, bj, At, Bt) do { __builtin_amdgcn_s_setprio(1); _Pragma("unroll") for (int m = 0; m < 4; ++m) _Pragma("unroll") for (int n = 0; n < 2; ++n) { \
        if constexpr (F8) { mfma_f8_acc(acc[ai][bj][m][n], Bt##8[n], At##8[m], scw, sca); } \
        else { _Pragma("unroll") for (int k = 0; k < 2; ++k) acc[ai][bj][m][n] = __builtin_amdgcn_mfma_f32_16x16x32_bf16(Bt[n][k], At[m][k], acc[ai][bj][m][n], 0, 0, 0); } } \
        __builtin_amdgcn_s_setprio(0); } while (0)
#define PG8_WAIT_V(n) asm volatile("s_waitcnt vmcnt(" #n ")" ::: "memory")
    constexpr int RELAX = 8 + Epi::NST + (Sched::GATHER ? 4 : 0);
#define PG8_WAIT_V8R(rx) do { if (rx) { if constexpr (RELAX == 12) PG8_WAIT_V(12); else if constexpr (RELAX == 16) PG8_WAIT_V(16); else if constexpr (RELAX == 20) PG8_WAIT_V(20); \
        else if constexpr (RELAX == 24) PG8_WAIT_V(24); else if constexpr (RELAX == 28) PG8_WAIT_V(28); else PG8_WAIT_V(8); } else PG8_WAIT_V(8); } while (0)
#define PG8_WAIT_L(n) asm volatile("s_waitcnt lgkmcnt(" #n ")" ::: "memory")
#define PG8_BAR __builtin_amdgcn_s_barrier()
#define PG8_SCHED __builtin_amdgcn_sched_barrier(0)
#define PG8_VOFF(dst, u) do { _Pragma("unroll") for (int _h = 0; _h < 2; ++_h) _Pragma("unroll") for (int _i = 0; _i < 2; ++_i) { \
        const int _row = Sched::GATHER ? S.row_of(u, _h * HALF + Rr[_i]) : Rr[_i]; dst[_h][_i] = (unsigned)(_row * KB + Cc[_i] * 2); } } while (0)
    Unit cur, nxt; int ui = 0;
    if (!S.next(0, cur)) return;
    f32x4 acc[2][2][4][2];
#pragma unroll
    for (int a = 0; a < 2; ++a)
#pragma unroll
        for (int b = 0; b < 2; ++b)
#pragma unroll
            for (int m = 0; m < 4; ++m)
#pragma unroll
                for (int n = 0; n < 2; ++n) acc[a][b][m][n] = (f32x4){0.f, 0.f, 0.f, 0.f};
    const int scw = F8_SCALE_W, sca = F8_SCALE_A;
    bf16x8 At[4][2], B0[2][2], B1[2][2]; i32x8 At8[4], B08[2], B18[2];
    PG8_VOFF(cvA, cur);
    if (Sched::GATHER) { asm volatile("s_waitcnt vmcnt(0)" ::: "memory"); }
    PG8_STAGE(PG8_SB(0, 0), cur.B0, voffB); PG8_STAGE(PG8_SB(0, 1), cur.B1, voffB); PG8_STAGE(PG8_SA(0, 0), cur.A0, cvA[0]); PG8_STAGE(PG8_SA(0, 1), cur.A1, cvA[1]);
    if (wr == 1) PG8_BAR;
    PG8_WAIT_V(2); PG8_BAR;
    PG8_STAGE(PG8_SB(1, 0), cur.B0 + kstep, voffB); PG8_STAGE(PG8_SA(1, 0), cur.A0 + kstep, cvA[0]); PG8_STAGE(PG8_SB(1, 1), cur.B1 + kstep, voffB);
    PG8_WAIT_V(6); PG8_BAR;
    for (;;) {
        const bool has_next = S.next(ui + 1, nxt);
        if (!has_next) nxt = cur;
        int nraw[2][2];
        if (Sched::GATHER && has_next) {
#pragma unroll
            for (int _h = 0; _h < 2; ++_h)
#pragma unroll
                for (int _i = 0; _i < 2; ++_i) { const int* p_ = S.row_ptr(nxt, _h * HALF + Rr[_i]); asm volatile("global_load_dword %0, %1, off" : "=v"(nraw[_h][_i]) : "v"(p_) : "memory"); }
        }
        if (has_next) { if (!Sched::GATHER) { PG8_VOFF(nvA, nxt); } }
        else {
#pragma unroll
            for (int _h = 0; _h < 2; ++_h)
#pragma unroll
                for (int _i = 0; _i < 2; ++_i) nvA[_h][_i] = cvA[_h][_i]; }
#pragma unroll 1
        for (int t = 0; t < nt; t += 2) {
            const bool last = (t == nt - 2); const bool rx = (t == 0) && (ui > 0);
            if (Epi::MID && t == nt / 2) E.mid(acc, cur, wr, wc, fr, fq);
            const char* a1_1 = cur.A1 + (size_t)((t + 1) % nt1) * kstep;
            const char* a2_0 = last ? nxt.A0 : cur.A0 + (size_t)((t + 2) % nt1) * kstep; const char* a2_1 = last ? nxt.A1 : cur.A1 + (size_t)((t + 2) % nt1) * kstep;
            const char* b2_0 = last ? nxt.B0 : cur.B0 + (size_t)((t + 2) % nt1) * kstep; const char* b2_1 = last ? nxt.B1 : cur.B1 + (size_t)((t + 2) % nt1) * kstep;
            const char* a3_0 = a2_0 + kstep; const char* a3_1 = a2_1 + kstep; const char* b3_0 = b2_0 + kstep; const char* b3_1 = b2_1 + kstep;
            if (Sched::GATHER && last && has_next) {
#pragma unroll
                for (int _h = 0; _h < 2; ++_h)
#pragma unroll
                    for (int _i = 0; _i < 2; ++_i) { int r_ = nraw[_h][_i]; asm volatile("" : "+v"(r_));
                        nvA[_h][_i] = (unsigned)(r_ * KB + Cc[_i] * 2); } }
            unsigned sv0[2], sv1[2];
#pragma unroll
            for (int _i = 0; _i < 2; ++_i) { sv0[_i] = last ? nvA[0][_i] : cvA[0][_i]; sv1[_i] = last ? nvA[1][_i] : cvA[1][_i]; }
            PG8_LDB(B0, 0, 0); PG8_LDB(B1, 0, 1); PG8_SCHED; PG8_LDA(At, 0, 0); PG8_STAGE(PG8_SA(1, 1), a1_1, cvA[1]);
            PG8_WAIT_V8R(rx); PG8_WAIT_L(0); PG8_BAR; PG8_MMA(0, 0, At, B0); PG8_MMA(0, 1, At, B1); PG8_BAR; PG8_SCHED;
            PG8_LDA(At, 0, 1); PG8_STAGE(PG8_SB(0, 0), b2_0, voffB); PG8_STAGE(PG8_SB(0, 1), b2_1, voffB); PG8_STAGE(PG8_SA(0, 0), a2_0, sv0);
            PG8_WAIT_V8R(rx); PG8_WAIT_L(0); PG8_BAR; PG8_MMA(1, 0, At, B0); PG8_MMA(1, 1, At, B1); PG8_BAR; PG8_SCHED;
            PG8_LDB(B0, 1, 0); PG8_LDB(B1, 1, 1); PG8_SCHED; PG8_LDA(At, 1, 0); PG8_STAGE(PG8_SA(0, 1), a2_1, sv1);
            PG8_WAIT_V(8); PG8_WAIT_L(0); PG8_BAR; PG8_MMA(0, 0, At, B0); PG8_MMA(0, 1, At, B1); PG8_BAR; PG8_SCHED;
            PG8_LDA(At, 1, 1); PG8_STAGE(PG8_SB(1, 0), b3_0, voffB); PG8_STAGE(PG8_SB(1, 1), b3_1, voffB); PG8_STAGE(PG8_SA(1, 0), a3_0, sv0);
            PG8_WAIT_V(8); PG8_WAIT_L(0); PG8_BAR; PG8_MMA(1, 0, At, B0); PG8_MMA(1, 1, At, B1); PG8_BAR; PG8_SCHED;
            (void)a3_1; (void)b3_1;
        }
        if (wr == 0) PG8_BAR;
        if constexpr (F8) { asm volatile("s_nop 15\n\ts_nop 15\n\ts_nop 7" ::: "memory"); }
        E(acc, cur, wr, wc, fr, fq);
        if (!has_next) break;
#pragma unroll
        for (int a = 0; a < 2; ++a)
#pragma unroll
            for (int b = 0; b < 2; ++b)
#pragma unroll
                for (int m = 0; m < 4; ++m)
#pragma unroll
                    for (int n = 0; n < 2; ++n) acc[a][b][m][n] = (f32x4){0.f, 0.f, 0.f, 0.f};
        cur = nxt; ++ui;
#pragma unroll
        for (int _h = 0; _h < 2; ++_h)
#pragma unroll
            for (int _i = 0; _i < 2; ++_i) cvA[_h][_i] = nvA[_h][_i];
        if (wr == 1) PG8_BAR;
    }
    PG8_WAIT_V(0);
    PG8_BAR;
#undef PG8_SA
#undef PG8_SB
#undef PG8_STAGE
#undef PG8_LDA
#undef PG8_LDB
#undef PG8_MMA
#undef PG8_LD8
#undef PG8_WAIT_V
#undef PG8_WAIT_V8R
#undef PG8_WAIT_L
#undef PG8_BAR
#undef PG8_SCHED
#undef PG8_VOFF
}
}

namespace pg8 {

struct DenseOrder {
    static constexpr bool GATHER = false;
    const bf16_t* A; const bf16_t* Bt; int nM, nN, nwg, G, c;
    __device__ __forceinline__ void init(const bf16_t* A_, const bf16_t* Bt_, int M, int N, int G_, int c_) { A = A_; Bt = Bt_; nM = M / BM; nN = N / BM; nwg = nM * nN; G = G_; c = c_; }
    __device__ __forceinline__ bool next(int i, Unit& u) const {
        const long L = (long)i * G + c; if (L >= nwg) return false;
        int wgid = (int)L; { const int q = nwg / NXCD, r = nwg % NXCD, xcd = wgid % NXCD, off = wgid / NXCD; wgid = (xcd < r ? xcd * (q + 1) : r * (q + 1) + (xcd - r) * q) + off; }
        const int nig = WGM * nN, gid = wgid / nig, fm = gid * WGM, gsz = (nM - fm) < WGM ? (nM - fm) : WGM;
        u.pm = fm + ((wgid % nig) % gsz); u.pn = (wgid % nig) / gsz; u.e = 0; u.ord = i;
        u.A0 = (const char*)A + (size_t)u.pm * BM * GK * 2; u.A1 = u.A0 + (size_t)HALF * GK * 2;
        u.B0 = (const char*)Bt + (size_t)u.pn * BM * GK * 2; u.B1 = u.B0 + (size_t)HALF * GK * 2;
        return true;
    }
    __device__ __forceinline__ int row_of(const Unit&, int r) const { return r; }
    __device__ __forceinline__ const int* row_ptr(const Unit&, int) const { return nullptr; }
};
struct UpOrder {
    static constexpr bool GATHER = true;
    const unsigned char* H2; const unsigned char* WupT; const int* row_tok; const PG8_LAS int* mt_exp; int nunits, G, c;
    __device__ __forceinline__ bool next(int i, Unit& u) const {
        const int L = i * G + c; if (L >= nunits) return false;
        u.pm = L >> 3; u.pn = L & 7; u.e = __builtin_amdgcn_readfirstlane(mt_exp[u.pm]); u.ord = i;
        u.A0 = (const char*)H2; u.A1 = (const char*)H2;
        u.B0 = (const char*)WupT + ((size_t)u.e * 2 * DEXP + (size_t)u.pn * HALF) * GK; u.B1 = u.B0 + (size_t)DEXP * GK;
        return true;
    }
    __device__ __forceinline__ int row_of(const Unit& u, int r) const { return row_tok[u.pm * BM + r]; }
    __device__ __forceinline__ const int* row_ptr(const Unit& u, int r) const { return row_tok + u.pm * BM + r; }
};
struct DownOrder {
    static constexpr bool GATHER = false;
    const unsigned char* ACT; const unsigned char* WdnT; const PG8_LAS int* mt_exp; int nunits, G, c;
    __device__ __forceinline__ bool next(int i, Unit& u) const {
        const int L = i * G + c; if (L >= nunits) return false;
        u.pm = L >> 2; u.pn = L & 3; u.e = __builtin_amdgcn_readfirstlane(mt_exp[u.pm]); u.ord = i;
        u.A0 = (const char*)ACT + (size_t)u.pm * BM * GK; u.A1 = u.A0 + (size_t)HALF * GK;
        u.B0 = (const char*)WdnT + ((size_t)u.e * DM + (size_t)u.pn * BM) * GK; u.B1 = u.B0 + (size_t)HALF * GK;
        return true;
    }
    __device__ __forceinline__ int row_of(const Unit&, int r) const { return r; }
    __device__ __forceinline__ const int* row_ptr(const Unit&, int) const { return nullptr; }
};

struct EpiProj {
    static constexpr bool PERM = true, MID = false; static constexpr int NST = 16;
    bf16_t* O; size_t tstride; float qscale;
    __device__ __forceinline__ void mid(f32x4 (&)[2][2][4][2], const Unit&, int, int, int, int) const {}
    __device__ __forceinline__ void operator()(const f32x4 (&acc)[2][2][4][2], const Unit& u, int wr, int wc, int fr, int fq) const {
        const int t = u.pn >> 1; bf16_t* base = O + (size_t)t * tstride; const float sc = (t == 2) ? qscale : 1.f;
        const int row0 = u.pm * BM + wr * 64 + fr, col0 = (u.pn & 1) * BM + wc * 32 + 8 * fq;
#pragma unroll
        for (int ai = 0; ai < 2; ++ai)
#pragma unroll
            for (int m = 0; m < 4; ++m) { bf16_t* rowp = base + (size_t)(row0 + ai * HALF + m * 16) * 512 + col0;
#pragma unroll
                for (int bj = 0; bj < 2; ++bj) { const f32x4 v0 = acc[ai][bj][m][0] * sc, v1 = acc[ai][bj][m][1] * sc;
                    u32x4 w; w.x = cvt_pk_bf16(v0[0], v0[1]); w.y = cvt_pk_bf16(v0[2], v0[3]); w.z = cvt_pk_bf16(v1[0], v1[1]); w.w = cvt_pk_bf16(v1[2], v1[3]);
                    *(u32x4*)(rowp + bj * HALF) = w; } }
    }
};
struct EpiOut {
    static constexpr bool PERM = true, MID = true; static constexpr int NST = 0;
    bf16_t* Y; const float* ssq;
    __device__ __forceinline__ void mid(f32x4 (&acc)[2][2][4][2], const Unit& u, int wr, int wc, int fr, int fq) const {
#pragma unroll
        for (int ai = 0; ai < 2; ++ai)
#pragma unroll
            for (int m = 0; m < 4; ++m) { const int row = u.pm * BM + ai * HALF + wr * 64 + m * 16 + fr;
                const f32x4 s0 = *(const f32x4*)(ssq + (size_t)row * 8), s1 = *(const f32x4*)(ssq + (size_t)row * 8 + 4);
                const float tot = ((s0[0] + s0[1]) + (s0[2] + s0[3])) + ((s1[0] + s1[1]) + (s1[2] + s1[3]));
                const float ri = 1.0f / sqrtf(tot * (1.0f / DATT) + RMS_EPS);
#pragma unroll
                for (int bj = 0; bj < 2; ++bj)
#pragma unroll
                    for (int n = 0; n < 2; ++n) acc[ai][bj][m][n] = acc[ai][bj][m][n] * ri; }
    }
    __device__ __forceinline__ void operator()(const f32x4 (&acc)[2][2][4][2], const Unit& u, int wr, int wc, int fr, int fq) const {
        const int row0 = u.pm * BM + wr * 64 + fr, col0 = u.pn * BM + wc * 32 + 8 * fq;
#pragma unroll
        for (int ai = 0; ai < 2; ++ai)
#pragma unroll
            for (int m = 0; m < 4; ++m) { bf16_t* rowp = Y + (size_t)(row0 + ai * HALF + m * 16) * DM + col0;
#pragma unroll
                for (int bj = 0; bj < 2; ++bj) { const f32x4 v0 = acc[ai][bj][m][0], v1 = acc[ai][bj][m][1];
                    u32x4 w; w.x = cvt_pk_bf16(v0[0], v0[1]); w.y = cvt_pk_bf16(v0[2], v0[3]); w.z = cvt_pk_bf16(v1[0], v1[1]); w.w = cvt_pk_bf16(v1[2], v1[3]);
                    *(u32x4*)(rowp + bj * HALF) = w; } }
    }
};
template <bool STORE = true> struct EpiUpT {
    static constexpr bool PERM = true, MID = false; static constexpr int NST = STORE ? 8 : 0;
    unsigned char* ACT; const PG8_LAS float* bias;
    __device__ __forceinline__ void mid(f32x4 (&)[2][2][4][2], const Unit&, int, int, int, int) const {}
    __device__ __forceinline__ void operator()(const f32x4 (&acc)[2][2][4][2], const Unit& u, int wr, int wc, int fr, int fq) const {
        const int row0 = u.pm * BM + wr * 64 + fr, col0 = u.pn * HALF + wc * 32 + 8 * fq;
        const PG8_LAS float* bg = bias + u.ord * 256 + wc * 32 + 8 * fq;
        f32x4 bgl[2], bli[2];
#pragma unroll
        for (int n = 0; n < 2; ++n) { bgl[n] = *(const PG8_LAS f32x4*)(bg + 4 * n); bli[n] = *(const PG8_LAS f32x4*)(bg + HALF + 4 * n) + 1.0f; }
#pragma unroll
        for (int ai = 0; ai < 2; ++ai)
#pragma unroll
            for (int m = 0; m < 4; ++m) { unsigned char* rowp = ACT + (size_t)(row0 + ai * HALF + m * 16) * DEXP + col0;
                f32x4 o[2];
#pragma unroll
                for (int n = 0; n < 2; ++n) { f32x4 g = acc[ai][0][m][n] + bgl[n], l = acc[ai][1][m][n] + bli[n];
#pragma unroll
                    for (int j = 0; j < 4; ++j) { g[j] = fminf(g[j], 7.0f); l[j] = __builtin_amdgcn_fmed3f(l[j], -6.0f, 8.0f); }
                    f32x4 t = g * (-1.702f * 1.4426950408889634f);
#pragma unroll
                    for (int j = 0; j < 4; ++j) t[j] = __builtin_amdgcn_exp2f(t[j]);
                    t = t + 1.0f;
#pragma unroll
                    for (int j = 0; j < 4; ++j) t[j] = __builtin_amdgcn_rcpf(t[j]);
                    o[n] = (g * t) * l; }
                int w0 = 0, w1 = 0; w0 = __builtin_amdgcn_cvt_pk_fp8_f32(o[0][0], o[0][1], w0, false); w0 = __builtin_amdgcn_cvt_pk_fp8_f32(o[0][2], o[0][3], w0, true);
                w1 = __builtin_amdgcn_cvt_pk_fp8_f32(o[1][0], o[1][1], w1, false); w1 = __builtin_amdgcn_cvt_pk_fp8_f32(o[1][2], o[1][3], w1, true);
                typedef int i32x2_ __attribute__((ext_vector_type(2))); if (STORE) *(i32x2_*)rowp = (i32x2_){w0, w1}; else asm volatile("" :: "v"(w0), "v"(w1)); }
    }
};
typedef EpiUpT<true> EpiUp;
struct EpiDown {
    static constexpr bool PERM = true, MID = false; static constexpr int NST = 16;
    unsigned char* YP; const PG8_LAS float* bias; const int* row_pair; const float* row_w;
    __device__ __forceinline__ void mid(f32x4 (&)[2][2][4][2], const Unit&, int, int, int, int) const {}
    __device__ __forceinline__ void operator()(const f32x4 (&acc)[2][2][4][2], const Unit& u, int wr, int wc, int fr, int fq) const {
        const int row0 = u.pm * BM + wr * 64 + fr, col0 = u.pn * BM + wc * 32 + 8 * fq;
        const PG8_LAS float* bd = bias + u.ord * 256 + wc * 32 + 8 * fq;
        f32x4 bv[2][2];
#pragma unroll
        for (int bj = 0; bj < 2; ++bj)
#pragma unroll
            for (int n = 0; n < 2; ++n) bv[bj][n] = *(const PG8_LAS f32x4*)(bd + bj * HALF + 4 * n);
        int pr[2][4]; float wt[2][4];
#pragma unroll
        for (int ai = 0; ai < 2; ++ai)
#pragma unroll
            for (int m = 0; m < 4; ++m) { const int pos = row0 + ai * HALF + m * 16; pr[ai][m] = row_pair[pos]; wt[ai][m] = row_w[pos] * 4.0f; }
#pragma unroll
        for (int ai = 0; ai < 2; ++ai)
#pragma unroll
            for (int m = 0; m < 4; ++m) { const int pair = pr[ai][m] >= 0 ? pr[ai][m] : NTOK * TOPK; const float w = wt[ai][m];
                { unsigned char* rowp = YP + (size_t)pair * DM + col0;
#pragma unroll
                    for (int bj = 0; bj < 2; ++bj) { const f32x4 v0 = (acc[ai][bj][m][0] + bv[bj][0]) * w, v1 = (acc[ai][bj][m][1] + bv[bj][1]) * w;
                        int q0 = 0, q1 = 0; q0 = __builtin_amdgcn_cvt_pk_fp8_f32(v0[0], v0[1], q0, false); q0 = __builtin_amdgcn_cvt_pk_fp8_f32(v0[2], v0[3], q0, true);
                        q1 = __builtin_amdgcn_cvt_pk_fp8_f32(v1[0], v1[1], q1, false); q1 = __builtin_amdgcn_cvt_pk_fp8_f32(v1[2], v1[3], q1, true);
                        typedef int i32x2_ __attribute__((ext_vector_type(2))); *(i32x2_*)(rowp + bj * HALF) = (i32x2_){q0, q1}; } } }
    }
};
#ifdef MK_PROBES
struct EpiNop {
    static constexpr bool PERM = true, MID = false; static constexpr int NST = 0;
    __device__ __forceinline__ void mid(f32x4 (&)[2][2][4][2], const Unit&, int, int, int, int) const {}
    __device__ __forceinline__ void operator()(const f32x4 (&)[2][2][4][2], const Unit&, int, int, int, int) const {}
};
#endif
}

namespace attn_body {
using bf16=__hip_bfloat16;
using bf16x8=__attribute__((ext_vector_type(8)))short;
using s16x4=__attribute__((ext_vector_type(4)))short;
using f32x16=__attribute__((ext_vector_type(16)))float;
using u32x4=__attribute__((ext_vector_type(4)))unsigned;
constexpr int BATCH=8,NHEAD=8,SEQ=2048,D=64,DM=NHEAD*D,OPITCH=1024;
constexpr int NW=8,QBLK=32,QB=QBLK*NW,KVBLK=64,NQB=SEQ/QB;
constexpr int ATTN_PITCH=DM, ATTN_UNIT_ROWS=QB;
__device__ __forceinline__ int crow(int r,int hi){return (r&3)+8*(r>>2)+4*hi;}
#define SBAR() __builtin_amdgcn_sched_barrier(0)
__device__ __forceinline__ void cmask(f32x16&p0,f32x16&p1,int jb,int qrel,int hi){
  const float NEG=-INFINITY; int kb=64*jb+4*hi;
  #pragma unroll
  for(int r=0;r<16;++r){int kv=kb+(r&3)+8*(r>>2); if(kv>qrel)p0[r]=NEG; if(kv+32>qrel)p1[r]=NEG;}
}

constexpr int NSLOT=3, SLOTB=8192;
constexpr int LDS_K=0, LDS_V=NSLOT*SLOTB, LDS_WS=2*NSLOT*SLOTB, LDS_OST=LDS_WS+NW*64*4, LDS_BIAS=LDS_OST+NW*4096, LDS_SCAN=LDS_BIAS+(SEQ+64)*4, LDS_BYTES=LDS_SCAN+256;
constexpr float C2=0.125f*1.4426950408889634f;
__device__ __forceinline__ void glds16(const void*gsrc,unsigned lds_dst){unsigned keep;
  asm volatile("s_mov_b32 %0, m0\n\ts_mov_b32 m0, %2\n\ts_nop 0\n\tglobal_load_lds_dwordx4 %1, off\n\ts_mov_b32 m0, %0":"=&s"(keep):"v"(gsrc),"s"(lds_dst):"memory");}
__device__ __forceinline__ float max3f(float a,float b,float c){float r;asm("v_max3_f32 %0, %1, %2, %3":"=v"(r):"v"(a),"v"(b),"v"(c));return r;}
__device__ __forceinline__ float max2f(float a,float b){float r;asm("v_max_f32_e32 %0, %1, %2":"=v"(r):"v"(a),"v"(b));return r;}
__device__ __forceinline__ float fadd_s(float a,float b){float r;asm("v_add_f32_e32 %0, %1, %2":"=v"(r):"v"(a),"v"(b));return r;}
__device__ __forceinline__ float fsub_s(float a,float b){float r;asm("v_sub_f32_e32 %0, %1, %2":"=v"(r):"v"(a),"v"(b));return r;}
typedef float f32x2_t __attribute__((ext_vector_type(2))); typedef float f32x4_t __attribute__((ext_vector_type(4))); typedef __bf16 bf16x2_t __attribute__((ext_vector_type(2)));
__device__ __forceinline__ unsigned cvtpk_s(float lo,float hi){f32x2_t v={lo,hi};bf16x2_t b=__builtin_convertvector(v,bf16x2_t);return __builtin_bit_cast(unsigned,b);}
#define WAIT_BAR(N) asm volatile("s_waitcnt vmcnt(" #N ") lgkmcnt(0)\n\ts_barrier":::"memory")

__device__ __forceinline__ void qkt(f32x16&p0,f32x16&p1,const char*Kslot,const bf16x8*qr,int r32,int hi){
  const char*kb=Kslot+hi*1024+r32*16;
  #pragma unroll
  for(int d0=0;d0<4;++d0){
    const bf16x8 b0=*reinterpret_cast<const bf16x8*>(kb+d0*2048);
    const bf16x8 b1=*reinterpret_cast<const bf16x8*>(kb+d0*2048+512);
    p0=__builtin_amdgcn_mfma_f32_32x32x16_bf16(b0,qr[d0],p0,0,0,0);p1=__builtin_amdgcn_mfma_f32_32x32x16_bf16(b1,qr[d0],p1,0,0,0);}
}
typedef __attribute__((address_space(3))) const char* lds_cptr;
typedef short v4i16_t __attribute__((ext_vector_type(4)));
__device__ __forceinline__ void kload8(bf16x8*kf,lds_cptr kp){
  kf[0]=*(const __attribute__((address_space(3))) bf16x8*)(kp);      kf[1]=*(const __attribute__((address_space(3))) bf16x8*)(kp+512);
  kf[2]=*(const __attribute__((address_space(3))) bf16x8*)(kp+2048); kf[3]=*(const __attribute__((address_space(3))) bf16x8*)(kp+2560);
  kf[4]=*(const __attribute__((address_space(3))) bf16x8*)(kp+4096); kf[5]=*(const __attribute__((address_space(3))) bf16x8*)(kp+4608);
  kf[6]=*(const __attribute__((address_space(3))) bf16x8*)(kp+6144); kf[7]=*(const __attribute__((address_space(3))) bf16x8*)(kp+6656);
}
__device__ __forceinline__ void kload2(bf16x8*kf,lds_cptr kp,int j){ kf[2*j]=*(const __attribute__((address_space(3))) bf16x8*)(kp+j*2048); kf[2*j+1]=*(const __attribute__((address_space(3))) bf16x8*)(kp+j*2048+512); }
__device__ __forceinline__ s16x4 vtr(lds_cptr p){ return __builtin_bit_cast(s16x4,__builtin_amdgcn_ds_read_tr16_b64_v4i16((__attribute__((address_space(3))) v4i16_t*)p)); }
__device__ __forceinline__ float rowmax(const f32x16&p0,const f32x16&p1){
  float a=max3f(p0[0],p0[1],p1[0]),b=max3f(p0[2],p0[3],p1[1]);a=max3f(a,p1[2],p1[3]);
  #pragma unroll
  for(int r=4;r<16;r+=4){a=max3f(a,p0[r],p0[r+1]);b=max3f(b,p0[r+2],p0[r+3]);a=max3f(a,p1[r],p1[r+1]);b=max3f(b,p1[r+2],p1[r+3]);}
  const float m=max2f(a,b);
  auto rr=__builtin_amdgcn_permlane32_swap(__float_as_uint(m),__float_as_uint(m),false,false);
  return max2f(__uint_as_float(rr[0]),__uint_as_float(rr[1]));
}
__device__ __forceinline__ void pv(f32x16*o,int vb,bf16x8 pa0,bf16x8 pa1,bf16x8 pa2,bf16x8 pa3){
  #pragma unroll
  for(int d0=0;d0<2;++d0){s16x4 lo[4],hi[4];
    #pragma unroll
    for(int ks=0;ks<4;++ks){
      asm volatile("ds_read_b64_tr_b16 %0,%1 offset:%c2":"=&v"(lo[ks]):"v"(vb),"i"(d0*4096+ks*1024):"memory");
      asm volatile("ds_read_b64_tr_b16 %0,%1 offset:%c2":"=&v"(hi[ks]):"v"(vb),"i"(d0*4096+ks*1024+512):"memory");}
    asm volatile("s_waitcnt lgkmcnt(0)":::"memory");SBAR();
    #define PK(k) (bf16x8){lo[k][0],lo[k][1],lo[k][2],lo[k][3],hi[k][0],hi[k][1],hi[k][2],hi[k][3]}
    o[d0]=__builtin_amdgcn_mfma_f32_32x32x16_bf16(pa0,PK(0),o[d0],0,0,0);
    o[d0]=__builtin_amdgcn_mfma_f32_32x32x16_bf16(pa1,PK(1),o[d0],0,0,0);
    o[d0]=__builtin_amdgcn_mfma_f32_32x32x16_bf16(pa2,PK(2),o[d0],0,0,0);
    o[d0]=__builtin_amdgcn_mfma_f32_32x32x16_bf16(pa3,PK(3),o[d0],0,0,0);
    #undef PK
  }
}

#ifndef ATTN_STORE16
#define ATTN_STORE16(p,v) (*(u32x4*)(p)=(v))
#endif
template<int THRL> __device__ __forceinline__ void attn_unit(int b,int h,int qb,const bf16*Q,const bf16*__restrict__ K,const bf16*__restrict__ V,bf16*O,const float*__restrict__ LOGF2,float*SSQ,char*shm){
  const int tid=threadIdx.x,lane=tid&63,r32=lane&31,hi=lane>>5; const int wid=__builtin_amdgcn_readfirstlane(tid>>6);
  const long rowbase=(long)b*SEQ; const int q0=qb*QB;
  const bf16*Qw=Q+(rowbase+q0+wid*QBLK)*DM+h*D;
  const bf16*Kh=K+rowbase*DM+h*D,*Vh=V+rowbase*DM+h*D;
  const unsigned lds0=(unsigned)(uintptr_t)shm;
  float*wsf=(float*)(shm+LDS_WS)+wid*64;
  const bf16*ksrc=Kh+(long)lane*DM+wid*8;
  const bf16*vsrc=Vh+(long)(16*(wid&3)+(lane>>2))*DM+(wid>>2)*32+(lane&3)*8;
  const unsigned kdst=lds0+LDS_K+wid*1024, vdst=lds0+LDS_V+wid*1024;
  #define DMA_K(t,slot) glds16(ksrc+(long)(t)*KVBLK*DM,(unsigned)__builtin_amdgcn_readfirstlane(kdst+(slot)))
  #define DMA_V(t,slot) glds16(vsrc+(long)(t)*KVBLK*DM,(unsigned)__builtin_amdgcn_readfirstlane(vdst+(slot)))
  const int vb0=(int)(lds0+LDS_V)+((lane>>4)&1)*32+(lane&3)*8+(4*hi+((lane&15)>>2))*64;
  const char*Kbase=shm+LDS_K; bf16x8 kf[8];
  const lds_cptr shm3=(lds_cptr)shm; const lds_cptr kp0=shm3+LDS_K+hi*1024+r32*16; const lds_cptr vp0=shm3+LDS_V+((lane>>4)&1)*32+(lane&3)*8+(4*hi+((lane&15)>>2))*64;
  const int NT=(q0+QB)/KVBLK;
  const lds_cptr biasr=(lds_cptr)shm+LDS_BIAS+16*hi;
  #define BIAS4(t,o) (*(const __attribute__((address_space(3))) f32x4_t*)(biasr+(t)*(KVBLK*4)+(o)*4))
  #define INIT4(Y,g,t,o) do{ const f32x4_t x_=BIAS4(t,(o)+8*(g)); Y[4*(g)]=x_[0]-mhat; Y[4*(g)+1]=x_[1]-mhat; Y[4*(g)+2]=x_[2]-mhat; Y[4*(g)+3]=x_[3]-mhat; }while(0)
  #define INITT(Y0,Y1,t) do{ INIT4(Y0,0,t,0);INIT4(Y0,1,t,0);INIT4(Y0,2,t,0);INIT4(Y0,3,t,0); INIT4(Y1,0,t,32);INIT4(Y1,1,t,32);INIT4(Y1,2,t,32);INIT4(Y1,3,t,32); }while(0)
  DMA_K(0,0);DMA_V(0,0);DMA_K(1,SLOTB);
  bf16x8 qr[4];
  #pragma unroll
  for(int d0=0;d0<4;++d0)qr[d0]=*reinterpret_cast<const bf16x8*>(&Qw[(long)r32*DM+d0*16+hi*8]);
  float mhat,l_reg=0.f;f32x16 o[2];o[0]=f32x16{};o[1]=f32x16{};
  const int qrel=wid*QBLK+r32;
  #define CMASK(P0,P1,t) do{int jb_=(t)-(NT-4); if(jb_>=0)cmask(P0,P1,jb_,qrel,hi);}while(0)
  bool resc=false;
  #define START(P0,P1) do{ const float rm=rowmax(P0,P1); resc=false; \
    { const float dl=__builtin_fmaxf(rm,0.f); mhat=fadd_s(mhat,dl); \
      _Pragma("unroll") for(int r=0;r<16;++r){P0[r]=fsub_s(P0[r],dl);P1[r]=fsub_s(P1[r],dl);} } \
    _Pragma("unroll") for(int r=0;r<16;++r)P0[r]=__builtin_amdgcn_exp2f(P0[r]); }while(0)
  #define RESC() do{ if(resc){ asm volatile("s_waitcnt lgkmcnt(0)":::"memory"); \
      _Pragma("unroll") for(int d_=0;d_<2;++d_) _Pragma("unroll") for(int r=0;r<16;++r)o[d_][r]*=wsf[crow(r,hi)]; } }while(0)
  f32x16 pA0,pA1,pB0,pB1;
  int sl_prev=0,sl_cur=0,sl_next=SLOTB;
  #define ROT() do{sl_prev=sl_cur;sl_cur=sl_next;sl_next=(sl_next==(NSLOT-1)*SLOTB)?0:sl_next+SLOTB;}while(0)
  DMA_K(2,2*SLOTB);
  { float*biasl=(float*)(shm+LDS_BIAS); float*scn=(float*)(shm+LDS_SCAN);
    const float*lf=LOGF2+rowbase*NHEAD+h;
    float v0=0.f,v1=0.f,v2=0.f,v3=0.f; const int i0=4*tid;
    if(i0<q0){ v0=lf[(long)(q0-1-i0)*NHEAD]; v1=lf[(long)(q0-2-i0)*NHEAD]; v2=lf[(long)(q0-3-i0)*NHEAD]; v3=lf[(long)(q0-4-i0)*NHEAD]; }
    const float tsum=(v0+v1)+(v2+v3); float inc=tsum;
    #pragma unroll
    for(int o=1;o<64;o<<=1){ const float n_=__shfl_up(inc,o); if(lane>=o)inc+=n_; }
    if(lane==63)scn[wid]=inc;
    const float f0=lf[(long)(q0+4*lane)*NHEAD],f1=lf[(long)(q0+4*lane+1)*NHEAD],f2=lf[(long)(q0+4*lane+2)*NHEAD],f3=lf[(long)(q0+4*lane+3)*NHEAD];
    float finc=(f0+f1)+(f2+f3);
    #pragma unroll
    for(int o=1;o<64;o<<=1){ const float n_=__shfl_up(finc,o); if(lane>=o)finc+=n_; }
    const float fex=finc-((f0+f1)+(f2+f3));
    if(wid==0){ biasl[q0+4*lane]=-(fex+f0); biasl[q0+4*lane+1]=-(fex+f0+f1); biasl[q0+4*lane+2]=-(fex+f0+f1+f2); biasl[q0+4*lane+3]=-(fex+f0+f1+f2+f3); }
    __syncthreads();
    float woff=0.f;
    #pragma unroll
    for(int w_=0;w_<NW;++w_) woff+=(w_<wid)?scn[w_]:0.f;
    const float ex=woff+inc-tsum;
    if(i0<q0){ biasl[q0-1-i0]=ex; biasl[q0-2-i0]=ex+v0; biasl[q0-3-i0]=ex+v0+v1; biasl[q0-4-i0]=ex+v0+v1+v2; }
    __syncthreads(); }
  mhat=((const float*)(shm+LDS_BIAS))[q0+wid*QBLK+r32]+8.0f;

  WAIT_BAR(3);
  INITT(pA0,pA1,0); qkt(pA0,pA1,Kbase,qr,r32,hi);asm volatile("s_nop 15\n\ts_nop 7":"+v"(pA0),"+v"(pA1));CMASK(pA0,pA1,0);
  START(pA0,pA1);
  _Pragma("unroll") for(int r=0;r<16;++r)pA1[r]=__builtin_amdgcn_exp2f(pA1[r]);
  INITT(pB0,pB1,1);
  WAIT_BAR(0);
  DMA_K(3,0);DMA_V(1,SLOTB);
  ROT();
  kload8(kf,kp0+sl_cur);
  WAIT_BAR(2);
  s16x4 vlo[8],vhi[8]; u32x4 pw0,pw1,pw2,pw3;
  #define PKW(P,B) cvtpk_s(P[B],P[B+1])
  #define PAF(k) __builtin_bit_cast(bf16x8,pw##k)
  #define VFR(i) (bf16x8){vlo[i][0],vlo[i][1],vlo[i][2],vlo[i][3],vhi[i][0],vhi[i][1],vhi[i][2],vhi[i][3]}
  #define PIN(x) asm volatile("":"+v"(x))
  #define MX3(a,b,c) __builtin_fmaxf(__builtin_fmaxf((a),(b)),(c))
  #define GAPA(MF,A0,A1,A2,A3,W0,W1,PW) do{ MF; sacc+=A0; sacc+=A1; sacc+=A2; sacc+=A3; PIN(sacc); W0; W1; PIN(PW); SBAR(); }while(0)
  #define EX(v) __builtin_amdgcn_exp2f(v)
  #define GAPB(MF,X,B,GN,Y,tn,o) do{ MF; X[B]=EX(X[B]); X[B+1]=EX(X[B+1]); X[B+2]=EX(X[B+2]); X[B+3]=EX(X[B+3]); PIN(X); if(GN){ INIT4(Y,(B)/4,tn,o); PIN(Y); } SBAR(); }while(0)
  #define VRD(i) do{ vlo[i]=vtr(vp_+(((i)>>2)*4096+((i)&3)*1024)); vhi[i]=vtr(vp_+(((i)>>2)*4096+((i)&3)*1024+512)); }while(0)
  #define KRD(G,j) do{ if(G){ kload2(kf,kp0+sl_next,j); SBAR(); } }while(0)
  #define STEP(C0,C1,P0,P1,t,GK,GV,GL) do{ SBAR(); \
    const lds_cptr vp_=vp0+sl_prev; \
    VRD(0); SBAR(); float sacc=(P0[0]+P0[1]); \
    GAPA(C0=__builtin_amdgcn_mfma_f32_32x32x16_bf16(kf[0],qr[0],C0,0,0,0), P0[2],P0[3],P0[4],P0[5],     pw0[0]=PKW(P0,0), pw0[1]=PKW(P0,2), pw0); \
    VRD(4); SBAR(); GAPA(C1=__builtin_amdgcn_mfma_f32_32x32x16_bf16(kf[1],qr[0],C1,0,0,0), P0[6],P0[7],P0[8],P0[9],     pw0[2]=PKW(P0,4), pw0[3]=PKW(P0,6), pw0); \
    VRD(1); SBAR(); GAPA(C0=__builtin_amdgcn_mfma_f32_32x32x16_bf16(kf[2],qr[1],C0,0,0,0),   P0[10],P0[11],P0[12],P0[13], pw1[0]=PKW(P0,8), pw1[1]=PKW(P0,10), pw1); \
    VRD(5); SBAR(); GAPA(C1=__builtin_amdgcn_mfma_f32_32x32x16_bf16(kf[3],qr[1],C1,0,0,0),   P0[14],P0[15],P1[0],P1[1],   pw1[2]=PKW(P0,12),pw1[3]=PKW(P0,14), pw1); \
    VRD(2); SBAR(); GAPA(C0=__builtin_amdgcn_mfma_f32_32x32x16_bf16(kf[4],qr[2],C0,0,0,0),   P1[2],P1[3],P1[4],P1[5],     pw2[0]=PKW(P1,0), pw2[1]=PKW(P1,2), pw2); \
    VRD(6); SBAR(); GAPA(C1=__builtin_amdgcn_mfma_f32_32x32x16_bf16(kf[5],qr[2],C1,0,0,0),   P1[6],P1[7],P1[8],P1[9],     pw2[2]=PKW(P1,4), pw2[3]=PKW(P1,6), pw2); \
    VRD(3); SBAR(); GAPA(C0=__builtin_amdgcn_mfma_f32_32x32x16_bf16(kf[6],qr[3],C0,0,0,0),   P1[10],P1[11],P1[12],P1[13], pw3[0]=PKW(P1,8), pw3[1]=PKW(P1,10), pw3); \
    VRD(7); SBAR(); GAPA(C1=__builtin_amdgcn_mfma_f32_32x32x16_bf16(kf[7],qr[3],C1,0,0,0),   P1[14],P1[15],0.f,0.f,       pw3[2]=PKW(P1,12),pw3[3]=PKW(P1,14), pw3); \
    l_reg+=sacc; \
    if(GK){DMA_K((t)+3,sl_cur);} if(GV){DMA_V((t)+1,sl_next);} \
    CMASK(C0,C1,t); \
    { float a=MX3(C0[0],C0[1],C1[0]),b=MX3(C0[2],C0[3],C1[1]); a=MX3(a,C1[2],C1[3]); \
      _Pragma("unroll") for(int r=4;r<16;r+=4){a=MX3(a,C0[r],C0[r+1]);b=MX3(b,C0[r+2],C0[r+3]);a=MX3(a,C1[r],C1[r+1]);b=MX3(b,C1[r+2],C1[r+3]);} \
      float rm=__builtin_fmaxf(a,b); { auto rr=__builtin_amdgcn_permlane32_swap(__float_as_uint(rm),__float_as_uint(rm),false,false); rm=__builtin_fmaxf(__uint_as_float(rr[0]),__uint_as_float(rr[1])); } \
      resc=false; \
      if(__builtin_expect(__any(rm>(float)THRL),0)){ const float dl=__builtin_fmaxf(rm,0.f); mhat+=dl; \
        _Pragma("unroll") for(int r=0;r<16;++r){C0[r]-=dl;C1[r]-=dl;} \
        const float f=__builtin_amdgcn_exp2f(-dl); l_reg*=f; if(hi==0)wsf[r32]=f; resc=true; } } \
    SBAR(); \
    GAPB(o[0]=__builtin_amdgcn_mfma_f32_32x32x16_bf16(PAF(0),VFR(0),o[0],0,0,0), C0,0,  GL,P0,(t)+1,0); \
    GAPB(o[1]=__builtin_amdgcn_mfma_f32_32x32x16_bf16(PAF(0),VFR(4),o[1],0,0,0), C0,4,  GL,P0,(t)+1,0); \
    KRD(GL,0); GAPB(o[0]=__builtin_amdgcn_mfma_f32_32x32x16_bf16(PAF(1),VFR(1),o[0],0,0,0), C0,8,  GL,P0,(t)+1,0); \
    KRD(GL,1); GAPB(o[1]=__builtin_amdgcn_mfma_f32_32x32x16_bf16(PAF(1),VFR(5),o[1],0,0,0), C0,12, GL,P0,(t)+1,0); \
    KRD(GL,2); GAPB(o[0]=__builtin_amdgcn_mfma_f32_32x32x16_bf16(PAF(2),VFR(2),o[0],0,0,0), C1,0,  GL,P1,(t)+1,32); \
    KRD(GL,3); GAPB(o[1]=__builtin_amdgcn_mfma_f32_32x32x16_bf16(PAF(2),VFR(6),o[1],0,0,0), C1,4,  GL,P1,(t)+1,32); \
    GAPB(o[0]=__builtin_amdgcn_mfma_f32_32x32x16_bf16(PAF(3),VFR(3),o[0],0,0,0), C1,8,  GL,P1,(t)+1,32); \
    GAPB(o[1]=__builtin_amdgcn_mfma_f32_32x32x16_bf16(PAF(3),VFR(7),o[1],0,0,0), C1,12, GL,P1,(t)+1,32); \
    }while(0)
  int t=1;
  #undef CMASK
  #define CMASK(P0,P1,t) do{}while(0)
  for(;t+5<NT;t+=2){
    STEP(pB0,pB1,pA0,pA1,t,true,true,true);     WAIT_BAR(2); RESC(); ROT();
    STEP(pA0,pA1,pB0,pB1,t+1,true,true,true);   WAIT_BAR(2); RESC(); ROT();
  }
  #undef CMASK
  #define CMASK(P0,P1,t) do{int jb_=(t)-(NT-4); if(jb_>=0)cmask(P0,P1,jb_,qrel,hi);}while(0)
  #define ENDW(tt) do{ if((tt)+3<NT){WAIT_BAR(2);} else if((tt)+2<NT){WAIT_BAR(1);} else {WAIT_BAR(0);} }while(0)
  for(;t+1<NT;t+=2){
    STEP(pB0,pB1,pA0,pA1,t,(t+3<NT),(t+1<NT),(t+1<NT));       ENDW(t);   RESC(); ROT();
    STEP(pA0,pA1,pB0,pB1,t+1,(t+4<NT),(t+2<NT),(t+2<NT));     ENDW(t+1); RESC(); ROT();
  }
  STEP(pB0,pB1,pA0,pA1,NT-1,false,false,false); RESC();
  { float sacc=pB0[0]+pB0[1]; _Pragma("unroll") for(int r=2;r<16;++r)sacc+=pB0[r]; _Pragma("unroll") for(int r=0;r<16;++r)sacc+=pB1[r]; l_reg+=sacc;
    pw0=(u32x4){PKW(pB0,0),PKW(pB0,2),PKW(pB0,4),PKW(pB0,6)};pw1=(u32x4){PKW(pB0,8),PKW(pB0,10),PKW(pB0,12),PKW(pB0,14)};pw2=(u32x4){PKW(pB1,0),PKW(pB1,2),PKW(pB1,4),PKW(pB1,6)};pw3=(u32x4){PKW(pB1,8),PKW(pB1,10),PKW(pB1,12),PKW(pB1,14)};
    SBAR(); pv(o,vb0+sl_cur,PAF(0),PAF(1),PAF(2),PAF(3)); }
  #undef PKW
  #undef PAF
  #undef VFR
  #undef PIN
  #undef MX3
  #undef GAPA
  #undef GAPB
  #undef EX
  #undef VRD
  #undef KRD
  #undef STEP
  #undef ENDW
  {auto rr=__builtin_amdgcn_permlane32_swap(__float_as_uint(l_reg),__float_as_uint(l_reg),false,false);l_reg=__uint_as_float(rr[0])+__uint_as_float(rr[1]);}
  if(hi==0)wsf[32+r32]=l_reg;asm volatile("s_waitcnt lgkmcnt(0)":::"memory");
  float rli[16];
  #pragma unroll
  for(int r=0;r<16;++r)rli[r]=__builtin_amdgcn_rcpf(wsf[32+crow(r,hi)]);
  bf16*Ow=O+(rowbase+q0+wid*QBLK)*OPITCH+h*D; float*Sw=SSQ+(rowbase+q0+wid*QBLK)*NHEAD+h;
  { bf16*stg=(bf16*)(shm+LDS_OST)+wid*2048;
    #pragma unroll
    for(int r=0;r<16;++r){const int orow=crow(r,hi);
      #pragma unroll
      for(int d0=0;d0<2;++d0)stg[orow*64+d0*32+r32]=__float2bfloat16(o[d0][r]*rli[r]);}
    asm volatile("s_waitcnt lgkmcnt(0)":::"memory");
    #pragma unroll
    for(int i=0;i<4;++i){const int row=i*8+(lane>>3),ch=lane&7; const u32x4 v=*(const u32x4*)(stg+row*64+ch*8); ATTN_STORE16(Ow+(long)row*OPITCH+ch*8,v);
      float sq=0.f;
      #pragma unroll
      for(int j=0;j<4;++j){ const float lo_=__uint_as_float(v[j]<<16), hi_=__uint_as_float(v[j]&0xffff0000u); sq+=lo_*lo_+hi_*hi_; }
      sq+=__shfl_xor(sq,1); sq+=__shfl_xor(sq,2); sq+=__shfl_xor(sq,4);
      if(ch==0)Sw[(long)row*NHEAD]=sq; } }
  asm volatile("s_waitcnt lgkmcnt(0)\n\ts_barrier":::"memory");
  #undef DMA_K
  #undef BIAS4
  #undef INIT4
  #undef INITT
  #undef DMA_V
  #undef CMASK
  #undef START
  #undef RESC
  #undef ROT
}
constexpr int ATTN_LDS_BYTES=LDS_BYTES;
struct AttnTensors { const bf16* Q; const bf16* K; const bf16* V; bf16* O; const float* LOGF2; float* SSQ; };
struct AttnUnit { int bh; int qb; };
struct StaticOrder {
  int vcu,G;
  __device__ __forceinline__ explicit StaticOrder(int grid,int vcu_):vcu(vcu_),G(grid){}
  __device__ __forceinline__ bool next(int i,AttnUnit&u)const{ const int L=(i>>1)*G+vcu; if(L>=BATCH*NHEAD*4)return false; const int s=L&3; u.bh=L>>2; u.qb=(i&1)?7-s:s; return true; }
  __device__ __forceinline__ void a_ready(const AttnUnit&)const{}
  __device__ __forceinline__ void done(const AttnUnit&)const{}
};
template<class Sched,int THRL=8> __device__ __forceinline__ void attn_phase(char*lds,const AttnTensors&T,const Sched&S){
  AttnUnit u;
  for(int i=0;S.next(i,u);++i){ S.a_ready(u); attn_unit<THRL>(u.bh/NHEAD,u.bh%NHEAD,u.qb,T.Q,T.K,T.V,T.O,T.LOGF2,T.SSQ,lds); S.done(u); }
}
#undef SBAR
#undef WAIT_BAR
}

constexpr int NWAVES = 8;
constexpr int NPHASES = 11;

constexpr size_t MiB = 1u << 20, KiB = 1u << 10;
constexpr size_t WS_CTL = 0, CTL_ZERO_BYTES = 1 * MiB;
constexpr size_t WS_MOD = 1 * MiB;
constexpr size_t WS_LOGF2 = 1 * MiB + 256 * KiB;
constexpr size_t WS_SSQ = 1 * MiB + 768 * KiB;
constexpr size_t WS_TOPI = 2 * MiB + 256 * KiB;
constexpr size_t WS_TOPW = 2 * MiB + 512 * KiB;
constexpr size_t WS_WGCNT = 2 * MiB + 768 * KiB;
constexpr size_t WS_LSUM = 3 * MiB;
constexpr size_t WS_ROWTOK = 4 * MiB, WS_ROWPAIR = 4 * MiB + 512 * KiB, WS_ROWW = 5 * MiB, WS_MTEXP = 5 * MiB + 512 * KiB;
constexpr size_t WS_LWT = 6 * MiB;
constexpr size_t WS_WFT = 6 * MiB + 512 * KiB;
constexpr size_t WS_WRT = 7 * MiB;
constexpr size_t WS_WIN = 8 * MiB;
constexpr size_t WS_WOUT = 13 * MiB;
constexpr size_t WS_WUP = 16 * MiB;
constexpr size_t WS_WDN = 144 * MiB;
constexpr size_t WS_H1 = 208 * MiB;
constexpr size_t WS_XMID = WS_H1;
constexpr size_t WS_PJ = 240 * MiB;
constexpr size_t PJ_STRIDE = (size_t)NTOK * 512;
constexpr size_t WS_MRG = 320 * MiB;
constexpr size_t WS_Y = 352 * MiB;
constexpr size_t WS_H2 = 416 * MiB;
constexpr size_t WS_ACT = 448 * MiB;
constexpr size_t WS_YP = 592 * MiB;
constexpr size_t WS_LTOK = 720 * MiB, WS_LPAIR = 722 * MiB, WS_LW = 724 * MiB;
constexpr size_t WS_END = 726 * MiB;
static_assert(WS_ACT + (size_t)MAXROWS * 1024 * 2 <= WS_YP && WS_YP + (size_t)NTOK * 4 * 1024 * 2 <= WS_END, "d_ws map");
constexpr int CW_CNT = 200000;
constexpr int CW_BAR = 4096;

constexpr int LDS_BYTES = 147456;
constexpr int LDSCTL_OFF = LDS_BYTES - 512, MISC_OFF = LDSCTL_OFF + 320;
constexpr int SCRATCH_BYTES = LDSCTL_OFF;

#define GAS __attribute__((address_space(1)))
#define LAS __attribute__((address_space(3)))
typedef unsigned short bf16;
typedef unsigned v4u __attribute__((ext_vector_type(4)));
typedef unsigned v2u __attribute__((ext_vector_type(2)));
typedef float f32x4 __attribute__((ext_vector_type(4)));
typedef float f32x16 __attribute__((ext_vector_type(16)));
typedef short bf16x8 __attribute__((ext_vector_type(8)));
typedef GAS unsigned gu32;
#define RLX_AGENT __ATOMIC_RELAXED, __HIP_MEMORY_SCOPE_AGENT
#define LDS_WAIT() asm volatile("s_waitcnt lgkmcnt(0)" ::: "memory")
#define VM_WAIT() asm volatile("s_waitcnt vmcnt(0)" ::: "memory")
typedef float f32x2_cv __attribute__((ext_vector_type(2))); typedef __bf16 bf16x2_cv __attribute__((ext_vector_type(2)));
__device__ __forceinline__ unsigned pk2(float lo, float hi) { const f32x2_cv v = {lo, hi}; return __builtin_bit_cast(unsigned, __builtin_convertvector(v, bf16x2_cv)); }
__device__ __forceinline__ unsigned f2bf(float f) { return pk2(f, 0.f) & 0xffffu; }
__device__ __forceinline__ float bflo(unsigned w) { return __uint_as_float(w << 16); }
__device__ __forceinline__ float bfhi(unsigned w) { return __uint_as_float(w & 0xffff0000u); }
__device__ __forceinline__ float bf1(bf16 h) { return __uint_as_float((unsigned)h << 16); }

#define XB_TMO      128
#define XB_XCNT(j)  (256  + 64 * (j))
#define XB_XSUB(j)  (1280 + 64 * (j))
#define XB_XFLAG    3328
#define XCD_BAR_WORDS 3456
#define XB_SPIN_CAP (1u << 18)
__device__ __forceinline__ unsigned xb_ld(unsigned* p)              { return __hip_atomic_load(p, __ATOMIC_RELAXED, __HIP_MEMORY_SCOPE_AGENT); }
__device__ __forceinline__ unsigned xb_add(unsigned* p, unsigned v) { return __hip_atomic_fetch_add(p, v, __ATOMIC_RELAXED, __HIP_MEMORY_SCOPE_AGENT); }
__device__ __forceinline__ unsigned xb_xcc_id() { return (unsigned)__builtin_amdgcn_s_getreg((3 << 11) | 20) & 0xFu; }
struct XcdBarrier { unsigned* bar; unsigned x; volatile LAS unsigned* st; };
__device__ __forceinline__ XcdBarrier xcd_barrier_post(unsigned* bar, volatile LAS unsigned* st) {
    XcdBarrier b; b.bar = bar; b.x = xb_xcc_id(); b.st = st;
    if (threadIdx.x == 0) (void)xb_add(&bar[XB_XCNT(b.x)], 1u);
    return b;
}
__device__ __forceinline__ void xcd_barrier_complete(unsigned* bar, unsigned x, unsigned& nloc, unsigned& mask) {
    const unsigned G = gridDim.x * gridDim.y * gridDim.z;
    unsigned sum, msk, mine, sp = 0u;
    for (;;) {
        sum = 0u; msk = 0u; mine = 0u;
#pragma unroll
        for (unsigned j = 0; j < 16; ++j) { const unsigned c = xb_ld(&bar[XB_XCNT(j)]); sum += c; msk |= (c > 0u) ? (1u << j) : 0u; mine = (j == x) ? c : mine; }
        if (sum == G) break;
        __builtin_amdgcn_s_sleep(1);
        if ((++sp & 255u) == 0u) { if (xb_ld(&bar[XB_TMO])) break; if (sp > XB_SPIN_CAP) { atomicAdd(&bar[XB_TMO], 1u); break; } }
    }
    nloc = mine > 0u ? mine : 1u; mask = msk | (1u << x);
}
template <class Hook> __device__ __forceinline__ void xcd_barrier(const XcdBarrier& b, const Hook& hook) {
    asm volatile("s_waitcnt vmcnt(0)" ::: "memory");
    __syncthreads();
    if (threadIdx.x >= 64) { hook(); asm volatile("s_waitcnt vmcnt(0)" ::: "memory"); }
    else {
        unsigned* bar = b.bar;
        const unsigned lane = threadIdx.x;
        unsigned want = 0u, mask = 0u;
        if (lane == 0) {
            __builtin_amdgcn_s_waitcnt(0);
            unsigned nloc = b.st[0], m = b.st[1];
            if (nloc == 0u) { xcd_barrier_complete(bar, b.x, nloc, m); b.st[0] = nloc; b.st[1] = m; }
            const unsigned old = xb_add(&bar[XB_XSUB(b.x)], 1u);
            const unsigned gen = old / nloc;
            if (old + 1u == (gen + 1u) * nloc) {
                __builtin_amdgcn_fence(__ATOMIC_RELEASE, "agent");
                asm volatile("s_waitcnt vmcnt(0)" ::: "memory");
                __hip_atomic_store(&bar[XB_XFLAG + b.x], gen + 1u, __ATOMIC_RELAXED, __HIP_MEMORY_SCOPE_AGENT);
            }
            want = gen + 1u; mask = m;
        }
        want = (unsigned)__builtin_amdgcn_readfirstlane((int)want); mask = (unsigned)__builtin_amdgcn_readfirstlane((int)mask);
        const bool mine = lane < 16u && ((mask >> (lane & 15u)) & 1u) != 0u;
        unsigned sp = 0u;
        for (;;) {
            unsigned v = want; if (mine) v = xb_ld(&bar[XB_XFLAG + lane]);
            if (__builtin_amdgcn_ballot_w64((int)(v - want) < 0) == 0ull) break;
            __builtin_amdgcn_s_sleep(1);
            if ((++sp & 255u) == 0u) { if (xb_ld(&bar[XB_TMO])) break; if (sp > XB_SPIN_CAP) { if (lane == 0) atomicAdd(&bar[XB_TMO], 1u); break; } }
        }
        __builtin_amdgcn_fence(__ATOMIC_ACQUIRE, "agent");
        asm volatile("s_waitcnt vmcnt(0)" ::: "memory");
    }
    __syncthreads();
}
__device__ __forceinline__ void xcd_barrier(const XcdBarrier& b) { xcd_barrier(b, [] {}); }

struct Args { const float* in[26]; float* out; unsigned char* ws; int ph_lo, ph_hi, li, pad; };
struct Frame {
    LAS unsigned char* lds;
    int tid, lane, wave, vcu, G;
    float* out; unsigned char* ws;
    __device__ __forceinline__ const float* in(int k) const { const LAS unsigned* t = (const LAS unsigned*)(lds + LDSCTL_OFF) + 2 * k;
        const unsigned lo = (unsigned)__builtin_amdgcn_readfirstlane((int)t[0]), hi = (unsigned)__builtin_amdgcn_readfirstlane((int)t[1]);
        return (const float*)(const GAS float*)(((unsigned long long)hi << 32) | lo); }
};
template <int CTRL> __device__ __forceinline__ float dpp_mov(float x) { return __builtin_bit_cast(float, __builtin_amdgcn_update_dpp(0, __builtin_bit_cast(int, x), CTRL, 0xF, 0xF, false)); }
__device__ __forceinline__ float lane_xor1(float x) { return dpp_mov<0xB1>(x); }
__device__ __forceinline__ float lane_xor2(float x) { return dpp_mov<0x4E>(x); }
__device__ __forceinline__ float lane_xor4(float x) { return dpp_mov<0x1B>(dpp_mov<0x141>(x)); }
__device__ __forceinline__ float lane_xor8(float x) { return dpp_mov<0x128>(x); }
__device__ __forceinline__ void swap_rows16(float& a, float& b) { asm volatile("s_nop 1\n\tv_permlane16_swap_b32 %0, %1" : "+v"(a), "+v"(b)); }
__device__ __forceinline__ void swap_half32(float& a, float& b) { asm volatile("s_nop 1\n\tv_permlane32_swap_b32 %0, %1" : "+v"(a), "+v"(b)); }
__device__ __forceinline__ float wave_sum(float v) {
    v += lane_xor1(v); v += lane_xor2(v); v += lane_xor4(v); v += lane_xor8(v);
    { float a = v, b = v; swap_rows16(a, b); v = a + b; }
    { float a = v, b = v; swap_half32(a, b); v = a + b; }
    return v;
}
__device__ __forceinline__ float wave_max(float v) {
    v = fmaxf(v, lane_xor1(v)); v = fmaxf(v, lane_xor2(v)); v = fmaxf(v, lane_xor4(v)); v = fmaxf(v, lane_xor8(v));
    { float a = v, b = v; swap_rows16(a, b); v = fmaxf(a, b); }
    { float a = v, b = v; swap_half32(a, b); v = fmaxf(a, b); }
    return v;
}
__device__ __forceinline__ float sigmoid_f(float x) { return __builtin_amdgcn_rcpf(1.0f + __builtin_amdgcn_exp2f(-1.4426950408889634f * x)); }
__device__ __forceinline__ float gelu_tanh_f(float x) { const float u = 0.7978845608028654f * (x + 0.044715f * x * x * x); const float e = __builtin_amdgcn_exp2f(2.8853900817779268f * u); return x * (1.0f - __builtin_amdgcn_rcpf(e + 1.0f)); }
__device__ __forceinline__ float log_sigmoid_f(float z) { return z >= 0.f ? -log1pf(expf(-z)) : z - log1pf(expf(z)); }
__device__ __forceinline__ float softplus_f(float z) { return z > 0.f ? z + log1pf(expf(-z)) : log1pf(expf(z)); }

__device__ __forceinline__ void p0_transpose_item(const float* W, int ldw, bf16* WT, int k0, int n0, int kdst0, const float* gain, LAS float* scr, int lane) {
#pragma unroll 8
    for (int i = 0; i < 32; ++i) { const int kk = 2 * i + (lane >> 5); float v = W[(size_t)(k0 + kk) * ldw + n0 + (lane & 31)]; if (gain) v *= gain[k0 + kk]; scr[kk * 33 + (lane & 31)] = v; }
    LDS_WAIT(); asm volatile("" ::: "memory");
    const int c = lane & 7;
#pragma unroll
    for (int j = 0; j < 4; ++j) { const int n = (lane >> 3) + 8 * j; const LAS float* s = scr + (8 * c) * 33 + n;
        v4u o; o.x = pk2(s[0 * 33], s[1 * 33]); o.y = pk2(s[2 * 33], s[3 * 33]); o.z = pk2(s[4 * 33], s[5 * 33]); o.w = pk2(s[6 * 33], s[7 * 33]);
        *(GAS v4u*)(WT + (size_t)(n0 + n) * 1024 + kdst0 + 8 * c) = o; }
    LDS_WAIT(); asm volatile("" ::: "memory");
}
constexpr int CV_UP_ITEMS = NE * 16 * 32, CV_DN_ITEMS = NE * 16 * 16;
constexpr int CV_UP_TAIL = 8192, CV_DN_TAIL = 4096;
__device__ __forceinline__ void cvt_block_f8(const float* W, int ldw, unsigned char* WT, LAS unsigned char* scr, int lane) {
    float v[64];
#pragma unroll
    for (int i = 0; i < 64; ++i) v[i] = W[(size_t)i * ldw + lane];
#pragma unroll
    for (int q = 0; q < 4; ++q) { int w[4];
#pragma unroll
        for (int j = 0; j < 4; ++j) { int t = 0; t = __builtin_amdgcn_cvt_pk_fp8_f32(v[16 * q + 4 * j] * 64.0f, v[16 * q + 4 * j + 1] * 64.0f, t, false); t = __builtin_amdgcn_cvt_pk_fp8_f32(v[16 * q + 4 * j + 2] * 64.0f, v[16 * q + 4 * j + 3] * 64.0f, t, true); w[j] = t; }
        *(LAS v4u*)(scr + lane * 80 + 16 * q) = (v4u){(unsigned)w[0], (unsigned)w[1], (unsigned)w[2], (unsigned)w[3]}; }
    LDS_WAIT(); asm volatile("" ::: "memory");
#pragma unroll
    for (int j = 0; j < 4; ++j) { const int row = 16 * j + (lane >> 2), c = lane & 3;
        *(GAS v4u*)(WT + (size_t)row * 1024 + 16 * c) = *(const LAS v4u*)(scr + row * 80 + 16 * c); }
    LDS_WAIT(); asm volatile("" ::: "memory");
}
__device__ __forceinline__ void cvt_up_item(Frame& F, int u) { const int e = u >> 9, q = u & 511, kb = q >> 5, nb = q & 31;
    cvt_block_f8(F.in(22) + (size_t)e * DM * 2 * DEXP + (size_t)(64 * kb) * (2 * DEXP) + 64 * nb, 2 * DEXP, (unsigned char*)(F.ws + WS_WUP) + ((size_t)e * 2 * DEXP + 64 * nb) * 1024 + 64 * kb, F.lds + F.wave * 16384, F.lane); }
__device__ __forceinline__ void cvt_dn_item(Frame& F, int d) { const int e = d >> 8, q = d & 255, kb = q >> 4, nb = q & 15;
    cvt_block_f8(F.in(24) + (size_t)e * DEXP * DM + (size_t)(64 * kb) * DM + 64 * nb, DM, (unsigned char*)(F.ws + WS_WDN) + ((size_t)e * DM + 64 * nb) * 1024 + 64 * kb, F.lds + F.wave * 16384, F.lane); }
template <bool UP> __device__ __forceinline__ void cvt_range(Frame& F, int lo, int hi, int wr_, int nw) {
    for (int it = lo + wr_; it < hi; it += nw) { if (UP) cvt_up_item(F, it); else cvt_dn_item(F, it); }
}
__device__ __forceinline__ void p0_transpose_item_f8(const float* W, int ldw, unsigned char* WT, int k0, int n0, float scale, LAS float* scr, int lane) {
#pragma unroll 8
    for (int i = 0; i < 32; ++i) { const int kk = 2 * i + (lane >> 5); scr[kk * 33 + (lane & 31)] = W[(size_t)(k0 + kk) * ldw + n0 + (lane & 31)] * scale; }
    LDS_WAIT(); asm volatile("" ::: "memory");
    const int c = lane & 7;
#pragma unroll
    for (int j = 0; j < 4; ++j) { const int n = (lane >> 3) + 8 * j; const LAS float* s = scr + (8 * c) * 33 + n;
        int w0 = 0, w1 = 0; w0 = __builtin_amdgcn_cvt_pk_fp8_f32(s[0 * 33], s[1 * 33], w0, false); w0 = __builtin_amdgcn_cvt_pk_fp8_f32(s[2 * 33], s[3 * 33], w0, true);
        w1 = __builtin_amdgcn_cvt_pk_fp8_f32(s[4 * 33], s[5 * 33], w1, false); w1 = __builtin_amdgcn_cvt_pk_fp8_f32(s[6 * 33], s[7 * 33], w1, true);
        typedef int i32x2_ __attribute__((ext_vector_type(2))); *(GAS i32x2_*)(WT + (size_t)(n0 + n) * 1024 + k0 + 8 * c) = (i32x2_){w0, w1}; }
    LDS_WAIT(); asm volatile("" ::: "memory");
}
template <int PARTS = 7> __device__ __forceinline__ void p0_phase(Frame& F) {
    const float* c_in = F.in(1); const float* w_ada = F.in(2); const float* b_ada = F.in(3);
    float* MOD = (float*)(F.ws + WS_MOD);
    if ((PARTS & 1) && F.vcu < 192) {
        LAS float* sc = (LAS float*)F.lds;
        LAS float* red = (LAS float*)(F.lds + 32768);
        for (int i = F.tid; i < BATCH * DM; i += NWAVES * 64) { const int b = i >> 10, k = i & 1023; const float v = c_in[i]; sc[k * 8 + b] = v * sigmoid_f(v); }
        __syncthreads();
        for (int ci = F.vcu; ci < 192; ci += F.G) {
            const int col = F.lane & 31, ks = F.lane >> 5;
            float acc[8];
#pragma unroll
            for (int b = 0; b < 8; ++b) acc[b] = 0.f;
            const float* wp = w_ada + (size_t)(128 * F.wave + ks) * (NMOD * DM) + ci * 32 + col;
#pragma unroll 1
            for (int i0 = 0; i0 < 64; i0 += 32) {
                float wv[32];
#pragma unroll
                for (int i = 0; i < 32; ++i) wv[i] = wp[(size_t)(2 * (i0 + i)) * (NMOD * DM)];
#pragma unroll
                for (int i = 0; i < 32; ++i) { const LAS f32x4* sp = (const LAS f32x4*)(sc + (128 * F.wave + 2 * (i0 + i) + ks) * 8); const f32x4 s0 = sp[0], s1 = sp[1];
                    acc[0] += s0[0] * wv[i]; acc[1] += s0[1] * wv[i]; acc[2] += s0[2] * wv[i]; acc[3] += s0[3] * wv[i]; acc[4] += s1[0] * wv[i]; acc[5] += s1[1] * wv[i]; acc[6] += s1[2] * wv[i]; acc[7] += s1[3] * wv[i]; }
            }
#pragma unroll
            for (int b = 0; b < 8; ++b) { acc[b] += __shfl_xor(acc[b], 32); if (ks == 0) red[(F.wave * 8 + b) * 32 + col] = acc[b]; }
            __syncthreads();
            if (F.tid < 256) { const int b = F.tid >> 5, cl = F.tid & 31; float s = 0.f;
#pragma unroll
              for (int w = 0; w < 8; ++w) s += red[(w * 8 + b) * 32 + cl];
              MOD[b * NMOD * DM + ci * 32 + cl] = s + b_ada[ci * 32 + cl]; }
            __syncthreads();
        }
    }
    __syncthreads();
    const float* w_in = F.in(6); const float* w_out = F.in(17); const float* gn_attn = F.in(16);
    bf16* WIN = (bf16*)(F.ws + WS_WIN); bf16* WOUT = (bf16*)(F.ws + WS_WOUT);
    LAS float* scr = (LAS float*)(F.lds + F.wave * 16384);
    const int gw = F.vcu * NWAVES + F.wave, NGW = F.G * NWAVES;
    constexpr int I_IN = 16 * (NPJ / 32), I_OUT = 16 * (DM / 32);
    constexpr int NITEMS = I_IN + I_OUT;
    if (PARTS & 2) for (int it = gw; it < NITEMS; it += NGW) {
        int r = it;
        if (r < I_IN) { const int kb = r / (NPJ / 32), nb = r % (NPJ / 32); p0_transpose_item(w_in, NPROJ, WIN, 64 * kb, 32 * nb, 64 * kb, nullptr, scr, F.lane); continue; } r -= I_IN;
        { const int kb = r / (DM / 32), nb = r % (DM / 32); const int k0 = 64 * kb;
            p0_transpose_item(w_out, DM, WOUT, k0, 32 * nb, (k0 + 512) & 1023, k0 >= 512 ? gn_attn - 512 : nullptr, scr, F.lane); }
    }
    if (PARTS & 4) {
        if (F.G == 256) {
            constexpr int NU = CV_UP_ITEMS - CV_UP_TAIL, NV = NU + (CV_DN_ITEMS - CV_DN_TAIL);
            auto run = [&](int v) { if (v < NU) cvt_up_item(F, CV_UP_TAIL + v); else cvt_dn_item(F, CV_DN_TAIL + (v - NU)); };
            constexpr int A_END = 2048 * 5;
            for (int v = gw; v < A_END && v < NV; v += NGW) run(v);
            if (F.vcu >= 192) { const int r = (F.vcu - 192) * NWAVES + F.wave; for (int v = A_END + r; v < A_END + 1536 && v < NV; v += 512) run(v); }
            else { const int r = F.vcu * NWAVES + F.wave; if (r < 512) { const int v = A_END + 1536 + r; if (v < NV) run(v); } }
            static_assert(A_END + 1536 + 512 >= NV, "phase-0 conversion shares cover the list");
        } else { cvt_range<true>(F, 0, CV_UP_ITEMS, gw, NGW); cvt_range<false>(F, 0, CV_DN_ITEMS, gw, NGW); }
    }
    if (PARTS & 2) { const float* w_in2 = F.in(6); float* WFT = (float*)(F.ws + WS_WFT);
      for (int idx = F.vcu * (NWAVES * 64) + F.tid; idx < 8 * DM; idx += F.G * NWAVES * 64) { const int h = idx >> 10, k = idx & 1023; WFT[idx] = w_in2[(size_t)k * NPROJ + NPJ + h]; } }
    { const float* w_router = F.in(20); float* WRT = (float*)(F.ws + WS_WRT);
      for (int idx = F.vcu * (NWAVES * 64) + F.tid; idx < NE * DM; idx += F.G * NWAVES * 64) { const int e = idx >> 10, k = idx & 1023; WRT[idx] = w_router[k * NE + e]; } }
    { const float* wa = F.in(9); const float* wx = F.in(11); bf16* LWT = (bf16*)(F.ws + WS_LWT);
      for (int idx = F.vcu * (NWAVES * 64) + F.tid; idx < 2 * 8 * 64 * 64; idx += F.G * NWAVES * 64) { const int gate = idx >> 15, g = (idx >> 12) & 7, j = (idx >> 6) & 63, i = idx & 63;
          LWT[idx] = (bf16)f2bf((gate ? wx : wa)[(g * 64 + i) * 64 + j]); } }
}

__device__ __forceinline__ void p1_phase(Frame& F) {
    const float* x = F.in(0); const float* gpre = F.in(4); const float* fb = F.in(14);
    const float* MOD = (const float*)(F.ws + WS_MOD); bf16* H1 = (bf16*)(F.ws + WS_H1); float* LOGF2 = (float*)(F.ws + WS_LOGF2);
    LAS float* wf = (LAS float*)F.lds;
    { const float* WFT = (const float*)(F.ws + WS_WFT);
#pragma unroll
      for (int i = F.tid; i < 8 * DM / 4; i += NWAVES * 64) *(LAS f32x4*)(wf + 4 * i) = *(const f32x4*)(WFT + 4 * i); }
    __syncthreads();
    const int gw = F.vcu * NWAVES + F.wave;
    if (F.G * NWAVES * 8 != NTOK) return;
    const int row0 = gw * 8, b = row0 / SEQ;
    f32x4 gm[4], sh[4];
#pragma unroll
    for (int j = 0; j < 4; ++j) { const int k = 4 * F.lane + 256 * j; const f32x4 g = *(const f32x4*)(gpre + k), s = *(const f32x4*)(MOD + b * NMOD * DM + DM + k); gm[j] = g * (s + 1.0f); sh[j] = *(const f32x4*)(MOD + b * NMOD * DM + k); }
    f32x4 nx[4];
#pragma unroll
    for (int j = 0; j < 4; ++j) nx[j] = *(const f32x4*)(x + (size_t)row0 * DM + 4 * F.lane + 256 * j);
    for (int r = 0; r < 8; ++r) { const int row = row0 + r;
        f32x4 v[4]; float ss = 0.f;
#pragma unroll
        for (int j = 0; j < 4; ++j) { v[j] = nx[j]; ss += (v[j][0] * v[j][0] + v[j][1] * v[j][1]) + (v[j][2] * v[j][2] + v[j][3] * v[j][3]); }
        if (r < 7) {
#pragma unroll
            for (int j = 0; j < 4; ++j) nx[j] = *(const f32x4*)(x + (size_t)(row + 1) * DM + 4 * F.lane + 256 * j); }
        const float rinv = 1.0f / sqrtf(wave_sum(ss) * (1.0f / DM) + RMS_EPS);
        float fl[8];
#pragma unroll
        for (int h = 0; h < 8; ++h) fl[h] = 0.f;
#pragma unroll
        for (int j = 0; j < 4; ++j) { const f32x4 hv = v[j] * rinv * gm[j] + sh[j];
            v2u o; o.x = pk2(hv[0], hv[1]); o.y = pk2(hv[2], hv[3]); *(GAS v2u*)(H1 + (size_t)row * DM + 4 * F.lane + 256 * j) = o;
#pragma unroll
            for (int h = 0; h < 8; ++h) { const f32x4 w = *(const LAS f32x4*)(wf + h * DM + 4 * F.lane + 256 * j); fl[h] += (hv[0] * w[0] + hv[1] * w[1]) + (hv[2] * w[2] + hv[3] * w[3]); } }
#pragma unroll
        for (int h = 0; h < 8; ++h) fl[h] = wave_sum(fl[h]);
        if (F.lane < 8) { float f = fl[0];
#pragma unroll
            for (int h = 1; h < 8; ++h) f = (F.lane == h) ? fl[h] : f;
            LOGF2[(size_t)row * 8 + F.lane] = log_sigmoid_f(f + fb[F.lane]) * 1.4426950408889634f; }
    }
}

constexpr int LRU_XP = 1040;
constexpr int LRU_XT = 0, LRU_XC = 69696, LRU_CAR = 136256;
constexpr int CW_LRU = 131072;
static_assert(LRU_CAR + 2048 <= SCRATCH_BYTES && 67 * LRU_XP <= LRU_XC && LRU_XC + 64 * LRU_XP <= LRU_CAR, "LRU LDS map");
__device__ __forceinline__ float one_minus_exp(float x) {
    float p = -x * (1.0f + x * (0.5f + x * (0.16666667f + x * (0.041666668f + x * (0.0083333338f + x * 0.0013888889f)))));
    if (__builtin_expect(__any(x <= -0.25f), 0)) { const float d = 1.0f - __builtin_amdgcn_exp2f(1.4426950408889634f * x); p = x > -0.25f ? p : d; }
    return p;
}
__device__ __forceinline__ void lru_item(Frame& F, int b, int c) {
    LAS unsigned char* XT = F.lds + LRU_XT; LAS unsigned char* XC = F.lds + LRU_XC; LAS float* CAR = (LAS float*)(F.lds + LRU_CAR);
    const bf16* XL = (const bf16*)(F.ws + WS_PJ); const bf16* YL = XL + PJ_STRIDE; const bf16* LWT = (const bf16*)(F.ws + WS_LWT);
    float* LSUM = (float*)(F.ws + WS_LSUM); bf16* MRG = (bf16*)(F.ws + WS_MRG); unsigned* flags = (unsigned*)(F.ws + WS_CTL) + CW_LRU;
    const float* conv_w = F.in(7); const float* conv_b = F.in(8); const float* ba = F.in(10); const float* bx = F.in(12); const float* lam = F.in(13); const float* gn_lru = F.in(15);
    const int t0 = c * 64; const size_t rowb = (size_t)b * SEQ;
    { v4u xv[9];
#pragma unroll
      for (int q = 0; q < 9; ++q) { const int p = F.tid + q * (NWAVES * 64), i = p >> 6, c8 = p & 63, t = t0 - 3 + i; xv[q] = (v4u){0u, 0u, 0u, 0u};
          if (p < 67 * 64 && t >= 0) xv[q] = *(const GAS v4u*)(XL + (rowb + t) * 512 + c8 * 8); }
#pragma unroll
      for (int q = 0; q < 9; ++q) { const int p = F.tid + q * (NWAVES * 64), i = p >> 6, c8 = p & 63; if (p < 67 * 64) *(LAS v4u*)(XT + i * LRU_XP + c8 * 16) = xv[q]; } }
    v4u yv8[8];
#pragma unroll
    for (int q = 0; q < 8; ++q) { const int p = F.tid + q * (NWAVES * 64), i = p >> 6, c8 = p & 63; yv8[q] = *(const GAS v4u*)(YL + (rowb + t0 + i) * 512 + c8 * 8); }
    __syncthreads();
    { const int ch = F.tid; const float w0 = conv_w[ch], w1 = conv_w[512 + ch], w2 = conv_w[1024 + ch], w3 = conv_w[1536 + ch], cb = conv_b[ch];
      float xa = bf1(*(const LAS bf16*)(XT + 0 * LRU_XP + ch * 2)), xb = bf1(*(const LAS bf16*)(XT + 1 * LRU_XP + ch * 2)), xc = bf1(*(const LAS bf16*)(XT + 2 * LRU_XP + ch * 2));
#pragma unroll 8
      for (int t = 0; t < 64; ++t) { const float xd = bf1(*(const LAS bf16*)(XT + (t + 3) * LRU_XP + ch * 2)); const float v = ((w0 * xa + w1 * xb) + (w2 * xc + w3 * xd)) + cb;
          *(LAS bf16*)(XC + t * LRU_XP + ch * 2) = (bf16)f2bf(v); xa = xb; xb = xc; xc = xd; } }
    __syncthreads();
#pragma unroll
    for (int q = 0; q < 8; ++q) { const int p = F.tid + q * (NWAVES * 64), i = p >> 6, c8 = p & 63; *(LAS v4u*)(XT + i * LRU_XP + c8 * 16) = yv8[q]; }
    const int g = F.wave, l31 = F.lane & 31, hi = F.lane >> 5;
    __syncthreads();
#pragma unroll 1
    for (int hp = 0; hp < 2; ++hp) {
        const int chl = g * 64 + 32 * hp + l31;
        f32x16 cumA[2], hloc[2];
#pragma unroll
        for (int tg = 0; tg < 2; ++tg) { cumA[tg] = f32x16{}; hloc[tg] = f32x16{}; }
#pragma unroll
        for (int s = 0; s < 4; ++s) {
            const bf16x8 wa = *(const GAS bf16x8*)(LWT + ((size_t)((0 * 8 + g) * 64 + 32 * hp + l31)) * 64 + 16 * s + 8 * hi);
            const bf16x8 wx = *(const GAS bf16x8*)(LWT + ((size_t)((1 * 8 + g) * 64 + 32 * hp + l31)) * 64 + 16 * s + 8 * hi);
#pragma unroll
            for (int tg = 0; tg < 2; ++tg) { const bf16x8 bfr = *(const LAS bf16x8*)(XC + (32 * tg + l31) * LRU_XP + (g * 64 + 16 * s + 8 * hi) * 2);
                cumA[tg] = __builtin_amdgcn_mfma_f32_32x32x16_bf16(bfr, wa, cumA[tg], 0, 0, 0); hloc[tg] = __builtin_amdgcn_mfma_f32_32x32x16_bf16(bfr, wx, hloc[tg], 0, 0, 0); }
        }
        const float pba = ba[chl], pbx = bx[chl], psp = 8.0f * softplus_f(-lam[chl]);
        float cA = 1.0f, cB = 0.0f;
#pragma unroll
        for (int tg = 0; tg < 2; ++tg) {
            f32x16& A = cumA[tg]; f32x16& X = hloc[tg];
#pragma unroll
            for (int r = 0; r < 16; ++r) { const int tok = 32 * tg + (r & 3) + 8 * (r >> 2) + 4 * hi; const float xv = bf1(*(const LAS bf16*)(XC + tok * LRU_XP + chl * 2));
                const float rg = sigmoid_f(A[r] + pba), ig = sigmoid_f(X[r] + pbx); const float la = -rg * psp;
                A[r] = __builtin_amdgcn_exp2f(1.4426950408889634f * la); X[r] = __builtin_amdgcn_sqrtf(one_minus_exp(2.0f * la)) * (ig * xv); }
#pragma unroll
            for (int q = 0; q < 4; ++q)
#pragma unroll
                for (int i = 1; i < 4; ++i) { X[4 * q + i] = A[4 * q + i] * X[4 * q + i - 1] + X[4 * q + i]; A[4 * q + i] = A[4 * q + i] * A[4 * q + i - 1]; }
#pragma unroll
            for (int q2 = 0; q2 < 8; ++q2) { const int q = q2 >> 1; const bool own = (hi == (q2 & 1));
#pragma unroll
                for (int i = 0; i < 4; ++i) { const float nb = A[4 * q + i] * cB + X[4 * q + i], na = A[4 * q + i] * cA; X[4 * q + i] = own ? nb : X[4 * q + i]; A[4 * q + i] = own ? na : A[4 * q + i]; }
                float ra, rb; { float a0 = A[4 * q + 3], a1 = a0; swap_half32(a0, a1); ra = hi ? a0 : a1; float b0 = X[4 * q + 3], b1 = b0; swap_half32(b0, b1); rb = hi ? b0 : b1; }
                cA = own ? A[4 * q + 3] : ra; cB = own ? X[4 * q + 3] : rb; }
        }
        if (hi == 0) { float* d0 = LSUM + (((size_t)b * 32 + c) * 2 + 0) * 512 + chl; __hip_atomic_store(d0, cA, __ATOMIC_RELAXED, __HIP_MEMORY_SCOPE_AGENT); __hip_atomic_store(d0 + 512, cB, __ATOMIC_RELAXED, __HIP_MEMORY_SCOPE_AGENT); }
        asm volatile("s_waitcnt vmcnt(0)" ::: "memory");
        __syncthreads();
        if (F.wave == 0) {
            if (F.lane == 0) __hip_atomic_store(flags + 64 * ((32 * b + c) * 2 + hp), 1u, __ATOMIC_RELAXED, __HIP_MEMORY_SCOPE_AGENT);
            unsigned sp = 0;
            for (;;) { const unsigned v = (F.lane < c) ? __hip_atomic_load(flags + 64 * ((32 * b + F.lane) * 2 + hp), __ATOMIC_RELAXED, __HIP_MEMORY_SCOPE_AGENT) : 1u;
                if (__all(v != 0u)) break; __builtin_amdgcn_s_sleep(1); if (++sp > (1u << 20)) break; }
        }
        __syncthreads();
        if (F.tid < 256) { const int ch = (F.tid >> 5) * 64 + 32 * hp + (F.tid & 31); float cr = 0.f; float* LS = LSUM + (size_t)b * 32 * 2 * 512 + ch;
          for (int c0 = 0; c0 < c; c0 += 32) { float A8[32], B8[32];
#pragma unroll
              for (int u = 0; u < 32; ++u) { const bool ok = (c0 + u) < c; A8[u] = 1.0f; B8[u] = 0.0f; if (ok) { A8[u] = __hip_atomic_load(LS + (size_t)(c0 + u) * 1024, __ATOMIC_RELAXED, __HIP_MEMORY_SCOPE_AGENT); B8[u] = __hip_atomic_load(LS + (size_t)(c0 + u) * 1024 + 512, __ATOMIC_RELAXED, __HIP_MEMORY_SCOPE_AGENT); } }
#pragma unroll
              for (int u = 0; u < 32; ++u) cr = A8[u] * cr + B8[u]; }
          CAR[ch] = cr; }
        __syncthreads();
        { const float cin = CAR[chl];
#pragma unroll
          for (int tg = 0; tg < 2; ++tg)
#pragma unroll
              for (int r = 0; r < 16; ++r) { const int tok = 32 * tg + (r & 3) + 8 * (r >> 2) + 4 * hi; LAS bf16* yp = (LAS bf16*)(XT + tok * LRU_XP + chl * 2);
                  const float h = hloc[tg][r] + cumA[tg][r] * cin; *yp = (bf16)f2bf(h * gelu_tanh_f(bf1(*yp))); } }
    }
    __syncthreads();
#pragma unroll 2
    for (int q = 0; q < 8; ++q) { const int i = F.wave + 8 * q, c8 = F.lane;
        const v4u w = *(const LAS v4u*)(XT + i * LRU_XP + c8 * 16);
        const float v0 = bflo(w.x), v1 = bfhi(w.x), v2 = bflo(w.y), v3 = bfhi(w.y), v4 = bflo(w.z), v5 = bfhi(w.z), v6 = bflo(w.w), v7 = bfhi(w.w);
        const float ss = wave_sum(((v0 * v0 + v1 * v1) + (v2 * v2 + v3 * v3)) + ((v4 * v4 + v5 * v5) + (v6 * v6 + v7 * v7)));
        const float rinv = 1.0f / sqrtf(ss * (1.0f / DLRU) + RMS_EPS);
        const f32x4 g0 = *(const f32x4*)(gn_lru + c8 * 8), g1 = *(const f32x4*)(gn_lru + c8 * 8 + 4);
        v4u o; o.x = pk2(v0 * rinv * g0[0], v1 * rinv * g0[1]); o.y = pk2(v2 * rinv * g0[2], v3 * rinv * g0[3]); o.z = pk2(v4 * rinv * g1[0], v5 * rinv * g1[1]); o.w = pk2(v6 * rinv * g1[2], v7 * rinv * g1[3]);
        *(GAS v4u*)(MRG + (rowb + t0 + i) * 1024 + 512 + c8 * 8) = o; }
    __syncthreads();
}
__device__ __forceinline__ void lru_phase(Frame& F) { for (int it = F.vcu; it < BATCH * 32; it += F.G) lru_item(F, it >> 5, it & 31); }

__device__ __forceinline__ void p6_prologue(Frame& F, int t0) {
    LAS float* wrl = (LAS float*)F.lds; LAS int* hist = (LAS int*)(F.lds + 131072); const float* WRT = (const float*)(F.ws + WS_WRT);
    const int t = (int)threadIdx.x - t0, nt = NWAVES * 64 - t0;
#pragma unroll 4
    for (int i = t; i < NE * DM / 4; i += nt) *(LAS f32x4*)(wrl + 4 * i) = *(const f32x4*)(WRT + 4 * i);
    if (t < NE) hist[t] = 0;
}
template <int VAR = 0, bool PRO = true> __device__ __forceinline__ void p6_phase(Frame& F) {
    const float* x = F.in(0); const float* gpost = F.in(5); const float* gffn = F.in(18); const float* b_router = F.in(21);
    const float* MOD = (const float*)(F.ws + WS_MOD); const bf16* Y = (const bf16*)(F.ws + WS_Y); unsigned char* H2 = (unsigned char*)(F.ws + WS_H2);
    int* TOPI = (int*)(F.ws + WS_TOPI); float* TOPW = (float*)(F.ws + WS_TOPW); int* WGCNT = (int*)(F.ws + WS_WGCNT); bf16* XMID = (bf16*)(F.ws + WS_XMID);
    LAS float* wrl = (LAS float*)F.lds;
    LAS int* hist = (LAS int*)(F.lds + 131072);
    if (PRO) { p6_prologue(F, 0); __syncthreads(); }
    if (F.G * 64 == NTOK) {
    const int bx = blockIdx.x, row0 = bx * 64 + F.wave * 8, b = row0 / SEQ;
    f32x4 gpm[4], gf[4], shf[4];
#pragma unroll
    for (int j = 0; j < 4; ++j) { const int k = 4 * F.lane + 256 * j; const float* mb = MOD + b * NMOD * DM + k;
        gpm[j] = *(const f32x4*)(mb + 2 * DM) * *(const f32x4*)(gpost + k); gf[j] = *(const f32x4*)(gffn + k) * (*(const f32x4*)(mb + 4 * DM) + 1.0f); shf[j] = *(const f32x4*)(mb + 3 * DM); }
    v2u ywn[2][4]; f32x4 xn[2][4];
#pragma unroll
    for (int u = 0; u < 2; ++u)
#pragma unroll
        for (int j = 0; j < 4; ++j) { ywn[u][j] = *(const GAS v2u*)(Y + (size_t)(row0 + u) * DM + 4 * F.lane + 256 * j); xn[u][j] = *(const f32x4*)(x + (size_t)(row0 + u) * DM + 4 * F.lane + 256 * j); }
    for (int rp = 0; rp < 4; ++rp) {
        f32x4 hv[2][4];
        v2u ywc[2][4]; f32x4 xc[2][4];
#pragma unroll
        for (int u = 0; u < 2; ++u)
#pragma unroll
            for (int j = 0; j < 4; ++j) { ywc[u][j] = ywn[u][j]; xc[u][j] = xn[u][j]; }
        if (rp < 3) {
#pragma unroll
            for (int u = 0; u < 2; ++u)
#pragma unroll
                for (int j = 0; j < 4; ++j) { ywn[u][j] = *(const GAS v2u*)(Y + (size_t)(row0 + 2 * rp + 2 + u) * DM + 4 * F.lane + 256 * j); xn[u][j] = *(const f32x4*)(x + (size_t)(row0 + 2 * rp + 2 + u) * DM + 4 * F.lane + 256 * j); } }
#pragma unroll
        for (int u = 0; u < 2; ++u) { const int row = row0 + 2 * rp + u;
            f32x4 yv[4]; float ss = 0.f;
#pragma unroll
            for (int j = 0; j < 4; ++j) { const v2u yw = ywc[u][j]; yv[j] = (f32x4){bflo(yw.x), bfhi(yw.x), bflo(yw.y), bfhi(yw.y)}; ss += (yv[j][0] * yv[j][0] + yv[j][1] * yv[j][1]) + (yv[j][2] * yv[j][2] + yv[j][3] * yv[j][3]); }
            const float rinv = 1.0f / sqrtf(wave_sum(ss) * (1.0f / DM) + RMS_EPS);
            float s2 = 0.f;
#pragma unroll
            for (int j = 0; j < 4; ++j) { const f32x4 xm = xc[u][j] + gpm[j] * (yv[j] * rinv);
                { v2u o; o.x = pk2(xm[0], xm[1]); o.y = pk2(xm[2], xm[3]); *(GAS v2u*)(XMID + (size_t)row * DM + 4 * F.lane + 256 * j) = o; }
                yv[j] = xm; s2 += (xm[0] * xm[0] + xm[1] * xm[1]) + (xm[2] * xm[2] + xm[3] * xm[3]); }
            const float rinv2 = 1.0f / sqrtf(wave_sum(s2) * (1.0f / DM) + RMS_EPS);
#pragma unroll
            for (int j = 0; j < 4; ++j) { const f32x4 h = yv[j] * rinv2 * gf[j] + shf[j]; hv[u][j] = h;
                int w8 = 0; w8 = __builtin_amdgcn_cvt_pk_fp8_f32(h[0], h[1], w8, false); w8 = __builtin_amdgcn_cvt_pk_fp8_f32(h[2], h[3], w8, true); *(GAS int*)(H2 + (size_t)row * DM + 4 * F.lane + 256 * j) = w8; }
        }
        typedef float f32x2 __attribute__((ext_vector_type(2)));
        f32x2 hp[4][4];
#pragma unroll
        for (int j = 0; j < 4; ++j)
#pragma unroll
            for (int i = 0; i < 4; ++i) hp[j][i] = (f32x2){hv[0][j][i], hv[1][j][i]};
        float pa[32], pb[32];
#pragma unroll
        for (int e = 0; e < 32; ++e) { f32x2 s2 = (f32x2){0.f, 0.f};
#pragma unroll
            for (int j = 0; j < (VAR == 1 ? 0 : 4); ++j) { const f32x4 w = *(const LAS f32x4*)(wrl + e * DM + 4 * F.lane + 256 * j);
#pragma unroll
                for (int i = 0; i < 4; ++i) s2 = __builtin_elementwise_fma(hp[j][i], (f32x2){w[i], w[i]}, s2); }
            pa[e] = s2[0]; pb[e] = s2[1]; }
#pragma unroll
        for (int i = 0; i < 16; ++i) { float a = pa[i], b = pa[16 + i]; swap_half32(a, b); pa[i] = a + b; float c2 = pb[i], d2 = pb[16 + i]; swap_half32(c2, d2); pb[i] = c2 + d2; }
#pragma unroll
        for (int i = 0; i < 8; ++i) { float a = pa[i], b = pa[8 + i]; swap_rows16(a, b); pa[i] = a + b; float c2 = pb[i], d2 = pb[8 + i]; swap_rows16(c2, d2); pb[i] = c2 + d2; }
#define TR_STEP(N, XOR, BIT) _Pragma("unroll") for (int i = 0; i < N; ++i) { const bool up = (F.lane & BIT) != 0; \
            const float ka = up ? pa[N + i] : pa[i], sa_ = up ? pa[i] : pa[N + i], kb = up ? pb[N + i] : pb[i], sb_ = up ? pb[i] : pb[N + i]; \
            pa[i] = ka + XOR(sa_); pb[i] = kb + XOR(sb_); }
        TR_STEP(4, lane_xor8, 8) TR_STEP(2, lane_xor4, 4) TR_STEP(1, lane_xor2, 2)
#undef TR_STEP
        const int e = (F.lane >> 1) & 31; const float br = b_router[e];
#pragma unroll
        for (int u = 0; u < 2; ++u) { const int row = row0 + 2 * rp + u; float v = (u ? pb[0] : pa[0]); v += lane_xor1(v); v += br;
            int rank = 0;
#pragma unroll
            for (int j = 0; j < 32; ++j) { const float vj = __uint_as_float((unsigned)__builtin_amdgcn_readlane((int)__float_as_uint(v), 2 * j)); rank += (vj > v || (vj == v && j < e)) ? 1 : 0; }
            const bool sel = rank < TOPK; const float vmax = wave_max(v); const float ex = sel ? __expf(v - vmax) : 0.f; const float den = wave_sum(ex) * 0.5f;
            if (sel && !(F.lane & 1)) { TOPI[(size_t)row * TOPK + rank] = e; TOPW[(size_t)row * TOPK + rank] = ex / den; __hip_atomic_fetch_add((LAS int*)&hist[e], 1, __ATOMIC_RELAXED, __HIP_MEMORY_SCOPE_WORKGROUP); } }
    }
    __syncthreads();
    if (F.tid < NE) WGCNT[bx * NE + F.tid] = hist[F.tid];
    }
}

__device__ __forceinline__ void p7_phase(Frame& F) {
    const int* TOPI = (const int*)(F.ws + WS_TOPI); const float* TOPW = (const float*)(F.ws + WS_TOPW); const int* WGCNT = (const int*)(F.ws + WS_WGCNT);
    int* ROWTOK = (int*)(F.ws + WS_ROWTOK); int* ROWPAIR = (int*)(F.ws + WS_ROWPAIR); float* ROWW = (float*)(F.ws + WS_ROWW); int* MTEXP = (int*)(F.ws + WS_MTEXP);
    LAS int* ptot = (LAS int*)F.lds; LAS int* pbef = ptot + 512; LAS int* cnt = pbef + 512; LAS int* wgb = cnt + 32; LAS int* pst = wgb + 32; LAS int* pad = pst + 64; LAS int* ep = pad + 32;
    if (F.G != 256) return;
    const int bx = blockIdx.x;
    { const int e = F.tid & 31, part = F.tid >> 5; int tt = 0, tb = 0;
      for (int w = part * 16; w < part * 16 + 16; ++w) { const int v = WGCNT[w * NE + e]; tt += v; tb += (w < bx) ? v : 0; }
      ptot[part * 32 + e] = tt; pbef[part * 32 + e] = tb; }
    __syncthreads();
    if (F.tid < NE) { int tt = 0, tb = 0; for (int p = 0; p < 16; ++p) { tt += ptot[p * 32 + F.tid]; tb += pbef[p * 32 + F.tid]; } cnt[F.tid] = tt; wgb[F.tid] = tb; pad[F.tid] = (tt + 255) & ~255; }
    __syncthreads();
    if (F.tid == 0) { int s = 0; for (int e = 0; e < NE; ++e) { pst[e] = s; s += pad[e]; } pst[NE] = s; }
    if (F.tid < 256) ep[F.tid] = TOPI[(size_t)bx * 256 + F.tid];
    __syncthreads();
    if (F.tid < 256) { const int p = F.tid, e = ep[p]; int rk = 0; for (int q = 0; q < p; ++q) rk += (ep[q] == e) ? 1 : 0;
        const int dest = pst[e] + wgb[e] + rk; const int pair = bx * 256 + p; ROWTOK[dest] = pair >> 2; ROWPAIR[dest] = pair; ROWW[dest] = TOPW[pair]; }
    if (bx < NE) { const int e = bx; for (int i = pst[e] + cnt[e] + F.tid; i < pst[e] + pad[e]; i += NWAVES * 64) { ROWTOK[i] = 0; ROWPAIR[i] = -1; ROWW[i] = 0.f; } }
    if (bx == 0) { if (F.tid < NE) { for (int mt = pst[F.tid] >> 8; mt < (pst[F.tid] + pad[F.tid]) >> 8; ++mt) MTEXP[mt] = F.tid; } if (F.tid == 0) MTEXP[512] = pst[NE] >> 8; }
}

__device__ __forceinline__ void p10_phase(Frame& F) {
    const float* gpost = F.in(19); const float* MOD = (const float*)(F.ws + WS_MOD);
    const unsigned char* YP = (const unsigned char*)(F.ws + WS_YP); const bf16* XMID = (const bf16*)(F.ws + WS_XMID);
    const int gw = F.vcu * NWAVES + F.wave;
    if (F.G * NWAVES * 8 != NTOK) return;
    const int row0 = gw * 8, b = row0 / SEQ;
    f32x4 gg[4];
#pragma unroll
    for (int j = 0; j < 4; ++j) { const int k = 4 * F.lane + 256 * j; gg[j] = *(const f32x4*)(MOD + b * NMOD * DM + 5 * DM + k) * *(const f32x4*)(gpost + k); }
    int nw[4][TOPK]; v2u nm[4];
#pragma unroll
    for (int j = 0; j < 4; ++j) { nm[j] = *(const GAS v2u*)(XMID + (size_t)row0 * DM + 4 * F.lane + 256 * j);
#pragma unroll
        for (int k = 0; k < TOPK; ++k) nw[j][k] = *(const GAS int*)(YP + ((size_t)row0 * TOPK + k) * DM + 4 * F.lane + 256 * j); }
    for (int r = 0; r < 8; ++r) { const int row = row0 + r;
        f32x4 y[4], xm[4]; float ss = 0.f;
#pragma unroll
        for (int j = 0; j < 4; ++j) { f32x4 s = (f32x4){0.f, 0.f, 0.f, 0.f};
#pragma unroll
            for (int k = 0; k < TOPK; ++k) { const int w = nw[j][k]; s += (f32x4){__builtin_amdgcn_cvt_f32_fp8(w, 0), __builtin_amdgcn_cvt_f32_fp8(w, 1), __builtin_amdgcn_cvt_f32_fp8(w, 2), __builtin_amdgcn_cvt_f32_fp8(w, 3)}; }
            y[j] = s; ss += (s[0] * s[0] + s[1] * s[1]) + (s[2] * s[2] + s[3] * s[3]);
            const v2u mw = nm[j]; xm[j] = (f32x4){bflo(mw.x), bfhi(mw.x), bflo(mw.y), bfhi(mw.y)}; }
        if (r < 7) {
#pragma unroll
            for (int j = 0; j < 4; ++j) { nm[j] = *(const GAS v2u*)(XMID + (size_t)(row + 1) * DM + 4 * F.lane + 256 * j);
#pragma unroll
                for (int k = 0; k < TOPK; ++k) nw[j][k] = *(const GAS int*)(YP + ((size_t)(row + 1) * TOPK + k) * DM + 4 * F.lane + 256 * j); } }
        const float rinv = 1.0f / sqrtf(wave_sum(ss) * (1.0f / DM) + RMS_EPS * 16.0f);
#pragma unroll
        for (int j = 0; j < 4; ++j) *(f32x4*)(F.out + (size_t)row * DM + 4 * F.lane + 256 * j) = xm[j] + gg[j] * (y[j] * rinv);
    }
}

__device__ __forceinline__ void p9_bias(Frame& F, int nmt, int t0) {
    const LAS int* mtl = (const LAS int*)(F.lds + 131072); LAS float* bsl = (LAS float*)(F.lds + 131072 + 2048); const float* b_dn = F.in(25);
    const int t = (int)threadIdx.x - t0;
    if (t >= 0 && t < 256) for (int i = 0; i < 12; ++i) { const int L = i * F.G + F.vcu; if (L >= nmt * 4) break; const int ex = mtl[L >> 2], pn = L & 3; bsl[i * 256 + t] = b_dn[(size_t)ex * DM + pn * 256 + t]; }
}
__global__ void __launch_bounds__(NWAVES * 64, 2) mega_fwd(Args args) {
    extern __shared__ __attribute__((aligned(16))) unsigned char lds[];
    Frame F;
    F.lds = (LAS unsigned char*)lds;
    F.tid = threadIdx.x; F.lane = F.tid & 63; F.wave = __builtin_amdgcn_readfirstlane(F.tid >> 6);
    F.G = gridDim.x; { const int bx = blockIdx.x; F.vcu = (F.G % 8 == 0) ? (bx % 8) * (F.G / 8) + bx / 8 : bx; }
    F.out = args.out; F.ws = args.ws;
    volatile LAS unsigned* MISC = (volatile LAS unsigned*)(F.lds + MISC_OFF);
    for (int u = F.tid; u < (LDS_BYTES - LDSCTL_OFF) / 4; u += NWAVES * 64) ((LAS unsigned*)(F.lds + LDSCTL_OFF))[u] = 0u;
    __syncthreads();
    if (F.tid < 26) ((LAS unsigned long long*)(F.lds + LDSCTL_OFF))[F.tid] = (unsigned long long)args.in[F.tid];
    __syncthreads();
    gu32* ctl = (gu32*)(F.ws + WS_CTL);
    XcdBarrier bar = xcd_barrier_post((unsigned*)(ctl + CW_BAR) + args.li * XCD_BAR_WORDS, MISC + 8);
    const int lo = args.ph_lo, hi = args.ph_hi;
#ifndef PHMASK
#define PHMASK 0x7ff
#endif
#define IN(k) (((PHMASK >> (k)) & 1) && lo <= (k) && (k) < hi)
#define SEAM(k, n) do { if (IN(k) && IN(n)) xcd_barrier(bar); } while (0)
#define REFRESH() do { int t_; asm volatile("v_mov_b32 %0, %1" : "=v"(t_) : "v"(threadIdx.x)); F.tid = t_; F.lane = t_ & 63; } while (0)
#define ATTN_TENSORS attn_body::AttnTensors{(const attn_body::bf16*)(F.ws + WS_PJ) + 2 * PJ_STRIDE, (const attn_body::bf16*)(F.ws + WS_PJ) + 3 * PJ_STRIDE, (const attn_body::bf16*)(F.ws + WS_PJ) + 4 * PJ_STRIDE, \
                                          (attn_body::bf16*)(F.ws + WS_MRG), (const float*)(F.ws + WS_LOGF2), (float*)(F.ws + WS_SSQ)}
    if (IN(0)) { REFRESH(); p0_phase(F); } SEAM(0, 1);
    if (IN(1)) { REFRESH(); p1_phase(F); } SEAM(1, 2);
    if (IN(2)) { REFRESH();
        pg8::DenseOrder S; S.init((const pg8::bf16_t*)(F.ws + WS_H1), (const pg8::bf16_t*)(F.ws + WS_WIN), NTOK, NPJ, F.G, (int)blockIdx.x);
        pg8::EpiProj E{(pg8::bf16_t*)(F.ws + WS_PJ), PJ_STRIDE, attn_body::C2};
        pg8::gemm_phase<pg8::EpiProj, pg8::DenseOrder>(F.lds, S, E);
        if (F.G == 256 && blockIdx.x >= 128) { REFRESH(); cvt_range<true>(F, 0, CV_UP_TAIL, ((int)blockIdx.x - 128) * NWAVES + F.wave, 128 * NWAVES); }
    } SEAM(2, 3);
    if (IN(3)) { REFRESH();
        lru_phase(F);
        const attn_body::AttnTensors AT = ATTN_TENSORS; const attn_body::StaticOrder S((int)F.G, F.vcu);
        attn_body::attn_phase<attn_body::StaticOrder>((char*)lds, AT, S);
    } SEAM(3, 5);
    if (IN(5)) { REFRESH();
        pg8::DenseOrder S; S.init((const pg8::bf16_t*)(F.ws + WS_MRG), (const pg8::bf16_t*)(F.ws + WS_WOUT), NTOK, DM, F.G, (int)blockIdx.x);
        pg8::EpiOut E{(pg8::bf16_t*)(F.ws + WS_Y), (const float*)(F.ws + WS_SSQ)};
        pg8::gemm_phase<pg8::EpiOut, pg8::DenseOrder>(F.lds, S, E);
    } if (IN(5) && IN(6)) xcd_barrier(bar, [&] { p6_prologue(F, 64); });
    if (IN(6)) { REFRESH(); if (IN(5)) p6_phase<0, false>(F); else p6_phase<0, true>(F); } SEAM(6, 7);
    if (IN(7)) { REFRESH(); p7_phase(F); } SEAM(7, 8);
    if (IN(8)) { REFRESH();
        const int nmt = ((const int*)(F.ws + WS_MTEXP))[512];
        LAS int* mtl = (LAS int*)(F.lds + 131072); LAS float* bsl = (LAS float*)(F.lds + 131072 + 2048);
        for (int i = F.tid; i < nmt; i += NWAVES * 64) mtl[i] = ((const int*)(F.ws + WS_MTEXP))[i];
        __syncthreads();
        { const float* b_up = F.in(23);
          for (int i = 0; i < 12; ++i) { const int L = i * F.G + F.vcu; if (L >= nmt * 8) break; const int ex = mtl[L >> 3], pn = L & 7;
              if (F.tid < 256) bsl[i * 256 + F.tid] = b_up[(size_t)ex * 2 * DEXP + (F.tid >> 7) * DEXP + pn * 128 + (F.tid & 127)]; } }
        __syncthreads();
        pg8::UpOrder S{(const unsigned char*)(F.ws + WS_H2), (const unsigned char*)(F.ws + WS_WUP), (const int*)(F.ws + WS_ROWTOK), mtl, nmt * 8, F.G, F.vcu};
        pg8::EpiUp E{(unsigned char*)(F.ws + WS_ACT), bsl};
        pg8::gemm_phase<pg8::EpiUp, pg8::UpOrder, true>(F.lds, S, E);
        if (F.G == 256) {
            const int units = nmt * 8, maxu = (units + 255) >> 8, nfull = units - (maxu - 1) * 256, nidle = 256 - nfull;
            REFRESH();
            if (nidle >= 32) { if (F.vcu >= nfull) cvt_range<false>(F, 0, CV_DN_TAIL, (F.vcu - nfull) * NWAVES + F.wave, nidle * NWAVES); }
            else cvt_range<false>(F, 0, CV_DN_TAIL, F.vcu * NWAVES + F.wave, 256 * NWAVES); }
        if (IN(9)) xcd_barrier(bar, [&] { p9_bias(F, nmt, 64); });
    }
    if (IN(9)) { REFRESH();
        const int nmt = ((const int*)(F.ws + WS_MTEXP))[512];
        LAS int* mtl = (LAS int*)(F.lds + 131072); LAS float* bsl = (LAS float*)(F.lds + 131072 + 2048);
        if (!IN(8)) {
            for (int i = F.tid; i < nmt; i += NWAVES * 64) mtl[i] = ((const int*)(F.ws + WS_MTEXP))[i];
            __syncthreads();
            p9_bias(F, nmt, 0);
            __syncthreads(); }
        pg8::DownOrder S{(const unsigned char*)(F.ws + WS_ACT), (const unsigned char*)(F.ws + WS_WDN), mtl, nmt * 4, F.G, F.vcu};
        pg8::EpiDown E{(unsigned char*)(F.ws + WS_YP), bsl, (const int*)(F.ws + WS_ROWPAIR), (const float*)(F.ws + WS_ROWW)};
        pg8::gemm_phase<pg8::EpiDown, pg8::DownOrder, true>(F.lds, S, E);
    } SEAM(9, 10);
    if (IN(10)) { REFRESH(); p10_phase(F); }
#ifdef MK_PROBES
    if (lo == 11) { REFRESH(); lru_phase(F); }
    if (lo == 12) { REFRESH(); const attn_body::AttnTensors AT = ATTN_TENSORS; const attn_body::StaticOrder S((int)F.G, F.vcu); attn_body::attn_phase<attn_body::StaticOrder>((char*)lds, AT, S); }
    if (lo == 14) { REFRESH(); p0_phase<1>(F); }
    if (lo == 15) { REFRESH(); p0_phase<2>(F); }
    if (lo == 16) { REFRESH(); p0_phase<4>(F); }
    if (lo == 17) { for (int i = 0; i < 10; ++i) xcd_barrier(bar); }
    if (lo == 18) { REFRESH(); p6_phase<1>(F); }
    if (lo >= 21 && lo <= 24) { REFRESH();
        const int nmt = ((const int*)(F.ws + WS_MTEXP))[512];
        LAS int* mtl = (LAS int*)(F.lds + 131072); LAS float* bsl = (LAS float*)(F.lds + 131072 + 2048);
        for (int i = F.tid; i < nmt; i += NWAVES * 64) mtl[i] = ((const int*)(F.ws + WS_MTEXP))[i];
        for (int i = F.tid; i < 12 * 256; i += NWAVES * 64) bsl[i] = 0.f;
        __syncthreads();
        pg8::UpOrder S{(const unsigned char*)(F.ws + WS_H2), (const unsigned char*)(F.ws + WS_WUP), (const int*)(F.ws + WS_ROWTOK), mtl, nmt * 8, F.G, F.vcu};
        if (lo == 21) { pg8::EpiNop E{}; pg8::gemm_phase<pg8::EpiNop, pg8::UpOrder, true, 1>(F.lds, S, E); }
        else if (lo == 22) { pg8::EpiNop E{}; pg8::gemm_phase<pg8::EpiNop, pg8::UpOrder, true, 2>(F.lds, S, E); }
        else if (lo == 23) { pg8::EpiUp E{(unsigned char*)(F.ws + WS_H1), bsl}; pg8::gemm_phase<pg8::EpiUp, pg8::UpOrder, true, 1>(F.lds, S, E); }
        else { pg8::EpiUpT<false> E{(unsigned char*)(F.ws + WS_H1), bsl}; pg8::gemm_phase<pg8::EpiUpT<false>, pg8::UpOrder, true, 1>(F.lds, S, E); } }
#endif
#undef IN
#undef SEAM
#undef REFRESH
#undef ATTN_TENSORS
}

static void launch_mega(hipStream_t stream, void* const* d_in, void* d_out, void* d_ws, int lo, int hi, int li, int grid) {
    Args a{};
    for (int i = 0; i < 26; ++i) a.in[i] = (const float*)d_in[i];
    a.out = (float*)d_out; a.ws = (unsigned char*)d_ws; a.ph_lo = lo; a.ph_hi = hi; a.li = li; a.pad = 0;
    hipLaunchKernelGGL(mega_fwd, dim3(grid), dim3(NWAVES * 64), LDS_BYTES, stream, a);
}

extern "C" void kernel_launch(void* const* d_in, const int* in_sizes, int n_in, void* d_out, int out_size, void* d_ws, size_t ws_size, hipStream_t stream) {
    static int grid = 0;
    if (grid == 0) {
        int dev = 0, cus = 0;
        if (n_in != 26 || out_size != NTOK * DM || ws_size < WS_END) { fprintf(stderr, "kernel_launch: unexpected problem shape / workspace (%d inputs, out %d, ws %zu)\n", n_in, out_size, ws_size); grid = -1; return; }
        if (hipGetDevice(&dev) != hipSuccess || hipDeviceGetAttribute(&cus, hipDeviceAttributeMultiprocessorCount, dev) != hipSuccess) { grid = -1; return; }
        if (hipFuncSetAttribute((const void*)mega_fwd, hipFuncAttributeMaxDynamicSharedMemorySize, LDS_BYTES) != hipSuccess) { fprintf(stderr, "kernel_launch: hipFuncSetAttribute failed\n"); grid = -1; return; }
        grid = cus;
        if (grid != 256) fprintf(stderr, "kernel_launch: %d CUs; this kernel is laid out for 256\n", grid);
    }
    if (grid < 0) return;
    (void)in_sizes;
    (void)hipMemsetAsync((char*)d_ws + WS_CTL, 0, CTL_ZERO_BYTES, stream);
    launch_mega(stream, d_in, d_out, d_ws, 0, NPHASES, 0, grid);
#ifdef MK_PROBES
#ifdef EXTRA_LO
    launch_mega(stream, d_in, d_out, d_ws, EXTRA_LO, EXTRA_HI, 1, grid);
#endif
#endif
}
```

```cpp
#include <hip/hip_runtime.h>
#include <hip/hip_bf16.h>
#include <cstdio>
#include <cstdint>
#include <cmath>

constexpr int DM = 1024, BATCH = 8, SEQ = 2048, NTOK = BATCH * SEQ;
constexpr int DLRU = 512, DATT = 512, NH = 8, HD = 64, NPROJ = 2 * DLRU + 3 * DATT + NH, NPJ = 2560;
constexpr int NE = 32, TOPK = 4, DEXP = 1024, NMOD = 6;
constexpr float RMS_EPS = 1e-6f;
constexpr int MAXROWS = NTOK * TOPK + NE * 256;
constexpr int MAXMT = MAXROWS / 256;

namespace pg8 {
#define PG8_LAS __attribute__((address_space(3)))
typedef unsigned short bf16_t;
typedef short bf16x8 __attribute__((ext_vector_type(8)));
typedef float f32x4 __attribute__((ext_vector_type(4)));
typedef float f32x2 __attribute__((ext_vector_type(2)));
typedef unsigned u32x4 __attribute__((ext_vector_type(4)));
constexpr int BM = 256, BK = 64, HALF = 128, HTB = HALF * BK * 2  , STAGE_BYTES = 8 * HTB, NXCD = 8, WGM = 4;
constexpr int GK = 1024, GNT = GK / BK;
typedef int i32x8 __attribute__((ext_vector_type(8)));
typedef int i32x4 __attribute__((ext_vector_type(4)));
constexpr int F8_SCALE_W = 0x79797979, F8_SCALE_A = 0x7f7f7f7f;

__host__ __device__ __forceinline__ int lds_byte(int r, int c) { const int st = (r >> 4) * 2 + (c >> 5), rr = r & 15, cc = c & 31, ob = rr * 64 + cc * 2; return st * 1024 + (ob ^ (((ob >> 9) & 1) << 5)); }
__host__ __device__ __forceinline__ void stage_rc(int b, int& R, int& C) { const int st = b / 1024, sb = b % 1024, swz = sb ^ (((sb >> 9) & 1) << 5); R = (st >> 1) * 16 + swz / 64; C = (st & 1) * 32 + (swz % 64) / 2; }
__host__ __device__ __forceinline__ int perm32(int rho) { const int n = rho >> 4, i = rho & 15; return 8 * (i >> 2) + 4 * n + (i & 3); }

struct Unit { const char* A0; const char* A1; const char* B0; const char* B1; int pm, pn, e, ord; };

__device__ __forceinline__ void mfma_f8_acc(f32x4& acc, const i32x8& b, const i32x8& a, int sw, int sa) {
    asm volatile("v_mfma_scale_f32_16x16x128_f8f6f4 %0, %1, %2, %0, %3, %4 op_sel_hi:[0,0,0]" : "+v"(acc) : "v"(b), "v"(a), "v"(sw), "v"(sa)); }
__device__ __forceinline__ unsigned cvt_pk_bf16(float lo, float hi) { unsigned r; asm volatile("v_cvt_pk_bf16_f32 %0, %1, %2" : "=v"(r) : "v"(lo), "v"(hi)); return r; }

template <class Epi, class Sched, bool F8 = false, int KREP = 1>
__device__ __forceinline__ void gemm_phase(PG8_LAS unsigned char* lds, const Sched& S, const Epi& E) {
    const int tid = threadIdx.x, wid = __builtin_amdgcn_readfirstlane(tid >> 6), lane = tid & 63, wr = wid >> 2, wc = wid & 3, fr = lane & 15, fq = lane >> 4;
    constexpr int KB = F8 ? GK : GK * 2, nt1 = F8 ? GK / 128 : GNT, nt = nt1 * KREP;
    int Rr[2], Cc[2];
    unsigned voffB[2], cvA[2][2], nvA[2][2];
#pragma unroll
    for (int i = 0; i < 2; ++i) { stage_rc(tid * 16 + i * 8192, Rr[i], Cc[i]); const int Rb = Epi::PERM ? ((Rr[i] & ~31) + perm32(Rr[i] & 31)) : Rr[i]; voffB[i] = (unsigned)(Rb * KB + Cc[i] * 2); }
    constexpr size_t kstep = (size_t)(BK * 2);
    const unsigned ldsw = (unsigned)wid * 1024u;
    const int aoff = lds_byte(wr * 64 + fr, fq * 8), boff = lds_byte(wc * 32 + fr, fq * 8);
#define PG8_SA(b, h) (((b) * 2 + (h)) * HTB)
#define PG8_SB(b, h) ((4 + (b) * 2 + (h)) * HTB)
#define PG8_STAGE(bufoff, gbase, voff) do { _Pragma("unroll") for (int _i = 0; _i < 2; ++_i) \
        __builtin_amdgcn_global_load_lds((const unsigned*)((const char*)(gbase) + (voff)[_i]), (PG8_LAS unsigned*)(lds + (bufoff) + ldsw + _i * 8192), 16, 0, 0); } while (0)
#define PG8_LD8(p) __builtin_shufflevector(*(const PG8_LAS i32x4*)(p), *(const PG8_LAS i32x4*)((p) + 1024), 0, 1, 2, 3, 4, 5, 6, 7)
#define PG8_LDA(dst, b, h) do { _Pragma("unroll") for (int m = 0; m < 4; ++m) { if constexpr (F8) { dst##8[m] = PG8_LD8(lds + PG8_SA(b, h) + aoff + m * 2048); } \
        else { _Pragma("unroll") for (int k = 0; k < 2; ++k) dst[m][k] = *(const PG8_LAS bf16x8*)(lds + PG8_SA(b, h) + aoff + m * 2048 + k * 1024); } } } while (0)
#define PG8_LDB(dst, b, h) do { _Pragma("unroll") for (int n = 0; n < 2; ++n) { if constexpr (F8) { dst##8[n] = PG8_LD8(lds + PG8_SB(b, h) + boff + n * 2048); } \
        else { _Pragma("unroll") for (int k = 0; k < 2; ++k) dst[n][k] = *(const PG8_LAS bf16x8*)(lds + PG8_SB(b, h) + boff + n * 2048 + k * 1024); } } } while (0)
#define PG8_MMA(ai, bj, At, Bt) do { __builtin_amdgcn_s_setprio(1); _Pragma("unroll") for (int m = 0; m < 4; ++m) _Pragma("unroll") for (int n = 0; n < 2; ++n) { \
        if constexpr (F8) { mfma_f8_acc(acc[ai][bj][m][n], Bt##8[n], At##8[m], scw, sca); } \
        else { _Pragma("unroll") for (int k = 0; k < 2; ++k) acc[ai][bj][m][n] = __builtin_amdgcn_mfma_f32_16x16x32_bf16(Bt[n][k], At[m][k], acc[ai][bj][m][n], 0, 0, 0); } } \
        __builtin_amdgcn_s_setprio(0); } while (0)
#define PG8_WAIT_V(n) asm volatile("s_waitcnt vmcnt(" #n ")" ::: "memory")
    constexpr int RELAX = 8 + Epi::NST + (Sched::GATHER ? 4 : 0);
#define PG8_WAIT_V8R(rx) do { if (rx) { if constexpr (RELAX == 12) PG8_WAIT_V(12); else if constexpr (RELAX == 16) PG8_WAIT_V(16); else if constexpr (RELAX == 20) PG8_WAIT_V(20); \
        else if constexpr (RELAX == 24) PG8_WAIT_V(24); else if constexpr (RELAX == 28) PG8_WAIT_V(28); else PG8_WAIT_V(8); } else PG8_WAIT_V(8); } while (0)
#define PG8_WAIT_L(n) asm volatile("s_waitcnt lgkmcnt(" #n ")" ::: "memory")
#define PG8_BAR __builtin_amdgcn_s_barrier()
#define PG8_SCHED __builtin_amdgcn_sched_barrier(0)
#define PG8_VOFF(dst, u) do { _Pragma("unroll") for (int _h = 0; _h < 2; ++_h) _Pragma("unroll") for (int _i = 0; _i < 2; ++_i) { \
        const int _row = Sched::GATHER ? S.row_of(u, _h * HALF + Rr[_i]) : Rr[_i]; dst[_h][_i] = (unsigned)(_row * KB + Cc[_i] * 2); } } while (0)
    Unit cur, nxt; int ui = 0;
    if (!S.next(0, cur)) return;
    f32x4 acc[2][2][4][2];
#pragma unroll
    for (int a = 0; a < 2; ++a)
#pragma unroll
        for (int b = 0; b < 2; ++b)
#pragma unroll
            for (int m = 0; m < 4; ++m)
#pragma unroll
                for (int n = 0; n < 2; ++n) acc[a][b][m][n] = (f32x4){0.f, 0.f, 0.f, 0.f};
    const int scw = F8_SCALE_W, sca = F8_SCALE_A;
    bf16x8 At[4][2], B0[2][2], B1[2][2]; i32x8 At8[4], B08[2], B18[2];
    PG8_VOFF(cvA, cur);
    if (Sched::GATHER) { asm volatile("s_waitcnt vmcnt(0)" ::: "memory"); }
    PG8_STAGE(PG8_SB(0, 0), cur.B0, voffB); PG8_STAGE(PG8_SB(0, 1), cur.B1, voffB); PG8_STAGE(PG8_SA(0, 0), cur.A0, cvA[0]); PG8_STAGE(PG8_SA(0, 1), cur.A1, cvA[1]);
    if (wr == 1) PG8_BAR;
    PG8_WAIT_V(2); PG8_BAR;
    PG8_STAGE(PG8_SB(1, 0), cur.B0 + kstep, voffB); PG8_STAGE(PG8_SA(1, 0), cur.A0 + kstep, cvA[0]); PG8_STAGE(PG8_SB(1, 1), cur.B1 + kstep, voffB);
    PG8_WAIT_V(6); PG8_BAR;
    for (;;) {
        const bool has_next = S.next(ui + 1, nxt);
        if (!has_next) nxt = cur;
        int nraw[2][2];
        if (Sched::GATHER && has_next) {
#pragma unroll
            for (int _h = 0; _h < 2; ++_h)
#pragma unroll
                for (int _i = 0; _i < 2; ++_i) { const int* p_ = S.row_ptr(nxt, _h * HALF + Rr[_i]); asm volatile("global_load_dword %0, %1, off" : "=v"(nraw[_h][_i]) : "v"(p_) : "memory"); }
        }
        if (has_next) { if (!Sched::GATHER) { PG8_VOFF(nvA, nxt); } }
        else {
#pragma unroll
            for (int _h = 0; _h < 2; ++_h)
#pragma unroll
                for (int _i = 0; _i < 2; ++_i) nvA[_h][_i] = cvA[_h][_i]; }
#pragma unroll 1
        for (int t = 0; t < nt; t += 2) {
            const bool last = (t == nt - 2); const bool rx = (t == 0) && (ui > 0);
            if (Epi::MID && t == nt / 2) E.mid(acc, cur, wr, wc, fr, fq);
            const char* a1_1 = cur.A1 + (size_t)((t + 1) % nt1) * kstep;
            const char* a2_0 = last ? nxt.A0 : cur.A0 + (size_t)((t + 2) % nt1) * kstep; const char* a2_1 = last ? nxt.A1 : cur.A1 + (size_t)((t + 2) % nt1) * kstep;
            const char* b2_0 = last ? nxt.B0 : cur.B0 + (size_t)((t + 2) % nt1) * kstep; const char* b2_1 = last ? nxt.B1 : cur.B1 + (size_t)((t + 2) % nt1) * kstep;
            const char* a3_0 = a2_0 + kstep; const char* a3_1 = a2_1 + kstep; const char* b3_0 = b2_0 + kstep; const char* b3_1 = b2_1 + kstep;
            if (Sched::GATHER && last && has_next) {
#pragma unroll
                for (int _h = 0; _h < 2; ++_h)
#pragma unroll
                    for (int _i = 0; _i < 2; ++_i) { int r_ = nraw[_h][_i]; asm volatile("" : "+v"(r_));
                        nvA[_h][_i] = (unsigned)(r_ * KB + Cc[_i] * 2); } }
            unsigned sv0[2], sv1[2];
#pragma unroll
            for (int _i = 0; _i < 2; ++_i) { sv0[_i] = last ? nvA[0][_i] : cvA[0][_i]; sv1[_i] = last ? nvA[1][_i] : cvA[1][_i]; }
            PG8_LDB(B0, 0, 0); PG8_LDB(B1, 0, 1); PG8_SCHED; PG8_LDA(At, 0, 0); PG8_STAGE(PG8_SA(1, 1), a1_1, cvA[1]);
            PG8_WAIT_V8R(rx); PG8_WAIT_L(0); PG8_BAR; PG8_MMA(0, 0, At, B0); PG8_MMA(0, 1, At, B1); PG8_BAR; PG8_SCHED;
            PG8_LDA(At, 0, 1); PG8_STAGE(PG8_SB(0, 0), b2_0, voffB); PG8_STAGE(PG8_SB(0, 1), b2_1, voffB); PG8_STAGE(PG8_SA(0, 0), a2_0, sv0);
            PG8_WAIT_V8R(rx); PG8_WAIT_L(0); PG8_BAR; PG8_MMA(1, 0, At, B0); PG8_MMA(1, 1, At, B1); PG8_BAR; PG8_SCHED;
            PG8_LDB(B0, 1, 0); PG8_LDB(B1, 1, 1); PG8_SCHED; PG8_LDA(At, 1, 0); PG8_STAGE(PG8_SA(0, 1), a2_1, sv1);
            PG8_WAIT_V(8); PG8_WAIT_L(0); PG8_BAR; PG8_MMA(0, 0, At, B0); PG8_MMA(0, 1, At, B1); PG8_BAR; PG8_SCHED;
            PG8_LDA(At, 1, 1); PG8_STAGE(PG8_SB(1, 0), b3_0, voffB); PG8_STAGE(PG8_SB(1, 1), b3_1, voffB); PG8_STAGE(PG8_SA(1, 0), a3_0, sv0);
            PG8_WAIT_V(8); PG8_WAIT_L(0); PG8_BAR; PG8_MMA(1, 0, At, B0); PG8_MMA(1, 1, At, B1); PG8_BAR; PG8_SCHED;
            (void)a3_1; (void)b3_1;
        }
        if (wr == 0) PG8_BAR;
        if constexpr (F8) { asm volatile("s_nop 15\n\ts_nop 15\n\ts_nop 7" ::: "memory"); }
        E(acc, cur, wr, wc, fr, fq);
        if (!has_next) break;
#pragma unroll
        for (int a = 0; a < 2; ++a)
#pragma unroll
            for (int b = 0; b < 2; ++b)
#pragma unroll
                for (int m = 0; m < 4; ++m)
#pragma unroll
                    for (int n = 0; n < 2; ++n) acc[a][b][m][n] = (f32x4){0.f, 0.f, 0.f, 0.f};
        cur = nxt; ++ui;
#pragma unroll
        for (int _h = 0; _h < 2; ++_h)
#pragma unroll
            for (int _i = 0; _i < 2; ++_i) cvA[_h][_i] = nvA[_h][_i];
        if (wr == 1) PG8_BAR;
    }
    PG8_WAIT_V(0);
    PG8_BAR;
#undef PG8_SA
#undef PG8_SB
#undef PG8_STAGE
#undef PG8_LDA
#undef PG8_LDB
#undef PG8_MMA
#undef PG8_LD8
#undef PG8_WAIT_V
#undef PG8_WAIT_V8R
#undef PG8_WAIT_L
#undef PG8_BAR
#undef PG8_SCHED
#undef PG8_VOFF
}
}

namespace pg8 {

struct DenseOrder {
    static constexpr bool GATHER = false;
    const bf16_t* A; const bf16_t* Bt; int nM, nN, nwg, G, c;
    __device__ __forceinline__ void init(const bf16_t* A_, const bf16_t* Bt_, int M, int N, int G_, int c_) { A = A_; Bt = Bt_; nM = M / BM; nN = N / BM; nwg = nM * nN; G = G_; c = c_; }
    __device__ __forceinline__ bool next(int i, Unit& u) const {
        const long L = (long)i * G + c; if (L >= nwg) return false;
        int wgid = (int)L; { const int q = nwg / NXCD, r = nwg % NXCD, xcd = wgid % NXCD, off = wgid / NXCD; wgid = (xcd < r ? xcd * (q + 1) : r * (q + 1) + (xcd - r) * q) + off; }
        const int nig = WGM * nN, gid = wgid / nig, fm = gid * WGM, gsz = (nM - fm) < WGM ? (nM - fm) : WGM;
        u.pm = fm + ((wgid % nig) % gsz); u.pn = (wgid % nig) / gsz; u.e = 0; u.ord = i;
        u.A0 = (const char*)A + (size_t)u.pm * BM * GK * 2; u.A1 = u.A0 + (size_t)HALF * GK * 2;
        u.B0 = (const char*)Bt + (size_t)u.pn * BM * GK * 2; u.B1 = u.B0 + (size_t)HALF * GK * 2;
        return true;
    }
    __device__ __forceinline__ int row_of(const Unit&, int r) const { return r; }
    __device__ __forceinline__ const int* row_ptr(const Unit&, int) const { return nullptr; }
};
struct UpOrder {
    static constexpr bool GATHER = true;
    const unsigned char* H2; const unsigned char* WupT; const int* row_tok; const PG8_LAS int* mt_exp; int nunits, G, c;
    __device__ __forceinline__ bool next(int i, Unit& u) const {
        const int L = i * G + c; if (L >= nunits) return false;
        u.pm = L >> 3; u.pn = L & 7; u.e = __builtin_amdgcn_readfirstlane(mt_exp[u.pm]); u.ord = i;
        u.A0 = (const char*)H2; u.A1 = (const char*)H2;
        u.B0 = (const char*)WupT + ((size_t)u.e * 2 * DEXP + (size_t)u.pn * HALF) * GK; u.B1 = u.B0 + (size_t)DEXP * GK;
        return true;
    }
    __device__ __forceinline__ int row_of(const Unit& u, int r) const { return row_tok[u.pm * BM + r]; }
    __device__ __forceinline__ const int* row_ptr(const Unit& u, int r) const { return row_tok + u.pm * BM + r; }
};
struct DownOrder {
    static constexpr bool GATHER = false;
    const unsigned char* ACT; const unsigned char* WdnT; const PG8_LAS int* mt_exp; int nunits, G, c;
    __device__ __forceinline__ bool next(int i, Unit& u) const {
        const int L = i * G + c; if (L >= nunits) return false;
        u.pm = L >> 2; u.pn = L & 3; u.e = __builtin_amdgcn_readfirstlane(mt_exp[u.pm]); u.ord = i;
        u.A0 = (const char*)ACT + (size_t)u.pm * BM * GK; u.A1 = u.A0 + (size_t)HALF * GK;
        u.B0 = (const char*)WdnT + ((size_t)u.e * DM + (size_t)u.pn * BM) * GK; u.B1 = u.B0 + (size_t)HALF * GK;
        return true;
    }
    __device__ __forceinline__ int row_of(const Unit&, int r) const { return r; }
    __device__ __forceinline__ const int* row_ptr(const Unit&, int) const { return nullptr; }
};

struct EpiProj {
    static constexpr bool PERM = true, MID = false; static constexpr int NST = 16;
    bf16_t* O; size_t tstride; float qscale;
    __device__ __forceinline__ void mid(f32x4 (&)[2][2][4][2], const Unit&, int, int, int, int) const {}
    __device__ __forceinline__ void operator()(const f32x4 (&acc)[2][2][4][2], const Unit& u, int wr, int wc, int fr, int fq) const {
        const int t = u.pn >> 1; bf16_t* base = O + (size_t)t * tstride; const float sc = (t == 2) ? qscale : 1.f;
        const int row0 = u.pm * BM + wr * 64 + fr, col0 = (u.pn & 1) * BM + wc * 32 + 8 * fq;
#pragma unroll
        for (int ai = 0; ai < 2; ++ai)
#pragma unroll
            for (int m = 0; m < 4; ++m) { bf16_t* rowp = base + (size_t)(row0 + ai * HALF + m * 16) * 512 + col0;
#pragma unroll
                for (int bj = 0; bj < 2; ++bj) { const f32x4 v0 = acc[ai][bj][m][0] * sc, v1 = acc[ai][bj][m][1] * sc;
                    u32x4 w; w.x = cvt_pk_bf16(v0[0], v0[1]); w.y = cvt_pk_bf16(v0[2], v0[3]); w.z = cvt_pk_bf16(v1[0], v1[1]); w.w = cvt_pk_bf16(v1[2], v1[3]);
                    *(u32x4*)(rowp + bj * HALF) = w; } }
    }
};
struct EpiOut {
    static constexpr bool PERM = true, MID = true; static constexpr int NST = 0;
    bf16_t* Y; const float* ssq;
    __device__ __forceinline__ void mid(f32x4 (&acc)[2][2][4][2], const Unit& u, int wr, int wc, int fr, int fq) const {
#pragma unroll
        for (int ai = 0; ai < 2; ++ai)
#pragma unroll
            for (int m = 0; m < 4; ++m) { const int row = u.pm * BM + ai * HALF + wr * 64 + m * 16 + fr;
                const f32x4 s0 = *(const f32x4*)(ssq + (size_t)row * 8), s1 = *(const f32x4*)(ssq + (size_t)row * 8 + 4);
                const float tot = ((s0[0] + s0[1]) + (s0[2] + s0[3])) + ((s1[0] + s1[1]) + (s1[2] + s1[3]));
                const float ri = 1.0f / sqrtf(tot * (1.0f / DATT) + RMS_EPS);
#pragma unroll
                for (int bj = 0; bj < 2; ++bj)
#pragma unroll
                    for (int n = 0; n < 2; ++n) acc[ai][bj][m][n] = acc[ai][bj][m][n] * ri; }
    }
    __device__ __forceinline__ void operator()(const f32x4 (&acc)[2][2][4][2], const Unit& u, int wr, int wc, int fr, int fq) const {
        const int row0 = u.pm * BM + wr * 64 + fr, col0 = u.pn * BM + wc * 32 + 8 * fq;
#pragma unroll
        for (int ai = 0; ai < 2; ++ai)
#pragma unroll
            for (int m = 0; m < 4; ++m) { bf16_t* rowp = Y + (size_t)(row0 + ai * HALF + m * 16) * DM + col0;
#pragma unroll
                for (int bj = 0; bj < 2; ++bj) { const f32x4 v0 = acc[ai][bj][m][0], v1 = acc[ai][bj][m][1];
                    u32x4 w; w.x = cvt_pk_bf16(v0[0], v0[1]); w.y = cvt_pk_bf16(v0[2], v0[3]); w.z = cvt_pk_bf16(v1[0], v1[1]); w.w = cvt_pk_bf16(v1[2], v1[3]);
                    *(u32x4*)(rowp + bj * HALF) = w; } }
    }
};
template <bool STORE = true> struct EpiUpT {
    static constexpr bool PERM = true, MID = false; static constexpr int NST = STORE ? 8 : 0;
    unsigned char* ACT; const PG8_LAS float* bias;
    __device__ __forceinline__ void mid(f32x4 (&)[2][2][4][2], const Unit&, int, int, int, int) const {}
    __device__ __forceinline__ void operator()(const f32x4 (&acc)[2][2][4][2], const Unit& u, int wr, int wc, int fr, int fq) const {
        const int row0 = u.pm * BM + wr * 64 + fr, col0 = u.pn * HALF + wc * 32 + 8 * fq;
        const PG8_LAS float* bg = bias + u.ord * 256 + wc * 32 + 8 * fq;
        f32x4 bgl[2], bli[2];
#pragma unroll
        for (int n = 0; n < 2; ++n) { bgl[n] = *(const PG8_LAS f32x4*)(bg + 4 * n); bli[n] = *(const PG8_LAS f32x4*)(bg + HALF + 4 * n) + 1.0f; }
#pragma unroll
        for (int ai = 0; ai < 2; ++ai)
#pragma unroll
            for (int m = 0; m < 4; ++m) { unsigned char* rowp = ACT + (size_t)(row0 + ai * HALF + m * 16) * DEXP + col0;
                f32x4 o[2];
#pragma unroll
                for (int n = 0; n < 2; ++n) { f32x4 g = acc[ai][0][m][n] + bgl[n], l = acc[ai][1][m][n] + bli[n];
#pragma unroll
                    for (int j = 0; j < 4; ++j) { g[j] = fminf(g[j], 7.0f); l[j] = __builtin_amdgcn_fmed3f(l[j], -6.0f, 8.0f); }
                    f32x4 t = g * (-1.702f * 1.4426950408889634f);
#pragma unroll
                    for (int j = 0; j < 4; ++j) t[j] = __builtin_amdgcn_exp2f(t[j]);
                    t = t + 1.0f;
#pragma unroll
                    for (int j = 0; j < 4; ++j) t[j] = __builtin_amdgcn_rcpf(t[j]);
                    o[n] = (g * t) * l; }
                int w0 = 0, w1 = 0; w0 = __builtin_amdgcn_cvt_pk_fp8_f32(o[0][0], o[0][1], w0, false); w0 = __builtin_amdgcn_cvt_pk_fp8_f32(o[0][2], o[0][3], w0, true);
                w1 = __builtin_amdgcn_cvt_pk_fp8_f32(o[1][0], o[1][1], w1, false); w1 = __builtin_amdgcn_cvt_pk_fp8_f32(o[1][2], o[1][3], w1, true);
                typedef int i32x2_ __attribute__((ext_vector_type(2))); if (STORE) *(i32x2_*)rowp = (i32x2_){w0, w1}; else asm volatile("" :: "v"(w0), "v"(w1)); }
    }
};
typedef EpiUpT<true> EpiUp;
struct EpiDown {
    static constexpr bool PERM = true, MID = false; static constexpr int NST = 16;
    unsigned char* YP; const PG8_LAS float* bias; const int* row_pair; const float* row_w;
    __device__ __forceinline__ void mid(f32x4 (&)[2][2][4][2], const Unit&, int, int, int, int) const {}
    __device__ __forceinline__ void operator()(const f32x4 (&acc)[2][2][4][2], const Unit& u, int wr, int wc, int fr, int fq) const {
        const int row0 = u.pm * BM + wr * 64 + fr, col0 = u.pn * BM + wc * 32 + 8 * fq;
        const PG8_LAS float* bd = bias + u.ord * 256 + wc * 32 + 8 * fq;
        f32x4 bv[2][2];
#pragma unroll
        for (int bj = 0; bj < 2; ++bj)
#pragma unroll
            for (int n = 0; n < 2; ++n) bv[bj][n] = *(const PG8_LAS f32x4*)(bd + bj * HALF + 4 * n);
        int pr[2][4]; float wt[2][4];
#pragma unroll
        for (int ai = 0; ai < 2; ++ai)
#pragma unroll
            for (int m = 0; m < 4; ++m) { const int pos = row0 + ai * HALF + m * 16; pr[ai][m] = row_pair[pos]; wt[ai][m] = row_w[pos] * 4.0f; }
#pragma unroll
        for (int ai = 0; ai < 2; ++ai)
#pragma unroll
            for (int m = 0; m < 4; ++m) { const int pair = pr[ai][m] >= 0 ? pr[ai][m] : NTOK * TOPK; const float w = wt[ai][m];
                { unsigned char* rowp = YP + (size_t)pair * DM + col0;
#pragma unroll
                    for (int bj = 0; bj < 2; ++bj) { const f32x4 v0 = (acc[ai][bj][m][0] + bv[bj][0]) * w, v1 = (acc[ai][bj][m][1] + bv[bj][1]) * w;
                        int q0 = 0, q1 = 0; q0 = __builtin_amdgcn_cvt_pk_fp8_f32(v0[0], v0[1], q0, false); q0 = __builtin_amdgcn_cvt_pk_fp8_f32(v0[2], v0[3], q0, true);
                        q1 = __builtin_amdgcn_cvt_pk_fp8_f32(v1[0], v1[1], q1, false); q1 = __builtin_amdgcn_cvt_pk_fp8_f32(v1[2], v1[3], q1, true);
                        typedef int i32x2_ __attribute__((ext_vector_type(2))); *(i32x2_*)(rowp + bj * HALF) = (i32x2_){q0, q1}; } } }
    }
};
#ifdef MK_PROBES
struct EpiNop {
    static constexpr bool PERM = true, MID = false; static constexpr int NST = 0;
    __device__ __forceinline__ void mid(f32x4 (&)[2][2][4][2], const Unit&, int, int, int, int) const {}
    __device__ __forceinline__ void operator()(const f32x4 (&)[2][2][4][2], const Unit&, int, int, int, int) const {}
};
#endif
}

namespace attn_body {
using bf16=__hip_bfloat16;
using bf16x8=__attribute__((ext_vector_type(8)))short;
using s16x4=__attribute__((ext_vector_type(4)))short;
using f32x16=__attribute__((ext_vector_type(16)))float;
using u32x4=__attribute__((ext_vector_type(4)))unsigned;
constexpr int BATCH=8,NHEAD=8,SEQ=2048,D=64,DM=NHEAD*D,OPITCH=1024;
constexpr int NW=8,QBLK=32,QB=QBLK*NW,KVBLK=64,NQB=SEQ/QB;
constexpr int ATTN_PITCH=DM, ATTN_UNIT_ROWS=QB;
__device__ __forceinline__ int crow(int r,int hi){return (r&3)+8*(r>>2)+4*hi;}
#define SBAR() __builtin_amdgcn_sched_barrier(0)
__device__ __forceinline__ void cmask(f32x16&p0,f32x16&p1,int jb,int qrel,int hi){
  const float NEG=-INFINITY; int kb=64*jb+4*hi;
  #pragma unroll
  for(int r=0;r<16;++r){int kv=kb+(r&3)+8*(r>>2); if(kv>qrel)p0[r]=NEG; if(kv+32>qrel)p1[r]=NEG;}
}

constexpr int NSLOT=3, SLOTB=8192;
constexpr int LDS_K=0, LDS_V=NSLOT*SLOTB, LDS_WS=2*NSLOT*SLOTB, LDS_OST=LDS_WS+NW*64*4, LDS_BIAS=LDS_OST+NW*4096, LDS_SCAN=LDS_BIAS+(SEQ+64)*4, LDS_BYTES=LDS_SCAN+256;
constexpr float C2=0.125f*1.4426950408889634f;
__device__ __forceinline__ void glds16(const void*gsrc,unsigned lds_dst){unsigned keep;
  asm volatile("s_mov_b32 %0, m0\n\ts_mov_b32 m0, %2\n\ts_nop 0\n\tglobal_load_lds_dwordx4 %1, off\n\ts_mov_b32 m0, %0":"=&s"(keep):"v"(gsrc),"s"(lds_dst):"memory");}
__device__ __forceinline__ float max3f(float a,float b,float c){float r;asm("v_max3_f32 %0, %1, %2, %3":"=v"(r):"v"(a),"v"(b),"v"(c));return r;}
__device__ __forceinline__ float max2f(float a,float b){float r;asm("v_max_f32_e32 %0, %1, %2":"=v"(r):"v"(a),"v"(b));return r;}
__device__ __forceinline__ float fadd_s(float a,float b){float r;asm("v_add_f32_e32 %0, %1, %2":"=v"(r):"v"(a),"v"(b));return r;}
__device__ __forceinline__ float fsub_s(float a,float b){float r;asm("v_sub_f32_e32 %0, %1, %2":"=v"(r):"v"(a),"v"(b));return r;}
typedef float f32x2_t __attribute__((ext_vector_type(2))); typedef float f32x4_t __attribute__((ext_vector_type(4))); typedef __bf16 bf16x2_t __attribute__((ext_vector_type(2)));
__device__ __forceinline__ unsigned cvtpk_s(float lo,float hi){f32x2_t v={lo,hi};bf16x2_t b=__builtin_convertvector(v,bf16x2_t);return __builtin_bit_cast(unsigned,b);}
#define WAIT_BAR(N) asm volatile("s_waitcnt vmcnt(" #N ") lgkmcnt(0)\n\ts_barrier":::"memory")

__device__ __forceinline__ void qkt(f32x16&p0,f32x16&p1,const char*Kslot,const bf16x8*qr,int r32,int hi){
  const char*kb=Kslot+hi*1024+r32*16;
  #pragma unroll
  for(int d0=0;d0<4;++d0){
    const bf16x8 b0=*reinterpret_cast<const bf16x8*>(kb+d0*2048);
    const bf16x8 b1=*reinterpret_cast<const bf16x8*>(kb+d0*2048+512);
    p0=__builtin_amdgcn_mfma_f32_32x32x16_bf16(b0,qr[d0],p0,0,0,0);p1=__builtin_amdgcn_mfma_f32_32x32x16_bf16(b1,qr[d0],p1,0,0,0);}
}
typedef __attribute__((address_space(3))) const char* lds_cptr;
typedef short v4i16_t __attribute__((ext_vector_type(4)));
__device__ __forceinline__ void kload8(bf16x8*kf,lds_cptr kp){
  kf[0]=*(const __attribute__((address_space(3))) bf16x8*)(kp);      kf[1]=*(const __attribute__((address_space(3))) bf16x8*)(kp+512);
  kf[2]=*(const __attribute__((address_space(3))) bf16x8*)(kp+2048); kf[3]=*(const __attribute__((address_space(3))) bf16x8*)(kp+2560);
  kf[4]=*(const __attribute__((address_space(3))) bf16x8*)(kp+4096); kf[5]=*(const __attribute__((address_space(3))) bf16x8*)(kp+4608);
  kf[6]=*(const __attribute__((address_space(3))) bf16x8*)(kp+6144); kf[7]=*(const __attribute__((address_space(3))) bf16x8*)(kp+6656);
}
__device__ __forceinline__ void kload2(bf16x8*kf,lds_cptr kp,int j){ kf[2*j]=*(const __attribute__((address_space(3))) bf16x8*)(kp+j*2048); kf[2*j+1]=*(const __attribute__((address_space(3))) bf16x8*)(kp+j*2048+512); }
__device__ __forceinline__ s16x4 vtr(lds_cptr p){ return __builtin_bit_cast(s16x4,__builtin_amdgcn_ds_read_tr16_b64_v4i16((__attribute__((address_space(3))) v4i16_t*)p)); }
__device__ __forceinline__ float rowmax(const f32x16&p0,const f32x16&p1){
  float a=max3f(p0[0],p0[1],p1[0]),b=max3f(p0[2],p0[3],p1[1]);a=max3f(a,p1[2],p1[3]);
  #pragma unroll
  for(int r=4;r<16;r+=4){a=max3f(a,p0[r],p0[r+1]);b=max3f(b,p0[r+2],p0[r+3]);a=max3f(a,p1[r],p1[r+1]);b=max3f(b,p1[r+2],p1[r+3]);}
  const float m=max2f(a,b);
  auto rr=__builtin_amdgcn_permlane32_swap(__float_as_uint(m),__float_as_uint(m),false,false);
  return max2f(__uint_as_float(rr[0]),__uint_as_float(rr[1]));
}
__device__ __forceinline__ void pv(f32x16*o,int vb,bf16x8 pa0,bf16x8 pa1,bf16x8 pa2,bf16x8 pa3){
  #pragma unroll
  for(int d0=0;d0<2;++d0){s16x4 lo[4],hi[4];
    #pragma unroll
    for(int ks=0;ks<4;++ks){
      asm volatile("ds_read_b64_tr_b16 %0,%1 offset:%c2":"=&v"(lo[ks]):"v"(vb),"i"(d0*4096+ks*1024):"memory");
      asm volatile("ds_read_b64_tr_b16 %0,%1 offset:%c2":"=&v"(hi[ks]):"v"(vb),"i"(d0*4096+ks*1024+512):"memory");}
    asm volatile("s_waitcnt lgkmcnt(0)":::"memory");SBAR();
    #define PK(k) (bf16x8){lo[k][0],lo[k][1],lo[k][2],lo[k][3],hi[k][0],hi[k][1],hi[k][2],hi[k][3]}
    o[d0]=__builtin_amdgcn_mfma_f32_32x32x16_bf16(pa0,PK(0),o[d0],0,0,0);
    o[d0]=__builtin_amdgcn_mfma_f32_32x32x16_bf16(pa1,PK(1),o[d0],0,0,0);
    o[d0]=__builtin_amdgcn_mfma_f32_32x32x16_bf16(pa2,PK(2),o[d0],0,0,0);
    o[d0]=__builtin_amdgcn_mfma_f32_32x32x16_bf16(pa3,PK(3),o[d0],0,0,0);
    #undef PK
  }
}

#ifndef ATTN_STORE16
#define ATTN_STORE16(p,v) (*(u32x4*)(p)=(v))
#endif
template<int THRL> __device__ __forceinline__ void attn_unit(int b,int h,int qb,const bf16*Q,const bf16*__restrict__ K,const bf16*__restrict__ V,bf16*O,const float*__restrict__ LOGF2,float*SSQ,char*shm){
  const int tid=threadIdx.x,lane=tid&63,r32=lane&31,hi=lane>>5; const int wid=__builtin_amdgcn_readfirstlane(tid>>6);
  const long rowbase=(long)b*SEQ; const int q0=qb*QB;
  const bf16*Qw=Q+(rowbase+q0+wid*QBLK)*DM+h*D;
  const bf16*Kh=K+rowbase*DM+h*D,*Vh=V+rowbase*DM+h*D;
  const unsigned lds0=(unsigned)(uintptr_t)shm;
  float*wsf=(float*)(shm+LDS_WS)+wid*64;
  const bf16*ksrc=Kh+(long)lane*DM+wid*8;
  const bf16*vsrc=Vh+(long)(16*(wid&3)+(lane>>2))*DM+(wid>>2)*32+(lane&3)*8;
  const unsigned kdst=lds0+LDS_K+wid*1024, vdst=lds0+LDS_V+wid*1024;
  #define DMA_K(t,slot) glds16(ksrc+(long)(t)*KVBLK*DM,(unsigned)__builtin_amdgcn_readfirstlane(kdst+(slot)))
  #define DMA_V(t,slot) glds16(vsrc+(long)(t)*KVBLK*DM,(unsigned)__builtin_amdgcn_readfirstlane(vdst+(slot)))
  const int vb0=(int)(lds0+LDS_V)+((lane>>4)&1)*32+(lane&3)*8+(4*hi+((lane&15)>>2))*64;
  const char*Kbase=shm+LDS_K; bf16x8 kf[8];
  const lds_cptr shm3=(lds_cptr)shm; const lds_cptr kp0=shm3+LDS_K+hi*1024+r32*16; const lds_cptr vp0=shm3+LDS_V+((lane>>4)&1)*32+(lane&3)*8+(4*hi+((lane&15)>>2))*64;
  const int NT=(q0+QB)/KVBLK;
  const lds_cptr biasr=(lds_cptr)shm+LDS_BIAS+16*hi;
  #define BIAS4(t,o) (*(const __attribute__((address_space(3))) f32x4_t*)(biasr+(t)*(KVBLK*4)+(o)*4))
  #define INIT4(Y,g,t,o) do{ const f32x4_t x_=BIAS4(t,(o)+8*(g)); Y[4*(g)]=x_[0]-mhat; Y[4*(g)+1]=x_[1]-mhat; Y[4*(g)+2]=x_[2]-mhat; Y[4*(g)+3]=x_[3]-mhat; }while(0)
  #define INITT(Y0,Y1,t) do{ INIT4(Y0,0,t,0);INIT4(Y0,1,t,0);INIT4(Y0,2,t,0);INIT4(Y0,3,t,0); INIT4(Y1,0,t,32);INIT4(Y1,1,t,32);INIT4(Y1,2,t,32);INIT4(Y1,3,t,32); }while(0)
  DMA_K(0,0);DMA_V(0,0);DMA_K(1,SLOTB);
  bf16x8 qr[4];
  #pragma unroll
  for(int d0=0;d0<4;++d0)qr[d0]=*reinterpret_cast<const bf16x8*>(&Qw[(long)r32*DM+d0*16+hi*8]);
  float mhat,l_reg=0.f;f32x16 o[2];o[0]=f32x16{};o[1]=f32x16{};
  const int qrel=wid*QBLK+r32;
  #define CMASK(P0,P1,t) do{int jb_=(t)-(NT-4); if(jb_>=0)cmask(P0,P1,jb_,qrel,hi);}while(0)
  bool resc=false;
  #define START(P0,P1) do{ const float rm=rowmax(P0,P1); resc=false; \
    { const float dl=__builtin_fmaxf(rm,0.f); mhat=fadd_s(mhat,dl); \
      _Pragma("unroll") for(int r=0;r<16;++r){P0[r]=fsub_s(P0[r],dl);P1[r]=fsub_s(P1[r],dl);} } \
    _Pragma("unroll") for(int r=0;r<16;++r)P0[r]=__builtin_amdgcn_exp2f(P0[r]); }while(0)
  #define RESC() do{ if(resc){ asm volatile("s_waitcnt lgkmcnt(0)":::"memory"); \
      _Pragma("unroll") for(int d_=0;d_<2;++d_) _Pragma("unroll") for(int r=0;r<16;++r)o[d_][r]*=wsf[crow(r,hi)]; } }while(0)
  f32x16 pA0,pA1,pB0,pB1;
  int sl_prev=0,sl_cur=0,sl_next=SLOTB;
  #define ROT() do{sl_prev=sl_cur;sl_cur=sl_next;sl_next=(sl_next==(NSLOT-1)*SLOTB)?0:sl_next+SLOTB;}while(0)
  DMA_K(2,2*SLOTB);
  { float*biasl=(float*)(shm+LDS_BIAS); float*scn=(float*)(shm+LDS_SCAN);
    const float*lf=LOGF2+rowbase*NHEAD+h;
    float v0=0.f,v1=0.f,v2=0.f,v3=0.f; const int i0=4*tid;
    if(i0<q0){ v0=lf[(long)(q0-1-i0)*NHEAD]; v1=lf[(long)(q0-2-i0)*NHEAD]; v2=lf[(long)(q0-3-i0)*NHEAD]; v3=lf[(long)(q0-4-i0)*NHEAD]; }
    const float tsum=(v0+v1)+(v2+v3); float inc=tsum;
    #pragma unroll
    for(int o=1;o<64;o<<=1){ const float n_=__shfl_up(inc,o); if(lane>=o)inc+=n_; }
    if(lane==63)scn[wid]=inc;
    const float f0=lf[(long)(q0+4*lane)*NHEAD],f1=lf[(long)(q0+4*lane+1)*NHEAD],f2=lf[(long)(q0+4*lane+2)*NHEAD],f3=lf[(long)(q0+4*lane+3)*NHEAD];
    float finc=(f0+f1)+(f2+f3);
    #pragma unroll
    for(int o=1;o<64;o<<=1){ const float n_=__shfl_up(finc,o); if(lane>=o)finc+=n_; }
    const float fex=finc-((f0+f1)+(f2+f3));
    if(wid==0){ biasl[q0+4*lane]=-(fex+f0); biasl[q0+4*lane+1]=-(fex+f0+f1); biasl[q0+4*lane+2]=-(fex+f0+f1+f2); biasl[q0+4*lane+3]=-(fex+f0+f1+f2+f3); }
    __syncthreads();
    float woff=0.f;
    #pragma unroll
    for(int w_=0;w_<NW;++w_) woff+=(w_<wid)?scn[w_]:0.f;
    const float ex=woff+inc-tsum;
    if(i0<q0){ biasl[q0-1-i0]=ex; biasl[q0-2-i0]=ex+v0; biasl[q0-3-i0]=ex+v0+v1; biasl[q0-4-i0]=ex+v0+v1+v2; }
    __syncthreads(); }
  mhat=((const float*)(shm+LDS_BIAS))[q0+wid*QBLK+r32]+8.0f;

  WAIT_BAR(3);
  INITT(pA0,pA1,0); qkt(pA0,pA1,Kbase,qr,r32,hi);asm volatile("s_nop 15\n\ts_nop 7":"+v"(pA0),"+v"(pA1));CMASK(pA0,pA1,0);
  START(pA0,pA1);
  _Pragma("unroll") for(int r=0;r<16;++r)pA1[r]=__builtin_amdgcn_exp2f(pA1[r]);
  INITT(pB0,pB1,1);
  WAIT_BAR(0);
  DMA_K(3,0);DMA_V(1,SLOTB);
  ROT();
  kload8(kf,kp0+sl_cur);
  WAIT_BAR(2);
  s16x4 vlo[8],vhi[8]; u32x4 pw0,pw1,pw2,pw3;
  #define PKW(P,B) cvtpk_s(P[B],P[B+1])
  #define PAF(k) __builtin_bit_cast(bf16x8,pw##k)
  #define VFR(i) (bf16x8){vlo[i][0],vlo[i][1],vlo[i][2],vlo[i][3],vhi[i][0],vhi[i][1],vhi[i][2],vhi[i][3]}
  #define PIN(x) asm volatile("":"+v"(x))
  #define MX3(a,b,c) __builtin_fmaxf(__builtin_fmaxf((a),(b)),(c))
  #define GAPA(MF,A0,A1,A2,A3,W0,W1,PW) do{ MF; sacc+=A0; sacc+=A1; sacc+=A2; sacc+=A3; PIN(sacc); W0; W1; PIN(PW); SBAR(); }while(0)
  #define EX(v) __builtin_amdgcn_exp2f(v)
  #define GAPB(MF,X,B,GN,Y,tn,o) do{ MF; X[B]=EX(X[B]); X[B+1]=EX(X[B+1]); X[B+2]=EX(X[B+2]); X[B+3]=EX(X[B+3]); PIN(X); if(GN){ INIT4(Y,(B)/4,tn,o); PIN(Y); } SBAR(); }while(0)
  #define VRD(i) do{ vlo[i]=vtr(vp_+(((i)>>2)*4096+((i)&3)*1024)); vhi[i]=vtr(vp_+(((i)>>2)*4096+((i)&3)*1024+512)); }while(0)
  #define KRD(G,j) do{ if(G){ kload2(kf,kp0+sl_next,j); SBAR(); } }while(0)
  #define STEP(C0,C1,P0,P1,t,GK,GV,GL) do{ SBAR(); \
    const lds_cptr vp_=vp0+sl_prev; \
    VRD(0); SBAR(); float sacc=(P0[0]+P0[1]); \
    GAPA(C0=__builtin_amdgcn_mfma_f32_32x32x16_bf16(kf[0],qr[0],C0,0,0,0), P0[2],P0[3],P0[4],P0[5],     pw0[0]=PKW(P0,0), pw0[1]=PKW(P0,2), pw0); \
    VRD(4); SBAR(); GAPA(C1=__builtin_amdgcn_mfma_f32_32x32x16_bf16(kf[1],qr[0],C1,0,0,0), P0[6],P0[7],P0[8],P0[9],     pw0[2]=PKW(P0,4), pw0[3]=PKW(P0,6), pw0); \
    VRD(1); SBAR(); GAPA(C0=__builtin_amdgcn_mfma_f32_32x32x16_bf16(kf[2],qr[1],C0,0,0,0),   P0[10],P0[11],P0[12],P0[13], pw1[0]=PKW(P0,8), pw1[1]=PKW(P0,10), pw1); \
    VRD(5); SBAR(); GAPA(C1=__builtin_amdgcn_mfma_f32_32x32x16_bf16(kf[3],qr[1],C1,0,0,0),   P0[14],P0[15],P1[0],P1[1],   pw1[2]=PKW(P0,12),pw1[3]=PKW(P0,14), pw1); \
    VRD(2); SBAR(); GAPA(C0=__builtin_amdgcn_mfma_f32_32x32x16_bf16(kf[4],qr[2],C0,0,0,0),   P1[2],P1[3],P1[4],P1[5],     pw2[0]=PKW(P1,0), pw2[1]=PKW(P1,2), pw2); \
    VRD(6); SBAR(); GAPA(C1=__builtin_amdgcn_mfma_f32_32x32x16_bf16(kf[5],qr[2],C1,0,0,0),   P1[6],P1[7],P1[8],P1[9],     pw2[2]=PKW(P1,4), pw2[3]=PKW(P1,6), pw2); \
    VRD(3); SBAR(); GAPA(C0=__builtin_amdgcn_mfma_f32_32x32x16_bf16(kf[6],qr[3],C0,0,0,0),   P1[10],P1[11],P1[12],P1[13], pw3[0]=PKW(P1,8), pw3[1]=PKW(P1,10), pw3); \
    VRD(7); SBAR(); GAPA(C1=__builtin_amdgcn_mfma_f32_32x32x16_bf16(kf[7],qr[3],C1,0,0,0),   P1[14],P1[15],0.f,0.f,       pw3[2]=PKW(P1,12),pw3[3]=PKW(P1,14), pw3); \
    l_reg+=sacc; \
    if(GK){DMA_K((t)+3,sl_cur);} if(GV){DMA_V((t)+1,sl_next);} \
    CMASK(C0,C1,t); \
    { float a=MX3(C0[0],C0[1],C1[0]),b=MX3(C0[2],C0[3],C1[1]); a=MX3(a,C1[2],C1[3]); \
      _Pragma("unroll") for(int r=4;r<16;r+=4){a=MX3(a,C0[r],C0[r+1]);b=MX3(b,C0[r+2],C0[r+3]);a=MX3(a,C1[r],C1[r+1]);b=MX3(b,C1[r+2],C1[r+3]);} \
      float rm=__builtin_fmaxf(a,b); { auto rr=__builtin_amdgcn_permlane32_swap(__float_as_uint(rm),__float_as_uint(rm),false,false); rm=__builtin_fmaxf(__uint_as_float(rr[0]),__uint_as_float(rr[1])); } \
      resc=false; \
      if(__builtin_expect(__any(rm>(float)THRL),0)){ const float dl=__builtin_fmaxf(rm,0.f); mhat+=dl; \
        _Pragma("unroll") for(int r=0;r<16;++r){C0[r]-=dl;C1[r]-=dl;} \
        const float f=__builtin_amdgcn_exp2f(-dl); l_reg*=f; if(hi==0)wsf[r32]=f; resc=true; } } \
    SBAR(); \
    GAPB(o[0]=__builtin_amdgcn_mfma_f32_32x32x16_bf16(PAF(0),VFR(0),o[0],0,0,0), C0,0,  GL,P0,(t)+1,0); \
    GAPB(o[1]=__builtin_amdgcn_mfma_f32_32x32x16_bf16(PAF(0),VFR(4),o[1],0,0,0), C0,4,  GL,P0,(t)+1,0); \
    KRD(GL,0); GAPB(o[0]=__builtin_amdgcn_mfma_f32_32x32x16_bf16(PAF(1),VFR(1),o[0],0,0,0), C0,8,  GL,P0,(t)+1,0); \
    KRD(GL,1); GAPB(o[1]=__builtin_amdgcn_mfma_f32_32x32x16_bf16(PAF(1),VFR(5),o[1],0,0,0), C0,12, GL,P0,(t)+1,0); \
    KRD(GL,2); GAPB(o[0]=__builtin_amdgcn_mfma_f32_32x32x16_bf16(PAF(2),VFR(2),o[0],0,0,0), C1,0,  GL,P1,(t)+1,32); \
    KRD(GL,3); GAPB(o[1]=__builtin_amdgcn_mfma_f32_32x32x16_bf16(PAF(2),VFR(6),o[1],0,0,0), C1,4,  GL,P1,(t)+1,32); \
    GAPB(o[0]=__builtin_amdgcn_mfma_f32_32x32x16_bf16(PAF(3),VFR(3),o[0],0,0,0), C1,8,  GL,P1,(t)+1,32); \
    GAPB(o[1]=__builtin_amdgcn_mfma_f32_32x32x16_bf16(PAF(3),VFR(7),o[1],0,0,0), C1,12, GL,P1,(t)+1,32); \
    }while(0)
  int t=1;
  #undef CMASK
  #define CMASK(P0,P1,t) do{}while(0)
  for(;t+5<NT;t+=2){
    STEP(pB0,pB1,pA0,pA1,t,true,true,true);     WAIT_BAR(2); RESC(); ROT();
    STEP(pA0,pA1,pB0,pB1,t+1,true,true,true);   WAIT_BAR(2); RESC(); ROT();
  }
  #undef CMASK
  #define CMASK(P0,P1,t) do{int jb_=(t)-(NT-4); if(jb_>=0)cmask(P0,P1,jb_,qrel,hi);}while(0)
  #define ENDW(tt) do{ if((tt)+3<NT){WAIT_BAR(2);} else if((tt)+2<NT){WAIT_BAR(1);} else {WAIT_BAR(0);} }while(0)
  for(;t+1<NT;t+=2){
    STEP(pB0,pB1,pA0,pA1,t,(t+3<NT),(t+1<NT),(t+1<NT));       ENDW(t);   RESC(); ROT();
    STEP(pA0,pA1,pB0,pB1,t+1,(t+4<NT),(t+2<NT),(t+2<NT));     ENDW(t+1); RESC(); ROT();
  }
  STEP(pB0,pB1,pA0,pA1,NT-1,false,false,false); RESC();
  { float sacc=pB0[0]+pB0[1]; _Pragma("unroll") for(int r=2;r<16;++r)sacc+=pB0[r]; _Pragma("unroll") for(int r=0;r<16;++r)sacc+=pB1[r]; l_reg+=sacc;
    pw0=(u32x4){PKW(pB0,0),PKW(pB0,2),PKW(pB0,4),PKW(pB0,6)};pw1=(u32x4){PKW(pB0,8),PKW(pB0,10),PKW(pB0,12),PKW(pB0,14)};pw2=(u32x4){PKW(pB1,0),PKW(pB1,2),PKW(pB1,4),PKW(pB1,6)};pw3=(u32x4){PKW(pB1,8),PKW(pB1,10),PKW(pB1,12),PKW(pB1,14)};
    SBAR(); pv(o,vb0+sl_cur,PAF(0),PAF(1),PAF(2),PAF(3)); }
  #undef PKW
  #undef PAF
  #undef VFR
  #undef PIN
  #undef MX3
  #undef GAPA
  #undef GAPB
  #undef EX
  #undef VRD
  #undef KRD
  #undef STEP
  #undef ENDW
  {auto rr=__builtin_amdgcn_permlane32_swap(__float_as_uint(l_reg),__float_as_uint(l_reg),false,false);l_reg=__uint_as_float(rr[0])+__uint_as_float(rr[1]);}
  if(hi==0)wsf[32+r32]=l_reg;asm volatile("s_waitcnt lgkmcnt(0)":::"memory");
  float rli[16];
  #pragma unroll
  for(int r=0;r<16;++r)rli[r]=__builtin_amdgcn_rcpf(wsf[32+crow(r,hi)]);
  bf16*Ow=O+(rowbase+q0+wid*QBLK)*OPITCH+h*D; float*Sw=SSQ+(rowbase+q0+wid*QBLK)*NHEAD+h;
  { bf16*stg=(bf16*)(shm+LDS_OST)+wid*2048;
    #pragma unroll
    for(int r=0;r<16;++r){const int orow=crow(r,hi);
      #pragma unroll
      for(int d0=0;d0<2;++d0)stg[orow*64+d0*32+r32]=__float2bfloat16(o[d0][r]*rli[r]);}
    asm volatile("s_waitcnt lgkmcnt(0)":::"memory");
    #pragma unroll
    for(int i=0;i<4;++i){const int row=i*8+(lane>>3),ch=lane&7; const u32x4 v=*(const u32x4*)(stg+row*64+ch*8); ATTN_STORE16(Ow+(long)row*OPITCH+ch*8,v);
      float sq=0.f;
      #pragma unroll
      for(int j=0;j<4;++j){ const float lo_=__uint_as_float(v[j]<<16), hi_=__uint_as_float(v[j]&0xffff0000u); sq+=lo_*lo_+hi_*hi_; }
      sq+=__shfl_xor(sq,1); sq+=__shfl_xor(sq,2); sq+=__shfl_xor(sq,4);
      if(ch==0)Sw[(long)row*NHEAD]=sq; } }
  asm volatile("s_waitcnt lgkmcnt(0)\n\ts_barrier":::"memory");
  #undef DMA_K
  #undef BIAS4
  #undef INIT4
  #undef INITT
  #undef DMA_V
  #undef CMASK
  #undef START
  #undef RESC
  #undef ROT
}
constexpr int ATTN_LDS_BYTES=LDS_BYTES;
struct AttnTensors { const bf16* Q; const bf16* K; const bf16* V; bf16* O; const float* LOGF2; float* SSQ; };
struct AttnUnit { int bh; int qb; };
struct StaticOrder {
  int vcu,G;
  __device__ __forceinline__ explicit StaticOrder(int grid,int vcu_):vcu(vcu_),G(grid){}
  __device__ __forceinline__ bool next(int i,AttnUnit&u)const{ const int L=(i>>1)*G+vcu; if(L>=BATCH*NHEAD*4)return false; const int s=L&3; u.bh=L>>2; u.qb=(i&1)?7-s:s; return true; }
  __device__ __forceinline__ void a_ready(const AttnUnit&)const{}
  __device__ __forceinline__ void done(const AttnUnit&)const{}
};
template<class Sched,int THRL=8> __device__ __forceinline__ void attn_phase(char*lds,const AttnTensors&T,const Sched&S){
  AttnUnit u;
  for(int i=0;S.next(i,u);++i){ S.a_ready(u); attn_unit<THRL>(u.bh/NHEAD,u.bh%NHEAD,u.qb,T.Q,T.K,T.V,T.O,T.LOGF2,T.SSQ,lds); S.done(u); }
}
#undef SBAR
#undef WAIT_BAR
}

constexpr int NWAVES = 8;
constexpr int NPHASES = 11;

constexpr size_t MiB = 1u << 20, KiB = 1u << 10;
constexpr size_t WS_CTL = 0, CTL_ZERO_BYTES = 1 * MiB;
constexpr size_t WS_MOD = 1 * MiB;
constexpr size_t WS_LOGF2 = 1 * MiB + 256 * KiB;
constexpr size_t WS_SSQ = 1 * MiB + 768 * KiB;
constexpr size_t WS_TOPI = 2 * MiB + 256 * KiB;
constexpr size_t WS_TOPW = 2 * MiB + 512 * KiB;
constexpr size_t WS_WGCNT = 2 * MiB + 768 * KiB;
constexpr size_t WS_LSUM = 3 * MiB;
constexpr size_t WS_ROWTOK = 4 * MiB, WS_ROWPAIR = 4 * MiB + 512 * KiB, WS_ROWW = 5 * MiB, WS_MTEXP = 5 * MiB + 512 * KiB;
constexpr size_t WS_LWT = 6 * MiB;
constexpr size_t WS_WFT = 6 * MiB + 512 * KiB;
constexpr size_t WS_WRT = 7 * MiB;
constexpr size_t WS_WIN = 8 * MiB;
constexpr size_t WS_WOUT = 13 * MiB;
constexpr size_t WS_WUP = 16 * MiB;
constexpr size_t WS_WDN = 144 * MiB;
constexpr size_t WS_H1 = 208 * MiB;
constexpr size_t WS_XMID = WS_H1;
constexpr size_t WS_PJ = 240 * MiB;
constexpr size_t PJ_STRIDE = (size_t)NTOK * 512;
constexpr size_t WS_MRG = 320 * MiB;
constexpr size_t WS_Y = 352 * MiB;
constexpr size_t WS_H2 = 416 * MiB;
constexpr size_t WS_ACT = 448 * MiB;
constexpr size_t WS_YP = 592 * MiB;
constexpr size_t WS_LTOK = 720 * MiB, WS_LPAIR = 722 * MiB, WS_LW = 724 * MiB;
constexpr size_t WS_END = 726 * MiB;
static_assert(WS_ACT + (size_t)MAXROWS * 1024 * 2 <= WS_YP && WS_YP + (size_t)NTOK * 4 * 1024 * 2 <= WS_END, "d_ws map");
constexpr int CW_CNT = 200000;
constexpr int CW_BAR = 4096;

constexpr int LDS_BYTES = 147456;
constexpr int LDSCTL_OFF = LDS_BYTES - 512, MISC_OFF = LDSCTL_OFF + 320;
constexpr int SCRATCH_BYTES = LDSCTL_OFF;

#define GAS __attribute__((address_space(1)))
#define LAS __attribute__((address_space(3)))
typedef unsigned short bf16;
typedef unsigned v4u __attribute__((ext_vector_type(4)));
typedef unsigned v2u __attribute__((ext_vector_type(2)));
typedef float f32x4 __attribute__((ext_vector_type(4)));
typedef float f32x16 __attribute__((ext_vector_type(16)));
typedef short bf16x8 __attribute__((ext_vector_type(8)));
typedef GAS unsigned gu32;
#define RLX_AGENT __ATOMIC_RELAXED, __HIP_MEMORY_SCOPE_AGENT
#define LDS_WAIT() asm volatile("s_waitcnt lgkmcnt(0)" ::: "memory")
#define VM_WAIT() asm volatile("s_waitcnt vmcnt(0)" ::: "memory")
typedef float f32x2_cv __attribute__((ext_vector_type(2))); typedef __bf16 bf16x2_cv __attribute__((ext_vector_type(2)));
__device__ __forceinline__ unsigned pk2(float lo, float hi) { const f32x2_cv v = {lo, hi}; return __builtin_bit_cast(unsigned, __builtin_convertvector(v, bf16x2_cv)); }
__device__ __forceinline__ unsigned f2bf(float f) { return pk2(f, 0.f) & 0xffffu; }
__device__ __forceinline__ float bflo(unsigned w) { return __uint_as_float(w << 16); }
__device__ __forceinline__ float bfhi(unsigned w) { return __uint_as_float(w & 0xffff0000u); }
__device__ __forceinline__ float bf1(bf16 h) { return __uint_as_float((unsigned)h << 16); }

#define XB_TMO      128
#define XB_XCNT(j)  (256  + 64 * (j))
#define XB_XSUB(j)  (1280 + 64 * (j))
#define XB_XFLAG    3328
#define XCD_BAR_WORDS 3456
#define XB_SPIN_CAP (1u << 18)
__device__ __forceinline__ unsigned xb_ld(unsigned* p)              { return __hip_atomic_load(p, __ATOMIC_RELAXED, __HIP_MEMORY_SCOPE_AGENT); }
__device__ __forceinline__ unsigned xb_add(unsigned* p, unsigned v) { return __hip_atomic_fetch_add(p, v, __ATOMIC_RELAXED, __HIP_MEMORY_SCOPE_AGENT); }
__device__ __forceinline__ unsigned xb_xcc_id() { return (unsigned)__builtin_amdgcn_s_getreg((3 << 11) | 20) & 0xFu; }
struct XcdBarrier { unsigned* bar; unsigned x; volatile LAS unsigned* st; };
__device__ __forceinline__ XcdBarrier xcd_barrier_post(unsigned* bar, volatile LAS unsigned* st) {
    XcdBarrier b; b.bar = bar; b.x = xb_xcc_id(); b.st = st;
    if (threadIdx.x == 0) (void)xb_add(&bar[XB_XCNT(b.x)], 1u);
    return b;
}
__device__ __forceinline__ void xcd_barrier_complete(unsigned* bar, unsigned x, unsigned& nloc, unsigned& mask) {
    const unsigned G = gridDim.x * gridDim.y * gridDim.z;
    unsigned sum, msk, mine, sp = 0u;
    for (;;) {
        sum = 0u; msk = 0u; mine = 0u;
#pragma unroll
        for (unsigned j = 0; j < 16; ++j) { const unsigned c = xb_ld(&bar[XB_XCNT(j)]); sum += c; msk |= (c > 0u) ? (1u << j) : 0u; mine = (j == x) ? c : mine; }
        if (sum == G) break;
        __builtin_amdgcn_s_sleep(1);
        if ((++sp & 255u) == 0u) { if (xb_ld(&bar[XB_TMO])) break; if (sp > XB_SPIN_CAP) { atomicAdd(&bar[XB_TMO], 1u); break; } }
    }
    nloc = mine > 0u ? mine : 1u; mask = msk | (1u << x);
}
template <class Hook> __device__ __forceinline__ void xcd_barrier(const XcdBarrier& b, const Hook& hook) {
    asm volatile("s_waitcnt vmcnt(0)" ::: "memory");
    __syncthreads();
    if (threadIdx.x >= 64) { hook(); asm volatile("s_waitcnt vmcnt(0)" ::: "memory"); }
    else {
        unsigned* bar = b.bar;
        const unsigned lane = threadIdx.x;
        unsigned want = 0u, mask = 0u;
        if (lane == 0) {
            __builtin_amdgcn_s_waitcnt(0);
            unsigned nloc = b.st[0], m = b.st[1];
            if (nloc == 0u) { xcd_barrier_complete(bar, b.x, nloc, m); b.st[0] = nloc; b.st[1] = m; }
            const unsigned old = xb_add(&bar[XB_XSUB(b.x)], 1u);
            const unsigned gen = old / nloc;
            if (old + 1u == (gen + 1u) * nloc) {
                __builtin_amdgcn_fence(__ATOMIC_RELEASE, "agent");
                asm volatile("s_waitcnt vmcnt(0)" ::: "memory");
                __hip_atomic_store(&bar[XB_XFLAG + b.x], gen + 1u, __ATOMIC_RELAXED, __HIP_MEMORY_SCOPE_AGENT);
            }
            want = gen + 1u; mask = m;
        }
        want = (unsigned)__builtin_amdgcn_readfirstlane((int)want); mask = (unsigned)__builtin_amdgcn_readfirstlane((int)mask);
        const bool mine = lane < 16u && ((mask >> (lane & 15u)) & 1u) != 0u;
        unsigned sp = 0u;
        for (;;) {
            unsigned v = want; if (mine) v = xb_ld(&bar[XB_XFLAG + lane]);
            if (__builtin_amdgcn_ballot_w64((int)(v - want) < 0) == 0ull) break;
            __builtin_amdgcn_s_sleep(1);
            if ((++sp & 255u) == 0u) { if (xb_ld(&bar[XB_TMO])) break; if (sp > XB_SPIN_CAP) { if (lane == 0) atomicAdd(&bar[XB_TMO], 1u); break; } }
        }
        __builtin_amdgcn_fence(__ATOMIC_ACQUIRE, "agent");
        asm volatile("s_waitcnt vmcnt(0)" ::: "memory");
    }
    __syncthreads();
}
__device__ __forceinline__ void xcd_barrier(const XcdBarrier& b) { xcd_barrier(b, [] {}); }

struct Args { const float* in[26]; float* out; unsigned char* ws; int ph_lo, ph_hi, li, pad; };
struct Frame {
    LAS unsigned char* lds;
    int tid, lane, wave, vcu, G;
    float* out; unsigned char* ws;
    __device__ __forceinline__ const float* in(int k) const { const LAS unsigned* t = (const LAS unsigned*)(lds + LDSCTL_OFF) + 2 * k;
        const unsigned lo = (unsigned)__builtin_amdgcn_readfirstlane((int)t[0]), hi = (unsigned)__builtin_amdgcn_readfirstlane((int)t[1]);
        return (const float*)(const GAS float*)(((unsigned long long)hi << 32) | lo); }
};
template <int CTRL> __device__ __forceinline__ float dpp_mov(float x) { return __builtin_bit_cast(float, __builtin_amdgcn_update_dpp(0, __builtin_bit_cast(int, x), CTRL, 0xF, 0xF, false)); }
__device__ __forceinline__ float lane_xor1(float x) { return dpp_mov<0xB1>(x); }
__device__ __forceinline__ float lane_xor2(float x) { return dpp_mov<0x4E>(x); }
__device__ __forceinline__ float lane_xor4(float x) { return dpp_mov<0x1B>(dpp_mov<0x141>(x)); }
__device__ __forceinline__ float lane_xor8(float x) { return dpp_mov<0x128>(x); }
__device__ __forceinline__ void swap_rows16(float& a, float& b) { asm volatile("s_nop 1\n\tv_permlane16_swap_b32 %0, %1" : "+v"(a), "+v"(b)); }
__device__ __forceinline__ void swap_half32(float& a, float& b) { asm volatile("s_nop 1\n\tv_permlane32_swap_b32 %0, %1" : "+v"(a), "+v"(b)); }
__device__ __forceinline__ float wave_sum(float v) {
    v += lane_xor1(v); v += lane_xor2(v); v += lane_xor4(v); v += lane_xor8(v);
    { float a = v, b = v; swap_rows16(a, b); v = a + b; }
    { float a = v, b = v; swap_half32(a, b); v = a + b; }
    return v;
}
__device__ __forceinline__ float wave_max(float v) {
    v = fmaxf(v, lane_xor1(v)); v = fmaxf(v, lane_xor2(v)); v = fmaxf(v, lane_xor4(v)); v = fmaxf(v, lane_xor8(v));
    { float a = v, b = v; swap_rows16(a, b); v = fmaxf(a, b); }
    { float a = v, b = v; swap_half32(a, b); v = fmaxf(a, b); }
    return v;
}
__device__ __forceinline__ float sigmoid_f(float x) { return __builtin_amdgcn_rcpf(1.0f + __builtin_amdgcn_exp2f(-1.4426950408889634f * x)); }
__device__ __forceinline__ float gelu_tanh_f(float x) { const float u = 0.7978845608028654f * (x + 0.044715f * x * x * x); const float e = __builtin_amdgcn_exp2f(2.8853900817779268f * u); return x * (1.0f - __builtin_amdgcn_rcpf(e + 1.0f)); }
__device__ __forceinline__ float log_sigmoid_f(float z) { return z >= 0.f ? -log1pf(expf(-z)) : z - log1pf(expf(z)); }
__device__ __forceinline__ float softplus_f(float z) { return z > 0.f ? z + log1pf(expf(-z)) : log1pf(expf(z)); }

__device__ __forceinline__ void p0_transpose_item(const float* W, int ldw, bf16* WT, int k0, int n0, int kdst0, const float* gain, LAS float* scr, int lane) {
#pragma unroll 8
    for (int i = 0; i < 32; ++i) { const int kk = 2 * i + (lane >> 5); float v = W[(size_t)(k0 + kk) * ldw + n0 + (lane & 31)]; if (gain) v *= gain[k0 + kk]; scr[kk * 33 + (lane & 31)] = v; }
    LDS_WAIT(); asm volatile("" ::: "memory");
    const int c = lane & 7;
#pragma unroll
    for (int j = 0; j < 4; ++j) { const int n = (lane >> 3) + 8 * j; const LAS float* s = scr + (8 * c) * 33 + n;
        v4u o; o.x = pk2(s[0 * 33], s[1 * 33]); o.y = pk2(s[2 * 33], s[3 * 33]); o.z = pk2(s[4 * 33], s[5 * 33]); o.w = pk2(s[6 * 33], s[7 * 33]);
        *(GAS v4u*)(WT + (size_t)(n0 + n) * 1024 + kdst0 + 8 * c) = o; }
    LDS_WAIT(); asm volatile("" ::: "memory");
}
constexpr int CV_UP_ITEMS = NE * 16 * 32, CV_DN_ITEMS = NE * 16 * 16;
constexpr int CV_UP_TAIL = 8192, CV_DN_TAIL = 4096;
__device__ __forceinline__ void cvt_block_f8(const float* W, int ldw, unsigned char* WT, LAS unsigned char* scr, int lane) {
    float v[64];
#pragma unroll
    for (int i = 0; i < 64; ++i) v[i] = W[(size_t)i * ldw + lane];
#pragma unroll
    for (int q = 0; q < 4; ++q) { int w[4];
#pragma unroll
        for (int j = 0; j < 4; ++j) { int t = 0; t = __builtin_amdgcn_cvt_pk_fp8_f32(v[16 * q + 4 * j] * 64.0f, v[16 * q + 4 * j + 1] * 64.0f, t, false); t = __builtin_amdgcn_cvt_pk_fp8_f32(v[16 * q + 4 * j + 2] * 64.0f, v[16 * q + 4 * j + 3] * 64.0f, t, true); w[j] = t; }
        *(LAS v4u*)(scr + lane * 80 + 16 * q) = (v4u){(unsigned)w[0], (unsigned)w[1], (unsigned)w[2], (unsigned)w[3]}; }
    LDS_WAIT(); asm volatile("" ::: "memory");
#pragma unroll
    for (int j = 0; j < 4; ++j) { const int row = 16 * j + (lane >> 2), c = lane & 3;
        *(GAS v4u*)(WT + (size_t)row * 1024 + 16 * c) = *(const LAS v4u*)(scr + row * 80 + 16 * c); }
    LDS_WAIT(); asm volatile("" ::: "memory");
}
__device__ __forceinline__ void cvt_up_item(Frame& F, int u) { const int e = u >> 9, q = u & 511, kb = q >> 5, nb = q & 31;
    cvt_block_f8(F.in(22) + (size_t)e * DM * 2 * DEXP + (size_t)(64 * kb) * (2 * DEXP) + 64 * nb, 2 * DEXP, (unsigned char*)(F.ws + WS_WUP) + ((size_t)e * 2 * DEXP + 64 * nb) * 1024 + 64 * kb, F.lds + F.wave * 16384, F.lane); }
__device__ __forceinline__ void cvt_dn_item(Frame& F, int d) { const int e = d >> 8, q = d & 255, kb = q >> 4, nb = q & 15;
    cvt_block_f8(F.in(24) + (size_t)e * DEXP * DM + (size_t)(64 * kb) * DM + 64 * nb, DM, (unsigned char*)(F.ws + WS_WDN) + ((size_t)e * DM + 64 * nb) * 1024 + 64 * kb, F.lds + F.wave * 16384, F.lane); }
template <bool UP> __device__ __forceinline__ void cvt_range(Frame& F, int lo, int hi, int wr_, int nw) {
    for (int it = lo + wr_; it < hi; it += nw) { if (UP) cvt_up_item(F, it); else cvt_dn_item(F, it); }
}
__device__ __forceinline__ void p0_transpose_item_f8(const float* W, int ldw, unsigned char* WT, int k0, int n0, float scale, LAS float* scr, int lane) {
#pragma unroll 8
    for (int i = 0; i < 32; ++i) { const int kk = 2 * i + (lane >> 5); scr[kk * 33 + (lane & 31)] = W[(size_t)(k0 + kk) * ldw + n0 + (lane & 31)] * scale; }
    LDS_WAIT(); asm volatile("" ::: "memory");
    const int c = lane & 7;
#pragma unroll
    for (int j = 0; j < 4; ++j) { const int n = (lane >> 3) + 8 * j; const LAS float* s = scr + (8 * c) * 33 + n;
        int w0 = 0, w1 = 0; w0 = __builtin_amdgcn_cvt_pk_fp8_f32(s[0 * 33], s[1 * 33], w0, false); w0 = __builtin_amdgcn_cvt_pk_fp8_f32(s[2 * 33], s[3 * 33], w0, true);
        w1 = __builtin_amdgcn_cvt_pk_fp8_f32(s[4 * 33], s[5 * 33], w1, false); w1 = __builtin_amdgcn_cvt_pk_fp8_f32(s[6 * 33], s[7 * 33], w1, true);
        typedef int i32x2_ __attribute__((ext_vector_type(2))); *(GAS i32x2_*)(WT + (size_t)(n0 + n) * 1024 + k0 + 8 * c) = (i32x2_){w0, w1}; }
    LDS_WAIT(); asm volatile("" ::: "memory");
}
template <int PARTS = 7> __device__ __forceinline__ void p0_phase(Frame& F) {
    const float* c_in = F.in(1); const float* w_ada = F.in(2); const float* b_ada = F.in(3);
    float* MOD = (float*)(F.ws + WS_MOD);
    if ((PARTS & 1) && F.vcu < 192) {
        LAS float* sc = (LAS float*)F.lds;
        LAS float* red = (LAS float*)(F.lds + 32768);
        for (int i = F.tid; i < BATCH * DM; i += NWAVES * 64) { const int b = i >> 10, k = i & 1023; const float v = c_in[i]; sc[k * 8 + b] = v * sigmoid_f(v); }
        __syncthreads();
        for (int ci = F.vcu; ci < 192; ci += F.G) {
            const int col = F.lane & 31, ks = F.lane >> 5;
            float acc[8];
#pragma unroll
            for (int b = 0; b < 8; ++b) acc[b] = 0.f;
            const float* wp = w_ada + (size_t)(128 * F.wave + ks) * (NMOD * DM) + ci * 32 + col;
#pragma unroll 1
            for (int i0 = 0; i0 < 64; i0 += 32) {
                float wv[32];
#pragma unroll
                for (int i = 0; i < 32; ++i) wv[i] = wp[(size_t)(2 * (i0 + i)) * (NMOD * DM)];
#pragma unroll
                for (int i = 0; i < 32; ++i) { const LAS f32x4* sp = (const LAS f32x4*)(sc + (128 * F.wave + 2 * (i0 + i) + ks) * 8); const f32x4 s0 = sp[0], s1 = sp[1];
                    acc[0] += s0[0] * wv[i]; acc[1] += s0[1] * wv[i]; acc[2] += s0[2] * wv[i]; acc[3] += s0[3] * wv[i]; acc[4] += s1[0] * wv[i]; acc[5] += s1[1] * wv[i]; acc[6] += s1[2] * wv[i]; acc[7] += s1[3] * wv[i]; }
            }
#pragma unroll
            for (int b = 0; b < 8; ++b) { acc[b] += __shfl_xor(acc[b], 32); if (ks == 0) red[(F.wave * 8 + b) * 32 + col] = acc[b]; }
            __syncthreads();
            if (F.tid < 256) { const int b = F.tid >> 5, cl = F.tid & 31; float s = 0.f;
#pragma unroll
              for (int w = 0; w < 8; ++w) s += red[(w * 8 + b) * 32 + cl];
              MOD[b * NMOD * DM + ci * 32 + cl] = s + b_ada[ci * 32 + cl]; }
            __syncthreads();
        }
    }
    __syncthreads();
    const float* w_in = F.in(6); const float* w_out = F.in(17); const float* gn_attn = F.in(16);
    bf16* WIN = (bf16*)(F.ws + WS_WIN); bf16* WOUT = (bf16*)(F.ws + WS_WOUT);
    LAS float* scr = (LAS float*)(F.lds + F.wave * 16384);
    const int gw = F.vcu * NWAVES + F.wave, NGW = F.G * NWAVES;
    constexpr int I_IN = 16 * (NPJ / 32), I_OUT = 16 * (DM / 32);
    constexpr int NITEMS = I_IN + I_OUT;
    if (PARTS & 2) for (int it = gw; it < NITEMS; it += NGW) {
        int r = it;
        if (r < I_IN) { const int kb = r / (NPJ / 32), nb = r % (NPJ / 32); p0_transpose_item(w_in, NPROJ, WIN, 64 * kb, 32 * nb, 64 * kb, nullptr, scr, F.lane); continue; } r -= I_IN;
        { const int kb = r / (DM / 32), nb = r % (DM / 32); const int k0 = 64 * kb;
            p0_transpose_item(w_out, DM, WOUT, k0, 32 * nb, (k0 + 512) & 1023, k0 >= 512 ? gn_attn - 512 : nullptr, scr, F.lane); }
    }
    if (PARTS & 4) {
        if (F.G == 256) {
            constexpr int NU = CV_UP_ITEMS - CV_UP_TAIL, NV = NU + (CV_DN_ITEMS - CV_DN_TAIL);
            auto run = [&](int v) { if (v < NU) cvt_up_item(F, CV_UP_TAIL + v); else cvt_dn_item(F, CV_DN_TAIL + (v - NU)); };
            constexpr int A_END = 2048 * 5;
            for (int v = gw; v < A_END && v < NV; v += NGW) run(v);
            if (F.vcu >= 192) { const int r = (F.vcu - 192) * NWAVES + F.wave; for (int v = A_END + r; v < A_END + 1536 && v < NV; v += 512) run(v); }
            else { const int r = F.vcu * NWAVES + F.wave; if (r < 512) { const int v = A_END + 1536 + r; if (v < NV) run(v); } }
            static_assert(A_END + 1536 + 512 >= NV, "phase-0 conversion shares cover the list");
        } else { cvt_range<true>(F, 0, CV_UP_ITEMS, gw, NGW); cvt_range<false>(F, 0, CV_DN_ITEMS, gw, NGW); }
    }
    if (PARTS & 2) { const float* w_in2 = F.in(6); float* WFT = (float*)(F.ws + WS_WFT);
      for (int idx = F.vcu * (NWAVES * 64) + F.tid; idx < 8 * DM; idx += F.G * NWAVES * 64) { const int h = idx >> 10, k = idx & 1023; WFT[idx] = w_in2[(size_t)k * NPROJ + NPJ + h]; } }
    { const float* w_router = F.in(20); float* WRT = (float*)(F.ws + WS_WRT);
      for (int idx = F.vcu * (NWAVES * 64) + F.tid; idx < NE * DM; idx += F.G * NWAVES * 64) { const int e = idx >> 10, k = idx & 1023; WRT[idx] = w_router[k * NE + e]; } }
    { const float* wa = F.in(9); const float* wx = F.in(11); bf16* LWT = (bf16*)(F.ws + WS_LWT);
      for (int idx = F.vcu * (NWAVES * 64) + F.tid; idx < 2 * 8 * 64 * 64; idx += F.G * NWAVES * 64) { const int gate = idx >> 15, g = (idx >> 12) & 7, j = (idx >> 6) & 63, i = idx & 63;
          LWT[idx] = (bf16)f2bf((gate ? wx : wa)[(g * 64 + i) * 64 + j]); } }
}

__device__ __forceinline__ void p1_phase(Frame& F) {
    const float* x = F.in(0); const float* gpre = F.in(4); const float* fb = F.in(14);
    const float* MOD = (const float*)(F.ws + WS_MOD); bf16* H1 = (bf16*)(F.ws + WS_H1); float* LOGF2 = (float*)(F.ws + WS_LOGF2);
    LAS float* wf = (LAS float*)F.lds;
    { const float* WFT = (const float*)(F.ws + WS_WFT);
#pragma unroll
      for (int i = F.tid; i < 8 * DM / 4; i += NWAVES * 64) *(LAS f32x4*)(wf + 4 * i) = *(const f32x4*)(WFT + 4 * i); }
    __syncthreads();
    const int gw = F.vcu * NWAVES + F.wave;
    if (F.G * NWAVES * 8 != NTOK) return;
    const int row0 = gw * 8, b = row0 / SEQ;
    f32x4 gm[4], sh[4];
#pragma unroll
    for (int j = 0; j < 4; ++j) { const int k = 4 * F.lane + 256 * j; const f32x4 g = *(const f32x4*)(gpre + k), s = *(const f32x4*)(MOD + b * NMOD * DM + DM + k); gm[j] = g * (s + 1.0f); sh[j] = *(const f32x4*)(MOD + b * NMOD * DM + k); }
    f32x4 nx[4];
#pragma unroll
    for (int j = 0; j < 4; ++j) nx[j] = *(const f32x4*)(x + (size_t)row0 * DM + 4 * F.lane + 256 * j);
    for (int r = 0; r < 8; ++r) { const int row = row0 + r;
        f32x4 v[4]; float ss = 0.f;
#pragma unroll
        for (int j = 0; j < 4; ++j) { v[j] = nx[j]; ss += (v[j][0] * v[j][0] + v[j][1] * v[j][1]) + (v[j][2] * v[j][2] + v[j][3] * v[j][3]); }
        if (r < 7) {
#pragma unroll
            for (int j = 0; j < 4; ++j) nx[j] = *(const f32x4*)(x + (size_t)(row + 1) * DM + 4 * F.lane + 256 * j); }
        const float rinv = 1.0f / sqrtf(wave_sum(ss) * (1.0f / DM) + RMS_EPS);
        float fl[8];
#pragma unroll
        for (int h = 0; h < 8; ++h) fl[h] = 0.f;
#pragma unroll
        for (int j = 0; j < 4; ++j) { const f32x4 hv = v[j] * rinv * gm[j] + sh[j];
            v2u o; o.x = pk2(hv[0], hv[1]); o.y = pk2(hv[2], hv[3]); *(GAS v2u*)(H1 + (size_t)row * DM + 4 * F.lane + 256 * j) = o;
#pragma unroll
            for (int h = 0; h < 8; ++h) { const f32x4 w = *(const LAS f32x4*)(wf + h * DM + 4 * F.lane + 256 * j); fl[h] += (hv[0] * w[0] + hv[1] * w[1]) + (hv[2] * w[2] + hv[3] * w[3]); } }
#pragma unroll
        for (int h = 0; h < 8; ++h) fl[h] = wave_sum(fl[h]);
        if (F.lane < 8) { float f = fl[0];
#pragma unroll
            for (int h = 1; h < 8; ++h) f = (F.lane == h) ? fl[h] : f;
            LOGF2[(size_t)row * 8 + F.lane] = log_sigmoid_f(f + fb[F.lane]) * 1.4426950408889634f; }
    }
}

constexpr int LRU_XP = 1040;
constexpr int LRU_XT = 0, LRU_XC = 69696, LRU_CAR = 136256;
constexpr int CW_LRU = 131072;
static_assert(LRU_CAR + 2048 <= SCRATCH_BYTES && 67 * LRU_XP <= LRU_XC && LRU_XC + 64 * LRU_XP <= LRU_CAR, "LRU LDS map");
__device__ __forceinline__ float one_minus_exp(float x) {
    float p = -x * (1.0f + x * (0.5f + x * (0.16666667f + x * (0.041666668f + x * (0.0083333338f + x * 0.0013888889f)))));
    if (__builtin_expect(__any(x <= -0.25f), 0)) { const float d = 1.0f - __builtin_amdgcn_exp2f(1.4426950408889634f * x); p = x > -0.25f ? p : d; }
    return p;
}
__device__ __forceinline__ void lru_item(Frame& F, int b, int c) {
    LAS unsigned char* XT = F.lds + LRU_XT; LAS unsigned char* XC = F.lds + LRU_XC; LAS float* CAR = (LAS float*)(F.lds + LRU_CAR);
    const bf16* XL = (const bf16*)(F.ws + WS_PJ); const bf16* YL = XL + PJ_STRIDE; const bf16* LWT = (const bf16*)(F.ws + WS_LWT);
    float* LSUM = (float*)(F.ws + WS_LSUM); bf16* MRG = (bf16*)(F.ws + WS_MRG); unsigned* flags = (unsigned*)(F.ws + WS_CTL) + CW_LRU;
    const float* conv_w = F.in(7); const float* conv_b = F.in(8); const float* ba = F.in(10); const float* bx = F.in(12); const float* lam = F.in(13); const float* gn_lru = F.in(15);
    const int t0 = c * 64; const size_t rowb = (size_t)b * SEQ;
    { v4u xv[9];
#pragma unroll
      for (int q = 0; q < 9; ++q) { const int p = F.tid + q * (NWAVES * 64), i = p >> 6, c8 = p & 63, t = t0 - 3 + i; xv[q] = (v4u){0u, 0u, 0u, 0u};
          if (p < 67 * 64 && t >= 0) xv[q] = *(const GAS v4u*)(XL + (rowb + t) * 512 + c8 * 8); }
#pragma unroll
      for (int q = 0; q < 9; ++q) { const int p = F.tid + q * (NWAVES * 64), i = p >> 6, c8 = p & 63; if (p < 67 * 64) *(LAS v4u*)(XT + i * LRU_XP + c8 * 16) = xv[q]; } }
    v4u yv8[8];
#pragma unroll
    for (int q = 0; q < 8; ++q) { const int p = F.tid + q * (NWAVES * 64), i = p >> 6, c8 = p & 63; yv8[q] = *(const GAS v4u*)(YL + (rowb + t0 + i) * 512 + c8 * 8); }
    __syncthreads();
    { const int ch = F.tid; const float w0 = conv_w[ch], w1 = conv_w[512 + ch], w2 = conv_w[1024 + ch], w3 = conv_w[1536 + ch], cb = conv_b[ch];
      float xa = bf1(*(const LAS bf16*)(XT + 0 * LRU_XP + ch * 2)), xb = bf1(*(const LAS bf16*)(XT + 1 * LRU_XP + ch * 2)), xc = bf1(*(const LAS bf16*)(XT + 2 * LRU_XP + ch * 2));
#pragma unroll 8
      for (int t = 0; t < 64; ++t) { const float xd = bf1(*(const LAS bf16*)(XT + (t + 3) * LRU_XP + ch * 2)); const float v = ((w0 * xa + w1 * xb) + (w2 * xc + w3 * xd)) + cb;
          *(LAS bf16*)(XC + t * LRU_XP + ch * 2) = (bf16)f2bf(v); xa = xb; xb = xc; xc = xd; } }
    __syncthreads();
#pragma unroll
    for (int q = 0; q < 8; ++q) { const int p = F.tid + q * (NWAVES * 64), i = p >> 6, c8 = p & 63; *(LAS v4u*)(XT + i * LRU_XP + c8 * 16) = yv8[q]; }
    const int g = F.wave, l31 = F.lane & 31, hi = F.lane >> 5;
    __syncthreads();
#pragma unroll 1
    for (int hp = 0; hp < 2; ++hp) {
        const int chl = g * 64 + 32 * hp + l31;
        f32x16 cumA[2], hloc[2];
#pragma unroll
        for (int tg = 0; tg < 2; ++tg) { cumA[tg] = f32x16{}; hloc[tg] = f32x16{}; }
#pragma unroll
        for (int s = 0; s < 4; ++s) {
            const bf16x8 wa = *(const GAS bf16x8*)(LWT + ((size_t)((0 * 8 + g) * 64 + 32 * hp + l31)) * 64 + 16 * s + 8 * hi);
            const bf16x8 wx = *(const GAS bf16x8*)(LWT + ((size_t)((1 * 8 + g) * 64 + 32 * hp + l31)) * 64 + 16 * s + 8 * hi);
#pragma unroll
            for (int tg = 0; tg < 2; ++tg) { const bf16x8 bfr = *(const LAS bf16x8*)(XC + (32 * tg + l31) * LRU_XP + (g * 64 + 16 * s + 8 * hi) * 2);
                cumA[tg] = __builtin_amdgcn_mfma_f32_32x32x16_bf16(bfr, wa, cumA[tg], 0, 0, 0); hloc[tg] = __builtin_amdgcn_mfma_f32_32x32x16_bf16(bfr, wx, hloc[tg], 0, 0, 0); }
        }
        const float pba = ba[chl], pbx = bx[chl], psp = 8.0f * softplus_f(-lam[chl]);
        float cA = 1.0f, cB = 0.0f;
#pragma unroll
        for (int tg = 0; tg < 2; ++tg) {
            f32x16& A = cumA[tg]; f32x16& X = hloc[tg];
#pragma unroll
            for (int r = 0; r < 16; ++r) { const int tok = 32 * tg + (r & 3) + 8 * (r >> 2) + 4 * hi; const float xv = bf1(*(const LAS bf16*)(XC + tok * LRU_XP + chl * 2));
                const float rg = sigmoid_f(A[r] + pba), ig = sigmoid_f(X[r] + pbx); const float la = -rg * psp;
                A[r] = __builtin_amdgcn_exp2f(1.4426950408889634f * la); X[r] = __builtin_amdgcn_sqrtf(one_minus_exp(2.0f * la)) * (ig * xv); }
#pragma unroll
            for (int q = 0; q < 4; ++q)
#pragma unroll
                for (int i = 1; i < 4; ++i) { X[4 * q + i] = A[4 * q + i] * X[4 * q + i - 1] + X[4 * q + i]; A[4 * q + i] = A[4 * q + i] * A[4 * q + i - 1]; }
#pragma unroll
            for (int q2 = 0; q2 < 8; ++q2) { const int q = q2 >> 1; const bool own = (hi == (q2 & 1));
#pragma unroll
                for (int i = 0; i < 4; ++i) { const float nb = A[4 * q + i] * cB + X[4 * q + i], na = A[4 * q + i] * cA; X[4 * q + i] = own ? nb : X[4 * q + i]; A[4 * q + i] = own ? na : A[4 * q + i]; }
                float ra, rb; { float a0 = A[4 * q + 3], a1 = a0; swap_half32(a0, a1); ra = hi ? a0 : a1; float b0 = X[4 * q + 3], b1 = b0; swap_half32(b0, b1); rb = hi ? b0 : b1; }
                cA = own ? A[4 * q + 3] : ra; cB = own ? X[4 * q + 3] : rb; }
        }
        if (hi == 0) { float* d0 = LSUM + (((size_t)b * 32 + c) * 2 + 0) * 512 + chl; __hip_atomic_store(d0, cA, __ATOMIC_RELAXED, __HIP_MEMORY_SCOPE_AGENT); __hip_atomic_store(d0 + 512, cB, __ATOMIC_RELAXED, __HIP_MEMORY_SCOPE_AGENT); }
        asm volatile("s_waitcnt vmcnt(0)" ::: "memory");
        __syncthreads();
        if (F.wave == 0) {
            if (F.lane == 0) __hip_atomic_store(flags + 64 * ((32 * b + c) * 2 + hp), 1u, __ATOMIC_RELAXED, __HIP_MEMORY_SCOPE_AGENT);
            unsigned sp = 0;
            for (;;) { const unsigned v = (F.lane < c) ? __hip_atomic_load(flags + 64 * ((32 * b + F.lane) * 2 + hp), __ATOMIC_RELAXED, __HIP_MEMORY_SCOPE_AGENT) : 1u;
                if (__all(v != 0u)) break; __builtin_amdgcn_s_sleep(1); if (++sp > (1u << 20)) break; }
        }
        __syncthreads();
        if (F.tid < 256) { const int ch = (F.tid >> 5) * 64 + 32 * hp + (F.tid & 31); float cr = 0.f; float* LS = LSUM + (size_t)b * 32 * 2 * 512 + ch;
          for (int c0 = 0; c0 < c; c0 += 32) { float A8[32], B8[32];
#pragma unroll
              for (int u = 0; u < 32; ++u) { const bool ok = (c0 + u) < c; A8[u] = 1.0f; B8[u] = 0.0f; if (ok) { A8[u] = __hip_atomic_load(LS + (size_t)(c0 + u) * 1024, __ATOMIC_RELAXED, __HIP_MEMORY_SCOPE_AGENT); B8[u] = __hip_atomic_load(LS + (size_t)(c0 + u) * 1024 + 512, __ATOMIC_RELAXED, __HIP_MEMORY_SCOPE_AGENT); } }
#pragma unroll
              for (int u = 0; u < 32; ++u) cr = A8[u] * cr + B8[u]; }
          CAR[ch] = cr; }
        __syncthreads();
        { const float cin = CAR[chl];
#pragma unroll
          for (int tg = 0; tg < 2; ++tg)
#pragma unroll
              for (int r = 0; r < 16; ++r) { const int tok = 32 * tg + (r & 3) + 8 * (r >> 2) + 4 * hi; LAS bf16* yp = (LAS bf16*)(XT + tok * LRU_XP + chl * 2);
                  const float h = hloc[tg][r] + cumA[tg][r] * cin; *yp = (bf16)f2bf(h * gelu_tanh_f(bf1(*yp))); } }
    }
    __syncthreads();
#pragma unroll 2
    for (int q = 0; q < 8; ++q) { const int i = F.wave + 8 * q, c8 = F.lane;
        const v4u w = *(const LAS v4u*)(XT + i * LRU_XP + c8 * 16);
        const float v0 = bflo(w.x), v1 = bfhi(w.x), v2 = bflo(w.y), v3 = bfhi(w.y), v4 = bflo(w.z), v5 = bfhi(w.z), v6 = bflo(w.w), v7 = bfhi(w.w);
        const float ss = wave_sum(((v0 * v0 + v1 * v1) + (v2 * v2 + v3 * v3)) + ((v4 * v4 + v5 * v5) + (v6 * v6 + v7 * v7)));
        const float rinv = 1.0f / sqrtf(ss * (1.0f / DLRU) + RMS_EPS);
        const f32x4 g0 = *(const f32x4*)(gn_lru + c8 * 8), g1 = *(const f32x4*)(gn_lru + c8 * 8 + 4);
        v4u o; o.x = pk2(v0 * rinv * g0[0], v1 * rinv * g0[1]); o.y = pk2(v2 * rinv * g0[2], v3 * rinv * g0[3]); o.z = pk2(v4 * rinv * g1[0], v5 * rinv * g1[1]); o.w = pk2(v6 * rinv * g1[2], v7 * rinv * g1[3]);
        *(GAS v4u*)(MRG + (rowb + t0 + i) * 1024 + 512 + c8 * 8) = o; }
    __syncthreads();
}
__device__ __forceinline__ void lru_phase(Frame& F) { for (int it = F.vcu; it < BATCH * 32; it += F.G) lru_item(F, it >> 5, it & 31); }

constexpr int P67_CARRY = 131072 + 2048;
__device__ __forceinline__ void p6_prologue(Frame& F, int t0) {
    LAS float* wrl = (LAS float*)F.lds; LAS int* hist = (LAS int*)(F.lds + 131072); const float* WRT = (const float*)(F.ws + WS_WRT);
    const int t = (int)threadIdx.x - t0, nt = NWAVES * 64 - t0;
#pragma unroll 4
    for (int i = t; i < NE * DM / 4; i += nt) *(LAS f32x4*)(wrl + 4 * i) = *(const f32x4*)(WRT + 4 * i);
    if (t < NE) hist[t] = 0;
}
template <int VAR = 0, bool PRO = true> __device__ __forceinline__ void p6_phase(Frame& F) {
    const float* x = F.in(0); const float* gpost = F.in(5); const float* gffn = F.in(18); const float* b_router = F.in(21);
    const float* MOD = (const float*)(F.ws + WS_MOD); const bf16* Y = (const bf16*)(F.ws + WS_Y); unsigned char* H2 = (unsigned char*)(F.ws + WS_H2);
    int* TOPI = (int*)(F.ws + WS_TOPI); float* TOPW = (float*)(F.ws + WS_TOPW); int* WGCNT = (int*)(F.ws + WS_WGCNT); bf16* XMID = (bf16*)(F.ws + WS_XMID);
    LAS float* wrl = (LAS float*)F.lds;
    LAS int* hist = (LAS int*)(F.lds + 131072);
    LAS int* pce = (LAS int*)(F.lds + P67_CARRY); LAS float* pcw = (LAS float*)(pce + 256); LAS int* pcr = pce + 512;
    if (PRO) { p6_prologue(F, 0); __syncthreads(); }
    if (F.G * 64 == NTOK) {
    const int bx = blockIdx.x, row0 = bx * 64 + F.wave * 8, b = row0 / SEQ;
    f32x4 gpm[4], gf[4], shf[4];
#pragma unroll
    for (int j = 0; j < 4; ++j) { const int k = 4 * F.lane + 256 * j; const float* mb = MOD + b * NMOD * DM + k;
        gpm[j] = *(const f32x4*)(mb + 2 * DM) * *(const f32x4*)(gpost + k); gf[j] = *(const f32x4*)(gffn + k) * (*(const f32x4*)(mb + 4 * DM) + 1.0f); shf[j] = *(const f32x4*)(mb + 3 * DM); }
    v2u ywn[2][4]; f32x4 xn[2][4];
#pragma unroll
    for (int u = 0; u < 2; ++u)
#pragma unroll
        for (int j = 0; j < 4; ++j) { ywn[u][j] = *(const GAS v2u*)(Y + (size_t)(row0 + u) * DM + 4 * F.lane + 256 * j); xn[u][j] = *(const f32x4*)(x + (size_t)(row0 + u) * DM + 4 * F.lane + 256 * j); }
    for (int rp = 0; rp < 4; ++rp) {
        f32x4 hv[2][4];
        v2u ywc[2][4]; f32x4 xc[2][4];
#pragma unroll
        for (int u = 0; u < 2; ++u)
#pragma unroll
            for (int j = 0; j < 4; ++j) { ywc[u][j] = ywn[u][j]; xc[u][j] = xn[u][j]; }
        if (rp < 3) {
#pragma unroll
            for (int u = 0; u < 2; ++u)
#pragma unroll
                for (int j = 0; j < 4; ++j) { ywn[u][j] = *(const GAS v2u*)(Y + (size_t)(row0 + 2 * rp + 2 + u) * DM + 4 * F.lane + 256 * j); xn[u][j] = *(const f32x4*)(x + (size_t)(row0 + 2 * rp + 2 + u) * DM + 4 * F.lane + 256 * j); } }
#pragma unroll
        for (int u = 0; u < 2; ++u) { const int row = row0 + 2 * rp + u;
            f32x4 yv[4]; float ss = 0.f;
#pragma unroll
            for (int j = 0; j < 4; ++j) { const v2u yw = ywc[u][j]; yv[j] = (f32x4){bflo(yw.x), bfhi(yw.x), bflo(yw.y), bfhi(yw.y)}; ss += (yv[j][0] * yv[j][0] + yv[j][1] * yv[j][1]) + (yv[j][2] * yv[j][2] + yv[j][3] * yv[j][3]); }
            const float rinv = 1.0f / sqrtf(wave_sum(ss) * (1.0f / DM) + RMS_EPS);
            float s2 = 0.f;
#pragma unroll
            for (int j = 0; j < 4; ++j) { const f32x4 xm = xc[u][j] + gpm[j] * (yv[j] * rinv);
                { v2u o; o.x = pk2(xm[0], xm[1]); o.y = pk2(xm[2], xm[3]); *(GAS v2u*)(XMID + (size_t)row * DM + 4 * F.lane + 256 * j) = o; }
                yv[j] = xm; s2 += (xm[0] * xm[0] + xm[1] * xm[1]) + (xm[2] * xm[2] + xm[3] * xm[3]); }
            const float rinv2 = 1.0f / sqrtf(wave_sum(s2) * (1.0f / DM) + RMS_EPS);
#pragma unroll
            for (int j = 0; j < 4; ++j) { const f32x4 h = yv[j] * rinv2 * gf[j] + shf[j]; hv[u][j] = h;
                int w8 = 0; w8 = __builtin_amdgcn_cvt_pk_fp8_f32(h[0], h[1], w8, false); w8 = __builtin_amdgcn_cvt_pk_fp8_f32(h[2], h[3], w8, true); *(GAS int*)(H2 + (size_t)row * DM + 4 * F.lane + 256 * j) = w8; }
        }
        typedef float f32x2 __attribute__((ext_vector_type(2)));
        f32x2 hp[4][4];
#pragma unroll
        for (int j = 0; j < 4; ++j)
#pragma unroll
            for (int i = 0; i < 4; ++i) hp[j][i] = (f32x2){hv[0][j][i], hv[1][j][i]};
        float pa[32], pb[32];
#pragma unroll
        for (int e = 0; e < 32; ++e) { f32x2 s2 = (f32x2){0.f, 0.f};
#pragma unroll
            for (int j = 0; j < (VAR == 1 ? 0 : 4); ++j) { const f32x4 w = *(const LAS f32x4*)(wrl + e * DM + 4 * F.lane + 256 * j);
#pragma unroll
                for (int i = 0; i < 4; ++i) s2 = __builtin_elementwise_fma(hp[j][i], (f32x2){w[i], w[i]}, s2); }
            pa[e] = s2[0]; pb[e] = s2[1]; }
#pragma unroll
        for (int i = 0; i < 16; ++i) { float a = pa[i], b = pa[16 + i]; swap_half32(a, b); pa[i] = a + b; float c2 = pb[i], d2 = pb[16 + i]; swap_half32(c2, d2); pb[i] = c2 + d2; }
#pragma unroll
        for (int i = 0; i < 8; ++i) { float a = pa[i], b = pa[8 + i]; swap_rows16(a, b); pa[i] = a + b; float c2 = pb[i], d2 = pb[8 + i]; swap_rows16(c2, d2); pb[i] = c2 + d2; }
#define TR_STEP(N, XOR, BIT) _Pragma("unroll") for (int i = 0; i < N; ++i) { const bool up = (F.lane & BIT) != 0; \
            const float ka = up ? pa[N + i] : pa[i], sa_ = up ? pa[i] : pa[N + i], kb = up ? pb[N + i] : pb[i], sb_ = up ? pb[i] : pb[N + i]; \
            pa[i] = ka + XOR(sa_); pb[i] = kb + XOR(sb_); }
        TR_STEP(4, lane_xor8, 8) TR_STEP(2, lane_xor4, 4) TR_STEP(1, lane_xor2, 2)
#undef TR_STEP
        const int e = (F.lane >> 1) & 31; const float br = b_router[e];
#pragma unroll
        for (int u = 0; u < 2; ++u) { const int row = row0 + 2 * rp + u; float v = (u ? pb[0] : pa[0]); v += lane_xor1(v); v += br;
            int rank = 0;
#pragma unroll
            for (int j = 0; j < 32; ++j) { const float vj = __uint_as_float((unsigned)__builtin_amdgcn_readlane((int)__float_as_uint(v), 2 * j)); rank += (vj > v || (vj == v && j < e)) ? 1 : 0; }
            const bool sel = rank < TOPK; const float vmax = wave_max(v); const float ex = sel ? __expf(v - vmax) : 0.f; const float den = wave_sum(ex) * 0.5f;
            if (sel && !(F.lane & 1)) { const int p = (row - bx * 64) * TOPK + rank;
                pce[p] = e; pcw[p] = ex / den; pcr[p] = __hip_atomic_fetch_add((LAS int*)&hist[e], 1, __ATOMIC_RELAXED, __HIP_MEMORY_SCOPE_WORKGROUP);
                TOPI[(size_t)row * TOPK + rank] = e; TOPW[(size_t)row * TOPK + rank] = ex / den; } }
    }
    __syncthreads();
    if (F.tid < NE) WGCNT[bx * NE + F.tid] = hist[F.tid];
    }
}

template <bool CARRY> __device__ __forceinline__ void p7_phase(Frame& F) {
    const int* TOPI = (const int*)(F.ws + WS_TOPI); const float* TOPW = (const float*)(F.ws + WS_TOPW); const int* WGCNT = (const int*)(F.ws + WS_WGCNT);
    int* ROWTOK = (int*)(F.ws + WS_ROWTOK); int* ROWPAIR = (int*)(F.ws + WS_ROWPAIR); float* ROWW = (float*)(F.ws + WS_ROWW); int* MTEXP = (int*)(F.ws + WS_MTEXP);
    LAS int* ptot = (LAS int*)F.lds; LAS int* pbef = ptot + 512; LAS int* cnt = pbef + 512; LAS int* wgb = cnt + 32; LAS int* pst = wgb + 32; LAS int* pad = pst + 64; LAS int* ep = pad + 32;
    LAS int* mtl = (LAS int*)(F.lds + 131072);
    const LAS int* pce = (const LAS int*)(F.lds + P67_CARRY); const LAS float* pcw = (const LAS float*)(pce + 256); const LAS int* pcr = pce + 512;
    if (F.G != 256) return;
    const int bx = blockIdx.x;
    { const int e = F.tid & 31, part = F.tid >> 5; int tt = 0, tb = 0;
      for (int w = part * 16; w < part * 16 + 16; ++w) { const int v = WGCNT[w * NE + e]; tt += v; tb += (w < bx) ? v : 0; }
      ptot[part * 32 + e] = tt; pbef[part * 32 + e] = tb; }
    if (!CARRY) { if (F.tid < 256) ep[F.tid] = TOPI[(size_t)bx * 256 + F.tid]; }
    __syncthreads();
    if (F.tid < NE) { int tt = 0, tb = 0; for (int p = 0; p < 16; ++p) { tt += ptot[p * 32 + F.tid]; tb += pbef[p * 32 + F.tid]; } cnt[F.tid] = tt; wgb[F.tid] = tb; pad[F.tid] = (tt + 255) & ~255; }
    __syncthreads();
    if (F.tid == 0) { int s = 0; for (int e = 0; e < NE; ++e) { pst[e] = s; s += pad[e]; } pst[NE] = s; mtl[511] = s >> 8; }
    __syncthreads();
    if (F.tid < 256) { const int p = F.tid; int e, rk; float w;
        if (CARRY) { e = pce[p]; rk = pcr[p]; w = pcw[p]; }
        else { e = ep[p]; rk = 0; for (int q2 = 0; q2 < p; ++q2) rk += (ep[q2] == e) ? 1 : 0; w = TOPW[(size_t)bx * 256 + p]; }
        const int dest = pst[e] + wgb[e] + rk; const int pair = bx * 256 + p; ROWTOK[dest] = pair >> 2; ROWPAIR[dest] = pair; ROWW[dest] = w; }
    if (bx < NE) { const int e = bx; for (int i = pst[e] + cnt[e] + F.tid; i < pst[e] + pad[e]; i += NWAVES * 64) { ROWTOK[i] = 0; ROWPAIR[i] = -1; ROWW[i] = 0.f; } }
    if (F.tid >= 256 && F.tid < 256 + NE) { const int e = F.tid - 256; for (int mt = pst[e] >> 8; mt < (pst[e] + pad[e]) >> 8; ++mt) { mtl[mt] = e; if (bx == 0) MTEXP[mt] = e; } }
    if (bx == 0 && F.tid == 0) MTEXP[512] = pst[NE] >> 8;
}

__device__ __forceinline__ void p10_phase(Frame& F) {
    const float* gpost = F.in(19); const float* MOD = (const float*)(F.ws + WS_MOD);
    const unsigned char* YP = (const unsigned char*)(F.ws + WS_YP); const bf16* XMID = (const bf16*)(F.ws + WS_XMID);
    const int gw = F.vcu * NWAVES + F.wave;
    if (F.G * NWAVES * 8 != NTOK) return;
    const int row0 = gw * 8, b = row0 / SEQ;
    f32x4 gg[4];
#pragma unroll
    for (int j = 0; j < 4; ++j) { const int k = 4 * F.lane + 256 * j; gg[j] = *(const f32x4*)(MOD + b * NMOD * DM + 5 * DM + k) * *(const f32x4*)(gpost + k); }
    int nw[4][TOPK]; v2u nm[4];
#pragma unroll
    for (int j = 0; j < 4; ++j) { nm[j] = *(const GAS v2u*)(XMID + (size_t)row0 * DM + 4 * F.lane + 256 * j);
#pragma unroll
        for (int k = 0; k < TOPK; ++k) nw[j][k] = *(const GAS int*)(YP + ((size_t)row0 * TOPK + k) * DM + 4 * F.lane + 256 * j); }
    for (int r = 0; r < 8; ++r) { const int row = row0 + r;
        f32x4 y[4], xm[4]; float ss = 0.f;
#pragma unroll
        for (int j = 0; j < 4; ++j) { f32x4 s = (f32x4){0.f, 0.f, 0.f, 0.f};
#pragma unroll
            for (int k = 0; k < TOPK; ++k) { const int w = nw[j][k]; s += (f32x4){__builtin_amdgcn_cvt_f32_fp8(w, 0), __builtin_amdgcn_cvt_f32_fp8(w, 1), __builtin_amdgcn_cvt_f32_fp8(w, 2), __builtin_amdgcn_cvt_f32_fp8(w, 3)}; }
            y[j] = s; ss += (s[0] * s[0] + s[1] * s[1]) + (s[2] * s[2] + s[3] * s[3]);
            const v2u mw = nm[j]; xm[j] = (f32x4){bflo(mw.x), bfhi(mw.x), bflo(mw.y), bfhi(mw.y)}; }
        if (r < 7) {
#pragma unroll
            for (int j = 0; j < 4; ++j) { nm[j] = *(const GAS v2u*)(XMID + (size_t)(row + 1) * DM + 4 * F.lane + 256 * j);
#pragma unroll
                for (int k = 0; k < TOPK; ++k) nw[j][k] = *(const GAS int*)(YP + ((size_t)(row + 1) * TOPK + k) * DM + 4 * F.lane + 256 * j); } }
        const float rinv = 1.0f / sqrtf(wave_sum(ss) * (1.0f / DM) + RMS_EPS * 16.0f);
#pragma unroll
        for (int j = 0; j < 4; ++j) *(f32x4*)(F.out + (size_t)row * DM + 4 * F.lane + 256 * j) = xm[j] + gg[j] * (y[j] * rinv);
    }
}

__device__ __forceinline__ void p8_bias(Frame& F, int t0) {
    const LAS int* mtl = (const LAS int*)(F.lds + 131072); LAS float* bsl = (LAS float*)(F.lds + 131072 + 2048); const float* b_up = F.in(23);
    const int t = (int)threadIdx.x - t0, nmt = mtl[511];
    if (t >= 0 && t < 256) for (int i = 0; i < 12; ++i) { const int L = i * F.G + F.vcu; if (L >= nmt * 8) break; const int ex = mtl[L >> 3], pn = L & 7;
        bsl[i * 256 + t] = b_up[(size_t)ex * 2 * DEXP + (t >> 7) * DEXP + pn * 128 + (t & 127)]; }
}
__device__ __forceinline__ void p9_bias(Frame& F, int nmt, int t0) {
    const LAS int* mtl = (const LAS int*)(F.lds + 131072); LAS float* bsl = (LAS float*)(F.lds + 131072 + 2048); const float* b_dn = F.in(25);
    const int t = (int)threadIdx.x - t0;
    if (t >= 0 && t < 256) for (int i = 0; i < 12; ++i) { const int L = i * F.G + F.vcu; if (L >= nmt * 4) break; const int ex = mtl[L >> 2], pn = L & 3; bsl[i * 256 + t] = b_dn[(size_t)ex * DM + pn * 256 + t]; }
}
__global__ void __launch_bounds__(NWAVES * 64, 2) mega_fwd(Args args) {
    extern __shared__ __attribute__((aligned(16))) unsigned char lds[];
    Frame F;
    F.lds = (LAS unsigned char*)lds;
    F.tid = threadIdx.x; F.lane = F.tid & 63; F.wave = __builtin_amdgcn_readfirstlane(F.tid >> 6);
    F.G = gridDim.x; { const int bx = blockIdx.x; F.vcu = (F.G % 8 == 0) ? (bx % 8) * (F.G / 8) + bx / 8 : bx; }
    F.out = args.out; F.ws = args.ws;
    volatile LAS unsigned* MISC = (volatile LAS unsigned*)(F.lds + MISC_OFF);
    for (int u = F.tid; u < (LDS_BYTES - LDSCTL_OFF) / 4; u += NWAVES * 64) ((LAS unsigned*)(F.lds + LDSCTL_OFF))[u] = 0u;
    __syncthreads();
    if (F.tid < 26) ((LAS unsigned long long*)(F.lds + LDSCTL_OFF))[F.tid] = (unsigned long long)args.in[F.tid];
    __syncthreads();
    gu32* ctl = (gu32*)(F.ws + WS_CTL);
    XcdBarrier bar = xcd_barrier_post((unsigned*)(ctl + CW_BAR) + args.li * XCD_BAR_WORDS, MISC + 8);
    const int lo = args.ph_lo, hi = args.ph_hi;
#ifndef PHMASK
#define PHMASK 0x7ff
#endif
#define IN(k) (((PHMASK >> (k)) & 1) && lo <= (k) && (k) < hi)
#define SEAM(k, n) do { if (IN(k) && IN(n)) xcd_barrier(bar); } while (0)
#define REFRESH() do { int t_; asm volatile("v_mov_b32 %0, %1" : "=v"(t_) : "v"(threadIdx.x)); F.tid = t_; F.lane = t_ & 63; } while (0)
#define ATTN_TENSORS attn_body::AttnTensors{(const attn_body::bf16*)(F.ws + WS_PJ) + 2 * PJ_STRIDE, (const attn_body::bf16*)(F.ws + WS_PJ) + 3 * PJ_STRIDE, (const attn_body::bf16*)(F.ws + WS_PJ) + 4 * PJ_STRIDE, \
                                          (attn_body::bf16*)(F.ws + WS_MRG), (const float*)(F.ws + WS_LOGF2), (float*)(F.ws + WS_SSQ)}
    if (IN(0)) { REFRESH(); p0_phase(F); } SEAM(0, 1);
    if (IN(1)) { REFRESH(); p1_phase(F); } SEAM(1, 2);
    if (IN(2)) { REFRESH();
        pg8::DenseOrder S; S.init((const pg8::bf16_t*)(F.ws + WS_H1), (const pg8::bf16_t*)(F.ws + WS_WIN), NTOK, NPJ, F.G, (int)blockIdx.x);
        pg8::EpiProj E{(pg8::bf16_t*)(F.ws + WS_PJ), PJ_STRIDE, attn_body::C2};
        pg8::gemm_phase<pg8::EpiProj, pg8::DenseOrder>(F.lds, S, E);
        if (F.G == 256 && blockIdx.x >= 128) { REFRESH(); cvt_range<true>(F, 0, CV_UP_TAIL, ((int)blockIdx.x - 128) * NWAVES + F.wave, 128 * NWAVES); }
    } SEAM(2, 3);
    if (IN(3)) { REFRESH();
        lru_phase(F);
        const attn_body::AttnTensors AT = ATTN_TENSORS; const attn_body::StaticOrder S((int)F.G, F.vcu);
        attn_body::attn_phase<attn_body::StaticOrder>((char*)lds, AT, S);
    } SEAM(3, 5);
    if (IN(5)) { REFRESH();
        pg8::DenseOrder S; S.init((const pg8::bf16_t*)(F.ws + WS_MRG), (const pg8::bf16_t*)(F.ws + WS_WOUT), NTOK, DM, F.G, (int)blockIdx.x);
        pg8::EpiOut E{(pg8::bf16_t*)(F.ws + WS_Y), (const float*)(F.ws + WS_SSQ)};
        pg8::gemm_phase<pg8::EpiOut, pg8::DenseOrder>(F.lds, S, E);
    } if (IN(5) && IN(6)) xcd_barrier(bar, [&] { p6_prologue(F, 64); });
    if (IN(6)) { REFRESH(); if (IN(5)) p6_phase<0, false>(F); else p6_phase<0, true>(F); } SEAM(6, 7);
    if (IN(7)) { REFRESH(); if (IN(6)) p7_phase<true>(F); else p7_phase<false>(F); }
    if (IN(7) && IN(8)) xcd_barrier(bar, [&] { p8_bias(F, 64); });
    if (IN(8)) { REFRESH();
        LAS int* mtl = (LAS int*)(F.lds + 131072); LAS float* bsl = (LAS float*)(F.lds + 131072 + 2048);
        if (!IN(7)) {
            const int n_ = ((const int*)(F.ws + WS_MTEXP))[512];
            for (int i = F.tid; i < n_; i += NWAVES * 64) mtl[i] = ((const int*)(F.ws + WS_MTEXP))[i];
            if (F.tid == 0) mtl[511] = n_;
            __syncthreads();
            p8_bias(F, 0);
            __syncthreads(); }
        const int nmt = __builtin_amdgcn_readfirstlane(mtl[511]);
        pg8::UpOrder S{(const unsigned char*)(F.ws + WS_H2), (const unsigned char*)(F.ws + WS_WUP), (const int*)(F.ws + WS_ROWTOK), mtl, nmt * 8, F.G, F.vcu};
        pg8::EpiUp E{(unsigned char*)(F.ws + WS_ACT), bsl};
        pg8::gemm_phase<pg8::EpiUp, pg8::UpOrder, true>(F.lds, S, E);
        if (F.G == 256) {
            const int units = nmt * 8, maxu = (units + 255) >> 8, nfull = units - (maxu - 1) * 256, nidle = 256 - nfull;
            REFRESH();
            if (nidle >= 32) { if (F.vcu >= nfull) cvt_range<false>(F, 0, CV_DN_TAIL, (F.vcu - nfull) * NWAVES + F.wave, nidle * NWAVES); }
            else cvt_range<false>(F, 0, CV_DN_TAIL, F.vcu * NWAVES + F.wave, 256 * NWAVES); }
        if (IN(9)) xcd_barrier(bar, [&] { p9_bias(F, nmt, 64); });
    }
    if (IN(9)) { REFRESH();
        LAS int* mtl = (LAS int*)(F.lds + 131072); LAS float* bsl = (LAS float*)(F.lds + 131072 + 2048);
        if (!IN(8)) {
            const int n_ = ((const int*)(F.ws + WS_MTEXP))[512];
            for (int i = F.tid; i < n_; i += NWAVES * 64) mtl[i] = ((const int*)(F.ws + WS_MTEXP))[i];
            if (F.tid == 0) mtl[511] = n_;
            __syncthreads();
            p9_bias(F, n_, 0);
            __syncthreads(); }
        const int nmt = __builtin_amdgcn_readfirstlane(mtl[511]);
        pg8::DownOrder S{(const unsigned char*)(F.ws + WS_ACT), (const unsigned char*)(F.ws + WS_WDN), mtl, nmt * 4, F.G, F.vcu};
        pg8::EpiDown E{(unsigned char*)(F.ws + WS_YP), bsl, (const int*)(F.ws + WS_ROWPAIR), (const float*)(F.ws + WS_ROWW)};
        pg8::gemm_phase<pg8::EpiDown, pg8::DownOrder, true>(F.lds, S, E);
    } SEAM(9, 10);
    if (IN(10)) { REFRESH(); p10_phase(F); }
#ifdef MK_PROBES
    if (lo == 11) { REFRESH(); lru_phase(F); }
    if (lo == 12) { REFRESH(); const attn_body::AttnTensors AT = ATTN_TENSORS; const attn_body::StaticOrder S((int)F.G, F.vcu); attn_body::attn_phase<attn_body::StaticOrder>((char*)lds, AT, S); }
    if (lo == 14) { REFRESH(); p0_phase<1>(F); }
    if (lo == 15) { REFRESH(); p0_phase<2>(F); }
    if (lo == 16) { REFRESH(); p0_phase<4>(F); }
    if (lo == 17) { for (int i = 0; i < 10; ++i) xcd_barrier(bar); }
    if (lo == 18) { REFRESH(); p6_phase<1>(F); }
    if (lo >= 21 && lo <= 24) { REFRESH();
        const int nmt = ((const int*)(F.ws + WS_MTEXP))[512];
        LAS int* mtl = (LAS int*)(F.lds + 131072); LAS float* bsl = (LAS float*)(F.lds + 131072 + 2048);
        for (int i = F.tid; i < nmt; i += NWAVES * 64) mtl[i] = ((const int*)(F.ws + WS_MTEXP))[i];
        for (int i = F.tid; i < 12 * 256; i += NWAVES * 64) bsl[i] = 0.f;
        __syncthreads();
        pg8::UpOrder S{(const unsigned char*)(F.ws + WS_H2), (const unsigned char*)(F.ws + WS_WUP), (const int*)(F.ws + WS_ROWTOK), mtl, nmt * 8, F.G, F.vcu};
        if (lo == 21) { pg8::EpiNop E{}; pg8::gemm_phase<pg8::EpiNop, pg8::UpOrder, true, 1>(F.lds, S, E); }
        else if (lo == 22) { pg8::EpiNop E{}; pg8::gemm_phase<pg8::EpiNop, pg8::UpOrder, true, 2>(F.lds, S, E); }
        else if (lo == 23) { pg8::EpiUp E{(unsigned char*)(F.ws + WS_H1), bsl}; pg8::gemm_phase<pg8::EpiUp, pg8::UpOrder, true, 1>(F.lds, S, E); }
        else { pg8::EpiUpT<false> E{(unsigned char*)(F.ws + WS_H1), bsl}; pg8::gemm_phase<pg8::EpiUpT<false>, pg8::UpOrder, true, 1>(F.lds, S, E); } }
#endif
#undef IN
#undef SEAM
#undef REFRESH
#undef ATTN_TENSORS
}

static void launch_mega(hipStream_t stream, void* const* d_in, void* d_out, void* d_ws, int lo, int hi, int li, int grid) {
    Args a{};
    for (int i = 0; i < 26; ++i) a.in[i] = (const float*)d_in[i];
    a.out = (float*)d_out; a.ws = (unsigned char*)d_ws; a.ph_lo = lo; a.ph_hi = hi; a.li = li; a.pad = 0;
    hipLaunchKernelGGL(mega_fwd, dim3(grid), dim3(NWAVES * 64), LDS_BYTES, stream, a);
}

extern "C" void kernel_launch(void* const* d_in, const int* in_sizes, int n_in, void* d_out, int out_size, void* d_ws, size_t ws_size, hipStream_t stream) {
    static int grid = 0;
    if (grid == 0) {
        int dev = 0, cus = 0;
        if (n_in != 26 || out_size != NTOK * DM || ws_size < WS_END) { fprintf(stderr, "kernel_launch: unexpected problem shape / workspace (%d inputs, out %d, ws %zu)\n", n_in, out_size, ws_size); grid = -1; return; }
        if (hipGetDevice(&dev) != hipSuccess || hipDeviceGetAttribute(&cus, hipDeviceAttributeMultiprocessorCount, dev) != hipSuccess) { grid = -1; return; }
        if (hipFuncSetAttribute((const void*)mega_fwd, hipFuncAttributeMaxDynamicSharedMemorySize, LDS_BYTES) != hipSuccess) { fprintf(stderr, "kernel_launch: hipFuncSetAttribute failed\n"); grid = -1; return; }
        grid = cus;
        if (grid != 256) fprintf(stderr, "kernel_launch: %d CUs; this kernel is laid out for 256\n", grid);
    }
    if (grid < 0) return;
    (void)in_sizes;
    (void)hipMemsetAsync((char*)d_ws + WS_CTL, 0, CTL_ZERO_BYTES, stream);
    launch_mega(stream, d_in, d_out, d_ws, 0, NPHASES, 0, grid);
#ifdef MK_PROBES
#ifdef EXTRA_LO
    launch_mega(stream, d_in, d_out, d_ws, EXTRA_LO, EXTRA_HI, 1, grid);
#endif
#endif
}
```

```cpp
#include <hip/hip_runtime.h>
#include <hip/hip_bf16.h>
#include <cstdio>
#include <cstdint>
#include <cmath>

constexpr int DM = 1024, BATCH = 8, SEQ = 2048, NTOK = BATCH * SEQ;
constexpr int DLRU = 512, DATT = 512, NH = 8, HD = 64, NPROJ = 2 * DLRU + 3 * DATT + NH, NPJ = 2560;
constexpr int NE = 32, TOPK = 4, DEXP = 1024, NMOD = 6;
constexpr float RMS_EPS = 1e-6f;
constexpr int MAXROWS = NTOK * TOPK + NE * 256;
constexpr int MAXMT = MAXROWS / 256;

namespace pg8 {
#define PG8_LAS __attribute__((address_space(3)))
typedef unsigned short bf16_t;
typedef short bf16x8 __attribute__((ext_vector_type(8)));
typedef float f32x4 __attribute__((ext_vector_type(4)));
typedef float f32x2 __attribute__((ext_vector_type(2)));
typedef unsigned u32x4 __attribute__((ext_vector_type(4)));
constexpr int BM = 256, BK = 64, HALF = 128, HTB = HALF * BK * 2  , STAGE_BYTES = 8 * HTB, NXCD = 8, WGM = 4;
constexpr int GK = 1024, GNT = GK / BK;
typedef int i32x8 __attribute__((ext_vector_type(8)));
typedef int i32x4 __attribute__((ext_vector_type(4)));
constexpr int F8_SCALE_W = 0x79797979, F8_SCALE_A = 0x7f7f7f7f;

__host__ __device__ __forceinline__ int lds_byte(int r, int c) { const int st = (r >> 4) * 2 + (c >> 5), rr = r & 15, cc = c & 31, ob = rr * 64 + cc * 2; return st * 1024 + (ob ^ (((ob >> 9) & 1) << 5)); }
__host__ __device__ __forceinline__ void stage_rc(int b, int& R, int& C) { const int st = b / 1024, sb = b % 1024, swz = sb ^ (((sb >> 9) & 1) << 5); R = (st >> 1) * 16 + swz / 64; C = (st & 1) * 32 + (swz % 64) / 2; }
__host__ __device__ __forceinline__ int perm32(int rho) { const int n = rho >> 4, i = rho & 15; return 8 * (i >> 2) + 4 * n + (i & 3); }

struct Unit { const char* A0; const char* A1; const char* B0; const char* B1; int pm, pn, e, ord, sub, koff; };

__device__ __forceinline__ void mfma_f8_acc(f32x4& acc, const i32x8& b, const i32x8& a, int sw, int sa) {
    asm volatile("v_mfma_scale_f32_16x16x128_f8f6f4 %0, %1, %2, %0, %3, %4 op_sel_hi:[0,0,0]" : "+v"(acc) : "v"(b), "v"(a), "v"(sw), "v"(sa)); }
__device__ __forceinline__ unsigned cvt_pk_bf16(float lo, float hi) { unsigned r; asm volatile("v_cvt_pk_bf16_f32 %0, %1, %2" : "=v"(r) : "v"(lo), "v"(hi)); return r; }

template <class Epi, class Sched, bool F8 = false, int KREP = 1>
__device__ __forceinline__ void gemm_phase(PG8_LAS unsigned char* lds, const Sched& S, const Epi& E) {
    const int tid = threadIdx.x, wid = __builtin_amdgcn_readfirstlane(tid >> 6), lane = tid & 63, wr = wid >> 2, wc = wid & 3, fr = lane & 15, fq = lane >> 4;
    constexpr int KB = F8 ? GK : GK * 2, nt1 = F8 ? GK / 128 : GNT, nt = nt1 * KREP;
    int Rr[2], Cc[2];
    unsigned voffB[2], cvA[2][2], nvA[2][2];
#pragma unroll
    for (int i = 0; i < 2; ++i) { stage_rc(tid * 16 + i * 8192, Rr[i], Cc[i]); const int Rb = Epi::PERM ? ((Rr[i] & ~31) + perm32(Rr[i] & 31)) : Rr[i]; voffB[i] = (unsigned)(Rb * KB + Cc[i] * 2); }
    constexpr size_t kstep = (size_t)(BK * 2);
    const unsigned ldsw = (unsigned)wid * 1024u;
    const int aoff = lds_byte(wr * 64 + fr, fq * 8), boff = lds_byte(wc * 32 + fr, fq * 8);
#define PG8_SA(b, h) (((b) * 2 + (h)) * HTB)
#define PG8_SB(b, h) ((4 + (b) * 2 + (h)) * HTB)
#define PG8_STAGE(bufoff, gbase, voff) do { _Pragma("unroll") for (int _i = 0; _i < 2; ++_i) \
        __builtin_amdgcn_global_load_lds((const unsigned*)((const char*)(gbase) + (voff)[_i]), (PG8_LAS unsigned*)(lds + (bufoff) + ldsw + _i * 8192), 16, 0, 0); } while (0)
#define PG8_LD8(p) __builtin_shufflevector(*(const PG8_LAS i32x4*)(p), *(const PG8_LAS i32x4*)((p) + 1024), 0, 1, 2, 3, 4, 5, 6, 7)
#define PG8_LDA(dst, b, h) do { _Pragma("unroll") for (int m = 0; m < 4; ++m) { if constexpr (F8) { dst##8[m] = PG8_LD8(lds + PG8_SA(b, h) + aoff + m * 2048); } \
        else { _Pragma("unroll") for (int k = 0; k < 2; ++k) dst[m][k] = *(const PG8_LAS bf16x8*)(lds + PG8_SA(b, h) + aoff + m * 2048 + k * 1024); } } } while (0)
#define PG8_LDB(dst, b, h) do { _Pragma("unroll") for (int n = 0; n < 2; ++n) { if constexpr (F8) { dst##8[n] = PG8_LD8(lds + PG8_SB(b, h) + boff + n * 2048); } \
        else { _Pragma("unroll") for (int k = 0; k < 2; ++k) dst[n][k] = *(const PG8_LAS bf16x8*)(lds + PG8_SB(b, h) + boff + n * 2048 + k * 1024); } } } while (0)
#define PG8_MMA(ai, bj, At, Bt) do { __builtin_amdgcn_s_setprio(1); _Pragma("unroll") for (int m = 0; m < 4; ++m) _Pragma("unroll") for (int n = 0; n < 2; ++n) { \
        if constexpr (F8) { mfma_f8_acc(acc[ai][bj][m][n], Bt##8[n], At##8[m], scw, sca); } \
        else { _Pragma("unroll") for (int k = 0; k < 2; ++k) acc[ai][bj][m][n] = __builtin_amdgcn_mfma_f32_16x16x32_bf16(Bt[n][k], At[m][k], acc[ai][bj][m][n], 0, 0, 0); } } \
        __builtin_amdgcn_s_setprio(0); } while (0)
#define PG8_WAIT_V(n) asm volatile("s_waitcnt vmcnt(" #n ")" ::: "memory")
    constexpr int RELAX = 8 + Epi::NST + (Sched::GATHER ? 4 : 0);
#define PG8_WAIT_V8R(rx) do { if (rx) { if constexpr (RELAX == 12) PG8_WAIT_V(12); else if constexpr (RELAX == 16) PG8_WAIT_V(16); else if constexpr (RELAX == 20) PG8_WAIT_V(20); \
        else if constexpr (RELAX == 24) PG8_WAIT_V(24); else if constexpr (RELAX == 28) PG8_WAIT_V(28); else PG8_WAIT_V(8); } else PG8_WAIT_V(8); } while (0)
#define PG8_WAIT_L(n) asm volatile("s_waitcnt lgkmcnt(" #n ")" ::: "memory")
#define PG8_BAR __builtin_amdgcn_s_barrier()
#define PG8_SCHED __builtin_amdgcn_sched_barrier(0)
#define PG8_VOFF(dst, u) do { _Pragma("unroll") for (int _h = 0; _h < 2; ++_h) _Pragma("unroll") for (int _i = 0; _i < 2; ++_i) { \
        const int _row = Sched::GATHER ? S.row_of(u, _h * HALF + Rr[_i]) : Rr[_i]; dst[_h][_i] = (unsigned)(_row * KB + Cc[_i] * 2); } } while (0)
    Unit cur, nxt; int ui = 0;
    if (!S.next(0, cur)) return;
    f32x4 acc[2][2][4][2];
#pragma unroll
    for (int a = 0; a < 2; ++a)
#pragma unroll
        for (int b = 0; b < 2; ++b)
#pragma unroll
            for (int m = 0; m < 4; ++m)
#pragma unroll
                for (int n = 0; n < 2; ++n) acc[a][b][m][n] = (f32x4){0.f, 0.f, 0.f, 0.f};
    const int scw = F8_SCALE_W, sca = F8_SCALE_A;
    bf16x8 At[4][2], B0[2][2], B1[2][2]; i32x8 At8[4], B08[2], B18[2];
#define PG8_KT(u, t_) ((size_t)(Sched::ROT ? (((t_) + (u).koff) % nt1) : ((t_) % nt1)) * kstep)
    PG8_STAGE(PG8_SB(0, 0), cur.B0 + PG8_KT(cur, 0), voffB); PG8_STAGE(PG8_SB(0, 1), cur.B1 + PG8_KT(cur, 0), voffB);
    PG8_VOFF(cvA, cur);
    if (Sched::GATHER) { asm volatile("s_waitcnt vmcnt(0)" ::: "memory"); }
    PG8_STAGE(PG8_SA(0, 0), cur.A0 + PG8_KT(cur, 0), cvA[0]); PG8_STAGE(PG8_SA(0, 1), cur.A1 + PG8_KT(cur, 0), cvA[1]);
    if (wr == 1) PG8_BAR;
    PG8_WAIT_V(2); PG8_BAR;
    PG8_STAGE(PG8_SB(1, 0), cur.B0 + PG8_KT(cur, 1), voffB); PG8_STAGE(PG8_SA(1, 0), cur.A0 + PG8_KT(cur, 1), cvA[0]); PG8_STAGE(PG8_SB(1, 1), cur.B1 + PG8_KT(cur, 1), voffB);
    PG8_WAIT_V(6); PG8_BAR;
    for (;;) {
        const bool has_next = S.next(ui + 1, nxt);
        if (!has_next) nxt = cur;
        int nraw[2][2];
        if (Sched::GATHER && has_next) {
#pragma unroll
            for (int _h = 0; _h < 2; ++_h)
#pragma unroll
                for (int _i = 0; _i < 2; ++_i) { const int* p_ = S.row_ptr(nxt, _h * HALF + Rr[_i]); asm volatile("global_load_dword %0, %1, off" : "=v"(nraw[_h][_i]) : "v"(p_) : "memory"); }
        }
        if (has_next) { if (!Sched::GATHER) { PG8_VOFF(nvA, nxt); } }
        else {
#pragma unroll
            for (int _h = 0; _h < 2; ++_h)
#pragma unroll
                for (int _i = 0; _i < 2; ++_i) nvA[_h][_i] = cvA[_h][_i]; }
        const bool sub1A = Sched::SUB && (cur.sub & 1), sub1B = Sched::SUB && (cur.sub & 2);
#pragma unroll 1
        for (int t = 0; t < nt; t += 2) {
            const bool last = (t == nt - 2); const bool rx = (t == 0) && (ui > 0);
            if (Epi::MID && t == nt / 2) E.mid(acc, cur, wr, wc, fr, fq);
            const char* a1_1 = cur.A1 + PG8_KT(cur, t + 1);
            const size_t k2 = last ? PG8_KT(nxt, 0) : PG8_KT(cur, t + 2), k3 = last ? PG8_KT(nxt, 1) : PG8_KT(cur, t + 3);
            const char* a2_0 = (last ? nxt.A0 : cur.A0) + k2; const char* a2_1 = (last ? nxt.A1 : cur.A1) + k2;
            const char* b2_0 = (last ? nxt.B0 : cur.B0) + k2; const char* b2_1 = (last ? nxt.B1 : cur.B1) + k2;
            const char* a3_0 = (last ? nxt.A0 : cur.A0) + k3; const char* a3_1 = (last ? nxt.A1 : cur.A1) + k3; const char* b3_0 = (last ? nxt.B0 : cur.B0) + k3; const char* b3_1 = (last ? nxt.B1 : cur.B1) + k3;
            if (Sched::GATHER && last && has_next) {
#pragma unroll
                for (int _h = 0; _h < 2; ++_h)
#pragma unroll
                    for (int _i = 0; _i < 2; ++_i) { int r_ = nraw[_h][_i]; asm volatile("" : "+v"(r_));
                        nvA[_h][_i] = (unsigned)(r_ * KB + Cc[_i] * 2); } }
            unsigned sv0[2], sv1[2];
#pragma unroll
            for (int _i = 0; _i < 2; ++_i) { sv0[_i] = last ? nvA[0][_i] : cvA[0][_i]; sv1[_i] = last ? nvA[1][_i] : cvA[1][_i]; }
            PG8_LDB(B0, 0, 0); if (!sub1B) PG8_LDB(B1, 0, 1); PG8_SCHED; PG8_LDA(At, 0, 0); PG8_STAGE(PG8_SA(1, 1), a1_1, cvA[1]);
            PG8_WAIT_V8R(rx); PG8_WAIT_L(0); PG8_BAR; PG8_MMA(0, 0, At, B0); if (!sub1B) PG8_MMA(0, 1, At, B1); PG8_BAR; PG8_SCHED;
            if (!sub1A) PG8_LDA(At, 0, 1); PG8_STAGE(PG8_SB(0, 0), b2_0, voffB); PG8_STAGE(PG8_SB(0, 1), b2_1, voffB); PG8_STAGE(PG8_SA(0, 0), a2_0, sv0);
            PG8_WAIT_V8R(rx); PG8_WAIT_L(0); PG8_BAR; if (!sub1A) { PG8_MMA(1, 0, At, B0); if (!sub1B) PG8_MMA(1, 1, At, B1); } PG8_BAR; PG8_SCHED;
            PG8_LDB(B0, 1, 0); if (!sub1B) PG8_LDB(B1, 1, 1); PG8_SCHED; PG8_LDA(At, 1, 0); PG8_STAGE(PG8_SA(0, 1), a2_1, sv1);
            PG8_WAIT_V(8); PG8_WAIT_L(0); PG8_BAR; PG8_MMA(0, 0, At, B0); if (!sub1B) PG8_MMA(0, 1, At, B1); PG8_BAR; PG8_SCHED;
            if (!sub1A) PG8_LDA(At, 1, 1); PG8_STAGE(PG8_SB(1, 0), b3_0, voffB); PG8_STAGE(PG8_SB(1, 1), b3_1, voffB); PG8_STAGE(PG8_SA(1, 0), a3_0, sv0);
            PG8_WAIT_V(8); PG8_WAIT_L(0); PG8_BAR; if (!sub1A) { PG8_MMA(1, 0, At, B0); if (!sub1B) PG8_MMA(1, 1, At, B1); } PG8_BAR; PG8_SCHED;
            (void)a3_1; (void)b3_1;
        }
        if (wr == 0) PG8_BAR;
        if constexpr (F8) { asm volatile("s_nop 15\n\ts_nop 15\n\ts_nop 7" ::: "memory"); }
        E(acc, cur, wr, wc, fr, fq);
        if (!has_next) break;
#pragma unroll
        for (int a = 0; a < 2; ++a)
#pragma unroll
            for (int b = 0; b < 2; ++b)
#pragma unroll
                for (int m = 0; m < 4; ++m)
#pragma unroll
                    for (int n = 0; n < 2; ++n) acc[a][b][m][n] = (f32x4){0.f, 0.f, 0.f, 0.f};
        cur = nxt; ++ui;
#pragma unroll
        for (int _h = 0; _h < 2; ++_h)
#pragma unroll
            for (int _i = 0; _i < 2; ++_i) cvA[_h][_i] = nvA[_h][_i];
        if (wr == 1) PG8_BAR;
    }
    PG8_WAIT_V(0);
    PG8_BAR;
#undef PG8_SA
#undef PG8_SB
#undef PG8_STAGE
#undef PG8_LDA
#undef PG8_LDB
#undef PG8_MMA
#undef PG8_LD8
#undef PG8_WAIT_V
#undef PG8_WAIT_V8R
#undef PG8_WAIT_L
#undef PG8_BAR
#undef PG8_SCHED
#undef PG8_VOFF
#undef PG8_KT
}
}

namespace pg8 {

template <bool ROT_ = false> struct DenseOrderT {
    static constexpr bool GATHER = false, SUB = false, ROT = ROT_;
    const bf16_t* A; const bf16_t* Bt; int nM, nN, nwg, G, c;
    __device__ __forceinline__ void init(const bf16_t* A_, const bf16_t* Bt_, int M, int N, int G_, int c_) { A = A_; Bt = Bt_; nM = M / BM; nN = N / BM; nwg = nM * nN; G = G_; c = c_; }
    __device__ __forceinline__ bool next(int i, Unit& u) const {
        const long L = (long)i * G + c; if (L >= nwg) return false;
        int wgid = (int)L; { const int q = nwg / NXCD, r = nwg % NXCD, xcd = wgid % NXCD, off = wgid / NXCD; wgid = (xcd < r ? xcd * (q + 1) : r * (q + 1) + (xcd - r) * q) + off; }
        const int nig = WGM * nN, gid = wgid / nig, fm = gid * WGM, gsz = (nM - fm) < WGM ? (nM - fm) : WGM;
        u.pm = fm + ((wgid % nig) % gsz); u.pn = (wgid % nig) / gsz; u.e = 0; u.ord = i; u.sub = 0; u.koff = ROT ? ((u.pm + u.pn) & 1) * (GNT / 2) : 0;
        u.A0 = (const char*)A + (size_t)u.pm * BM * GK * 2; u.A1 = u.A0 + (size_t)HALF * GK * 2;
        u.B0 = (const char*)Bt + (size_t)u.pn * BM * GK * 2; u.B1 = u.B0 + (size_t)HALF * GK * 2;
        return true;
    }
    __device__ __forceinline__ int row_of(const Unit&, int r) const { return r; }
    __device__ __forceinline__ const int* row_ptr(const Unit&, int) const { return nullptr; }
};
typedef DenseOrderT<false> DenseOrder;
struct UpOrder {
    static constexpr bool GATHER = true, SUB = false, ROT = false;
    const unsigned char* H2; const unsigned char* WupT; const int* row_tok; const PG8_LAS int* mt_exp; int nunits, G, c;
    __device__ __forceinline__ bool next(int i, Unit& u) const {
        const int L = i * G + c; if (L >= nunits) return false;
        u.pm = L >> 3; u.pn = L & 7; u.e = __builtin_amdgcn_readfirstlane(mt_exp[u.pm]); u.ord = i; u.sub = 0; u.koff = 0;
        u.A0 = (const char*)H2; u.A1 = (const char*)H2;
        u.B0 = (const char*)WupT + ((size_t)u.e * 2 * DEXP + (size_t)u.pn * HALF) * GK; u.B1 = u.B0 + (size_t)DEXP * GK;
        return true;
    }
    __device__ __forceinline__ int row_of(const Unit& u, int r) const { return row_tok[u.pm * BM + r]; }
    __device__ __forceinline__ const int* row_ptr(const Unit& u, int r) const { return row_tok + u.pm * BM + r; }
};
__host__ __device__ __forceinline__ bool down_unit(int i, int c, int nunits, int G, int& L, int& sub) {
    const int full = nunits / G, rem = nunits - full * G;
    sub = 0;
    if (i < full) { L = i * G + c; return true; }
    if (i > full || rem == 0) return false;
    if (rem * 4 <= G) { if (c >= rem * 4) return false; L = full * G + (c >> 2); sub = 3 | ((c & 2) << 1) | ((c & 1) << 3); return true; }
    if (rem * 2 <= G) { if (c >= rem * 2) return false; L = full * G + (c >> 1); sub = 2 | ((c & 1) << 3); return true; }
    if (c >= rem) return false;
    L = full * G + c; return true;
}
struct DownOrder {
    static constexpr bool GATHER = false, SUB = true, ROT = false;
    const unsigned char* ACT; const unsigned char* WdnT; const PG8_LAS int* mt_exp; int nunits, G, c;
    __device__ __forceinline__ bool next(int i, Unit& u) const {
        int L, sub; if (!down_unit(i, c, nunits, G, L, sub)) return false;
        u.pm = L >> 2; u.pn = L & 3; u.e = __builtin_amdgcn_readfirstlane(mt_exp[u.pm]); u.ord = i; u.sub = sub; u.koff = 0;
        u.A0 = (const char*)ACT + (size_t)u.pm * BM * GK; u.A1 = u.A0 + (size_t)HALF * GK;
        u.B0 = (const char*)WdnT + ((size_t)u.e * DM + (size_t)u.pn * BM) * GK; u.B1 = u.B0 + (size_t)HALF * GK;
        if (sub & 1) { if (sub & 4) u.A0 = u.A1; else u.A1 = u.A0; }
        if (sub & 2) { if (sub & 8) u.B0 = u.B1; else u.B1 = u.B0; }
        return true;
    }
    __device__ __forceinline__ int row_of(const Unit&, int r) const { return r; }
    __device__ __forceinline__ const int* row_ptr(const Unit&, int) const { return nullptr; }
};

struct EpiProj {
    static constexpr bool PERM = true, MID = false; static constexpr int NST = 16;
    bf16_t* O; size_t tstride; float qscale;
    __device__ __forceinline__ void mid(f32x4 (&)[2][2][4][2], const Unit&, int, int, int, int) const {}
    __device__ __forceinline__ void operator()(const f32x4 (&acc)[2][2][4][2], const Unit& u, int wr, int wc, int fr, int fq) const {
        const int t = u.pn >> 1; bf16_t* base = O + (size_t)t * tstride; const float sc = (t == 2) ? qscale : 1.f;
        const int row0 = u.pm * BM + wr * 64 + fr, col0 = (u.pn & 1) * BM + wc * 32 + 8 * fq;
#pragma unroll
        for (int ai = 0; ai < 2; ++ai)
#pragma unroll
            for (int m = 0; m < 4; ++m) { bf16_t* rowp = base + (size_t)(row0 + ai * HALF + m * 16) * 512 + col0;
#pragma unroll
                for (int bj = 0; bj < 2; ++bj) { const f32x4 v0 = acc[ai][bj][m][0] * sc, v1 = acc[ai][bj][m][1] * sc;
                    u32x4 w; w.x = cvt_pk_bf16(v0[0], v0[1]); w.y = cvt_pk_bf16(v0[2], v0[3]); w.z = cvt_pk_bf16(v1[0], v1[1]); w.w = cvt_pk_bf16(v1[2], v1[3]);
                    *(u32x4*)(rowp + bj * HALF) = w; } }
    }
};
struct EpiOut {
    static constexpr bool PERM = true, MID = true; static constexpr int NST = 0;
    bf16_t* Y; const PG8_LAS float* ssql;
    __device__ __forceinline__ void mid(f32x4 (&acc)[2][2][4][2], const Unit& u, int wr, int wc, int fr, int fq) const {
#pragma unroll
        for (int ai = 0; ai < 2; ++ai)
#pragma unroll
            for (int m = 0; m < 4; ++m) { const int row = ai * HALF + wr * 64 + m * 16 + fr;
                const f32x4 s0 = *(const PG8_LAS f32x4*)(ssql + row * 8), s1 = *(const PG8_LAS f32x4*)(ssql + row * 8 + 4);
                const float tot = ((s0[0] + s0[1]) + (s0[2] + s0[3])) + ((s1[0] + s1[1]) + (s1[2] + s1[3]));
                const float ri = __builtin_amdgcn_rsqf(tot * (1.0f / DATT) + RMS_EPS);
#pragma unroll
                for (int bj = 0; bj < 2; ++bj)
#pragma unroll
                    for (int n = 0; n < 2; ++n) acc[ai][bj][m][n] = acc[ai][bj][m][n] * ri; }
    }
    __device__ __forceinline__ void operator()(const f32x4 (&acc)[2][2][4][2], const Unit& u, int wr, int wc, int fr, int fq) const {
        const int row0 = u.pm * BM + wr * 64 + fr, col0 = u.pn * BM + wc * 32 + 8 * fq;
#pragma unroll
        for (int ai = 0; ai < 2; ++ai)
#pragma unroll
            for (int m = 0; m < 4; ++m) { bf16_t* rowp = Y + (size_t)(row0 + ai * HALF + m * 16) * DM + col0;
#pragma unroll
                for (int bj = 0; bj < 2; ++bj) { const f32x4 v0 = acc[ai][bj][m][0], v1 = acc[ai][bj][m][1];
                    u32x4 w; w.x = cvt_pk_bf16(v0[0], v0[1]); w.y = cvt_pk_bf16(v0[2], v0[3]); w.z = cvt_pk_bf16(v1[0], v1[1]); w.w = cvt_pk_bf16(v1[2], v1[3]);
                    *(u32x4*)(rowp + bj * HALF) = w; } }
    }
};
template <bool STORE = true> struct EpiUpT {
    static constexpr bool PERM = true, MID = false; static constexpr int NST = STORE ? 8 : 0;
    unsigned char* ACT; const PG8_LAS float* bias;
    __device__ __forceinline__ void mid(f32x4 (&)[2][2][4][2], const Unit&, int, int, int, int) const {}
    __device__ __forceinline__ void operator()(const f32x4 (&acc)[2][2][4][2], const Unit& u, int wr, int wc, int fr, int fq) const {
        const int row0 = u.pm * BM + wr * 64 + fr, col0 = u.pn * HALF + wc * 32 + 8 * fq;
        const PG8_LAS float* bg = bias + u.ord * 256 + wc * 32 + 8 * fq;
        f32x4 bgl[2], bli[2];
#pragma unroll
        for (int n = 0; n < 2; ++n) { bgl[n] = *(const PG8_LAS f32x4*)(bg + 4 * n); bli[n] = *(const PG8_LAS f32x4*)(bg + HALF + 4 * n) + 1.0f; }
#pragma unroll
        for (int ai = 0; ai < 2; ++ai)
#pragma unroll
            for (int m = 0; m < 4; ++m) { unsigned char* rowp = ACT + (size_t)(row0 + ai * HALF + m * 16) * DEXP + col0;
                f32x4 o[2];
#pragma unroll
                for (int n = 0; n < 2; ++n) { f32x4 g = acc[ai][0][m][n] + bgl[n], l = acc[ai][1][m][n] + bli[n];
#pragma unroll
                    for (int j = 0; j < 4; ++j) { g[j] = fminf(g[j], 7.0f); l[j] = __builtin_amdgcn_fmed3f(l[j], -6.0f, 8.0f); }
                    f32x4 t = g * (-1.702f * 1.4426950408889634f);
#pragma unroll
                    for (int j = 0; j < 4; ++j) t[j] = __builtin_amdgcn_exp2f(t[j]);
                    t = t + 1.0f;
#pragma unroll
                    for (int j = 0; j < 4; ++j) t[j] = __builtin_amdgcn_rcpf(t[j]);
                    o[n] = (g * t) * l; }
                int w0 = 0, w1 = 0; w0 = __builtin_amdgcn_cvt_pk_fp8_f32(o[0][0], o[0][1], w0, false); w0 = __builtin_amdgcn_cvt_pk_fp8_f32(o[0][2], o[0][3], w0, true);
                w1 = __builtin_amdgcn_cvt_pk_fp8_f32(o[1][0], o[1][1], w1, false); w1 = __builtin_amdgcn_cvt_pk_fp8_f32(o[1][2], o[1][3], w1, true);
                typedef int i32x2_ __attribute__((ext_vector_type(2))); if (STORE) *(i32x2_*)rowp = (i32x2_){w0, w1}; else asm volatile("" :: "v"(w0), "v"(w1)); }
    }
};
typedef EpiUpT<true> EpiUp;
struct EpiDown {
    static constexpr bool PERM = true, MID = false; static constexpr int NST = 16;
    unsigned char* YP; const PG8_LAS float* bias; const int* row_pair; const float* row_w;
    __device__ __forceinline__ void mid(f32x4 (&)[2][2][4][2], const Unit&, int, int, int, int) const {}
    __device__ __forceinline__ void operator()(const f32x4 (&acc)[2][2][4][2], const Unit& u, int wr, int wc, int fr, int fq) const {
        const int nA = (u.sub & 1) ? 1 : 2, nB = (u.sub & 2) ? 1 : 2, ro = (u.sub & 4) ? HALF : 0, co = (u.sub & 8) ? HALF : 0;
        const int row0 = u.pm * BM + ro + wr * 64 + fr, col0 = u.pn * BM + co + wc * 32 + 8 * fq;
        const PG8_LAS float* bd = bias + u.ord * 256 + co + wc * 32 + 8 * fq;
        f32x4 bv[2][2];
#pragma unroll
        for (int bj = 0; bj < 2; ++bj)
#pragma unroll
            for (int n = 0; n < 2; ++n) bv[bj][n] = *(const PG8_LAS f32x4*)(bd + (bj < nB ? bj : 0) * HALF + 4 * n);
        int pr[2][4]; float wt[2][4];
#pragma unroll
        for (int ai = 0; ai < 2; ++ai)
#pragma unroll
            for (int m = 0; m < 4; ++m) { const int pos = row0 + (ai < nA ? ai : 0) * HALF + m * 16; pr[ai][m] = row_pair[pos]; wt[ai][m] = row_w[pos] * 4.0f; }
#pragma unroll
        for (int ai = 0; ai < 2; ++ai) { if (ai >= nA) continue;
#pragma unroll
            for (int m = 0; m < 4; ++m) { const int pair = pr[ai][m] >= 0 ? pr[ai][m] : NTOK * TOPK; const float w = wt[ai][m];
                { unsigned char* rowp = YP + (size_t)pair * DM + col0;
#pragma unroll
                    for (int bj = 0; bj < 2; ++bj) if (bj < nB) { const f32x4 v0 = (acc[ai][bj][m][0] + bv[bj][0]) * w, v1 = (acc[ai][bj][m][1] + bv[bj][1]) * w;
                        int q0 = 0, q1 = 0; q0 = __builtin_amdgcn_cvt_pk_fp8_f32(v0[0], v0[1], q0, false); q0 = __builtin_amdgcn_cvt_pk_fp8_f32(v0[2], v0[3], q0, true);
                        q1 = __builtin_amdgcn_cvt_pk_fp8_f32(v1[0], v1[1], q1, false); q1 = __builtin_amdgcn_cvt_pk_fp8_f32(v1[2], v1[3], q1, true);
                        typedef int i32x2_ __attribute__((ext_vector_type(2))); *(i32x2_*)(rowp + bj * HALF) = (i32x2_){q0, q1}; } } } }
    }
};
#ifdef MK_PROBES
struct EpiNop {
    static constexpr bool PERM = true, MID = false; static constexpr int NST = 0;
    __device__ __forceinline__ void mid(f32x4 (&)[2][2][4][2], const Unit&, int, int, int, int) const {}
    __device__ __forceinline__ void operator()(const f32x4 (&)[2][2][4][2], const Unit&, int, int, int, int) const {}
};
#endif
}

namespace attn_body {
using bf16=__hip_bfloat16;
using bf16x8=__attribute__((ext_vector_type(8)))short;
using s16x4=__attribute__((ext_vector_type(4)))short;
using f32x16=__attribute__((ext_vector_type(16)))float;
using u32x4=__attribute__((ext_vector_type(4)))unsigned;
constexpr int BATCH=8,NHEAD=8,SEQ=2048,D=64,DM=NHEAD*D,OPITCH=1024;
constexpr int NW=8,QBLK=32,QB=QBLK*NW,KVBLK=64,NQB=SEQ/QB;
constexpr int ATTN_PITCH=DM, ATTN_UNIT_ROWS=QB;
__device__ __forceinline__ int crow(int r,int hi){return (r&3)+8*(r>>2)+4*hi;}
#define SBAR() __builtin_amdgcn_sched_barrier(0)
__device__ __forceinline__ void cmask(f32x16&p0,f32x16&p1,int jb,int qrel,int hi){
  const float NEG=-INFINITY; int kb=64*jb+4*hi;
  #pragma unroll
  for(int r=0;r<16;++r){int kv=kb+(r&3)+8*(r>>2); if(kv>qrel)p0[r]=NEG; if(kv+32>qrel)p1[r]=NEG;}
}

constexpr int NSLOT=3, SLOTB=8192;
constexpr int LDS_K=0, LDS_V=NSLOT*SLOTB, LDS_WS=2*NSLOT*SLOTB, LDS_OST=LDS_WS+NW*64*4, LDS_BIAS=LDS_OST+NW*4096, LDS_SCAN=LDS_BIAS+(SEQ+64)*4, LDS_BYTES=LDS_SCAN+256;
constexpr float C2=0.125f*1.4426950408889634f;
__device__ __forceinline__ void glds16(const void*gsrc,unsigned lds_dst){unsigned keep;
  asm volatile("s_mov_b32 %0, m0\n\ts_mov_b32 m0, %2\n\ts_nop 0\n\tglobal_load_lds_dwordx4 %1, off\n\ts_mov_b32 m0, %0":"=&s"(keep):"v"(gsrc),"s"(lds_dst):"memory");}
__device__ __forceinline__ float max3f(float a,float b,float c){float r;asm("v_max3_f32 %0, %1, %2, %3":"=v"(r):"v"(a),"v"(b),"v"(c));return r;}
__device__ __forceinline__ float max2f(float a,float b){float r;asm("v_max_f32_e32 %0, %1, %2":"=v"(r):"v"(a),"v"(b));return r;}
__device__ __forceinline__ float fadd_s(float a,float b){float r;asm("v_add_f32_e32 %0, %1, %2":"=v"(r):"v"(a),"v"(b));return r;}
__device__ __forceinline__ float fsub_s(float a,float b){float r;asm("v_sub_f32_e32 %0, %1, %2":"=v"(r):"v"(a),"v"(b));return r;}
typedef float f32x2_t __attribute__((ext_vector_type(2))); typedef float f32x4_t __attribute__((ext_vector_type(4))); typedef __bf16 bf16x2_t __attribute__((ext_vector_type(2)));
__device__ __forceinline__ unsigned cvtpk_s(float lo,float hi){f32x2_t v={lo,hi};bf16x2_t b=__builtin_convertvector(v,bf16x2_t);return __builtin_bit_cast(unsigned,b);}
#define WAIT_BAR(N) asm volatile("s_waitcnt vmcnt(" #N ") lgkmcnt(0)\n\ts_barrier":::"memory")

__device__ __forceinline__ void qkt(f32x16&p0,f32x16&p1,const char*Kslot,const bf16x8*qr,int r32,int hi){
  const char*kb=Kslot+hi*1024+r32*16;
  #pragma unroll
  for(int d0=0;d0<4;++d0){
    const bf16x8 b0=*reinterpret_cast<const bf16x8*>(kb+d0*2048);
    const bf16x8 b1=*reinterpret_cast<const bf16x8*>(kb+d0*2048+512);
    p0=__builtin_amdgcn_mfma_f32_32x32x16_bf16(b0,qr[d0],p0,0,0,0);p1=__builtin_amdgcn_mfma_f32_32x32x16_bf16(b1,qr[d0],p1,0,0,0);}
}
typedef __attribute__((address_space(3))) const char* lds_cptr;
typedef short v4i16_t __attribute__((ext_vector_type(4)));
__device__ __forceinline__ void kload8(bf16x8*kf,lds_cptr kp){
  kf[0]=*(const __attribute__((address_space(3))) bf16x8*)(kp);      kf[1]=*(const __attribute__((address_space(3))) bf16x8*)(kp+512);
  kf[2]=*(const __attribute__((address_space(3))) bf16x8*)(kp+2048); kf[3]=*(const __attribute__((address_space(3))) bf16x8*)(kp+2560);
  kf[4]=*(const __attribute__((address_space(3))) bf16x8*)(kp+4096); kf[5]=*(const __attribute__((address_space(3))) bf16x8*)(kp+4608);
  kf[6]=*(const __attribute__((address_space(3))) bf16x8*)(kp+6144); kf[7]=*(const __attribute__((address_space(3))) bf16x8*)(kp+6656);
}
__device__ __forceinline__ void kload2(bf16x8*kf,lds_cptr kp,int j){ kf[2*j]=*(const __attribute__((address_space(3))) bf16x8*)(kp+j*2048); kf[2*j+1]=*(const __attribute__((address_space(3))) bf16x8*)(kp+j*2048+512); }
__device__ __forceinline__ s16x4 vtr(lds_cptr p){ return __builtin_bit_cast(s16x4,__builtin_amdgcn_ds_read_tr16_b64_v4i16((__attribute__((address_space(3))) v4i16_t*)p)); }
__device__ __forceinline__ float rowmax(const f32x16&p0,const f32x16&p1){
  float a=max3f(p0[0],p0[1],p1[0]),b=max3f(p0[2],p0[3],p1[1]);a=max3f(a,p1[2],p1[3]);
  #pragma unroll
  for(int r=4;r<16;r+=4){a=max3f(a,p0[r],p0[r+1]);b=max3f(b,p0[r+2],p0[r+3]);a=max3f(a,p1[r],p1[r+1]);b=max3f(b,p1[r+2],p1[r+3]);}
  const float m=max2f(a,b);
  auto rr=__builtin_amdgcn_permlane32_swap(__float_as_uint(m),__float_as_uint(m),false,false);
  return max2f(__uint_as_float(rr[0]),__uint_as_float(rr[1]));
}
__device__ __forceinline__ void pv(f32x16*o,int vb,bf16x8 pa0,bf16x8 pa1,bf16x8 pa2,bf16x8 pa3){
  #pragma unroll
  for(int d0=0;d0<2;++d0){s16x4 lo[4],hi[4];
    #pragma unroll
    for(int ks=0;ks<4;++ks){
      asm volatile("ds_read_b64_tr_b16 %0,%1 offset:%c2":"=&v"(lo[ks]):"v"(vb),"i"(d0*4096+ks*1024):"memory");
      asm volatile("ds_read_b64_tr_b16 %0,%1 offset:%c2":"=&v"(hi[ks]):"v"(vb),"i"(d0*4096+ks*1024+512):"memory");}
    asm volatile("s_waitcnt lgkmcnt(0)":::"memory");SBAR();
    #define PK(k) (bf16x8){lo[k][0],lo[k][1],lo[k][2],lo[k][3],hi[k][0],hi[k][1],hi[k][2],hi[k][3]}
    o[d0]=__builtin_amdgcn_mfma_f32_32x32x16_bf16(pa0,PK(0),o[d0],0,0,0);
    o[d0]=__builtin_amdgcn_mfma_f32_32x32x16_bf16(pa1,PK(1),o[d0],0,0,0);
    o[d0]=__builtin_amdgcn_mfma_f32_32x32x16_bf16(pa2,PK(2),o[d0],0,0,0);
    o[d0]=__builtin_amdgcn_mfma_f32_32x32x16_bf16(pa3,PK(3),o[d0],0,0,0);
    #undef PK
  }
}

#ifndef ATTN_STORE16
#define ATTN_STORE16(p,v) (*(u32x4*)(p)=(v))
#endif
template<int THRL> __device__ __forceinline__ void attn_unit(int b,int h,int qb,const bf16*Q,const bf16*__restrict__ K,const bf16*__restrict__ V,bf16*O,const float*__restrict__ LOGF2,float*SSQ,char*shm){
  const int tid=threadIdx.x,lane=tid&63,r32=lane&31,hi=lane>>5; const int wid=__builtin_amdgcn_readfirstlane(tid>>6);
  const long rowbase=(long)b*SEQ; const int q0=qb*QB;
  const bf16*Qw=Q+(rowbase+q0+wid*QBLK)*DM+h*D;
  const bf16*Kh=K+rowbase*DM+h*D,*Vh=V+rowbase*DM+h*D;
  const unsigned lds0=(unsigned)(uintptr_t)shm;
  float*wsf=(float*)(shm+LDS_WS)+wid*64;
  const bf16*ksrc=Kh+(long)lane*DM+wid*8;
  const bf16*vsrc=Vh+(long)(16*(wid&3)+(lane>>2))*DM+(wid>>2)*32+(lane&3)*8;
  const unsigned kdst=lds0+LDS_K+wid*1024, vdst=lds0+LDS_V+wid*1024;
  #define DMA_K(t,slot) glds16(ksrc+(long)(t)*KVBLK*DM,(unsigned)__builtin_amdgcn_readfirstlane(kdst+(slot)))
  #define DMA_V(t,slot) glds16(vsrc+(long)(t)*KVBLK*DM,(unsigned)__builtin_amdgcn_readfirstlane(vdst+(slot)))
  const int vb0=(int)(lds0+LDS_V)+((lane>>4)&1)*32+(lane&3)*8+(4*hi+((lane&15)>>2))*64;
  const char*Kbase=shm+LDS_K; bf16x8 kf[8];
  const lds_cptr shm3=(lds_cptr)shm; const lds_cptr kp0=shm3+LDS_K+hi*1024+r32*16; const lds_cptr vp0=shm3+LDS_V+((lane>>4)&1)*32+(lane&3)*8+(4*hi+((lane&15)>>2))*64;
  const int NT=(q0+QB)/KVBLK;
  const lds_cptr biasr=(lds_cptr)shm+LDS_BIAS+16*hi;
  #define BIAS4(t,o) (*(const __attribute__((address_space(3))) f32x4_t*)(biasr+(t)*(KVBLK*4)+(o)*4))
  #define INIT4(Y,g,t,o) do{ const f32x4_t x_=BIAS4(t,(o)+8*(g)); const f32x2_t m2_={mhat,mhat}; const f32x2_t a_=(f32x2_t){x_[0],x_[1]}-m2_, b_=(f32x2_t){x_[2],x_[3]}-m2_; Y[4*(g)]=a_[0]; Y[4*(g)+1]=a_[1]; Y[4*(g)+2]=b_[0]; Y[4*(g)+3]=b_[1]; }while(0)
  #define INITT(Y0,Y1,t) do{ INIT4(Y0,0,t,0);INIT4(Y0,1,t,0);INIT4(Y0,2,t,0);INIT4(Y0,3,t,0); INIT4(Y1,0,t,32);INIT4(Y1,1,t,32);INIT4(Y1,2,t,32);INIT4(Y1,3,t,32); }while(0)
  DMA_K(0,0);DMA_V(0,0);DMA_K(1,SLOTB);
  bf16x8 qr[4];
  #pragma unroll
  for(int d0=0;d0<4;++d0)qr[d0]=*reinterpret_cast<const bf16x8*>(&Qw[(long)r32*DM+d0*16+hi*8]);
  float mhat,l_reg=0.f;f32x16 o[2];o[0]=f32x16{};o[1]=f32x16{};
  const int qrel=wid*QBLK+r32;
  #define CMASK(P0,P1,t) do{int jb_=(t)-(NT-4); if(jb_>=0)cmask(P0,P1,jb_,qrel,hi);}while(0)
  bool resc=false;
  #define START(P0,P1) do{ const float rm=rowmax(P0,P1); resc=false; \
    { const float dl=__builtin_fmaxf(rm,0.f); mhat=fadd_s(mhat,dl); \
      _Pragma("unroll") for(int r=0;r<16;++r){P0[r]=fsub_s(P0[r],dl);P1[r]=fsub_s(P1[r],dl);} } \
    _Pragma("unroll") for(int r=0;r<16;++r)P0[r]=__builtin_amdgcn_exp2f(P0[r]); }while(0)
  #define RESC() do{ if(resc){ asm volatile("s_waitcnt lgkmcnt(0)":::"memory"); \
      _Pragma("unroll") for(int d_=0;d_<2;++d_) _Pragma("unroll") for(int r=0;r<16;++r)o[d_][r]*=wsf[crow(r,hi)]; } }while(0)
  f32x16 pA0,pA1,pB0,pB1;
  int sl_prev=0,sl_cur=0,sl_next=SLOTB;
  #define ROT() do{sl_prev=sl_cur;sl_cur=sl_next;sl_next=(sl_next==(NSLOT-1)*SLOTB)?0:sl_next+SLOTB;}while(0)
  DMA_K(2,2*SLOTB);
  { float*biasl=(float*)(shm+LDS_BIAS); float*scn=(float*)(shm+LDS_SCAN);
    const float*lf=LOGF2+rowbase*NHEAD+h;
    float v0=0.f,v1=0.f,v2=0.f,v3=0.f; const int i0=4*tid;
    if(i0<q0){ v0=lf[(long)(q0-1-i0)*NHEAD]; v1=lf[(long)(q0-2-i0)*NHEAD]; v2=lf[(long)(q0-3-i0)*NHEAD]; v3=lf[(long)(q0-4-i0)*NHEAD]; }
    const float tsum=(v0+v1)+(v2+v3); float inc=tsum;
    #pragma unroll
    for(int o=1;o<64;o<<=1){ const float n_=__shfl_up(inc,o); if(lane>=o)inc+=n_; }
    if(lane==63)scn[wid]=inc;
    const float f0=lf[(long)(q0+4*lane)*NHEAD],f1=lf[(long)(q0+4*lane+1)*NHEAD],f2=lf[(long)(q0+4*lane+2)*NHEAD],f3=lf[(long)(q0+4*lane+3)*NHEAD];
    float finc=(f0+f1)+(f2+f3);
    #pragma unroll
    for(int o=1;o<64;o<<=1){ const float n_=__shfl_up(finc,o); if(lane>=o)finc+=n_; }
    const float fex=finc-((f0+f1)+(f2+f3));
    if(wid==0){ biasl[q0+4*lane]=-(fex+f0); biasl[q0+4*lane+1]=-(fex+f0+f1); biasl[q0+4*lane+2]=-(fex+f0+f1+f2); biasl[q0+4*lane+3]=-(fex+f0+f1+f2+f3); }
    __syncthreads();
    float woff=0.f;
    #pragma unroll
    for(int w_=0;w_<NW;++w_) woff+=(w_<wid)?scn[w_]:0.f;
    const float ex=woff+inc-tsum;
    if(i0<q0){ biasl[q0-1-i0]=ex; biasl[q0-2-i0]=ex+v0; biasl[q0-3-i0]=ex+v0+v1; biasl[q0-4-i0]=ex+v0+v1+v2; }
    __syncthreads(); }
  mhat=((const float*)(shm+LDS_BIAS))[q0+wid*QBLK+r32]+8.0f;

  WAIT_BAR(3);
  INITT(pA0,pA1,0); qkt(pA0,pA1,Kbase,qr,r32,hi);asm volatile("s_nop 15\n\ts_nop 7":"+v"(pA0),"+v"(pA1));CMASK(pA0,pA1,0);
  START(pA0,pA1);
  _Pragma("unroll") for(int r=0;r<16;++r)pA1[r]=__builtin_amdgcn_exp2f(pA1[r]);
  INITT(pB0,pB1,1);
  WAIT_BAR(0);
  DMA_K(3,0);DMA_V(1,SLOTB);
  ROT();
  kload8(kf,kp0+sl_cur);
  WAIT_BAR(2);
  s16x4 vlo[8],vhi[8]; u32x4 pw0,pw1,pw2,pw3;
  #define PKW(P,B) cvtpk_s(P[B],P[B+1])
  #define PAF(k) __builtin_bit_cast(bf16x8,pw##k)
  #define VFR(i) (bf16x8){vlo[i][0],vlo[i][1],vlo[i][2],vlo[i][3],vhi[i][0],vhi[i][1],vhi[i][2],vhi[i][3]}
  #define PIN(x) asm volatile("":"+v"(x))
  #define MX3(a,b,c) __builtin_fmaxf(__builtin_fmaxf((a),(b)),(c))
  #define GAPA(MF,A0,A1,A2,A3,W0,W1,PW) do{ MF; sacc+=A0; sacc+=A1; sacc+=A2; sacc+=A3; PIN(sacc); W0; W1; PIN(PW); SBAR(); }while(0)
  #define EX(v) __builtin_amdgcn_exp2f(v)
  #define GAPB(MF,X,B,GN,Y,tn,o) do{ MF; X[B]=EX(X[B]); X[B+1]=EX(X[B+1]); X[B+2]=EX(X[B+2]); X[B+3]=EX(X[B+3]); PIN(X); if(GN){ INIT4(Y,(B)/4,tn,o); PIN(Y); } SBAR(); }while(0)
  #define VRD(i) do{ vlo[i]=vtr(vp_+(((i)>>2)*4096+((i)&3)*1024)); vhi[i]=vtr(vp_+(((i)>>2)*4096+((i)&3)*1024+512)); }while(0)
  #define KRD(G,j) do{ if(G){ kload2(kf,kp0+sl_next,j); SBAR(); } }while(0)
  #define STEP(C0,C1,P0,P1,t,GK,GV,GL) do{ SBAR(); \
    const lds_cptr vp_=vp0+sl_prev; \
    VRD(0); SBAR(); float sacc=(P0[0]+P0[1]); \
    GAPA(C0=__builtin_amdgcn_mfma_f32_32x32x16_bf16(kf[0],qr[0],C0,0,0,0), P0[2],P0[3],P0[4],P0[5],     pw0[0]=PKW(P0,0), pw0[1]=PKW(P0,2), pw0); \
    VRD(4); SBAR(); GAPA(C1=__builtin_amdgcn_mfma_f32_32x32x16_bf16(kf[1],qr[0],C1,0,0,0), P0[6],P0[7],P0[8],P0[9],     pw0[2]=PKW(P0,4), pw0[3]=PKW(P0,6), pw0); \
    VRD(1); SBAR(); GAPA(C0=__builtin_amdgcn_mfma_f32_32x32x16_bf16(kf[2],qr[1],C0,0,0,0),   P0[10],P0[11],P0[12],P0[13], pw1[0]=PKW(P0,8), pw1[1]=PKW(P0,10), pw1); \
    VRD(5); SBAR(); GAPA(C1=__builtin_amdgcn_mfma_f32_32x32x16_bf16(kf[3],qr[1],C1,0,0,0),   P0[14],P0[15],P1[0],P1[1],   pw1[2]=PKW(P0,12),pw1[3]=PKW(P0,14), pw1); \
    VRD(2); SBAR(); GAPA(C0=__builtin_amdgcn_mfma_f32_32x32x16_bf16(kf[4],qr[2],C0,0,0,0),   P1[2],P1[3],P1[4],P1[5],     pw2[0]=PKW(P1,0), pw2[1]=PKW(P1,2), pw2); \
    VRD(6); SBAR(); GAPA(C1=__builtin_amdgcn_mfma_f32_32x32x16_bf16(kf[5],qr[2],C1,0,0,0),   P1[6],P1[7],P1[8],P1[9],     pw2[2]=PKW(P1,4), pw2[3]=PKW(P1,6), pw2); \
    VRD(3); SBAR(); GAPA(C0=__builtin_amdgcn_mfma_f32_32x32x16_bf16(kf[6],qr[3],C0,0,0,0),   P1[10],P1[11],P1[12],P1[13], pw3[0]=PKW(P1,8), pw3[1]=PKW(P1,10), pw3); \
    VRD(7); SBAR(); GAPA(C1=__builtin_amdgcn_mfma_f32_32x32x16_bf16(kf[7],qr[3],C1,0,0,0),   P1[14],P1[15],0.f,0.f,       pw3[2]=PKW(P1,12),pw3[3]=PKW(P1,14), pw3); \
    l_reg+=sacc; \
    if(GK){DMA_K((t)+3,sl_cur);} if(GV){DMA_V((t)+1,sl_next);} \
    CMASK(C0,C1,t); \
    { float a=MX3(C0[0],C0[1],C1[0]),b=MX3(C0[2],C0[3],C1[1]); a=MX3(a,C1[2],C1[3]); \
      _Pragma("unroll") for(int r=4;r<16;r+=4){a=MX3(a,C0[r],C0[r+1]);b=MX3(b,C0[r+2],C0[r+3]);a=MX3(a,C1[r],C1[r+1]);b=MX3(b,C1[r+2],C1[r+3]);} \
      float rm=__builtin_fmaxf(a,b); { auto rr=__builtin_amdgcn_permlane32_swap(__float_as_uint(rm),__float_as_uint(rm),false,false); rm=__builtin_fmaxf(__uint_as_float(rr[0]),__uint_as_float(rr[1])); } \
      resc=false; \
      if(__builtin_expect(__any(rm>(float)THRL),0)){ const float dl=__builtin_fmaxf(rm,0.f); mhat+=dl; \
        _Pragma("unroll") for(int r=0;r<16;++r){C0[r]-=dl;C1[r]-=dl;} \
        const float f=__builtin_amdgcn_exp2f(-dl); l_reg*=f; if(hi==0)wsf[r32]=f; resc=true; } } \
    SBAR(); \
    GAPB(o[0]=__builtin_amdgcn_mfma_f32_32x32x16_bf16(PAF(0),VFR(0),o[0],0,0,0), C0,0,  GL,P0,(t)+1,0); \
    GAPB(o[1]=__builtin_amdgcn_mfma_f32_32x32x16_bf16(PAF(0),VFR(4),o[1],0,0,0), C0,4,  GL,P0,(t)+1,0); \
    KRD(GL,0); GAPB(o[0]=__builtin_amdgcn_mfma_f32_32x32x16_bf16(PAF(1),VFR(1),o[0],0,0,0), C0,8,  GL,P0,(t)+1,0); \
    KRD(GL,1); GAPB(o[1]=__builtin_amdgcn_mfma_f32_32x32x16_bf16(PAF(1),VFR(5),o[1],0,0,0), C0,12, GL,P0,(t)+1,0); \
    KRD(GL,2); GAPB(o[0]=__builtin_amdgcn_mfma_f32_32x32x16_bf16(PAF(2),VFR(2),o[0],0,0,0), C1,0,  GL,P1,(t)+1,32); \
    KRD(GL,3); GAPB(o[1]=__builtin_amdgcn_mfma_f32_32x32x16_bf16(PAF(2),VFR(6),o[1],0,0,0), C1,4,  GL,P1,(t)+1,32); \
    GAPB(o[0]=__builtin_amdgcn_mfma_f32_32x32x16_bf16(PAF(3),VFR(3),o[0],0,0,0), C1,8,  GL,P1,(t)+1,32); \
    GAPB(o[1]=__builtin_amdgcn_mfma_f32_32x32x16_bf16(PAF(3),VFR(7),o[1],0,0,0), C1,12, GL,P1,(t)+1,32); \
    }while(0)
  int t=1;
  #undef CMASK
  #define CMASK(P0,P1,t) do{}while(0)
  for(;t+5<NT;t+=2){
    STEP(pB0,pB1,pA0,pA1,t,true,true,true);     WAIT_BAR(2); RESC(); ROT();
    STEP(pA0,pA1,pB0,pB1,t+1,true,true,true);   WAIT_BAR(2); RESC(); ROT();
  }
  #undef CMASK
  #define CMASK(P0,P1,t) do{int jb_=(t)-(NT-4); if(jb_>=0)cmask(P0,P1,jb_,qrel,hi);}while(0)
  #define ENDW(tt) do{ if((tt)+3<NT){WAIT_BAR(2);} else if((tt)+2<NT){WAIT_BAR(1);} else {WAIT_BAR(0);} }while(0)
  for(;t+1<NT;t+=2){
    STEP(pB0,pB1,pA0,pA1,t,(t+3<NT),(t+1<NT),(t+1<NT));       ENDW(t);   RESC(); ROT();
    STEP(pA0,pA1,pB0,pB1,t+1,(t+4<NT),(t+2<NT),(t+2<NT));     ENDW(t+1); RESC(); ROT();
  }
  STEP(pB0,pB1,pA0,pA1,NT-1,false,false,false); RESC();
  { float sacc=pB0[0]+pB0[1]; _Pragma("unroll") for(int r=2;r<16;++r)sacc+=pB0[r]; _Pragma("unroll") for(int r=0;r<16;++r)sacc+=pB1[r]; l_reg+=sacc;
    pw0=(u32x4){PKW(pB0,0),PKW(pB0,2),PKW(pB0,4),PKW(pB0,6)};pw1=(u32x4){PKW(pB0,8),PKW(pB0,10),PKW(pB0,12),PKW(pB0,14)};pw2=(u32x4){PKW(pB1,0),PKW(pB1,2),PKW(pB1,4),PKW(pB1,6)};pw3=(u32x4){PKW(pB1,8),PKW(pB1,10),PKW(pB1,12),PKW(pB1,14)};
    SBAR(); pv(o,vb0+sl_cur,PAF(0),PAF(1),PAF(2),PAF(3)); }
  #undef PKW
  #undef PAF
  #undef VFR
  #undef PIN
  #undef MX3
  #undef GAPA
  #undef GAPB
  #undef EX
  #undef VRD
  #undef KRD
  #undef STEP
  #undef ENDW
  {auto rr=__builtin_amdgcn_permlane32_swap(__float_as_uint(l_reg),__float_as_uint(l_reg),false,false);l_reg=__uint_as_float(rr[0])+__uint_as_float(rr[1]);}
  if(hi==0)wsf[32+r32]=l_reg;asm volatile("s_waitcnt lgkmcnt(0)":::"memory");
  float rli[16];
  #pragma unroll
  for(int r=0;r<16;++r)rli[r]=__builtin_amdgcn_rcpf(wsf[32+crow(r,hi)]);
  bf16*Ow=O+(rowbase+q0+wid*QBLK)*OPITCH+h*D; float*Sw=SSQ+(rowbase+q0+wid*QBLK)*NHEAD+h;
  { bf16*stg=(bf16*)(shm+LDS_OST)+wid*2048;
    #pragma unroll
    for(int r=0;r<16;++r){const int orow=crow(r,hi);
      #pragma unroll
      for(int d0=0;d0<2;++d0)stg[orow*64+d0*32+r32]=__float2bfloat16(o[d0][r]*rli[r]);}
    asm volatile("s_waitcnt lgkmcnt(0)":::"memory");
    #pragma unroll
    for(int i=0;i<4;++i){const int row=i*8+(lane>>3),ch=lane&7; const u32x4 v=*(const u32x4*)(stg+row*64+ch*8); ATTN_STORE16(Ow+(long)row*OPITCH+ch*8,v);
      float sq=0.f;
      #pragma unroll
      for(int j=0;j<4;++j){ const float lo_=__uint_as_float(v[j]<<16), hi_=__uint_as_float(v[j]&0xffff0000u); sq+=lo_*lo_+hi_*hi_; }
      sq+=__shfl_xor(sq,1); sq+=__shfl_xor(sq,2); sq+=__shfl_xor(sq,4);
      if(ch==0)Sw[(long)row*NHEAD]=sq; } }
  asm volatile("s_waitcnt lgkmcnt(0)\n\ts_barrier":::"memory");
  #undef DMA_K
  #undef BIAS4
  #undef INIT4
  #undef INITT
  #undef DMA_V
  #undef CMASK
  #undef START
  #undef RESC
  #undef ROT
}
constexpr int ATTN_LDS_BYTES=LDS_BYTES;
struct AttnTensors { const bf16* Q; const bf16* K; const bf16* V; bf16* O; const float* LOGF2; float* SSQ; };
struct AttnUnit { int bh; int qb; };
struct StaticOrder {
  int vcu,G;
  __device__ __forceinline__ explicit StaticOrder(int grid,int vcu_):vcu(vcu_),G(grid){}
  __device__ __forceinline__ bool next(int i,AttnUnit&u)const{ const int L=(i>>1)*G+vcu; if(L>=BATCH*NHEAD*4)return false; const int s=L&3; u.bh=L>>2; u.qb=(i&1)?7-s:s; return true; }
  __device__ __forceinline__ void a_ready(const AttnUnit&)const{}
  __device__ __forceinline__ void done(const AttnUnit&)const{}
};
template<class Sched,int THRL=8> __device__ __forceinline__ void attn_phase(char*lds,const AttnTensors&T,const Sched&S){
  AttnUnit u;
  for(int i=0;S.next(i,u);++i){ S.a_ready(u); attn_unit<THRL>(u.bh/NHEAD,u.bh%NHEAD,u.qb,T.Q,T.K,T.V,T.O,T.LOGF2,T.SSQ,lds); S.done(u); }
}
#undef SBAR
#undef WAIT_BAR
}

constexpr int NWAVES = 8;
constexpr int NPHASES = 11;

constexpr size_t MiB = 1u << 20, KiB = 1u << 10;
constexpr size_t WS_CTL = 0, CTL_ZERO_BYTES = 176 * KiB;
constexpr size_t WS_MOD = 1 * MiB;
constexpr size_t WS_LOGF2 = 1 * MiB + 256 * KiB;
constexpr size_t WS_SSQ = 1 * MiB + 768 * KiB;
constexpr size_t WS_TOPI = 2 * MiB + 256 * KiB;
constexpr size_t WS_TOPW = 2 * MiB + 512 * KiB;
constexpr size_t WS_WGCNT = 2 * MiB + 768 * KiB;
constexpr size_t WS_LSUM = 3 * MiB;
constexpr size_t WS_ROWTOK = 4 * MiB, WS_ROWPAIR = 4 * MiB + 512 * KiB, WS_ROWW = 5 * MiB, WS_MTEXP = 5 * MiB + 512 * KiB;
constexpr size_t WS_LWT = 6 * MiB;
constexpr size_t WS_WFT = 6 * MiB + 512 * KiB;
constexpr size_t WS_WRT = 7 * MiB;
constexpr size_t WS_WIN = 8 * MiB;
constexpr size_t WS_WOUT = 13 * MiB;
constexpr size_t WS_WUP = 16 * MiB;
constexpr size_t WS_WDN = 144 * MiB;
constexpr size_t WS_H1 = 208 * MiB;
constexpr size_t WS_XMID = WS_H1;
constexpr size_t WS_PJ = 240 * MiB;
constexpr size_t PJ_STRIDE = (size_t)NTOK * 512;
constexpr size_t WS_MRG = 320 * MiB;
constexpr size_t WS_Y = 352 * MiB;
constexpr size_t WS_H2 = 416 * MiB;
constexpr size_t WS_ACT = 448 * MiB;
constexpr size_t WS_YP = 592 * MiB;
constexpr size_t WS_LTOK = 720 * MiB, WS_LPAIR = 722 * MiB, WS_LW = 724 * MiB;
constexpr size_t WS_END = 726 * MiB;
static_assert(WS_ACT + (size_t)MAXROWS * 1024 * 2 <= WS_YP && WS_YP + (size_t)NTOK * 4 * 1024 * 2 <= WS_END, "d_ws map");
constexpr int CW_BAR = 4096;

constexpr int LDS_BYTES = 147456;
constexpr int LDSCTL_OFF = LDS_BYTES - 512, MISC_OFF = LDSCTL_OFF + 320;
constexpr int SCRATCH_BYTES = LDSCTL_OFF;

#define GAS __attribute__((address_space(1)))
#define LAS __attribute__((address_space(3)))
typedef unsigned short bf16;
typedef unsigned v4u __attribute__((ext_vector_type(4)));
typedef unsigned v2u __attribute__((ext_vector_type(2)));
typedef float f32x4 __attribute__((ext_vector_type(4)));
typedef float f32x16 __attribute__((ext_vector_type(16)));
typedef short bf16x8 __attribute__((ext_vector_type(8)));
typedef GAS unsigned gu32;
#define RLX_AGENT __ATOMIC_RELAXED, __HIP_MEMORY_SCOPE_AGENT
#define LDS_WAIT() asm volatile("s_waitcnt lgkmcnt(0)" ::: "memory")
#define VM_WAIT() asm volatile("s_waitcnt vmcnt(0)" ::: "memory")
typedef float f32x2_cv __attribute__((ext_vector_type(2))); typedef __bf16 bf16x2_cv __attribute__((ext_vector_type(2)));
__device__ __forceinline__ unsigned pk2(float lo, float hi) { const f32x2_cv v = {lo, hi}; return __builtin_bit_cast(unsigned, __builtin_convertvector(v, bf16x2_cv)); }
__device__ __forceinline__ unsigned f2bf(float f) { return pk2(f, 0.f) & 0xffffu; }
__device__ __forceinline__ float bflo(unsigned w) { return __uint_as_float(w << 16); }
__device__ __forceinline__ float bfhi(unsigned w) { return __uint_as_float(w & 0xffff0000u); }
__device__ __forceinline__ float bf1(bf16 h) { return __uint_as_float((unsigned)h << 16); }

#define XB_TMO      128
#define XB_XCNT(j)  (256  + 64 * (j))
#define XB_XSUB(j)  (1280 + 64 * (j))
#define XB_XFLAG    3328
#define XCD_BAR_WORDS 3456
#define XB_SPIN_CAP (1u << 18)
__device__ __forceinline__ unsigned xb_ld(unsigned* p)              { return __hip_atomic_load(p, __ATOMIC_RELAXED, __HIP_MEMORY_SCOPE_AGENT); }
__device__ __forceinline__ unsigned xb_add(unsigned* p, unsigned v) { return __hip_atomic_fetch_add(p, v, __ATOMIC_RELAXED, __HIP_MEMORY_SCOPE_AGENT); }
__device__ __forceinline__ unsigned xb_xcc_id() { return (unsigned)__builtin_amdgcn_s_getreg((3 << 11) | 20) & 0xFu; }
struct XcdBarrier { unsigned* bar; unsigned x; volatile LAS unsigned* st; };
__device__ __forceinline__ XcdBarrier xcd_barrier_post(unsigned* bar, volatile LAS unsigned* st) {
    XcdBarrier b; b.bar = bar; b.x = xb_xcc_id(); b.st = st;
    if (threadIdx.x == 0) (void)xb_add(&bar[XB_XCNT(b.x)], 1u);
    return b;
}
__device__ __forceinline__ void xcd_barrier_complete(unsigned* bar, unsigned x, unsigned& nloc, unsigned& mask) {
    const unsigned G = gridDim.x * gridDim.y * gridDim.z;
    unsigned sum, msk, mine, sp = 0u;
    for (;;) {
        sum = 0u; msk = 0u; mine = 0u;
#pragma unroll
        for (unsigned j = 0; j < 16; ++j) { const unsigned c = xb_ld(&bar[XB_XCNT(j)]); sum += c; msk |= (c > 0u) ? (1u << j) : 0u; mine = (j == x) ? c : mine; }
        if (sum == G) break;
        __builtin_amdgcn_s_sleep(1);
        if ((++sp & 255u) == 0u) { if (xb_ld(&bar[XB_TMO])) break; if (sp > XB_SPIN_CAP) { atomicAdd(&bar[XB_TMO], 1u); break; } }
    }
    nloc = mine > 0u ? mine : 1u; mask = msk | (1u << x);
}
template <class Hook> __device__ __forceinline__ void xcd_barrier(const XcdBarrier& b, const Hook& hook) {
    asm volatile("s_waitcnt vmcnt(0)" ::: "memory");
    __syncthreads();
    if (threadIdx.x >= 64) { hook(); asm volatile("s_waitcnt vmcnt(0)" ::: "memory"); }
    else {
        unsigned* bar = b.bar;
        const unsigned lane = threadIdx.x;
        unsigned want = 0u, mask = 0u;
        if (lane == 0) {
            __builtin_amdgcn_s_waitcnt(0);
            unsigned nloc = b.st[0], m = b.st[1];
            if (nloc == 0u) { xcd_barrier_complete(bar, b.x, nloc, m); b.st[0] = nloc; b.st[1] = m; }
            const unsigned old = xb_add(&bar[XB_XSUB(b.x)], 1u);
            const unsigned gen = old / nloc;
            if (old + 1u == (gen + 1u) * nloc) {
                __builtin_amdgcn_fence(__ATOMIC_RELEASE, "agent");
                asm volatile("s_waitcnt vmcnt(0)" ::: "memory");
                __hip_atomic_store(&bar[XB_XFLAG + b.x], gen + 1u, __ATOMIC_RELAXED, __HIP_MEMORY_SCOPE_AGENT);
            }
            want = gen + 1u; mask = m;
        }
        want = (unsigned)__builtin_amdgcn_readfirstlane((int)want); mask = (unsigned)__builtin_amdgcn_readfirstlane((int)mask);
        const bool mine = lane < 16u && ((mask >> (lane & 15u)) & 1u) != 0u;
        asm volatile("buffer_inv sc1" ::: "memory");
        unsigned sp = 0u;
        for (;;) {
            unsigned v = want; if (mine) v = xb_ld(&bar[XB_XFLAG + lane]);
            if (__builtin_amdgcn_ballot_w64((int)(v - want) < 0) == 0ull) break;
            __builtin_amdgcn_s_sleep(1);
            if ((++sp & 255u) == 0u) { if (xb_ld(&bar[XB_TMO])) break; if (sp > XB_SPIN_CAP) { if (lane == 0) atomicAdd(&bar[XB_TMO], 1u); break; } }
        }
        asm volatile("s_waitcnt vmcnt(0)" ::: "memory");
    }
    __syncthreads();
}
__device__ __forceinline__ void xcd_barrier(const XcdBarrier& b) { xcd_barrier(b, [] {}); }

struct Args { const float* in[26]; float* out; unsigned char* ws; int ph_lo, ph_hi, li, pad; };
struct Frame {
    LAS unsigned char* lds;
    int tid, lane, wave, vcu, G;
    float* out; unsigned char* ws;
    __device__ __forceinline__ const float* in(int k) const { const LAS unsigned* t = (const LAS unsigned*)(lds + LDSCTL_OFF) + 2 * k;
        const unsigned lo = (unsigned)__builtin_amdgcn_readfirstlane((int)t[0]), hi = (unsigned)__builtin_amdgcn_readfirstlane((int)t[1]);
        return (const float*)(const GAS float*)(((unsigned long long)hi << 32) | lo); }
};
template <int CTRL> __device__ __forceinline__ float dpp_mov(float x) { return __builtin_bit_cast(float, __builtin_amdgcn_update_dpp(0, __builtin_bit_cast(int, x), CTRL, 0xF, 0xF, false)); }
__device__ __forceinline__ float lane_xor1(float x) { return dpp_mov<0xB1>(x); }
__device__ __forceinline__ float lane_xor2(float x) { return dpp_mov<0x4E>(x); }
__device__ __forceinline__ float lane_xor4(float x) { return dpp_mov<0x1B>(dpp_mov<0x141>(x)); }
__device__ __forceinline__ float lane_xor8(float x) { return dpp_mov<0x128>(x); }
__device__ __forceinline__ void swap_rows16(float& a, float& b) { asm volatile("s_nop 1\n\tv_permlane16_swap_b32 %0, %1" : "+v"(a), "+v"(b)); }
__device__ __forceinline__ void swap_half32(float& a, float& b) { asm volatile("s_nop 1\n\tv_permlane32_swap_b32 %0, %1" : "+v"(a), "+v"(b)); }
__device__ __forceinline__ float wave_sum(float v) {
    v += lane_xor1(v); v += lane_xor2(v); v += lane_xor4(v); v += lane_xor8(v);
    { float a = v, b = v; swap_rows16(a, b); v = a + b; }
    { float a = v, b = v; swap_half32(a, b); v = a + b; }
    return v;
}
__device__ __forceinline__ float wave_max(float v) {
    v = fmaxf(v, lane_xor1(v)); v = fmaxf(v, lane_xor2(v)); v = fmaxf(v, lane_xor4(v)); v = fmaxf(v, lane_xor8(v));
    { float a = v, b = v; swap_rows16(a, b); v = fmaxf(a, b); }
    { float a = v, b = v; swap_half32(a, b); v = fmaxf(a, b); }
    return v;
}
__device__ __forceinline__ float rsq_f(float x) { return __builtin_amdgcn_rsqf(x); }
__device__ __forceinline__ float wave_max_par(float v) {
    v = fmaxf(v, lane_xor2(v)); v = fmaxf(v, lane_xor4(v)); v = fmaxf(v, lane_xor8(v));
    { float a = v, b = v; swap_rows16(a, b); v = fmaxf(a, b); }
    { float a = v, b = v; swap_half32(a, b); v = fmaxf(a, b); }
    return v;
}
__device__ __forceinline__ float wave_sum_par(float v) {
    v += lane_xor2(v); v += lane_xor4(v); v += lane_xor8(v);
    { float a = v, b = v; swap_rows16(a, b); v = a + b; }
    { float a = v, b = v; swap_half32(a, b); v = a + b; }
    return v;
}
__device__ __forceinline__ float sigmoid_f(float x) { return __builtin_amdgcn_rcpf(1.0f + __builtin_amdgcn_exp2f(-1.4426950408889634f * x)); }
__device__ __forceinline__ float gelu_tanh_f(float x) { const float x2 = x * x; const float e = __builtin_amdgcn_exp2f(x * __builtin_fmaf(x2, 0.10294324f, 2.3022082f)); return x * (1.0f - __builtin_amdgcn_rcpf(e + 1.0f)); }
__device__ __forceinline__ float log_sigmoid_f(float z) { return z >= 0.f ? -log1pf(expf(-z)) : z - log1pf(expf(z)); }
__device__ __forceinline__ float softplus_f(float z) { return z > 0.f ? z + log1pf(expf(-z)) : log1pf(expf(z)); }

struct P0TrItem { const float* W; int ldw; bf16* WT; int k0, n0, kdst0; const float* gain; };
__device__ __forceinline__ void p0_transpose_load(const P0TrItem& t, int lane, float (&tv)[32]) {
#pragma unroll
    for (int i = 0; i < 32; ++i) tv[i] = t.W[(size_t)(t.k0 + 2 * i + (lane >> 5)) * t.ldw + t.n0 + (lane & 31)];
    if (t.gain) {
        float gv[32];
#pragma unroll
        for (int i = 0; i < 32; ++i) gv[i] = t.gain[t.k0 + 2 * i + (lane >> 5)];
#pragma unroll
        for (int i = 0; i < 32; ++i) tv[i] *= gv[i];
    }
}
__device__ __forceinline__ void p0_transpose_finish(const P0TrItem& t, const float (&tv)[32], LAS float* scr, int lane) {
#pragma unroll
    for (int i = 0; i < 32; ++i) scr[(2 * i + (lane >> 5)) * 33 + (lane & 31)] = tv[i];
    LDS_WAIT(); asm volatile("" ::: "memory");
    const int c = lane & 7;
#pragma unroll
    for (int j = 0; j < 4; ++j) { const int n = (lane >> 3) + 8 * j; const LAS float* s = scr + (8 * c) * 33 + n;
        v4u o; o.x = pk2(s[0 * 33], s[1 * 33]); o.y = pk2(s[2 * 33], s[3 * 33]); o.z = pk2(s[4 * 33], s[5 * 33]); o.w = pk2(s[6 * 33], s[7 * 33]);
        *(GAS v4u*)(t.WT + (size_t)(t.n0 + n) * 1024 + t.kdst0 + 8 * c) = o; }
    LDS_WAIT(); asm volatile("" ::: "memory");
}
constexpr int CV_UP_ITEMS = NE * 16 * 32, CV_DN_ITEMS = NE * 16 * 16;
constexpr int CV_UP_TAIL = 4096, CV_DN_TAIL = 2048;
__device__ __forceinline__ void cvt_block_load(const float* W, int ldw, int lane, float (&v)[64]) {
#pragma unroll
    for (int i = 0; i < 64; ++i) v[i] = __builtin_nontemporal_load((const GAS float*)W + (size_t)i * ldw + lane);
}
__device__ __forceinline__ void cvt_block_finish(const float (&v)[64], unsigned char* WT, LAS unsigned char* scr, int lane) {
#pragma unroll
    for (int q = 0; q < 4; ++q) { int w[4];
#pragma unroll
        for (int j = 0; j < 4; ++j) { int t = 0; t = __builtin_amdgcn_cvt_pk_fp8_f32(v[16 * q + 4 * j] * 64.0f, v[16 * q + 4 * j + 1] * 64.0f, t, false); t = __builtin_amdgcn_cvt_pk_fp8_f32(v[16 * q + 4 * j + 2] * 64.0f, v[16 * q + 4 * j + 3] * 64.0f, t, true); w[j] = t; }
        *(LAS v4u*)(scr + lane * 80 + 16 * q) = (v4u){(unsigned)w[0], (unsigned)w[1], (unsigned)w[2], (unsigned)w[3]}; }
    LDS_WAIT(); asm volatile("" ::: "memory");
#pragma unroll
    for (int j = 0; j < 4; ++j) { const int row = 16 * j + (lane >> 2), c = lane & 3;
        *(GAS v4u*)(WT + (size_t)row * 1024 + 16 * c) = *(const LAS v4u*)(scr + row * 80 + 16 * c); }
    LDS_WAIT(); asm volatile("" ::: "memory");
}
__device__ __forceinline__ void cvt_block_f8(const float* W, int ldw, unsigned char* WT, LAS unsigned char* scr, int lane) { float v[64]; cvt_block_load(W, ldw, lane, v); cvt_block_finish(v, WT, scr, lane); }
__device__ __forceinline__ void cvt_up_ptrs(Frame& F, int u, const float*& W, int& ldw, unsigned char*& WT) { const int e = u >> 9, q = u & 511, kb = q >> 5, nb = q & 31;
    W = F.in(22) + (size_t)e * DM * 2 * DEXP + (size_t)(64 * kb) * (2 * DEXP) + 64 * nb; ldw = 2 * DEXP; WT = (unsigned char*)(F.ws + WS_WUP) + ((size_t)e * 2 * DEXP + 64 * nb) * 1024 + 64 * kb; }
__device__ __forceinline__ void cvt_dn_ptrs(Frame& F, int d, const float*& W, int& ldw, unsigned char*& WT) { const int e = d >> 8, q = d & 255, kb = q >> 4, nb = q & 15;
    W = F.in(24) + (size_t)e * DEXP * DM + (size_t)(64 * kb) * DM + 64 * nb; ldw = DM; WT = (unsigned char*)(F.ws + WS_WDN) + ((size_t)e * DM + 64 * nb) * 1024 + 64 * kb; }
__device__ __forceinline__ void cvt_up_item(Frame& F, int u) { const float* W; int ldw; unsigned char* WT; cvt_up_ptrs(F, u, W, ldw, WT); cvt_block_f8(W, ldw, WT, F.lds + F.wave * 16384, F.lane); }
__device__ __forceinline__ void cvt_dn_item(Frame& F, int d) { const float* W; int ldw; unsigned char* WT; cvt_dn_ptrs(F, d, W, ldw, WT); cvt_block_f8(W, ldw, WT, F.lds + F.wave * 16384, F.lane); }
template <bool UP> __device__ __forceinline__ void cvt_range(Frame& F, int lo, int hi, int wr_, int nw) {
    for (int it = lo + wr_; it < hi; it += nw) { if (UP) cvt_up_item(F, it); else cvt_dn_item(F, it); }
}
__device__ __forceinline__ void p0_transpose_item_f8(const float* W, int ldw, unsigned char* WT, int k0, int n0, float scale, LAS float* scr, int lane) {
#pragma unroll 8
    for (int i = 0; i < 32; ++i) { const int kk = 2 * i + (lane >> 5); scr[kk * 33 + (lane & 31)] = W[(size_t)(k0 + kk) * ldw + n0 + (lane & 31)] * scale; }
    LDS_WAIT(); asm volatile("" ::: "memory");
    const int c = lane & 7;
#pragma unroll
    for (int j = 0; j < 4; ++j) { const int n = (lane >> 3) + 8 * j; const LAS float* s = scr + (8 * c) * 33 + n;
        int w0 = 0, w1 = 0; w0 = __builtin_amdgcn_cvt_pk_fp8_f32(s[0 * 33], s[1 * 33], w0, false); w0 = __builtin_amdgcn_cvt_pk_fp8_f32(s[2 * 33], s[3 * 33], w0, true);
        w1 = __builtin_amdgcn_cvt_pk_fp8_f32(s[4 * 33], s[5 * 33], w1, false); w1 = __builtin_amdgcn_cvt_pk_fp8_f32(s[6 * 33], s[7 * 33], w1, true);
        typedef int i32x2_ __attribute__((ext_vector_type(2))); *(GAS i32x2_*)(WT + (size_t)(n0 + n) * 1024 + k0 + 8 * c) = (i32x2_){w0, w1}; }
    LDS_WAIT(); asm volatile("" ::: "memory");
}
constexpr int CV_P3_ITEMS = (CV_UP_ITEMS - CV_UP_TAIL) + (CV_DN_ITEMS - CV_DN_TAIL);
constexpr int CV_P3_PER_WAVE = CV_P3_ITEMS / (2 * 128 * NWAVES);
static_assert(CV_P3_ITEMS == 2 * CV_P3_PER_WAVE * 128 * NWAVES, "P3 conversion shares");
__device__ __forceinline__ void cvt_p3_share(Frame& F, int half) {
    constexpr int NU = CV_UP_ITEMS - CV_UP_TAIL;
    const int r = ((F.vcu >> 3) * 4 + (F.vcu & 3)) * NWAVES + F.wave;
    for (int i = 0; i < CV_P3_PER_WAVE; ++i) { const int v = half * (CV_P3_ITEMS / 2) + i * (128 * NWAVES) + r;
        const float* W; int ldw; unsigned char* WT;
        if (v < NU) cvt_up_ptrs(F, CV_UP_TAIL + v, W, ldw, WT); else cvt_dn_ptrs(F, CV_DN_TAIL + (v - NU), W, ldw, WT);
        cvt_block_f8(W, ldw, WT, F.lds + F.wave * 16384, F.lane); }
}
template <int PARTS = 7> __device__ __forceinline__ void p0_phase(Frame& F) {
    const float* c_in = F.in(1); const float* w_ada = F.in(2); const float* b_ada = F.in(3);
    float* MOD = (float*)(F.ws + WS_MOD);
    constexpr int NU = CV_UP_ITEMS - CV_UP_TAIL, NV = NU + (CV_DN_ITEMS - CV_DN_TAIL), QN = 8, NON = 512 * QN;
    static_assert(NV >= NON + 1536, "phase-0 conversion shares");
    auto item_ptrs = [&](int v, const float*& W, int& ldw, unsigned char*& WT) { if (v < NU) cvt_up_ptrs(F, CV_UP_TAIL + v, W, ldw, WT); else cvt_dn_ptrs(F, CV_DN_TAIL + (v - NU), W, ldw, WT); };
    constexpr bool PRE = false;
    float pv[64]; unsigned char* pWT = nullptr; const bool pre = PRE && F.G == 256 && F.vcu < 192;
    if (PRE) { if (pre) { const float* W; int ldw; item_ptrs(NON + F.vcu * NWAVES + F.wave, W, ldw, pWT); cvt_block_load(W, ldw, F.lane, pv); } }
    const bool g256 = F.G == 256, is_ada = g256 ? (F.vcu & 3) != 3 : F.vcu < 192;
    if ((PARTS & 1) && is_ada) {
        LAS float* sc = (LAS float*)F.lds;
        LAS float* red = (LAS float*)(F.lds + 32768);
        for (int i = F.tid; i < BATCH * DM; i += NWAVES * 64) { const int b = i >> 10, k = i & 1023; const float v = c_in[i]; sc[k * 8 + b] = v * sigmoid_f(v); }
        __syncthreads();
        for (int ci = g256 ? (F.vcu >> 2) * 3 + (F.vcu & 3) : F.vcu; ci < 192; ci += F.G) {
            const int col = F.lane & 31, ks = F.lane >> 5;
            float acc[8];
#pragma unroll
            for (int b = 0; b < 8; ++b) acc[b] = 0.f;
            const float* wp = w_ada + (size_t)(128 * F.wave + ks) * (NMOD * DM) + ci * 32 + col;
#pragma unroll 1
            for (int i0 = 0; i0 < 64; i0 += 32) {
                float wv[32];
#pragma unroll
                for (int i = 0; i < 32; ++i) wv[i] = wp[(size_t)(2 * (i0 + i)) * (NMOD * DM)];
#pragma unroll
                for (int i = 0; i < 32; ++i) { const LAS f32x4* sp = (const LAS f32x4*)(sc + (128 * F.wave + 2 * (i0 + i) + ks) * 8); const f32x4 s0 = sp[0], s1 = sp[1];
                    acc[0] += s0[0] * wv[i]; acc[1] += s0[1] * wv[i]; acc[2] += s0[2] * wv[i]; acc[3] += s0[3] * wv[i]; acc[4] += s1[0] * wv[i]; acc[5] += s1[1] * wv[i]; acc[6] += s1[2] * wv[i]; acc[7] += s1[3] * wv[i]; }
            }
#pragma unroll
            for (int b = 0; b < 8; ++b) { acc[b] += __shfl_xor(acc[b], 32); if (ks == 0) red[(F.wave * 8 + b) * 32 + col] = acc[b]; }
            __syncthreads();
            if (F.tid < 256) { const int b = F.tid >> 5, cl = F.tid & 31; float s = 0.f;
#pragma unroll
              for (int w = 0; w < 8; ++w) s += red[(w * 8 + b) * 32 + cl];
              MOD[b * NMOD * DM + ci * 32 + cl] = s + b_ada[ci * 32 + cl]; }
            __syncthreads();
        }
    }
    __syncthreads();
    if (PRE) { if (pre) cvt_block_finish(pv, pWT, F.lds + F.wave * 16384, F.lane); }
    const float* w_in = F.in(6); const float* w_out = F.in(17); const float* gn_attn = F.in(16);
    bf16* WIN = (bf16*)(F.ws + WS_WIN); bf16* WOUT = (bf16*)(F.ws + WS_WOUT);
    LAS float* scr = (LAS float*)(F.lds + F.wave * 16384);
    if (g256 && is_ada) return;
    const int svcu = g256 ? F.vcu >> 2 : F.vcu, sG = g256 ? 64 : F.G;
    const int gw = svcu * NWAVES + F.wave, NGW = sG * NWAVES;
    constexpr int I_IN = 16 * (NPJ / 32), I_OUT = 16 * (DM / 32);
    constexpr int NITEMS = I_IN + I_OUT;
    const int t0 = svcu * (NWAVES * 64) + F.tid;
    float sm_f = 0.f, sm_r = 0.f, sm_l0 = 0.f, sm_l1 = 0.f;
    if (g256) { const float* w_in2 = F.in(6); const float* w_router = F.in(20); const float* wa = F.in(9); const float* wx = F.in(11);
        if (t0 < 8 * DM) sm_f = w_in2[(size_t)(t0 & 1023) * NPROJ + NPJ + (t0 >> 10)];
        sm_r = w_router[(t0 & 1023) * NE + (t0 >> 10)];
        { const int g = (t0 >> 12) & 7, j = (t0 >> 6) & 63, i = t0 & 63; sm_l0 = wa[(g * 64 + i) * 64 + j]; sm_l1 = wx[(g * 64 + i) * 64 + j]; } }
    auto tr_item = [&](int r, P0TrItem& t) {
        if (r < I_IN) { const int kb = r / (NPJ / 32), nb = r % (NPJ / 32); t = P0TrItem{w_in, NPROJ, WIN, 64 * kb, 32 * nb, 64 * kb, nullptr}; return; } r -= I_IN;
        const int kb = r / (DM / 32), nb = r % (DM / 32), k0 = 64 * kb;
        t = P0TrItem{w_out, DM, WOUT, k0, 32 * nb, (k0 + 512) & 1023, k0 >= 512 ? gn_attn - 512 : nullptr}; };
    if (PARTS & 2) for (int it = gw; it < NITEMS; it += 2 * NGW) {
        P0TrItem ta, tb; float va[32], vb[32]; const bool hb = it + NGW < NITEMS;
        tr_item(it, ta); p0_transpose_load(ta, F.lane, va);
        if (hb) { tr_item(it + NGW, tb); p0_transpose_load(tb, F.lane, vb); }
        p0_transpose_finish(ta, va, scr, F.lane);
        if (hb) p0_transpose_finish(tb, vb, scr, F.lane);
    }
    if ((PARTS & 4) && F.G != 256) {
        if (F.G == 256) {
            auto run = [&](int v) { const float* W; int ldw; unsigned char* WT; item_ptrs(v, W, ldw, WT); cvt_block_f8(W, ldw, WT, F.lds + F.wave * 16384, F.lane); };
            if (F.vcu >= 192) { const int r = (F.vcu - 192) * NWAVES + F.wave; for (int v = r; v < NON; v += 512) run(v); }
            else { const int r = F.vcu * NWAVES + F.wave; for (int v = NON + r + (PRE ? 1536 : 0); v < NV; v += 1536) run(v); }
        } else { cvt_range<true>(F, 0, CV_UP_ITEMS, gw, NGW); cvt_range<false>(F, 0, CV_DN_ITEMS, gw, NGW); }
    }
    if (g256) { float* WFT = (float*)(F.ws + WS_WFT); float* WRT = (float*)(F.ws + WS_WRT); bf16* LWT = (bf16*)(F.ws + WS_LWT);
        if (t0 < 8 * DM) WFT[t0] = sm_f;
        WRT[t0] = sm_r; LWT[t0] = (bf16)f2bf(sm_l0); LWT[t0 + 32768] = (bf16)f2bf(sm_l1);
        return; }
    if (PARTS & 2) { const float* w_in2 = F.in(6); float* WFT = (float*)(F.ws + WS_WFT);
      for (int idx = F.vcu * (NWAVES * 64) + F.tid; idx < 8 * DM; idx += F.G * NWAVES * 64) { const int h = idx >> 10, k = idx & 1023; WFT[idx] = w_in2[(size_t)k * NPROJ + NPJ + h]; } }
    { const float* w_router = F.in(20); float* WRT = (float*)(F.ws + WS_WRT);
      for (int idx = F.vcu * (NWAVES * 64) + F.tid; idx < NE * DM; idx += F.G * NWAVES * 64) { const int e = idx >> 10, k = idx & 1023; WRT[idx] = w_router[k * NE + e]; } }
    { const float* wa = F.in(9); const float* wx = F.in(11); bf16* LWT = (bf16*)(F.ws + WS_LWT);
      for (int idx = F.vcu * (NWAVES * 64) + F.tid; idx < 2 * 8 * 64 * 64; idx += F.G * NWAVES * 64) { const int gate = idx >> 15, g = (idx >> 12) & 7, j = (idx >> 6) & 63, i = idx & 63;
          LWT[idx] = (bf16)f2bf((gate ? wx : wa)[(g * 64 + i) * 64 + j]); } }
}

__device__ __forceinline__ void p1_prologue(Frame& F, int t0) {
    LAS float* wf = (LAS float*)F.lds; const float* w_in = F.in(6);
    for (int k = (int)threadIdx.x - t0; k < DM; k += NWAVES * 64 - t0) { const f32x4 a = *(const f32x4*)(w_in + (size_t)k * NPROJ + NPJ), c = *(const f32x4*)(w_in + (size_t)k * NPROJ + NPJ + 4);
        wf[0 * DM + k] = a[0]; wf[1 * DM + k] = a[1]; wf[2 * DM + k] = a[2]; wf[3 * DM + k] = a[3]; wf[4 * DM + k] = c[0]; wf[5 * DM + k] = c[1]; wf[6 * DM + k] = c[2]; wf[7 * DM + k] = c[3]; }
}
constexpr int P1_HPITCH = 2064, P1_HHI = 0, P1_HLO = 16 * P1_HPITCH, P1_PB = 66560;
template <int R0, int R1> __device__ __forceinline__ void p1_load_x(Frame& F, f32x4 (&xr)[8][4]) {
    const float* x = F.in(0); const int row0 = (F.vcu * NWAVES + F.wave) * 8;
#pragma unroll
    for (int r = R0; r < R1; ++r)
#pragma unroll
        for (int j = 0; j < 4; ++j) xr[r][j] = *(const f32x4*)(x + (size_t)(row0 + r) * DM + 4 * F.lane + 256 * j);
}
template <bool PRO = true> __device__ __forceinline__ void p1_phase(Frame& F, const f32x4 (&xr)[8][4]) {
    const float* x = F.in(0); const float* gpre = F.in(4); const float* fb = F.in(14);
    const float* MOD = (const float*)(F.ws + WS_MOD); bf16* H1 = (bf16*)(F.ws + WS_H1); float* LOGF2 = (float*)(F.ws + WS_LOGF2);
    LAS float* pbl = (LAS float*)(F.lds + P1_PB);
    const int gw = F.vcu * NWAVES + F.wave;
    if (F.G * NWAVES * 8 != NTOK) return;
    const int row0 = gw * 8, b = row0 / SEQ, l15 = F.lane & 15, l4 = F.lane >> 4;
    f32x4 gm[4], sh[4];
#pragma unroll
    for (int j = 0; j < 4; ++j) { const int k = 4 * F.lane + 256 * j; const f32x4 g = *(const f32x4*)(gpre + k), s = *(const f32x4*)(MOD + b * NMOD * DM + DM + k); gm[j] = g * (s + 1.0f); sh[j] = *(const f32x4*)(MOD + b * NMOD * DM + k); }
    bf16x8 wh[4], wl[4];
    { const float* WFT = (const float*)(F.ws + WS_WFT);
#pragma unroll
      for (int s = 0; s < 4; ++s) { f32x4 a = (f32x4){0.f, 0.f, 0.f, 0.f}, c = a;
          if (l15 < 8) { const float* wp = WFT + (size_t)l15 * DM + 128 * F.wave + 32 * s + 8 * l4; a = *(const f32x4*)wp; c = *(const f32x4*)(wp + 4); }
          v4u h_, l_; h_.x = pk2(a[0], a[1]); h_.y = pk2(a[2], a[3]); h_.z = pk2(c[0], c[1]); h_.w = pk2(c[2], c[3]);
          l_.x = pk2(a[0] - bflo(h_.x), a[1] - bfhi(h_.x)); l_.y = pk2(a[2] - bflo(h_.y), a[3] - bfhi(h_.y)); l_.z = pk2(c[0] - bflo(h_.z), c[1] - bfhi(h_.z)); l_.w = pk2(c[2] - bflo(h_.w), c[3] - bfhi(h_.w));
          wh[s] = __builtin_bit_cast(bf16x8, h_); wl[s] = __builtin_bit_cast(bf16x8, l_); } }
#pragma unroll
    for (int rp = 0; rp < 4; ++rp) {
        f32x4 v[2][4];
#pragma unroll
        for (int u = 0; u < 2; ++u)
#pragma unroll
            for (int j = 0; j < 4; ++j) v[u][j] = xr[2 * rp + u][j];
#pragma unroll
        for (int u = 0; u < 2; ++u) { const int row = row0 + 2 * rp + u; float ss = 0.f;
#pragma unroll
            for (int j = 0; j < 4; ++j) ss += (v[u][j][0] * v[u][j][0] + v[u][j][1] * v[u][j][1]) + (v[u][j][2] * v[u][j][2] + v[u][j][3] * v[u][j][3]);
            const float rinv = rsq_f(wave_sum(ss) * (1.0f / DM) + RMS_EPS);
            LAS unsigned char* hrow = F.lds + (2 * F.wave + u) * P1_HPITCH + 8 * F.lane;
#pragma unroll
            for (int j = 0; j < 4; ++j) { const f32x4 hv = v[u][j] * rinv * gm[j] + sh[j];
                v2u hh; hh.x = pk2(hv[0], hv[1]); hh.y = pk2(hv[2], hv[3]); *(GAS v2u*)(H1 + (size_t)row * DM + 4 * F.lane + 256 * j) = hh;
                v2u hl; hl.x = pk2(hv[0] - bflo(hh.x), hv[1] - bfhi(hh.x)); hl.y = pk2(hv[2] - bflo(hh.y), hv[3] - bfhi(hh.y));
                *(LAS v2u*)(hrow + P1_HHI + 512 * j) = hh; *(LAS v2u*)(hrow + P1_HLO + 512 * j) = hl; } }
        __syncthreads();
        { f32x4 acc = (f32x4){0.f, 0.f, 0.f, 0.f};
          const LAS unsigned char* ab = F.lds + l15 * P1_HPITCH + (128 * F.wave + 8 * l4) * 2;
#pragma unroll
          for (int s = 0; s < 4; ++s) { const bf16x8 ah = *(const LAS bf16x8*)(ab + P1_HHI + 64 * s), al = *(const LAS bf16x8*)(ab + P1_HLO + 64 * s);
              acc = __builtin_amdgcn_mfma_f32_16x16x32_bf16(ah, wh[s], acc, 0, 0, 0); acc = __builtin_amdgcn_mfma_f32_16x16x32_bf16(ah, wl[s], acc, 0, 0, 0); acc = __builtin_amdgcn_mfma_f32_16x16x32_bf16(al, wh[s], acc, 0, 0, 0); }
#pragma unroll
          for (int r = 0; r < 4; ++r) pbl[(F.wave * 16 + 4 * l4 + r) * 16 + l15] = acc[r]; }
        __syncthreads();
        if (F.lane < 16) { const int u = F.lane >> 3, hd = F.lane & 7; float f = fb[hd];
#pragma unroll
            for (int ww = 0; ww < 8; ++ww) f += pbl[(ww * 16 + 2 * F.wave + u) * 16 + hd];
            const float z = f, e_ = __builtin_amdgcn_exp2f(-1.4426950408889634f * fabsf(z));
            LOGF2[(size_t)(row0 + 2 * rp + u) * 8 + hd] = fminf(z, 0.f) * 1.4426950408889634f - __builtin_amdgcn_logf(1.0f + e_); }
    }
}

constexpr int LRU_XP = 1040;
constexpr int LRU_XT = 0, LRU_XC = 69696, LRU_CAR = 136256;
constexpr int CW_LRU = 12288;
static_assert((size_t)(CW_BAR + 2 * XCD_BAR_WORDS) <= (size_t)CW_LRU && (size_t)(CW_LRU + 64 * 512) * 4 <= CTL_ZERO_BYTES, "control words");
static_assert(LRU_CAR + 2048 <= SCRATCH_BYTES && 67 * LRU_XP <= LRU_XC && LRU_XC + 64 * LRU_XP <= LRU_CAR, "LRU LDS map");
__device__ __forceinline__ float one_minus_exp(float x, bool wide) {
    float p = -x * (1.0f + x * (0.5f + x * (0.16666667f + x * (0.041666668f + x * (0.0083333338f + x * 0.0013888889f)))));
    if (__builtin_expect(wide, 0)) { const float d = 1.0f - __builtin_amdgcn_exp2f(1.4426950408889634f * x); p = x > -0.25f ? p : d; }
    return p;
}
__device__ __forceinline__ void lru_item(Frame& F, int b, int c) {
    LAS unsigned char* XT = F.lds + LRU_XT; LAS unsigned char* XC = F.lds + LRU_XC; LAS float* CAR = (LAS float*)(F.lds + LRU_CAR);
    const bf16* XL = (const bf16*)(F.ws + WS_PJ); const bf16* YL = XL + PJ_STRIDE; const bf16* LWT = (const bf16*)(F.ws + WS_LWT);
    float* LSUM = (float*)(F.ws + WS_LSUM); bf16* MRG = (bf16*)(F.ws + WS_MRG); unsigned* flags = (unsigned*)(F.ws + WS_CTL) + CW_LRU;
    const float* conv_w = F.in(7); const float* conv_b = F.in(8); const float* ba = F.in(10); const float* bx = F.in(12); const float* lam = F.in(13); const float* gn_lru = F.in(15);
    const int t0 = c * 64; const size_t rowb = (size_t)b * SEQ;
    const int g = F.wave, l31 = F.lane & 31, hi = F.lane >> 5;
    const float cw0 = conv_w[F.tid], cw1 = conv_w[512 + F.tid], cw2 = conv_w[1024 + F.tid], cw3 = conv_w[1536 + F.tid], ccb = conv_b[F.tid];
    bf16x8 gwa[4], gwx[4];
#define LRU_LDW(HP) do { _Pragma("unroll") for (int s = 0; s < 4; ++s) { \
        gwa[s] = *(const GAS bf16x8*)(LWT + ((size_t)((0 * 8 + g) * 64 + 32 * (HP) + l31)) * 64 + 16 * s + 8 * hi); \
        gwx[s] = *(const GAS bf16x8*)(LWT + ((size_t)((1 * 8 + g) * 64 + 32 * (HP) + l31)) * 64 + 16 * s + 8 * hi); } } while (0)
    { v4u xv[9];
#pragma unroll
      for (int q = 0; q < 9; ++q) { const int p = F.tid + q * (NWAVES * 64), i = p >> 6, c8 = p & 63, t = t0 - 3 + i; xv[q] = (v4u){0u, 0u, 0u, 0u};
          if (p < 67 * 64 && t >= 0) xv[q] = *(const GAS v4u*)(XL + (rowb + t) * 512 + c8 * 8); }
#pragma unroll
      for (int q = 0; q < 9; ++q) { const int p = F.tid + q * (NWAVES * 64), i = p >> 6, c8 = p & 63; if (p < 67 * 64) *(LAS v4u*)(XT + i * LRU_XP + c8 * 16) = xv[q]; } }
    v4u yv8[8];
#pragma unroll
    for (int q = 0; q < 8; ++q) { const int p = F.tid + q * (NWAVES * 64), i = p >> 6, c8 = p & 63; yv8[q] = *(const GAS v4u*)(YL + (rowb + t0 + i) * 512 + c8 * 8); }
    __syncthreads();
    { const int ch = F.tid; const float w0 = cw0, w1 = cw1, w2 = cw2, w3 = cw3, cb = ccb;
      float xa = bf1(*(const LAS bf16*)(XT + 0 * LRU_XP + ch * 2)), xb = bf1(*(const LAS bf16*)(XT + 1 * LRU_XP + ch * 2)), xc = bf1(*(const LAS bf16*)(XT + 2 * LRU_XP + ch * 2));
#pragma unroll 8
      for (int t = 0; t < 64; ++t) { const float xd = bf1(*(const LAS bf16*)(XT + (t + 3) * LRU_XP + ch * 2)); const float v = ((w0 * xa + w1 * xb) + (w2 * xc + w3 * xd)) + cb;
          *(LAS bf16*)(XC + t * LRU_XP + ch * 2) = (bf16)f2bf(v); xa = xb; xb = xc; xc = xd; } }
    __syncthreads();
#pragma unroll
    for (int q = 0; q < 8; ++q) { const int p = F.tid + q * (NWAVES * 64), i = p >> 6, c8 = p & 63; *(LAS v4u*)(XT + i * LRU_XP + c8 * 16) = yv8[q]; }
    __syncthreads();
    unsigned stt[2][2][16];
#pragma unroll
    for (int hp = 0; hp < 2; ++hp) {
        const int chl = g * 64 + 32 * hp + l31;
        f32x16 cumA[2], hloc[2];
#pragma unroll
        for (int tg = 0; tg < 2; ++tg) { cumA[tg] = f32x16{}; hloc[tg] = f32x16{}; }
        LRU_LDW(hp);
        const float psp = 8.0f * softplus_f(-lam[chl]);
        const float cba = -1.4426950408889634f * ba[chl], cbx = -1.4426950408889634f * bx[chl], ca = -1.4426950408889634f * psp, c2 = -2.0f * psp;
        const bool wide = __any(2.0f * psp >= 0.25f);
#pragma unroll
        for (int s = 0; s < 4; ++s) {
#pragma unroll
            for (int tg = 0; tg < 2; ++tg) { const bf16x8 bfr = *(const LAS bf16x8*)(XC + (32 * tg + l31) * LRU_XP + (g * 64 + 16 * s + 8 * hi) * 2);
                cumA[tg] = __builtin_amdgcn_mfma_f32_32x32x16_bf16(bfr, gwa[s], cumA[tg], 0, 0, 0); hloc[tg] = __builtin_amdgcn_mfma_f32_32x32x16_bf16(bfr, gwx[s], hloc[tg], 0, 0, 0); }
        }
        float cA = 1.0f, cB = 0.0f;
#pragma unroll
        for (int tg = 0; tg < 2; ++tg) {
            f32x16& A = cumA[tg]; f32x16& X = hloc[tg];
#pragma unroll
            for (int r = 0; r < 16; ++r) { const int tok = 32 * tg + (r & 3) + 8 * (r >> 2) + 4 * hi; const float xv = bf1(*(const LAS bf16*)(XC + tok * LRU_XP + chl * 2));
                const float rg = __builtin_amdgcn_rcpf(1.0f + __builtin_amdgcn_exp2f(__builtin_fmaf(A[r], -1.4426950408889634f, cba)));
                const float ig = __builtin_amdgcn_rcpf(1.0f + __builtin_amdgcn_exp2f(__builtin_fmaf(X[r], -1.4426950408889634f, cbx)));
                A[r] = __builtin_amdgcn_exp2f(rg * ca); X[r] = __builtin_amdgcn_sqrtf(one_minus_exp(rg * c2, wide)) * (ig * xv); }
#pragma unroll
            for (int q = 0; q < 4; ++q)
#pragma unroll
                for (int i = 1; i < 4; ++i) { X[4 * q + i] = A[4 * q + i] * X[4 * q + i - 1] + X[4 * q + i]; A[4 * q + i] = A[4 * q + i] * A[4 * q + i - 1]; }
#pragma unroll
            for (int q2 = 0; q2 < 8; ++q2) { const int q = q2 >> 1; const bool own = (hi == (q2 & 1));
#pragma unroll
                for (int i = 0; i < 4; ++i) { const float nb = A[4 * q + i] * cB + X[4 * q + i], na = A[4 * q + i] * cA; X[4 * q + i] = own ? nb : X[4 * q + i]; A[4 * q + i] = own ? na : A[4 * q + i]; }
                float ra, rb; { float a0 = A[4 * q + 3], a1 = a0; swap_half32(a0, a1); ra = hi ? a0 : a1; float b0 = X[4 * q + 3], b1 = b0; swap_half32(b0, b1); rb = hi ? b0 : b1; }
                cA = own ? A[4 * q + 3] : ra; cB = own ? X[4 * q + 3] : rb; }
#pragma unroll
            for (int r = 0; r < 16; ++r) stt[hp][tg][r] = pk2(X[r], A[r]);
        }
        if (hi == 0) { float* d0 = LSUM + (((size_t)b * 32 + c) * 2 + 0) * 512 + chl; __hip_atomic_store(d0, cA, __ATOMIC_RELAXED, __HIP_MEMORY_SCOPE_AGENT); __hip_atomic_store(d0 + 512, cB, __ATOMIC_RELAXED, __HIP_MEMORY_SCOPE_AGENT); }
        __builtin_amdgcn_sched_barrier(0);
    }
    asm volatile("s_waitcnt vmcnt(0)" ::: "memory");
    __syncthreads();
    if (F.wave == 0) {
        if (F.lane == 0) __hip_atomic_store(flags + 64 * ((32 * b + c) * 2), 1u, __ATOMIC_RELAXED, __HIP_MEMORY_SCOPE_AGENT);
        unsigned sp = 0;
        for (;;) { const unsigned v = (F.lane < c) ? __hip_atomic_load(flags + 64 * ((32 * b + F.lane) * 2), __ATOMIC_RELAXED, __HIP_MEMORY_SCOPE_AGENT) : 1u;
            if (__all(v != 0u)) break; __builtin_amdgcn_s_sleep(1); if (++sp > (1u << 20)) break; }
    }
    __syncthreads();
    { const int ch = F.tid; float cr = 0.f; float* LSb = LSUM + (size_t)b * 32 * 2 * 512;
      for (int c0 = 0; c0 < c; c0 += 16) { float A8[16], B8[16];
#pragma unroll
          for (int u = 0; u < 16; ++u) { const bool ok = (c0 + u) < c; A8[u] = 1.0f; B8[u] = 0.0f; if (ok) { float* q_ = LSb + (size_t)(c0 + u) * 1024; A8[u] = __hip_atomic_load(q_ + ch, __ATOMIC_RELAXED, __HIP_MEMORY_SCOPE_AGENT); B8[u] = __hip_atomic_load(q_ + 512 + ch, __ATOMIC_RELAXED, __HIP_MEMORY_SCOPE_AGENT); } }
#pragma unroll
          for (int u = 0; u < 16; ++u) cr = A8[u] * cr + B8[u]; }
      CAR[ch] = cr; }
    __syncthreads();
#pragma unroll
    for (int hp = 0; hp < 2; ++hp) { const int chl = g * 64 + 32 * hp + l31; const float cin = CAR[chl];
#pragma unroll
        for (int tg = 0; tg < 2; ++tg)
#pragma unroll
            for (int r = 0; r < 16; ++r) { const int tok = 32 * tg + (r & 3) + 8 * (r >> 2) + 4 * hi; LAS bf16* yp = (LAS bf16*)(XT + tok * LRU_XP + chl * 2);
                const unsigned sw = stt[hp][tg][r]; const float h = bflo(sw) + bfhi(sw) * cin; *yp = (bf16)f2bf(h * gelu_tanh_f(bf1(*yp))); } }
    __syncthreads();
#pragma unroll 2
    for (int q = 0; q < 8; ++q) { const int i = F.wave + 8 * q, c8 = F.lane;
        const v4u w = *(const LAS v4u*)(XT + i * LRU_XP + c8 * 16);
        const float v0 = bflo(w.x), v1 = bfhi(w.x), v2 = bflo(w.y), v3 = bfhi(w.y), v4 = bflo(w.z), v5 = bfhi(w.z), v6 = bflo(w.w), v7 = bfhi(w.w);
        const float ss = wave_sum(((v0 * v0 + v1 * v1) + (v2 * v2 + v3 * v3)) + ((v4 * v4 + v5 * v5) + (v6 * v6 + v7 * v7)));
        const float rinv = rsq_f(ss * (1.0f / DLRU) + RMS_EPS);
        const f32x4 g0 = *(const f32x4*)(gn_lru + c8 * 8), g1 = *(const f32x4*)(gn_lru + c8 * 8 + 4);
        v4u o; o.x = pk2(v0 * rinv * g0[0], v1 * rinv * g0[1]); o.y = pk2(v2 * rinv * g0[2], v3 * rinv * g0[3]); o.z = pk2(v4 * rinv * g1[0], v5 * rinv * g1[1]); o.w = pk2(v6 * rinv * g1[2], v7 * rinv * g1[3]);
        *(GAS v4u*)(MRG + (rowb + t0 + i) * 1024 + 512 + c8 * 8) = o; }
    __syncthreads();
}
#undef LRU_LDW
__device__ __forceinline__ void lru_phase(Frame& F) { if (F.G == BATCH * 32) lru_item(F, F.vcu >> 5, F.vcu & 31); }

constexpr int P67_CARRY = 131072 + 2048;
constexpr int P6_HPITCH = 2064;
constexpr int P6_HHI = 0, P6_HLO = 16 * P6_HPITCH, P6_PB = 66560;
constexpr int P6_SHF = P6_PB + 8 * 16 * 32 * 4;
static_assert(P6_HLO + 16 * P6_HPITCH <= P6_PB && P6_SHF + 4096 <= 131072, "P6 LDS map");
template <int VAR = 0> __device__ __forceinline__ void p6_phase(Frame& F) {
    const float* x = F.in(0); const float* gpost = F.in(5); const float* gffn = F.in(18); const float* b_router = F.in(21);
    const float* MOD = (const float*)(F.ws + WS_MOD); const bf16* Y = (const bf16*)(F.ws + WS_Y); unsigned char* H2 = (unsigned char*)(F.ws + WS_H2);
    int* TOPI = (int*)(F.ws + WS_TOPI); float* TOPW = (float*)(F.ws + WS_TOPW); int* WGCNT = (int*)(F.ws + WS_WGCNT); bf16* XMID = (bf16*)(F.ws + WS_XMID);
    LAS int* hist = (LAS int*)(F.lds + 131072);
    LAS int* pce = (LAS int*)(F.lds + P67_CARRY); LAS float* pcw = (LAS float*)(pce + 256); LAS int* pcr = pce + 512;
    LAS float* pbl = (LAS float*)(F.lds + P6_PB);
    if (F.tid < NE) hist[F.tid] = 0;
    if (F.G * 64 == NTOK) {
    const int bx = blockIdx.x, row0 = bx * 64 + F.wave * 8, b = row0 / SEQ;
    const int l15 = F.lane & 15, l4 = F.lane >> 4;
    const int e = (F.lane >> 1) & 31, par = F.lane & 1; const float br = b_router[e];
    v2u ywb[2][2][4]; f32x4 xb[2][2][4];
#pragma unroll
    for (int q = 0; q < 2; ++q)
#pragma unroll
        for (int u = 0; u < 2; ++u)
#pragma unroll
            for (int j = 0; j < 4; ++j) { ywb[q][u][j] = *(const GAS v2u*)(Y + (size_t)(row0 + 2 * q + u) * DM + 4 * F.lane + 256 * j); xb[q][u][j] = *(const f32x4*)(x + (size_t)(row0 + 2 * q + u) * DM + 4 * F.lane + 256 * j); }
    f32x4 gpm[4], gf[4];
    LAS f32x4* shl = (LAS f32x4*)(F.lds + P6_SHF) + F.lane;
#pragma unroll
    for (int j = 0; j < 4; ++j) { const int k = 4 * F.lane + 256 * j; const float* mb = MOD + b * NMOD * DM + k;
        gpm[j] = *(const f32x4*)(mb + 2 * DM) * *(const f32x4*)(gpost + k); gf[j] = *(const f32x4*)(gffn + k) * (*(const f32x4*)(mb + 4 * DM) + 1.0f); if (F.wave == 0) shl[64 * j] = *(const f32x4*)(mb + 3 * DM); }
    bf16x8 wh[4][2], wl[4][2];
    { const float* WRT = (const float*)(F.ws + WS_WRT);
#pragma unroll
      for (int s = 0; s < 4; ++s)
#pragma unroll
          for (int hf = 0; hf < 2; ++hf) { const float* wp = WRT + (size_t)(16 * hf + l15) * DM + 128 * F.wave + 32 * s + 8 * l4;
              const f32x4 a = *(const f32x4*)wp, c = *(const f32x4*)(wp + 4);
              v4u h_, l_; h_.x = pk2(a[0], a[1]); h_.y = pk2(a[2], a[3]); h_.z = pk2(c[0], c[1]); h_.w = pk2(c[2], c[3]);
              l_.x = pk2(a[0] - bflo(h_.x), a[1] - bfhi(h_.x)); l_.y = pk2(a[2] - bflo(h_.y), a[3] - bfhi(h_.y)); l_.z = pk2(c[0] - bflo(h_.z), c[1] - bfhi(h_.z)); l_.w = pk2(c[2] - bflo(h_.w), c[3] - bfhi(h_.w));
              wh[s][hf] = __builtin_bit_cast(bf16x8, h_); wl[s][hf] = __builtin_bit_cast(bf16x8, l_); } }
    __syncthreads();
#pragma unroll
    for (int rp = 0; rp < 4; ++rp) { const int q = rp & 1;
#pragma unroll
        for (int u = 0; u < 2; ++u) { const int row = row0 + 2 * rp + u;
            f32x4 yv[4]; float ss = 0.f;
#pragma unroll
            for (int j = 0; j < 4; ++j) { const v2u yw = ywb[q][u][j]; yv[j] = (f32x4){bflo(yw.x), bfhi(yw.x), bflo(yw.y), bfhi(yw.y)}; ss += (yv[j][0] * yv[j][0] + yv[j][1] * yv[j][1]) + (yv[j][2] * yv[j][2] + yv[j][3] * yv[j][3]); }
            const float rinv = rsq_f(wave_sum(ss) * (1.0f / DM) + RMS_EPS);
            float s2 = 0.f;
#pragma unroll
            for (int j = 0; j < 4; ++j) { const f32x4 xm = xb[q][u][j] + gpm[j] * (yv[j] * rinv);
                if (VAR != 2) { v2u o; o.x = pk2(xm[0], xm[1]); o.y = pk2(xm[2], xm[3]); *(GAS v2u*)(XMID + (size_t)row * DM + 4 * F.lane + 256 * j) = o; }
                yv[j] = xm; s2 += (xm[0] * xm[0] + xm[1] * xm[1]) + (xm[2] * xm[2] + xm[3] * xm[3]); }
            const float rinv2 = rsq_f(wave_sum(s2) * (1.0f / DM) + RMS_EPS);
            LAS unsigned char* hrow = F.lds + (2 * F.wave + u) * P6_HPITCH + 8 * F.lane;
#pragma unroll
            for (int j = 0; j < 4; ++j) { const f32x4 h = yv[j] * rinv2 * gf[j] + shl[64 * j];
                int w8 = 0; w8 = __builtin_amdgcn_cvt_pk_fp8_f32(h[0], h[1], w8, false); w8 = __builtin_amdgcn_cvt_pk_fp8_f32(h[2], h[3], w8, true); if (VAR != 2) *(GAS int*)(H2 + (size_t)row * DM + 4 * F.lane + 256 * j) = w8;
                v2u hh; hh.x = pk2(h[0], h[1]); hh.y = pk2(h[2], h[3]);
                v2u hl; hl.x = pk2(h[0] - bflo(hh.x), h[1] - bfhi(hh.x)); hl.y = pk2(h[2] - bflo(hh.y), h[3] - bfhi(hh.y));
                *(LAS v2u*)(hrow + P6_HHI + 512 * j) = hh; *(LAS v2u*)(hrow + P6_HLO + 512 * j) = hl; }
        }
        if (rp < 2) {
#pragma unroll
            for (int u = 0; u < 2; ++u)
#pragma unroll
                for (int j = 0; j < 4; ++j) { ywb[q][u][j] = *(const GAS v2u*)(Y + (size_t)(row0 + 2 * rp + 4 + u) * DM + 4 * F.lane + 256 * j); xb[q][u][j] = *(const f32x4*)(x + (size_t)(row0 + 2 * rp + 4 + u) * DM + 4 * F.lane + 256 * j); } }
        __syncthreads();
        if (VAR != 1) {
            f32x4 acc[2] = {(f32x4){0.f, 0.f, 0.f, 0.f}, (f32x4){0.f, 0.f, 0.f, 0.f}};
            const LAS unsigned char* ab = F.lds + l15 * P6_HPITCH + (128 * F.wave + 8 * l4) * 2;
#pragma unroll
            for (int s = 0; s < 4; ++s) { const bf16x8 ah = *(const LAS bf16x8*)(ab + P6_HHI + 64 * s), al = *(const LAS bf16x8*)(ab + P6_HLO + 64 * s);
#pragma unroll
                for (int hf = 0; hf < 2; ++hf) { acc[hf] = __builtin_amdgcn_mfma_f32_16x16x32_bf16(ah, wh[s][hf], acc[hf], 0, 0, 0);
                    acc[hf] = __builtin_amdgcn_mfma_f32_16x16x32_bf16(ah, wl[s][hf], acc[hf], 0, 0, 0); acc[hf] = __builtin_amdgcn_mfma_f32_16x16x32_bf16(al, wh[s][hf], acc[hf], 0, 0, 0); } }
#pragma unroll
            for (int hf = 0; hf < 2; ++hf)
#pragma unroll
                for (int r = 0; r < 4; ++r) pbl[(F.wave * 16 + 4 * l4 + r) * 32 + 16 * hf + l15] = acc[hf][r];
        }
        __syncthreads();
        { float v = br;
          if (VAR != 1) {
#pragma unroll
              for (int ww = 0; ww < 8; ++ww) v += pbl[(ww * 16 + 2 * F.wave + par) * 32 + e]; }
          const int row = row0 + 2 * rp + par;
          float w = v, m0 = 0.f; int rank = -1;
#pragma unroll
          for (int k = 0; k < TOPK; ++k) { const float m = wave_max_par(w); if (k == 0) m0 = m;
              const unsigned long long eq = __builtin_amdgcn_ballot_w64(w == m);
              const int fe = __builtin_ctzll(eq & 0x5555555555555555ull | (1ull << 62)), fo = __builtin_ctzll(eq & 0xAAAAAAAAAAAAAAAAull | (1ull << 63));
              const bool win = F.lane == (par ? fo : fe); rank = win ? k : rank; w = win ? -__builtin_inff() : w; }
          const bool sel = rank >= 0; const float ex = sel ? __expf(v - m0) : 0.f; const float wgt = ex * __builtin_amdgcn_rcpf(wave_sum_par(ex));
          if (sel) { const int p = (row - bx * 64) * TOPK + rank;
              pce[p] = e; pcw[p] = wgt; pcr[p] = __hip_atomic_fetch_add((LAS int*)&hist[e], 1, __ATOMIC_RELAXED, __HIP_MEMORY_SCOPE_WORKGROUP);
              TOPI[(size_t)row * TOPK + rank] = e; TOPW[(size_t)row * TOPK + rank] = wgt; } }
    }
    __syncthreads();
    if (F.tid < NE) WGCNT[bx * NE + F.tid] = hist[F.tid];
    }
}

template <bool CARRY> __device__ __forceinline__ void p7_phase(Frame& F) {
    const int* TOPI = (const int*)(F.ws + WS_TOPI); const float* TOPW = (const float*)(F.ws + WS_TOPW); const int* WGCNT = (const int*)(F.ws + WS_WGCNT);
    int* ROWTOK = (int*)(F.ws + WS_ROWTOK); int* ROWPAIR = (int*)(F.ws + WS_ROWPAIR); float* ROWW = (float*)(F.ws + WS_ROWW); int* MTEXP = (int*)(F.ws + WS_MTEXP);
    LAS int* ptot = (LAS int*)F.lds; LAS int* pbef = ptot + 512; LAS int* cnt = pbef + 512; LAS int* wgb = cnt + 32; LAS int* pst = wgb + 32; LAS int* pad = pst + 64; LAS int* ep = pad + 32;
    LAS int* mtl = (LAS int*)(F.lds + 131072);
    const LAS int* pce = (const LAS int*)(F.lds + P67_CARRY); const LAS float* pcw = (const LAS float*)(pce + 256); const LAS int* pcr = pce + 512;
    if (F.G != 256) return;
    const int bx = blockIdx.x;
    { const int e = F.tid & 31, part = F.tid >> 5; int tt = 0, tb = 0;
      for (int w = part * 16; w < part * 16 + 16; ++w) { const int v = WGCNT[w * NE + e]; tt += v; tb += (w < bx) ? v : 0; }
      ptot[part * 32 + e] = tt; pbef[part * 32 + e] = tb; }
    if (!CARRY) { if (F.tid < 256) ep[F.tid] = TOPI[(size_t)bx * 256 + F.tid]; }
    __syncthreads();
    if (F.tid < NE) { int tt = 0, tb = 0; for (int p = 0; p < 16; ++p) { tt += ptot[p * 32 + F.tid]; tb += pbef[p * 32 + F.tid]; } cnt[F.tid] = tt; wgb[F.tid] = tb; pad[F.tid] = (tt + 255) & ~255; }
    __syncthreads();
    if (F.tid == 0) { int s = 0; for (int e = 0; e < NE; ++e) { pst[e] = s; s += pad[e]; } pst[NE] = s; mtl[511] = s >> 8; }
    __syncthreads();
    if (F.tid < 256) { const int p = F.tid; int e, rk; float w;
        if (CARRY) { e = pce[p]; rk = pcr[p]; w = pcw[p]; }
        else { e = ep[p]; rk = 0; for (int q2 = 0; q2 < p; ++q2) rk += (ep[q2] == e) ? 1 : 0; w = TOPW[(size_t)bx * 256 + p]; }
        const int dest = pst[e] + wgb[e] + rk; const int pair = bx * 256 + p; ROWTOK[dest] = pair >> 2; ROWPAIR[dest] = pair; ROWW[dest] = w; }
    if (bx < NE) { const int e = bx; for (int i = pst[e] + cnt[e] + F.tid; i < pst[e] + pad[e]; i += NWAVES * 64) { ROWTOK[i] = 0; ROWPAIR[i] = -1; ROWW[i] = 0.f; } }
    if (F.tid >= 256 && F.tid < 256 + NE) { const int e = F.tid - 256; for (int mt = pst[e] >> 8; mt < (pst[e] + pad[e]) >> 8; ++mt) { mtl[mt] = e; if (bx == 0) MTEXP[mt] = e; } }
    if (bx == 0 && F.tid == 0) MTEXP[512] = pst[NE] >> 8;
}

__device__ __forceinline__ void p10_phase(Frame& F) {
    const float* gpost = F.in(19); const float* MOD = (const float*)(F.ws + WS_MOD);
    const unsigned char* YP = (const unsigned char*)(F.ws + WS_YP); const bf16* XMID = (const bf16*)(F.ws + WS_XMID);
    const int gw = F.vcu * NWAVES + F.wave;
    if (F.G * NWAVES * 8 != NTOK) return;
    const int row0 = gw * 8, b = row0 / SEQ;
    f32x4 gg[4];
#pragma unroll
    for (int j = 0; j < 4; ++j) { const int k = 4 * F.lane + 256 * j; gg[j] = *(const f32x4*)(MOD + b * NMOD * DM + 5 * DM + k) * *(const f32x4*)(gpost + k); }
    int nw[4][TOPK]; v2u nm[4];
#pragma unroll
    for (int j = 0; j < 4; ++j) { nm[j] = *(const GAS v2u*)(XMID + (size_t)row0 * DM + 4 * F.lane + 256 * j);
#pragma unroll
        for (int k = 0; k < TOPK; ++k) nw[j][k] = *(const GAS int*)(YP + ((size_t)row0 * TOPK + k) * DM + 4 * F.lane + 256 * j); }
    for (int r = 0; r < 8; ++r) { const int row = row0 + r;
        f32x4 y[4], xm[4]; float ss = 0.f;
#pragma unroll
        for (int j = 0; j < 4; ++j) { f32x4 s = (f32x4){0.f, 0.f, 0.f, 0.f};
#pragma unroll
            for (int k = 0; k < TOPK; ++k) { const int w = nw[j][k]; s += (f32x4){__builtin_amdgcn_cvt_f32_fp8(w, 0), __builtin_amdgcn_cvt_f32_fp8(w, 1), __builtin_amdgcn_cvt_f32_fp8(w, 2), __builtin_amdgcn_cvt_f32_fp8(w, 3)}; }
            y[j] = s; ss += (s[0] * s[0] + s[1] * s[1]) + (s[2] * s[2] + s[3] * s[3]);
            const v2u mw = nm[j]; xm[j] = (f32x4){bflo(mw.x), bfhi(mw.x), bflo(mw.y), bfhi(mw.y)}; }
        if (r < 7) {
#pragma unroll
            for (int j = 0; j < 4; ++j) { nm[j] = *(const GAS v2u*)(XMID + (size_t)(row + 1) * DM + 4 * F.lane + 256 * j);
#pragma unroll
                for (int k = 0; k < TOPK; ++k) nw[j][k] = *(const GAS int*)(YP + ((size_t)(row + 1) * TOPK + k) * DM + 4 * F.lane + 256 * j); } }
        const float rinv = rsq_f(wave_sum(ss) * (1.0f / DM) + RMS_EPS * 16.0f);
#pragma unroll
        for (int j = 0; j < 4; ++j) *(f32x4*)(F.out + (size_t)row * DM + 4 * F.lane + 256 * j) = xm[j] + gg[j] * (y[j] * rinv);
    }
}

__device__ __forceinline__ void p8_bias(Frame& F, int t0) {
    const LAS int* mtl = (const LAS int*)(F.lds + 131072); LAS float* bsl = (LAS float*)(F.lds + 131072 + 2048); const float* b_up = F.in(23);
    const int t = (int)threadIdx.x - t0, nmt = mtl[511];
    if (t >= 0 && t < 256) for (int i = 0; i < 12; ++i) { const int L = i * F.G + F.vcu; if (L >= nmt * 8) break; const int ex = mtl[L >> 3], pn = L & 7;
        bsl[i * 256 + t] = b_up[(size_t)ex * 2 * DEXP + (t >> 7) * DEXP + pn * 128 + (t & 127)]; }
}
__device__ __forceinline__ void p9_bias(Frame& F, int nmt, int t0) {
    const LAS int* mtl = (const LAS int*)(F.lds + 131072); LAS float* bsl = (LAS float*)(F.lds + 131072 + 2048); const float* b_dn = F.in(25);
    const int t = (int)threadIdx.x - t0;
    if (t >= 0 && t < 256) for (int i = 0; i < 12; ++i) { int L, sub; if (!pg8::down_unit(i, F.vcu, nmt * 4, F.G, L, sub)) break; const int ex = mtl[L >> 2], pn = L & 3; bsl[i * 256 + t] = b_dn[(size_t)ex * DM + pn * 256 + t]; }
}
__device__ __forceinline__ void l2_warm(const void* p, int bytes) {
    const float* f = (const float*)p; float t_ = 0.f;
    for (int i = (int)threadIdx.x - 64; i < bytes / 128; i += NWAVES * 64 - 64) t_ += f[32 * i];
    asm volatile("" :: "v"(t_));
}
__global__ void __launch_bounds__(NWAVES * 64, 2) mega_fwd(Args args) {
    extern __shared__ __attribute__((aligned(16))) unsigned char lds[];
    Frame F;
    F.lds = (LAS unsigned char*)lds;
    F.tid = threadIdx.x; F.lane = F.tid & 63; F.wave = __builtin_amdgcn_readfirstlane(F.tid >> 6);
    F.G = gridDim.x; { const int bx = blockIdx.x; F.vcu = (F.G % 8 == 0) ? (bx % 8) * (F.G / 8) + bx / 8 : bx; }
    F.out = args.out; F.ws = args.ws;
    volatile LAS unsigned* MISC = (volatile LAS unsigned*)(F.lds + MISC_OFF);
    for (int u = F.tid; u < (LDS_BYTES - LDSCTL_OFF) / 4; u += NWAVES * 64) ((LAS unsigned*)(F.lds + LDSCTL_OFF))[u] = 0u;
    __syncthreads();
    if (F.tid < 26) ((LAS unsigned long long*)(F.lds + LDSCTL_OFF))[F.tid] = (unsigned long long)args.in[F.tid];
    __syncthreads();
    gu32* ctl = (gu32*)(F.ws + WS_CTL);
    XcdBarrier bar = xcd_barrier_post((unsigned*)(ctl + CW_BAR) + args.li * XCD_BAR_WORDS, MISC + 8);
    const int lo = args.ph_lo, hi = args.ph_hi;
#ifndef PHMASK
#define PHMASK 0x7ff
#endif
#define IN(k) (((PHMASK >> (k)) & 1) && lo <= (k) && (k) < hi)
#define SEAM(k, n) do { if (IN(k) && IN(n)) xcd_barrier(bar); } while (0)
#define REFRESH() do { int t_; asm volatile("v_mov_b32 %0, %1" : "=v"(t_) : "v"(threadIdx.x)); F.tid = t_; F.lane = t_ & 63; } while (0)
#define ATTN_TENSORS attn_body::AttnTensors{(const attn_body::bf16*)(F.ws + WS_PJ) + 2 * PJ_STRIDE, (const attn_body::bf16*)(F.ws + WS_PJ) + 3 * PJ_STRIDE, (const attn_body::bf16*)(F.ws + WS_PJ) + 4 * PJ_STRIDE, \
                                          (attn_body::bf16*)(F.ws + WS_MRG), (const float*)(F.ws + WS_LOGF2), (float*)(F.ws + WS_SSQ)}
    f32x4 xr[8][4];
    constexpr int XPRE = 4;
    if (IN(0) && IN(1) && F.G * NWAVES * 8 == NTOK) p1_load_x<0, XPRE>(F, xr);
    if (IN(0)) { p0_phase(F); } SEAM(0, 1);
    if (IN(1)) { if (F.G * NWAVES * 8 == NTOK) { if (!IN(0)) p1_load_x<0, XPRE>(F, xr); p1_load_x<XPRE, 8>(F, xr); } p1_phase<false>(F, xr); } SEAM(1, 2);
    if (IN(2)) { REFRESH();
        typedef pg8::DenseOrderT<false> ProjOrder;
        ProjOrder S; S.init((const pg8::bf16_t*)(F.ws + WS_H1), (const pg8::bf16_t*)(F.ws + WS_WIN), NTOK, NPJ, F.G, (int)blockIdx.x);
        pg8::EpiProj E{(pg8::bf16_t*)(F.ws + WS_PJ), PJ_STRIDE, attn_body::C2};
        pg8::gemm_phase<pg8::EpiProj, ProjOrder>(F.lds, S, E);
        if (F.G == 256 && blockIdx.x >= 128) { REFRESH(); cvt_range<true>(F, 0, CV_UP_TAIL, ((int)blockIdx.x - 128) * NWAVES + F.wave, 128 * NWAVES); }
    } SEAM(2, 3);
    if (IN(3)) { REFRESH();
        lru_phase(F);
        if (F.G == 256 && ((F.vcu >> 2) & 1) == 0) { __syncthreads(); REFRESH(); cvt_p3_share(F, 0); __syncthreads(); }
        { const attn_body::AttnTensors AT = ATTN_TENSORS; const attn_body::StaticOrder S((int)F.G, F.vcu);
          attn_body::attn_phase<attn_body::StaticOrder>((char*)lds, AT, S); }
        if (F.G == 256 && ((F.vcu >> 2) & 1) == 1) { __syncthreads(); REFRESH(); cvt_p3_share(F, 1); }
    } SEAM(3, 5);
    if (IN(5)) { REFRESH();
        pg8::DenseOrder S; S.init((const pg8::bf16_t*)(F.ws + WS_MRG), (const pg8::bf16_t*)(F.ws + WS_WOUT), NTOK, DM, F.G, (int)blockIdx.x);
        { pg8::Unit u0; if (S.next(0, u0)) {
              const float* src = (const float*)(F.ws + WS_SSQ) + ((size_t)u0.pm * 256 + F.wave * 32) * 8 + 4 * F.lane;
              __builtin_amdgcn_global_load_lds((const unsigned*)src, (LAS unsigned*)(F.lds + 131072 + 4096 + F.wave * 1024), 16, 0, 0); } }
        pg8::EpiOut E{(pg8::bf16_t*)(F.ws + WS_Y), (const LAS float*)(F.lds + 131072 + 4096)};
        pg8::gemm_phase<pg8::EpiOut, pg8::DenseOrder>(F.lds, S, E);
    } if (IN(5) && IN(6)) xcd_barrier(bar, [&] {
        l2_warm(F.ws + WS_WRT, NE * DM * 4); });
    if (IN(6)) { REFRESH(); p6_phase<0>(F); } SEAM(6, 7);
    if (IN(7)) { REFRESH(); if (IN(6)) p7_phase<true>(F); else p7_phase<false>(F); }
    if (IN(7) && IN(8)) xcd_barrier(bar, [&] { p8_bias(F, 64); });
    if (IN(8)) { REFRESH();
        LAS int* mtl = (LAS int*)(F.lds + 131072); LAS float* bsl = (LAS float*)(F.lds + 131072 + 2048);
        if (!IN(7)) {
            const int n_ = ((const int*)(F.ws + WS_MTEXP))[512];
            for (int i = F.tid; i < n_; i += NWAVES * 64) mtl[i] = ((const int*)(F.ws + WS_MTEXP))[i];
            if (F.tid == 0) mtl[511] = n_;
            __syncthreads();
            p8_bias(F, 0);
            __syncthreads(); }
        const int nmt = __builtin_amdgcn_readfirstlane(mtl[511]);
        pg8::UpOrder S{(const unsigned char*)(F.ws + WS_H2), (const unsigned char*)(F.ws + WS_WUP), (const int*)(F.ws + WS_ROWTOK), mtl, nmt * 8, F.G, F.vcu};
        pg8::EpiUp E{(unsigned char*)(F.ws + WS_ACT), bsl};
        pg8::gemm_phase<pg8::EpiUp, pg8::UpOrder, true>(F.lds, S, E);
        if (F.G == 256) {
            const int units = nmt * 8, maxu = (units + 255) >> 8, nfull = units - (maxu - 1) * 256, nidle = 256 - nfull;
            REFRESH();
            if (nidle >= 32) { if (F.vcu >= nfull) cvt_range<false>(F, 0, CV_DN_TAIL, (F.vcu - nfull) * NWAVES + F.wave, nidle * NWAVES); }
            else cvt_range<false>(F, 0, CV_DN_TAIL, F.vcu * NWAVES + F.wave, 256 * NWAVES); }
        if (IN(9)) xcd_barrier(bar, [&] { p9_bias(F, nmt, 64); });
    }
    if (IN(9)) { REFRESH();
        LAS int* mtl = (LAS int*)(F.lds + 131072); LAS float* bsl = (LAS float*)(F.lds + 131072 + 2048);
        if (!IN(8)) {
            const int n_ = ((const int*)(F.ws + WS_MTEXP))[512];
            for (int i = F.tid; i < n_; i += NWAVES * 64) mtl[i] = ((const int*)(F.ws + WS_MTEXP))[i];
            if (F.tid == 0) mtl[511] = n_;
            __syncthreads();
            p9_bias(F, n_, 0);
            __syncthreads(); }
        const int nmt = __builtin_amdgcn_readfirstlane(mtl[511]);
        pg8::DownOrder S{(const unsigned char*)(F.ws + WS_ACT), (const unsigned char*)(F.ws + WS_WDN), mtl, nmt * 4, F.G, F.vcu};
        pg8::EpiDown E{(unsigned char*)(F.ws + WS_YP), bsl, (const int*)(F.ws + WS_ROWPAIR), (const float*)(F.ws + WS_ROWW)};
        pg8::gemm_phase<pg8::EpiDown, pg8::DownOrder, true>(F.lds, S, E);
    } SEAM(9, 10);
    if (IN(10)) { REFRESH(); p10_phase(F); }
#ifdef MK_PROBES
    if (lo == 11) { REFRESH(); lru_phase(F); }
    if (lo == 12) { REFRESH(); const attn_body::AttnTensors AT = ATTN_TENSORS; const attn_body::StaticOrder S((int)F.G, F.vcu); attn_body::attn_phase<attn_body::StaticOrder>((char*)lds, AT, S); }
    if (lo == 14) { REFRESH(); p0_phase<1>(F); }
    if (lo == 15) { REFRESH(); p0_phase<2>(F); }
    if (lo == 16) { REFRESH(); p0_phase<4>(F); }
    if (lo == 17) { for (int i = 0; i < 10; ++i) xcd_barrier(bar); }
    if (lo == 18) { REFRESH(); p6_phase<1>(F); }
    if (lo == 19) { REFRESH(); p6_phase<2>(F); }
    if (lo >= 21 && lo <= 24) { REFRESH();
        const int nmt = ((const int*)(F.ws + WS_MTEXP))[512];
        LAS int* mtl = (LAS int*)(F.lds + 131072); LAS float* bsl = (LAS float*)(F.lds + 131072 + 2048);
        for (int i = F.tid; i < nmt; i += NWAVES * 64) mtl[i] = ((const int*)(F.ws + WS_MTEXP))[i];
        for (int i = F.tid; i < 12 * 256; i += NWAVES * 64) bsl[i] = 0.f;
        __syncthreads();
        pg8::UpOrder S{(const unsigned char*)(F.ws + WS_H2), (const unsigned char*)(F.ws + WS_WUP), (const int*)(F.ws + WS_ROWTOK), mtl, nmt * 8, F.G, F.vcu};
        if (lo == 21) { pg8::EpiNop E{}; pg8::gemm_phase<pg8::EpiNop, pg8::UpOrder, true, 1>(F.lds, S, E); }
        else if (lo == 22) { pg8::EpiNop E{}; pg8::gemm_phase<pg8::EpiNop, pg8::UpOrder, true, 2>(F.lds, S, E); }
        else if (lo == 23) { pg8::EpiUp E{(unsigned char*)(F.ws + WS_H1), bsl}; pg8::gemm_phase<pg8::EpiUp, pg8::UpOrder, true, 1>(F.lds, S, E); }
        else { pg8::EpiUpT<false> E{(unsigned char*)(F.ws + WS_H1), bsl}; pg8::gemm_phase<pg8::EpiUpT<false>, pg8::UpOrder, true, 1>(F.lds, S, E); } }
#endif
#undef IN
#undef SEAM
#undef REFRESH
#undef ATTN_TENSORS
}

static void launch_mega(hipStream_t stream, void* const* d_in, void* d_out, void* d_ws, int lo, int hi, int li, int grid) {
    Args a{};
    for (int i = 0; i < 26; ++i) a.in[i] = (const float*)d_in[i];
    a.out = (float*)d_out; a.ws = (unsigned char*)d_ws; a.ph_lo = lo; a.ph_hi = hi; a.li = li; a.pad = 0;
    hipLaunchKernelGGL(mega_fwd, dim3(grid), dim3(NWAVES * 64), LDS_BYTES, stream, a);
}

extern "C" void kernel_launch(void* const* d_in, const int* in_sizes, int n_in, void* d_out, int out_size, void* d_ws, size_t ws_size, hipStream_t stream) {
    static int grid = 0;
    if (grid == 0) {
        int dev = 0, cus = 0;
        if (n_in != 26 || out_size != NTOK * DM || ws_size < WS_END) { fprintf(stderr, "kernel_launch: unexpected problem shape / workspace (%d inputs, out %d, ws %zu)\n", n_in, out_size, ws_size); grid = -1; return; }
        if (hipGetDevice(&dev) != hipSuccess || hipDeviceGetAttribute(&cus, hipDeviceAttributeMultiprocessorCount, dev) != hipSuccess) { grid = -1; return; }
        if (hipFuncSetAttribute((const void*)mega_fwd, hipFuncAttributeMaxDynamicSharedMemorySize, LDS_BYTES) != hipSuccess) { fprintf(stderr, "kernel_launch: hipFuncSetAttribute failed\n"); grid = -1; return; }
        int per_cu = 0;
        if (hipOccupancyMaxActiveBlocksPerMultiprocessor(&per_cu, mega_fwd, NWAVES * 64, LDS_BYTES) != hipSuccess || per_cu < 1) { fprintf(stderr, "kernel_launch: the kernel does not fit a CU (occupancy query: %d)\n", per_cu); grid = -1; return; }
        grid = cus;
        if (grid != 256) fprintf(stderr, "kernel_launch: %d CUs; this kernel is laid out for 256\n", grid);
    }
    if (grid < 0) return;
    (void)in_sizes;
    (void)hipMemsetAsync((char*)d_ws + WS_CTL, 0, CTL_ZERO_BYTES, stream);
    launch_mega(stream, d_in, d_out, d_ws, 0, NPHASES, 0, grid);
#ifdef MK_PROBES
#ifdef EXTRA_LO
    launch_mega(stream, d_in, d_out, d_ws, EXTRA_LO, EXTRA_HI, 1, grid);
#endif
#endif
}
```
